# Optimizing an MI355X kernel written in HIP

```python
import jax, jax.numpy as jnp
from jax import lax
import numpy as np

D_MODEL = 2048
BATCH = 4
SEQ = 4096
DEPTH = 2

HEAD_DIM = 64
D_MIX = D_MODEL
D_GROUP = D_MIX // 4
N_HEADS = D_GROUP // HEAD_DIM
NORM_EPS = 1e-6
GN_EPS = 64e-5

RET_CHUNK = 128
RET_THETA = 10000.0
RWKV_DECAY_LORA = 96
RWKV_AAA_LORA = 96
RWKV_GATE_LORA = 256
SGU_CHUNK = 128
N_SGU_GROUPS = N_HEADS
DIL_BRANCHES = ((128, 1), (512, 4), (2048, 16))
ROPE_THETA = 500000.0
ROPE_DIM = HEAD_DIM // 4
N_EXPERT_GROUPS = 4
EXPERTS_PER_GROUP = 8
N_EXPERTS = N_EXPERT_GROUPS * EXPERTS_PER_GROUP
TOP_K_IN_GROUP = 2
D_EXPERT = D_MODEL // 4
MOE_BLOCK = 128

A_COLS = 4 * D_GROUP
B_COLS = 3 * D_GROUP + RWKV_DECAY_LORA + RWKV_AAA_LORA + RWKV_GATE_LORA
C_COLS = 2 * D_GROUP
D_COLS = 3 * D_GROUP
D_IN = A_COLS + B_COLS + C_COLS + D_COLS

kernel_name = 'hybrid_parallel_group_encoder'


def rms_norm(x, g):
    x32 = x.astype(jnp.float32)
    y = x32 * lax.rsqrt(jnp.mean(x32 * x32, axis=-1, keepdims=True) + NORM_EPS)
    return (y * g.astype(jnp.float32)).astype(x.dtype)


def group_norm(y, g):
    mu = jnp.mean(y, -1, keepdims=True)
    var = jnp.mean(jnp.square(y - mu), -1, keepdims=True)
    yn = (y - mu) * lax.rsqrt(var + GN_EPS)
    return yn.reshape(*y.shape[:-2], -1) * g.astype(jnp.float32)


def heads(t):
    return t.reshape(*t.shape[:-1], N_HEADS, HEAD_DIM)


def rotary(t, pos, theta, rot_dim):
    half = rot_dim // 2
    inv = theta ** (-jnp.arange(half, dtype=jnp.float32) / half)
    ang = pos.astype(jnp.float32)[..., None] * inv
    cos = jnp.cos(ang)[:, :, None, :]
    sin = jnp.sin(ang)[:, :, None, :]
    t1, t2, rest = t[..., :half], t[..., half:rot_dim], t[..., rot_dim:]
    return jnp.concatenate([t1 * cos - t2 * sin, t2 * cos + t1 * sin, rest], axis=-1)


def retention_one_direction(q, k, v, log_gamma, include_diag):
    b, s, h, dh = q.shape
    c = RET_CHUNK
    n = s // c
    to_chunks = lambda t: t.reshape(b, n, c, h, dh).transpose(1, 0, 3, 2, 4)
    idx = jnp.arange(c, dtype=jnp.float32)
    diff = idx[:, None] - idx[None, :]
    valid = (diff >= 0) if include_diag else (diff > 0)
    lg = log_gamma[:, None, None]
    d_in = jnp.where(valid, jnp.exp(lg * jnp.maximum(diff, 0.0)), 0.0)
    q_dec = jnp.exp(log_gamma[:, None] * (idx + 1.0))[..., None]
    k_dec = jnp.exp(log_gamma[:, None] * (c - 1.0 - idx))[..., None]
    c_dec = jnp.exp(log_gamma * c)[:, None, None]

    def step(state, qkv):
        qc, kc, vc = qkv
        scores = jnp.einsum('bhnd,bhmd->bhnm', qc, kc) * d_in
        out = (jnp.einsum('bhnm,bhme->bhne', scores, vc)
               + jnp.einsum('bhnd,bhde->bhne', qc * q_dec, state))
        state = state * c_dec + jnp.einsum('bhmd,bhme->bhde', kc * k_dec, vc)
        return state, out

    state0 = jnp.zeros((b, h, dh, dh), jnp.float32)
    _, out = lax.scan(step, state0, (to_chunks(q), to_chunks(k), to_chunks(v)))
    return out.transpose(1, 0, 3, 2, 4).reshape(b, s, h, dh)


def retention_mixer(cols, positions, gamma_logit, norm_g):
    q, k, v, g = jnp.split(cols, 4, axis=-1)
    q = rotary(heads(q), positions, RET_THETA, HEAD_DIM)
    k = rotary(heads(k), positions, RET_THETA, HEAD_DIM) * HEAD_DIM ** -0.5
    v = heads(v)
    log_gamma = jax.nn.log_sigmoid(gamma_logit.astype(jnp.float32))
    fwd = retention_one_direction(q, k, v, log_gamma[0], True)
    bwd = retention_one_direction(q[:, ::-1], k[:, ::-1], v[:, ::-1], log_gamma[1], False)[:, ::-1]
    return jax.nn.silu(g) * group_norm(fwd + bwd, norm_g)


def centred_token_shift(t, mu):
    prev = jnp.pad(t[:, :-1], ((0, 0), (1, 0), (0, 0)))
    nxt = jnp.pad(t[:, 1:], ((0, 0), (0, 1), (0, 0)))
    return t + mu[0] * (prev - t) + mu[1] * (nxt - t)


def rwkv7_scan(r, w, k, v, kk, a, reverse):
    b, s, h, dh = r.shape
    tm = lambda t: jnp.moveaxis(t, 1, 0)

    def step(state, inp):
        rt, wt, kt, vt, kkt, at = inp
        sk = jnp.einsum('bhvk,bhk->bhv', state, kkt)
        state = (state * wt[:, :, None, :] - sk[..., None] * (kkt * at)[:, :, None, :]
                 + vt[..., None] * kt[:, :, None, :])
        return state, jnp.einsum('bhvk,bhk->bhv', state, rt)

    state0 = jnp.zeros((b, h, dh, dh), jnp.float32)
    _, y = lax.scan(step, state0, (tm(r), tm(w), tm(k), tm(v), tm(kk), tm(a)), reverse=reverse)
    return jnp.moveaxis(y, 0, 1)


def rwkv7_mixer(cols, mu, w0, w2, a0, a2, g2, k_k, k_a, r_k, ln_g):
    cols = centred_token_shift(cols, mu)
    r, k, v, xw, xa, xg = jnp.split(
        cols, [D_GROUP, 2 * D_GROUP, 3 * D_GROUP, 3 * D_GROUP + RWKV_DECAY_LORA,
               3 * D_GROUP + RWKV_DECAY_LORA + RWKV_AAA_LORA], axis=-1)
    w_lr = jnp.tanh(xw) @ w2
    a_lr = xa @ a2
    g = jax.nn.sigmoid(xg) @ g2
    kk = heads(k * k_k)
    kk = kk * lax.rsqrt(jnp.sum(kk * kk, -1, keepdims=True) + 1e-12)
    rh, vh = heads(r), heads(v)
    y = None
    for direction, rev in ((0, False), (1, True)):
        w_raw = w0[direction] + w_lr
        decay = jnp.exp(-jnp.exp(-jax.nn.softplus(-w_raw) - 0.5))
        a = jax.nn.sigmoid(a0[direction] + a_lr)
        kd = k * (1.0 + (a - 1.0) * k_a)
        yd = rwkv7_scan(rh, heads(decay), heads(kd), vh, kk, heads(a), rev)
        y = yd if y is None else y + yd
    y = group_norm(y, ln_g)
    bonus = jnp.sum(rh * heads(k) * r_k, -1, keepdims=True) * vh
    return (y + bonus.reshape(y.shape)) * g


def sgu_mixer(cols, ln_g, ln_b, w_s, b_s):
    u, v = jnp.split(jax.nn.gelu(cols), 2, axis=-1)
    mu = jnp.mean(v, -1, keepdims=True)
    var = jnp.mean(jnp.square(v - mu), -1, keepdims=True)
    v = (v - mu) * lax.rsqrt(var + NORM_EPS) * ln_g + ln_b
    b, s, _ = v.shape
    n = s // SGU_CHUNK
    vc = v.reshape(b, n, SGU_CHUNK, N_SGU_GROUPS, D_GROUP // N_SGU_GROUPS)
    mixed = (jnp.einsum('gpq,bcqgd->bcpgd', w_s, vc)
             + jnp.transpose(b_s)[None, None, :, :, None])
    return u * mixed.reshape(b, s, D_GROUP)


def dilated_branch(q, k, v, window, dilation):
    b, s, h, dh = q.shape
    r = window // (2 * dilation)
    L = s // dilation
    nb = -(-L // r)
    lp = nb * r

    def subseq(t):
        return t.reshape(b, L, dilation, h, dh).transpose(0, 2, 3, 1, 4)

    qs, ks, vs = subseq(q), subseq(k), subseq(v)
    qb = jnp.pad(qs, ((0, 0), (0, 0), (0, 0), (0, lp - L), (0, 0))).reshape(b, dilation, h, nb, r, dh)

    def band(t):
        tp = jnp.pad(t, ((0, 0), (0, 0), (0, 0), (r, lp - L + r), (0, 0))).reshape(b, dilation, h, nb + 2, r, dh)
        return jnp.concatenate([tp[:, :, :, :-2], tp[:, :, :, 1:-1], tp[:, :, :, 2:]], axis=4)

    kb, vb = band(ks), band(vs)
    qi = jnp.arange(r)[:, None]
    ki = jnp.arange(3 * r)[None, :]
    key_pos = jnp.arange(nb)[:, None, None] * r - r + ki[None]
    valid = (jnp.abs(ki - r - qi)[None] <= r) & (key_pos >= 0) & (key_pos < L)
    scores = jnp.einsum('bghnqe,bghnke->bghnqk', qb, kb)
    scores = jnp.where(valid, scores, -1e30)
    m = jnp.max(scores, -1, keepdims=True)
    p = jnp.exp(scores - m)
    l = jnp.sum(p, -1)
    o = jnp.einsum('bghnqk,bghnke->bghnqe', p, vb)

    def unsub(t):
        t = t.reshape(b, dilation, h, lp, *t.shape[5:])[:, :, :, :L]
        t = jnp.moveaxis(t, 3, 1)
        return t.reshape(b, s, h, *t.shape[4:])

    return unsub(m[..., 0]), unsub(l), unsub(o)


def dilated_attention_mixer(cols, positions):
    q, k, v = jnp.split(cols, 3, axis=-1)
    q = rotary(heads(q), positions, ROPE_THETA, ROPE_DIM) * HEAD_DIM ** -0.5
    k = rotary(heads(k), positions, ROPE_THETA, ROPE_DIM)
    v = heads(v)
    outs = [dilated_branch(q, k, v, w, d) for (w, d) in DIL_BRANCHES]
    m_all = jnp.stack([br[0] for br in outs])
    l_all = jnp.stack([br[1] for br in outs])
    o_all = jnp.stack([br[2] for br in outs])
    wts = jnp.exp(m_all - jnp.max(m_all, 0, keepdims=True))
    num = jnp.sum(wts[..., None] * o_all, 0)
    den = jnp.sum(wts * l_all, 0)
    y = num / den[..., None]
    return y.reshape(*y.shape[:2], D_GROUP)


def hierarchical_moe(h, wg, bg, we, be, w_gate, w_up, w_down):
    b, s, d = h.shape
    t = b * s
    xt = h.reshape(t, d)
    g_prob = jax.nn.softmax((xt @ wg + bg).astype(jnp.float32), axis=-1)
    g_top, g_idx = lax.top_k(g_prob, 1)
    e_logits = (xt @ we + be).astype(jnp.float32).reshape(t, N_EXPERT_GROUPS, EXPERTS_PER_GROUP)
    e_logits = jnp.take_along_axis(e_logits, g_idx[:, :, None], axis=1)[:, 0]
    e_prob = jax.nn.softmax(e_logits, axis=-1)
    e_top, e_local = lax.top_k(e_prob, TOP_K_IN_GROUP)
    gate = g_top * e_top / jnp.sum(e_top, -1, keepdims=True)
    expert = g_idx * EXPERTS_PER_GROUP + e_local
    n_assign = t * TOP_K_IN_GROUP
    a_exp = expert.reshape(n_assign)
    a_tok = jnp.repeat(jnp.arange(t, dtype=jnp.int32), TOP_K_IN_GROUP)
    a_gate = gate.reshape(n_assign)
    order = jnp.argsort(a_exp)
    s_exp, s_tok, s_gate = a_exp[order], a_tok[order], a_gate[order]
    counts = jnp.zeros((N_EXPERTS,), jnp.int32).at[a_exp].add(1)
    starts = jnp.cumsum(counts) - counts
    pcounts = (counts + MOE_BLOCK - 1) // MOE_BLOCK * MOE_BLOCK
    pends = jnp.cumsum(pcounts)
    pstarts = pends - pcounts
    dest = pstarts[s_exp] + jnp.arange(n_assign, dtype=jnp.int32) - starts[s_exp]
    n_blocks = -(-n_assign // MOE_BLOCK) + N_EXPERTS
    p = n_blocks * MOE_BLOCK
    buf_tok = jnp.full((p,), t, jnp.int32).at[dest].set(s_tok)
    buf_gate = jnp.zeros((p,), jnp.float32).at[dest].set(s_gate)
    blk_exp = jnp.minimum(
        jnp.searchsorted(pends, jnp.arange(n_blocks, dtype=jnp.int32) * MOE_BLOCK, side='right'),
        N_EXPERTS - 1)
    x_pad = jnp.concatenate([xt, jnp.zeros((1, d), xt.dtype)], axis=0)

    def expert_block(args):
        tok, e = args
        xb = x_pad[tok]
        hid = jax.nn.silu(xb @ w_gate[e]) * (xb @ w_up[e])
        return hid @ w_down[e]

    y_buf = lax.map(expert_block, (buf_tok.reshape(n_blocks, MOE_BLOCK), blk_exp))
    y = jnp.zeros((t + 1, d), jnp.float32).at[buf_tok].add(
        buf_gate[:, None] * y_buf.reshape(p, d).astype(jnp.float32))
    return y[:t].reshape(b, s, d).astype(h.dtype)


def setup_inputs(seed: int = 0) -> dict:
    key = jax.random.key(seed)
    ks = iter(jax.random.split(key, 40))
    f32 = jnp.float32
    nrm = lambda shape, scale: scale * jax.random.normal(next(ks), shape, f32)
    L = DEPTH
    x = jax.random.normal(next(ks), (BATCH, SEQ, D_MODEL), f32)
    offsets = jax.random.randint(next(ks), (BATCH, 1), 0, 1024, jnp.int32)
    positions = offsets + jnp.arange(SEQ, dtype=jnp.int32)[None, :]
    gamma = 1.0 - 2.0 ** (-5.0 - jnp.arange(N_HEADS, dtype=f32))
    gamma_logit = jnp.log(gamma) - jnp.log1p(-gamma)
    ramp = jnp.linspace(-6.0, 1.0, D_GROUP, dtype=f32)
    return {
        'x': x,
        'positions': positions,
        'norm_attn_g': 1.0 + nrm((L, D_MODEL), 0.05),
        'w_in': nrm((L, D_MODEL, D_IN), D_MODEL ** -0.5),
        'w_out': nrm((L, D_MIX, D_MODEL), D_MIX ** -0.5),
        'ret_gamma_logit': gamma_logit[None, None, :] + nrm((L, 2, N_HEADS), 0.1),
        'ret_norm_g': 1.0 + nrm((L, D_GROUP), 0.05),
        'rwkv_mu': jax.random.uniform(next(ks), (L, 2, B_COLS), f32, 0.0, 0.5),
        'rwkv_w0': ramp + nrm((L, 2, D_GROUP), 0.1),
        'rwkv_w2': nrm((L, RWKV_DECAY_LORA, D_GROUP), RWKV_DECAY_LORA ** -0.5),
        'rwkv_a0': nrm((L, 2, D_GROUP), 0.1),
        'rwkv_a2': nrm((L, RWKV_AAA_LORA, D_GROUP), RWKV_AAA_LORA ** -0.5),
        'rwkv_g2': nrm((L, RWKV_GATE_LORA, D_GROUP), RWKV_GATE_LORA ** -0.5),
        'rwkv_k_k': 0.85 + nrm((L, D_GROUP), 0.05),
        'rwkv_k_a': 1.0 + nrm((L, D_GROUP), 0.05),
        'rwkv_r_k': nrm((L, N_HEADS, HEAD_DIM), 0.1),
        'rwkv_ln_g': 1.0 + nrm((L, D_GROUP), 0.05),
        'sgu_ln_g': 1.0 + nrm((L, D_GROUP), 0.05),
        'sgu_ln_b': nrm((L, D_GROUP), 0.02),
        'sgu_w': nrm((L, N_SGU_GROUPS, SGU_CHUNK, SGU_CHUNK), SGU_CHUNK ** -0.5),
        'sgu_b': 1.0 + nrm((L, N_SGU_GROUPS, SGU_CHUNK), 0.1),
        'norm_ffn_g': 1.0 + nrm((L, D_MODEL), 0.05),
        'router_group_w': nrm((L, D_MODEL, N_EXPERT_GROUPS), D_MODEL ** -0.5),
        'router_group_b': nrm((L, N_EXPERT_GROUPS), 0.01),
        'router_expert_w': nrm((L, D_MODEL, N_EXPERTS), D_MODEL ** -0.5),
        'router_expert_b': nrm((L, N_EXPERTS), 0.01),
        'expert_w_gate': nrm((L, N_EXPERTS, D_MODEL, D_EXPERT), D_MODEL ** -0.5),
        'expert_w_up': nrm((L, N_EXPERTS, D_MODEL, D_EXPERT), D_MODEL ** -0.5),
        'expert_w_down': nrm((L, N_EXPERTS, D_EXPERT, D_MODEL), D_EXPERT ** -0.5),
        'final_norm_g': 1.0 + nrm((D_MODEL,), 0.05),
    }


def reference(x, positions, norm_attn_g, w_in, w_out, ret_gamma_logit, ret_norm_g, rwkv_mu,
              rwkv_w0, rwkv_w2, rwkv_a0, rwkv_a2, rwkv_g2, rwkv_k_k, rwkv_k_a, rwkv_r_k,
              rwkv_ln_g, sgu_ln_g, sgu_ln_b, sgu_w, sgu_b, norm_ffn_g, router_group_w,
              router_group_b, router_expert_w, router_expert_b, expert_w_gate, expert_w_up,
              expert_w_down, final_norm_g):
    for l in range(DEPTH):
        h = rms_norm(x, norm_attn_g[l])
        proj = (h @ w_in[l]).astype(jnp.float32)
        a_cols, b_cols, c_cols, d_cols = jnp.split(
            proj, [A_COLS, A_COLS + B_COLS, A_COLS + B_COLS + C_COLS], axis=-1)
        y_a = retention_mixer(a_cols, positions, ret_gamma_logit[l], ret_norm_g[l])
        y_b = rwkv7_mixer(b_cols, rwkv_mu[l], rwkv_w0[l], rwkv_w2[l], rwkv_a0[l], rwkv_a2[l],
                          rwkv_g2[l], rwkv_k_k[l], rwkv_k_a[l], rwkv_r_k[l], rwkv_ln_g[l])
        y_c = sgu_mixer(c_cols, sgu_ln_g[l], sgu_ln_b[l], sgu_w[l], sgu_b[l])
        y_d = dilated_attention_mixer(d_cols, positions)
        y = jnp.concatenate([y_a, y_b, y_c, y_d], axis=-1).astype(x.dtype)
        x = x + y @ w_out[l]
        h = rms_norm(x, norm_ffn_g[l])
        x = x + hierarchical_moe(h, router_group_w[l], router_group_b[l], router_expert_w[l],
                                 router_expert_b[l], expert_w_gate[l], expert_w_up[l],
                                 expert_w_down[l])
    return rms_norm(x, final_norm_g)
```

```cpp
#include <hip/hip_runtime.h>
#include <cstdio>
#include <cstdint>
#include <cmath>

#ifndef KB_BATCH
#define KB_BATCH 4
#define KB_SEQ 4096
#endif
#ifndef KB_SPLIT
#define KB_SPLIT 1
#endif

#ifndef KB_PHMASK
#define KB_PHMASK 0xffff
#endif
#define KB_EN(k) (((KB_PHMASK) >> (k)) & 1)
#define HD __host__ __device__ __forceinline__
typedef unsigned short bf16;

constexpr int BATCH = KB_BATCH, SEQ = KB_SEQ, T = BATCH * SEQ;
constexpr int DM = 2048, DG = 512, NH = 8, HDIM = 64;
constexpr int A_COLS = 2048, B_COLS = 1984, C_COLS = 1024, D_COLS = 1536, D_IN = 6592, NPROJ = 6656;
constexpr int OFF_A = 0, OFF_B = 2048, OFF_C = 4032, OFF_D = 5056;
constexpr int NC = SEQ / 128;
constexpr int NEXP = 32, DE = 512;
constexpr int NLORA = 448;
constexpr float NORM_EPS = 1e-6f, GN_EPS = 64e-5f;
constexpr int MOE_MAXTILES = (2 * T + NEXP * 255 + 255) / 256;
constexpr int DEPTH = 2;

constexpr size_t MiB = 1u << 20;
constexpr size_t WS_CTL = 0, CTL_ZERO_BYTES = 1 * MiB;
constexpr size_t WS_WIN = 2 * MiB, WS_WOUT = 28 * MiB, WS_WGU = 36 * MiB, WS_WD = 164 * MiB;
constexpr size_t WS_X = 228 * MiB;
constexpr size_t WS_ACT = 356 * MiB;
constexpr size_t WS_PROJ = 420 * MiB;
constexpr size_t WS_RKV = 628 * MiB, WS_RSP = 660 * MiB;
constexpr size_t WS_RS = 692 * MiB, WS_KS = 708 * MiB, WS_VS = 724 * MiB, WS_KK = 740 * MiB, WS_GG = 756 * MiB, WS_KDF = 772 * MiB, WS_KDB = 788 * MiB,
                 WS_AKF = 804 * MiB, WS_AKB = 820 * MiB, WS_YF = 836 * MiB, WS_YB = 852 * MiB, WS_LIN = 868 * MiB  , WS_WF = 882 * MiB, WS_WB = 914 * MiB;
constexpr size_t WS_TOK = 946 * MiB  , WS_SLOT = 948 * MiB, WS_GATE = 949 * MiB, WS_END = 950 * MiB;
constexpr size_t WS_APERM = 420 * MiB, WS_HID = 580 * MiB, WS_YP = 620 * MiB;
static_assert((size_t)MOE_MAXTILES * 256 * 2048 * 2 <= 160 * MiB && (size_t)T * NPROJ * 2 <= 208 * MiB, "ws map");
constexpr int CW_BAR = 4096;
constexpr int CW_CNT = 16384;

HD float bf2f(bf16 v) { return __builtin_bit_cast(float, (unsigned)v << 16); }
HD bf16 f2bf(float f) { unsigned u = __builtin_bit_cast(unsigned, f); return (bf16)((u + 0x7fffu + ((u >> 16) & 1u)) >> 16); }
HD float sigmoidf_(float x) { return 1.f / (1.f + expf(-x)); }
HD float siluf_(float x) { return x / (1.f + expf(-x)); }
HD float geluf_(float x) { return 0.5f * x * (1.f + tanhf(0.7978845608028654f * (x + 0.044715f * x * x * x))); }
HD float logsigmoidf_(float x) { return x < 0.f ? x - log1pf(expf(x)) : -log1pf(expf(-x)); }

struct Ctx {
    const int* pos;
    const float *gam, *ret_g, *mu, *w0, *w2, *a0, *a2, *g2, *k_k, *k_a, *r_k, *ln_g, *sgu_g, *sgu_b, *sgu_w, *sgu_bias;
    bf16 *proj, *ycat, *rs, *ks, *vs, *kk, *gg, *kdf, *kdb, *akf, *akb, *yf, *yb, *lin;
    float *wf, *wb, *rkv, *rsp;
};

HD void el_rot_ret(const Ctx& c, long idx) {
    const int i = (int)(idx & 31), h = (int)((idx >> 5) & 7); const long t = idx >> 8;
    const float inv = expf(-(float)i * (1.f / 32.f) * 9.210340371976184f);
    const float ang = (float)c.pos[t] * inv; float sn, cs; sincosf(ang, &sn, &cs);
    bf16* q = c.proj + (size_t)t * NPROJ + OFF_A + h * 64; bf16* k = q + 512;
    const float q1 = bf2f(q[i]), q2 = bf2f(q[i + 32]), k1 = bf2f(k[i]), k2 = bf2f(k[i + 32]);
    q[i] = f2bf(q1 * cs - q2 * sn); q[i + 32] = f2bf(q2 * cs + q1 * sn);
    k[i] = f2bf((k1 * cs - k2 * sn) * 0.125f); k[i + 32] = f2bf((k2 * cs + k1 * sn) * 0.125f);
}
HD void el_rot_dil(const Ctx& c, long idx) {
    const int j = (int)(idx & 31), h = (int)((idx >> 5) & 7); const long t = idx >> 8;
    bf16* q = c.proj + (size_t)t * NPROJ + OFF_D + h * 64; bf16* k = q + 512;
    if (j < 8) {
        const float inv = expf(-(float)j * (1.f / 8.f) * 13.122363377404328f);
        const float ang = (float)c.pos[t] * inv; float sn, cs; sincosf(ang, &sn, &cs);
        const float q1 = bf2f(q[j]), q2 = bf2f(q[j + 8]), k1 = bf2f(k[j]), k2 = bf2f(k[j + 8]);
        q[j] = f2bf((q1 * cs - q2 * sn) * 0.125f); q[j + 8] = f2bf((q2 * cs + q1 * sn) * 0.125f);
        k[j] = f2bf(k1 * cs - k2 * sn); k[j + 8] = f2bf(k2 * cs + k1 * sn);
    } else {
        const int d = 16 + 2 * (j - 8);
        q[d] = f2bf(bf2f(q[d]) * 0.125f); q[d + 1] = f2bf(bf2f(q[d + 1]) * 0.125f);
    }
}
HD void el_rwkv_shift(const Ctx& c, long idx) {
    const int j = (int)(idx % B_COLS); const long t = idx / B_COLS; const int s = (int)(t % SEQ);
    const bf16* p = c.proj + (size_t)t * NPROJ + OFF_B + j;
    const float x = bf2f(p[0]), xp = s > 0 ? bf2f(p[-(long)NPROJ]) : 0.f, xn = s < SEQ - 1 ? bf2f(p[NPROJ]) : 0.f;
    const float xs = x + c.mu[j] * (xp - x) + c.mu[B_COLS + j] * (xn - x);
    if (j < 512) c.rs[t * 512 + j] = f2bf(xs);
    else if (j < 1024) c.ks[t * 512 + j - 512] = f2bf(xs);
    else if (j < 1536) c.vs[t * 512 + j - 1024] = f2bf(xs);
    else if (j < 1632) c.lin[t * NLORA + (j - 1536)] = f2bf(tanhf(xs));
    else if (j < 1728) c.lin[t * NLORA + (j - 1536)] = f2bf(xs);
    else c.lin[t * NLORA + (j - 1536)] = f2bf(sigmoidf_(xs));
}
HD void el_rwkv_lora(const Ctx& c, long idx) {
    const int ch = (int)(idx & 511); const long t = idx >> 9;
    const bf16* li = c.lin + t * NLORA;
    float wl = 0.f, al = 0.f, g = 0.f;
    for (int i = 0; i < 96; ++i) { wl += bf2f(li[i]) * c.w2[i * 512 + ch]; al += bf2f(li[96 + i]) * c.a2[i * 512 + ch]; }
    for (int i = 0; i < 256; ++i) g += bf2f(li[192 + i]) * c.g2[i * 512 + ch];
    c.gg[t * 512 + ch] = f2bf(g);
    const float k = bf2f(c.ks[t * 512 + ch]), ka = c.k_a[ch];
    c.kk[t * 512 + ch] = f2bf(k * c.k_k[ch]);
    {   const float dec = expf(-0.6065306597126334f * sigmoidf_(c.w0[ch] + wl)); const float a = sigmoidf_(c.a0[ch] + al);
        c.wf[t * 512 + ch] = dec; c.kdf[t * 512 + ch] = f2bf(k * (1.f + (a - 1.f) * ka)); c.akf[t * 512 + ch] = f2bf(a); }
    {   const float dec = expf(-0.6065306597126334f * sigmoidf_(c.w0[512 + ch] + wl)); const float a = sigmoidf_(c.a0[512 + ch] + al);
        c.wb[t * 512 + ch] = dec; c.kdb[t * 512 + ch] = f2bf(k * (1.f + (a - 1.f) * ka)); c.akb[t * 512 + ch] = f2bf(a); }
}
HD void el_rwkv_kk(const Ctx& c, long idx) {
    const int h = (int)(idx & 7); const long t = idx >> 3; const size_t o = (size_t)t * 512 + h * 64;
    float ss = 0.f;
    for (int d = 0; d < 64; ++d) { const float v = bf2f(c.kk[o + d]); ss += v * v; }
    const float n = 1.f / sqrtf(ss + 1e-12f);
    for (int d = 0; d < 64; ++d) { const float v = bf2f(c.kk[o + d]) * n; c.kk[o + d] = f2bf(v);
        c.akf[o + d] = f2bf(bf2f(c.akf[o + d]) * v); c.akb[o + d] = f2bf(bf2f(c.akb[o + d]) * v); }
}
HD void el_sgu_prep(const Ctx& c, long t) {
    bf16* v = c.proj + (size_t)t * NPROJ + OFF_C + 512;
    float s = 0.f;
    for (int j = 0; j < 512; ++j) s += geluf_(bf2f(v[j]));
    const float mean = s * (1.f / 512.f); float q = 0.f;
    for (int j = 0; j < 512; ++j) { const float d = geluf_(bf2f(v[j])) - mean; q += d * d; }
    const float rstd = 1.f / sqrtf(q * (1.f / 512.f) + NORM_EPS);
    for (int j = 0; j < 512; ++j) v[j] = f2bf((geluf_(bf2f(v[j])) - mean) * rstd * c.sgu_g[j] + c.sgu_b[j]);
}

HD void el_ret_kv(const Ctx& c, long idx) {
    const int e = (int)(idx & 63), d = (int)((idx >> 6) & 63); long r = idx >> 12;
    const int ch = (int)(r % NC); r /= NC; const int dir = (int)(r & 1); r >>= 1; const int h = (int)(r & 7); const int b = (int)(r >> 3);
    const float lg = logsigmoidf_(c.gam[dir * 8 + h]);
    const bf16* base = c.proj + ((size_t)b * SEQ + (size_t)ch * 128) * NPROJ + OFF_A + h * 64;
    float kv = 0.f;
    for (int m = 0; m < 128; ++m) { const float dec = expf(lg * (float)(dir == 0 ? 127 - m : m));
        kv += dec * bf2f(base[(size_t)m * NPROJ + 512 + d]) * bf2f(base[(size_t)m * NPROJ + 1024 + e]); }
    c.rkv[idx] = kv;
}
HD void el_dil_attn(const Ctx& c, long idx) {
    const int h = (int)(idx & 7); const long t = idx >> 3; const int s = (int)(t % SEQ); const long tb = t - s;
    const bf16* qp = c.proj + (size_t)t * NPROJ + OFF_D + h * 64;
    float q[64], o[64];
#pragma unroll
    for (int i = 0; i < 64; ++i) { q[i] = bf2f(qp[i]); o[i] = 0.f; }
    float m = -1e30f, l = 0.f;
    for (int br = 0; br < 3; ++br) {
        const int dil = br == 0 ? 1 : (br == 1 ? 4 : 16);
        for (int j = -64; j <= 64; ++j) {
            const int sp = s + dil * j; if (sp < 0 || sp >= SEQ) continue;
            const bf16* kp = c.proj + (size_t)(tb + sp) * NPROJ + OFF_D + 512 + h * 64; const bf16* vp = kp + 512;
            float sc = 0.f;
#pragma unroll
            for (int i = 0; i < 64; ++i) sc += q[i] * bf2f(kp[i]);
            const float mn = sc > m ? sc : m, scale = expf(m - mn), p = expf(sc - mn);
            l = l * scale + p; m = mn;
#pragma unroll
            for (int i = 0; i < 64; ++i) o[i] = o[i] * scale + p * bf2f(vp[i]);
        }
    }
    const float il = 1.f / l; bf16* y = c.ycat + (size_t)t * 2048 + 1536 + h * 64;
#pragma unroll
    for (int i = 0; i < 64; ++i) y[i] = f2bf(o[i] * il);
}
HD void el_sgu_main(const Ctx& c, long idx) {
    const int j = (int)(idx & 511); const long t = idx >> 9; const int s = (int)(t % SEQ), p = s & 127, g = j >> 6; const long t0 = t - p;
    const float* w = c.sgu_w + ((size_t)g * 128 + p) * 128;
    const bf16* v = c.proj + (size_t)t0 * NPROJ + OFF_C + 512 + j;
    float acc = 0.f;
    for (int q = 0; q < 128; ++q) acc += w[q] * bf2f(v[(size_t)q * NPROJ]);
    const float u = geluf_(bf2f(c.proj[(size_t)t * NPROJ + OFF_C + j]));
    c.ycat[(size_t)t * 2048 + 1024 + j] = f2bf(u * (acc + c.sgu_bias[g * 128 + p]));
}
HD void el_ret_scan(const Ctx& c, long idx) {
    const int de = (int)(idx & 4095); const long r = idx >> 12; const int dir = (int)(r & 1), h = (int)((r >> 1) & 7);
    const float cd = expf(128.f * logsigmoidf_(c.gam[dir * 8 + h]));
    float S = 0.f;
    for (int k = 0; k < NC; ++k) { const int ch = dir == 0 ? k : NC - 1 - k; const size_t o = ((size_t)r * NC + ch) * 4096 + de; c.rsp[o] = S; S = S * cd + c.rkv[o]; }
}
HD void el_rwkv_scan(const Ctx& c, long idx) {
    const int row = (int)(idx & 63); const long r = idx >> 6; const int dir = (int)(r & 1), h = (int)((r >> 1) & 7), b = (int)(r >> 4);
    const float* W = dir ? c.wb : c.wf; const bf16* KD = dir ? c.kdb : c.kdf; const bf16* AK = dir ? c.akb : c.akf; bf16* Y = dir ? c.yb : c.yf;
    float S[64];
#pragma unroll
    for (int i = 0; i < 64; ++i) S[i] = 0.f;
    for (int k = 0; k < SEQ; ++k) {
        const int s = dir ? SEQ - 1 - k : k; const size_t o = ((size_t)b * SEQ + s) * 512 + h * 64;
        float sk = 0.f;
#pragma unroll
        for (int i = 0; i < 64; ++i) sk += S[i] * bf2f(c.kk[o + i]);
        const float v = bf2f(c.vs[o + row]); float y = 0.f;
#pragma unroll
        for (int i = 0; i < 64; ++i) { S[i] = S[i] * W[o + i] - sk * bf2f(AK[o + i]) + v * bf2f(KD[o + i]); y += S[i] * bf2f(c.rs[o + i]); }
        Y[o + row] = f2bf(y);
    }
}
HD void el_ret_out(const Ctx& c, long idx) {
    const int h = (int)(idx & 7); const long t = idx >> 3; const int s = (int)(t % SEQ), n = s & 127, ch = s >> 7; const int b = (int)(t / SEQ);
    const float lgf = logsigmoidf_(c.gam[h]), lgb = logsigmoidf_(c.gam[8 + h]);
    const bf16* qp = c.proj + (size_t)t * NPROJ + OFF_A + h * 64;
    float q[64], o[64];
#pragma unroll
    for (int i = 0; i < 64; ++i) { q[i] = bf2f(qp[i]); o[i] = 0.f; }
    const bf16* kb = c.proj + (size_t)(t - n) * NPROJ + OFF_A + 512 + h * 64;
    for (int m = 0; m < 128; ++m) {
        const bf16* kp = kb + (size_t)m * NPROJ; const bf16* vp = kp + 512;
        float sc = 0.f;
#pragma unroll
        for (int i = 0; i < 64; ++i) sc += q[i] * bf2f(kp[i]);
        sc *= m <= n ? expf(lgf * (float)(n - m)) : expf(lgb * (float)(m - n));
#pragma unroll
        for (int i = 0; i < 64; ++i) o[i] += sc * bf2f(vp[i]);
    }
    const float qdf = expf(lgf * (float)(n + 1)), qdb = expf(lgb * (float)(128 - n));
    const float* Sf = c.rsp + ((size_t)((b * 8 + h) * 2 + 0) * NC + ch) * 4096; const float* Sb = c.rsp + ((size_t)((b * 8 + h) * 2 + 1) * NC + ch) * 4096;
    for (int d = 0; d < 64; ++d) { const float qd = bf2f(qp[d]); const float a = qd * qdf, bb = qd * qdb;
#pragma unroll
        for (int i = 0; i < 64; ++i) o[i] += a * Sf[d * 64 + i] + bb * Sb[d * 64 + i]; }
    float mu = 0.f;
#pragma unroll
    for (int i = 0; i < 64; ++i) mu += o[i];
    mu *= (1.f / 64.f); float var = 0.f;
#pragma unroll
    for (int i = 0; i < 64; ++i) { const float d = o[i] - mu; var += d * d; }
    const float rstd = 1.f / sqrtf(var * (1.f / 64.f) + GN_EPS);
    const bf16* gp = c.proj + (size_t)t * NPROJ + OFF_A + 1536 + h * 64; bf16* y = c.ycat + (size_t)t * 2048 + h * 64;
#pragma unroll
    for (int i = 0; i < 64; ++i) y[i] = f2bf(siluf_(bf2f(gp[i])) * ((o[i] - mu) * rstd * c.ret_g[h * 64 + i]));
}
HD void el_rwkv_fin(const Ctx& c, long idx) {
    const int h = (int)(idx & 7); const long t = idx >> 3; const size_t o = (size_t)t * 512 + h * 64;
    float y[64]; float mu = 0.f, bonus = 0.f;
#pragma unroll
    for (int i = 0; i < 64; ++i) { y[i] = bf2f(c.yf[o + i]) + bf2f(c.yb[o + i]); mu += y[i]; bonus += bf2f(c.rs[o + i]) * bf2f(c.ks[o + i]) * c.r_k[h * 64 + i]; }
    mu *= (1.f / 64.f); float var = 0.f;
#pragma unroll
    for (int i = 0; i < 64; ++i) { const float d = y[i] - mu; var += d * d; }
    const float rstd = 1.f / sqrtf(var * (1.f / 64.f) + GN_EPS);
    bf16* out = c.ycat + (size_t)t * 2048 + 512 + h * 64;
#pragma unroll
    for (int i = 0; i < 64; ++i) out[i] = f2bf(((y[i] - mu) * rstd * c.ln_g[h * 64 + i] + bonus * bf2f(c.vs[o + i])) * bf2f(c.gg[o + i]));
}
HD void route_select(const float (&lg)[4], const float (&le)[32], const float* bg, const float* be, int& e1, int& e2, float& g1, float& g2) {
    float l[4]; float mx = -1e30f; int gi = 0;
#pragma unroll
    for (int i = 0; i < 4; ++i) { l[i] = lg[i] + bg[i]; if (l[i] > mx) { mx = l[i]; gi = i; } }
    float den = 0.f;
#pragma unroll
    for (int i = 0; i < 4; ++i) den += expf(l[i] - mx);
    const float gtop = 1.f / den;
    float el[8];
#pragma unroll
    for (int i = 0; i < 8; ++i) { float v = 0.f;
#pragma unroll
        for (int g = 0; g < 4; ++g) v = (g == gi) ? le[g * 8 + i] + be[g * 8 + i] : v;
        el[i] = v; }
    float m1 = -1e30f, m2 = -1e30f; int i1 = 0, i2 = 0;
#pragma unroll
    for (int i = 0; i < 8; ++i) { if (el[i] > m1) { m2 = m1; i2 = i1; m1 = el[i]; i1 = i; } else if (el[i] > m2) { m2 = el[i]; i2 = i; } }
    const float p2 = expf(m2 - m1);
    g1 = gtop / (1.f + p2); g2 = gtop * p2 / (1.f + p2); e1 = gi * 8 + i1; e2 = gi * 8 + i2;
}

#ifndef KB_HOST_ONLY
namespace pg8 {
#define PG8_LAS __attribute__((address_space(3)))
typedef unsigned short bf16_t;
typedef short bf16x8 __attribute__((ext_vector_type(8)));
typedef float f32x4 __attribute__((ext_vector_type(4)));
typedef unsigned u32x4 __attribute__((ext_vector_type(4)));
constexpr int BM = 256, BK = 64, HALF = 128, HTB = HALF * BK * 2, STAGE_BYTES = 8 * HTB, NXCD = 8, WGM = 8;
__host__ __device__ __forceinline__ int lds_byte(int r, int c) { const int st = (r >> 4) * 2 + (c >> 5), rr = r & 15, cc = c & 31, ob = rr * 64 + cc * 2; return st * 1024 + (ob ^ (((ob >> 9) & 1) << 5)); }
__host__ __device__ __forceinline__ void stage_rc(int b, int& R, int& C) { const int st = b / 1024, sb = b % 1024, swz = sb ^ (((sb >> 9) & 1) << 5); R = (st >> 1) * 16 + swz / 64; C = (st & 1) * 32 + (swz % 64) / 2; }
__host__ __device__ __forceinline__ int perm32(int rho) { const int n = rho >> 4, i = rho & 15; return 8 * (i >> 2) + 4 * n + (i & 3); }
struct Unit { int pm, pn, pe; };
struct Gemm { const bf16_t* A; const bf16_t* Bt; int M, N, K; size_t bstride; };
template <int M, int N> struct StaticOrder {
    static constexpr int nM = M / BM, nN = N / BM, nwg = nM * nN;
    int G, c;
    __host__ __device__ void init(int G_, int c_) { G = G_; c = c_; }
    __host__ __device__ __forceinline__ bool next(int i, Unit& u) const {
        const int L = i * G + c; if (L >= nwg) return false;
        int wgid = L; { constexpr int q = nwg / NXCD, r = nwg % NXCD; const int xcd = wgid % NXCD, off = wgid / NXCD; wgid = (xcd < r ? xcd * (q + 1) : r * (q + 1) + (xcd - r) * q) + off; }
        constexpr int nig = WGM * nN; const int gid = wgid / nig, fm = gid * WGM, gsz = (nM - fm) < WGM ? (nM - fm) : WGM;
        u.pm = fm + ((wgid % nig) % gsz); u.pn = (wgid % nig) / gsz; u.pe = 0; return true;
    }
    __device__ __forceinline__ void a_ready(const Unit&) const {}
    __device__ __forceinline__ void done(const Unit&) const {}
};
template <int NN> struct MoeOrder {
    int G, c, ntiles; const PG8_LAS int* tile_exp;
    __device__ __forceinline__ bool next(int i, Unit& u) const {
        const int L = i * G + c; if (L >= ntiles * NN) return false;
        u.pm = L / NN; u.pn = L % NN; u.pe = __builtin_amdgcn_readfirstlane(tile_exp[u.pm]); return true;
    }
    __device__ __forceinline__ void a_ready(const Unit&) const {}
    __device__ __forceinline__ void done(const Unit&) const {}
};
__device__ __forceinline__ unsigned cvt_pk_bf16(float lo, float hi) { unsigned r; asm volatile("v_cvt_pk_bf16_f32 %0, %1, %2" : "=v"(r) : "v"(lo), "v"(hi)); return r; }
struct EpiBf16 {
    static constexpr bool PERM = true, AFTER_DRAIN = false;
    bf16_t* O; int ldc;
    __device__ __forceinline__ void operator()(const f32x4 (&acc)[2][2][4][2], const Unit& u, int wr, int wc, int fr, int fq) const {
        const int row0 = u.pm * BM + wr * 64 + fr, col0 = u.pn * BM + wc * 32 + 8 * fq;
#pragma unroll
        for (int ai = 0; ai < 2; ++ai)
#pragma unroll
            for (int m = 0; m < 4; ++m) { bf16_t* rowp = O + (size_t)(row0 + ai * HALF + m * 16) * ldc + col0;
#pragma unroll
                for (int bj = 0; bj < 2; ++bj) { const f32x4 v0 = acc[ai][bj][m][0], v1 = acc[ai][bj][m][1];
                    u32x4 w; w.x = cvt_pk_bf16(v0[0], v0[1]); w.y = cvt_pk_bf16(v0[2], v0[3]); w.z = cvt_pk_bf16(v1[0], v1[1]); w.w = cvt_pk_bf16(v1[2], v1[3]);
                    *(u32x4*)(rowp + bj * HALF) = w; } }
    }
};
struct EpiResF32 {
    static constexpr bool PERM = false, AFTER_DRAIN = false;
    const float* base; float* out; int ldc;
    __device__ __forceinline__ void operator()(const f32x4 (&acc)[2][2][4][2], const Unit& u, int wr, int wc, int fr, int fq) const {
        const int row0 = u.pm * BM + wr * 64 + fr, col0 = u.pn * BM + wc * 32 + 4 * fq;
#pragma unroll
        for (int ai = 0; ai < 2; ++ai)
#pragma unroll
            for (int m = 0; m < 4; ++m) { const size_t off = (size_t)(row0 + ai * HALF + m * 16) * ldc + col0;
#pragma unroll
                for (int bj = 0; bj < 2; ++bj)
#pragma unroll
                    for (int n = 0; n < 2; ++n) { const f32x4 bs = *(const f32x4*)(base + off + bj * HALF + n * 16); *(f32x4*)(out + off + bj * HALF + n * 16) = bs + acc[ai][bj][m][n]; } }
    }
};
struct EpiSwiGLU {
    static constexpr bool PERM = true, AFTER_DRAIN = false;
    bf16_t* O; int ldc;
    __device__ __forceinline__ void operator()(const f32x4 (&acc)[2][2][4][2], const Unit& u, int wr, int wc, int fr, int fq) const {
        const int row0 = u.pm * BM + wr * 64 + fr, col0 = u.pn * HALF + wc * 32 + 8 * fq;
#pragma unroll
        for (int ai = 0; ai < 2; ++ai)
#pragma unroll
            for (int m = 0; m < 4; ++m) { bf16_t* rowp = O + (size_t)(row0 + ai * HALF + m * 16) * ldc + col0;
                float h[8];
#pragma unroll
                for (int n = 0; n < 2; ++n)
#pragma unroll
                    for (int j = 0; j < 4; ++j) { const float g = acc[ai][0][m][n][j], up = acc[ai][1][m][n][j]; h[n * 4 + j] = g * __builtin_amdgcn_rcpf(1.f + __expf(-g)) * up; }
                u32x4 w; w.x = cvt_pk_bf16(h[0], h[1]); w.y = cvt_pk_bf16(h[2], h[3]); w.z = cvt_pk_bf16(h[4], h[5]); w.w = cvt_pk_bf16(h[6], h[7]);
                *(u32x4*)rowp = w; }
    }
};

template <int KK, class Epi, class Sched, bool ALIGN_EPI = false, bool SP2 = false>
__device__ __forceinline__ void gemm_phase(PG8_LAS unsigned char* lds, const Gemm g, const Sched& S, const Epi& E) {
    const int tid = threadIdx.x, wid = __builtin_amdgcn_readfirstlane(tid >> 6), lane = tid & 63, wr = wid >> 2, wc = wid & 3, fr = lane & 15, fq = lane >> 4;
    constexpr int K = KK, nt = K / BK;
    unsigned voffA[2], voffB[2];
#pragma unroll
    for (int i = 0; i < 2; ++i) { int R, C; stage_rc(tid * 16 + i * 8192, R, C); const int Rb = Epi::PERM ? ((R & ~31) + perm32(R & 31)) : R;
        voffA[i] = (unsigned)(R * K + C) * 2u; voffB[i] = (unsigned)(Rb * K + C) * 2u; }
    constexpr size_t kstep = (size_t)(BK * 2);
    constexpr size_t hstep = (size_t)HALF * K * 2;
    constexpr size_t tstep = 2 * hstep;
    const unsigned ldsw = (unsigned)wid * 1024u;
    const int aoff = lds_byte(wr * 64 + fr, fq * 8), boff = lds_byte(wc * 32 + fr, fq * 8);
#define PG8_SA(b, h) (((b) * 2 + (h)) * HTB)
#define PG8_SB(b, h) ((4 + (b) * 2 + (h)) * HTB)
#define PG8_STAGE(bufoff, gbase, voff) do { _Pragma("unroll") for (int _i = 0; _i < 2; ++_i) \
        __builtin_amdgcn_global_load_lds((const unsigned*)((const char*)(gbase) + (voff)[_i]), (PG8_LAS unsigned*)(lds + (bufoff) + ldsw + _i * 8192), 16, 0, 0); } while (0)
#define PG8_LDA(dst, b, h) do { _Pragma("unroll") for (int m = 0; m < 4; ++m) _Pragma("unroll") for (int k = 0; k < 2; ++k) dst[m][k] = *(const PG8_LAS bf16x8*)(lds + PG8_SA(b, h) + aoff + m * 2048 + k * 1024); } while (0)
#define PG8_LDB(dst, b, h) do { _Pragma("unroll") for (int n = 0; n < 2; ++n) _Pragma("unroll") for (int k = 0; k < 2; ++k) dst[n][k] = *(const PG8_LAS bf16x8*)(lds + PG8_SB(b, h) + boff + n * 2048 + k * 1024); } while (0)
#define PG8_MMA(ai, bj, At, Bt) do { __builtin_amdgcn_s_setprio(1); _Pragma("unroll") for (int m = 0; m < 4; ++m) _Pragma("unroll") for (int n = 0; n < 2; ++n) _Pragma("unroll") for (int k = 0; k < 2; ++k) \
        acc[ai][bj][m][n] = __builtin_amdgcn_mfma_f32_16x16x32_bf16(Bt[n][k], At[m][k], acc[ai][bj][m][n], 0, 0, 0); __builtin_amdgcn_s_setprio(0); } while (0)
#define PG8_WAIT_V(n) asm volatile("s_waitcnt vmcnt(" #n ")" ::: "memory")
#define PG8_WAIT_L(n) asm volatile("s_waitcnt lgkmcnt(" #n ")" ::: "memory")
#define PG8_BAR __builtin_amdgcn_s_barrier()
#define PG8_SCHED __builtin_amdgcn_sched_barrier(0)
    Unit cur, nxt; int ui = 0;
    if (!S.next(0, cur)) return;
    f32x4 acc[2][2][4][2];
#pragma unroll
    for (int a = 0; a < 2; ++a)
#pragma unroll
        for (int b = 0; b < 2; ++b)
#pragma unroll
            for (int m = 0; m < 4; ++m)
#pragma unroll
                for (int n = 0; n < 2; ++n) acc[a][b][m][n] = (f32x4){0.f, 0.f, 0.f, 0.f};
    bf16x8 At[4][2], B0[2][2], B1[2][2];
    const char* cA = (const char*)g.A + (size_t)cur.pm * tstep; const char* cB = (const char*)g.Bt + (size_t)cur.pe * g.bstride + (size_t)cur.pn * tstep;
    S.a_ready(cur);
    if constexpr (SP2) {
        PG8_STAGE(PG8_SB(0, 0), cB, voffB); PG8_STAGE(PG8_SB(0, 1), cB + hstep, voffB); PG8_STAGE(PG8_SA(0, 0), cA, voffA); PG8_STAGE(PG8_SA(0, 1), cA + hstep, voffA);
        if (wr == 1) PG8_BAR;
        PG8_WAIT_V(2); PG8_BAR;
        PG8_STAGE(PG8_SB(1, 0), cB + kstep, voffB); PG8_STAGE(PG8_SA(1, 0), cA + kstep, voffA); PG8_STAGE(PG8_SB(1, 1), cB + hstep + kstep, voffB);
        PG8_WAIT_V(6); PG8_BAR;
    } else {
        PG8_STAGE(PG8_SB(0, 0), cB, voffB); PG8_STAGE(PG8_SA(0, 0), cA, voffA); PG8_STAGE(PG8_SB(0, 1), cB + hstep, voffB); PG8_STAGE(PG8_SA(0, 1), cA + hstep, voffA);
        if (wr == 1) PG8_BAR;
        PG8_WAIT_V(4); PG8_BAR;
        PG8_STAGE(PG8_SB(1, 0), cB + kstep, voffB); PG8_STAGE(PG8_SA(1, 0), cA + kstep, voffA); PG8_STAGE(PG8_SB(1, 1), cB + hstep + kstep, voffB);
        PG8_WAIT_V(6); PG8_BAR;
    }
    for (;;) {
        const bool has_next = S.next(ui + 1, nxt);
        const char* nA = has_next ? (const char*)g.A + (size_t)nxt.pm * tstep : cA; const char* nB = has_next ? (const char*)g.Bt + (size_t)nxt.pe * g.bstride + (size_t)nxt.pn * tstep : cB;
        for (int t = 0; t < nt; t += 2) {
            const bool last = (t == nt - 2);
            const char* a1 = cA + (size_t)(t + 1) * kstep;
            const char* a2 = last ? nA : cA + (size_t)(t + 2) * kstep; const char* b2 = last ? nB : cB + (size_t)(t + 2) * kstep;
            const char* a3 = a2 + kstep; const char* b3 = b2 + kstep;
            if (last && has_next) S.a_ready(nxt);
            if constexpr (SP2) {
            PG8_LDB(B0, 0, 0); PG8_LDB(B1, 0, 1); PG8_SCHED; PG8_LDA(At, 0, 0); PG8_STAGE(PG8_SA(1, 1), a1 + hstep, voffA);
            PG8_WAIT_V(8); PG8_WAIT_L(0); PG8_BAR; PG8_MMA(0, 0, At, B0); PG8_MMA(0, 1, At, B1); PG8_BAR; PG8_SCHED;
            PG8_LDA(At, 0, 1); PG8_STAGE(PG8_SB(0, 0), b2, voffB); PG8_STAGE(PG8_SB(0, 1), b2 + hstep, voffB); PG8_STAGE(PG8_SA(0, 0), a2, voffA);
            PG8_WAIT_V(8); PG8_WAIT_L(0); PG8_BAR; PG8_MMA(1, 0, At, B0); PG8_MMA(1, 1, At, B1); PG8_BAR; PG8_SCHED;
            PG8_LDB(B0, 1, 0); PG8_LDB(B1, 1, 1); PG8_SCHED; PG8_LDA(At, 1, 0); PG8_STAGE(PG8_SA(0, 1), a2 + hstep, voffA);
            PG8_WAIT_V(8); PG8_WAIT_L(0); PG8_BAR; PG8_MMA(0, 0, At, B0); PG8_MMA(0, 1, At, B1); PG8_BAR; PG8_SCHED;
            PG8_LDA(At, 1, 1); PG8_STAGE(PG8_SB(1, 0), b3, voffB); PG8_STAGE(PG8_SB(1, 1), b3 + hstep, voffB); PG8_STAGE(PG8_SA(1, 0), a3, voffA);
            PG8_WAIT_V(8); PG8_WAIT_L(0); PG8_BAR; PG8_MMA(1, 0, At, B0); PG8_MMA(1, 1, At, B1); PG8_BAR; PG8_SCHED;
            } else {
            PG8_LDB(B0, 0, 0); PG8_SCHED; PG8_LDA(At, 0, 0); PG8_STAGE(PG8_SA(1, 1), a1 + hstep, voffA);
            PG8_WAIT_L(8); PG8_BAR; PG8_WAIT_L(0); PG8_MMA(0, 0, At, B0); PG8_BAR; PG8_SCHED;
            PG8_LDB(B1, 0, 1); PG8_STAGE(PG8_SB(0, 0), b2, voffB);
            PG8_BAR; PG8_WAIT_L(0); PG8_MMA(0, 1, At, B1); PG8_BAR;
            PG8_LDA(At, 0, 1); PG8_STAGE(PG8_SA(0, 0), a2, voffA);
            PG8_BAR; PG8_WAIT_L(0); PG8_MMA(1, 0, At, B0); PG8_BAR; PG8_SCHED;
            PG8_STAGE(PG8_SB(0, 1), b2 + hstep, voffB);
            PG8_WAIT_V(6); PG8_BAR; PG8_MMA(1, 1, At, B1); PG8_BAR;
            PG8_LDB(B0, 1, 0); PG8_SCHED; PG8_LDA(At, 1, 0); PG8_STAGE(PG8_SA(0, 1), a2 + hstep, voffA);
            PG8_WAIT_L(8); PG8_BAR; PG8_WAIT_L(0); PG8_MMA(0, 0, At, B0); PG8_BAR; PG8_SCHED;
            PG8_LDB(B1, 1, 1); PG8_STAGE(PG8_SB(1, 0), b3, voffB);
            PG8_BAR; PG8_WAIT_L(0); PG8_MMA(0, 1, At, B1); PG8_BAR;
            PG8_LDA(At, 1, 1); PG8_STAGE(PG8_SA(1, 0), a3, voffA);
            PG8_BAR; PG8_WAIT_L(0); PG8_MMA(1, 0, At, B0); PG8_BAR; PG8_SCHED;
            PG8_STAGE(PG8_SB(1, 1), b3 + hstep, voffB);
            PG8_WAIT_V(6); PG8_BAR; PG8_MMA(1, 1, At, B1); PG8_BAR;
            }
        }
        if constexpr (ALIGN_EPI) { if (wr == 0) PG8_BAR; }
        E(acc, cur, wr, wc, fr, fq); S.done(cur);
        if (!has_next) break;
#pragma unroll
        for (int a = 0; a < 2; ++a)
#pragma unroll
            for (int b = 0; b < 2; ++b)
#pragma unroll
                for (int m = 0; m < 4; ++m)
#pragma unroll
                    for (int n = 0; n < 2; ++n) acc[a][b][m][n] = (f32x4){0.f, 0.f, 0.f, 0.f};
        cur = nxt; cA = nA; cB = nB; ++ui;
        if constexpr (ALIGN_EPI) { if (wr == 1) PG8_BAR; }
    }
    PG8_WAIT_V(0);
    if constexpr (!ALIGN_EPI) { if (wr == 0) PG8_BAR; }
    PG8_BAR;
#undef PG8_SA
#undef PG8_SB
#undef PG8_STAGE
#undef PG8_LDA
#undef PG8_LDB
#undef PG8_MMA
#undef PG8_WAIT_V
#undef PG8_WAIT_L
#undef PG8_BAR
#undef PG8_SCHED
}
}

#define GAS __attribute__((address_space(1)))
#define LAS __attribute__((address_space(3)))
typedef unsigned v4u __attribute__((ext_vector_type(4)));
typedef unsigned v2u __attribute__((ext_vector_type(2)));
typedef float f32x4 __attribute__((ext_vector_type(4)));
#define LDS_WAIT() asm volatile("s_waitcnt lgkmcnt(0)" ::: "memory")
__device__ __forceinline__ unsigned pk2(float lo, float hi) { return (unsigned)f2bf(lo) | ((unsigned)f2bf(hi) << 16); }

#define XB_TMO      128
#define XB_XCNT(j)  (256  + 64 * (j))
#define XB_XSUB(j)  (1280 + 64 * (j))
#define XB_XGEN(j)  (2304 + 64 * (j))
#define XB_TOP      3328
#define XB_TOPGEN   3392
#define XCD_BAR_WORDS 3456
#define XB_SPIN_CAP (1u << 18)
__device__ __forceinline__ unsigned xb_ld(unsigned* p)              { return __hip_atomic_load(p, __ATOMIC_RELAXED, __HIP_MEMORY_SCOPE_AGENT); }
__device__ __forceinline__ unsigned xb_add(unsigned* p, unsigned v) { return __hip_atomic_fetch_add(p, v, __ATOMIC_RELAXED, __HIP_MEMORY_SCOPE_AGENT); }
__device__ __forceinline__ unsigned xb_xcc_id() { return (unsigned)__builtin_amdgcn_s_getreg((3 << 11) | 20) & 0xFu; }
#define XB_SPIN(cond, bar) do { unsigned _sp = 0; while (cond) { __builtin_amdgcn_s_sleep(1); \
    if ((++_sp & 255u) == 0u) { if (xb_ld(&(bar)[XB_TMO])) break; if (_sp > XB_SPIN_CAP) { atomicAdd(&(bar)[XB_TMO], 1u); break; } } } } while (0)
struct XcdBarrier { unsigned* bar; unsigned x; volatile LAS unsigned* st; };
__device__ __forceinline__ XcdBarrier xcd_barrier_post(unsigned* bar, volatile LAS unsigned* st) {
    XcdBarrier b; b.bar = bar; b.x = xb_xcc_id(); b.st = st;
    if (threadIdx.x == 0) (void)xb_add(&bar[XB_XCNT(b.x)], 1u);
    return b;
}
__device__ __forceinline__ void xcd_barrier_complete(unsigned* bar, unsigned x, unsigned& nloc, unsigned& nx) {
    const unsigned G = gridDim.x * gridDim.y * gridDim.z;
    unsigned sum, cnt, mine, sp = 0u;
    for (;;) {
        sum = 0u; cnt = 0u; mine = 0u;
#pragma unroll
        for (unsigned j = 0; j < 16; ++j) { const unsigned c = xb_ld(&bar[XB_XCNT(j)]); sum += c; cnt += (c > 0u) ? 1u : 0u; mine = (j == x) ? c : mine; }
        if (sum == G) break;
        __builtin_amdgcn_s_sleep(1);
        if ((++sp & 255u) == 0u) { if (xb_ld(&bar[XB_TMO])) break; if (sp > XB_SPIN_CAP) { atomicAdd(&bar[XB_TMO], 1u); break; } }
    }
    nloc = mine > 0u ? mine : 1u; nx = cnt > 0u ? cnt : 1u;
}
__device__ __forceinline__ void xcd_barrier(const XcdBarrier& b) {
    asm volatile("s_waitcnt vmcnt(0)" ::: "memory");
    __syncthreads();
    if (threadIdx.x == 0) {
        unsigned* bar = b.bar;
        __builtin_amdgcn_s_waitcnt(0);
        unsigned nloc = b.st[0], nx = b.st[1];
        if (nloc == 0u) { xcd_barrier_complete(bar, b.x, nloc, nx); b.st[0] = nloc; b.st[1] = nx; }
        const unsigned old = xb_add(&bar[XB_XSUB(b.x)], 1u);
        const unsigned gen = old / nloc;
        if (old + 1u == (gen + 1u) * nloc) {
            __builtin_amdgcn_fence(__ATOMIC_RELEASE, "agent");
            asm volatile("s_waitcnt vmcnt(0)" ::: "memory");
            const unsigned og = xb_add(&bar[XB_TOP], 1u);
            const unsigned tg = og / nx;
            if (og + 1u == (tg + 1u) * nx) xb_add(&bar[XB_TOPGEN], 1u);
            else XB_SPIN(xb_ld(&bar[XB_TOPGEN]) == tg, bar);
            __builtin_amdgcn_fence(__ATOMIC_ACQUIRE, "agent");
            xb_add(&bar[XB_XGEN(b.x)], 1u);
            asm volatile("s_waitcnt vmcnt(0)" ::: "memory");
        } else {
            XB_SPIN(xb_ld(&bar[XB_XGEN(b.x)]) == gen, bar);
            __builtin_amdgcn_fence(__ATOMIC_ACQUIRE, "agent");
            asm volatile("s_waitcnt vmcnt(0)" ::: "memory");
        }
    }
    __syncthreads();
}

constexpr int RING_BYTES = 131072;
constexpr int TAB_OFF = RING_BYTES;
constexpr int TAB_CNT = TAB_OFF, TAB_ROWBASE = TAB_OFF + 128, TAB_NT = TAB_OFF + 256, TAB_TEXP = TAB_OFF + 272;
constexpr int MISC_OFF = TAB_OFF + 4096;
constexpr int PTAB_OFF = MISC_OFF + 16;
constexpr int LDS_BYTES = 147456;
static_assert(TAB_TEXP + MOE_MAXTILES * 4 <= MISC_OFF && PTAB_OFF + 32 * 8 <= LDS_BYTES, "LDS map");

__device__ __forceinline__ float wave_sum(float v) {
#pragma unroll
    for (int o = 1; o < 64; o <<= 1) v += __shfl_xor(v, o);
    return v;
}
__device__ __forceinline__ void transpose_item(const float* W, int K, int N, bf16* WT, int k0, int n0, int drow0, LAS float* scr, int lane) {
#pragma unroll 8
    for (int i = 0; i < 32; ++i) { const int kk = 2 * i + (lane >> 5); scr[kk * 33 + (lane & 31)] = W[(size_t)(k0 + kk) * N + n0 + (lane & 31)]; }
    LDS_WAIT(); asm volatile("" ::: "memory");
    const int c = lane & 7;
#pragma unroll
    for (int j = 0; j < 4; ++j) { const int n = (lane >> 3) + 8 * j; const LAS float* s = scr + (8 * c) * 33 + n;
        v4u o; o.x = pk2(s[0 * 33], s[1 * 33]); o.y = pk2(s[2 * 33], s[3 * 33]); o.z = pk2(s[4 * 33], s[5 * 33]); o.w = pk2(s[6 * 33], s[7 * 33]);
        *(GAS v4u*)(WT + (size_t)(drow0 + n) * K + k0 + 8 * c) = o; }
    LDS_WAIT(); asm volatile("" ::: "memory");
}


__device__ __forceinline__ void build_moe_tables(LAS unsigned char* lds, const unsigned* cnt_words) {
    LAS int* tcnt = (LAS int*)(lds + TAB_CNT); LAS int* trb = (LAS int*)(lds + TAB_ROWBASE); LAS int* tnt = (LAS int*)(lds + TAB_NT); LAS int* texp = (LAS int*)(lds + TAB_TEXP);
    __syncthreads();
    if (threadIdx.x < NEXP) tcnt[threadIdx.x] = (int)__hip_atomic_load(cnt_words + 64 * threadIdx.x, __ATOMIC_RELAXED, __HIP_MEMORY_SCOPE_AGENT);
    __syncthreads();
    if (threadIdx.x == 0) { int tile = 0;
#pragma unroll 1
        for (int e = 0; e < NEXP; ++e) { int c = tcnt[e]; if (c > 2 * T) c = 2 * T; int nt = (c + 255) >> 8; if (tile + nt > MOE_MAXTILES) nt = MOE_MAXTILES - tile; trb[e] = tile * 256;
#pragma unroll 1
            for (int i = 0; i < nt; ++i) texp[tile + i] = e;
            tile += nt; }
        tnt[0] = tile; }
    __syncthreads();
}

struct Args { const void* in[30]; float* out; unsigned char* ws; int layer, pad; };
__device__ __forceinline__ Ctx make_ctx(const Args& args, unsigned char* ws, int l) {
    Ctx c;
    c.pos = (const int*)args.in[1];
    c.gam = (const float*)args.in[5] + l * 16; c.ret_g = (const float*)args.in[6] + l * 512; c.mu = (const float*)args.in[7] + l * 2 * B_COLS;
    c.w0 = (const float*)args.in[8] + l * 1024; c.w2 = (const float*)args.in[9] + l * 96 * 512; c.a0 = (const float*)args.in[10] + l * 1024; c.a2 = (const float*)args.in[11] + l * 96 * 512;
    c.g2 = (const float*)args.in[12] + l * 256 * 512; c.k_k = (const float*)args.in[13] + l * 512; c.k_a = (const float*)args.in[14] + l * 512; c.r_k = (const float*)args.in[15] + l * 512;
    c.ln_g = (const float*)args.in[16] + l * 512; c.sgu_g = (const float*)args.in[17] + l * 512; c.sgu_b = (const float*)args.in[18] + l * 512;
    c.sgu_w = (const float*)args.in[19] + (size_t)l * 8 * 128 * 128; c.sgu_bias = (const float*)args.in[20] + l * 1024;
    c.proj = (bf16*)(ws + WS_PROJ); c.ycat = (bf16*)(ws + WS_ACT);
    c.rs = (bf16*)(ws + WS_RS); c.ks = (bf16*)(ws + WS_KS); c.vs = (bf16*)(ws + WS_VS); c.kk = (bf16*)(ws + WS_KK); c.gg = (bf16*)(ws + WS_GG);
    c.kdf = (bf16*)(ws + WS_KDF); c.kdb = (bf16*)(ws + WS_KDB); c.akf = (bf16*)(ws + WS_AKF); c.akb = (bf16*)(ws + WS_AKB); c.yf = (bf16*)(ws + WS_YF); c.yb = (bf16*)(ws + WS_YB);
    c.lin = (bf16*)(ws + WS_LIN); c.wf = (float*)(ws + WS_WF); c.wb = (float*)(ws + WS_WB); c.rkv = (float*)(ws + WS_RKV); c.rsp = (float*)(ws + WS_RSP);
    return c;
}


#define ROW_LOAD(v, ptr) _Pragma("unroll") for (int j = 0; j < 8; ++j) v[j] = ((const GAS f32x4*)(ptr))[lane + 64 * j]
__device__ __forceinline__ void row_add_moe(f32x4 (&v)[8], const bf16* yp, size_t R1, size_t R2, float g1, float g2, int lane) {
#pragma unroll
    for (int j = 0; j < 8; ++j) { const v2u a = ((const GAS v2u*)(yp + R1 * DM))[lane + 64 * j], b = ((const GAS v2u*)(yp + R2 * DM))[lane + 64 * j];
        v[j].x += g1 * bf2f((bf16)(a.x & 0xffff)) + g2 * bf2f((bf16)(b.x & 0xffff)); v[j].y += g1 * bf2f((bf16)(a.x >> 16)) + g2 * bf2f((bf16)(b.x >> 16));
        v[j].z += g1 * bf2f((bf16)(a.y & 0xffff)) + g2 * bf2f((bf16)(b.y & 0xffff)); v[j].w += g1 * bf2f((bf16)(a.y >> 16)) + g2 * bf2f((bf16)(b.y >> 16)); }
}
__device__ __forceinline__ float row_rstd(const f32x4 (&v)[8]) {
    float ss = 0.f;
#pragma unroll
    for (int j = 0; j < 8; ++j) ss += (v[j].x * v[j].x + v[j].y * v[j].y) + (v[j].z * v[j].z + v[j].w * v[j].w);
    return 1.f / sqrtf(wave_sum(ss) * (1.f / DM) + NORM_EPS);
}
template <int KSEL>
__global__ void __launch_bounds__(512, 2) fwd_kernel(Args args) {
    extern __shared__ __attribute__((aligned(16))) unsigned char lds_raw[];
    LAS unsigned char* lds = (LAS unsigned char*)lds_raw;
    const int tid = threadIdx.x, lane = tid & 63, wave = __builtin_amdgcn_readfirstlane(tid >> 6);
    if (tid < 4) ((LAS unsigned*)(lds + MISC_OFF))[tid] = 0u;
    __syncthreads();
    XcdBarrier bar; bar.bar = (unsigned*)(args.ws + WS_CTL) + CW_BAR; bar.x = 0; bar.st = nullptr;
    if constexpr (KSEL < 0) bar = xcd_barrier_post((unsigned*)(args.ws + WS_CTL) + CW_BAR, (volatile LAS unsigned*)(lds + MISC_OFF));
#define SEAM(k) do { if constexpr (KSEL < 0) xcd_barrier(bar); } while (0)
#define PH_ON(k) if constexpr ((KSEL < 0 && KB_EN(k)) || KSEL == (k))
#define PHASE_LOCALS() unsigned ws_lo_ = __builtin_amdgcn_readfirstlane((unsigned)(unsigned long long)args.ws), ws_hi_ = __builtin_amdgcn_readfirstlane((unsigned)((unsigned long long)args.ws >> 32)); \
    int ll = __builtin_amdgcn_readfirstlane(l); asm volatile("" : "+s"(ws_lo_), "+s"(ws_hi_), "+s"(ll)); unsigned char* ws = (unsigned char*)(((unsigned long long)ws_hi_ << 32) | ws_lo_); \
    const int G = gridDim.x, bid = blockIdx.x; const long gtid = (long)bid * 512 + tid, gstride = (long)G * 512; const int gw = bid * 8 + wave, NGW = G * 8; \
    (void)gtid; (void)gstride; (void)gw; (void)NGW; (void)ll

    for (int l = (KSEL < 0 ? 0 : args.layer); l < (KSEL < 0 ? DEPTH : (KSEL == 12 ? 0 : args.layer + 1)); ++l) {
        PH_ON(0) {
            PHASE_LOCALS();
            bf16* WinT = (bf16*)(ws + WS_WIN); bf16* WoutT = (bf16*)(ws + WS_WOUT); bf16* Wgu = (bf16*)(ws + WS_WGU); bf16* WdT = (bf16*)(ws + WS_WD);
            LAS float* scr = (LAS float*)(lds + wave * 16384);
            const float* w_in = (const float*)args.in[3] + (size_t)ll * DM * D_IN; const float* w_out = (const float*)args.in[4] + (size_t)ll * DM * DM;
            const float* wg_ = (const float*)args.in[26] + (size_t)ll * NEXP * DM * DE; const float* wu_ = (const float*)args.in[27] + (size_t)ll * NEXP * DM * DE; const float* wd_ = (const float*)args.in[28] + (size_t)ll * NEXP * DE * DM;
            constexpr int I_IN = (DM / 64) * (D_IN / 32), I_OUT = (DM / 64) * (DM / 32), I_GU = (DM / 64) * (DE / 32), I_D = (DE / 64) * (DM / 32);
            constexpr int NITEMS = I_IN + I_OUT + NEXP * (2 * I_GU + I_D);
            for (int it = gw; it < NITEMS; it += NGW) {
                int r = it;
                if (r < I_IN) { const int nblk = D_IN / 32, kb = r / nblk, nb = r % nblk; transpose_item(w_in, DM, D_IN, WinT, 64 * kb, 32 * nb, 32 * nb, scr, lane); continue; } r -= I_IN;
                if (r < I_OUT) { const int nblk = DM / 32, kb = r / nblk, nb = r % nblk; transpose_item(w_out, DM, DM, WoutT, 64 * kb, 32 * nb, 32 * nb, scr, lane); continue; } r -= I_OUT;
                const int e = r / (2 * I_GU + I_D); r -= e * (2 * I_GU + I_D);
                if (r < 2 * I_GU) { const int up = r >= I_GU ? 1 : 0; r -= up * I_GU; const int nblk = DE / 32, kb = r / nblk, nb = r % nblk, n0 = 32 * nb;
                    transpose_item((up ? wu_ : wg_) + (size_t)e * DM * DE, DM, DE, Wgu + (size_t)e * 1024 * DM, 64 * kb, n0, (n0 >> 7) * 256 + (n0 & 127) + up * 128, scr, lane); continue; }
                r -= 2 * I_GU;
                { const int nblk = DM / 32, kb = r / nblk, nb = r % nblk; transpose_item(wd_ + (size_t)e * DE * DM, DE, DM, WdT + (size_t)e * DM * DE, 64 * kb, 32 * nb, 32 * nb, scr, lane); }
            }
            for (long i = gtid; i < (long)(NPROJ - D_IN) * DM / 8; i += gstride) ((GAS v4u*)(WinT + (size_t)D_IN * DM))[i] = (v4u){0u, 0u, 0u, 0u};
            if (ll > 0) build_moe_tables(lds, (const unsigned*)(ws + WS_CTL) + CW_CNT + (ll - 1) * 2048);
            const LAS int* trb = (const LAS int*)(lds + TAB_ROWBASE);
            const float* x_in = (const float*)args.in[0]; float* xbuf = (float*)(ws + WS_X); bf16* act = (bf16*)(ws + WS_ACT); const bf16* yp = (const bf16*)(ws + WS_YP);
            const unsigned* slot_tok = (const unsigned*)(ws + WS_SLOT); const float* gate_tok = (const float*)(ws + WS_GATE);
            const float* norm1_g = (const float*)args.in[2] + ll * DM;
            for (int m = gw; m < T; m += NGW) {
                f32x4 v[8];
                ROW_LOAD(v, (ll == 0 ? x_in : xbuf) + (size_t)m * DM);
                if (ll > 0) {
                    const unsigned s1 = slot_tok[2 * m], s2 = slot_tok[2 * m + 1]; const float g1 = gate_tok[2 * m], g2 = gate_tok[2 * m + 1];
                    row_add_moe(v, yp, (size_t)(trb[s1 >> 20] + (int)(s1 & 0xfffffu)), (size_t)(trb[s2 >> 20] + (int)(s2 & 0xfffffu)), g1, g2, lane);
#pragma unroll
                    for (int j = 0; j < 8; ++j) ((GAS f32x4*)(xbuf + (size_t)m * DM))[lane + 64 * j] = v[j];
                }
                const float rstd = row_rstd(v);
#pragma unroll
                for (int j = 0; j < 8; ++j) { const f32x4 g = ((const GAS f32x4*)norm1_g)[lane + 64 * j];
                    v2u o; o.x = pk2(v[j].x * rstd * g.x, v[j].y * rstd * g.y); o.y = pk2(v[j].z * rstd * g.z, v[j].w * rstd * g.w);
                    ((GAS v2u*)(act + (size_t)m * DM))[lane + 64 * j] = o; }
            }
        }
        SEAM(0);
        PH_ON(1) {
            PHASE_LOCALS();
            pg8::Gemm g{(const bf16*)(ws + WS_ACT), (const bf16*)(ws + WS_WIN), T, NPROJ, DM, 0}; pg8::StaticOrder<T, NPROJ> S; S.init(G, bid);
            pg8::EpiBf16 E{(bf16*)(ws + WS_PROJ), NPROJ};
            pg8::gemm_phase<DM, pg8::EpiBf16, pg8::StaticOrder<T, NPROJ>, true, true>(lds, g, S, E);
        }
        SEAM(1);
        PH_ON(2) { PHASE_LOCALS(); const Ctx c = make_ctx(args, ws, ll);
            for (long i = gtid; i < (long)T * 256; i += gstride) el_rot_ret(c, i);
            for (long i = gtid; i < (long)T * 256; i += gstride) el_rot_dil(c, i);
            for (long i = gtid; i < (long)T * B_COLS; i += gstride) el_rwkv_shift(c, i);
            for (long i = gtid; i < (long)T; i += gstride) el_sgu_prep(c, i); }
        SEAM(2);
        PH_ON(3) { PHASE_LOCALS(); const Ctx c = make_ctx(args, ws, ll);
            for (long i = gtid; i < (long)T * 512; i += gstride) el_rwkv_lora(c, i);
            for (long i = gtid; i < (long)BATCH * 8 * 2 * NC * 4096; i += gstride) el_ret_kv(c, i);
            for (long i = gtid; i < (long)T * 512; i += gstride) el_sgu_main(c, i);
            for (long i = gtid; i < (long)T * 8; i += gstride) el_dil_attn(c, i); }
        SEAM(3);
        PH_ON(4) { PHASE_LOCALS(); const Ctx c = make_ctx(args, ws, ll);
            for (long i = gtid; i < (long)T * 8; i += gstride) el_rwkv_kk(c, i);
            for (long i = gtid; i < (long)BATCH * 8 * 2 * 4096; i += gstride) el_ret_scan(c, i); }
        SEAM(4);
        PH_ON(5) { PHASE_LOCALS(); const Ctx c = make_ctx(args, ws, ll);
            for (int u = bid + G * wave; u < BATCH * 16; u += G * 8) el_rwkv_scan(c, (long)u * 64 + lane); }
        SEAM(5);
        PH_ON(6) { PHASE_LOCALS(); const Ctx c = make_ctx(args, ws, ll);
            for (long i = gtid; i < (long)T * 8; i += gstride) el_ret_out(c, i);
            for (long i = gtid; i < (long)T * 8; i += gstride) el_rwkv_fin(c, i); }
        SEAM(6);
        PH_ON(7) {
            PHASE_LOCALS();
            pg8::Gemm g{(const bf16*)(ws + WS_ACT), (const bf16*)(ws + WS_WOUT), T, DM, DM, 0}; pg8::StaticOrder<T, DM> S; S.init(G, bid);
            pg8::EpiResF32 E{ll == 0 ? (const float*)args.in[0] : (const float*)(ws + WS_X), (float*)(ws + WS_X), DM};
            pg8::gemm_phase<DM, pg8::EpiResF32, pg8::StaticOrder<T, DM>, true, true>(lds, g, S, E);
        }
        SEAM(7);
        PH_ON(8) {
            PHASE_LOCALS();
            const float* wg = (const float*)args.in[22] + (size_t)ll * DM * 4; const float* bg = (const float*)args.in[23] + ll * 4;
            const float* we = (const float*)args.in[24] + (size_t)ll * DM * 32; const float* be = (const float*)args.in[25] + ll * 32;
            const float* norm2_g = (const float*)args.in[21] + ll * DM;
            const float* xbuf = (const float*)(ws + WS_X); bf16* act = (bf16*)(ws + WS_ACT);
            unsigned* cnt_cur = (unsigned*)(ws + WS_CTL) + CW_CNT + ll * 2048;
            int* tok_of = (int*)(ws + WS_TOK); unsigned* slot_tok = (unsigned*)(ws + WS_SLOT); float* gate_tok = (float*)(ws + WS_GATE);
            for (int m = gw; m < T; m += NGW) {
                f32x4 v[8];
                ROW_LOAD(v, xbuf + (size_t)m * DM);
                const float rstd = row_rstd(v);
#pragma unroll
                for (int j = 0; j < 8; ++j) { const f32x4 g = ((const GAS f32x4*)norm2_g)[lane + 64 * j];
                    v[j] = (f32x4){v[j].x * rstd * g.x, v[j].y * rstd * g.y, v[j].z * rstd * g.z, v[j].w * rstd * g.w};
                    v2u o; o.x = pk2(v[j].x, v[j].y); o.y = pk2(v[j].z, v[j].w);
                    ((GAS v2u*)(act + (size_t)m * DM))[lane + 64 * j] = o; }
                LAS f32x4* hrow = (LAS f32x4*)(lds + wave * 16384);
#pragma unroll
                for (int j = 0; j < 8; ++j) hrow[lane + 64 * j] = v[j];
                LDS_WAIT(); asm volatile("" ::: "memory");
                float lg[4], le[32];
#pragma unroll
                for (int i = 0; i < 4; ++i) lg[i] = 0.f;
#pragma unroll
                for (int i = 0; i < 32; ++i) le[i] = 0.f;
#pragma unroll 1
                for (int kk = 0; kk < 32; ++kk) { const int k = kk * 64 + lane; const float hv = ((const LAS float*)hrow)[k];
                    const f32x4 wgr = *(const GAS f32x4*)(wg + (size_t)k * 4);
                    lg[0] += hv * wgr.x; lg[1] += hv * wgr.y; lg[2] += hv * wgr.z; lg[3] += hv * wgr.w;
#pragma unroll
                    for (int q = 0; q < 8; ++q) { const f32x4 wr = *(const GAS f32x4*)(we + (size_t)k * 32 + 4 * q);
                        le[4 * q] += hv * wr.x; le[4 * q + 1] += hv * wr.y; le[4 * q + 2] += hv * wr.z; le[4 * q + 3] += hv * wr.w; } }
#pragma unroll
                for (int i = 0; i < 4; ++i) lg[i] = wave_sum(lg[i]);
#pragma unroll
                for (int i = 0; i < 32; ++i) le[i] = wave_sum(le[i]);
                LDS_WAIT(); asm volatile("" ::: "memory");
                int e1, e2; float g1, g2; route_select(lg, le, bg, be, e1, e2, g1, g2);
                if (lane == 0) {
                    const unsigned r1 = __hip_atomic_fetch_add(cnt_cur + 64 * e1, 1u, __ATOMIC_RELAXED, __HIP_MEMORY_SCOPE_AGENT);
                    const unsigned r2 = __hip_atomic_fetch_add(cnt_cur + 64 * e2, 1u, __ATOMIC_RELAXED, __HIP_MEMORY_SCOPE_AGENT);
                    tok_of[(size_t)e1 * T + r1] = m; tok_of[(size_t)e2 * T + r2] = m;
                    slot_tok[2 * m] = ((unsigned)e1 << 20) | r1; slot_tok[2 * m + 1] = ((unsigned)e2 << 20) | r2; gate_tok[2 * m] = g1; gate_tok[2 * m + 1] = g2;
                }
            }
        }
        SEAM(8);
        PH_ON(9) {
            PHASE_LOCALS();
            build_moe_tables(lds, (const unsigned*)(ws + WS_CTL) + CW_CNT + ll * 2048);
            const LAS int* tcnt = (const LAS int*)(lds + TAB_CNT); const LAS int* trb = (const LAS int*)(lds + TAB_ROWBASE); const LAS int* texp = (const LAS int*)(lds + TAB_TEXP);
            const int nrows = ((const LAS int*)(lds + TAB_NT))[0] * 256;
            const int* tok_of = (const int*)(ws + WS_TOK); const bf16* act = (const bf16*)(ws + WS_ACT); bf16* aperm = (bf16*)(ws + WS_APERM);
            for (int R = gw; R < nrows; R += NGW) {
                const int e = texp[R >> 8], r = R - trb[e];
                GAS v4u* dst = (GAS v4u*)(aperm + (size_t)R * DM);
                if (r < tcnt[e]) { const int tok = tok_of[(size_t)e * T + r]; const GAS v4u* src = (const GAS v4u*)(act + (size_t)tok * DM);
#pragma unroll
                    for (int j = 0; j < 4; ++j) dst[lane + 64 * j] = src[lane + 64 * j]; }
                else {
#pragma unroll
                    for (int j = 0; j < 4; ++j) dst[lane + 64 * j] = (v4u){0u, 0u, 0u, 0u}; }
            }
        }
        SEAM(9);
        PH_ON(10) {
            PHASE_LOCALS();
            build_moe_tables(lds, (const unsigned*)(ws + WS_CTL) + CW_CNT + ll * 2048);
            const int ntiles = __builtin_amdgcn_readfirstlane(((const LAS int*)(lds + TAB_NT))[0]);
            pg8::Gemm g{(const bf16*)(ws + WS_APERM), (const bf16*)(ws + WS_WGU), MOE_MAXTILES * 256, 1024, DM, (size_t)1024 * DM * 2};
            pg8::MoeOrder<4> S{G, bid, ntiles, (const LAS int*)(lds + TAB_TEXP)};
            pg8::EpiSwiGLU E{(bf16*)(ws + WS_HID), DE};
            pg8::gemm_phase<DM, pg8::EpiSwiGLU, pg8::MoeOrder<4>, true, true>(lds, g, S, E);
        }
        SEAM(10);
        PH_ON(11) {
            PHASE_LOCALS();
            build_moe_tables(lds, (const unsigned*)(ws + WS_CTL) + CW_CNT + ll * 2048);
            const int ntiles = __builtin_amdgcn_readfirstlane(((const LAS int*)(lds + TAB_NT))[0]);
            pg8::Gemm g{(const bf16*)(ws + WS_HID), (const bf16*)(ws + WS_WD), MOE_MAXTILES * 256, DM, DE, (size_t)DM * DE * 2};
            pg8::MoeOrder<8> S{G, bid, ntiles, (const LAS int*)(lds + TAB_TEXP)};
            pg8::EpiBf16 E{(bf16*)(ws + WS_YP), DM};
            pg8::gemm_phase<DE, pg8::EpiBf16, pg8::MoeOrder<8>, true, true>(lds, g, S, E);
        }
        SEAM(11);
    }
    PH_ON(12) {
        const int l = DEPTH - 1;
        PHASE_LOCALS();
        build_moe_tables(lds, (const unsigned*)(ws + WS_CTL) + CW_CNT + ll * 2048);
        const LAS int* trb = (const LAS int*)(lds + TAB_ROWBASE);
        const float* gfin = (const float*)args.in[29]; const float* xbuf = (const float*)(ws + WS_X); const bf16* yp = (const bf16*)(ws + WS_YP);
        const unsigned* slot_tok = (const unsigned*)(ws + WS_SLOT); const float* gate_tok = (const float*)(ws + WS_GATE);
        for (int m = gw; m < T; m += NGW) {
            f32x4 v[8];
            ROW_LOAD(v, xbuf + (size_t)m * DM);
            const unsigned s1 = slot_tok[2 * m], s2 = slot_tok[2 * m + 1]; const float g1 = gate_tok[2 * m], g2 = gate_tok[2 * m + 1];
            row_add_moe(v, yp, (size_t)(trb[s1 >> 20] + (int)(s1 & 0xfffffu)), (size_t)(trb[s2 >> 20] + (int)(s2 & 0xfffffu)), g1, g2, lane);
            const float rstd = row_rstd(v);
#pragma unroll
            for (int j = 0; j < 8; ++j) { const f32x4 g = ((const GAS f32x4*)gfin)[lane + 64 * j];
                ((GAS f32x4*)(args.out + (size_t)m * DM))[lane + 64 * j] = (f32x4){v[j].x * rstd * g.x, v[j].y * rstd * g.y, v[j].z * rstd * g.z, v[j].w * rstd * g.w}; }
        }
    }
#undef SEAM
#undef PH_ON
}

extern "C" void kernel_launch(void* const* d_in, const int* in_sizes, int n_in, void* d_out, int out_size, void* d_ws, size_t ws_size, hipStream_t stream) {
    static int grid = 0;
    if (grid == 0) {
        if (n_in != 30 || in_sizes[0] != T * DM || out_size != T * DM || ws_size < WS_END) { fprintf(stderr, "kernel_launch: unexpected shapes (n_in %d, in0 %d, out %d, ws %zu < %zu)\n", n_in, n_in > 0 ? in_sizes[0] : -1, out_size, ws_size, (size_t)WS_END); grid = -1; return; }
        int dev = 0, cus = 0, per_cu = 0; (void)per_cu;
        if (hipGetDevice(&dev) != hipSuccess || hipDeviceGetAttribute(&cus, hipDeviceAttributeMultiprocessorCount, dev) != hipSuccess) { grid = -1; return; }
#if KB_SPLIT
#define SET_ATTR(k) if (hipFuncSetAttribute((const void*)fwd_kernel<k>, hipFuncAttributeMaxDynamicSharedMemorySize, LDS_BYTES) != hipSuccess) { fprintf(stderr, "kernel_launch: hipFuncSetAttribute failed (%d)\n", k); grid = -1; return; }
        SET_ATTR(0) SET_ATTR(1) SET_ATTR(2) SET_ATTR(3) SET_ATTR(4) SET_ATTR(5) SET_ATTR(6) SET_ATTR(7) SET_ATTR(8) SET_ATTR(9) SET_ATTR(10) SET_ATTR(11) SET_ATTR(12)
#else
        if (hipFuncSetAttribute((const void*)fwd_kernel<-1>, hipFuncAttributeMaxDynamicSharedMemorySize, LDS_BYTES) != hipSuccess) { fprintf(stderr, "kernel_launch: hipFuncSetAttribute failed\n"); grid = -1; return; }
        if (hipOccupancyMaxActiveBlocksPerMultiprocessor(&per_cu, (const void*)fwd_kernel<-1>, 512, LDS_BYTES) != hipSuccess || per_cu < 1) fprintf(stderr, "kernel_launch: occupancy query says %d\n", per_cu);
#endif
        (void)hipGetLastError();
        grid = cus;
    }
    if (grid < 0) return;
    if (hipMemsetAsync((char*)d_ws + WS_CTL, 0, CTL_ZERO_BYTES, stream) != hipSuccess) return;
    Args a{};
    for (int i = 0; i < 30; ++i) a.in[i] = d_in[i];
    a.out = (float*)d_out; a.ws = (unsigned char*)d_ws; a.layer = 0; a.pad = 0;
#if KB_SPLIT
#define LAUNCH_PH(k) hipLaunchKernelGGL(fwd_kernel<k>, dim3(grid), dim3(512), LDS_BYTES, stream, a)
    for (int l = 0; l < DEPTH; ++l) { a.layer = l;
        LAUNCH_PH(0); LAUNCH_PH(1); LAUNCH_PH(2); LAUNCH_PH(3); LAUNCH_PH(4); LAUNCH_PH(5); LAUNCH_PH(6); LAUNCH_PH(7); LAUNCH_PH(8); LAUNCH_PH(9); LAUNCH_PH(10); LAUNCH_PH(11); }
    a.layer = DEPTH - 1; LAUNCH_PH(12);
#else
    hipLaunchKernelGGL(fwd_kernel<-1>, dim3(grid), dim3(512), LDS_BYTES, stream, a);
#endif
}
#endif
```

```cpp
#include <hip/hip_runtime.h>
#include <cstdio>
#include <cstdint>
#include <cmath>

#ifndef KB_BATCH
#define KB_BATCH 4
#define KB_SEQ 4096
#endif
#ifndef KB_SPLIT
#define KB_SPLIT 0
#endif

#ifndef KB_PHMASK
#define KB_PHMASK 0xffff
#endif
#define KB_EN(k) (((KB_PHMASK) >> (k)) & 1)
#define HD __host__ __device__ __forceinline__
typedef unsigned short bf16;

constexpr int BATCH = KB_BATCH, SEQ = KB_SEQ, T = BATCH * SEQ;
constexpr int DM = 2048, DG = 512, NH = 8, HDIM = 64;
constexpr int A_COLS = 2048, B_COLS = 1984, C_COLS = 1024, D_COLS = 1536, D_IN = 6592, NPROJ = 6656;
constexpr int OFF_A = 0, OFF_B = 2048, OFF_C = 4032, OFF_D = 5056;
constexpr int NC = SEQ / 128;
constexpr int NEXP = 32, DE = 512;
constexpr int NLORA = 448;
constexpr float NORM_EPS = 1e-6f, GN_EPS = 64e-5f;
constexpr int MOE_MAXTILES = (2 * T + NEXP * 255 + 255) / 256;
constexpr int DEPTH = 2;

constexpr size_t MiB = 1u << 20;
constexpr size_t WS_CTL = 0, CTL_ZERO_BYTES = 1 * MiB;
constexpr size_t WS_WIN = 2 * MiB, WS_WOUT = 28 * MiB, WS_WGU = 36 * MiB, WS_WD = 164 * MiB;
constexpr size_t WS_X = 228 * MiB;
constexpr size_t WS_ACT = 356 * MiB;
constexpr size_t WS_PROJ = 420 * MiB;
constexpr size_t WS_RKV = 628 * MiB, WS_RSP = 660 * MiB;
constexpr size_t WS_RS = 692 * MiB, WS_KS = 708 * MiB, WS_VS = 724 * MiB, WS_KK = 740 * MiB, WS_GG = 756 * MiB, WS_KDF = 772 * MiB, WS_KDB = 788 * MiB,
                 WS_AKF = 804 * MiB, WS_AKB = 820 * MiB, WS_YF = 836 * MiB, WS_YB = 852 * MiB, WS_LIN = 868 * MiB  , WS_WF = 882 * MiB, WS_WB = 914 * MiB;
constexpr size_t WS_TOK = 946 * MiB  , WS_SLOT = 948 * MiB, WS_GATE = 949 * MiB, WS_END = 950 * MiB;
constexpr size_t WS_APERM = 420 * MiB, WS_HID = 580 * MiB, WS_YP = 620 * MiB;
static_assert((size_t)MOE_MAXTILES * 256 * 2048 * 2 <= 160 * MiB && (size_t)T * NPROJ * 2 <= 208 * MiB, "ws map");
constexpr int CW_BAR = 4096;
constexpr int CW_CNT = 16384;

HD float bf2f(bf16 v) { return __builtin_bit_cast(float, (unsigned)v << 16); }
HD bf16 f2bf(float f) { unsigned u = __builtin_bit_cast(unsigned, f); return (bf16)((u + 0x7fffu + ((u >> 16) & 1u)) >> 16); }
HD float sigmoidf_(float x) { return 1.f / (1.f + expf(-x)); }
HD float siluf_(float x) { return x / (1.f + expf(-x)); }
HD float geluf_(float x) { return 0.5f * x * (1.f + tanhf(0.7978845608028654f * (x + 0.044715f * x * x * x))); }
HD float logsigmoidf_(float x) { return x < 0.f ? x - log1pf(expf(x)) : -log1pf(expf(-x)); }

struct Ctx {
    const int* pos;
    const float *gam, *ret_g, *mu, *w0, *w2, *a0, *a2, *g2, *k_k, *k_a, *r_k, *ln_g, *sgu_g, *sgu_b, *sgu_w, *sgu_bias;
    bf16 *proj, *ycat, *rs, *ks, *vs, *kk, *gg, *kdf, *kdb, *akf, *akb, *yf, *yb, *lin;
    float *wf, *wb, *rkv, *rsp;
};

HD void el_rot_ret(const Ctx& c, long idx) {
    const int i = (int)(idx & 31), h = (int)((idx >> 5) & 7); const long t = idx >> 8;
    const float inv = expf(-(float)i * (1.f / 32.f) * 9.210340371976184f);
    const float ang = (float)c.pos[t] * inv; float sn, cs; sincosf(ang, &sn, &cs);
    bf16* q = c.proj + (size_t)t * NPROJ + OFF_A + h * 64; bf16* k = q + 512;
    const float q1 = bf2f(q[i]), q2 = bf2f(q[i + 32]), k1 = bf2f(k[i]), k2 = bf2f(k[i + 32]);
    q[i] = f2bf(q1 * cs - q2 * sn); q[i + 32] = f2bf(q2 * cs + q1 * sn);
    k[i] = f2bf((k1 * cs - k2 * sn) * 0.125f); k[i + 32] = f2bf((k2 * cs + k1 * sn) * 0.125f);
}
HD void el_rot_dil(const Ctx& c, long idx) {
    const int j = (int)(idx & 31), h = (int)((idx >> 5) & 7); const long t = idx >> 8;
    bf16* q = c.proj + (size_t)t * NPROJ + OFF_D + h * 64; bf16* k = q + 512;
    if (j < 8) {
        const float inv = expf(-(float)j * (1.f / 8.f) * 13.122363377404328f);
        const float ang = (float)c.pos[t] * inv; float sn, cs; sincosf(ang, &sn, &cs);
        const float q1 = bf2f(q[j]), q2 = bf2f(q[j + 8]), k1 = bf2f(k[j]), k2 = bf2f(k[j + 8]);
        q[j] = f2bf((q1 * cs - q2 * sn) * 0.125f); q[j + 8] = f2bf((q2 * cs + q1 * sn) * 0.125f);
        k[j] = f2bf(k1 * cs - k2 * sn); k[j + 8] = f2bf(k2 * cs + k1 * sn);
    } else {
        const int d = 16 + 2 * (j - 8);
        q[d] = f2bf(bf2f(q[d]) * 0.125f); q[d + 1] = f2bf(bf2f(q[d + 1]) * 0.125f);
    }
}
HD void el_rwkv_shift(const Ctx& c, long idx) {
    const int j = (int)(idx % B_COLS); const long t = idx / B_COLS; const int s = (int)(t % SEQ);
    const bf16* p = c.proj + (size_t)t * NPROJ + OFF_B + j;
    const float x = bf2f(p[0]), xp = s > 0 ? bf2f(p[-(long)NPROJ]) : 0.f, xn = s < SEQ - 1 ? bf2f(p[NPROJ]) : 0.f;
    const float xs = x + c.mu[j] * (xp - x) + c.mu[B_COLS + j] * (xn - x);
    if (j < 512) c.rs[t * 512 + j] = f2bf(xs);
    else if (j < 1024) c.ks[t * 512 + j - 512] = f2bf(xs);
    else if (j < 1536) c.vs[t * 512 + j - 1024] = f2bf(xs);
    else if (j < 1632) c.lin[t * NLORA + (j - 1536)] = f2bf(tanhf(xs));
    else if (j < 1728) c.lin[t * NLORA + (j - 1536)] = f2bf(xs);
    else c.lin[t * NLORA + (j - 1536)] = f2bf(sigmoidf_(xs));
}
HD void el_rwkv_lora(const Ctx& c, long idx) {
    const int ch = (int)(idx & 511); const long t = idx >> 9;
    const bf16* li = c.lin + t * NLORA;
    float wl = 0.f, al = 0.f, g = 0.f;
    for (int i = 0; i < 96; ++i) { wl += bf2f(li[i]) * c.w2[i * 512 + ch]; al += bf2f(li[96 + i]) * c.a2[i * 512 + ch]; }
    for (int i = 0; i < 256; ++i) g += bf2f(li[192 + i]) * c.g2[i * 512 + ch];
    c.gg[t * 512 + ch] = f2bf(g);
    const float k = bf2f(c.ks[t * 512 + ch]), ka = c.k_a[ch];
    c.kk[t * 512 + ch] = f2bf(k * c.k_k[ch]);
    {   const float dec = expf(-0.6065306597126334f * sigmoidf_(c.w0[ch] + wl)); const float a = sigmoidf_(c.a0[ch] + al);
        c.wf[t * 512 + ch] = dec; c.kdf[t * 512 + ch] = f2bf(k * (1.f + (a - 1.f) * ka)); c.akf[t * 512 + ch] = f2bf(a); }
    {   const float dec = expf(-0.6065306597126334f * sigmoidf_(c.w0[512 + ch] + wl)); const float a = sigmoidf_(c.a0[512 + ch] + al);
        c.wb[t * 512 + ch] = dec; c.kdb[t * 512 + ch] = f2bf(k * (1.f + (a - 1.f) * ka)); c.akb[t * 512 + ch] = f2bf(a); }
}
HD void el_rwkv_kk(const Ctx& c, long idx) {
    const int h = (int)(idx & 7); const long t = idx >> 3; const size_t o = (size_t)t * 512 + h * 64;
    float ss = 0.f;
    for (int d = 0; d < 64; ++d) { const float v = bf2f(c.kk[o + d]); ss += v * v; }
    const float n = 1.f / sqrtf(ss + 1e-12f);
    for (int d = 0; d < 64; ++d) { const float v = bf2f(c.kk[o + d]) * n; c.kk[o + d] = f2bf(v);
        c.akf[o + d] = f2bf(bf2f(c.akf[o + d]) * v); c.akb[o + d] = f2bf(bf2f(c.akb[o + d]) * v); }
}
HD void el_sgu_prep(const Ctx& c, long t) {
    bf16* v = c.proj + (size_t)t * NPROJ + OFF_C + 512;
    float s = 0.f;
    for (int j = 0; j < 512; ++j) s += geluf_(bf2f(v[j]));
    const float mean = s * (1.f / 512.f); float q = 0.f;
    for (int j = 0; j < 512; ++j) { const float d = geluf_(bf2f(v[j])) - mean; q += d * d; }
    const float rstd = 1.f / sqrtf(q * (1.f / 512.f) + NORM_EPS);
    for (int j = 0; j < 512; ++j) v[j] = f2bf((geluf_(bf2f(v[j])) - mean) * rstd * c.sgu_g[j] + c.sgu_b[j]);
}

HD void el_ret_kv(const Ctx& c, long idx) {
    const int e = (int)(idx & 63), d = (int)((idx >> 6) & 63); long r = idx >> 12;
    const int ch = (int)(r % NC); r /= NC; const int dir = (int)(r & 1); r >>= 1; const int h = (int)(r & 7); const int b = (int)(r >> 3);
    const float lg = logsigmoidf_(c.gam[dir * 8 + h]);
    const bf16* base = c.proj + ((size_t)b * SEQ + (size_t)ch * 128) * NPROJ + OFF_A + h * 64;
    float kv = 0.f;
    for (int m = 0; m < 128; ++m) { const float dec = expf(lg * (float)(dir == 0 ? 127 - m : m));
        kv += dec * bf2f(base[(size_t)m * NPROJ + 512 + d]) * bf2f(base[(size_t)m * NPROJ + 1024 + e]); }
    c.rkv[idx] = kv;
}
HD void el_dil_attn(const Ctx& c, long idx) {
    const int h = (int)(idx & 7); const long t = idx >> 3; const int s = (int)(t % SEQ); const long tb = t - s;
    const bf16* qp = c.proj + (size_t)t * NPROJ + OFF_D + h * 64;
    float o[64];
#pragma unroll
    for (int i = 0; i < 64; ++i) o[i] = 0.f;
    float m = -1e30f, l = 0.f;
    for (int br = 0; br < 3; ++br) {
        const int dil = br == 0 ? 1 : (br == 1 ? 4 : 16);
        for (int j = -64; j <= 64; ++j) {
            const int sp = s + dil * j; if (sp < 0 || sp >= SEQ) continue;
            asm volatile("" ::: "memory");
            const bf16* kp = c.proj + (size_t)(tb + sp) * NPROJ + OFF_D + 512 + h * 64; const bf16* vp = kp + 512;
            float sc = 0.f;
#pragma unroll
            for (int i = 0; i < 64; ++i) sc += bf2f(qp[i]) * bf2f(kp[i]);
            const float mn = sc > m ? sc : m, scale = expf(m - mn), p = expf(sc - mn);
            l = l * scale + p; m = mn;
#pragma unroll
            for (int i = 0; i < 64; ++i) o[i] = o[i] * scale + p * bf2f(vp[i]);
        }
    }
    const float il = 1.f / l; bf16* y = c.ycat + (size_t)t * 2048 + 1536 + h * 64;
#pragma unroll
    for (int i = 0; i < 64; ++i) y[i] = f2bf(o[i] * il);
}
HD void el_sgu_main(const Ctx& c, long idx) {
    const int j = (int)(idx & 511); const long t = idx >> 9; const int s = (int)(t % SEQ), p = s & 127, g = j >> 6; const long t0 = t - p;
    const float* w = c.sgu_w + ((size_t)g * 128 + p) * 128;
    const bf16* v = c.proj + (size_t)t0 * NPROJ + OFF_C + 512 + j;
    float acc = 0.f;
    for (int q = 0; q < 128; ++q) acc += w[q] * bf2f(v[(size_t)q * NPROJ]);
    const float u = geluf_(bf2f(c.proj[(size_t)t * NPROJ + OFF_C + j]));
    c.ycat[(size_t)t * 2048 + 1024 + j] = f2bf(u * (acc + c.sgu_bias[g * 128 + p]));
}
HD void el_ret_scan(const Ctx& c, long idx) {
    const int de = (int)(idx & 4095); const long r = idx >> 12; const int dir = (int)(r & 1), h = (int)((r >> 1) & 7);
    const float cd = expf(128.f * logsigmoidf_(c.gam[dir * 8 + h]));
    float S = 0.f;
    for (int k = 0; k < NC; ++k) { const int ch = dir == 0 ? k : NC - 1 - k; const size_t o = ((size_t)r * NC + ch) * 4096 + de; c.rsp[o] = S; S = S * cd + c.rkv[o]; }
}
HD void el_rwkv_scan(const Ctx& c, long idx) {
    const int row = (int)(idx & 63); const long r = idx >> 6; const int dir = (int)(r & 1), h = (int)((r >> 1) & 7), b = (int)(r >> 4);
    const float* W = dir ? c.wb : c.wf; const bf16* KD = dir ? c.kdb : c.kdf; const bf16* AK = dir ? c.akb : c.akf; bf16* Y = dir ? c.yb : c.yf;
    float S[64];
#pragma unroll
    for (int i = 0; i < 64; ++i) S[i] = 0.f;
    for (int k = 0; k < SEQ; ++k) {
        asm volatile("" ::: "memory");
        const int s = dir ? SEQ - 1 - k : k; const size_t o = ((size_t)b * SEQ + s) * 512 + h * 64;
        float sk = 0.f;
#pragma unroll
        for (int q = 0; q < 4; ++q) { asm volatile("" ::: "memory");
#pragma unroll
            for (int i = 16 * q; i < 16 * q + 16; ++i) sk += S[i] * bf2f(c.kk[o + i]); }
        const float v = bf2f(c.vs[o + row]); float y = 0.f;
#pragma unroll
        for (int q = 0; q < 4; ++q) { asm volatile("" ::: "memory");
#pragma unroll
            for (int i = 16 * q; i < 16 * q + 16; ++i) { S[i] = S[i] * W[o + i] - sk * bf2f(AK[o + i]) + v * bf2f(KD[o + i]); y += S[i] * bf2f(c.rs[o + i]); } }
        Y[o + row] = f2bf(y);
    }
}
HD void el_ret_out(const Ctx& c, long idx) {
    const int h = (int)(idx & 7); const long t = idx >> 3; const int s = (int)(t % SEQ), n = s & 127, ch = s >> 7; const int b = (int)(t / SEQ);
    const float lgf = logsigmoidf_(c.gam[h]), lgb = logsigmoidf_(c.gam[8 + h]);
    const bf16* qp = c.proj + (size_t)t * NPROJ + OFF_A + h * 64;
    float o[64];
#pragma unroll
    for (int i = 0; i < 64; ++i) o[i] = 0.f;
    const bf16* kb = c.proj + (size_t)(t - n) * NPROJ + OFF_A + 512 + h * 64;
    for (int m = 0; m < 128; ++m) {
        asm volatile("" ::: "memory");
        const bf16* kp = kb + (size_t)m * NPROJ; const bf16* vp = kp + 512;
        float sc = 0.f;
#pragma unroll
        for (int i = 0; i < 64; ++i) sc += bf2f(qp[i]) * bf2f(kp[i]);
        sc *= m <= n ? expf(lgf * (float)(n - m)) : expf(lgb * (float)(m - n));
#pragma unroll
        for (int i = 0; i < 64; ++i) o[i] += sc * bf2f(vp[i]);
    }
    const float qdf = expf(lgf * (float)(n + 1)), qdb = expf(lgb * (float)(128 - n));
    const float* Sf = c.rsp + ((size_t)((b * 8 + h) * 2 + 0) * NC + ch) * 4096; const float* Sb = c.rsp + ((size_t)((b * 8 + h) * 2 + 1) * NC + ch) * 4096;
    for (int d = 0; d < 64; ++d) { asm volatile("" ::: "memory"); const float qd = bf2f(qp[d]); const float a = qd * qdf, bb = qd * qdb;
#pragma unroll
        for (int i = 0; i < 64; ++i) o[i] += a * Sf[d * 64 + i] + bb * Sb[d * 64 + i]; }
    float mu = 0.f;
#pragma unroll
    for (int i = 0; i < 64; ++i) mu += o[i];
    mu *= (1.f / 64.f); float var = 0.f;
#pragma unroll
    for (int i = 0; i < 64; ++i) { const float d = o[i] - mu; var += d * d; }
    const float rstd = 1.f / sqrtf(var * (1.f / 64.f) + GN_EPS);
    const bf16* gp = c.proj + (size_t)t * NPROJ + OFF_A + 1536 + h * 64; bf16* y = c.ycat + (size_t)t * 2048 + h * 64;
    for (int i = 0; i < 64; i += 8) { asm volatile("" ::: "memory");
#pragma unroll
        for (int j = 0; j < 8; ++j) y[i + j] = f2bf(siluf_(bf2f(gp[i + j])) * ((o[i + j] - mu) * rstd * c.ret_g[h * 64 + i + j])); }
}
HD void el_rwkv_fin(const Ctx& c, long idx) {
    const int h = (int)(idx & 7); const long t = idx >> 3; const size_t o = (size_t)t * 512 + h * 64;
    float mu = 0.f, bonus = 0.f;
    for (int i = 0; i < 64; ++i) { mu += bf2f(c.yf[o + i]) + bf2f(c.yb[o + i]); bonus += bf2f(c.rs[o + i]) * bf2f(c.ks[o + i]) * c.r_k[h * 64 + i]; }
    mu *= (1.f / 64.f); float var = 0.f;
    for (int i = 0; i < 64; ++i) { const float d = bf2f(c.yf[o + i]) + bf2f(c.yb[o + i]) - mu; var += d * d; }
    const float rstd = 1.f / sqrtf(var * (1.f / 64.f) + GN_EPS);
    bf16* out = c.ycat + (size_t)t * 2048 + 512 + h * 64;
    for (int i = 0; i < 64; ++i) { const float y = bf2f(c.yf[o + i]) + bf2f(c.yb[o + i]);
        out[i] = f2bf(((y - mu) * rstd * c.ln_g[h * 64 + i] + bonus * bf2f(c.vs[o + i])) * bf2f(c.gg[o + i])); }
}
HD void route_select(const float (&lg)[4], const float (&le)[32], const float* bg, const float* be, int& e1, int& e2, float& g1, float& g2) {
    float l[4]; float mx = -1e30f; int gi = 0;
#pragma unroll
    for (int i = 0; i < 4; ++i) { l[i] = lg[i] + bg[i]; if (l[i] > mx) { mx = l[i]; gi = i; } }
    float den = 0.f;
#pragma unroll
    for (int i = 0; i < 4; ++i) den += expf(l[i] - mx);
    const float gtop = 1.f / den;
    float el[8];
#pragma unroll
    for (int i = 0; i < 8; ++i) { float v = 0.f;
#pragma unroll
        for (int g = 0; g < 4; ++g) v = (g == gi) ? le[g * 8 + i] + be[g * 8 + i] : v;
        el[i] = v; }
    float m1 = -1e30f, m2 = -1e30f; int i1 = 0, i2 = 0;
#pragma unroll
    for (int i = 0; i < 8; ++i) { if (el[i] > m1) { m2 = m1; i2 = i1; m1 = el[i]; i1 = i; } else if (el[i] > m2) { m2 = el[i]; i2 = i; } }
    const float p2 = expf(m2 - m1);
    g1 = gtop / (1.f + p2); g2 = gtop * p2 / (1.f + p2); e1 = gi * 8 + i1; e2 = gi * 8 + i2;
}

#ifndef KB_HOST_ONLY
namespace pg8 {
#define PG8_LAS __attribute__((address_space(3)))
typedef unsigned short bf16_t;
typedef short bf16x8 __attribute__((ext_vector_type(8)));
typedef float f32x4 __attribute__((ext_vector_type(4)));
typedef unsigned u32x4 __attribute__((ext_vector_type(4)));
constexpr int BM = 256, BK = 64, HALF = 128, HTB = HALF * BK * 2, STAGE_BYTES = 8 * HTB, NXCD = 8, WGM = 8;
__host__ __device__ __forceinline__ int lds_byte(int r, int c) { const int st = (r >> 4) * 2 + (c >> 5), rr = r & 15, cc = c & 31, ob = rr * 64 + cc * 2; return st * 1024 + (ob ^ (((ob >> 9) & 1) << 5)); }
__host__ __device__ __forceinline__ void stage_rc(int b, int& R, int& C) { const int st = b / 1024, sb = b % 1024, swz = sb ^ (((sb >> 9) & 1) << 5); R = (st >> 1) * 16 + swz / 64; C = (st & 1) * 32 + (swz % 64) / 2; }
__host__ __device__ __forceinline__ int perm32(int rho) { const int n = rho >> 4, i = rho & 15; return 8 * (i >> 2) + 4 * n + (i & 3); }
struct Unit { int pm, pn, pe; };
struct Gemm { const bf16_t* A; const bf16_t* Bt; int M, N, K; size_t bstride; };
template <int M, int N> struct StaticOrder {
    static constexpr int nM = M / BM, nN = N / BM, nwg = nM * nN;
    int G, c;
    __host__ __device__ void init(int G_, int c_) { G = G_; c = c_; }
    __host__ __device__ __forceinline__ bool next(int i, Unit& u) const {
        const int L = i * G + c; if (L >= nwg) return false;
        int wgid = L; { constexpr int q = nwg / NXCD, r = nwg % NXCD; const int xcd = wgid % NXCD, off = wgid / NXCD; wgid = (xcd < r ? xcd * (q + 1) : r * (q + 1) + (xcd - r) * q) + off; }
        constexpr int nig = WGM * nN; const int gid = wgid / nig, fm = gid * WGM, gsz = (nM - fm) < WGM ? (nM - fm) : WGM;
        u.pm = fm + ((wgid % nig) % gsz); u.pn = (wgid % nig) / gsz; u.pe = 0; return true;
    }
    __device__ __forceinline__ void a_ready(const Unit&) const {}
    __device__ __forceinline__ void done(const Unit&) const {}
};
template <int NN> struct MoeOrder {
    int G, c, ntiles; const PG8_LAS int* tile_exp;
    __device__ __forceinline__ bool next(int i, Unit& u) const {
        const int L = i * G + c; if (L >= ntiles * NN) return false;
        u.pm = L / NN; u.pn = L % NN; u.pe = __builtin_amdgcn_readfirstlane(tile_exp[u.pm]); return true;
    }
    __device__ __forceinline__ void a_ready(const Unit&) const {}
    __device__ __forceinline__ void done(const Unit&) const {}
};
__device__ __forceinline__ unsigned cvt_pk_bf16(float lo, float hi) { unsigned r; asm volatile("v_cvt_pk_bf16_f32 %0, %1, %2" : "=v"(r) : "v"(lo), "v"(hi)); return r; }
struct EpiBf16 {
    static constexpr bool PERM = true, AFTER_DRAIN = false;
    bf16_t* O; int ldc;
    __device__ __forceinline__ void operator()(const f32x4 (&acc)[2][2][4][2], const Unit& u, int wr, int wc, int fr, int fq) const {
        const int row0 = u.pm * BM + wr * 64 + fr, col0 = u.pn * BM + wc * 32 + 8 * fq;
#pragma unroll
        for (int ai = 0; ai < 2; ++ai)
#pragma unroll
            for (int m = 0; m < 4; ++m) { bf16_t* rowp = O + (size_t)(row0 + ai * HALF + m * 16) * ldc + col0;
#pragma unroll
                for (int bj = 0; bj < 2; ++bj) { const f32x4 v0 = acc[ai][bj][m][0], v1 = acc[ai][bj][m][1];
                    u32x4 w; w.x = cvt_pk_bf16(v0[0], v0[1]); w.y = cvt_pk_bf16(v0[2], v0[3]); w.z = cvt_pk_bf16(v1[0], v1[1]); w.w = cvt_pk_bf16(v1[2], v1[3]);
                    *(u32x4*)(rowp + bj * HALF) = w; } }
    }
};
struct EpiResF32 {
    static constexpr bool PERM = false, AFTER_DRAIN = false;
    const float* base; float* out; int ldc;
    __device__ __forceinline__ void operator()(const f32x4 (&acc)[2][2][4][2], const Unit& u, int wr, int wc, int fr, int fq) const {
        const int row0 = u.pm * BM + wr * 64 + fr, col0 = u.pn * BM + wc * 32 + 4 * fq;
#pragma unroll
        for (int ai = 0; ai < 2; ++ai)
#pragma unroll
            for (int m = 0; m < 4; ++m) { const size_t off = (size_t)(row0 + ai * HALF + m * 16) * ldc + col0;
#pragma unroll
                for (int bj = 0; bj < 2; ++bj)
#pragma unroll
                    for (int n = 0; n < 2; ++n) { const f32x4 bs = *(const f32x4*)(base + off + bj * HALF + n * 16); *(f32x4*)(out + off + bj * HALF + n * 16) = bs + acc[ai][bj][m][n]; } }
    }
};
struct EpiSwiGLU {
    static constexpr bool PERM = true, AFTER_DRAIN = false;
    bf16_t* O; int ldc;
    __device__ __forceinline__ void operator()(const f32x4 (&acc)[2][2][4][2], const Unit& u, int wr, int wc, int fr, int fq) const {
        const int row0 = u.pm * BM + wr * 64 + fr, col0 = u.pn * HALF + wc * 32 + 8 * fq;
#pragma unroll
        for (int ai = 0; ai < 2; ++ai)
#pragma unroll
            for (int m = 0; m < 4; ++m) { bf16_t* rowp = O + (size_t)(row0 + ai * HALF + m * 16) * ldc + col0;
                float h[8];
#pragma unroll
                for (int n = 0; n < 2; ++n)
#pragma unroll
                    for (int j = 0; j < 4; ++j) { const float g = acc[ai][0][m][n][j], up = acc[ai][1][m][n][j]; h[n * 4 + j] = g * __builtin_amdgcn_rcpf(1.f + __expf(-g)) * up; }
                u32x4 w; w.x = cvt_pk_bf16(h[0], h[1]); w.y = cvt_pk_bf16(h[2], h[3]); w.z = cvt_pk_bf16(h[4], h[5]); w.w = cvt_pk_bf16(h[6], h[7]);
                *(u32x4*)rowp = w; }
    }
};

template <int KK, class Epi, class Sched, bool ALIGN_EPI = false, bool SP2 = false>
__device__ __forceinline__ void gemm_phase(PG8_LAS unsigned char* lds, const Gemm g, const Sched& S, const Epi& E, const int tid) {
    const int wid = __builtin_amdgcn_readfirstlane(tid >> 6), lane = tid & 63, wr = wid >> 2, wc = wid & 3, fr = lane & 15, fq = lane >> 4;
    constexpr int K = KK, nt = K / BK;
    unsigned voffA[2], voffB[2];
#pragma unroll
    for (int i = 0; i < 2; ++i) { int R, C; stage_rc(tid * 16 + i * 8192, R, C); const int Rb = Epi::PERM ? ((R & ~31) + perm32(R & 31)) : R;
        voffA[i] = (unsigned)(R * K + C) * 2u; voffB[i] = (unsigned)(Rb * K + C) * 2u; }
    constexpr size_t kstep = (size_t)(BK * 2);
    constexpr size_t hstep = (size_t)HALF * K * 2;
    constexpr size_t tstep = 2 * hstep;
    const unsigned ldsw = (unsigned)wid * 1024u;
    const int aoff = lds_byte(wr * 64 + fr, fq * 8), boff = lds_byte(wc * 32 + fr, fq * 8);
#define PG8_SA(b, h) (((b) * 2 + (h)) * HTB)
#define PG8_SB(b, h) ((4 + (b) * 2 + (h)) * HTB)
#define PG8_STAGE(bufoff, gbase, voff) do { _Pragma("unroll") for (int _i = 0; _i < 2; ++_i) \
        __builtin_amdgcn_global_load_lds((const unsigned*)((const char*)(gbase) + (voff)[_i]), (PG8_LAS unsigned*)(lds + (bufoff) + ldsw + _i * 8192), 16, 0, 0); } while (0)
#define PG8_LDA(dst, b, h) do { _Pragma("unroll") for (int m = 0; m < 4; ++m) _Pragma("unroll") for (int k = 0; k < 2; ++k) dst[m][k] = *(const PG8_LAS bf16x8*)(lds + PG8_SA(b, h) + aoff + m * 2048 + k * 1024); } while (0)
#define PG8_LDB(dst, b, h) do { _Pragma("unroll") for (int n = 0; n < 2; ++n) _Pragma("unroll") for (int k = 0; k < 2; ++k) dst[n][k] = *(const PG8_LAS bf16x8*)(lds + PG8_SB(b, h) + boff + n * 2048 + k * 1024); } while (0)
#define PG8_MMA(ai, bj, At, Bt) do { __builtin_amdgcn_s_setprio(1); _Pragma("unroll") for (int m = 0; m < 4; ++m) _Pragma("unroll") for (int n = 0; n < 2; ++n) _Pragma("unroll") for (int k = 0; k < 2; ++k) \
        acc[ai][bj][m][n] = __builtin_amdgcn_mfma_f32_16x16x32_bf16(Bt[n][k], At[m][k], acc[ai][bj][m][n], 0, 0, 0); __builtin_amdgcn_s_setprio(0); } while (0)
#define PG8_WAIT_V(n) asm volatile("s_waitcnt vmcnt(" #n ")" ::: "memory")
#define PG8_WAIT_L(n) asm volatile("s_waitcnt lgkmcnt(" #n ")" ::: "memory")
#define PG8_BAR __builtin_amdgcn_s_barrier()
#define PG8_SCHED __builtin_amdgcn_sched_barrier(0)
    Unit cur, nxt; int ui = 0;
    if (!S.next(0, cur)) return;
    f32x4 acc[2][2][4][2];
#pragma unroll
    for (int a = 0; a < 2; ++a)
#pragma unroll
        for (int b = 0; b < 2; ++b)
#pragma unroll
            for (int m = 0; m < 4; ++m)
#pragma unroll
                for (int n = 0; n < 2; ++n) acc[a][b][m][n] = (f32x4){0.f, 0.f, 0.f, 0.f};
    bf16x8 At[4][2], B0[2][2], B1[2][2];
    const char* cA = (const char*)g.A + (size_t)cur.pm * tstep; const char* cB = (const char*)g.Bt + (size_t)cur.pe * g.bstride + (size_t)cur.pn * tstep;
    S.a_ready(cur);
    if constexpr (SP2) {
        PG8_STAGE(PG8_SB(0, 0), cB, voffB); PG8_STAGE(PG8_SB(0, 1), cB + hstep, voffB); PG8_STAGE(PG8_SA(0, 0), cA, voffA); PG8_STAGE(PG8_SA(0, 1), cA + hstep, voffA);
        if (wr == 1) PG8_BAR;
        PG8_WAIT_V(2); PG8_BAR;
        PG8_STAGE(PG8_SB(1, 0), cB + kstep, voffB); PG8_STAGE(PG8_SA(1, 0), cA + kstep, voffA); PG8_STAGE(PG8_SB(1, 1), cB + hstep + kstep, voffB);
        PG8_WAIT_V(6); PG8_BAR;
    } else {
        PG8_STAGE(PG8_SB(0, 0), cB, voffB); PG8_STAGE(PG8_SA(0, 0), cA, voffA); PG8_STAGE(PG8_SB(0, 1), cB + hstep, voffB); PG8_STAGE(PG8_SA(0, 1), cA + hstep, voffA);
        if (wr == 1) PG8_BAR;
        PG8_WAIT_V(4); PG8_BAR;
        PG8_STAGE(PG8_SB(1, 0), cB + kstep, voffB); PG8_STAGE(PG8_SA(1, 0), cA + kstep, voffA); PG8_STAGE(PG8_SB(1, 1), cB + hstep + kstep, voffB);
        PG8_WAIT_V(6); PG8_BAR;
    }
    for (;;) {
        const bool has_next = S.next(ui + 1, nxt);
        const char* nA = has_next ? (const char*)g.A + (size_t)nxt.pm * tstep : cA; const char* nB = has_next ? (const char*)g.Bt + (size_t)nxt.pe * g.bstride + (size_t)nxt.pn * tstep : cB;
        for (int t = 0; t < nt; t += 2) {
            const bool last = (t == nt - 2);
            const char* a1 = cA + (size_t)(t + 1) * kstep;
            const char* a2 = last ? nA : cA + (size_t)(t + 2) * kstep; const char* b2 = last ? nB : cB + (size_t)(t + 2) * kstep;
            const char* a3 = a2 + kstep; const char* b3 = b2 + kstep;
            if (last && has_next) S.a_ready(nxt);
            if constexpr (SP2) {
            PG8_LDB(B0, 0, 0); PG8_LDB(B1, 0, 1); PG8_SCHED; PG8_LDA(At, 0, 0); PG8_STAGE(PG8_SA(1, 1), a1 + hstep, voffA);
            PG8_WAIT_V(8); PG8_WAIT_L(0); PG8_BAR; PG8_MMA(0, 0, At, B0); PG8_MMA(0, 1, At, B1); PG8_BAR; PG8_SCHED;
            PG8_LDA(At, 0, 1); PG8_STAGE(PG8_SB(0, 0), b2, voffB); PG8_STAGE(PG8_SB(0, 1), b2 + hstep, voffB); PG8_STAGE(PG8_SA(0, 0), a2, voffA);
            PG8_WAIT_V(8); PG8_WAIT_L(0); PG8_BAR; PG8_MMA(1, 0, At, B0); PG8_MMA(1, 1, At, B1); PG8_BAR; PG8_SCHED;
            PG8_LDB(B0, 1, 0); PG8_LDB(B1, 1, 1); PG8_SCHED; PG8_LDA(At, 1, 0); PG8_STAGE(PG8_SA(0, 1), a2 + hstep, voffA);
            PG8_WAIT_V(8); PG8_WAIT_L(0); PG8_BAR; PG8_MMA(0, 0, At, B0); PG8_MMA(0, 1, At, B1); PG8_BAR; PG8_SCHED;
            PG8_LDA(At, 1, 1); PG8_STAGE(PG8_SB(1, 0), b3, voffB); PG8_STAGE(PG8_SB(1, 1), b3 + hstep, voffB); PG8_STAGE(PG8_SA(1, 0), a3, voffA);
            PG8_WAIT_V(8); PG8_WAIT_L(0); PG8_BAR; PG8_MMA(1, 0, At, B0); PG8_MMA(1, 1, At, B1); PG8_BAR; PG8_SCHED;
            } else {
            PG8_LDB(B0, 0, 0); PG8_SCHED; PG8_LDA(At, 0, 0); PG8_STAGE(PG8_SA(1, 1), a1 + hstep, voffA);
            PG8_WAIT_L(8); PG8_BAR; PG8_WAIT_L(0); PG8_MMA(0, 0, At, B0); PG8_BAR; PG8_SCHED;
            PG8_LDB(B1, 0, 1); PG8_STAGE(PG8_SB(0, 0), b2, voffB);
            PG8_BAR; PG8_WAIT_L(0); PG8_MMA(0, 1, At, B1); PG8_BAR;
            PG8_LDA(At, 0, 1); PG8_STAGE(PG8_SA(0, 0), a2, voffA);
            PG8_BAR; PG8_WAIT_L(0); PG8_MMA(1, 0, At, B0); PG8_BAR; PG8_SCHED;
            PG8_STAGE(PG8_SB(0, 1), b2 + hstep, voffB);
            PG8_WAIT_V(6); PG8_BAR; PG8_MMA(1, 1, At, B1); PG8_BAR;
            PG8_LDB(B0, 1, 0); PG8_SCHED; PG8_LDA(At, 1, 0); PG8_STAGE(PG8_SA(0, 1), a2 + hstep, voffA);
            PG8_WAIT_L(8); PG8_BAR; PG8_WAIT_L(0); PG8_MMA(0, 0, At, B0); PG8_BAR; PG8_SCHED;
            PG8_LDB(B1, 1, 1); PG8_STAGE(PG8_SB(1, 0), b3, voffB);
            PG8_BAR; PG8_WAIT_L(0); PG8_MMA(0, 1, At, B1); PG8_BAR;
            PG8_LDA(At, 1, 1); PG8_STAGE(PG8_SA(1, 0), a3, voffA);
            PG8_BAR; PG8_WAIT_L(0); PG8_MMA(1, 0, At, B0); PG8_BAR; PG8_SCHED;
            PG8_STAGE(PG8_SB(1, 1), b3 + hstep, voffB);
            PG8_WAIT_V(6); PG8_BAR; PG8_MMA(1, 1, At, B1); PG8_BAR;
            }
        }
        if constexpr (ALIGN_EPI) { if (wr == 0) PG8_BAR; }
        E(acc, cur, wr, wc, fr, fq); S.done(cur);
        if (!has_next) break;
#pragma unroll
        for (int a = 0; a < 2; ++a)
#pragma unroll
            for (int b = 0; b < 2; ++b)
#pragma unroll
                for (int m = 0; m < 4; ++m)
#pragma unroll
                    for (int n = 0; n < 2; ++n) acc[a][b][m][n] = (f32x4){0.f, 0.f, 0.f, 0.f};
        cur = nxt; cA = nA; cB = nB; ++ui;
        if constexpr (ALIGN_EPI) { if (wr == 1) PG8_BAR; }
    }
    PG8_WAIT_V(0);
    if constexpr (!ALIGN_EPI) { if (wr == 0) PG8_BAR; }
    PG8_BAR;
#undef PG8_SA
#undef PG8_SB
#undef PG8_STAGE
#undef PG8_LDA
#undef PG8_LDB
#undef PG8_MMA
#undef PG8_WAIT_V
#undef PG8_WAIT_L
#undef PG8_BAR
#undef PG8_SCHED
}
}

#define GAS __attribute__((address_space(1)))
#define LAS __attribute__((address_space(3)))
typedef unsigned v4u __attribute__((ext_vector_type(4)));
typedef unsigned v2u __attribute__((ext_vector_type(2)));
typedef float f32x4 __attribute__((ext_vector_type(4)));
#define LDS_WAIT() asm volatile("s_waitcnt lgkmcnt(0)" ::: "memory")
__device__ __forceinline__ unsigned pk2(float lo, float hi) { return (unsigned)f2bf(lo) | ((unsigned)f2bf(hi) << 16); }

#define XB_TMO      128
#define XB_XCNT(j)  (256  + 64 * (j))
#define XB_XSUB(j)  (1280 + 64 * (j))
#define XB_XGEN(j)  (2304 + 64 * (j))
#define XB_TOP      3328
#define XB_TOPGEN   3392
#define XCD_BAR_WORDS 3456
#define XB_SPIN_CAP (1u << 18)
__device__ __forceinline__ unsigned xb_ld(unsigned* p)              { return __hip_atomic_load(p, __ATOMIC_RELAXED, __HIP_MEMORY_SCOPE_AGENT); }
__device__ __forceinline__ unsigned xb_add(unsigned* p, unsigned v) { return __hip_atomic_fetch_add(p, v, __ATOMIC_RELAXED, __HIP_MEMORY_SCOPE_AGENT); }
__device__ __forceinline__ unsigned xb_xcc_id() { return (unsigned)__builtin_amdgcn_s_getreg((3 << 11) | 20) & 0xFu; }
#define XB_SPIN(cond, bar) do { unsigned _sp = 0; while (cond) { __builtin_amdgcn_s_sleep(1); \
    if ((++_sp & 255u) == 0u) { if (xb_ld(&(bar)[XB_TMO])) break; if (_sp > XB_SPIN_CAP) { atomicAdd(&(bar)[XB_TMO], 1u); break; } } } } while (0)
struct XcdBarrier { unsigned* bar; unsigned x; volatile LAS unsigned* st; };
__device__ __forceinline__ XcdBarrier xcd_barrier_post(unsigned* bar, volatile LAS unsigned* st) {
    XcdBarrier b; b.bar = bar; b.x = xb_xcc_id(); b.st = st;
    if (threadIdx.x == 0) (void)xb_add(&bar[XB_XCNT(b.x)], 1u);
    return b;
}
__device__ __forceinline__ void xcd_barrier_complete(unsigned* bar, unsigned x, unsigned& nloc, unsigned& nx) {
    const unsigned G = gridDim.x * gridDim.y * gridDim.z;
    unsigned sum, cnt, mine, sp = 0u;
    for (;;) {
        sum = 0u; cnt = 0u; mine = 0u;
#pragma unroll
        for (unsigned j = 0; j < 16; ++j) { const unsigned c = xb_ld(&bar[XB_XCNT(j)]); sum += c; cnt += (c > 0u) ? 1u : 0u; mine = (j == x) ? c : mine; }
        if (sum == G) break;
        __builtin_amdgcn_s_sleep(1);
        if ((++sp & 255u) == 0u) { if (xb_ld(&bar[XB_TMO])) break; if (sp > XB_SPIN_CAP) { atomicAdd(&bar[XB_TMO], 1u); break; } }
    }
    nloc = mine > 0u ? mine : 1u; nx = cnt > 0u ? cnt : 1u;
}
__device__ __forceinline__ void xcd_barrier(const XcdBarrier& b) {
    asm volatile("s_waitcnt vmcnt(0)" ::: "memory");
    __syncthreads();
    if (threadIdx.x == 0) {
        unsigned* bar = b.bar;
        __builtin_amdgcn_s_waitcnt(0);
        unsigned nloc = b.st[0], nx = b.st[1];
        if (nloc == 0u) { xcd_barrier_complete(bar, b.x, nloc, nx); b.st[0] = nloc; b.st[1] = nx; }
        const unsigned old = xb_add(&bar[XB_XSUB(b.x)], 1u);
        const unsigned gen = old / nloc;
        if (old + 1u == (gen + 1u) * nloc) {
            __builtin_amdgcn_fence(__ATOMIC_RELEASE, "agent");
            asm volatile("s_waitcnt vmcnt(0)" ::: "memory");
            const unsigned og = xb_add(&bar[XB_TOP], 1u);
            const unsigned tg = og / nx;
            if (og + 1u == (tg + 1u) * nx) xb_add(&bar[XB_TOPGEN], 1u);
            else XB_SPIN(xb_ld(&bar[XB_TOPGEN]) == tg, bar);
            __builtin_amdgcn_fence(__ATOMIC_ACQUIRE, "agent");
            xb_add(&bar[XB_XGEN(b.x)], 1u);
            asm volatile("s_waitcnt vmcnt(0)" ::: "memory");
        } else {
            XB_SPIN(xb_ld(&bar[XB_XGEN(b.x)]) == gen, bar);
            __builtin_amdgcn_fence(__ATOMIC_ACQUIRE, "agent");
            asm volatile("s_waitcnt vmcnt(0)" ::: "memory");
        }
    }
    __syncthreads();
}

constexpr int RING_BYTES = 131072;
constexpr int TAB_OFF = RING_BYTES;
constexpr int TAB_CNT = TAB_OFF, TAB_ROWBASE = TAB_OFF + 128, TAB_NT = TAB_OFF + 256, TAB_TEXP = TAB_OFF + 272;
constexpr int MISC_OFF = TAB_OFF + 4096;
constexpr int PTAB_OFF = MISC_OFF + 16;
constexpr int LDS_BYTES = 147456;
static_assert(TAB_TEXP + MOE_MAXTILES * 4 <= MISC_OFF && PTAB_OFF + 32 * 8 <= LDS_BYTES, "LDS map");

__device__ __forceinline__ float wave_sum(float v, int lane) {
#pragma unroll
    for (int o = 1; o < 64; o <<= 1) v += __builtin_bit_cast(float, __builtin_amdgcn_ds_bpermute((lane ^ o) << 2, __builtin_bit_cast(int, v)));
    return v;
}
__device__ __forceinline__ void transpose_item(const float* W, int K, int N, bf16* WT, int k0, int n0, int drow0, LAS float* scr, int lane) {
#pragma unroll 8
    for (int i = 0; i < 32; ++i) { const int kk = 2 * i + (lane >> 5); scr[kk * 33 + (lane & 31)] = W[(size_t)(k0 + kk) * N + n0 + (lane & 31)]; }
    LDS_WAIT(); asm volatile("" ::: "memory");
    const int c = lane & 7;
#pragma unroll
    for (int j = 0; j < 4; ++j) { const int n = (lane >> 3) + 8 * j; const LAS float* s = scr + (8 * c) * 33 + n;
        v4u o; o.x = pk2(s[0 * 33], s[1 * 33]); o.y = pk2(s[2 * 33], s[3 * 33]); o.z = pk2(s[4 * 33], s[5 * 33]); o.w = pk2(s[6 * 33], s[7 * 33]);
        *(GAS v4u*)(WT + (size_t)(drow0 + n) * K + k0 + 8 * c) = o; }
    LDS_WAIT(); asm volatile("" ::: "memory");
}


__device__ __forceinline__ void build_moe_tables(LAS unsigned char* lds, const unsigned* cnt_words, const int tid) {
    LAS int* tcnt = (LAS int*)(lds + TAB_CNT); LAS int* trb = (LAS int*)(lds + TAB_ROWBASE); LAS int* tnt = (LAS int*)(lds + TAB_NT); LAS int* texp = (LAS int*)(lds + TAB_TEXP);
    __syncthreads();
    if (tid < NEXP) tcnt[tid] = (int)__hip_atomic_load(cnt_words + 64 * tid, __ATOMIC_RELAXED, __HIP_MEMORY_SCOPE_AGENT);
    __syncthreads();
    if (tid == 0) { int tile = 0;
#pragma unroll 1
        for (int e = 0; e < NEXP; ++e) { int c = tcnt[e]; if (c > 2 * T) c = 2 * T; int nt = (c + 255) >> 8; if (tile + nt > MOE_MAXTILES) nt = MOE_MAXTILES - tile; trb[e] = tile * 256;
#pragma unroll 1
            for (int i = 0; i < nt; ++i) texp[tile + i] = e;
            tile += nt; }
        tnt[0] = tile; }
    __syncthreads();
}

struct Args { const void* in[30]; float* out; unsigned char* ws; int layer, pad; };
__device__ __forceinline__ Ctx make_ctx(const Args& args, unsigned char* ws, int l) {
    Ctx c;
    c.pos = (const int*)args.in[1];
    c.gam = (const float*)args.in[5] + l * 16; c.ret_g = (const float*)args.in[6] + l * 512; c.mu = (const float*)args.in[7] + l * 2 * B_COLS;
    c.w0 = (const float*)args.in[8] + l * 1024; c.w2 = (const float*)args.in[9] + l * 96 * 512; c.a0 = (const float*)args.in[10] + l * 1024; c.a2 = (const float*)args.in[11] + l * 96 * 512;
    c.g2 = (const float*)args.in[12] + l * 256 * 512; c.k_k = (const float*)args.in[13] + l * 512; c.k_a = (const float*)args.in[14] + l * 512; c.r_k = (const float*)args.in[15] + l * 512;
    c.ln_g = (const float*)args.in[16] + l * 512; c.sgu_g = (const float*)args.in[17] + l * 512; c.sgu_b = (const float*)args.in[18] + l * 512;
    c.sgu_w = (const float*)args.in[19] + (size_t)l * 8 * 128 * 128; c.sgu_bias = (const float*)args.in[20] + l * 1024;
    c.proj = (bf16*)(ws + WS_PROJ); c.ycat = (bf16*)(ws + WS_ACT);
    c.rs = (bf16*)(ws + WS_RS); c.ks = (bf16*)(ws + WS_KS); c.vs = (bf16*)(ws + WS_VS); c.kk = (bf16*)(ws + WS_KK); c.gg = (bf16*)(ws + WS_GG);
    c.kdf = (bf16*)(ws + WS_KDF); c.kdb = (bf16*)(ws + WS_KDB); c.akf = (bf16*)(ws + WS_AKF); c.akb = (bf16*)(ws + WS_AKB); c.yf = (bf16*)(ws + WS_YF); c.yb = (bf16*)(ws + WS_YB);
    c.lin = (bf16*)(ws + WS_LIN); c.wf = (float*)(ws + WS_WF); c.wb = (float*)(ws + WS_WB); c.rkv = (float*)(ws + WS_RKV); c.rsp = (float*)(ws + WS_RSP);
    return c;
}


#define ROW_LOAD(v, ptr) _Pragma("unroll") for (int j = 0; j < 8; ++j) v[j] = ((const GAS f32x4*)(ptr))[lane + 64 * j]
__device__ __forceinline__ void row_add_moe(f32x4 (&v)[8], const bf16* yp, size_t R1, size_t R2, float g1, float g2, int lane) {
#pragma unroll
    for (int j = 0; j < 8; ++j) { const v2u a = ((const GAS v2u*)(yp + R1 * DM))[lane + 64 * j], b = ((const GAS v2u*)(yp + R2 * DM))[lane + 64 * j];
        v[j].x += g1 * bf2f((bf16)(a.x & 0xffff)) + g2 * bf2f((bf16)(b.x & 0xffff)); v[j].y += g1 * bf2f((bf16)(a.x >> 16)) + g2 * bf2f((bf16)(b.x >> 16));
        v[j].z += g1 * bf2f((bf16)(a.y & 0xffff)) + g2 * bf2f((bf16)(b.y & 0xffff)); v[j].w += g1 * bf2f((bf16)(a.y >> 16)) + g2 * bf2f((bf16)(b.y >> 16)); }
}
__device__ __forceinline__ float row_rstd(const f32x4 (&v)[8], int lane) {
    float ss = 0.f;
#pragma unroll
    for (int j = 0; j < 8; ++j) ss += (v[j].x * v[j].x + v[j].y * v[j].y) + (v[j].z * v[j].z + v[j].w * v[j].w);
    return 1.f / sqrtf(wave_sum(ss, lane) * (1.f / DM) + NORM_EPS);
}
#define SEAM(k) do { if constexpr (KSEL < 0) { XcdBarrier b_ = bar; unsigned blo_ = __builtin_amdgcn_readfirstlane((unsigned)(unsigned long long)b_.bar), bhi_ = __builtin_amdgcn_readfirstlane((unsigned)((unsigned long long)b_.bar >> 32)); \
    asm volatile("" : "+s"(blo_), "+s"(bhi_)); b_.bar = (unsigned*)(((unsigned long long)bhi_ << 32) | blo_); xcd_barrier(b_); } } while (0)
#define PH_ON(k) if constexpr ((KSEL < 0 && KB_EN(k)) || KSEL == (k))
#define PHASE_LOCALS() unsigned char* ws = args.ws; int ll = KSEL < 0 ? l : __builtin_amdgcn_readfirstlane(l); int tid = threadIdx.x; asm volatile("" : "+s"(ws), "+s"(ll), "+v"(tid)); \
    const int lane = tid & 63, wave = __builtin_amdgcn_readfirstlane(tid >> 6); \
    const int G = gridDim.x, bid = blockIdx.x; const long gtid = (long)bid * 512 + tid, gstride = (long)G * 512; const int gw = bid * 8 + wave, NGW = G * 8; \
    (void)gtid; (void)gstride; (void)gw; (void)NGW; (void)ll; (void)lane


__device__ __forceinline__ float quad_sum(float v) {
    v += __builtin_bit_cast(float, __builtin_amdgcn_update_dpp(0, __builtin_bit_cast(int, v), 0xB1, 0xF, 0xF, true));
    v += __builtin_bit_cast(float, __builtin_amdgcn_update_dpp(0, __builtin_bit_cast(int, v), 0x4E, 0xF, 0xF, true));
    return v;
}
__device__ __forceinline__ void rwkv_scan_quad(const Ctx& c, int unit, int w4, int lane) {
    const int dir = unit & 1, h = (unit >> 1) & 7, b = unit >> 4; const int row = w4 * 16 + (lane >> 2), q = lane & 3;
    const float* W = dir ? c.wb : c.wf; const bf16* KD = dir ? c.kdb : c.kdf; const bf16* AK = dir ? c.akb : c.akf; bf16* Y = dir ? c.yb : c.yf;
    float S[16];
#pragma unroll
    for (int i = 0; i < 16; ++i) S[i] = 0.f;
    for (int k = 0; k < SEQ; ++k) {
        const int s = dir ? SEQ - 1 - k : k; const size_t o = ((size_t)b * SEQ + s) * 512 + h * 64 + q * 16;
        float kkv[16], akv[16], kdv[16], rv[16], wv[16];
        { const v4u a = *(const GAS v4u*)(c.kk + o), bq = *(const GAS v4u*)(c.kk + o + 8);
          const unsigned t[8] = {a.x, a.y, a.z, a.w, bq.x, bq.y, bq.z, bq.w};
#pragma unroll
          for (int i = 0; i < 8; ++i) { kkv[2 * i] = __builtin_bit_cast(float, t[i] << 16); kkv[2 * i + 1] = __builtin_bit_cast(float, t[i] & 0xffff0000u); } }
        { const v4u a = *(const GAS v4u*)(AK + o), bq = *(const GAS v4u*)(AK + o + 8);
          const unsigned t[8] = {a.x, a.y, a.z, a.w, bq.x, bq.y, bq.z, bq.w};
#pragma unroll
          for (int i = 0; i < 8; ++i) { akv[2 * i] = __builtin_bit_cast(float, t[i] << 16); akv[2 * i + 1] = __builtin_bit_cast(float, t[i] & 0xffff0000u); } }
        { const v4u a = *(const GAS v4u*)(KD + o), bq = *(const GAS v4u*)(KD + o + 8);
          const unsigned t[8] = {a.x, a.y, a.z, a.w, bq.x, bq.y, bq.z, bq.w};
#pragma unroll
          for (int i = 0; i < 8; ++i) { kdv[2 * i] = __builtin_bit_cast(float, t[i] << 16); kdv[2 * i + 1] = __builtin_bit_cast(float, t[i] & 0xffff0000u); } }
        { const v4u a = *(const GAS v4u*)(c.rs + o), bq = *(const GAS v4u*)(c.rs + o + 8);
          const unsigned t[8] = {a.x, a.y, a.z, a.w, bq.x, bq.y, bq.z, bq.w};
#pragma unroll
          for (int i = 0; i < 8; ++i) { rv[2 * i] = __builtin_bit_cast(float, t[i] << 16); rv[2 * i + 1] = __builtin_bit_cast(float, t[i] & 0xffff0000u); } }
#pragma unroll
        for (int i = 0; i < 4; ++i) { const f32x4 w4v = *(const GAS f32x4*)(W + o + 4 * i); wv[4 * i] = w4v.x; wv[4 * i + 1] = w4v.y; wv[4 * i + 2] = w4v.z; wv[4 * i + 3] = w4v.w; }
        const float v = bf2f(c.vs[o - q * 16 + row]);
        float sk = 0.f;
#pragma unroll
        for (int i = 0; i < 16; ++i) sk += S[i] * kkv[i];
        sk = quad_sum(sk);
        float y = 0.f;
#pragma unroll
        for (int i = 0; i < 16; ++i) { S[i] = S[i] * wv[i] - sk * akv[i] + v * kdv[i]; y += S[i] * rv[i]; }
        y = quad_sum(y);
        if (q == 0) Y[o + row] = f2bf(y);
    }
}
template <int KSEL>
__device__ __forceinline__ void layer_program(const Args& args, LAS unsigned char* lds, const XcdBarrier& bar, const int l) {
        PH_ON(0) {
            PHASE_LOCALS();
            bf16* WinT = (bf16*)(ws + WS_WIN); bf16* WoutT = (bf16*)(ws + WS_WOUT); bf16* Wgu = (bf16*)(ws + WS_WGU); bf16* WdT = (bf16*)(ws + WS_WD);
            LAS float* scr = (LAS float*)(lds + wave * 16384);
            const float* w_in = (const float*)args.in[3] + (size_t)ll * DM * D_IN; const float* w_out = (const float*)args.in[4] + (size_t)ll * DM * DM;
            const float* wg_ = (const float*)args.in[26] + (size_t)ll * NEXP * DM * DE; const float* wu_ = (const float*)args.in[27] + (size_t)ll * NEXP * DM * DE; const float* wd_ = (const float*)args.in[28] + (size_t)ll * NEXP * DE * DM;
            constexpr int I_IN = (DM / 64) * (D_IN / 32), I_OUT = (DM / 64) * (DM / 32), I_GU = (DM / 64) * (DE / 32), I_D = (DE / 64) * (DM / 32);
            constexpr int NITEMS = I_IN + I_OUT + NEXP * (2 * I_GU + I_D);
            for (int it = gw; it < NITEMS; it += NGW) {
                int r = it;
                if (r < I_IN) { const int nblk = D_IN / 32, kb = r / nblk, nb = r % nblk; transpose_item(w_in, DM, D_IN, WinT, 64 * kb, 32 * nb, 32 * nb, scr, lane); continue; } r -= I_IN;
                if (r < I_OUT) { const int nblk = DM / 32, kb = r / nblk, nb = r % nblk; transpose_item(w_out, DM, DM, WoutT, 64 * kb, 32 * nb, 32 * nb, scr, lane); continue; } r -= I_OUT;
                const int e = r / (2 * I_GU + I_D); r -= e * (2 * I_GU + I_D);
                if (r < 2 * I_GU) { const int up = r >= I_GU ? 1 : 0; r -= up * I_GU; const int nblk = DE / 32, kb = r / nblk, nb = r % nblk, n0 = 32 * nb;
                    transpose_item((up ? wu_ : wg_) + (size_t)e * DM * DE, DM, DE, Wgu + (size_t)e * 1024 * DM, 64 * kb, n0, (n0 >> 7) * 256 + (n0 & 127) + up * 128, scr, lane); continue; }
                r -= 2 * I_GU;
                { const int nblk = DM / 32, kb = r / nblk, nb = r % nblk; transpose_item(wd_ + (size_t)e * DE * DM, DE, DM, WdT + (size_t)e * DM * DE, 64 * kb, 32 * nb, 32 * nb, scr, lane); }
            }
            for (long i = gtid; i < (long)(NPROJ - D_IN) * DM / 8; i += gstride) ((GAS v4u*)(WinT + (size_t)D_IN * DM))[i] = (v4u){0u, 0u, 0u, 0u};
            if (ll > 0) build_moe_tables(lds, (const unsigned*)(ws + WS_CTL) + CW_CNT + (ll - 1) * 2048, tid);
            const LAS int* trb = (const LAS int*)(lds + TAB_ROWBASE);
            const float* x_in = (const float*)args.in[0]; float* xbuf = (float*)(ws + WS_X); bf16* act = (bf16*)(ws + WS_ACT); const bf16* yp = (const bf16*)(ws + WS_YP);
            const unsigned* slot_tok = (const unsigned*)(ws + WS_SLOT); const float* gate_tok = (const float*)(ws + WS_GATE);
            const float* norm1_g = (const float*)args.in[2] + ll * DM;
            for (int m = gw; m < T; m += NGW) {
                f32x4 v[8];
                ROW_LOAD(v, (ll == 0 ? x_in : xbuf) + (size_t)m * DM);
                if (ll > 0) {
                    const unsigned s1 = slot_tok[2 * m], s2 = slot_tok[2 * m + 1]; const float g1 = gate_tok[2 * m], g2 = gate_tok[2 * m + 1];
                    row_add_moe(v, yp, (size_t)(trb[s1 >> 20] + (int)(s1 & 0xfffffu)), (size_t)(trb[s2 >> 20] + (int)(s2 & 0xfffffu)), g1, g2, lane);
#pragma unroll
                    for (int j = 0; j < 8; ++j) ((GAS f32x4*)(xbuf + (size_t)m * DM))[lane + 64 * j] = v[j];
                }
                const float rstd = row_rstd(v, lane);
#pragma unroll
                for (int j = 0; j < 8; ++j) { const f32x4 g = ((const GAS f32x4*)norm1_g)[lane + 64 * j];
                    v2u o; o.x = pk2(v[j].x * rstd * g.x, v[j].y * rstd * g.y); o.y = pk2(v[j].z * rstd * g.z, v[j].w * rstd * g.w);
                    ((GAS v2u*)(act + (size_t)m * DM))[lane + 64 * j] = o; }
            }
        }
        SEAM(0);
        PH_ON(1) {
            PHASE_LOCALS();
            pg8::Gemm g{(const bf16*)(ws + WS_ACT), (const bf16*)(ws + WS_WIN), T, NPROJ, DM, 0}; pg8::StaticOrder<T, NPROJ> S; S.init(G, bid);
            pg8::EpiBf16 E{(bf16*)(ws + WS_PROJ), NPROJ};
            pg8::gemm_phase<DM, pg8::EpiBf16, pg8::StaticOrder<T, NPROJ>, true, true>(lds, g, S, E, tid);
        }
        SEAM(1);
        PH_ON(2) { PHASE_LOCALS(); const Ctx c = make_ctx(args, ws, ll);
            for (long i = gtid; i < (long)T * 256; i += gstride) el_rot_ret(c, i);
            for (long i = gtid; i < (long)T * 256; i += gstride) el_rot_dil(c, i);
            for (long i = gtid; i < (long)T * B_COLS; i += gstride) el_rwkv_shift(c, i);
            for (long i = gtid; i < (long)T; i += gstride) el_sgu_prep(c, i); }
        SEAM(2);
        PH_ON(3) { PHASE_LOCALS(); const Ctx c = make_ctx(args, ws, ll);
            for (long i = gtid; i < (long)T * 512; i += gstride) el_rwkv_lora(c, i);
            for (long i = gtid; i < (long)BATCH * 8 * 2 * NC * 4096; i += gstride) el_ret_kv(c, i);
            for (long i = gtid; i < (long)T * 512; i += gstride) el_sgu_main(c, i);
            for (long i = gtid; i < (long)T * 8; i += gstride) el_dil_attn(c, i); }
        SEAM(3);
        PH_ON(4) { PHASE_LOCALS(); const Ctx c = make_ctx(args, ws, ll);
            for (long i = gtid; i < (long)T * 8; i += gstride) el_rwkv_kk(c, i);
            for (long i = gtid; i < (long)BATCH * 8 * 2 * 4096; i += gstride) el_ret_scan(c, i); }
        SEAM(4);
        PH_ON(5) { PHASE_LOCALS(); const Ctx c = make_ctx(args, ws, ll);
            for (int u = bid + G * (wave >> 2); u < BATCH * 16; u += G * 2) rwkv_scan_quad(c, u, wave & 3, lane); }
        SEAM(5);
        PH_ON(6) { PHASE_LOCALS(); const Ctx c = make_ctx(args, ws, ll);
            for (long i = gtid; i < (long)T * 8; i += gstride) el_ret_out(c, i);
            for (long i = gtid; i < (long)T * 8; i += gstride) el_rwkv_fin(c, i); }
        SEAM(6);
        PH_ON(7) {
            PHASE_LOCALS();
            pg8::Gemm g{(const bf16*)(ws + WS_ACT), (const bf16*)(ws + WS_WOUT), T, DM, DM, 0}; pg8::StaticOrder<T, DM> S; S.init(G, bid);
            pg8::EpiResF32 E{ll == 0 ? (const float*)args.in[0] : (const float*)(ws + WS_X), (float*)(ws + WS_X), DM};
            pg8::gemm_phase<DM, pg8::EpiResF32, pg8::StaticOrder<T, DM>, true, true>(lds, g, S, E, tid);
        }
        SEAM(7);
        PH_ON(8) {
            PHASE_LOCALS();
            const float* wg = (const float*)args.in[22] + (size_t)ll * DM * 4; const float* bg = (const float*)args.in[23] + ll * 4;
            const float* we = (const float*)args.in[24] + (size_t)ll * DM * 32; const float* be = (const float*)args.in[25] + ll * 32;
            const float* norm2_g = (const float*)args.in[21] + ll * DM;
            const float* xbuf = (const float*)(ws + WS_X); bf16* act = (bf16*)(ws + WS_ACT);
            unsigned* cnt_cur = (unsigned*)(ws + WS_CTL) + CW_CNT + ll * 2048;
            int* tok_of = (int*)(ws + WS_TOK); unsigned* slot_tok = (unsigned*)(ws + WS_SLOT); float* gate_tok = (float*)(ws + WS_GATE);
            for (int m = gw; m < T; m += NGW) {
                f32x4 v[8];
                ROW_LOAD(v, xbuf + (size_t)m * DM);
                const float rstd = row_rstd(v, lane);
#pragma unroll
                for (int j = 0; j < 8; ++j) { const f32x4 g = ((const GAS f32x4*)norm2_g)[lane + 64 * j];
                    v[j] = (f32x4){v[j].x * rstd * g.x, v[j].y * rstd * g.y, v[j].z * rstd * g.z, v[j].w * rstd * g.w};
                    v2u o; o.x = pk2(v[j].x, v[j].y); o.y = pk2(v[j].z, v[j].w);
                    ((GAS v2u*)(act + (size_t)m * DM))[lane + 64 * j] = o; }
                LAS f32x4* hrow = (LAS f32x4*)(lds + wave * 16384);
#pragma unroll
                for (int j = 0; j < 8; ++j) hrow[lane + 64 * j] = v[j];
                LDS_WAIT(); asm volatile("" ::: "memory");
                float lg[4], le[32];
#pragma unroll
                for (int i = 0; i < 4; ++i) lg[i] = 0.f;
#pragma unroll
                for (int i = 0; i < 32; ++i) le[i] = 0.f;
#pragma unroll 1
                for (int kk = 0; kk < 32; ++kk) { const int k = kk * 64 + lane; const float hv = ((const LAS float*)hrow)[k];
                    const f32x4 wgr = *(const GAS f32x4*)(wg + (size_t)k * 4);
                    lg[0] += hv * wgr.x; lg[1] += hv * wgr.y; lg[2] += hv * wgr.z; lg[3] += hv * wgr.w;
#pragma unroll
                    for (int q = 0; q < 8; ++q) { const f32x4 wr = *(const GAS f32x4*)(we + (size_t)k * 32 + 4 * q);
                        le[4 * q] += hv * wr.x; le[4 * q + 1] += hv * wr.y; le[4 * q + 2] += hv * wr.z; le[4 * q + 3] += hv * wr.w; } }
#pragma unroll
                for (int i = 0; i < 4; ++i) lg[i] = wave_sum(lg[i], lane);
#pragma unroll
                for (int i = 0; i < 32; ++i) le[i] = wave_sum(le[i], lane);
                LDS_WAIT(); asm volatile("" ::: "memory");
                int e1, e2; float g1, g2; route_select(lg, le, bg, be, e1, e2, g1, g2);
                if (lane == 0) {
                    const unsigned r1 = __hip_atomic_fetch_add(cnt_cur + 64 * e1, 1u, __ATOMIC_RELAXED, __HIP_MEMORY_SCOPE_AGENT);
                    const unsigned r2 = __hip_atomic_fetch_add(cnt_cur + 64 * e2, 1u, __ATOMIC_RELAXED, __HIP_MEMORY_SCOPE_AGENT);
                    tok_of[(size_t)e1 * T + r1] = m; tok_of[(size_t)e2 * T + r2] = m;
                    slot_tok[2 * m] = ((unsigned)e1 << 20) | r1; slot_tok[2 * m + 1] = ((unsigned)e2 << 20) | r2; gate_tok[2 * m] = g1; gate_tok[2 * m + 1] = g2;
                }
            }
        }
        SEAM(8);
        PH_ON(9) {
            PHASE_LOCALS();
            build_moe_tables(lds, (const unsigned*)(ws + WS_CTL) + CW_CNT + ll * 2048, tid);
            const LAS int* tcnt = (const LAS int*)(lds + TAB_CNT); const LAS int* trb = (const LAS int*)(lds + TAB_ROWBASE); const LAS int* texp = (const LAS int*)(lds + TAB_TEXP);
            const int nrows = ((const LAS int*)(lds + TAB_NT))[0] * 256;
            const int* tok_of = (const int*)(ws + WS_TOK); const bf16* act = (const bf16*)(ws + WS_ACT); bf16* aperm = (bf16*)(ws + WS_APERM);
            for (int R = gw; R < nrows; R += NGW) {
                const int e = texp[R >> 8], r = R - trb[e];
                GAS v4u* dst = (GAS v4u*)(aperm + (size_t)R * DM);
                if (r < tcnt[e]) { const int tok = tok_of[(size_t)e * T + r]; const GAS v4u* src = (const GAS v4u*)(act + (size_t)tok * DM);
#pragma unroll
                    for (int j = 0; j < 4; ++j) dst[lane + 64 * j] = src[lane + 64 * j]; }
                else {
#pragma unroll
                    for (int j = 0; j < 4; ++j) dst[lane + 64 * j] = (v4u){0u, 0u, 0u, 0u}; }
            }
        }
        SEAM(9);
        PH_ON(10) {
            PHASE_LOCALS();
            build_moe_tables(lds, (const unsigned*)(ws + WS_CTL) + CW_CNT + ll * 2048, tid);
            const int ntiles = __builtin_amdgcn_readfirstlane(((const LAS int*)(lds + TAB_NT))[0]);
            pg8::Gemm g{(const bf16*)(ws + WS_APERM), (const bf16*)(ws + WS_WGU), MOE_MAXTILES * 256, 1024, DM, (size_t)1024 * DM * 2};
            pg8::MoeOrder<4> S{G, bid, ntiles, (const LAS int*)(lds + TAB_TEXP)};
            pg8::EpiSwiGLU E{(bf16*)(ws + WS_HID), DE};
            pg8::gemm_phase<DM, pg8::EpiSwiGLU, pg8::MoeOrder<4>, true, true>(lds, g, S, E, tid);
        }
        SEAM(10);
        PH_ON(11) {
            PHASE_LOCALS();
            build_moe_tables(lds, (const unsigned*)(ws + WS_CTL) + CW_CNT + ll * 2048, tid);
            const int ntiles = __builtin_amdgcn_readfirstlane(((const LAS int*)(lds + TAB_NT))[0]);
            pg8::Gemm g{(const bf16*)(ws + WS_HID), (const bf16*)(ws + WS_WD), MOE_MAXTILES * 256, DM, DE, (size_t)DM * DE * 2};
            pg8::MoeOrder<8> S{G, bid, ntiles, (const LAS int*)(lds + TAB_TEXP)};
            pg8::EpiBf16 E{(bf16*)(ws + WS_YP), DM};
            pg8::gemm_phase<DE, pg8::EpiBf16, pg8::MoeOrder<8>, true, true>(lds, g, S, E, tid);
        }
        SEAM(11);
    }

template <int KSEL>
__global__ void __launch_bounds__(512, 2) fwd_kernel(Args args) {
    extern __shared__ __attribute__((aligned(16))) unsigned char lds_raw[];
    LAS unsigned char* lds = (LAS unsigned char*)lds_raw;
    if (threadIdx.x < 4) ((LAS unsigned*)(lds + MISC_OFF))[threadIdx.x] = 0u;
    __syncthreads();
    XcdBarrier bar; bar.bar = (unsigned*)(args.ws + WS_CTL) + CW_BAR; bar.x = 0; bar.st = nullptr;
    if constexpr (KSEL < 0) bar = xcd_barrier_post((unsigned*)(args.ws + WS_CTL) + CW_BAR, (volatile LAS unsigned*)(lds + MISC_OFF));
    if constexpr (KSEL < 0) { layer_program<KSEL>(args, lds, bar, 0); layer_program<KSEL>(args, lds, bar, 1); }
    else if constexpr (KSEL != 12) layer_program<KSEL>(args, lds, bar, args.layer);
    PH_ON(12) {
        const int l = DEPTH - 1;
        PHASE_LOCALS();
        build_moe_tables(lds, (const unsigned*)(ws + WS_CTL) + CW_CNT + ll * 2048, tid);
        const LAS int* trb = (const LAS int*)(lds + TAB_ROWBASE);
        const float* gfin = (const float*)args.in[29]; const float* xbuf = (const float*)(ws + WS_X); const bf16* yp = (const bf16*)(ws + WS_YP);
        const unsigned* slot_tok = (const unsigned*)(ws + WS_SLOT); const float* gate_tok = (const float*)(ws + WS_GATE);
        for (int m = gw; m < T; m += NGW) {
            f32x4 v[8];
            ROW_LOAD(v, xbuf + (size_t)m * DM);
            const unsigned s1 = slot_tok[2 * m], s2 = slot_tok[2 * m + 1]; const float g1 = gate_tok[2 * m], g2 = gate_tok[2 * m + 1];
            row_add_moe(v, yp, (size_t)(trb[s1 >> 20] + (int)(s1 & 0xfffffu)), (size_t)(trb[s2 >> 20] + (int)(s2 & 0xfffffu)), g1, g2, lane);
            const float rstd = row_rstd(v, lane);
#pragma unroll
            for (int j = 0; j < 8; ++j) { const f32x4 g = ((const GAS f32x4*)gfin)[lane + 64 * j];
                ((GAS f32x4*)(args.out + (size_t)m * DM))[lane + 64 * j] = (f32x4){v[j].x * rstd * g.x, v[j].y * rstd * g.y, v[j].z * rstd * g.z, v[j].w * rstd * g.w}; }
        }
    }
#undef SEAM
#undef PH_ON
}

extern "C" void kernel_launch(void* const* d_in, const int* in_sizes, int n_in, void* d_out, int out_size, void* d_ws, size_t ws_size, hipStream_t stream) {
    static int grid = 0;
    if (grid == 0) {
        if (n_in != 30 || in_sizes[0] != T * DM || out_size != T * DM || ws_size < WS_END) { fprintf(stderr, "kernel_launch: unexpected shapes (n_in %d, in0 %d, out %d, ws %zu < %zu)\n", n_in, n_in > 0 ? in_sizes[0] : -1, out_size, ws_size, (size_t)WS_END); grid = -1; return; }
        int dev = 0, cus = 0, per_cu = 0; (void)per_cu;
        if (hipGetDevice(&dev) != hipSuccess || hipDeviceGetAttribute(&cus, hipDeviceAttributeMultiprocessorCount, dev) != hipSuccess) { grid = -1; return; }
#if KB_SPLIT
#define SET_ATTR(k) if (hipFuncSetAttribute((const void*)fwd_kernel<k>, hipFuncAttributeMaxDynamicSharedMemorySize, LDS_BYTES) != hipSuccess) { fprintf(stderr, "kernel_launch: hipFuncSetAttribute failed (%d)\n", k); grid = -1; return; }
        SET_ATTR(0) SET_ATTR(1) SET_ATTR(2) SET_ATTR(3) SET_ATTR(4) SET_ATTR(5) SET_ATTR(6) SET_ATTR(7) SET_ATTR(8) SET_ATTR(9) SET_ATTR(10) SET_ATTR(11) SET_ATTR(12)
#else
        if (hipFuncSetAttribute((const void*)fwd_kernel<-1>, hipFuncAttributeMaxDynamicSharedMemorySize, LDS_BYTES) != hipSuccess) { fprintf(stderr, "kernel_launch: hipFuncSetAttribute failed\n"); grid = -1; return; }
        if (hipOccupancyMaxActiveBlocksPerMultiprocessor(&per_cu, (const void*)fwd_kernel<-1>, 512, LDS_BYTES) != hipSuccess || per_cu < 1) fprintf(stderr, "kernel_launch: occupancy query says %d\n", per_cu);
#endif
        (void)hipGetLastError();
        grid = cus;
    }
    if (grid < 0) return;
    if (hipMemsetAsync((char*)d_ws + WS_CTL, 0, CTL_ZERO_BYTES, stream) != hipSuccess) return;
    Args a{};
    for (int i = 0; i < 30; ++i) a.in[i] = d_in[i];
    a.out = (float*)d_out; a.ws = (unsigned char*)d_ws; a.layer = 0; a.pad = 0;
#if KB_SPLIT
#define LAUNCH_PH(k) hipLaunchKernelGGL(fwd_kernel<k>, dim3(grid), dim3(512), LDS_BYTES, stream, a)
    for (int l = 0; l < DEPTH; ++l) { a.layer = l;
        LAUNCH_PH(0); LAUNCH_PH(1); LAUNCH_PH(2); LAUNCH_PH(3); LAUNCH_PH(4); LAUNCH_PH(5); LAUNCH_PH(6); LAUNCH_PH(7); LAUNCH_PH(8); LAUNCH_PH(9); LAUNCH_PH(10); LAUNCH_PH(11); }
    a.layer = DEPTH - 1; LAUNCH_PH(12);
#else
    hipLaunchKernelGGL(fwd_kernel<-1>, dim3(grid), dim3(512), LDS_BYTES, stream, a);
#endif
}
#endif
```

```cpp
#include <hip/hip_runtime.h>
#include <cstdio>
#include <cstdint>
#include <cmath>

#ifndef KB_BATCH
#define KB_BATCH 4
#define KB_SEQ 4096
#endif
#ifndef KB_SPLIT
#define KB_SPLIT 0
#endif

#ifndef KB_PHMASK
#define KB_PHMASK 0xffff
#endif
#define KB_EN(k) (((KB_PHMASK) >> (k)) & 1)
#define HD __host__ __device__ __forceinline__
typedef unsigned short bf16;

constexpr int BATCH = KB_BATCH, SEQ = KB_SEQ, T = BATCH * SEQ;
constexpr int DM = 2048, DG = 512, NH = 8, HDIM = 64;
constexpr int A_COLS = 2048, B_COLS = 1984, C_COLS = 1024, D_COLS = 1536, D_IN = 6592, NPROJ = 6656;
constexpr int OFF_A = 0, OFF_B = 2048, OFF_C = 4032, OFF_D = 5056;
constexpr int NC = SEQ / 128;
constexpr int NEXP = 32, DE = 512;
constexpr int NLORA = 448;
constexpr float NORM_EPS = 1e-6f, GN_EPS = 64e-5f;
constexpr int MOE_MAXTILES = (2 * T + NEXP * 255 + 255) / 256;
constexpr int DEPTH = 2;

constexpr size_t MiB = 1u << 20;
constexpr size_t WS_CTL = 0, CTL_ZERO_BYTES = 1 * MiB;
constexpr size_t WS_WIN = 2 * MiB, WS_WOUT = 28 * MiB, WS_WGU = 36 * MiB, WS_WD = 164 * MiB;
constexpr size_t WS_X = 228 * MiB;
constexpr size_t WS_ACT = 356 * MiB;
constexpr size_t WS_PROJ = 420 * MiB;
constexpr size_t WS_RKV = 628 * MiB, WS_RSP = 660 * MiB;
constexpr size_t WS_RS = 692 * MiB, WS_KS = 708 * MiB, WS_VS = 724 * MiB, WS_KK = 740 * MiB, WS_GG = 756 * MiB, WS_KDF = 772 * MiB, WS_KDB = 788 * MiB,
                 WS_AKF = 804 * MiB, WS_AKB = 820 * MiB, WS_YF = 836 * MiB, WS_YB = 852 * MiB, WS_LIN = 868 * MiB  , WS_WF = 882 * MiB, WS_WB = 914 * MiB;
constexpr size_t WS_TOK = 946 * MiB  , WS_SLOT = 948 * MiB, WS_GATE = 949 * MiB;
constexpr size_t WS_DPO = 950 * MiB  , WS_DML = 998 * MiB  , WS_END = 1002 * MiB;
constexpr size_t WS_APERM = 420 * MiB, WS_HID = 580 * MiB, WS_YP = 620 * MiB;
static_assert((size_t)MOE_MAXTILES * 256 * 2048 * 2 <= 160 * MiB && (size_t)T * NPROJ * 2 <= 208 * MiB, "ws map");
constexpr int CW_BAR = 4096;
constexpr int CW_CNT = 16384;

HD float bf2f(bf16 v) { return __builtin_bit_cast(float, (unsigned)v << 16); }
HD bf16 f2bf(float f) { unsigned u = __builtin_bit_cast(unsigned, f); return (bf16)((u + 0x7fffu + ((u >> 16) & 1u)) >> 16); }
HD float sigmoidf_(float x) { return 1.f / (1.f + expf(-x)); }
HD float siluf_(float x) { return x / (1.f + expf(-x)); }
HD float geluf_(float x) { return 0.5f * x * (1.f + tanhf(0.7978845608028654f * (x + 0.044715f * x * x * x))); }
HD float logsigmoidf_(float x) { return x < 0.f ? x - log1pf(expf(x)) : -log1pf(expf(-x)); }

struct Ctx {
    const int* pos;
    const float *gam, *ret_g, *mu, *w0, *w2, *a0, *a2, *g2, *k_k, *k_a, *r_k, *ln_g, *sgu_g, *sgu_b, *sgu_w, *sgu_bias;
    bf16 *proj, *ycat, *rs, *ks, *vs, *kk, *gg, *kdf, *kdb, *akf, *akb, *yf, *yb, *lin;
    float *wf, *wb, *rkv, *rsp;
};

HD void el_rot_ret(const Ctx& c, long idx) {
    const int i = (int)(idx & 31), h = (int)((idx >> 5) & 7); const long t = idx >> 8;
    const float inv = expf(-(float)i * (1.f / 32.f) * 9.210340371976184f);
    const float ang = (float)c.pos[t] * inv; float sn, cs; sincosf(ang, &sn, &cs);
    bf16* q = c.proj + (size_t)t * NPROJ + OFF_A + h * 64; bf16* k = q + 512;
    const float q1 = bf2f(q[i]), q2 = bf2f(q[i + 32]), k1 = bf2f(k[i]), k2 = bf2f(k[i + 32]);
    q[i] = f2bf(q1 * cs - q2 * sn); q[i + 32] = f2bf(q2 * cs + q1 * sn);
    k[i] = f2bf((k1 * cs - k2 * sn) * 0.125f); k[i + 32] = f2bf((k2 * cs + k1 * sn) * 0.125f);
}
HD void el_rot_dil(const Ctx& c, long idx) {
    const int j = (int)(idx & 31), h = (int)((idx >> 5) & 7); const long t = idx >> 8;
    bf16* q = c.proj + (size_t)t * NPROJ + OFF_D + h * 64; bf16* k = q + 512;
    if (j < 8) {
        const float inv = expf(-(float)j * (1.f / 8.f) * 13.122363377404328f);
        const float ang = (float)c.pos[t] * inv; float sn, cs; sincosf(ang, &sn, &cs);
        const float q1 = bf2f(q[j]), q2 = bf2f(q[j + 8]), k1 = bf2f(k[j]), k2 = bf2f(k[j + 8]);
        q[j] = f2bf((q1 * cs - q2 * sn) * 0.125f); q[j + 8] = f2bf((q2 * cs + q1 * sn) * 0.125f);
        k[j] = f2bf(k1 * cs - k2 * sn); k[j + 8] = f2bf(k2 * cs + k1 * sn);
    } else {
        const int d = 16 + 2 * (j - 8);
        q[d] = f2bf(bf2f(q[d]) * 0.125f); q[d + 1] = f2bf(bf2f(q[d + 1]) * 0.125f);
    }
}
HD void el_rwkv_shift(const Ctx& c, long idx) {
    const int j = (int)(idx % B_COLS); const long t = idx / B_COLS; const int s = (int)(t % SEQ);
    const bf16* p = c.proj + (size_t)t * NPROJ + OFF_B + j;
    const float x = bf2f(p[0]), xp = s > 0 ? bf2f(p[-(long)NPROJ]) : 0.f, xn = s < SEQ - 1 ? bf2f(p[NPROJ]) : 0.f;
    const float xs = x + c.mu[j] * (xp - x) + c.mu[B_COLS + j] * (xn - x);
    if (j < 512) c.rs[t * 512 + j] = f2bf(xs);
    else if (j < 1024) c.ks[t * 512 + j - 512] = f2bf(xs);
    else if (j < 1536) c.vs[t * 512 + j - 1024] = f2bf(xs);
    else if (j < 1632) c.lin[t * NLORA + (j - 1536)] = f2bf(tanhf(xs));
    else if (j < 1728) c.lin[t * NLORA + (j - 1536)] = f2bf(xs);
    else c.lin[t * NLORA + (j - 1536)] = f2bf(sigmoidf_(xs));
}
HD void el_rwkv_lora(const Ctx& c, long idx) {
    const int ch = (int)(idx & 511); const long t = idx >> 9;
    const bf16* li = c.lin + t * NLORA;
    float wl = 0.f, al = 0.f, g = 0.f;
    for (int i = 0; i < 96; ++i) { wl += bf2f(li[i]) * c.w2[i * 512 + ch]; al += bf2f(li[96 + i]) * c.a2[i * 512 + ch]; }
    for (int i = 0; i < 256; ++i) g += bf2f(li[192 + i]) * c.g2[i * 512 + ch];
    c.gg[t * 512 + ch] = f2bf(g);
    const float k = bf2f(c.ks[t * 512 + ch]), ka = c.k_a[ch];
    c.kk[t * 512 + ch] = f2bf(k * c.k_k[ch]);
    {   const float dec = expf(-0.6065306597126334f * sigmoidf_(c.w0[ch] + wl)); const float a = sigmoidf_(c.a0[ch] + al);
        c.wf[t * 512 + ch] = dec; c.kdf[t * 512 + ch] = f2bf(k * (1.f + (a - 1.f) * ka)); c.akf[t * 512 + ch] = f2bf(a); }
    {   const float dec = expf(-0.6065306597126334f * sigmoidf_(c.w0[512 + ch] + wl)); const float a = sigmoidf_(c.a0[512 + ch] + al);
        c.wb[t * 512 + ch] = dec; c.kdb[t * 512 + ch] = f2bf(k * (1.f + (a - 1.f) * ka)); c.akb[t * 512 + ch] = f2bf(a); }
}
HD void el_rwkv_kk(const Ctx& c, long idx) {
    const int h = (int)(idx & 7); const long t = idx >> 3; const size_t o = (size_t)t * 512 + h * 64;
    float ss = 0.f;
    for (int d = 0; d < 64; ++d) { const float v = bf2f(c.kk[o + d]); ss += v * v; }
    const float n = 1.f / sqrtf(ss + 1e-12f);
    for (int d = 0; d < 64; ++d) { const float v = bf2f(c.kk[o + d]) * n; c.kk[o + d] = f2bf(v);
        c.akf[o + d] = f2bf(bf2f(c.akf[o + d]) * v); c.akb[o + d] = f2bf(bf2f(c.akb[o + d]) * v); }
}
HD void el_sgu_prep(const Ctx& c, long t) {
    bf16* v = c.proj + (size_t)t * NPROJ + OFF_C + 512;
    float s = 0.f;
    for (int j = 0; j < 512; ++j) s += geluf_(bf2f(v[j]));
    const float mean = s * (1.f / 512.f); float q = 0.f;
    for (int j = 0; j < 512; ++j) { const float d = geluf_(bf2f(v[j])) - mean; q += d * d; }
    const float rstd = 1.f / sqrtf(q * (1.f / 512.f) + NORM_EPS);
    for (int j = 0; j < 512; ++j) v[j] = f2bf((geluf_(bf2f(v[j])) - mean) * rstd * c.sgu_g[j] + c.sgu_b[j]);
}

HD void el_ret_kv(const Ctx& c, long idx) {
    const int e = (int)(idx & 63), d = (int)((idx >> 6) & 63); long r = idx >> 12;
    const int ch = (int)(r % NC); r /= NC; const int dir = (int)(r & 1); r >>= 1; const int h = (int)(r & 7); const int b = (int)(r >> 3);
    const float lg = logsigmoidf_(c.gam[dir * 8 + h]);
    const bf16* base = c.proj + ((size_t)b * SEQ + (size_t)ch * 128) * NPROJ + OFF_A + h * 64;
    float kv = 0.f;
    for (int m = 0; m < 128; ++m) { const float dec = expf(lg * (float)(dir == 0 ? 127 - m : m));
        kv += dec * bf2f(base[(size_t)m * NPROJ + 512 + d]) * bf2f(base[(size_t)m * NPROJ + 1024 + e]); }
    c.rkv[idx] = kv;
}
HD void el_dil_attn(const Ctx& c, long idx) {
    const int h = (int)(idx & 7); const long t = idx >> 3; const int s = (int)(t % SEQ); const long tb = t - s;
    const bf16* qp = c.proj + (size_t)t * NPROJ + OFF_D + h * 64;
    float o[64];
#pragma unroll
    for (int i = 0; i < 64; ++i) o[i] = 0.f;
    float m = -1e30f, l = 0.f;
    for (int br = 0; br < 3; ++br) {
        const int dil = br == 0 ? 1 : (br == 1 ? 4 : 16);
        for (int j = -64; j <= 64; ++j) {
            const int sp = s + dil * j; if (sp < 0 || sp >= SEQ) continue;
            asm volatile("" ::: "memory");
            const bf16* kp = c.proj + (size_t)(tb + sp) * NPROJ + OFF_D + 512 + h * 64; const bf16* vp = kp + 512;
            float sc = 0.f;
#pragma unroll
            for (int i = 0; i < 64; ++i) sc += bf2f(qp[i]) * bf2f(kp[i]);
            const float mn = sc > m ? sc : m, scale = expf(m - mn), p = expf(sc - mn);
            l = l * scale + p; m = mn;
#pragma unroll
            for (int i = 0; i < 64; ++i) o[i] = o[i] * scale + p * bf2f(vp[i]);
        }
    }
    const float il = 1.f / l; bf16* y = c.ycat + (size_t)t * 2048 + 1536 + h * 64;
#pragma unroll
    for (int i = 0; i < 64; ++i) y[i] = f2bf(o[i] * il);
}
HD void el_dil_combine(const bf16* dpo, const float* dml, bf16* ycat, long idx) {
    const int h = (int)(idx & 7); const long t = idx >> 3;
    float m[3], l[3];
#pragma unroll
    for (int br = 0; br < 3; ++br) { const float* mp = dml + (((size_t)br * T + t) * 8 + h) * 2; m[br] = mp[0]; l[br] = mp[1]; }
    const float M = fmaxf(m[0], fmaxf(m[1], m[2]));
    float wgt[3], den = 0.f;
#pragma unroll
    for (int br = 0; br < 3; ++br) { wgt[br] = expf(m[br] - M) * l[br]; den += wgt[br]; }
    const float inv = 1.f / den;
    bf16* y = ycat + (size_t)t * 2048 + 1536 + h * 64;
    for (int i = 0; i < 64; ++i) { float a = 0.f;
#pragma unroll
        for (int br = 0; br < 3; ++br) a += wgt[br] * bf2f(dpo[((size_t)br * T + t) * 512 + h * 64 + i]);
        y[i] = f2bf(a * inv); }
}
HD void el_sgu_main(const Ctx& c, long idx) {
    const int j = (int)(idx & 511); const long t = idx >> 9; const int s = (int)(t % SEQ), p = s & 127, g = j >> 6; const long t0 = t - p;
    const float* w = c.sgu_w + ((size_t)g * 128 + p) * 128;
    const bf16* v = c.proj + (size_t)t0 * NPROJ + OFF_C + 512 + j;
    float acc = 0.f;
    for (int q = 0; q < 128; ++q) acc += w[q] * bf2f(v[(size_t)q * NPROJ]);
    const float u = geluf_(bf2f(c.proj[(size_t)t * NPROJ + OFF_C + j]));
    c.ycat[(size_t)t * 2048 + 1024 + j] = f2bf(u * (acc + c.sgu_bias[g * 128 + p]));
}
HD void el_ret_scan(const Ctx& c, long idx) {
    const int de = (int)(idx & 4095); const long r = idx >> 12; const int dir = (int)(r & 1), h = (int)((r >> 1) & 7);
    const float cd = expf(128.f * logsigmoidf_(c.gam[dir * 8 + h]));
    float S = 0.f;
    for (int k = 0; k < NC; ++k) { const int ch = dir == 0 ? k : NC - 1 - k; const size_t o = ((size_t)r * NC + ch) * 4096 + de; c.rsp[o] = S; S = S * cd + c.rkv[o]; }
}
HD void el_rwkv_scan(const Ctx& c, long idx) {
    const int row = (int)(idx & 63); const long r = idx >> 6; const int dir = (int)(r & 1), h = (int)((r >> 1) & 7), b = (int)(r >> 4);
    const float* W = dir ? c.wb : c.wf; const bf16* KD = dir ? c.kdb : c.kdf; const bf16* AK = dir ? c.akb : c.akf; bf16* Y = dir ? c.yb : c.yf;
    float S[64];
#pragma unroll
    for (int i = 0; i < 64; ++i) S[i] = 0.f;
    for (int k = 0; k < SEQ; ++k) {
        asm volatile("" ::: "memory");
        const int s = dir ? SEQ - 1 - k : k; const size_t o = ((size_t)b * SEQ + s) * 512 + h * 64;
        float sk = 0.f;
#pragma unroll
        for (int q = 0; q < 4; ++q) { asm volatile("" ::: "memory");
#pragma unroll
            for (int i = 16 * q; i < 16 * q + 16; ++i) sk += S[i] * bf2f(c.kk[o + i]); }
        const float v = bf2f(c.vs[o + row]); float y = 0.f;
#pragma unroll
        for (int q = 0; q < 4; ++q) { asm volatile("" ::: "memory");
#pragma unroll
            for (int i = 16 * q; i < 16 * q + 16; ++i) { S[i] = S[i] * W[o + i] - sk * bf2f(AK[o + i]) + v * bf2f(KD[o + i]); y += S[i] * bf2f(c.rs[o + i]); } }
        Y[o + row] = f2bf(y);
    }
}
HD void el_ret_out(const Ctx& c, long idx) {
    const int h = (int)(idx & 7); const long t = idx >> 3; const int s = (int)(t % SEQ), n = s & 127, ch = s >> 7; const int b = (int)(t / SEQ);
    const float lgf = logsigmoidf_(c.gam[h]), lgb = logsigmoidf_(c.gam[8 + h]);
    const bf16* qp = c.proj + (size_t)t * NPROJ + OFF_A + h * 64;
    float o[64];
#pragma unroll
    for (int i = 0; i < 64; ++i) o[i] = 0.f;
    const bf16* kb = c.proj + (size_t)(t - n) * NPROJ + OFF_A + 512 + h * 64;
    for (int m = 0; m < 128; ++m) {
        asm volatile("" ::: "memory");
        const bf16* kp = kb + (size_t)m * NPROJ; const bf16* vp = kp + 512;
        float sc = 0.f;
#pragma unroll
        for (int i = 0; i < 64; ++i) sc += bf2f(qp[i]) * bf2f(kp[i]);
        sc *= m <= n ? expf(lgf * (float)(n - m)) : expf(lgb * (float)(m - n));
#pragma unroll
        for (int i = 0; i < 64; ++i) o[i] += sc * bf2f(vp[i]);
    }
    const float qdf = expf(lgf * (float)(n + 1)), qdb = expf(lgb * (float)(128 - n));
    const float* Sf = c.rsp + ((size_t)((b * 8 + h) * 2 + 0) * NC + ch) * 4096; const float* Sb = c.rsp + ((size_t)((b * 8 + h) * 2 + 1) * NC + ch) * 4096;
    for (int d = 0; d < 64; ++d) { asm volatile("" ::: "memory"); const float qd = bf2f(qp[d]); const float a = qd * qdf, bb = qd * qdb;
#pragma unroll
        for (int i = 0; i < 64; ++i) o[i] += a * Sf[d * 64 + i] + bb * Sb[d * 64 + i]; }
    float mu = 0.f;
#pragma unroll
    for (int i = 0; i < 64; ++i) mu += o[i];
    mu *= (1.f / 64.f); float var = 0.f;
#pragma unroll
    for (int i = 0; i < 64; ++i) { const float d = o[i] - mu; var += d * d; }
    const float rstd = 1.f / sqrtf(var * (1.f / 64.f) + GN_EPS);
    const bf16* gp = c.proj + (size_t)t * NPROJ + OFF_A + 1536 + h * 64; bf16* y = c.ycat + (size_t)t * 2048 + h * 64;
    for (int i = 0; i < 64; i += 8) { asm volatile("" ::: "memory");
#pragma unroll
        for (int j = 0; j < 8; ++j) y[i + j] = f2bf(siluf_(bf2f(gp[i + j])) * ((o[i + j] - mu) * rstd * c.ret_g[h * 64 + i + j])); }
}
HD void el_rwkv_fin(const Ctx& c, long idx) {
    const int h = (int)(idx & 7); const long t = idx >> 3; const size_t o = (size_t)t * 512 + h * 64;
    float mu = 0.f, bonus = 0.f;
    for (int i = 0; i < 64; ++i) { mu += bf2f(c.yf[o + i]) + bf2f(c.yb[o + i]); bonus += bf2f(c.rs[o + i]) * bf2f(c.ks[o + i]) * c.r_k[h * 64 + i]; }
    mu *= (1.f / 64.f); float var = 0.f;
    for (int i = 0; i < 64; ++i) { const float d = bf2f(c.yf[o + i]) + bf2f(c.yb[o + i]) - mu; var += d * d; }
    const float rstd = 1.f / sqrtf(var * (1.f / 64.f) + GN_EPS);
    bf16* out = c.ycat + (size_t)t * 2048 + 512 + h * 64;
    for (int i = 0; i < 64; ++i) { const float y = bf2f(c.yf[o + i]) + bf2f(c.yb[o + i]);
        out[i] = f2bf(((y - mu) * rstd * c.ln_g[h * 64 + i] + bonus * bf2f(c.vs[o + i])) * bf2f(c.gg[o + i])); }
}
HD void route_select(const float (&lg)[4], const float (&le)[32], const float* bg, const float* be, int& e1, int& e2, float& g1, float& g2) {
    float l[4]; float mx = -1e30f; int gi = 0;
#pragma unroll
    for (int i = 0; i < 4; ++i) { l[i] = lg[i] + bg[i]; if (l[i] > mx) { mx = l[i]; gi = i; } }
    float den = 0.f;
#pragma unroll
    for (int i = 0; i < 4; ++i) den += expf(l[i] - mx);
    const float gtop = 1.f / den;
    float el[8];
#pragma unroll
    for (int i = 0; i < 8; ++i) { float v = 0.f;
#pragma unroll
        for (int g = 0; g < 4; ++g) v = (g == gi) ? le[g * 8 + i] + be[g * 8 + i] : v;
        el[i] = v; }
    float m1 = -1e30f, m2 = -1e30f; int i1 = 0, i2 = 0;
#pragma unroll
    for (int i = 0; i < 8; ++i) { if (el[i] > m1) { m2 = m1; i2 = i1; m1 = el[i]; i1 = i; } else if (el[i] > m2) { m2 = el[i]; i2 = i; } }
    const float p2 = expf(m2 - m1);
    g1 = gtop / (1.f + p2); g2 = gtop * p2 / (1.f + p2); e1 = gi * 8 + i1; e2 = gi * 8 + i2;
}

#ifndef KB_HOST_ONLY
namespace pg8 {
#define PG8_LAS __attribute__((address_space(3)))
typedef unsigned short bf16_t;
typedef short bf16x8 __attribute__((ext_vector_type(8)));
typedef float f32x4 __attribute__((ext_vector_type(4)));
typedef unsigned u32x4 __attribute__((ext_vector_type(4)));
constexpr int BM = 256, BK = 64, HALF = 128, HTB = HALF * BK * 2, STAGE_BYTES = 8 * HTB, NXCD = 8, WGM = 8;
__host__ __device__ __forceinline__ int lds_byte(int r, int c) { const int st = (r >> 4) * 2 + (c >> 5), rr = r & 15, cc = c & 31, ob = rr * 64 + cc * 2; return st * 1024 + (ob ^ (((ob >> 9) & 1) << 5)); }
__host__ __device__ __forceinline__ void stage_rc(int b, int& R, int& C) { const int st = b / 1024, sb = b % 1024, swz = sb ^ (((sb >> 9) & 1) << 5); R = (st >> 1) * 16 + swz / 64; C = (st & 1) * 32 + (swz % 64) / 2; }
__host__ __device__ __forceinline__ int perm32(int rho) { const int n = rho >> 4, i = rho & 15; return 8 * (i >> 2) + 4 * n + (i & 3); }
struct Unit { int pm, pn, pe; };
struct Gemm { const bf16_t* A; const bf16_t* Bt; int M, N, K; size_t bstride; };
template <int M, int N> struct StaticOrder {
    static constexpr int nM = M / BM, nN = N / BM, nwg = nM * nN;
    int G, c;
    __host__ __device__ void init(int G_, int c_) { G = G_; c = c_; }
    __host__ __device__ __forceinline__ bool next(int i, Unit& u) const {
        const int L = i * G + c; if (L >= nwg) return false;
        int wgid = L; { constexpr int q = nwg / NXCD, r = nwg % NXCD; const int xcd = wgid % NXCD, off = wgid / NXCD; wgid = (xcd < r ? xcd * (q + 1) : r * (q + 1) + (xcd - r) * q) + off; }
        constexpr int nig = WGM * nN; const int gid = wgid / nig, fm = gid * WGM, gsz = (nM - fm) < WGM ? (nM - fm) : WGM;
        u.pm = fm + ((wgid % nig) % gsz); u.pn = (wgid % nig) / gsz; u.pe = 0; return true;
    }
    __device__ __forceinline__ void a_ready(const Unit&) const {}
    __device__ __forceinline__ void done(const Unit&) const {}
};
template <int NN> struct MoeOrder {
    int G, c, ntiles; const PG8_LAS int* tile_exp;
    __device__ __forceinline__ bool next(int i, Unit& u) const {
        const int L = i * G + c; if (L >= ntiles * NN) return false;
        u.pm = L / NN; u.pn = L % NN; u.pe = __builtin_amdgcn_readfirstlane(tile_exp[u.pm]); return true;
    }
    __device__ __forceinline__ void a_ready(const Unit&) const {}
    __device__ __forceinline__ void done(const Unit&) const {}
};
__device__ __forceinline__ unsigned cvt_pk_bf16(float lo, float hi) { unsigned r; asm volatile("v_cvt_pk_bf16_f32 %0, %1, %2" : "=v"(r) : "v"(lo), "v"(hi)); return r; }
struct EpiBf16 {
    static constexpr bool PERM = true, AFTER_DRAIN = false;
    bf16_t* O; int ldc;
    __device__ __forceinline__ void operator()(const f32x4 (&acc)[2][2][4][2], const Unit& u, int wr, int wc, int fr, int fq) const {
        const int row0 = u.pm * BM + wr * 64 + fr, col0 = u.pn * BM + wc * 32 + 8 * fq;
#pragma unroll
        for (int ai = 0; ai < 2; ++ai)
#pragma unroll
            for (int m = 0; m < 4; ++m) { bf16_t* rowp = O + (size_t)(row0 + ai * HALF + m * 16) * ldc + col0;
#pragma unroll
                for (int bj = 0; bj < 2; ++bj) { const f32x4 v0 = acc[ai][bj][m][0], v1 = acc[ai][bj][m][1];
                    u32x4 w; w.x = cvt_pk_bf16(v0[0], v0[1]); w.y = cvt_pk_bf16(v0[2], v0[3]); w.z = cvt_pk_bf16(v1[0], v1[1]); w.w = cvt_pk_bf16(v1[2], v1[3]);
                    *(u32x4*)(rowp + bj * HALF) = w; } }
    }
};
struct EpiResF32 {
    static constexpr bool PERM = false, AFTER_DRAIN = false;
    const float* base; float* out; int ldc;
    __device__ __forceinline__ void operator()(const f32x4 (&acc)[2][2][4][2], const Unit& u, int wr, int wc, int fr, int fq) const {
        const int row0 = u.pm * BM + wr * 64 + fr, col0 = u.pn * BM + wc * 32 + 4 * fq;
#pragma unroll
        for (int ai = 0; ai < 2; ++ai)
#pragma unroll
            for (int m = 0; m < 4; ++m) { const size_t off = (size_t)(row0 + ai * HALF + m * 16) * ldc + col0;
#pragma unroll
                for (int bj = 0; bj < 2; ++bj)
#pragma unroll
                    for (int n = 0; n < 2; ++n) { const f32x4 bs = *(const f32x4*)(base + off + bj * HALF + n * 16); *(f32x4*)(out + off + bj * HALF + n * 16) = bs + acc[ai][bj][m][n]; } }
    }
};
struct EpiSwiGLU {
    static constexpr bool PERM = true, AFTER_DRAIN = false;
    bf16_t* O; int ldc;
    __device__ __forceinline__ void operator()(const f32x4 (&acc)[2][2][4][2], const Unit& u, int wr, int wc, int fr, int fq) const {
        const int row0 = u.pm * BM + wr * 64 + fr, col0 = u.pn * HALF + wc * 32 + 8 * fq;
#pragma unroll
        for (int ai = 0; ai < 2; ++ai)
#pragma unroll
            for (int m = 0; m < 4; ++m) { bf16_t* rowp = O + (size_t)(row0 + ai * HALF + m * 16) * ldc + col0;
                float h[8];
#pragma unroll
                for (int n = 0; n < 2; ++n)
#pragma unroll
                    for (int j = 0; j < 4; ++j) { const float g = acc[ai][0][m][n][j], up = acc[ai][1][m][n][j]; h[n * 4 + j] = g * __builtin_amdgcn_rcpf(1.f + __expf(-g)) * up; }
                u32x4 w; w.x = cvt_pk_bf16(h[0], h[1]); w.y = cvt_pk_bf16(h[2], h[3]); w.z = cvt_pk_bf16(h[4], h[5]); w.w = cvt_pk_bf16(h[6], h[7]);
                *(u32x4*)rowp = w; }
    }
};

template <int KK, class Epi, class Sched, bool ALIGN_EPI = false, bool SP2 = false>
__device__ __forceinline__ void gemm_phase(PG8_LAS unsigned char* lds, const Gemm g, const Sched& S, const Epi& E, const int tid) {
    const int wid = __builtin_amdgcn_readfirstlane(tid >> 6), lane = tid & 63, wr = wid >> 2, wc = wid & 3, fr = lane & 15, fq = lane >> 4;
    constexpr int K = KK, nt = K / BK;
    unsigned voffA[2], voffB[2];
#pragma unroll
    for (int i = 0; i < 2; ++i) { int R, C; stage_rc(tid * 16 + i * 8192, R, C); const int Rb = Epi::PERM ? ((R & ~31) + perm32(R & 31)) : R;
        voffA[i] = (unsigned)(R * K + C) * 2u; voffB[i] = (unsigned)(Rb * K + C) * 2u; }
    constexpr size_t kstep = (size_t)(BK * 2);
    constexpr size_t hstep = (size_t)HALF * K * 2;
    constexpr size_t tstep = 2 * hstep;
    const unsigned ldsw = (unsigned)wid * 1024u;
    const int aoff = lds_byte(wr * 64 + fr, fq * 8), boff = lds_byte(wc * 32 + fr, fq * 8);
#define PG8_SA(b, h) (((b) * 2 + (h)) * HTB)
#define PG8_SB(b, h) ((4 + (b) * 2 + (h)) * HTB)
#define PG8_STAGE(bufoff, gbase, voff) do { _Pragma("unroll") for (int _i = 0; _i < 2; ++_i) \
        __builtin_amdgcn_global_load_lds((const unsigned*)((const char*)(gbase) + (voff)[_i]), (PG8_LAS unsigned*)(lds + (bufoff) + ldsw + _i * 8192), 16, 0, 0); } while (0)
#define PG8_LDA(dst, b, h) do { _Pragma("unroll") for (int m = 0; m < 4; ++m) _Pragma("unroll") for (int k = 0; k < 2; ++k) dst[m][k] = *(const PG8_LAS bf16x8*)(lds + PG8_SA(b, h) + aoff + m * 2048 + k * 1024); } while (0)
#define PG8_LDB(dst, b, h) do { _Pragma("unroll") for (int n = 0; n < 2; ++n) _Pragma("unroll") for (int k = 0; k < 2; ++k) dst[n][k] = *(const PG8_LAS bf16x8*)(lds + PG8_SB(b, h) + boff + n * 2048 + k * 1024); } while (0)
#define PG8_MMA(ai, bj, At, Bt) do { __builtin_amdgcn_s_setprio(1); _Pragma("unroll") for (int m = 0; m < 4; ++m) _Pragma("unroll") for (int n = 0; n < 2; ++n) _Pragma("unroll") for (int k = 0; k < 2; ++k) \
        acc[ai][bj][m][n] = __builtin_amdgcn_mfma_f32_16x16x32_bf16(Bt[n][k], At[m][k], acc[ai][bj][m][n], 0, 0, 0); __builtin_amdgcn_s_setprio(0); } while (0)
#define PG8_WAIT_V(n) asm volatile("s_waitcnt vmcnt(" #n ")" ::: "memory")
#define PG8_WAIT_L(n) asm volatile("s_waitcnt lgkmcnt(" #n ")" ::: "memory")
#define PG8_BAR __builtin_amdgcn_s_barrier()
#define PG8_SCHED __builtin_amdgcn_sched_barrier(0)
    Unit cur, nxt; int ui = 0;
    if (!S.next(0, cur)) return;
    f32x4 acc[2][2][4][2];
#pragma unroll
    for (int a = 0; a < 2; ++a)
#pragma unroll
        for (int b = 0; b < 2; ++b)
#pragma unroll
            for (int m = 0; m < 4; ++m)
#pragma unroll
                for (int n = 0; n < 2; ++n) acc[a][b][m][n] = (f32x4){0.f, 0.f, 0.f, 0.f};
    bf16x8 At[4][2], B0[2][2], B1[2][2];
    const char* cA = (const char*)g.A + (size_t)cur.pm * tstep; const char* cB = (const char*)g.Bt + (size_t)cur.pe * g.bstride + (size_t)cur.pn * tstep;
    S.a_ready(cur);
    if constexpr (SP2) {
        PG8_STAGE(PG8_SB(0, 0), cB, voffB); PG8_STAGE(PG8_SB(0, 1), cB + hstep, voffB); PG8_STAGE(PG8_SA(0, 0), cA, voffA); PG8_STAGE(PG8_SA(0, 1), cA + hstep, voffA);
        if (wr == 1) PG8_BAR;
        PG8_WAIT_V(2); PG8_BAR;
        PG8_STAGE(PG8_SB(1, 0), cB + kstep, voffB); PG8_STAGE(PG8_SA(1, 0), cA + kstep, voffA); PG8_STAGE(PG8_SB(1, 1), cB + hstep + kstep, voffB);
        PG8_WAIT_V(6); PG8_BAR;
    } else {
        PG8_STAGE(PG8_SB(0, 0), cB, voffB); PG8_STAGE(PG8_SA(0, 0), cA, voffA); PG8_STAGE(PG8_SB(0, 1), cB + hstep, voffB); PG8_STAGE(PG8_SA(0, 1), cA + hstep, voffA);
        if (wr == 1) PG8_BAR;
        PG8_WAIT_V(4); PG8_BAR;
        PG8_STAGE(PG8_SB(1, 0), cB + kstep, voffB); PG8_STAGE(PG8_SA(1, 0), cA + kstep, voffA); PG8_STAGE(PG8_SB(1, 1), cB + hstep + kstep, voffB);
        PG8_WAIT_V(6); PG8_BAR;
    }
    for (;;) {
        const bool has_next = S.next(ui + 1, nxt);
        const char* nA = has_next ? (const char*)g.A + (size_t)nxt.pm * tstep : cA; const char* nB = has_next ? (const char*)g.Bt + (size_t)nxt.pe * g.bstride + (size_t)nxt.pn * tstep : cB;
        for (int t = 0; t < nt; t += 2) {
            const bool last = (t == nt - 2);
            const char* a1 = cA + (size_t)(t + 1) * kstep;
            const char* a2 = last ? nA : cA + (size_t)(t + 2) * kstep; const char* b2 = last ? nB : cB + (size_t)(t + 2) * kstep;
            const char* a3 = a2 + kstep; const char* b3 = b2 + kstep;
            if (last && has_next) S.a_ready(nxt);
            if constexpr (SP2) {
            PG8_LDB(B0, 0, 0); PG8_LDB(B1, 0, 1); PG8_SCHED; PG8_LDA(At, 0, 0); PG8_STAGE(PG8_SA(1, 1), a1 + hstep, voffA);
            PG8_WAIT_V(8); PG8_WAIT_L(0); PG8_BAR; PG8_MMA(0, 0, At, B0); PG8_MMA(0, 1, At, B1); PG8_BAR; PG8_SCHED;
            PG8_LDA(At, 0, 1); PG8_STAGE(PG8_SB(0, 0), b2, voffB); PG8_STAGE(PG8_SB(0, 1), b2 + hstep, voffB); PG8_STAGE(PG8_SA(0, 0), a2, voffA);
            PG8_WAIT_V(8); PG8_WAIT_L(0); PG8_BAR; PG8_MMA(1, 0, At, B0); PG8_MMA(1, 1, At, B1); PG8_BAR; PG8_SCHED;
            PG8_LDB(B0, 1, 0); PG8_LDB(B1, 1, 1); PG8_SCHED; PG8_LDA(At, 1, 0); PG8_STAGE(PG8_SA(0, 1), a2 + hstep, voffA);
            PG8_WAIT_V(8); PG8_WAIT_L(0); PG8_BAR; PG8_MMA(0, 0, At, B0); PG8_MMA(0, 1, At, B1); PG8_BAR; PG8_SCHED;
            PG8_LDA(At, 1, 1); PG8_STAGE(PG8_SB(1, 0), b3, voffB); PG8_STAGE(PG8_SB(1, 1), b3 + hstep, voffB); PG8_STAGE(PG8_SA(1, 0), a3, voffA);
            PG8_WAIT_V(8); PG8_WAIT_L(0); PG8_BAR; PG8_MMA(1, 0, At, B0); PG8_MMA(1, 1, At, B1); PG8_BAR; PG8_SCHED;
            } else {
            PG8_LDB(B0, 0, 0); PG8_SCHED; PG8_LDA(At, 0, 0); PG8_STAGE(PG8_SA(1, 1), a1 + hstep, voffA);
            PG8_WAIT_L(8); PG8_BAR; PG8_WAIT_L(0); PG8_MMA(0, 0, At, B0); PG8_BAR; PG8_SCHED;
            PG8_LDB(B1, 0, 1); PG8_STAGE(PG8_SB(0, 0), b2, voffB);
            PG8_BAR; PG8_WAIT_L(0); PG8_MMA(0, 1, At, B1); PG8_BAR;
            PG8_LDA(At, 0, 1); PG8_STAGE(PG8_SA(0, 0), a2, voffA);
            PG8_BAR; PG8_WAIT_L(0); PG8_MMA(1, 0, At, B0); PG8_BAR; PG8_SCHED;
            PG8_STAGE(PG8_SB(0, 1), b2 + hstep, voffB);
            PG8_WAIT_V(6); PG8_BAR; PG8_MMA(1, 1, At, B1); PG8_BAR;
            PG8_LDB(B0, 1, 0); PG8_SCHED; PG8_LDA(At, 1, 0); PG8_STAGE(PG8_SA(0, 1), a2 + hstep, voffA);
            PG8_WAIT_L(8); PG8_BAR; PG8_WAIT_L(0); PG8_MMA(0, 0, At, B0); PG8_BAR; PG8_SCHED;
            PG8_LDB(B1, 1, 1); PG8_STAGE(PG8_SB(1, 0), b3, voffB);
            PG8_BAR; PG8_WAIT_L(0); PG8_MMA(0, 1, At, B1); PG8_BAR;
            PG8_LDA(At, 1, 1); PG8_STAGE(PG8_SA(1, 0), a3, voffA);
            PG8_BAR; PG8_WAIT_L(0); PG8_MMA(1, 0, At, B0); PG8_BAR; PG8_SCHED;
            PG8_STAGE(PG8_SB(1, 1), b3 + hstep, voffB);
            PG8_WAIT_V(6); PG8_BAR; PG8_MMA(1, 1, At, B1); PG8_BAR;
            }
        }
        if constexpr (ALIGN_EPI) { if (wr == 0) PG8_BAR; }
        E(acc, cur, wr, wc, fr, fq); S.done(cur);
        if (!has_next) break;
#pragma unroll
        for (int a = 0; a < 2; ++a)
#pragma unroll
            for (int b = 0; b < 2; ++b)
#pragma unroll
                for (int m = 0; m < 4; ++m)
#pragma unroll
                    for (int n = 0; n < 2; ++n) acc[a][b][m][n] = (f32x4){0.f, 0.f, 0.f, 0.f};
        cur = nxt; cA = nA; cB = nB; ++ui;
        if constexpr (ALIGN_EPI) { if (wr == 1) PG8_BAR; }
    }
    PG8_WAIT_V(0);
    if constexpr (!ALIGN_EPI) { if (wr == 0) PG8_BAR; }
    PG8_BAR;
#undef PG8_SA
#undef PG8_SB
#undef PG8_STAGE
#undef PG8_LDA
#undef PG8_LDB
#undef PG8_MMA
#undef PG8_WAIT_V
#undef PG8_WAIT_L
#undef PG8_BAR
#undef PG8_SCHED
}
}

#define GAS __attribute__((address_space(1)))
#define LAS __attribute__((address_space(3)))
typedef unsigned v4u __attribute__((ext_vector_type(4)));
typedef unsigned v2u __attribute__((ext_vector_type(2)));
typedef float f32x4 __attribute__((ext_vector_type(4)));
#define LDS_WAIT() asm volatile("s_waitcnt lgkmcnt(0)" ::: "memory")
__device__ __forceinline__ unsigned pk2(float lo, float hi) { return (unsigned)f2bf(lo) | ((unsigned)f2bf(hi) << 16); }

#define XB_TMO      128
#define XB_XCNT(j)  (256  + 64 * (j))
#define XB_XSUB(j)  (1280 + 64 * (j))
#define XB_XGEN(j)  (2304 + 64 * (j))
#define XB_TOP      3328
#define XB_TOPGEN   3392
#define XCD_BAR_WORDS 3456
#define XB_SPIN_CAP (1u << 18)
__device__ __forceinline__ unsigned xb_ld(unsigned* p)              { return __hip_atomic_load(p, __ATOMIC_RELAXED, __HIP_MEMORY_SCOPE_AGENT); }
__device__ __forceinline__ unsigned xb_add(unsigned* p, unsigned v) { return __hip_atomic_fetch_add(p, v, __ATOMIC_RELAXED, __HIP_MEMORY_SCOPE_AGENT); }
__device__ __forceinline__ unsigned xb_xcc_id() { return (unsigned)__builtin_amdgcn_s_getreg((3 << 11) | 20) & 0xFu; }
#define XB_SPIN(cond, bar) do { unsigned _sp = 0; while (cond) { __builtin_amdgcn_s_sleep(1); \
    if ((++_sp & 255u) == 0u) { if (xb_ld(&(bar)[XB_TMO])) break; if (_sp > XB_SPIN_CAP) { atomicAdd(&(bar)[XB_TMO], 1u); break; } } } } while (0)
struct XcdBarrier { unsigned* bar; unsigned x; volatile LAS unsigned* st; };
__device__ __forceinline__ XcdBarrier xcd_barrier_post(unsigned* bar, volatile LAS unsigned* st) {
    XcdBarrier b; b.bar = bar; b.x = xb_xcc_id(); b.st = st;
    if (threadIdx.x == 0) (void)xb_add(&bar[XB_XCNT(b.x)], 1u);
    return b;
}
__device__ __forceinline__ void xcd_barrier_complete(unsigned* bar, unsigned x, unsigned& nloc, unsigned& nx) {
    const unsigned G = gridDim.x * gridDim.y * gridDim.z;
    unsigned sum, cnt, mine, sp = 0u;
    for (;;) {
        sum = 0u; cnt = 0u; mine = 0u;
#pragma unroll
        for (unsigned j = 0; j < 16; ++j) { const unsigned c = xb_ld(&bar[XB_XCNT(j)]); sum += c; cnt += (c > 0u) ? 1u : 0u; mine = (j == x) ? c : mine; }
        if (sum == G) break;
        __builtin_amdgcn_s_sleep(1);
        if ((++sp & 255u) == 0u) { if (xb_ld(&bar[XB_TMO])) break; if (sp > XB_SPIN_CAP) { atomicAdd(&bar[XB_TMO], 1u); break; } }
    }
    nloc = mine > 0u ? mine : 1u; nx = cnt > 0u ? cnt : 1u;
}
__device__ __forceinline__ void xcd_barrier(const XcdBarrier& b) {
    asm volatile("s_waitcnt vmcnt(0)" ::: "memory");
    __syncthreads();
    if (threadIdx.x == 0) {
        unsigned* bar = b.bar;
        __builtin_amdgcn_s_waitcnt(0);
        unsigned nloc = b.st[0], nx = b.st[1];
        if (nloc == 0u) { xcd_barrier_complete(bar, b.x, nloc, nx); b.st[0] = nloc; b.st[1] = nx; }
        const unsigned old = xb_add(&bar[XB_XSUB(b.x)], 1u);
        const unsigned gen = old / nloc;
        if (old + 1u == (gen + 1u) * nloc) {
            __builtin_amdgcn_fence(__ATOMIC_RELEASE, "agent");
            asm volatile("s_waitcnt vmcnt(0)" ::: "memory");
            const unsigned og = xb_add(&bar[XB_TOP], 1u);
            const unsigned tg = og / nx;
            if (og + 1u == (tg + 1u) * nx) xb_add(&bar[XB_TOPGEN], 1u);
            else XB_SPIN(xb_ld(&bar[XB_TOPGEN]) == tg, bar);
            __builtin_amdgcn_fence(__ATOMIC_ACQUIRE, "agent");
            xb_add(&bar[XB_XGEN(b.x)], 1u);
            asm volatile("s_waitcnt vmcnt(0)" ::: "memory");
        } else {
            XB_SPIN(xb_ld(&bar[XB_XGEN(b.x)]) == gen, bar);
            __builtin_amdgcn_fence(__ATOMIC_ACQUIRE, "agent");
            asm volatile("s_waitcnt vmcnt(0)" ::: "memory");
        }
    }
    __syncthreads();
}

constexpr int RING_BYTES = 131072;
constexpr int TAB_OFF = RING_BYTES;
constexpr int TAB_CNT = TAB_OFF, TAB_ROWBASE = TAB_OFF + 128, TAB_NT = TAB_OFF + 256, TAB_TEXP = TAB_OFF + 272;
constexpr int MISC_OFF = TAB_OFF + 4096;
constexpr int PTAB_OFF = MISC_OFF + 16;
constexpr int LDS_BYTES = 147456;
static_assert(TAB_TEXP + MOE_MAXTILES * 4 <= MISC_OFF && PTAB_OFF + 32 * 8 <= LDS_BYTES, "LDS map");

__device__ __forceinline__ float wave_sum(float v, int lane) {
#pragma unroll
    for (int o = 1; o < 64; o <<= 1) v += __builtin_bit_cast(float, __builtin_amdgcn_ds_bpermute((lane ^ o) << 2, __builtin_bit_cast(int, v)));
    return v;
}
__device__ __forceinline__ void transpose_item(const float* W, int K, int N, bf16* WT, int k0, int n0, int drow0, LAS float* scr, int lane) {
#pragma unroll 8
    for (int i = 0; i < 32; ++i) { const int kk = 2 * i + (lane >> 5); scr[kk * 33 + (lane & 31)] = W[(size_t)(k0 + kk) * N + n0 + (lane & 31)]; }
    LDS_WAIT(); asm volatile("" ::: "memory");
    const int c = lane & 7;
#pragma unroll
    for (int j = 0; j < 4; ++j) { const int n = (lane >> 3) + 8 * j; const LAS float* s = scr + (8 * c) * 33 + n;
        v4u o; o.x = pk2(s[0 * 33], s[1 * 33]); o.y = pk2(s[2 * 33], s[3 * 33]); o.z = pk2(s[4 * 33], s[5 * 33]); o.w = pk2(s[6 * 33], s[7 * 33]);
        *(GAS v4u*)(WT + (size_t)(drow0 + n) * K + k0 + 8 * c) = o; }
    LDS_WAIT(); asm volatile("" ::: "memory");
}


__device__ __forceinline__ void build_moe_tables(LAS unsigned char* lds, const unsigned* cnt_words, const int tid) {
    LAS int* tcnt = (LAS int*)(lds + TAB_CNT); LAS int* trb = (LAS int*)(lds + TAB_ROWBASE); LAS int* tnt = (LAS int*)(lds + TAB_NT); LAS int* texp = (LAS int*)(lds + TAB_TEXP);
    __syncthreads();
    if (tid < NEXP) tcnt[tid] = (int)__hip_atomic_load(cnt_words + 64 * tid, __ATOMIC_RELAXED, __HIP_MEMORY_SCOPE_AGENT);
    __syncthreads();
    if (tid == 0) { int tile = 0;
#pragma unroll 1
        for (int e = 0; e < NEXP; ++e) { int c = tcnt[e]; if (c > 2 * T) c = 2 * T; int nt = (c + 255) >> 8; if (tile + nt > MOE_MAXTILES) nt = MOE_MAXTILES - tile; trb[e] = tile * 256;
#pragma unroll 1
            for (int i = 0; i < nt; ++i) texp[tile + i] = e;
            tile += nt; }
        tnt[0] = tile; }
    __syncthreads();
}

struct Args { const void* in[30]; float* out; unsigned char* ws; int layer, pad; };
__device__ __forceinline__ Ctx make_ctx(const Args& args, unsigned char* ws, int l) {
    Ctx c;
    c.pos = (const int*)args.in[1];
    c.gam = (const float*)args.in[5] + l * 16; c.ret_g = (const float*)args.in[6] + l * 512; c.mu = (const float*)args.in[7] + l * 2 * B_COLS;
    c.w0 = (const float*)args.in[8] + l * 1024; c.w2 = (const float*)args.in[9] + l * 96 * 512; c.a0 = (const float*)args.in[10] + l * 1024; c.a2 = (const float*)args.in[11] + l * 96 * 512;
    c.g2 = (const float*)args.in[12] + l * 256 * 512; c.k_k = (const float*)args.in[13] + l * 512; c.k_a = (const float*)args.in[14] + l * 512; c.r_k = (const float*)args.in[15] + l * 512;
    c.ln_g = (const float*)args.in[16] + l * 512; c.sgu_g = (const float*)args.in[17] + l * 512; c.sgu_b = (const float*)args.in[18] + l * 512;
    c.sgu_w = (const float*)args.in[19] + (size_t)l * 8 * 128 * 128; c.sgu_bias = (const float*)args.in[20] + l * 1024;
    c.proj = (bf16*)(ws + WS_PROJ); c.ycat = (bf16*)(ws + WS_ACT);
    c.rs = (bf16*)(ws + WS_RS); c.ks = (bf16*)(ws + WS_KS); c.vs = (bf16*)(ws + WS_VS); c.kk = (bf16*)(ws + WS_KK); c.gg = (bf16*)(ws + WS_GG);
    c.kdf = (bf16*)(ws + WS_KDF); c.kdb = (bf16*)(ws + WS_KDB); c.akf = (bf16*)(ws + WS_AKF); c.akb = (bf16*)(ws + WS_AKB); c.yf = (bf16*)(ws + WS_YF); c.yb = (bf16*)(ws + WS_YB);
    c.lin = (bf16*)(ws + WS_LIN); c.wf = (float*)(ws + WS_WF); c.wb = (float*)(ws + WS_WB); c.rkv = (float*)(ws + WS_RKV); c.rsp = (float*)(ws + WS_RSP);
    return c;
}


#define ROW_LOAD(v, ptr) _Pragma("unroll") for (int j = 0; j < 8; ++j) v[j] = ((const GAS f32x4*)(ptr))[lane + 64 * j]
__device__ __forceinline__ void row_add_moe(f32x4 (&v)[8], const bf16* yp, size_t R1, size_t R2, float g1, float g2, int lane) {
#pragma unroll
    for (int j = 0; j < 8; ++j) { const v2u a = ((const GAS v2u*)(yp + R1 * DM))[lane + 64 * j], b = ((const GAS v2u*)(yp + R2 * DM))[lane + 64 * j];
        v[j].x += g1 * bf2f((bf16)(a.x & 0xffff)) + g2 * bf2f((bf16)(b.x & 0xffff)); v[j].y += g1 * bf2f((bf16)(a.x >> 16)) + g2 * bf2f((bf16)(b.x >> 16));
        v[j].z += g1 * bf2f((bf16)(a.y & 0xffff)) + g2 * bf2f((bf16)(b.y & 0xffff)); v[j].w += g1 * bf2f((bf16)(a.y >> 16)) + g2 * bf2f((bf16)(b.y >> 16)); }
}
__device__ __forceinline__ float row_rstd(const f32x4 (&v)[8], int lane) {
    float ss = 0.f;
#pragma unroll
    for (int j = 0; j < 8; ++j) ss += (v[j].x * v[j].x + v[j].y * v[j].y) + (v[j].z * v[j].z + v[j].w * v[j].w);
    return 1.f / sqrtf(wave_sum(ss, lane) * (1.f / DM) + NORM_EPS);
}
#define SEAM(k) do { if constexpr (KSEL < 0) { XcdBarrier b_ = bar; unsigned blo_ = __builtin_amdgcn_readfirstlane((unsigned)(unsigned long long)b_.bar), bhi_ = __builtin_amdgcn_readfirstlane((unsigned)((unsigned long long)b_.bar >> 32)); \
    asm volatile("" : "+s"(blo_), "+s"(bhi_)); b_.bar = (unsigned*)(((unsigned long long)bhi_ << 32) | blo_); xcd_barrier(b_); } } while (0)
#define PH_ON(k) if constexpr ((KSEL < 0 && KB_EN(k)) || KSEL == (k))
#define PHASE_LOCALS() unsigned char* ws = args.ws; int ll = KSEL < 0 ? l : __builtin_amdgcn_readfirstlane(l); int tid = threadIdx.x; asm volatile("" : "+s"(ws), "+s"(ll), "+v"(tid)); \
    const int lane = tid & 63, wave = __builtin_amdgcn_readfirstlane(tid >> 6); \
    const int G = gridDim.x, bid = blockIdx.x; const long gtid = (long)bid * 512 + tid, gstride = (long)G * 512; const int gw = bid * 8 + wave, NGW = G * 8; \
    (void)gtid; (void)gstride; (void)gw; (void)NGW; (void)ll; (void)lane


typedef short bf16x8 __attribute__((ext_vector_type(8)));
typedef short s16x4 __attribute__((ext_vector_type(4)));
typedef short v4i16_t __attribute__((ext_vector_type(4)));
#define MMA16(a, b, c) __builtin_amdgcn_mfma_f32_16x16x32_bf16((a), (b), (c), 0, 0, 0)
__device__ __forceinline__ bf16x8 frag_row(const LAS bf16* X, int ld, int r0, int c0, int fr, int fq) { return *(const LAS bf16x8*)(X + (r0 + fr) * ld + c0 + 8 * fq); }
__device__ __forceinline__ s16x4 tr4(const LAS bf16* X, int ld, int r0, int c0, int fr) { return __builtin_bit_cast(s16x4, __builtin_amdgcn_ds_read_tr16_b64_v4i16((LAS v4i16_t*)(X + (r0 + (fr >> 2)) * ld + c0 + 4 * (fr & 3)))); }
__device__ __forceinline__ bf16x8 frag_col(const LAS bf16* X, int ld, int k0, int c0, int fr, int fq) {
    const s16x4 a = tr4(X, ld, k0 + 8 * fq, c0, fr), b = tr4(X, ld, k0 + 8 * fq + 4, c0, fr);
    return (bf16x8){a[0], a[1], a[2], a[3], b[0], b[1], b[2], b[3]}; }
__device__ __forceinline__ unsigned cvtpk(float lo, float hi) { unsigned r; asm("v_cvt_pk_bf16_f32 %0, %1, %2" : "=v"(r) : "v"(lo), "v"(hi)); return r; }
__device__ __forceinline__ float xlane_max4(float v, int lane) {
    v = fmaxf(v, __builtin_bit_cast(float, __builtin_amdgcn_ds_bpermute((lane ^ 16) << 2, __builtin_bit_cast(int, v))));
    v = fmaxf(v, __builtin_bit_cast(float, __builtin_amdgcn_ds_bpermute((lane ^ 32) << 2, __builtin_bit_cast(int, v)))); return v; }
__device__ __forceinline__ float xlane_sum4(float v, int lane) {
    v += __builtin_bit_cast(float, __builtin_amdgcn_ds_bpermute((lane ^ 16) << 2, __builtin_bit_cast(int, v)));
    v += __builtin_bit_cast(float, __builtin_amdgcn_ds_bpermute((lane ^ 32) << 2, __builtin_bit_cast(int, v))); return v; }

constexpr int DIL_LD = 72, DIL_TEAM_BYTES = (64 + 192 + 192) * DIL_LD * 2;
static_assert(2 * DIL_TEAM_BYTES <= RING_BYTES, "dilated attention LDS");
__device__ __forceinline__ void dil_attn_phase(LAS unsigned char* lds, const bf16* proj, bf16* dpo, float* dml, const int tid, const int bid, const int G) {
    const int lane = tid & 63, wave = __builtin_amdgcn_readfirstlane(tid >> 6), team = wave >> 2, w = wave & 3, tt = tid & 255, fr = lane & 15, fq = lane >> 4;
    LAS bf16* Qs = (LAS bf16*)(lds + team * DIL_TEAM_BYTES); LAS bf16* Ks = Qs + 64 * DIL_LD; LAS bf16* Vs = Ks + 192 * DIL_LD;
    constexpr int NITEMS = BATCH * 8 * 3 * 64;
    for (int it0 = bid * 2; it0 < NITEMS; it0 += G * 2) {
        const int it = it0 + team;
        const int blk = it & 63; int r = it >> 6; const int br = r % 3; r /= 3; const int h = r & 7, b = r >> 3;
        const int dil = br == 0 ? 1 : (br == 1 ? 4 : 16), L = SEQ / dil, nb = L / 64, g = blk / nb, n = blk % nb;
        const bf16* base = proj + (size_t)b * SEQ * NPROJ + OFF_D + h * 64;
        __syncthreads();
#pragma unroll
        for (int c = tt; c < 512; c += 256) { const int i = c >> 3, ch = c & 7; const int pos = (64 * n + i) * dil + g;
            *(LAS v4u*)(Qs + i * DIL_LD + ch * 8) = *(const GAS v4u*)(base + (size_t)pos * NPROJ + ch * 8); }
#pragma unroll
        for (int c = tt; c < 1536; c += 256) { const int kr = c >> 3, ch = c & 7; const int kidx = 64 * (n - 1) + kr; const bool ok = kidx >= 0 && kidx < L; const int pos = (ok ? kidx : 0) * dil + g;
            v4u kv = (v4u){0u, 0u, 0u, 0u}, vv = kv;
            if (ok) { kv = *(const GAS v4u*)(base + (size_t)pos * NPROJ + 512 + ch * 8); vv = *(const GAS v4u*)(base + (size_t)pos * NPROJ + 1024 + ch * 8); }
            *(LAS v4u*)(Ks + kr * DIL_LD + ch * 8) = kv; *(LAS v4u*)(Vs + kr * DIL_LD + ch * 8) = vv; }
        __syncthreads();
        bf16x8 qf[2];
#pragma unroll
        for (int ks = 0; ks < 2; ++ks) qf[ks] = frag_row(Qs, DIL_LD, 16 * w, 32 * ks, fr, fq);
        f32x4 sc[12];
#pragma unroll
        for (int kt = 0; kt < 12; ++kt) { sc[kt] = (f32x4){0.f, 0.f, 0.f, 0.f};
#pragma unroll
            for (int ks = 0; ks < 2; ++ks) sc[kt] = MMA16(frag_row(Ks, DIL_LD, 16 * kt, 32 * ks, fr, fq), qf[ks], sc[kt]); }
        const int qi = 64 * n + 16 * w + fr; float mx = -1e30f;
#pragma unroll
        for (int kt = 0; kt < 12; ++kt)
#pragma unroll
            for (int j = 0; j < 4; ++j) { const int ki = 64 * (n - 1) + 16 * kt + 4 * fq + j; const int dd = ki - qi; const bool ok = dd >= -64 && dd <= 64 && ki >= 0 && ki < L;
                sc[kt][j] = ok ? sc[kt][j] : -1e30f; mx = fmaxf(mx, sc[kt][j]); }
        mx = xlane_max4(mx, lane);
        float den = 0.f;
#pragma unroll
        for (int kt = 0; kt < 12; ++kt)
#pragma unroll
            for (int j = 0; j < 4; ++j) { const float p = sc[kt][j] > -1e29f ? __expf(sc[kt][j] - mx) : 0.f; sc[kt][j] = p; den += p; }
        den = xlane_sum4(den, lane);
        f32x4 o[4];
#pragma unroll
        for (int et = 0; et < 4; ++et) o[et] = (f32x4){0.f, 0.f, 0.f, 0.f};
#pragma unroll
        for (int u = 0; u < 6; ++u) {
            const unsigned p0 = cvtpk(sc[2 * u][0], sc[2 * u][1]), p1 = cvtpk(sc[2 * u][2], sc[2 * u][3]), p2 = cvtpk(sc[2 * u + 1][0], sc[2 * u + 1][1]), p3 = cvtpk(sc[2 * u + 1][2], sc[2 * u + 1][3]);
            const bf16x8 pf = __builtin_bit_cast(bf16x8, (v4u){p0, p1, p2, p3});
#pragma unroll
            for (int et = 0; et < 4; ++et) { const s16x4 a = tr4(Vs, DIL_LD, 32 * u + 4 * fq, 16 * et, fr), bq = tr4(Vs, DIL_LD, 32 * u + 16 + 4 * fq, 16 * et, fr);
                o[et] = MMA16(((bf16x8){a[0], a[1], a[2], a[3], bq[0], bq[1], bq[2], bq[3]}), pf, o[et]); }
        }
        const float inv = 1.f / den; const size_t t = (size_t)b * SEQ + (size_t)qi * dil + g;
        bf16* op = dpo + ((size_t)br * T + t) * 512 + h * 64 + 4 * fq;
#pragma unroll
        for (int et = 0; et < 4; ++et) { v2u pk; pk.x = cvtpk(o[et][0] * inv, o[et][1] * inv); pk.y = cvtpk(o[et][2] * inv, o[et][3] * inv); *(GAS v2u*)(op + 16 * et) = pk; }
        if (fq == 0) { float* mp = dml + (((size_t)br * T + t) * 8 + h) * 2; mp[0] = mx; mp[1] = den; }
    }
}

__device__ __forceinline__ float quad_sum(float v) {
    v += __builtin_bit_cast(float, __builtin_amdgcn_update_dpp(0, __builtin_bit_cast(int, v), 0xB1, 0xF, 0xF, true));
    v += __builtin_bit_cast(float, __builtin_amdgcn_update_dpp(0, __builtin_bit_cast(int, v), 0x4E, 0xF, 0xF, true));
    return v;
}
__device__ __forceinline__ void rwkv_scan_quad(const Ctx& c, int unit, int w4, int lane) {
    const int dir = unit & 1, h = (unit >> 1) & 7, b = unit >> 4; const int row = w4 * 16 + (lane >> 2), q = lane & 3;
    const float* W = dir ? c.wb : c.wf; const bf16* KD = dir ? c.kdb : c.kdf; const bf16* AK = dir ? c.akb : c.akf; bf16* Y = dir ? c.yb : c.yf;
    float S[16];
#pragma unroll
    for (int i = 0; i < 16; ++i) S[i] = 0.f;
    for (int k = 0; k < SEQ; ++k) {
        const int s = dir ? SEQ - 1 - k : k; const size_t o = ((size_t)b * SEQ + s) * 512 + h * 64 + q * 16;
        float kkv[16], akv[16], kdv[16], rv[16], wv[16];
        { const v4u a = *(const GAS v4u*)(c.kk + o), bq = *(const GAS v4u*)(c.kk + o + 8);
          const unsigned t[8] = {a.x, a.y, a.z, a.w, bq.x, bq.y, bq.z, bq.w};
#pragma unroll
          for (int i = 0; i < 8; ++i) { kkv[2 * i] = __builtin_bit_cast(float, t[i] << 16); kkv[2 * i + 1] = __builtin_bit_cast(float, t[i] & 0xffff0000u); } }
        { const v4u a = *(const GAS v4u*)(AK + o), bq = *(const GAS v4u*)(AK + o + 8);
          const unsigned t[8] = {a.x, a.y, a.z, a.w, bq.x, bq.y, bq.z, bq.w};
#pragma unroll
          for (int i = 0; i < 8; ++i) { akv[2 * i] = __builtin_bit_cast(float, t[i] << 16); akv[2 * i + 1] = __builtin_bit_cast(float, t[i] & 0xffff0000u); } }
        { const v4u a = *(const GAS v4u*)(KD + o), bq = *(const GAS v4u*)(KD + o + 8);
          const unsigned t[8] = {a.x, a.y, a.z, a.w, bq.x, bq.y, bq.z, bq.w};
#pragma unroll
          for (int i = 0; i < 8; ++i) { kdv[2 * i] = __builtin_bit_cast(float, t[i] << 16); kdv[2 * i + 1] = __builtin_bit_cast(float, t[i] & 0xffff0000u); } }
        { const v4u a = *(const GAS v4u*)(c.rs + o), bq = *(const GAS v4u*)(c.rs + o + 8);
          const unsigned t[8] = {a.x, a.y, a.z, a.w, bq.x, bq.y, bq.z, bq.w};
#pragma unroll
          for (int i = 0; i < 8; ++i) { rv[2 * i] = __builtin_bit_cast(float, t[i] << 16); rv[2 * i + 1] = __builtin_bit_cast(float, t[i] & 0xffff0000u); } }
#pragma unroll
        for (int i = 0; i < 4; ++i) { const f32x4 w4v = *(const GAS f32x4*)(W + o + 4 * i); wv[4 * i] = w4v.x; wv[4 * i + 1] = w4v.y; wv[4 * i + 2] = w4v.z; wv[4 * i + 3] = w4v.w; }
        const float v = bf2f(c.vs[o - q * 16 + row]);
        float sk = 0.f;
#pragma unroll
        for (int i = 0; i < 16; ++i) sk += S[i] * kkv[i];
        sk = quad_sum(sk);
        float y = 0.f;
#pragma unroll
        for (int i = 0; i < 16; ++i) { S[i] = S[i] * wv[i] - sk * akv[i] + v * kdv[i]; y += S[i] * rv[i]; }
        y = quad_sum(y);
        if (q == 0) Y[o + row] = f2bf(y);
    }
}
template <int KSEL>
__device__ __forceinline__ void layer_program(const Args& args, LAS unsigned char* lds, const XcdBarrier& bar, const int l) {
        PH_ON(0) {
            PHASE_LOCALS();
            bf16* WinT = (bf16*)(ws + WS_WIN); bf16* WoutT = (bf16*)(ws + WS_WOUT); bf16* Wgu = (bf16*)(ws + WS_WGU); bf16* WdT = (bf16*)(ws + WS_WD);
            LAS float* scr = (LAS float*)(lds + wave * 16384);
            const float* w_in = (const float*)args.in[3] + (size_t)ll * DM * D_IN; const float* w_out = (const float*)args.in[4] + (size_t)ll * DM * DM;
            const float* wg_ = (const float*)args.in[26] + (size_t)ll * NEXP * DM * DE; const float* wu_ = (const float*)args.in[27] + (size_t)ll * NEXP * DM * DE; const float* wd_ = (const float*)args.in[28] + (size_t)ll * NEXP * DE * DM;
            constexpr int I_IN = (DM / 64) * (D_IN / 32), I_OUT = (DM / 64) * (DM / 32), I_GU = (DM / 64) * (DE / 32), I_D = (DE / 64) * (DM / 32);
            constexpr int NITEMS = I_IN + I_OUT + NEXP * (2 * I_GU + I_D);
            for (int it = gw; it < NITEMS; it += NGW) {
                int r = it;
                if (r < I_IN) { const int nblk = D_IN / 32, kb = r / nblk, nb = r % nblk; transpose_item(w_in, DM, D_IN, WinT, 64 * kb, 32 * nb, 32 * nb, scr, lane); continue; } r -= I_IN;
                if (r < I_OUT) { const int nblk = DM / 32, kb = r / nblk, nb = r % nblk; transpose_item(w_out, DM, DM, WoutT, 64 * kb, 32 * nb, 32 * nb, scr, lane); continue; } r -= I_OUT;
                const int e = r / (2 * I_GU + I_D); r -= e * (2 * I_GU + I_D);
                if (r < 2 * I_GU) { const int up = r >= I_GU ? 1 : 0; r -= up * I_GU; const int nblk = DE / 32, kb = r / nblk, nb = r % nblk, n0 = 32 * nb;
                    transpose_item((up ? wu_ : wg_) + (size_t)e * DM * DE, DM, DE, Wgu + (size_t)e * 1024 * DM, 64 * kb, n0, (n0 >> 7) * 256 + (n0 & 127) + up * 128, scr, lane); continue; }
                r -= 2 * I_GU;
                { const int nblk = DM / 32, kb = r / nblk, nb = r % nblk; transpose_item(wd_ + (size_t)e * DE * DM, DE, DM, WdT + (size_t)e * DM * DE, 64 * kb, 32 * nb, 32 * nb, scr, lane); }
            }
            for (long i = gtid; i < (long)(NPROJ - D_IN) * DM / 8; i += gstride) ((GAS v4u*)(WinT + (size_t)D_IN * DM))[i] = (v4u){0u, 0u, 0u, 0u};
            if (ll > 0) build_moe_tables(lds, (const unsigned*)(ws + WS_CTL) + CW_CNT + (ll - 1) * 2048, tid);
            const LAS int* trb = (const LAS int*)(lds + TAB_ROWBASE);
            const float* x_in = (const float*)args.in[0]; float* xbuf = (float*)(ws + WS_X); bf16* act = (bf16*)(ws + WS_ACT); const bf16* yp = (const bf16*)(ws + WS_YP);
            const unsigned* slot_tok = (const unsigned*)(ws + WS_SLOT); const float* gate_tok = (const float*)(ws + WS_GATE);
            const float* norm1_g = (const float*)args.in[2] + ll * DM;
            for (int m = gw; m < T; m += NGW) {
                f32x4 v[8];
                ROW_LOAD(v, (ll == 0 ? x_in : xbuf) + (size_t)m * DM);
                if (ll > 0) {
                    const unsigned s1 = slot_tok[2 * m], s2 = slot_tok[2 * m + 1]; const float g1 = gate_tok[2 * m], g2 = gate_tok[2 * m + 1];
                    row_add_moe(v, yp, (size_t)(trb[s1 >> 20] + (int)(s1 & 0xfffffu)), (size_t)(trb[s2 >> 20] + (int)(s2 & 0xfffffu)), g1, g2, lane);
#pragma unroll
                    for (int j = 0; j < 8; ++j) ((GAS f32x4*)(xbuf + (size_t)m * DM))[lane + 64 * j] = v[j];
                }
                const float rstd = row_rstd(v, lane);
#pragma unroll
                for (int j = 0; j < 8; ++j) { const f32x4 g = ((const GAS f32x4*)norm1_g)[lane + 64 * j];
                    v2u o; o.x = pk2(v[j].x * rstd * g.x, v[j].y * rstd * g.y); o.y = pk2(v[j].z * rstd * g.z, v[j].w * rstd * g.w);
                    ((GAS v2u*)(act + (size_t)m * DM))[lane + 64 * j] = o; }
            }
        }
        SEAM(0);
        PH_ON(1) {
            PHASE_LOCALS();
            pg8::Gemm g{(const bf16*)(ws + WS_ACT), (const bf16*)(ws + WS_WIN), T, NPROJ, DM, 0}; pg8::StaticOrder<T, NPROJ> S; S.init(G, bid);
            pg8::EpiBf16 E{(bf16*)(ws + WS_PROJ), NPROJ};
            pg8::gemm_phase<DM, pg8::EpiBf16, pg8::StaticOrder<T, NPROJ>, true, true>(lds, g, S, E, tid);
        }
        SEAM(1);
        PH_ON(2) { PHASE_LOCALS(); const Ctx c = make_ctx(args, ws, ll);
            for (long i = gtid; i < (long)T * 256; i += gstride) el_rot_ret(c, i);
            for (long i = gtid; i < (long)T * 256; i += gstride) el_rot_dil(c, i);
            for (long i = gtid; i < (long)T * B_COLS; i += gstride) el_rwkv_shift(c, i);
            for (long i = gtid; i < (long)T; i += gstride) el_sgu_prep(c, i); }
        SEAM(2);
        PH_ON(3) { PHASE_LOCALS(); const Ctx c = make_ctx(args, ws, ll);
            for (long i = gtid; i < (long)T * 512; i += gstride) el_rwkv_lora(c, i);
            for (long i = gtid; i < (long)BATCH * 8 * 2 * NC * 4096; i += gstride) el_ret_kv(c, i);
            for (long i = gtid; i < (long)T * 512; i += gstride) el_sgu_main(c, i);
            dil_attn_phase(lds, c.proj, (bf16*)(ws + WS_DPO), (float*)(ws + WS_DML), tid, bid, G); }
        SEAM(3);
        PH_ON(4) { PHASE_LOCALS(); const Ctx c = make_ctx(args, ws, ll);
            for (long i = gtid; i < (long)T * 8; i += gstride) el_rwkv_kk(c, i);
            for (long i = gtid; i < (long)BATCH * 8 * 2 * 4096; i += gstride) el_ret_scan(c, i); }
        SEAM(4);
        PH_ON(5) { PHASE_LOCALS(); const Ctx c = make_ctx(args, ws, ll);
            for (int u = bid + G * (wave >> 2); u < BATCH * 16; u += G * 2) rwkv_scan_quad(c, u, wave & 3, lane); }
        SEAM(5);
        PH_ON(6) { PHASE_LOCALS(); const Ctx c = make_ctx(args, ws, ll);
            for (long i = gtid; i < (long)T * 8; i += gstride) el_dil_combine((const bf16*)(ws + WS_DPO), (const float*)(ws + WS_DML), c.ycat, i);
            for (long i = gtid; i < (long)T * 8; i += gstride) el_ret_out(c, i);
            for (long i = gtid; i < (long)T * 8; i += gstride) el_rwkv_fin(c, i); }
        SEAM(6);
        PH_ON(7) {
            PHASE_LOCALS();
            pg8::Gemm g{(const bf16*)(ws + WS_ACT), (const bf16*)(ws + WS_WOUT), T, DM, DM, 0}; pg8::StaticOrder<T, DM> S; S.init(G, bid);
            pg8::EpiResF32 E{ll == 0 ? (const float*)args.in[0] : (const float*)(ws + WS_X), (float*)(ws + WS_X), DM};
            pg8::gemm_phase<DM, pg8::EpiResF32, pg8::StaticOrder<T, DM>, true, true>(lds, g, S, E, tid);
        }
        SEAM(7);
        PH_ON(8) {
            PHASE_LOCALS();
            const float* wg = (const float*)args.in[22] + (size_t)ll * DM * 4; const float* bg = (const float*)args.in[23] + ll * 4;
            const float* we = (const float*)args.in[24] + (size_t)ll * DM * 32; const float* be = (const float*)args.in[25] + ll * 32;
            const float* norm2_g = (const float*)args.in[21] + ll * DM;
            const float* xbuf = (const float*)(ws + WS_X); bf16* act = (bf16*)(ws + WS_ACT);
            unsigned* cnt_cur = (unsigned*)(ws + WS_CTL) + CW_CNT + ll * 2048;
            int* tok_of = (int*)(ws + WS_TOK); unsigned* slot_tok = (unsigned*)(ws + WS_SLOT); float* gate_tok = (float*)(ws + WS_GATE);
            for (int m = gw; m < T; m += NGW) {
                f32x4 v[8];
                ROW_LOAD(v, xbuf + (size_t)m * DM);
                const float rstd = row_rstd(v, lane);
#pragma unroll
                for (int j = 0; j < 8; ++j) { const f32x4 g = ((const GAS f32x4*)norm2_g)[lane + 64 * j];
                    v[j] = (f32x4){v[j].x * rstd * g.x, v[j].y * rstd * g.y, v[j].z * rstd * g.z, v[j].w * rstd * g.w};
                    v2u o; o.x = pk2(v[j].x, v[j].y); o.y = pk2(v[j].z, v[j].w);
                    ((GAS v2u*)(act + (size_t)m * DM))[lane + 64 * j] = o; }
                LAS f32x4* hrow = (LAS f32x4*)(lds + wave * 16384);
#pragma unroll
                for (int j = 0; j < 8; ++j) hrow[lane + 64 * j] = v[j];
                LDS_WAIT(); asm volatile("" ::: "memory");
                float lg[4], le[32];
#pragma unroll
                for (int i = 0; i < 4; ++i) lg[i] = 0.f;
#pragma unroll
                for (int i = 0; i < 32; ++i) le[i] = 0.f;
#pragma unroll 1
                for (int kk = 0; kk < 32; ++kk) { const int k = kk * 64 + lane; const float hv = ((const LAS float*)hrow)[k];
                    const f32x4 wgr = *(const GAS f32x4*)(wg + (size_t)k * 4);
                    lg[0] += hv * wgr.x; lg[1] += hv * wgr.y; lg[2] += hv * wgr.z; lg[3] += hv * wgr.w;
#pragma unroll
                    for (int q = 0; q < 8; ++q) { const f32x4 wr = *(const GAS f32x4*)(we + (size_t)k * 32 + 4 * q);
                        le[4 * q] += hv * wr.x; le[4 * q + 1] += hv * wr.y; le[4 * q + 2] += hv * wr.z; le[4 * q + 3] += hv * wr.w; } }
#pragma unroll
                for (int i = 0; i < 4; ++i) lg[i] = wave_sum(lg[i], lane);
#pragma unroll
                for (int i = 0; i < 32; ++i) le[i] = wave_sum(le[i], lane);
                LDS_WAIT(); asm volatile("" ::: "memory");
                int e1, e2; float g1, g2; route_select(lg, le, bg, be, e1, e2, g1, g2);
                if (lane == 0) {
                    const unsigned r1 = __hip_atomic_fetch_add(cnt_cur + 64 * e1, 1u, __ATOMIC_RELAXED, __HIP_MEMORY_SCOPE_AGENT);
                    const unsigned r2 = __hip_atomic_fetch_add(cnt_cur + 64 * e2, 1u, __ATOMIC_RELAXED, __HIP_MEMORY_SCOPE_AGENT);
                    tok_of[(size_t)e1 * T + r1] = m; tok_of[(size_t)e2 * T + r2] = m;
                    slot_tok[2 * m] = ((unsigned)e1 << 20) | r1; slot_tok[2 * m + 1] = ((unsigned)e2 << 20) | r2; gate_tok[2 * m] = g1; gate_tok[2 * m + 1] = g2;
                }
            }
        }
        SEAM(8);
        PH_ON(9) {
            PHASE_LOCALS();
            build_moe_tables(lds, (const unsigned*)(ws + WS_CTL) + CW_CNT + ll * 2048, tid);
            const LAS int* tcnt = (const LAS int*)(lds + TAB_CNT); const LAS int* trb = (const LAS int*)(lds + TAB_ROWBASE); const LAS int* texp = (const LAS int*)(lds + TAB_TEXP);
            const int nrows = ((const LAS int*)(lds + TAB_NT))[0] * 256;
            const int* tok_of = (const int*)(ws + WS_TOK); const bf16* act = (const bf16*)(ws + WS_ACT); bf16* aperm = (bf16*)(ws + WS_APERM);
            for (int R = gw; R < nrows; R += NGW) {
                const int e = texp[R >> 8], r = R - trb[e];
                GAS v4u* dst = (GAS v4u*)(aperm + (size_t)R * DM);
                if (r < tcnt[e]) { const int tok = tok_of[(size_t)e * T + r]; const GAS v4u* src = (const GAS v4u*)(act + (size_t)tok * DM);
#pragma unroll
                    for (int j = 0; j < 4; ++j) dst[lane + 64 * j] = src[lane + 64 * j]; }
                else {
#pragma unroll
                    for (int j = 0; j < 4; ++j) dst[lane + 64 * j] = (v4u){0u, 0u, 0u, 0u}; }
            }
        }
        SEAM(9);
        PH_ON(10) {
            PHASE_LOCALS();
            build_moe_tables(lds, (const unsigned*)(ws + WS_CTL) + CW_CNT + ll * 2048, tid);
            const int ntiles = __builtin_amdgcn_readfirstlane(((const LAS int*)(lds + TAB_NT))[0]);
            pg8::Gemm g{(const bf16*)(ws + WS_APERM), (const bf16*)(ws + WS_WGU), MOE_MAXTILES * 256, 1024, DM, (size_t)1024 * DM * 2};
            pg8::MoeOrder<4> S{G, bid, ntiles, (const LAS int*)(lds + TAB_TEXP)};
            pg8::EpiSwiGLU E{(bf16*)(ws + WS_HID), DE};
            pg8::gemm_phase<DM, pg8::EpiSwiGLU, pg8::MoeOrder<4>, true, true>(lds, g, S, E, tid);
        }
        SEAM(10);
        PH_ON(11) {
            PHASE_LOCALS();
            build_moe_tables(lds, (const unsigned*)(ws + WS_CTL) + CW_CNT + ll * 2048, tid);
            const int ntiles = __builtin_amdgcn_readfirstlane(((const LAS int*)(lds + TAB_NT))[0]);
            pg8::Gemm g{(const bf16*)(ws + WS_HID), (const bf16*)(ws + WS_WD), MOE_MAXTILES * 256, DM, DE, (size_t)DM * DE * 2};
            pg8::MoeOrder<8> S{G, bid, ntiles, (const LAS int*)(lds + TAB_TEXP)};
            pg8::EpiBf16 E{(bf16*)(ws + WS_YP), DM};
            pg8::gemm_phase<DE, pg8::EpiBf16, pg8::MoeOrder<8>, true, true>(lds, g, S, E, tid);
        }
        SEAM(11);
    }

template <int KSEL>
__global__ void __launch_bounds__(512, 2) fwd_kernel(Args args) {
    extern __shared__ __attribute__((aligned(16))) unsigned char lds_raw[];
    LAS unsigned char* lds = (LAS unsigned char*)lds_raw;
    if (threadIdx.x < 4) ((LAS unsigned*)(lds + MISC_OFF))[threadIdx.x] = 0u;
    __syncthreads();
    XcdBarrier bar; bar.bar = (unsigned*)(args.ws + WS_CTL) + CW_BAR; bar.x = 0; bar.st = nullptr;
    if constexpr (KSEL < 0) bar = xcd_barrier_post((unsigned*)(args.ws + WS_CTL) + CW_BAR, (volatile LAS unsigned*)(lds + MISC_OFF));
    if constexpr (KSEL < 0) { layer_program<KSEL>(args, lds, bar, 0); layer_program<KSEL>(args, lds, bar, 1); }
    else if constexpr (KSEL != 12) layer_program<KSEL>(args, lds, bar, args.layer);
    PH_ON(12) {
        const int l = DEPTH - 1;
        PHASE_LOCALS();
        build_moe_tables(lds, (const unsigned*)(ws + WS_CTL) + CW_CNT + ll * 2048, tid);
        const LAS int* trb = (const LAS int*)(lds + TAB_ROWBASE);
        const float* gfin = (const float*)args.in[29]; const float* xbuf = (const float*)(ws + WS_X); const bf16* yp = (const bf16*)(ws + WS_YP);
        const unsigned* slot_tok = (const unsigned*)(ws + WS_SLOT); const float* gate_tok = (const float*)(ws + WS_GATE);
        for (int m = gw; m < T; m += NGW) {
            f32x4 v[8];
            ROW_LOAD(v, xbuf + (size_t)m * DM);
            const unsigned s1 = slot_tok[2 * m], s2 = slot_tok[2 * m + 1]; const float g1 = gate_tok[2 * m], g2 = gate_tok[2 * m + 1];
            row_add_moe(v, yp, (size_t)(trb[s1 >> 20] + (int)(s1 & 0xfffffu)), (size_t)(trb[s2 >> 20] + (int)(s2 & 0xfffffu)), g1, g2, lane);
            const float rstd = row_rstd(v, lane);
#pragma unroll
            for (int j = 0; j < 8; ++j) { const f32x4 g = ((const GAS f32x4*)gfin)[lane + 64 * j];
                ((GAS f32x4*)(args.out + (size_t)m * DM))[lane + 64 * j] = (f32x4){v[j].x * rstd * g.x, v[j].y * rstd * g.y, v[j].z * rstd * g.z, v[j].w * rstd * g.w}; }
        }
    }
#undef SEAM
#undef PH_ON
}

extern "C" void kernel_launch(void* const* d_in, const int* in_sizes, int n_in, void* d_out, int out_size, void* d_ws, size_t ws_size, hipStream_t stream) {
    static int grid = 0;
    if (grid == 0) {
        if (n_in != 30 || in_sizes[0] != T * DM || out_size != T * DM || ws_size < WS_END) { fprintf(stderr, "kernel_launch: unexpected shapes (n_in %d, in0 %d, out %d, ws %zu < %zu)\n", n_in, n_in > 0 ? in_sizes[0] : -1, out_size, ws_size, (size_t)WS_END); grid = -1; return; }
        int dev = 0, cus = 0, per_cu = 0; (void)per_cu;
        if (hipGetDevice(&dev) != hipSuccess || hipDeviceGetAttribute(&cus, hipDeviceAttributeMultiprocessorCount, dev) != hipSuccess) { grid = -1; return; }
#if KB_SPLIT
#define SET_ATTR(k) if (hipFuncSetAttribute((const void*)fwd_kernel<k>, hipFuncAttributeMaxDynamicSharedMemorySize, LDS_BYTES) != hipSuccess) { fprintf(stderr, "kernel_launch: hipFuncSetAttribute failed (%d)\n", k); grid = -1; return; }
        SET_ATTR(0) SET_ATTR(1) SET_ATTR(2) SET_ATTR(3) SET_ATTR(4) SET_ATTR(5) SET_ATTR(6) SET_ATTR(7) SET_ATTR(8) SET_ATTR(9) SET_ATTR(10) SET_ATTR(11) SET_ATTR(12)
#else
        if (hipFuncSetAttribute((const void*)fwd_kernel<-1>, hipFuncAttributeMaxDynamicSharedMemorySize, LDS_BYTES) != hipSuccess) { fprintf(stderr, "kernel_launch: hipFuncSetAttribute failed\n"); grid = -1; return; }
        if (hipOccupancyMaxActiveBlocksPerMultiprocessor(&per_cu, (const void*)fwd_kernel<-1>, 512, LDS_BYTES) != hipSuccess || per_cu < 1) fprintf(stderr, "kernel_launch: occupancy query says %d\n", per_cu);
#endif
        (void)hipGetLastError();
        grid = cus;
    }
    if (grid < 0) return;
    if (hipMemsetAsync((char*)d_ws + WS_CTL, 0, CTL_ZERO_BYTES, stream) != hipSuccess) return;
    Args a{};
    for (int i = 0; i < 30; ++i) a.in[i] = d_in[i];
    a.out = (float*)d_out; a.ws = (unsigned char*)d_ws; a.layer = 0; a.pad = 0;
#if KB_SPLIT
#define LAUNCH_PH(k) hipLaunchKernelGGL(fwd_kernel<k>, dim3(grid), dim3(512), LDS_BYTES, stream, a)
    for (int l = 0; l < DEPTH; ++l) { a.layer = l;
        LAUNCH_PH(0); LAUNCH_PH(1); LAUNCH_PH(2); LAUNCH_PH(3); LAUNCH_PH(4); LAUNCH_PH(5); LAUNCH_PH(6); LAUNCH_PH(7); LAUNCH_PH(8); LAUNCH_PH(9); LAUNCH_PH(10); LAUNCH_PH(11); }
    a.layer = DEPTH - 1; LAUNCH_PH(12);
#else
    hipLaunchKernelGGL(fwd_kernel<-1>, dim3(grid), dim3(512), LDS_BYTES, stream, a);
#endif
}
#endif
```

```cpp
#include <hip/hip_runtime.h>
#include <cstdio>
#include <cstdint>
#include <cmath>

#ifndef KB_BATCH
#define KB_BATCH 4
#define KB_SEQ 4096
#endif
#ifndef KB_SPLIT
#define KB_SPLIT 0
#endif

#ifndef KB_PHMASK
#define KB_PHMASK 0xffff
#endif
#define KB_EN(k) (((KB_PHMASK) >> (k)) & 1)
#define HD __host__ __device__ __forceinline__
typedef unsigned short bf16;

constexpr int BATCH = KB_BATCH, SEQ = KB_SEQ, T = BATCH * SEQ;
constexpr int DM = 2048, DG = 512, NH = 8, HDIM = 64;
constexpr int A_COLS = 2048, B_COLS = 1984, C_COLS = 1024, D_COLS = 1536, D_IN = 6592, NPROJ = 6656;
constexpr int OFF_A = 0, OFF_B = 2048, OFF_C = 4032, OFF_D = 5056;
constexpr int NC = SEQ / 128;
constexpr int NEXP = 32, DE = 512;
constexpr int NLORA = 448;
constexpr float NORM_EPS = 1e-6f, GN_EPS = 64e-5f;
constexpr int MOE_MAXTILES = (2 * T + NEXP * 255 + 255) / 256;
constexpr int DEPTH = 2;

constexpr size_t MiB = 1u << 20;
constexpr size_t WS_CTL = 0, CTL_ZERO_BYTES = 1 * MiB;
constexpr size_t WS_WIN = 2 * MiB, WS_WOUT = 28 * MiB, WS_WGU = 36 * MiB, WS_WD = 164 * MiB;
constexpr size_t WS_X = 228 * MiB;
constexpr size_t WS_ACT = 356 * MiB;
constexpr size_t WS_PROJ = 420 * MiB;
constexpr size_t WS_RKV = 628 * MiB, WS_RSP = 660 * MiB;
constexpr size_t WS_RS = 692 * MiB, WS_KS = 708 * MiB, WS_VS = 724 * MiB, WS_KK = 740 * MiB, WS_GG = 756 * MiB, WS_KDF = 772 * MiB, WS_KDB = 788 * MiB,
                 WS_AKF = 804 * MiB, WS_AKB = 820 * MiB, WS_YF = 836 * MiB, WS_YB = 852 * MiB, WS_LIN = 868 * MiB  , WS_WF = 882 * MiB, WS_WB = 914 * MiB;
constexpr size_t WS_TOK = 946 * MiB  , WS_SLOT = 948 * MiB, WS_GATE = 949 * MiB;
constexpr size_t WS_DPO = 950 * MiB  , WS_DML = 998 * MiB  , WS_END = 1002 * MiB;
constexpr size_t WS_APERM = 420 * MiB, WS_HID = 580 * MiB, WS_YP = 620 * MiB;
static_assert((size_t)MOE_MAXTILES * 256 * 2048 * 2 <= 160 * MiB && (size_t)T * NPROJ * 2 <= 208 * MiB, "ws map");
constexpr int CW_BAR = 4096;
constexpr int CW_CNT = 16384;

HD float bf2f(bf16 v) { return __builtin_bit_cast(float, (unsigned)v << 16); }
HD bf16 f2bf(float f) { unsigned u = __builtin_bit_cast(unsigned, f); return (bf16)((u + 0x7fffu + ((u >> 16) & 1u)) >> 16); }
HD float sigmoidf_(float x) { return 1.f / (1.f + expf(-x)); }
HD float siluf_(float x) { return x / (1.f + expf(-x)); }
HD float geluf_(float x) { return 0.5f * x * (1.f + tanhf(0.7978845608028654f * (x + 0.044715f * x * x * x))); }
HD float logsigmoidf_(float x) { return x < 0.f ? x - log1pf(expf(x)) : -log1pf(expf(-x)); }

struct Ctx {
    const int* pos;
    const float *gam, *ret_g, *mu, *w0, *w2, *a0, *a2, *g2, *k_k, *k_a, *r_k, *ln_g, *sgu_g, *sgu_b, *sgu_w, *sgu_bias;
    bf16 *proj, *ycat, *rs, *ks, *vs, *kk, *gg, *kdf, *kdb, *akf, *akb, *yf, *yb, *lin;
    float *wf, *wb, *rkv, *rsp;
};

HD void el_rot_ret(const Ctx& c, long idx) {
    const int i = (int)(idx & 31), h = (int)((idx >> 5) & 7); const long t = idx >> 8;
    const float inv = expf(-(float)i * (1.f / 32.f) * 9.210340371976184f);
    const float ang = (float)c.pos[t] * inv; float sn, cs; sincosf(ang, &sn, &cs);
    bf16* q = c.proj + (size_t)t * NPROJ + OFF_A + h * 64; bf16* k = q + 512;
    const float q1 = bf2f(q[i]), q2 = bf2f(q[i + 32]), k1 = bf2f(k[i]), k2 = bf2f(k[i + 32]);
    q[i] = f2bf(q1 * cs - q2 * sn); q[i + 32] = f2bf(q2 * cs + q1 * sn);
    k[i] = f2bf((k1 * cs - k2 * sn) * 0.125f); k[i + 32] = f2bf((k2 * cs + k1 * sn) * 0.125f);
}
HD void el_rot_dil(const Ctx& c, long idx) {
    const int j = (int)(idx & 31), h = (int)((idx >> 5) & 7); const long t = idx >> 8;
    bf16* q = c.proj + (size_t)t * NPROJ + OFF_D + h * 64; bf16* k = q + 512;
    if (j < 8) {
        const float inv = expf(-(float)j * (1.f / 8.f) * 13.122363377404328f);
        const float ang = (float)c.pos[t] * inv; float sn, cs; sincosf(ang, &sn, &cs);
        const float q1 = bf2f(q[j]), q2 = bf2f(q[j + 8]), k1 = bf2f(k[j]), k2 = bf2f(k[j + 8]);
        q[j] = f2bf((q1 * cs - q2 * sn) * 0.125f); q[j + 8] = f2bf((q2 * cs + q1 * sn) * 0.125f);
        k[j] = f2bf(k1 * cs - k2 * sn); k[j + 8] = f2bf(k2 * cs + k1 * sn);
    } else {
        const int d = 16 + 2 * (j - 8);
        q[d] = f2bf(bf2f(q[d]) * 0.125f); q[d + 1] = f2bf(bf2f(q[d + 1]) * 0.125f);
    }
}
HD void el_rwkv_shift(const Ctx& c, long idx) {
    const int j = (int)(idx % B_COLS); const long t = idx / B_COLS; const int s = (int)(t % SEQ);
    const bf16* p = c.proj + (size_t)t * NPROJ + OFF_B + j;
    const float x = bf2f(p[0]), xp = s > 0 ? bf2f(p[-(long)NPROJ]) : 0.f, xn = s < SEQ - 1 ? bf2f(p[NPROJ]) : 0.f;
    const float xs = x + c.mu[j] * (xp - x) + c.mu[B_COLS + j] * (xn - x);
    if (j < 512) c.rs[t * 512 + j] = f2bf(xs);
    else if (j < 1024) c.ks[t * 512 + j - 512] = f2bf(xs);
    else if (j < 1536) c.vs[t * 512 + j - 1024] = f2bf(xs);
    else if (j < 1632) c.lin[t * NLORA + (j - 1536)] = f2bf(tanhf(xs));
    else if (j < 1728) c.lin[t * NLORA + (j - 1536)] = f2bf(xs);
    else c.lin[t * NLORA + (j - 1536)] = f2bf(sigmoidf_(xs));
}
HD void el_rwkv_lora(const Ctx& c, long idx) {
    const int ch = (int)(idx & 511); const long t = idx >> 9;
    const bf16* li = c.lin + t * NLORA;
    float wl = 0.f, al = 0.f, g = 0.f;
    for (int i = 0; i < 96; ++i) { wl += bf2f(li[i]) * c.w2[i * 512 + ch]; al += bf2f(li[96 + i]) * c.a2[i * 512 + ch]; }
    for (int i = 0; i < 256; ++i) g += bf2f(li[192 + i]) * c.g2[i * 512 + ch];
    c.gg[t * 512 + ch] = f2bf(g);
    const float k = bf2f(c.ks[t * 512 + ch]), ka = c.k_a[ch];
    c.kk[t * 512 + ch] = f2bf(k * c.k_k[ch]);
    {   const float dec = expf(-0.6065306597126334f * sigmoidf_(c.w0[ch] + wl)); const float a = sigmoidf_(c.a0[ch] + al);
        c.wf[t * 512 + ch] = dec; c.kdf[t * 512 + ch] = f2bf(k * (1.f + (a - 1.f) * ka)); c.akf[t * 512 + ch] = f2bf(a); }
    {   const float dec = expf(-0.6065306597126334f * sigmoidf_(c.w0[512 + ch] + wl)); const float a = sigmoidf_(c.a0[512 + ch] + al);
        c.wb[t * 512 + ch] = dec; c.kdb[t * 512 + ch] = f2bf(k * (1.f + (a - 1.f) * ka)); c.akb[t * 512 + ch] = f2bf(a); }
}
HD void el_rwkv_kk(const Ctx& c, long idx) {
    const int h = (int)(idx & 7); const long t = idx >> 3; const size_t o = (size_t)t * 512 + h * 64;
    float ss = 0.f;
    for (int d = 0; d < 64; ++d) { const float v = bf2f(c.kk[o + d]); ss += v * v; }
    const float n = 1.f / sqrtf(ss + 1e-12f);
    for (int d = 0; d < 64; ++d) { const float v = bf2f(c.kk[o + d]) * n; c.kk[o + d] = f2bf(v);
        c.akf[o + d] = f2bf(bf2f(c.akf[o + d]) * v); c.akb[o + d] = f2bf(bf2f(c.akb[o + d]) * v); }
}
HD void el_sgu_prep(const Ctx& c, long t) {
    bf16* v = c.proj + (size_t)t * NPROJ + OFF_C + 512;
    float s = 0.f;
    for (int j = 0; j < 512; ++j) s += geluf_(bf2f(v[j]));
    const float mean = s * (1.f / 512.f); float q = 0.f;
    for (int j = 0; j < 512; ++j) { const float d = geluf_(bf2f(v[j])) - mean; q += d * d; }
    const float rstd = 1.f / sqrtf(q * (1.f / 512.f) + NORM_EPS);
    for (int j = 0; j < 512; ++j) v[j] = f2bf((geluf_(bf2f(v[j])) - mean) * rstd * c.sgu_g[j] + c.sgu_b[j]);
}

HD void el_ret_kv(const Ctx& c, long idx) {
    const int e = (int)(idx & 63), d = (int)((idx >> 6) & 63); long r = idx >> 12;
    const int ch = (int)(r % NC); r /= NC; const int dir = (int)(r & 1); r >>= 1; const int h = (int)(r & 7); const int b = (int)(r >> 3);
    const float lg = logsigmoidf_(c.gam[dir * 8 + h]);
    const bf16* base = c.proj + ((size_t)b * SEQ + (size_t)ch * 128) * NPROJ + OFF_A + h * 64;
    float kv = 0.f;
    for (int m = 0; m < 128; ++m) { const float dec = expf(lg * (float)(dir == 0 ? 127 - m : m));
        kv += dec * bf2f(base[(size_t)m * NPROJ + 512 + d]) * bf2f(base[(size_t)m * NPROJ + 1024 + e]); }
    c.rkv[idx] = kv;
}
HD void el_dil_attn(const Ctx& c, long idx) {
    const int h = (int)(idx & 7); const long t = idx >> 3; const int s = (int)(t % SEQ); const long tb = t - s;
    const bf16* qp = c.proj + (size_t)t * NPROJ + OFF_D + h * 64;
    float o[64];
#pragma unroll
    for (int i = 0; i < 64; ++i) o[i] = 0.f;
    float m = -1e30f, l = 0.f;
    for (int br = 0; br < 3; ++br) {
        const int dil = br == 0 ? 1 : (br == 1 ? 4 : 16);
        for (int j = -64; j <= 64; ++j) {
            const int sp = s + dil * j; if (sp < 0 || sp >= SEQ) continue;
            asm volatile("" ::: "memory");
            const bf16* kp = c.proj + (size_t)(tb + sp) * NPROJ + OFF_D + 512 + h * 64; const bf16* vp = kp + 512;
            float sc = 0.f;
#pragma unroll
            for (int i = 0; i < 64; ++i) sc += bf2f(qp[i]) * bf2f(kp[i]);
            const float mn = sc > m ? sc : m, scale = expf(m - mn), p = expf(sc - mn);
            l = l * scale + p; m = mn;
#pragma unroll
            for (int i = 0; i < 64; ++i) o[i] = o[i] * scale + p * bf2f(vp[i]);
        }
    }
    const float il = 1.f / l; bf16* y = c.ycat + (size_t)t * 2048 + 1536 + h * 64;
#pragma unroll
    for (int i = 0; i < 64; ++i) y[i] = f2bf(o[i] * il);
}
HD void el_dil_combine(const bf16* dpo, const float* dml, bf16* ycat, long idx) {
    const int h = (int)(idx & 7); const long t = idx >> 3;
    float m[3], l[3];
#pragma unroll
    for (int br = 0; br < 3; ++br) { const float* mp = dml + (((size_t)br * T + t) * 8 + h) * 2; m[br] = mp[0]; l[br] = mp[1]; }
    const float M = fmaxf(m[0], fmaxf(m[1], m[2]));
    float wgt[3], den = 0.f;
#pragma unroll
    for (int br = 0; br < 3; ++br) { wgt[br] = expf(m[br] - M) * l[br]; den += wgt[br]; }
    const float inv = 1.f / den;
    bf16* y = ycat + (size_t)t * 2048 + 1536 + h * 64;
    for (int i = 0; i < 64; ++i) { float a = 0.f;
#pragma unroll
        for (int br = 0; br < 3; ++br) a += wgt[br] * bf2f(dpo[((size_t)br * T + t) * 512 + h * 64 + i]);
        y[i] = f2bf(a * inv); }
}
HD void el_sgu_main(const Ctx& c, long idx) {
    const int j = (int)(idx & 511); const long t = idx >> 9; const int s = (int)(t % SEQ), p = s & 127, g = j >> 6; const long t0 = t - p;
    const float* w = c.sgu_w + ((size_t)g * 128 + p) * 128;
    const bf16* v = c.proj + (size_t)t0 * NPROJ + OFF_C + 512 + j;
    float acc = 0.f;
    for (int q = 0; q < 128; ++q) acc += w[q] * bf2f(v[(size_t)q * NPROJ]);
    const float u = geluf_(bf2f(c.proj[(size_t)t * NPROJ + OFF_C + j]));
    c.ycat[(size_t)t * 2048 + 1024 + j] = f2bf(u * (acc + c.sgu_bias[g * 128 + p]));
}
HD void el_ret_scan(const Ctx& c, long idx) {
    const int de = (int)(idx & 4095); const long r = idx >> 12; const int dir = (int)(r & 1), h = (int)((r >> 1) & 7);
    const float cd = expf(128.f * logsigmoidf_(c.gam[dir * 8 + h]));
    float S = 0.f;
    for (int k = 0; k < NC; ++k) { const int ch = dir == 0 ? k : NC - 1 - k; const size_t o = ((size_t)r * NC + ch) * 4096 + de; c.rsp[o] = S; S = S * cd + c.rkv[o]; }
}
HD void el_rwkv_scan(const Ctx& c, long idx) {
    const int row = (int)(idx & 63); const long r = idx >> 6; const int dir = (int)(r & 1), h = (int)((r >> 1) & 7), b = (int)(r >> 4);
    const float* W = dir ? c.wb : c.wf; const bf16* KD = dir ? c.kdb : c.kdf; const bf16* AK = dir ? c.akb : c.akf; bf16* Y = dir ? c.yb : c.yf;
    float S[64];
#pragma unroll
    for (int i = 0; i < 64; ++i) S[i] = 0.f;
    for (int k = 0; k < SEQ; ++k) {
        asm volatile("" ::: "memory");
        const int s = dir ? SEQ - 1 - k : k; const size_t o = ((size_t)b * SEQ + s) * 512 + h * 64;
        float sk = 0.f;
#pragma unroll
        for (int q = 0; q < 4; ++q) { asm volatile("" ::: "memory");
#pragma unroll
            for (int i = 16 * q; i < 16 * q + 16; ++i) sk += S[i] * bf2f(c.kk[o + i]); }
        const float v = bf2f(c.vs[o + row]); float y = 0.f;
#pragma unroll
        for (int q = 0; q < 4; ++q) { asm volatile("" ::: "memory");
#pragma unroll
            for (int i = 16 * q; i < 16 * q + 16; ++i) { S[i] = S[i] * W[o + i] - sk * bf2f(AK[o + i]) + v * bf2f(KD[o + i]); y += S[i] * bf2f(c.rs[o + i]); } }
        Y[o + row] = f2bf(y);
    }
}
HD void el_ret_out(const Ctx& c, long idx) {
    const int h = (int)(idx & 7); const long t = idx >> 3; const int s = (int)(t % SEQ), n = s & 127, ch = s >> 7; const int b = (int)(t / SEQ);
    const float lgf = logsigmoidf_(c.gam[h]), lgb = logsigmoidf_(c.gam[8 + h]);
    const bf16* qp = c.proj + (size_t)t * NPROJ + OFF_A + h * 64;
    float o[64];
#pragma unroll
    for (int i = 0; i < 64; ++i) o[i] = 0.f;
    const bf16* kb = c.proj + (size_t)(t - n) * NPROJ + OFF_A + 512 + h * 64;
    for (int m = 0; m < 128; ++m) {
        asm volatile("" ::: "memory");
        const bf16* kp = kb + (size_t)m * NPROJ; const bf16* vp = kp + 512;
        float sc = 0.f;
#pragma unroll
        for (int i = 0; i < 64; ++i) sc += bf2f(qp[i]) * bf2f(kp[i]);
        sc *= m <= n ? expf(lgf * (float)(n - m)) : expf(lgb * (float)(m - n));
#pragma unroll
        for (int i = 0; i < 64; ++i) o[i] += sc * bf2f(vp[i]);
    }
    const float qdf = expf(lgf * (float)(n + 1)), qdb = expf(lgb * (float)(128 - n));
    const float* Sf = c.rsp + ((size_t)((b * 8 + h) * 2 + 0) * NC + ch) * 4096; const float* Sb = c.rsp + ((size_t)((b * 8 + h) * 2 + 1) * NC + ch) * 4096;
    for (int d = 0; d < 64; ++d) { asm volatile("" ::: "memory"); const float qd = bf2f(qp[d]); const float a = qd * qdf, bb = qd * qdb;
#pragma unroll
        for (int i = 0; i < 64; ++i) o[i] += a * Sf[d * 64 + i] + bb * Sb[d * 64 + i]; }
    float mu = 0.f;
#pragma unroll
    for (int i = 0; i < 64; ++i) mu += o[i];
    mu *= (1.f / 64.f); float var = 0.f;
#pragma unroll
    for (int i = 0; i < 64; ++i) { const float d = o[i] - mu; var += d * d; }
    const float rstd = 1.f / sqrtf(var * (1.f / 64.f) + GN_EPS);
    const bf16* gp = c.proj + (size_t)t * NPROJ + OFF_A + 1536 + h * 64; bf16* y = c.ycat + (size_t)t * 2048 + h * 64;
    for (int i = 0; i < 64; i += 8) { asm volatile("" ::: "memory");
#pragma unroll
        for (int j = 0; j < 8; ++j) y[i + j] = f2bf(siluf_(bf2f(gp[i + j])) * ((o[i + j] - mu) * rstd * c.ret_g[h * 64 + i + j])); }
}
HD void el_rwkv_fin(const Ctx& c, long idx) {
    const int h = (int)(idx & 7); const long t = idx >> 3; const size_t o = (size_t)t * 512 + h * 64;
    float mu = 0.f, bonus = 0.f;
    for (int i = 0; i < 64; ++i) { mu += bf2f(c.yf[o + i]) + bf2f(c.yb[o + i]); bonus += bf2f(c.rs[o + i]) * bf2f(c.ks[o + i]) * c.r_k[h * 64 + i]; }
    mu *= (1.f / 64.f); float var = 0.f;
    for (int i = 0; i < 64; ++i) { const float d = bf2f(c.yf[o + i]) + bf2f(c.yb[o + i]) - mu; var += d * d; }
    const float rstd = 1.f / sqrtf(var * (1.f / 64.f) + GN_EPS);
    bf16* out = c.ycat + (size_t)t * 2048 + 512 + h * 64;
    for (int i = 0; i < 64; ++i) { const float y = bf2f(c.yf[o + i]) + bf2f(c.yb[o + i]);
        out[i] = f2bf(((y - mu) * rstd * c.ln_g[h * 64 + i] + bonus * bf2f(c.vs[o + i])) * bf2f(c.gg[o + i])); }
}
HD void route_select(const float (&lg)[4], const float (&le)[32], const float* bg, const float* be, int& e1, int& e2, float& g1, float& g2) {
    float l[4]; float mx = -1e30f; int gi = 0;
#pragma unroll
    for (int i = 0; i < 4; ++i) { l[i] = lg[i] + bg[i]; if (l[i] > mx) { mx = l[i]; gi = i; } }
    float den = 0.f;
#pragma unroll
    for (int i = 0; i < 4; ++i) den += expf(l[i] - mx);
    const float gtop = 1.f / den;
    float el[8];
#pragma unroll
    for (int i = 0; i < 8; ++i) { float v = 0.f;
#pragma unroll
        for (int g = 0; g < 4; ++g) v = (g == gi) ? le[g * 8 + i] + be[g * 8 + i] : v;
        el[i] = v; }
    float m1 = -1e30f, m2 = -1e30f; int i1 = 0, i2 = 0;
#pragma unroll
    for (int i = 0; i < 8; ++i) { if (el[i] > m1) { m2 = m1; i2 = i1; m1 = el[i]; i1 = i; } else if (el[i] > m2) { m2 = el[i]; i2 = i; } }
    const float p2 = expf(m2 - m1);
    g1 = gtop / (1.f + p2); g2 = gtop * p2 / (1.f + p2); e1 = gi * 8 + i1; e2 = gi * 8 + i2;
}

#ifndef KB_HOST_ONLY
namespace pg8 {
#define PG8_LAS __attribute__((address_space(3)))
typedef unsigned short bf16_t;
typedef short bf16x8 __attribute__((ext_vector_type(8)));
typedef float f32x4 __attribute__((ext_vector_type(4)));
typedef unsigned u32x4 __attribute__((ext_vector_type(4)));
constexpr int BM = 256, BK = 64, HALF = 128, HTB = HALF * BK * 2, STAGE_BYTES = 8 * HTB, NXCD = 8, WGM = 8;
__host__ __device__ __forceinline__ int lds_byte(int r, int c) { const int st = (r >> 4) * 2 + (c >> 5), rr = r & 15, cc = c & 31, ob = rr * 64 + cc * 2; return st * 1024 + (ob ^ (((ob >> 9) & 1) << 5)); }
__host__ __device__ __forceinline__ void stage_rc(int b, int& R, int& C) { const int st = b / 1024, sb = b % 1024, swz = sb ^ (((sb >> 9) & 1) << 5); R = (st >> 1) * 16 + swz / 64; C = (st & 1) * 32 + (swz % 64) / 2; }
__host__ __device__ __forceinline__ int perm32(int rho) { const int n = rho >> 4, i = rho & 15; return 8 * (i >> 2) + 4 * n + (i & 3); }
struct Unit { int pm, pn, pe; };
struct Gemm { const bf16_t* A; const bf16_t* Bt; int M, N, K; size_t bstride; };
template <int M, int N> struct StaticOrder {
    static constexpr int nM = M / BM, nN = N / BM, nwg = nM * nN;
    int G, c;
    __host__ __device__ void init(int G_, int c_) { G = G_; c = c_; }
    __host__ __device__ __forceinline__ bool next(int i, Unit& u) const {
        const int L = i * G + c; if (L >= nwg) return false;
        int wgid = L; { constexpr int q = nwg / NXCD, r = nwg % NXCD; const int xcd = wgid % NXCD, off = wgid / NXCD; wgid = (xcd < r ? xcd * (q + 1) : r * (q + 1) + (xcd - r) * q) + off; }
        constexpr int nig = WGM * nN; const int gid = wgid / nig, fm = gid * WGM, gsz = (nM - fm) < WGM ? (nM - fm) : WGM;
        u.pm = fm + ((wgid % nig) % gsz); u.pn = (wgid % nig) / gsz; u.pe = 0; return true;
    }
    __device__ __forceinline__ void a_ready(const Unit&) const {}
    __device__ __forceinline__ void done(const Unit&) const {}
};
template <int NN> struct MoeOrder {
    int G, c, ntiles; const PG8_LAS int* tile_exp;
    __device__ __forceinline__ bool next(int i, Unit& u) const {
        const int L = i * G + c; if (L >= ntiles * NN) return false;
        u.pm = L / NN; u.pn = L % NN; u.pe = __builtin_amdgcn_readfirstlane(tile_exp[u.pm]); return true;
    }
    __device__ __forceinline__ void a_ready(const Unit&) const {}
    __device__ __forceinline__ void done(const Unit&) const {}
};
__device__ __forceinline__ unsigned cvt_pk_bf16(float lo, float hi) { unsigned r; asm volatile("v_cvt_pk_bf16_f32 %0, %1, %2" : "=v"(r) : "v"(lo), "v"(hi)); return r; }
struct EpiBf16 {
    static constexpr bool PERM = true, AFTER_DRAIN = false;
    bf16_t* O; int ldc;
    __device__ __forceinline__ void operator()(const f32x4 (&acc)[2][2][4][2], const Unit& u, int wr, int wc, int fr, int fq) const {
        const int row0 = u.pm * BM + wr * 64 + fr, col0 = u.pn * BM + wc * 32 + 8 * fq;
#pragma unroll
        for (int ai = 0; ai < 2; ++ai)
#pragma unroll
            for (int m = 0; m < 4; ++m) { bf16_t* rowp = O + (size_t)(row0 + ai * HALF + m * 16) * ldc + col0;
#pragma unroll
                for (int bj = 0; bj < 2; ++bj) { const f32x4 v0 = acc[ai][bj][m][0], v1 = acc[ai][bj][m][1];
                    u32x4 w; w.x = cvt_pk_bf16(v0[0], v0[1]); w.y = cvt_pk_bf16(v0[2], v0[3]); w.z = cvt_pk_bf16(v1[0], v1[1]); w.w = cvt_pk_bf16(v1[2], v1[3]);
                    *(u32x4*)(rowp + bj * HALF) = w; } }
    }
};
struct EpiResF32 {
    static constexpr bool PERM = false, AFTER_DRAIN = false;
    const float* base; float* out; int ldc;
    __device__ __forceinline__ void operator()(const f32x4 (&acc)[2][2][4][2], const Unit& u, int wr, int wc, int fr, int fq) const {
        const int row0 = u.pm * BM + wr * 64 + fr, col0 = u.pn * BM + wc * 32 + 4 * fq;
#pragma unroll
        for (int ai = 0; ai < 2; ++ai)
#pragma unroll
            for (int m = 0; m < 4; ++m) { const size_t off = (size_t)(row0 + ai * HALF + m * 16) * ldc + col0;
#pragma unroll
                for (int bj = 0; bj < 2; ++bj)
#pragma unroll
                    for (int n = 0; n < 2; ++n) { const f32x4 bs = *(const f32x4*)(base + off + bj * HALF + n * 16); *(f32x4*)(out + off + bj * HALF + n * 16) = bs + acc[ai][bj][m][n]; } }
    }
};
struct EpiSwiGLU {
    static constexpr bool PERM = true, AFTER_DRAIN = false;
    bf16_t* O; int ldc;
    __device__ __forceinline__ void operator()(const f32x4 (&acc)[2][2][4][2], const Unit& u, int wr, int wc, int fr, int fq) const {
        const int row0 = u.pm * BM + wr * 64 + fr, col0 = u.pn * HALF + wc * 32 + 8 * fq;
#pragma unroll
        for (int ai = 0; ai < 2; ++ai)
#pragma unroll
            for (int m = 0; m < 4; ++m) { bf16_t* rowp = O + (size_t)(row0 + ai * HALF + m * 16) * ldc + col0;
                float h[8];
#pragma unroll
                for (int n = 0; n < 2; ++n)
#pragma unroll
                    for (int j = 0; j < 4; ++j) { const float g = acc[ai][0][m][n][j], up = acc[ai][1][m][n][j]; h[n * 4 + j] = g * __builtin_amdgcn_rcpf(1.f + __expf(-g)) * up; }
                u32x4 w; w.x = cvt_pk_bf16(h[0], h[1]); w.y = cvt_pk_bf16(h[2], h[3]); w.z = cvt_pk_bf16(h[4], h[5]); w.w = cvt_pk_bf16(h[6], h[7]);
                *(u32x4*)rowp = w; }
    }
};

template <int KK, class Epi, class Sched, bool ALIGN_EPI = false, bool SP2 = false>
__device__ __forceinline__ void gemm_phase(PG8_LAS unsigned char* lds, const Gemm g, const Sched& S, const Epi& E, const int tid) {
    const int wid = __builtin_amdgcn_readfirstlane(tid >> 6), lane = tid & 63, wr = wid >> 2, wc = wid & 3, fr = lane & 15, fq = lane >> 4;
    constexpr int K = KK, nt = K / BK;
    unsigned voffA[2], voffB[2];
#pragma unroll
    for (int i = 0; i < 2; ++i) { int R, C; stage_rc(tid * 16 + i * 8192, R, C); const int Rb = Epi::PERM ? ((R & ~31) + perm32(R & 31)) : R;
        voffA[i] = (unsigned)(R * K + C) * 2u; voffB[i] = (unsigned)(Rb * K + C) * 2u; }
    constexpr size_t kstep = (size_t)(BK * 2);
    constexpr size_t hstep = (size_t)HALF * K * 2;
    constexpr size_t tstep = 2 * hstep;
    const unsigned ldsw = (unsigned)wid * 1024u;
    const int aoff = lds_byte(wr * 64 + fr, fq * 8), boff = lds_byte(wc * 32 + fr, fq * 8);
#define PG8_SA(b, h) (((b) * 2 + (h)) * HTB)
#define PG8_SB(b, h) ((4 + (b) * 2 + (h)) * HTB)
#define PG8_STAGE(bufoff, gbase, voff) do { _Pragma("unroll") for (int _i = 0; _i < 2; ++_i) \
        __builtin_amdgcn_global_load_lds((const unsigned*)((const char*)(gbase) + (voff)[_i]), (PG8_LAS unsigned*)(lds + (bufoff) + ldsw + _i * 8192), 16, 0, 0); } while (0)
#define PG8_LDA(dst, b, h) do { _Pragma("unroll") for (int m = 0; m < 4; ++m) _Pragma("unroll") for (int k = 0; k < 2; ++k) dst[m][k] = *(const PG8_LAS bf16x8*)(lds + PG8_SA(b, h) + aoff + m * 2048 + k * 1024); } while (0)
#define PG8_LDB(dst, b, h) do { _Pragma("unroll") for (int n = 0; n < 2; ++n) _Pragma("unroll") for (int k = 0; k < 2; ++k) dst[n][k] = *(const PG8_LAS bf16x8*)(lds + PG8_SB(b, h) + boff + n * 2048 + k * 1024); } while (0)
#define PG8_MMA(ai, bj, At, Bt) do { __builtin_amdgcn_s_setprio(1); _Pragma("unroll") for (int m = 0; m < 4; ++m) _Pragma("unroll") for (int n = 0; n < 2; ++n) _Pragma("unroll") for (int k = 0; k < 2; ++k) \
        acc[ai][bj][m][n] = __builtin_amdgcn_mfma_f32_16x16x32_bf16(Bt[n][k], At[m][k], acc[ai][bj][m][n], 0, 0, 0); __builtin_amdgcn_s_setprio(0); } while (0)
#define PG8_WAIT_V(n) asm volatile("s_waitcnt vmcnt(" #n ")" ::: "memory")
#define PG8_WAIT_L(n) asm volatile("s_waitcnt lgkmcnt(" #n ")" ::: "memory")
#define PG8_BAR __builtin_amdgcn_s_barrier()
#define PG8_SCHED __builtin_amdgcn_sched_barrier(0)
    Unit cur, nxt; int ui = 0;
    if (!S.next(0, cur)) return;
    f32x4 acc[2][2][4][2];
#pragma unroll
    for (int a = 0; a < 2; ++a)
#pragma unroll
        for (int b = 0; b < 2; ++b)
#pragma unroll
            for (int m = 0; m < 4; ++m)
#pragma unroll
                for (int n = 0; n < 2; ++n) acc[a][b][m][n] = (f32x4){0.f, 0.f, 0.f, 0.f};
    bf16x8 At[4][2], B0[2][2], B1[2][2];
    const char* cA = (const char*)g.A + (size_t)cur.pm * tstep; const char* cB = (const char*)g.Bt + (size_t)cur.pe * g.bstride + (size_t)cur.pn * tstep;
    S.a_ready(cur);
    if constexpr (SP2) {
        PG8_STAGE(PG8_SB(0, 0), cB, voffB); PG8_STAGE(PG8_SB(0, 1), cB + hstep, voffB); PG8_STAGE(PG8_SA(0, 0), cA, voffA); PG8_STAGE(PG8_SA(0, 1), cA + hstep, voffA);
        if (wr == 1) PG8_BAR;
        PG8_WAIT_V(2); PG8_BAR;
        PG8_STAGE(PG8_SB(1, 0), cB + kstep, voffB); PG8_STAGE(PG8_SA(1, 0), cA + kstep, voffA); PG8_STAGE(PG8_SB(1, 1), cB + hstep + kstep, voffB);
        PG8_WAIT_V(6); PG8_BAR;
    } else {
        PG8_STAGE(PG8_SB(0, 0), cB, voffB); PG8_STAGE(PG8_SA(0, 0), cA, voffA); PG8_STAGE(PG8_SB(0, 1), cB + hstep, voffB); PG8_STAGE(PG8_SA(0, 1), cA + hstep, voffA);
        if (wr == 1) PG8_BAR;
        PG8_WAIT_V(4); PG8_BAR;
        PG8_STAGE(PG8_SB(1, 0), cB + kstep, voffB); PG8_STAGE(PG8_SA(1, 0), cA + kstep, voffA); PG8_STAGE(PG8_SB(1, 1), cB + hstep + kstep, voffB);
        PG8_WAIT_V(6); PG8_BAR;
    }
    for (;;) {
        const bool has_next = S.next(ui + 1, nxt);
        const char* nA = has_next ? (const char*)g.A + (size_t)nxt.pm * tstep : cA; const char* nB = has_next ? (const char*)g.Bt + (size_t)nxt.pe * g.bstride + (size_t)nxt.pn * tstep : cB;
        for (int t = 0; t < nt; t += 2) {
            const bool last = (t == nt - 2);
            const char* a1 = cA + (size_t)(t + 1) * kstep;
            const char* a2 = last ? nA : cA + (size_t)(t + 2) * kstep; const char* b2 = last ? nB : cB + (size_t)(t + 2) * kstep;
            const char* a3 = a2 + kstep; const char* b3 = b2 + kstep;
            if (last && has_next) S.a_ready(nxt);
            if constexpr (SP2) {
            PG8_LDB(B0, 0, 0); PG8_LDB(B1, 0, 1); PG8_SCHED; PG8_LDA(At, 0, 0); PG8_STAGE(PG8_SA(1, 1), a1 + hstep, voffA);
            PG8_WAIT_V(8); PG8_WAIT_L(0); PG8_BAR; PG8_MMA(0, 0, At, B0); PG8_MMA(0, 1, At, B1); PG8_BAR; PG8_SCHED;
            PG8_LDA(At, 0, 1); PG8_STAGE(PG8_SB(0, 0), b2, voffB); PG8_STAGE(PG8_SB(0, 1), b2 + hstep, voffB); PG8_STAGE(PG8_SA(0, 0), a2, voffA);
            PG8_WAIT_V(8); PG8_WAIT_L(0); PG8_BAR; PG8_MMA(1, 0, At, B0); PG8_MMA(1, 1, At, B1); PG8_BAR; PG8_SCHED;
            PG8_LDB(B0, 1, 0); PG8_LDB(B1, 1, 1); PG8_SCHED; PG8_LDA(At, 1, 0); PG8_STAGE(PG8_SA(0, 1), a2 + hstep, voffA);
            PG8_WAIT_V(8); PG8_WAIT_L(0); PG8_BAR; PG8_MMA(0, 0, At, B0); PG8_MMA(0, 1, At, B1); PG8_BAR; PG8_SCHED;
            PG8_LDA(At, 1, 1); PG8_STAGE(PG8_SB(1, 0), b3, voffB); PG8_STAGE(PG8_SB(1, 1), b3 + hstep, voffB); PG8_STAGE(PG8_SA(1, 0), a3, voffA);
            PG8_WAIT_V(8); PG8_WAIT_L(0); PG8_BAR; PG8_MMA(1, 0, At, B0); PG8_MMA(1, 1, At, B1); PG8_BAR; PG8_SCHED;
            } else {
            PG8_LDB(B0, 0, 0); PG8_SCHED; PG8_LDA(At, 0, 0); PG8_STAGE(PG8_SA(1, 1), a1 + hstep, voffA);
            PG8_WAIT_L(8); PG8_BAR; PG8_WAIT_L(0); PG8_MMA(0, 0, At, B0); PG8_BAR; PG8_SCHED;
            PG8_LDB(B1, 0, 1); PG8_STAGE(PG8_SB(0, 0), b2, voffB);
            PG8_BAR; PG8_WAIT_L(0); PG8_MMA(0, 1, At, B1); PG8_BAR;
            PG8_LDA(At, 0, 1); PG8_STAGE(PG8_SA(0, 0), a2, voffA);
            PG8_BAR; PG8_WAIT_L(0); PG8_MMA(1, 0, At, B0); PG8_BAR; PG8_SCHED;
            PG8_STAGE(PG8_SB(0, 1), b2 + hstep, voffB);
            PG8_WAIT_V(6); PG8_BAR; PG8_MMA(1, 1, At, B1); PG8_BAR;
            PG8_LDB(B0, 1, 0); PG8_SCHED; PG8_LDA(At, 1, 0); PG8_STAGE(PG8_SA(0, 1), a2 + hstep, voffA);
            PG8_WAIT_L(8); PG8_BAR; PG8_WAIT_L(0); PG8_MMA(0, 0, At, B0); PG8_BAR; PG8_SCHED;
            PG8_LDB(B1, 1, 1); PG8_STAGE(PG8_SB(1, 0), b3, voffB);
            PG8_BAR; PG8_WAIT_L(0); PG8_MMA(0, 1, At, B1); PG8_BAR;
            PG8_LDA(At, 1, 1); PG8_STAGE(PG8_SA(1, 0), a3, voffA);
            PG8_BAR; PG8_WAIT_L(0); PG8_MMA(1, 0, At, B0); PG8_BAR; PG8_SCHED;
            PG8_STAGE(PG8_SB(1, 1), b3 + hstep, voffB);
            PG8_WAIT_V(6); PG8_BAR; PG8_MMA(1, 1, At, B1); PG8_BAR;
            }
        }
        if constexpr (ALIGN_EPI) { if (wr == 0) PG8_BAR; }
        E(acc, cur, wr, wc, fr, fq); S.done(cur);
        if (!has_next) break;
#pragma unroll
        for (int a = 0; a < 2; ++a)
#pragma unroll
            for (int b = 0; b < 2; ++b)
#pragma unroll
                for (int m = 0; m < 4; ++m)
#pragma unroll
                    for (int n = 0; n < 2; ++n) acc[a][b][m][n] = (f32x4){0.f, 0.f, 0.f, 0.f};
        cur = nxt; cA = nA; cB = nB; ++ui;
        if constexpr (ALIGN_EPI) { if (wr == 1) PG8_BAR; }
    }
    PG8_WAIT_V(0);
    if constexpr (!ALIGN_EPI) { if (wr == 0) PG8_BAR; }
    PG8_BAR;
#undef PG8_SA
#undef PG8_SB
#undef PG8_STAGE
#undef PG8_LDA
#undef PG8_LDB
#undef PG8_MMA
#undef PG8_WAIT_V
#undef PG8_WAIT_L
#undef PG8_BAR
#undef PG8_SCHED
}
}

#define GAS __attribute__((address_space(1)))
#define LAS __attribute__((address_space(3)))
typedef unsigned v4u __attribute__((ext_vector_type(4)));
typedef unsigned v2u __attribute__((ext_vector_type(2)));
typedef float f32x4 __attribute__((ext_vector_type(4)));
#define LDS_WAIT() asm volatile("s_waitcnt lgkmcnt(0)" ::: "memory")
__device__ __forceinline__ unsigned pk2(float lo, float hi) { return (unsigned)f2bf(lo) | ((unsigned)f2bf(hi) << 16); }

#define XB_TMO      128
#define XB_XCNT(j)  (256  + 64 * (j))
#define XB_XSUB(j)  (1280 + 64 * (j))
#define XB_XGEN(j)  (2304 + 64 * (j))
#define XB_TOP      3328
#define XB_TOPGEN   3392
#define XCD_BAR_WORDS 3456
#define XB_SPIN_CAP (1u << 18)
__device__ __forceinline__ unsigned xb_ld(unsigned* p)              { return __hip_atomic_load(p, __ATOMIC_RELAXED, __HIP_MEMORY_SCOPE_AGENT); }
__device__ __forceinline__ unsigned xb_add(unsigned* p, unsigned v) { return __hip_atomic_fetch_add(p, v, __ATOMIC_RELAXED, __HIP_MEMORY_SCOPE_AGENT); }
__device__ __forceinline__ unsigned xb_xcc_id() { return (unsigned)__builtin_amdgcn_s_getreg((3 << 11) | 20) & 0xFu; }
#define XB_SPIN(cond, bar) do { unsigned _sp = 0; while (cond) { __builtin_amdgcn_s_sleep(1); \
    if ((++_sp & 255u) == 0u) { if (xb_ld(&(bar)[XB_TMO])) break; if (_sp > XB_SPIN_CAP) { atomicAdd(&(bar)[XB_TMO], 1u); break; } } } } while (0)
struct XcdBarrier { unsigned* bar; unsigned x; volatile LAS unsigned* st; };
__device__ __forceinline__ XcdBarrier xcd_barrier_post(unsigned* bar, volatile LAS unsigned* st) {
    XcdBarrier b; b.bar = bar; b.x = xb_xcc_id(); b.st = st;
    if (threadIdx.x == 0) (void)xb_add(&bar[XB_XCNT(b.x)], 1u);
    return b;
}
__device__ __forceinline__ void xcd_barrier_complete(unsigned* bar, unsigned x, unsigned& nloc, unsigned& nx) {
    const unsigned G = gridDim.x * gridDim.y * gridDim.z;
    unsigned sum, cnt, mine, sp = 0u;
    for (;;) {
        sum = 0u; cnt = 0u; mine = 0u;
#pragma unroll
        for (unsigned j = 0; j < 16; ++j) { const unsigned c = xb_ld(&bar[XB_XCNT(j)]); sum += c; cnt += (c > 0u) ? 1u : 0u; mine = (j == x) ? c : mine; }
        if (sum == G) break;
        __builtin_amdgcn_s_sleep(1);
        if ((++sp & 255u) == 0u) { if (xb_ld(&bar[XB_TMO])) break; if (sp > XB_SPIN_CAP) { atomicAdd(&bar[XB_TMO], 1u); break; } }
    }
    nloc = mine > 0u ? mine : 1u; nx = cnt > 0u ? cnt : 1u;
}
__device__ __forceinline__ void xcd_barrier(const XcdBarrier& b) {
    asm volatile("s_waitcnt vmcnt(0)" ::: "memory");
    __syncthreads();
    if (threadIdx.x == 0) {
        unsigned* bar = b.bar;
        __builtin_amdgcn_s_waitcnt(0);
        unsigned nloc = b.st[0], nx = b.st[1];
        if (nloc == 0u) { xcd_barrier_complete(bar, b.x, nloc, nx); b.st[0] = nloc; b.st[1] = nx; }
        const unsigned old = xb_add(&bar[XB_XSUB(b.x)], 1u);
        const unsigned gen = old / nloc;
        if (old + 1u == (gen + 1u) * nloc) {
            __builtin_amdgcn_fence(__ATOMIC_RELEASE, "agent");
            asm volatile("s_waitcnt vmcnt(0)" ::: "memory");
            const unsigned og = xb_add(&bar[XB_TOP], 1u);
            const unsigned tg = og / nx;
            if (og + 1u == (tg + 1u) * nx) xb_add(&bar[XB_TOPGEN], 1u);
            else XB_SPIN(xb_ld(&bar[XB_TOPGEN]) == tg, bar);
            __builtin_amdgcn_fence(__ATOMIC_ACQUIRE, "agent");
            xb_add(&bar[XB_XGEN(b.x)], 1u);
            asm volatile("s_waitcnt vmcnt(0)" ::: "memory");
        } else {
            XB_SPIN(xb_ld(&bar[XB_XGEN(b.x)]) == gen, bar);
            __builtin_amdgcn_fence(__ATOMIC_ACQUIRE, "agent");
            asm volatile("s_waitcnt vmcnt(0)" ::: "memory");
        }
    }
    __syncthreads();
}

constexpr int RING_BYTES = 131072;
constexpr int TAB_OFF = RING_BYTES;
constexpr int TAB_CNT = TAB_OFF, TAB_ROWBASE = TAB_OFF + 128, TAB_NT = TAB_OFF + 256, TAB_TEXP = TAB_OFF + 272;
constexpr int MISC_OFF = TAB_OFF + 4096;
constexpr int PTAB_OFF = MISC_OFF + 16;
constexpr int LDS_BYTES = 147456;
static_assert(TAB_TEXP + MOE_MAXTILES * 4 <= MISC_OFF && PTAB_OFF + 32 * 8 <= LDS_BYTES, "LDS map");

__device__ __forceinline__ float wave_sum(float v, int lane) {
#pragma unroll
    for (int o = 1; o < 64; o <<= 1) v += __builtin_bit_cast(float, __builtin_amdgcn_ds_bpermute((lane ^ o) << 2, __builtin_bit_cast(int, v)));
    return v;
}
__device__ __forceinline__ void transpose_item(const float* W, int K, int N, bf16* WT, int k0, int n0, int drow0, LAS float* scr, int lane) {
#pragma unroll 8
    for (int i = 0; i < 32; ++i) { const int kk = 2 * i + (lane >> 5); scr[kk * 33 + (lane & 31)] = W[(size_t)(k0 + kk) * N + n0 + (lane & 31)]; }
    LDS_WAIT(); asm volatile("" ::: "memory");
    const int c = lane & 7;
#pragma unroll
    for (int j = 0; j < 4; ++j) { const int n = (lane >> 3) + 8 * j; const LAS float* s = scr + (8 * c) * 33 + n;
        v4u o; o.x = pk2(s[0 * 33], s[1 * 33]); o.y = pk2(s[2 * 33], s[3 * 33]); o.z = pk2(s[4 * 33], s[5 * 33]); o.w = pk2(s[6 * 33], s[7 * 33]);
        *(GAS v4u*)(WT + (size_t)(drow0 + n) * K + k0 + 8 * c) = o; }
    LDS_WAIT(); asm volatile("" ::: "memory");
}


__device__ __forceinline__ void build_moe_tables(LAS unsigned char* lds, const unsigned* cnt_words, const int tid) {
    LAS int* tcnt = (LAS int*)(lds + TAB_CNT); LAS int* trb = (LAS int*)(lds + TAB_ROWBASE); LAS int* tnt = (LAS int*)(lds + TAB_NT); LAS int* texp = (LAS int*)(lds + TAB_TEXP);
    __syncthreads();
    if (tid < NEXP) tcnt[tid] = (int)__hip_atomic_load(cnt_words + 64 * tid, __ATOMIC_RELAXED, __HIP_MEMORY_SCOPE_AGENT);
    __syncthreads();
    if (tid == 0) { int tile = 0;
#pragma unroll 1
        for (int e = 0; e < NEXP; ++e) { int c = tcnt[e]; if (c > 2 * T) c = 2 * T; int nt = (c + 255) >> 8; if (tile + nt > MOE_MAXTILES) nt = MOE_MAXTILES - tile; trb[e] = tile * 256;
#pragma unroll 1
            for (int i = 0; i < nt; ++i) texp[tile + i] = e;
            tile += nt; }
        tnt[0] = tile; }
    __syncthreads();
}

struct Args { const void* in[30]; float* out; unsigned char* ws; int layer, pad; };
__device__ __forceinline__ Ctx make_ctx(const Args& args, unsigned char* ws, int l) {
    Ctx c;
    c.pos = (const int*)args.in[1];
    c.gam = (const float*)args.in[5] + l * 16; c.ret_g = (const float*)args.in[6] + l * 512; c.mu = (const float*)args.in[7] + l * 2 * B_COLS;
    c.w0 = (const float*)args.in[8] + l * 1024; c.w2 = (const float*)args.in[9] + l * 96 * 512; c.a0 = (const float*)args.in[10] + l * 1024; c.a2 = (const float*)args.in[11] + l * 96 * 512;
    c.g2 = (const float*)args.in[12] + l * 256 * 512; c.k_k = (const float*)args.in[13] + l * 512; c.k_a = (const float*)args.in[14] + l * 512; c.r_k = (const float*)args.in[15] + l * 512;
    c.ln_g = (const float*)args.in[16] + l * 512; c.sgu_g = (const float*)args.in[17] + l * 512; c.sgu_b = (const float*)args.in[18] + l * 512;
    c.sgu_w = (const float*)args.in[19] + (size_t)l * 8 * 128 * 128; c.sgu_bias = (const float*)args.in[20] + l * 1024;
    c.proj = (bf16*)(ws + WS_PROJ); c.ycat = (bf16*)(ws + WS_ACT);
    c.rs = (bf16*)(ws + WS_RS); c.ks = (bf16*)(ws + WS_KS); c.vs = (bf16*)(ws + WS_VS); c.kk = (bf16*)(ws + WS_KK); c.gg = (bf16*)(ws + WS_GG);
    c.kdf = (bf16*)(ws + WS_KDF); c.kdb = (bf16*)(ws + WS_KDB); c.akf = (bf16*)(ws + WS_AKF); c.akb = (bf16*)(ws + WS_AKB); c.yf = (bf16*)(ws + WS_YF); c.yb = (bf16*)(ws + WS_YB);
    c.lin = (bf16*)(ws + WS_LIN); c.wf = (float*)(ws + WS_WF); c.wb = (float*)(ws + WS_WB); c.rkv = (float*)(ws + WS_RKV); c.rsp = (float*)(ws + WS_RSP);
    return c;
}


#define ROW_LOAD(v, ptr) _Pragma("unroll") for (int j = 0; j < 8; ++j) v[j] = ((const GAS f32x4*)(ptr))[lane + 64 * j]
__device__ __forceinline__ void row_add_moe(f32x4 (&v)[8], const bf16* yp, size_t R1, size_t R2, float g1, float g2, int lane) {
#pragma unroll
    for (int j = 0; j < 8; ++j) { const v2u a = ((const GAS v2u*)(yp + R1 * DM))[lane + 64 * j], b = ((const GAS v2u*)(yp + R2 * DM))[lane + 64 * j];
        v[j].x += g1 * bf2f((bf16)(a.x & 0xffff)) + g2 * bf2f((bf16)(b.x & 0xffff)); v[j].y += g1 * bf2f((bf16)(a.x >> 16)) + g2 * bf2f((bf16)(b.x >> 16));
        v[j].z += g1 * bf2f((bf16)(a.y & 0xffff)) + g2 * bf2f((bf16)(b.y & 0xffff)); v[j].w += g1 * bf2f((bf16)(a.y >> 16)) + g2 * bf2f((bf16)(b.y >> 16)); }
}
__device__ __forceinline__ float row_rstd(const f32x4 (&v)[8], int lane) {
    float ss = 0.f;
#pragma unroll
    for (int j = 0; j < 8; ++j) ss += (v[j].x * v[j].x + v[j].y * v[j].y) + (v[j].z * v[j].z + v[j].w * v[j].w);
    return 1.f / sqrtf(wave_sum(ss, lane) * (1.f / DM) + NORM_EPS);
}
#define SEAM(k) do { if constexpr (KSEL < 0) { XcdBarrier b_ = bar; unsigned blo_ = __builtin_amdgcn_readfirstlane((unsigned)(unsigned long long)b_.bar), bhi_ = __builtin_amdgcn_readfirstlane((unsigned)((unsigned long long)b_.bar >> 32)); \
    asm volatile("" : "+s"(blo_), "+s"(bhi_)); b_.bar = (unsigned*)(((unsigned long long)bhi_ << 32) | blo_); xcd_barrier(b_); } } while (0)
#define PH_ON(k) if constexpr ((KSEL < 0 && KB_EN(k)) || KSEL == (k))
#define PHASE_LOCALS() unsigned char* ws = args.ws; int ll = KSEL < 0 ? l : __builtin_amdgcn_readfirstlane(l); int tid = threadIdx.x; asm volatile("" : "+s"(ws), "+s"(ll), "+v"(tid)); \
    const int lane = tid & 63, wave = __builtin_amdgcn_readfirstlane(tid >> 6); \
    const int G = gridDim.x, bid = blockIdx.x; const long gtid = (long)bid * 512 + tid, gstride = (long)G * 512; const int gw = bid * 8 + wave, NGW = G * 8; \
    (void)gtid; (void)gstride; (void)gw; (void)NGW; (void)ll; (void)lane


typedef short bf16x8 __attribute__((ext_vector_type(8)));
typedef short s16x4 __attribute__((ext_vector_type(4)));
typedef short v4i16_t __attribute__((ext_vector_type(4)));
#define MMA16(a, b, c) __builtin_amdgcn_mfma_f32_16x16x32_bf16((a), (b), (c), 0, 0, 0)
__device__ __forceinline__ bf16x8 frag_row(const LAS bf16* X, int ld, int r0, int c0, int fr, int fq) { return *(const LAS bf16x8*)(X + (r0 + fr) * ld + c0 + 8 * fq); }
__device__ __forceinline__ s16x4 tr4(const LAS bf16* X, int ld, int r0, int c0, int fr) { return __builtin_bit_cast(s16x4, __builtin_amdgcn_ds_read_tr16_b64_v4i16((LAS v4i16_t*)(X + (r0 + (fr >> 2)) * ld + c0 + 4 * (fr & 3)))); }
__device__ __forceinline__ bf16x8 frag_col(const LAS bf16* X, int ld, int k0, int c0, int fr, int fq) {
    const s16x4 a = tr4(X, ld, k0 + 8 * fq, c0, fr), b = tr4(X, ld, k0 + 8 * fq + 4, c0, fr);
    return (bf16x8){a[0], a[1], a[2], a[3], b[0], b[1], b[2], b[3]}; }
__device__ __forceinline__ unsigned cvtpk(float lo, float hi) { unsigned r; asm("v_cvt_pk_bf16_f32 %0, %1, %2" : "=v"(r) : "v"(lo), "v"(hi)); return r; }
__device__ __forceinline__ float xlane_max4(float v, int lane) {
    v = fmaxf(v, __builtin_bit_cast(float, __builtin_amdgcn_ds_bpermute((lane ^ 16) << 2, __builtin_bit_cast(int, v))));
    v = fmaxf(v, __builtin_bit_cast(float, __builtin_amdgcn_ds_bpermute((lane ^ 32) << 2, __builtin_bit_cast(int, v)))); return v; }
__device__ __forceinline__ float xlane_sum4(float v, int lane) {
    v += __builtin_bit_cast(float, __builtin_amdgcn_ds_bpermute((lane ^ 16) << 2, __builtin_bit_cast(int, v)));
    v += __builtin_bit_cast(float, __builtin_amdgcn_ds_bpermute((lane ^ 32) << 2, __builtin_bit_cast(int, v))); return v; }

constexpr int DIL_LD = 72, DIL_TEAM_BYTES = (64 + 192 + 192) * DIL_LD * 2;
static_assert(2 * DIL_TEAM_BYTES <= RING_BYTES, "dilated attention LDS");
__device__ __forceinline__ void dil_attn_phase(LAS unsigned char* lds, const bf16* proj, bf16* dpo, float* dml, const int tid, const int bid, const int G) {
    const int lane = tid & 63, wave = __builtin_amdgcn_readfirstlane(tid >> 6), team = wave >> 2, w = wave & 3, tt = tid & 255, fr = lane & 15, fq = lane >> 4;
    LAS bf16* Qs = (LAS bf16*)(lds + team * DIL_TEAM_BYTES); LAS bf16* Ks = Qs + 64 * DIL_LD; LAS bf16* Vs = Ks + 192 * DIL_LD;
    constexpr int NITEMS = BATCH * 8 * 3 * 64;
    for (int it0 = bid * 2; it0 < NITEMS; it0 += G * 2) {
        const int it = it0 + team;
        const int blk = it & 63; int r = it >> 6; const int br = r % 3; r /= 3; const int h = r & 7, b = r >> 3;
        const int dil = br == 0 ? 1 : (br == 1 ? 4 : 16), L = SEQ / dil, nb = L / 64, g = blk / nb, n = blk % nb;
        const bf16* base = proj + (size_t)b * SEQ * NPROJ + OFF_D + h * 64;
        __syncthreads();
#pragma unroll
        for (int c = tt; c < 512; c += 256) { const int i = c >> 3, ch = c & 7; const int pos = (64 * n + i) * dil + g;
            *(LAS v4u*)(Qs + i * DIL_LD + ch * 8) = *(const GAS v4u*)(base + (size_t)pos * NPROJ + ch * 8); }
#pragma unroll
        for (int c = tt; c < 1536; c += 256) { const int kr = c >> 3, ch = c & 7; const int kidx = 64 * (n - 1) + kr; const bool ok = kidx >= 0 && kidx < L; const int pos = (ok ? kidx : 0) * dil + g;
            v4u kv = (v4u){0u, 0u, 0u, 0u}, vv = kv;
            if (ok) { kv = *(const GAS v4u*)(base + (size_t)pos * NPROJ + 512 + ch * 8); vv = *(const GAS v4u*)(base + (size_t)pos * NPROJ + 1024 + ch * 8); }
            *(LAS v4u*)(Ks + kr * DIL_LD + ch * 8) = kv; *(LAS v4u*)(Vs + kr * DIL_LD + ch * 8) = vv; }
        __syncthreads();
        bf16x8 qf[2];
#pragma unroll
        for (int ks = 0; ks < 2; ++ks) qf[ks] = frag_row(Qs, DIL_LD, 16 * w, 32 * ks, fr, fq);
        f32x4 sc[12];
#pragma unroll
        for (int kt = 0; kt < 12; ++kt) { sc[kt] = (f32x4){0.f, 0.f, 0.f, 0.f};
#pragma unroll
            for (int ks = 0; ks < 2; ++ks) sc[kt] = MMA16(frag_row(Ks, DIL_LD, 16 * kt, 32 * ks, fr, fq), qf[ks], sc[kt]); }
        const int qi = 64 * n + 16 * w + fr; float mx = -1e30f;
#pragma unroll
        for (int kt = 0; kt < 12; ++kt)
#pragma unroll
            for (int j = 0; j < 4; ++j) { const int ki = 64 * (n - 1) + 16 * kt + 4 * fq + j; const int dd = ki - qi; const bool ok = dd >= -64 && dd <= 64 && ki >= 0 && ki < L;
                sc[kt][j] = ok ? sc[kt][j] : -1e30f; mx = fmaxf(mx, sc[kt][j]); }
        mx = xlane_max4(mx, lane);
        float den = 0.f;
#pragma unroll
        for (int kt = 0; kt < 12; ++kt)
#pragma unroll
            for (int j = 0; j < 4; ++j) { const float p = sc[kt][j] > -1e29f ? __expf(sc[kt][j] - mx) : 0.f; sc[kt][j] = p; den += p; }
        den = xlane_sum4(den, lane);
        f32x4 o[4];
#pragma unroll
        for (int et = 0; et < 4; ++et) o[et] = (f32x4){0.f, 0.f, 0.f, 0.f};
#pragma unroll
        for (int u = 0; u < 6; ++u) {
            const unsigned p0 = cvtpk(sc[2 * u][0], sc[2 * u][1]), p1 = cvtpk(sc[2 * u][2], sc[2 * u][3]), p2 = cvtpk(sc[2 * u + 1][0], sc[2 * u + 1][1]), p3 = cvtpk(sc[2 * u + 1][2], sc[2 * u + 1][3]);
            const bf16x8 pf = __builtin_bit_cast(bf16x8, (v4u){p0, p1, p2, p3});
#pragma unroll
            for (int et = 0; et < 4; ++et) { const s16x4 a = tr4(Vs, DIL_LD, 32 * u + 4 * fq, 16 * et, fr), bq = tr4(Vs, DIL_LD, 32 * u + 16 + 4 * fq, 16 * et, fr);
                o[et] = MMA16(((bf16x8){a[0], a[1], a[2], a[3], bq[0], bq[1], bq[2], bq[3]}), pf, o[et]); }
        }
        const float inv = 1.f / den; const size_t t = (size_t)b * SEQ + (size_t)qi * dil + g;
        bf16* op = dpo + ((size_t)br * T + t) * 512 + h * 64 + 4 * fq;
#pragma unroll
        for (int et = 0; et < 4; ++et) { v2u pk; pk.x = cvtpk(o[et][0] * inv, o[et][1] * inv); pk.y = cvtpk(o[et][2] * inv, o[et][3] * inv); *(GAS v2u*)(op + 16 * et) = pk; }
        if (fq == 0) { float* mp = dml + (((size_t)br * T + t) * 8 + h) * 2; mp[0] = mx; mp[1] = den; }
    }
}

constexpr int RET_LD = 72, RET1_TEAM_BYTES = 3 * 128 * RET_LD * 2;
static_assert(2 * RET1_TEAM_BYTES <= RING_BYTES && (3 * 128 + 2 * 64) * RET_LD * 2 <= RING_BYTES, "retention LDS");
__device__ __forceinline__ void unpack8(const v4u x, float (&f)[8]) {
    f[0] = __builtin_bit_cast(float, x.x << 16); f[1] = __builtin_bit_cast(float, x.x & 0xffff0000u); f[2] = __builtin_bit_cast(float, x.y << 16); f[3] = __builtin_bit_cast(float, x.y & 0xffff0000u);
    f[4] = __builtin_bit_cast(float, x.z << 16); f[5] = __builtin_bit_cast(float, x.z & 0xffff0000u); f[6] = __builtin_bit_cast(float, x.w << 16); f[7] = __builtin_bit_cast(float, x.w & 0xffff0000u); }
__device__ __forceinline__ void ret_kv_phase(LAS unsigned char* lds, const bf16* proj, const float* gam, float* rkv, const int tid, const int bid, const int G) {
    const int lane = tid & 63, wave = __builtin_amdgcn_readfirstlane(tid >> 6), team = wave >> 2, w = wave & 3, tt = tid & 255, fr = lane & 15, fq = lane >> 4;
    LAS bf16* Kf = (LAS bf16*)(lds + team * RET1_TEAM_BYTES); LAS bf16* Kb = Kf + 128 * RET_LD; LAS bf16* Vs = Kb + 128 * RET_LD;
    constexpr int NITEMS = BATCH * 8 * NC;
    for (int it0 = bid * 2; it0 < NITEMS; it0 += G * 2) {
        const int it = it0 + team; const int ch = it % NC, h = (it / NC) & 7, b = it / (NC * 8);
        const float lgf = logsigmoidf_(gam[h]), lgb = logsigmoidf_(gam[8 + h]);
        const bf16* base = proj + ((size_t)b * SEQ + (size_t)ch * 128) * NPROJ + OFF_A + h * 64;
        __syncthreads();
#pragma unroll
        for (int c = tt; c < 1024; c += 256) { const int m = c >> 3, cc = c & 7;
            const v4u kv = *(const GAS v4u*)(base + (size_t)m * NPROJ + 512 + cc * 8), vv = *(const GAS v4u*)(base + (size_t)m * NPROJ + 1024 + cc * 8);
            float f[8]; unpack8(kv, f); const float df = __expf(lgf * (float)(127 - m)), db = __expf(lgb * (float)m);
            *(LAS v4u*)(Kf + m * RET_LD + cc * 8) = (v4u){cvtpk(f[0] * df, f[1] * df), cvtpk(f[2] * df, f[3] * df), cvtpk(f[4] * df, f[5] * df), cvtpk(f[6] * df, f[7] * df)};
            *(LAS v4u*)(Kb + m * RET_LD + cc * 8) = (v4u){cvtpk(f[0] * db, f[1] * db), cvtpk(f[2] * db, f[3] * db), cvtpk(f[4] * db, f[5] * db), cvtpk(f[6] * db, f[7] * db)};
            *(LAS v4u*)(Vs + m * RET_LD + cc * 8) = vv; }
        __syncthreads();
        f32x4 aF[4], aB[4];
#pragma unroll
        for (int dt = 0; dt < 4; ++dt) { aF[dt] = (f32x4){0.f, 0.f, 0.f, 0.f}; aB[dt] = aF[dt]; }
#pragma unroll
        for (int ks = 0; ks < 4; ++ks) { const bf16x8 a = frag_col(Vs, RET_LD, 32 * ks, 16 * w, fr, fq);
#pragma unroll
            for (int dt = 0; dt < 4; ++dt) { aF[dt] = MMA16(a, frag_col(Kf, RET_LD, 32 * ks, 16 * dt, fr, fq), aF[dt]); aB[dt] = MMA16(a, frag_col(Kb, RET_LD, 32 * ks, 16 * dt, fr, fq), aB[dt]); } }
        float* oF = rkv + ((size_t)((b * 8 + h) * 2 + 0) * NC + ch) * 4096; float* oB = rkv + ((size_t)((b * 8 + h) * 2 + 1) * NC + ch) * 4096;
#pragma unroll
        for (int dt = 0; dt < 4; ++dt)
#pragma unroll
            for (int j = 0; j < 4; ++j) { const int e = 16 * w + 4 * fq + j, d = 16 * dt + fr; oF[e * 64 + d] = aF[dt][j]; oB[e * 64 + d] = aB[dt][j]; }
    }
}
__device__ __forceinline__ void ret_out_phase(LAS unsigned char* lds, const bf16* proj, const float* gam, const float* ret_g, const float* rsp, bf16* ycat, const int tid, const int bid, const int G) {
    const int lane = tid & 63, w = __builtin_amdgcn_readfirstlane(tid >> 6), fr = lane & 15, fq = lane >> 4;
    LAS bf16* Qs = (LAS bf16*)lds; LAS bf16* Ks = Qs + 128 * RET_LD; LAS bf16* Vs = Ks + 128 * RET_LD; LAS bf16* Sf = Vs + 128 * RET_LD; LAS bf16* Sb = Sf + 64 * RET_LD;
    constexpr int NITEMS = BATCH * 8 * NC;
    for (int it = bid; it < NITEMS; it += G) {
        const int ch = it % NC, h = (it / NC) & 7, b = it / (NC * 8);
        const float lgf = logsigmoidf_(gam[h]), lgb = logsigmoidf_(gam[8 + h]);
        const size_t t0 = (size_t)b * SEQ + (size_t)ch * 128;
        const bf16* base = proj + t0 * NPROJ + OFF_A + h * 64;
        const float* gSf = rsp + ((size_t)((b * 8 + h) * 2 + 0) * NC + ch) * 4096; const float* gSb = rsp + ((size_t)((b * 8 + h) * 2 + 1) * NC + ch) * 4096;
        __syncthreads();
#pragma unroll
        for (int c = tid; c < 1024; c += 512) { const int m = c >> 3, cc = c & 7; const bf16* rp = base + (size_t)m * NPROJ + cc * 8;
            *(LAS v4u*)(Qs + m * RET_LD + cc * 8) = *(const GAS v4u*)(rp); *(LAS v4u*)(Ks + m * RET_LD + cc * 8) = *(const GAS v4u*)(rp + 512); *(LAS v4u*)(Vs + m * RET_LD + cc * 8) = *(const GAS v4u*)(rp + 1024); }
#pragma unroll
        for (int c = tid; c < 1024; c += 512) { const int e = c >> 4, d4 = (c & 15) * 4; const f32x4 a = *(const GAS f32x4*)(gSf + e * 64 + d4), bb = *(const GAS f32x4*)(gSb + e * 64 + d4);
            *(LAS v2u*)(Sf + e * RET_LD + d4) = (v2u){cvtpk(a.x, a.y), cvtpk(a.z, a.w)}; *(LAS v2u*)(Sb + e * RET_LD + d4) = (v2u){cvtpk(bb.x, bb.y), cvtpk(bb.z, bb.w)}; }
        __syncthreads();
        bf16x8 qf[2];
#pragma unroll
        for (int ks = 0; ks < 2; ++ks) qf[ks] = frag_row(Qs, RET_LD, 16 * w, 32 * ks, fr, fq);
        f32x4 sc[8];
#pragma unroll
        for (int kt = 0; kt < 8; ++kt) { sc[kt] = (f32x4){0.f, 0.f, 0.f, 0.f};
#pragma unroll
            for (int ks = 0; ks < 2; ++ks) sc[kt] = MMA16(frag_row(Ks, RET_LD, 16 * kt, 32 * ks, fr, fq), qf[ks], sc[kt]); }
        const int n = 16 * w + fr;
#pragma unroll
        for (int kt = 0; kt < 8; ++kt)
#pragma unroll
            for (int j = 0; j < 4; ++j) { const int m = 16 * kt + 4 * fq + j; sc[kt][j] *= m <= n ? __expf(lgf * (float)(n - m)) : __expf(lgb * (float)(m - n)); }
        f32x4 o[4], aF[4], aB[4];
#pragma unroll
        for (int et = 0; et < 4; ++et) { o[et] = (f32x4){0.f, 0.f, 0.f, 0.f}; aF[et] = o[et]; aB[et] = o[et]; }
#pragma unroll
        for (int u = 0; u < 4; ++u) {
            const bf16x8 pf = __builtin_bit_cast(bf16x8, (v4u){cvtpk(sc[2 * u][0], sc[2 * u][1]), cvtpk(sc[2 * u][2], sc[2 * u][3]), cvtpk(sc[2 * u + 1][0], sc[2 * u + 1][1]), cvtpk(sc[2 * u + 1][2], sc[2 * u + 1][3])});
#pragma unroll
            for (int et = 0; et < 4; ++et) { const s16x4 a = tr4(Vs, RET_LD, 32 * u + 4 * fq, 16 * et, fr), bq = tr4(Vs, RET_LD, 32 * u + 16 + 4 * fq, 16 * et, fr);
                o[et] = MMA16(((bf16x8){a[0], a[1], a[2], a[3], bq[0], bq[1], bq[2], bq[3]}), pf, o[et]); }
        }
#pragma unroll
        for (int et = 0; et < 4; ++et)
#pragma unroll
            for (int ks = 0; ks < 2; ++ks) { aF[et] = MMA16(frag_row(Sf, RET_LD, 16 * et, 32 * ks, fr, fq), qf[ks], aF[et]); aB[et] = MMA16(frag_row(Sb, RET_LD, 16 * et, 32 * ks, fr, fq), qf[ks], aB[et]); }
        const float qdf = __expf(lgf * (float)(n + 1)), qdb = __expf(lgb * (float)(128 - n));
        float mu = 0.f;
#pragma unroll
        for (int et = 0; et < 4; ++et)
#pragma unroll
            for (int j = 0; j < 4; ++j) { o[et][j] += qdf * aF[et][j] + qdb * aB[et][j]; mu += o[et][j]; }
        mu = xlane_sum4(mu, lane) * (1.f / 64.f);
        float var = 0.f;
#pragma unroll
        for (int et = 0; et < 4; ++et)
#pragma unroll
            for (int j = 0; j < 4; ++j) { const float dlt = o[et][j] - mu; var += dlt * dlt; }
        const float rstd = 1.f / sqrtf(xlane_sum4(var, lane) * (1.f / 64.f) + GN_EPS);
        const bf16* gp = proj + (t0 + n) * NPROJ + OFF_A + 1536 + h * 64 + 4 * fq; bf16* yp = ycat + (t0 + n) * 2048 + h * 64 + 4 * fq; const float* gg = ret_g + h * 64 + 4 * fq;
#pragma unroll
        for (int et = 0; et < 4; ++et) { const v2u gv = *(const GAS v2u*)(gp + 16 * et); const f32x4 gn = *(const GAS f32x4*)(gg + 16 * et);
            const float g0 = __builtin_bit_cast(float, gv.x << 16), g1 = __builtin_bit_cast(float, gv.x & 0xffff0000u), g2 = __builtin_bit_cast(float, gv.y << 16), g3 = __builtin_bit_cast(float, gv.y & 0xffff0000u);
            const float y0 = siluf_(g0) * ((o[et][0] - mu) * rstd * gn.x), y1 = siluf_(g1) * ((o[et][1] - mu) * rstd * gn.y), y2 = siluf_(g2) * ((o[et][2] - mu) * rstd * gn.z), y3 = siluf_(g3) * ((o[et][3] - mu) * rstd * gn.w);
            *(GAS v2u*)(yp + 16 * et) = (v2u){cvtpk(y0, y1), cvtpk(y2, y3)}; }
    }
}
constexpr int SGU_LDV = 72, SGU_LDW = 136, SGU_TEAM_BYTES = (128 * SGU_LDV + 128 * SGU_LDW) * 2;
static_assert(2 * SGU_TEAM_BYTES <= RING_BYTES, "SGU LDS");
__device__ __forceinline__ void sgu_phase(LAS unsigned char* lds, const bf16* proj, const float* sgu_w, const float* sgu_bias, bf16* ycat, const int tid, const int bid, const int G) {
    const int lane = tid & 63, wave = __builtin_amdgcn_readfirstlane(tid >> 6), team = wave >> 2, w = wave & 3, tt = tid & 255, fr = lane & 15, fq = lane >> 4;
    LAS bf16* Vn = (LAS bf16*)(lds + team * SGU_TEAM_BYTES); LAS bf16* Ws = Vn + 128 * SGU_LDV;
    constexpr int NITEMS = BATCH * NC * 8;
    for (int it0 = bid * 2; it0 < NITEMS; it0 += G * 2) {
        const int it = it0 + team; const int bc = it % (BATCH * NC), g = it / (BATCH * NC);
        const size_t t0 = (size_t)bc * 128;
        const bf16* vb = proj + t0 * NPROJ + OFF_C + 512 + g * 64; const float* wsrc = sgu_w + (size_t)g * 128 * 128;
        __syncthreads();
#pragma unroll
        for (int c = tt; c < 1024; c += 256) { const int q = c >> 3, cc = c & 7; *(LAS v4u*)(Vn + q * SGU_LDV + cc * 8) = *(const GAS v4u*)(vb + (size_t)q * NPROJ + cc * 8); }
#pragma unroll
        for (int c = tt; c < 4096; c += 256) { const int p = c >> 5, q4 = (c & 31) * 4; const f32x4 a = *(const GAS f32x4*)(wsrc + p * 128 + q4); *(LAS v2u*)(Ws + p * SGU_LDW + q4) = (v2u){cvtpk(a.x, a.y), cvtpk(a.z, a.w)}; }
        __syncthreads();
        f32x4 acc[2][4];
#pragma unroll
        for (int i = 0; i < 2; ++i)
#pragma unroll
            for (int dt = 0; dt < 4; ++dt) acc[i][dt] = (f32x4){0.f, 0.f, 0.f, 0.f};
#pragma unroll
        for (int ks = 0; ks < 4; ++ks) { bf16x8 a[4];
#pragma unroll
            for (int dt = 0; dt < 4; ++dt) a[dt] = frag_col(Vn, SGU_LDV, 32 * ks, 16 * dt, fr, fq);
#pragma unroll
            for (int i = 0; i < 2; ++i) { const bf16x8 bfr = frag_row(Ws, SGU_LDW, 16 * (2 * w + i), 32 * ks, fr, fq);
#pragma unroll
                for (int dt = 0; dt < 4; ++dt) acc[i][dt] = MMA16(a[dt], bfr, acc[i][dt]); } }
#pragma unroll
        for (int i = 0; i < 2; ++i) { const int p = 16 * (2 * w + i) + fr; const float bias = sgu_bias[g * 128 + p];
            const bf16* up = proj + (t0 + p) * NPROJ + OFF_C + g * 64 + 4 * fq; bf16* yp = ycat + (t0 + p) * 2048 + 1024 + g * 64 + 4 * fq;
#pragma unroll
            for (int dt = 0; dt < 4; ++dt) { const v2u uv = *(const GAS v2u*)(up + 16 * dt);
                const float u0 = __builtin_bit_cast(float, uv.x << 16), u1 = __builtin_bit_cast(float, uv.x & 0xffff0000u), u2 = __builtin_bit_cast(float, uv.y << 16), u3 = __builtin_bit_cast(float, uv.y & 0xffff0000u);
                *(GAS v2u*)(yp + 16 * dt) = (v2u){cvtpk(geluf_(u0) * (acc[i][dt][0] + bias), geluf_(u1) * (acc[i][dt][1] + bias)), cvtpk(geluf_(u2) * (acc[i][dt][2] + bias), geluf_(u3) * (acc[i][dt][3] + bias))}; } }
    }
}

__device__ __forceinline__ float quad_sum(float v) {
    v += __builtin_bit_cast(float, __builtin_amdgcn_update_dpp(0, __builtin_bit_cast(int, v), 0xB1, 0xF, 0xF, true));
    v += __builtin_bit_cast(float, __builtin_amdgcn_update_dpp(0, __builtin_bit_cast(int, v), 0x4E, 0xF, 0xF, true));
    return v;
}
__device__ __forceinline__ void rwkv_scan_quad(const Ctx& c, int unit, int w4, int lane) {
    const int dir = unit & 1, h = (unit >> 1) & 7, b = unit >> 4; const int row = w4 * 16 + (lane >> 2), q = lane & 3;
    const float* W = dir ? c.wb : c.wf; const bf16* KD = dir ? c.kdb : c.kdf; const bf16* AK = dir ? c.akb : c.akf; bf16* Y = dir ? c.yb : c.yf;
    float S[16];
#pragma unroll
    for (int i = 0; i < 16; ++i) S[i] = 0.f;
    for (int k = 0; k < SEQ; ++k) {
        const int s = dir ? SEQ - 1 - k : k; const size_t o = ((size_t)b * SEQ + s) * 512 + h * 64 + q * 16;
        float kkv[16], akv[16], kdv[16], rv[16], wv[16];
        { const v4u a = *(const GAS v4u*)(c.kk + o), bq = *(const GAS v4u*)(c.kk + o + 8);
          const unsigned t[8] = {a.x, a.y, a.z, a.w, bq.x, bq.y, bq.z, bq.w};
#pragma unroll
          for (int i = 0; i < 8; ++i) { kkv[2 * i] = __builtin_bit_cast(float, t[i] << 16); kkv[2 * i + 1] = __builtin_bit_cast(float, t[i] & 0xffff0000u); } }
        { const v4u a = *(const GAS v4u*)(AK + o), bq = *(const GAS v4u*)(AK + o + 8);
          const unsigned t[8] = {a.x, a.y, a.z, a.w, bq.x, bq.y, bq.z, bq.w};
#pragma unroll
          for (int i = 0; i < 8; ++i) { akv[2 * i] = __builtin_bit_cast(float, t[i] << 16); akv[2 * i + 1] = __builtin_bit_cast(float, t[i] & 0xffff0000u); } }
        { const v4u a = *(const GAS v4u*)(KD + o), bq = *(const GAS v4u*)(KD + o + 8);
          const unsigned t[8] = {a.x, a.y, a.z, a.w, bq.x, bq.y, bq.z, bq.w};
#pragma unroll
          for (int i = 0; i < 8; ++i) { kdv[2 * i] = __builtin_bit_cast(float, t[i] << 16); kdv[2 * i + 1] = __builtin_bit_cast(float, t[i] & 0xffff0000u); } }
        { const v4u a = *(const GAS v4u*)(c.rs + o), bq = *(const GAS v4u*)(c.rs + o + 8);
          const unsigned t[8] = {a.x, a.y, a.z, a.w, bq.x, bq.y, bq.z, bq.w};
#pragma unroll
          for (int i = 0; i < 8; ++i) { rv[2 * i] = __builtin_bit_cast(float, t[i] << 16); rv[2 * i + 1] = __builtin_bit_cast(float, t[i] & 0xffff0000u); } }
#pragma unroll
        for (int i = 0; i < 4; ++i) { const f32x4 w4v = *(const GAS f32x4*)(W + o + 4 * i); wv[4 * i] = w4v.x; wv[4 * i + 1] = w4v.y; wv[4 * i + 2] = w4v.z; wv[4 * i + 3] = w4v.w; }
        const float v = bf2f(c.vs[o - q * 16 + row]);
        float sk = 0.f;
#pragma unroll
        for (int i = 0; i < 16; ++i) sk += S[i] * kkv[i];
        sk = quad_sum(sk);
        float y = 0.f;
#pragma unroll
        for (int i = 0; i < 16; ++i) { S[i] = S[i] * wv[i] - sk * akv[i] + v * kdv[i]; y += S[i] * rv[i]; }
        y = quad_sum(y);
        if (q == 0) Y[o + row] = f2bf(y);
    }
}
template <int KSEL>
__device__ __forceinline__ void layer_program(const Args& args, LAS unsigned char* lds, const XcdBarrier& bar, const int l) {
        PH_ON(0) {
            PHASE_LOCALS();
            bf16* WinT = (bf16*)(ws + WS_WIN); bf16* WoutT = (bf16*)(ws + WS_WOUT); bf16* Wgu = (bf16*)(ws + WS_WGU); bf16* WdT = (bf16*)(ws + WS_WD);
            LAS float* scr = (LAS float*)(lds + wave * 16384);
            const float* w_in = (const float*)args.in[3] + (size_t)ll * DM * D_IN; const float* w_out = (const float*)args.in[4] + (size_t)ll * DM * DM;
            const float* wg_ = (const float*)args.in[26] + (size_t)ll * NEXP * DM * DE; const float* wu_ = (const float*)args.in[27] + (size_t)ll * NEXP * DM * DE; const float* wd_ = (const float*)args.in[28] + (size_t)ll * NEXP * DE * DM;
            constexpr int I_IN = (DM / 64) * (D_IN / 32), I_OUT = (DM / 64) * (DM / 32), I_GU = (DM / 64) * (DE / 32), I_D = (DE / 64) * (DM / 32);
            constexpr int NITEMS = I_IN + I_OUT + NEXP * (2 * I_GU + I_D);
            for (int it = gw; it < NITEMS; it += NGW) {
                int r = it;
                if (r < I_IN) { const int nblk = D_IN / 32, kb = r / nblk, nb = r % nblk; transpose_item(w_in, DM, D_IN, WinT, 64 * kb, 32 * nb, 32 * nb, scr, lane); continue; } r -= I_IN;
                if (r < I_OUT) { const int nblk = DM / 32, kb = r / nblk, nb = r % nblk; transpose_item(w_out, DM, DM, WoutT, 64 * kb, 32 * nb, 32 * nb, scr, lane); continue; } r -= I_OUT;
                const int e = r / (2 * I_GU + I_D); r -= e * (2 * I_GU + I_D);
                if (r < 2 * I_GU) { const int up = r >= I_GU ? 1 : 0; r -= up * I_GU; const int nblk = DE / 32, kb = r / nblk, nb = r % nblk, n0 = 32 * nb;
                    transpose_item((up ? wu_ : wg_) + (size_t)e * DM * DE, DM, DE, Wgu + (size_t)e * 1024 * DM, 64 * kb, n0, (n0 >> 7) * 256 + (n0 & 127) + up * 128, scr, lane); continue; }
                r -= 2 * I_GU;
                { const int nblk = DM / 32, kb = r / nblk, nb = r % nblk; transpose_item(wd_ + (size_t)e * DE * DM, DE, DM, WdT + (size_t)e * DM * DE, 64 * kb, 32 * nb, 32 * nb, scr, lane); }
            }
            for (long i = gtid; i < (long)(NPROJ - D_IN) * DM / 8; i += gstride) ((GAS v4u*)(WinT + (size_t)D_IN * DM))[i] = (v4u){0u, 0u, 0u, 0u};
            if (ll > 0) build_moe_tables(lds, (const unsigned*)(ws + WS_CTL) + CW_CNT + (ll - 1) * 2048, tid);
            const LAS int* trb = (const LAS int*)(lds + TAB_ROWBASE);
            const float* x_in = (const float*)args.in[0]; float* xbuf = (float*)(ws + WS_X); bf16* act = (bf16*)(ws + WS_ACT); const bf16* yp = (const bf16*)(ws + WS_YP);
            const unsigned* slot_tok = (const unsigned*)(ws + WS_SLOT); const float* gate_tok = (const float*)(ws + WS_GATE);
            const float* norm1_g = (const float*)args.in[2] + ll * DM;
            for (int m = gw; m < T; m += NGW) {
                f32x4 v[8];
                ROW_LOAD(v, (ll == 0 ? x_in : xbuf) + (size_t)m * DM);
                if (ll > 0) {
                    const unsigned s1 = slot_tok[2 * m], s2 = slot_tok[2 * m + 1]; const float g1 = gate_tok[2 * m], g2 = gate_tok[2 * m + 1];
                    row_add_moe(v, yp, (size_t)(trb[s1 >> 20] + (int)(s1 & 0xfffffu)), (size_t)(trb[s2 >> 20] + (int)(s2 & 0xfffffu)), g1, g2, lane);
#pragma unroll
                    for (int j = 0; j < 8; ++j) ((GAS f32x4*)(xbuf + (size_t)m * DM))[lane + 64 * j] = v[j];
                }
                const float rstd = row_rstd(v, lane);
#pragma unroll
                for (int j = 0; j < 8; ++j) { const f32x4 g = ((const GAS f32x4*)norm1_g)[lane + 64 * j];
                    v2u o; o.x = pk2(v[j].x * rstd * g.x, v[j].y * rstd * g.y); o.y = pk2(v[j].z * rstd * g.z, v[j].w * rstd * g.w);
                    ((GAS v2u*)(act + (size_t)m * DM))[lane + 64 * j] = o; }
            }
        }
        SEAM(0);
        PH_ON(1) {
            PHASE_LOCALS();
            pg8::Gemm g{(const bf16*)(ws + WS_ACT), (const bf16*)(ws + WS_WIN), T, NPROJ, DM, 0}; pg8::StaticOrder<T, NPROJ> S; S.init(G, bid);
            pg8::EpiBf16 E{(bf16*)(ws + WS_PROJ), NPROJ};
            pg8::gemm_phase<DM, pg8::EpiBf16, pg8::StaticOrder<T, NPROJ>, true, true>(lds, g, S, E, tid);
        }
        SEAM(1);
        PH_ON(2) { PHASE_LOCALS(); const Ctx c = make_ctx(args, ws, ll);
            for (long i = gtid; i < (long)T * 256; i += gstride) el_rot_ret(c, i);
            for (long i = gtid; i < (long)T * 256; i += gstride) el_rot_dil(c, i);
            for (long i = gtid; i < (long)T * B_COLS; i += gstride) el_rwkv_shift(c, i);
            for (long i = gtid; i < (long)T; i += gstride) el_sgu_prep(c, i); }
        SEAM(2);
        PH_ON(3) { PHASE_LOCALS(); const Ctx c = make_ctx(args, ws, ll);
            for (long i = gtid; i < (long)T * 512; i += gstride) el_rwkv_lora(c, i);
            ret_kv_phase(lds, c.proj, c.gam, c.rkv, tid, bid, G);
            sgu_phase(lds, c.proj, c.sgu_w, c.sgu_bias, c.ycat, tid, bid, G);
            dil_attn_phase(lds, c.proj, (bf16*)(ws + WS_DPO), (float*)(ws + WS_DML), tid, bid, G); }
        SEAM(3);
        PH_ON(4) { PHASE_LOCALS(); const Ctx c = make_ctx(args, ws, ll);
            for (long i = gtid; i < (long)T * 8; i += gstride) el_rwkv_kk(c, i);
            for (long i = gtid; i < (long)BATCH * 8 * 2 * 4096; i += gstride) el_ret_scan(c, i); }
        SEAM(4);
        PH_ON(5) { PHASE_LOCALS(); const Ctx c = make_ctx(args, ws, ll);
            for (int u = bid + G * (wave >> 2); u < BATCH * 16; u += G * 2) rwkv_scan_quad(c, u, wave & 3, lane); }
        SEAM(5);
        PH_ON(6) { PHASE_LOCALS(); const Ctx c = make_ctx(args, ws, ll);
            for (long i = gtid; i < (long)T * 8; i += gstride) el_dil_combine((const bf16*)(ws + WS_DPO), (const float*)(ws + WS_DML), c.ycat, i);
            ret_out_phase(lds, c.proj, c.gam, c.ret_g, c.rsp, c.ycat, tid, bid, G);
            for (long i = gtid; i < (long)T * 8; i += gstride) el_rwkv_fin(c, i); }
        SEAM(6);
        PH_ON(7) {
            PHASE_LOCALS();
            pg8::Gemm g{(const bf16*)(ws + WS_ACT), (const bf16*)(ws + WS_WOUT), T, DM, DM, 0}; pg8::StaticOrder<T, DM> S; S.init(G, bid);
            pg8::EpiResF32 E{ll == 0 ? (const float*)args.in[0] : (const float*)(ws + WS_X), (float*)(ws + WS_X), DM};
            pg8::gemm_phase<DM, pg8::EpiResF32, pg8::StaticOrder<T, DM>, true, true>(lds, g, S, E, tid);
        }
        SEAM(7);
        PH_ON(8) {
            PHASE_LOCALS();
            const float* wg = (const float*)args.in[22] + (size_t)ll * DM * 4; const float* bg = (const float*)args.in[23] + ll * 4;
            const float* we = (const float*)args.in[24] + (size_t)ll * DM * 32; const float* be = (const float*)args.in[25] + ll * 32;
            const float* norm2_g = (const float*)args.in[21] + ll * DM;
            const float* xbuf = (const float*)(ws + WS_X); bf16* act = (bf16*)(ws + WS_ACT);
            unsigned* cnt_cur = (unsigned*)(ws + WS_CTL) + CW_CNT + ll * 2048;
            int* tok_of = (int*)(ws + WS_TOK); unsigned* slot_tok = (unsigned*)(ws + WS_SLOT); float* gate_tok = (float*)(ws + WS_GATE);
            for (int m = gw; m < T; m += NGW) {
                f32x4 v[8];
                ROW_LOAD(v, xbuf + (size_t)m * DM);
                const float rstd = row_rstd(v, lane);
#pragma unroll
                for (int j = 0; j < 8; ++j) { const f32x4 g = ((const GAS f32x4*)norm2_g)[lane + 64 * j];
                    v[j] = (f32x4){v[j].x * rstd * g.x, v[j].y * rstd * g.y, v[j].z * rstd * g.z, v[j].w * rstd * g.w};
                    v2u o; o.x = pk2(v[j].x, v[j].y); o.y = pk2(v[j].z, v[j].w);
                    ((GAS v2u*)(act + (size_t)m * DM))[lane + 64 * j] = o; }
                LAS f32x4* hrow = (LAS f32x4*)(lds + wave * 16384);
#pragma unroll
                for (int j = 0; j < 8; ++j) hrow[lane + 64 * j] = v[j];
                LDS_WAIT(); asm volatile("" ::: "memory");
                float lg[4], le[32];
#pragma unroll
                for (int i = 0; i < 4; ++i) lg[i] = 0.f;
#pragma unroll
                for (int i = 0; i < 32; ++i) le[i] = 0.f;
#pragma unroll 1
                for (int kk = 0; kk < 32; ++kk) { const int k = kk * 64 + lane; const float hv = ((const LAS float*)hrow)[k];
                    const f32x4 wgr = *(const GAS f32x4*)(wg + (size_t)k * 4);
                    lg[0] += hv * wgr.x; lg[1] += hv * wgr.y; lg[2] += hv * wgr.z; lg[3] += hv * wgr.w;
#pragma unroll
                    for (int q = 0; q < 8; ++q) { const f32x4 wr = *(const GAS f32x4*)(we + (size_t)k * 32 + 4 * q);
                        le[4 * q] += hv * wr.x; le[4 * q + 1] += hv * wr.y; le[4 * q + 2] += hv * wr.z; le[4 * q + 3] += hv * wr.w; } }
#pragma unroll
                for (int i = 0; i < 4; ++i) lg[i] = wave_sum(lg[i], lane);
#pragma unroll
                for (int i = 0; i < 32; ++i) le[i] = wave_sum(le[i], lane);
                LDS_WAIT(); asm volatile("" ::: "memory");
                int e1, e2; float g1, g2; route_select(lg, le, bg, be, e1, e2, g1, g2);
                if (lane == 0) {
                    const unsigned r1 = __hip_atomic_fetch_add(cnt_cur + 64 * e1, 1u, __ATOMIC_RELAXED, __HIP_MEMORY_SCOPE_AGENT);
                    const unsigned r2 = __hip_atomic_fetch_add(cnt_cur + 64 * e2, 1u, __ATOMIC_RELAXED, __HIP_MEMORY_SCOPE_AGENT);
                    tok_of[(size_t)e1 * T + r1] = m; tok_of[(size_t)e2 * T + r2] = m;
                    slot_tok[2 * m] = ((unsigned)e1 << 20) | r1; slot_tok[2 * m + 1] = ((unsigned)e2 << 20) | r2; gate_tok[2 * m] = g1; gate_tok[2 * m + 1] = g2;
                }
            }
        }
        SEAM(8);
        PH_ON(9) {
            PHASE_LOCALS();
            build_moe_tables(lds, (const unsigned*)(ws + WS_CTL) + CW_CNT + ll * 2048, tid);
            const LAS int* tcnt = (const LAS int*)(lds + TAB_CNT); const LAS int* trb = (const LAS int*)(lds + TAB_ROWBASE); const LAS int* texp = (const LAS int*)(lds + TAB_TEXP);
            const int nrows = ((const LAS int*)(lds + TAB_NT))[0] * 256;
            const int* tok_of = (const int*)(ws + WS_TOK); const bf16* act = (const bf16*)(ws + WS_ACT); bf16* aperm = (bf16*)(ws + WS_APERM);
            for (int R = gw; R < nrows; R += NGW) {
                const int e = texp[R >> 8], r = R - trb[e];
                GAS v4u* dst = (GAS v4u*)(aperm + (size_t)R * DM);
                if (r < tcnt[e]) { const int tok = tok_of[(size_t)e * T + r]; const GAS v4u* src = (const GAS v4u*)(act + (size_t)tok * DM);
#pragma unroll
                    for (int j = 0; j < 4; ++j) dst[lane + 64 * j] = src[lane + 64 * j]; }
                else {
#pragma unroll
                    for (int j = 0; j < 4; ++j) dst[lane + 64 * j] = (v4u){0u, 0u, 0u, 0u}; }
            }
        }
        SEAM(9);
        PH_ON(10) {
            PHASE_LOCALS();
            build_moe_tables(lds, (const unsigned*)(ws + WS_CTL) + CW_CNT + ll * 2048, tid);
            const int ntiles = __builtin_amdgcn_readfirstlane(((const LAS int*)(lds + TAB_NT))[0]);
            pg8::Gemm g{(const bf16*)(ws + WS_APERM), (const bf16*)(ws + WS_WGU), MOE_MAXTILES * 256, 1024, DM, (size_t)1024 * DM * 2};
            pg8::MoeOrder<4> S{G, bid, ntiles, (const LAS int*)(lds + TAB_TEXP)};
            pg8::EpiSwiGLU E{(bf16*)(ws + WS_HID), DE};
            pg8::gemm_phase<DM, pg8::EpiSwiGLU, pg8::MoeOrder<4>, true, true>(lds, g, S, E, tid);
        }
        SEAM(10);
        PH_ON(11) {
            PHASE_LOCALS();
            build_moe_tables(lds, (const unsigned*)(ws + WS_CTL) + CW_CNT + ll * 2048, tid);
            const int ntiles = __builtin_amdgcn_readfirstlane(((const LAS int*)(lds + TAB_NT))[0]);
            pg8::Gemm g{(const bf16*)(ws + WS_HID), (const bf16*)(ws + WS_WD), MOE_MAXTILES * 256, DM, DE, (size_t)DM * DE * 2};
            pg8::MoeOrder<8> S{G, bid, ntiles, (const LAS int*)(lds + TAB_TEXP)};
            pg8::EpiBf16 E{(bf16*)(ws + WS_YP), DM};
            pg8::gemm_phase<DE, pg8::EpiBf16, pg8::MoeOrder<8>, true, true>(lds, g, S, E, tid);
        }
        SEAM(11);
    }

template <int KSEL>
__global__ void __launch_bounds__(512, 2) fwd_kernel(Args args) {
    extern __shared__ __attribute__((aligned(16))) unsigned char lds_raw[];
    LAS unsigned char* lds = (LAS unsigned char*)lds_raw;
    if (threadIdx.x < 4) ((LAS unsigned*)(lds + MISC_OFF))[threadIdx.x] = 0u;
    __syncthreads();
    XcdBarrier bar; bar.bar = (unsigned*)(args.ws + WS_CTL) + CW_BAR; bar.x = 0; bar.st = nullptr;
    if constexpr (KSEL < 0) bar = xcd_barrier_post((unsigned*)(args.ws + WS_CTL) + CW_BAR, (volatile LAS unsigned*)(lds + MISC_OFF));
    if constexpr (KSEL < 0) { layer_program<KSEL>(args, lds, bar, 0); layer_program<KSEL>(args, lds, bar, 1); }
    else if constexpr (KSEL != 12) layer_program<KSEL>(args, lds, bar, args.layer);
    PH_ON(12) {
        const int l = DEPTH - 1;
        PHASE_LOCALS();
        build_moe_tables(lds, (const unsigned*)(ws + WS_CTL) + CW_CNT + ll * 2048, tid);
        const LAS int* trb = (const LAS int*)(lds + TAB_ROWBASE);
        const float* gfin = (const float*)args.in[29]; const float* xbuf = (const float*)(ws + WS_X); const bf16* yp = (const bf16*)(ws + WS_YP);
        const unsigned* slot_tok = (const unsigned*)(ws + WS_SLOT); const float* gate_tok = (const float*)(ws + WS_GATE);
        for (int m = gw; m < T; m += NGW) {
            f32x4 v[8];
            ROW_LOAD(v, xbuf + (size_t)m * DM);
            const unsigned s1 = slot_tok[2 * m], s2 = slot_tok[2 * m + 1]; const float g1 = gate_tok[2 * m], g2 = gate_tok[2 * m + 1];
            row_add_moe(v, yp, (size_t)(trb[s1 >> 20] + (int)(s1 & 0xfffffu)), (size_t)(trb[s2 >> 20] + (int)(s2 & 0xfffffu)), g1, g2, lane);
            const float rstd = row_rstd(v, lane);
#pragma unroll
            for (int j = 0; j < 8; ++j) { const f32x4 g = ((const GAS f32x4*)gfin)[lane + 64 * j];
                ((GAS f32x4*)(args.out + (size_t)m * DM))[lane + 64 * j] = (f32x4){v[j].x * rstd * g.x, v[j].y * rstd * g.y, v[j].z * rstd * g.z, v[j].w * rstd * g.w}; }
        }
    }
#undef SEAM
#undef PH_ON
}

extern "C" void kernel_launch(void* const* d_in, const int* in_sizes, int n_in, void* d_out, int out_size, void* d_ws, size_t ws_size, hipStream_t stream) {
    static int grid = 0;
    if (grid == 0) {
        if (n_in != 30 || in_sizes[0] != T * DM || out_size != T * DM || ws_size < WS_END) { fprintf(stderr, "kernel_launch: unexpected shapes (n_in %d, in0 %d, out %d, ws %zu < %zu)\n", n_in, n_in > 0 ? in_sizes[0] : -1, out_size, ws_size, (size_t)WS_END); grid = -1; return; }
        int dev = 0, cus = 0, per_cu = 0; (void)per_cu;
        if (hipGetDevice(&dev) != hipSuccess || hipDeviceGetAttribute(&cus, hipDeviceAttributeMultiprocessorCount, dev) != hipSuccess) { grid = -1; return; }
#if KB_SPLIT
#define SET_ATTR(k) if (hipFuncSetAttribute((const void*)fwd_kernel<k>, hipFuncAttributeMaxDynamicSharedMemorySize, LDS_BYTES) != hipSuccess) { fprintf(stderr, "kernel_launch: hipFuncSetAttribute failed (%d)\n", k); grid = -1; return; }
        SET_ATTR(0) SET_ATTR(1) SET_ATTR(2) SET_ATTR(3) SET_ATTR(4) SET_ATTR(5) SET_ATTR(6) SET_ATTR(7) SET_ATTR(8) SET_ATTR(9) SET_ATTR(10) SET_ATTR(11) SET_ATTR(12)
#else
        if (hipFuncSetAttribute((const void*)fwd_kernel<-1>, hipFuncAttributeMaxDynamicSharedMemorySize, LDS_BYTES) != hipSuccess) { fprintf(stderr, "kernel_launch: hipFuncSetAttribute failed\n"); grid = -1; return; }
        if (hipOccupancyMaxActiveBlocksPerMultiprocessor(&per_cu, (const void*)fwd_kernel<-1>, 512, LDS_BYTES) != hipSuccess || per_cu < 1) fprintf(stderr, "kernel_launch: occupancy query says %d\n", per_cu);
#endif
        (void)hipGetLastError();
        grid = cus;
    }
    if (grid < 0) return;
    if (hipMemsetAsync((char*)d_ws + WS_CTL, 0, CTL_ZERO_BYTES, stream) != hipSuccess) return;
    Args a{};
    for (int i = 0; i < 30; ++i) a.in[i] = d_in[i];
    a.out = (float*)d_out; a.ws = (unsigned char*)d_ws; a.layer = 0; a.pad = 0;
#if KB_SPLIT
#define LAUNCH_PH(k) hipLaunchKernelGGL(fwd_kernel<k>, dim3(grid), dim3(512), LDS_BYTES, stream, a)
    for (int l = 0; l < DEPTH; ++l) { a.layer = l;
        LAUNCH_PH(0); LAUNCH_PH(1); LAUNCH_PH(2); LAUNCH_PH(3); LAUNCH_PH(4); LAUNCH_PH(5); LAUNCH_PH(6); LAUNCH_PH(7); LAUNCH_PH(8); LAUNCH_PH(9); LAUNCH_PH(10); LAUNCH_PH(11); }
    a.layer = DEPTH - 1; LAUNCH_PH(12);
#else
    hipLaunchKernelGGL(fwd_kernel<-1>, dim3(grid), dim3(512), LDS_BYTES, stream, a);
#endif
}
#endif
```

```cpp
#ifndef KB_EMU
#include <hip/hip_runtime.h>
#endif
#include <cstdio>
#include <cstdint>
#include <cmath>

#ifndef KB_BATCH
#define KB_BATCH 4
#define KB_SEQ 4096
#endif
#ifndef KB_SPLIT
#define KB_SPLIT 0
#endif

#ifndef KB_PHMASK
#define KB_PHMASK 0xffff
#endif
#define KB_EN(k) (((KB_PHMASK) >> (k)) & 1)
#define HD __host__ __device__ __forceinline__
typedef unsigned short bf16;

constexpr int BATCH = KB_BATCH, SEQ = KB_SEQ, T = BATCH * SEQ;
constexpr int DM = 2048, DG = 512, NH = 8, HDIM = 64;
constexpr int A_COLS = 2048, B_COLS = 1984, C_COLS = 1024, D_COLS = 1536, D_IN = 6592, NPROJ = 6656;
constexpr int OFF_A = 0, OFF_B = 2048, OFF_C = 4032, OFF_D = 5056;
constexpr int NC = SEQ / 128;
constexpr int NEXP = 32, DE = 512;
constexpr int NLORA = 448;
constexpr float NORM_EPS = 1e-6f, GN_EPS = 64e-5f;
constexpr int MOE_MAXTILES = (2 * T + NEXP * 255 + 255) / 256;
constexpr int DEPTH = 2;

constexpr size_t MiB = 1u << 20;
constexpr size_t WS_CTL = 0, CTL_ZERO_BYTES = 1 * MiB;
constexpr size_t WS_WIN = 2 * MiB, WS_WOUT = 28 * MiB, WS_WGU = 36 * MiB, WS_WD = 164 * MiB;
constexpr size_t WS_X = 228 * MiB;
constexpr size_t WS_ACT = 356 * MiB;
constexpr size_t WS_PROJ = 420 * MiB;
constexpr size_t WS_RKV = 628 * MiB, WS_RSP = 660 * MiB;
constexpr size_t WS_RS = 692 * MiB, WS_KS = 708 * MiB, WS_VS = 724 * MiB, WS_KK = 740 * MiB, WS_GG = 756 * MiB, WS_KDF = 772 * MiB, WS_KDB = 788 * MiB,
                 WS_AKF = 804 * MiB, WS_AKB = 820 * MiB, WS_YF = 836 * MiB, WS_YB = 852 * MiB, WS_LIN = 868 * MiB  , WS_WF = 882 * MiB, WS_WB = 914 * MiB;
constexpr size_t WS_TOK = 946 * MiB  , WS_SLOT = 948 * MiB, WS_GATE = 949 * MiB;
constexpr size_t WS_RB = 36 * MiB  , WS_PT = 68 * MiB  , WS_QF = 132 * MiB  , WS_YL = 196 * MiB  , WS_DC = 1002 * MiB  ;
constexpr size_t WS_DPO = 950 * MiB  , WS_DML = 998 * MiB  , WS_END = 1004 * MiB;
constexpr size_t WS_APERM = 420 * MiB, WS_HID = 580 * MiB, WS_YP = 620 * MiB;
static_assert((size_t)MOE_MAXTILES * 256 * 2048 * 2 <= 160 * MiB && (size_t)T * NPROJ * 2 <= 208 * MiB, "ws map");
constexpr int CW_BAR = 4096;
constexpr int CW_CNT = 16384;

HD float bf2f(bf16 v) { return __builtin_bit_cast(float, (unsigned)v << 16); }
HD bf16 f2bf(float f) { unsigned u = __builtin_bit_cast(unsigned, f); return (bf16)((u + 0x7fffu + ((u >> 16) & 1u)) >> 16); }
HD float sigmoidf_(float x) { return 1.f / (1.f + expf(-x)); }
HD float siluf_(float x) { return x / (1.f + expf(-x)); }
HD float geluf_(float x) { return 0.5f * x * (1.f + tanhf(0.7978845608028654f * (x + 0.044715f * x * x * x))); }
HD float logsigmoidf_(float x) { return x < 0.f ? x - log1pf(expf(x)) : -log1pf(expf(-x)); }

struct Ctx {
    const int* pos;
    const float *gam, *ret_g, *mu, *w0, *w2, *a0, *a2, *g2, *k_k, *k_a, *r_k, *ln_g, *sgu_g, *sgu_b, *sgu_w, *sgu_bias;
    bf16 *proj, *ycat, *rs, *ks, *vs, *kk, *gg, *kdf, *kdb, *akf, *akb, *yf, *yb, *lin;
    float *wf, *wb, *rkv, *rsp;
};

HD void el_rot_ret(const Ctx& c, long idx) {
    const int i = (int)(idx & 31), h = (int)((idx >> 5) & 7); const long t = idx >> 8;
    const float inv = expf(-(float)i * (1.f / 32.f) * 9.210340371976184f);
    const float ang = (float)c.pos[t] * inv; float sn, cs; sincosf(ang, &sn, &cs);
    bf16* q = c.proj + (size_t)t * NPROJ + OFF_A + h * 64; bf16* k = q + 512;
    const float q1 = bf2f(q[i]), q2 = bf2f(q[i + 32]), k1 = bf2f(k[i]), k2 = bf2f(k[i + 32]);
    q[i] = f2bf(q1 * cs - q2 * sn); q[i + 32] = f2bf(q2 * cs + q1 * sn);
    k[i] = f2bf((k1 * cs - k2 * sn) * 0.125f); k[i + 32] = f2bf((k2 * cs + k1 * sn) * 0.125f);
}
HD void el_rot_dil(const Ctx& c, long idx) {
    const int j = (int)(idx & 31), h = (int)((idx >> 5) & 7); const long t = idx >> 8;
    bf16* q = c.proj + (size_t)t * NPROJ + OFF_D + h * 64; bf16* k = q + 512;
    if (j < 8) {
        const float inv = expf(-(float)j * (1.f / 8.f) * 13.122363377404328f);
        const float ang = (float)c.pos[t] * inv; float sn, cs; sincosf(ang, &sn, &cs);
        const float q1 = bf2f(q[j]), q2 = bf2f(q[j + 8]), k1 = bf2f(k[j]), k2 = bf2f(k[j + 8]);
        q[j] = f2bf((q1 * cs - q2 * sn) * 0.125f); q[j + 8] = f2bf((q2 * cs + q1 * sn) * 0.125f);
        k[j] = f2bf(k1 * cs - k2 * sn); k[j + 8] = f2bf(k2 * cs + k1 * sn);
    } else {
        const int d = 16 + 2 * (j - 8);
        q[d] = f2bf(bf2f(q[d]) * 0.125f); q[d + 1] = f2bf(bf2f(q[d + 1]) * 0.125f);
    }
}
HD void el_rwkv_shift(const Ctx& c, long idx) {
    const int j = (int)(idx % B_COLS); const long t = idx / B_COLS; const int s = (int)(t % SEQ);
    const bf16* p = c.proj + (size_t)t * NPROJ + OFF_B + j;
    const float x = bf2f(p[0]), xp = s > 0 ? bf2f(p[-(long)NPROJ]) : 0.f, xn = s < SEQ - 1 ? bf2f(p[NPROJ]) : 0.f;
    const float xs = x + c.mu[j] * (xp - x) + c.mu[B_COLS + j] * (xn - x);
    if (j < 512) c.rs[t * 512 + j] = f2bf(xs);
    else if (j < 1024) c.ks[t * 512 + j - 512] = f2bf(xs);
    else if (j < 1536) c.vs[t * 512 + j - 1024] = f2bf(xs);
    else if (j < 1632) c.lin[t * NLORA + (j - 1536)] = f2bf(tanhf(xs));
    else if (j < 1728) c.lin[t * NLORA + (j - 1536)] = f2bf(xs);
    else c.lin[t * NLORA + (j - 1536)] = f2bf(sigmoidf_(xs));
}
HD void el_rwkv_lora(const Ctx& c, long idx) {
    const int ch = (int)(idx & 511); const long t = idx >> 9;
    const bf16* li = c.lin + t * NLORA;
    float wl = 0.f, al = 0.f, g = 0.f;
    for (int i = 0; i < 96; ++i) { wl += bf2f(li[i]) * c.w2[i * 512 + ch]; al += bf2f(li[96 + i]) * c.a2[i * 512 + ch]; }
    for (int i = 0; i < 256; ++i) g += bf2f(li[192 + i]) * c.g2[i * 512 + ch];
    c.gg[t * 512 + ch] = f2bf(g);
    const float k = bf2f(c.ks[t * 512 + ch]), ka = c.k_a[ch];
    c.kk[t * 512 + ch] = f2bf(k * c.k_k[ch]);
    {   const float dec = -0.6065306597126334f * sigmoidf_(c.w0[ch] + wl); const float a = sigmoidf_(c.a0[ch] + al);
        c.wf[t * 512 + ch] = dec; c.kdf[t * 512 + ch] = f2bf(k * (1.f + (a - 1.f) * ka)); c.akf[t * 512 + ch] = f2bf(a); }
    {   const float dec = -0.6065306597126334f * sigmoidf_(c.w0[512 + ch] + wl); const float a = sigmoidf_(c.a0[512 + ch] + al);
        c.wb[t * 512 + ch] = dec; c.kdb[t * 512 + ch] = f2bf(k * (1.f + (a - 1.f) * ka)); c.akb[t * 512 + ch] = f2bf(a); }
}
HD void el_rwkv_kk(const Ctx& c, long idx) {
    const int h = (int)(idx & 7); const long t = idx >> 3; const size_t o = (size_t)t * 512 + h * 64;
    float ss = 0.f;
    for (int d = 0; d < 64; ++d) { const float v = bf2f(c.kk[o + d]); ss += v * v; }
    const float n = 1.f / sqrtf(ss + 1e-12f);
    for (int d = 0; d < 64; ++d) { const float v = bf2f(c.kk[o + d]) * n; c.kk[o + d] = f2bf(v);
        c.akf[o + d] = f2bf(bf2f(c.akf[o + d]) * v); c.akb[o + d] = f2bf(bf2f(c.akb[o + d]) * v); }
}
HD void el_sgu_prep(const Ctx& c, long t) {
    bf16* v = c.proj + (size_t)t * NPROJ + OFF_C + 512;
    float s = 0.f;
    for (int j = 0; j < 512; ++j) s += geluf_(bf2f(v[j]));
    const float mean = s * (1.f / 512.f); float q = 0.f;
    for (int j = 0; j < 512; ++j) { const float d = geluf_(bf2f(v[j])) - mean; q += d * d; }
    const float rstd = 1.f / sqrtf(q * (1.f / 512.f) + NORM_EPS);
    for (int j = 0; j < 512; ++j) v[j] = f2bf((geluf_(bf2f(v[j])) - mean) * rstd * c.sgu_g[j] + c.sgu_b[j]);
}

HD void el_ret_kv(const Ctx& c, long idx) {
    const int e = (int)(idx & 63), d = (int)((idx >> 6) & 63); long r = idx >> 12;
    const int ch = (int)(r % NC); r /= NC; const int dir = (int)(r & 1); r >>= 1; const int h = (int)(r & 7); const int b = (int)(r >> 3);
    const float lg = logsigmoidf_(c.gam[dir * 8 + h]);
    const bf16* base = c.proj + ((size_t)b * SEQ + (size_t)ch * 128) * NPROJ + OFF_A + h * 64;
    float kv = 0.f;
    for (int m = 0; m < 128; ++m) { const float dec = expf(lg * (float)(dir == 0 ? 127 - m : m));
        kv += dec * bf2f(base[(size_t)m * NPROJ + 512 + d]) * bf2f(base[(size_t)m * NPROJ + 1024 + e]); }
    c.rkv[idx] = kv;
}
HD void el_dil_attn(const Ctx& c, long idx) {
    const int h = (int)(idx & 7); const long t = idx >> 3; const int s = (int)(t % SEQ); const long tb = t - s;
    const bf16* qp = c.proj + (size_t)t * NPROJ + OFF_D + h * 64;
    float o[64];
#pragma unroll
    for (int i = 0; i < 64; ++i) o[i] = 0.f;
    float m = -1e30f, l = 0.f;
    for (int br = 0; br < 3; ++br) {
        const int dil = br == 0 ? 1 : (br == 1 ? 4 : 16);
        for (int j = -64; j <= 64; ++j) {
            const int sp = s + dil * j; if (sp < 0 || sp >= SEQ) continue;
            asm volatile("" ::: "memory");
            const bf16* kp = c.proj + (size_t)(tb + sp) * NPROJ + OFF_D + 512 + h * 64; const bf16* vp = kp + 512;
            float sc = 0.f;
#pragma unroll
            for (int i = 0; i < 64; ++i) sc += bf2f(qp[i]) * bf2f(kp[i]);
            const float mn = sc > m ? sc : m, scale = expf(m - mn), p = expf(sc - mn);
            l = l * scale + p; m = mn;
#pragma unroll
            for (int i = 0; i < 64; ++i) o[i] = o[i] * scale + p * bf2f(vp[i]);
        }
    }
    const float il = 1.f / l; bf16* y = c.ycat + (size_t)t * 2048 + 1536 + h * 64;
#pragma unroll
    for (int i = 0; i < 64; ++i) y[i] = f2bf(o[i] * il);
}
HD void el_dil_combine(const bf16* dpo, const float* dml, bf16* ycat, long idx) {
    const int h = (int)(idx & 7); const long t = idx >> 3;
    float m[3], l[3];
#pragma unroll
    for (int br = 0; br < 3; ++br) { const float* mp = dml + (((size_t)br * T + t) * 8 + h) * 2; m[br] = mp[0]; l[br] = mp[1]; }
    const float M = fmaxf(m[0], fmaxf(m[1], m[2]));
    float wgt[3], den = 0.f;
#pragma unroll
    for (int br = 0; br < 3; ++br) { wgt[br] = expf(m[br] - M) * l[br]; den += wgt[br]; }
    const float inv = 1.f / den;
    bf16* y = ycat + (size_t)t * 2048 + 1536 + h * 64;
    for (int i = 0; i < 64; ++i) { float a = 0.f;
#pragma unroll
        for (int br = 0; br < 3; ++br) a += wgt[br] * bf2f(dpo[((size_t)br * T + t) * 512 + h * 64 + i]);
        y[i] = f2bf(a * inv); }
}
HD void el_sgu_main(const Ctx& c, long idx) {
    const int j = (int)(idx & 511); const long t = idx >> 9; const int s = (int)(t % SEQ), p = s & 127, g = j >> 6; const long t0 = t - p;
    const float* w = c.sgu_w + ((size_t)g * 128 + p) * 128;
    const bf16* v = c.proj + (size_t)t0 * NPROJ + OFF_C + 512 + j;
    float acc = 0.f;
    for (int q = 0; q < 128; ++q) acc += w[q] * bf2f(v[(size_t)q * NPROJ]);
    const float u = geluf_(bf2f(c.proj[(size_t)t * NPROJ + OFF_C + j]));
    c.ycat[(size_t)t * 2048 + 1024 + j] = f2bf(u * (acc + c.sgu_bias[g * 128 + p]));
}
HD void el_ret_scan(const Ctx& c, long idx) {
    const int de = (int)(idx & 4095); const long r = idx >> 12; const int dir = (int)(r & 1), h = (int)((r >> 1) & 7);
    const float cd = expf(128.f * logsigmoidf_(c.gam[dir * 8 + h]));
    float S = 0.f;
    for (int k = 0; k < NC; ++k) { const int ch = dir == 0 ? k : NC - 1 - k; const size_t o = ((size_t)r * NC + ch) * 4096 + de; c.rsp[o] = S; S = S * cd + c.rkv[o]; }
}
HD void el_rwkv_scan(const Ctx& c, long idx) {
    const int row = (int)(idx & 63); const long r = idx >> 6; const int dir = (int)(r & 1), h = (int)((r >> 1) & 7), b = (int)(r >> 4);
    const float* W = dir ? c.wb : c.wf; const bf16* KD = dir ? c.kdb : c.kdf; const bf16* AK = dir ? c.akb : c.akf; bf16* Y = dir ? c.yb : c.yf;
    float S[64];
#pragma unroll
    for (int i = 0; i < 64; ++i) S[i] = 0.f;
    for (int k = 0; k < SEQ; ++k) {
        asm volatile("" ::: "memory");
        const int s = dir ? SEQ - 1 - k : k; const size_t o = ((size_t)b * SEQ + s) * 512 + h * 64;
        float sk = 0.f;
#pragma unroll
        for (int q = 0; q < 4; ++q) { asm volatile("" ::: "memory");
#pragma unroll
            for (int i = 16 * q; i < 16 * q + 16; ++i) sk += S[i] * bf2f(c.kk[o + i]); }
        const float v = bf2f(c.vs[o + row]); float y = 0.f;
#pragma unroll
        for (int q = 0; q < 4; ++q) { asm volatile("" ::: "memory");
#pragma unroll
            for (int i = 16 * q; i < 16 * q + 16; ++i) { S[i] = S[i] * expf(W[o + i]) - sk * bf2f(AK[o + i]) + v * bf2f(KD[o + i]); y += S[i] * bf2f(c.rs[o + i]); } }
        Y[o + row] = f2bf(y);
    }
}
HD void el_ret_out(const Ctx& c, long idx) {
    const int h = (int)(idx & 7); const long t = idx >> 3; const int s = (int)(t % SEQ), n = s & 127, ch = s >> 7; const int b = (int)(t / SEQ);
    const float lgf = logsigmoidf_(c.gam[h]), lgb = logsigmoidf_(c.gam[8 + h]);
    const bf16* qp = c.proj + (size_t)t * NPROJ + OFF_A + h * 64;
    float o[64];
#pragma unroll
    for (int i = 0; i < 64; ++i) o[i] = 0.f;
    const bf16* kb = c.proj + (size_t)(t - n) * NPROJ + OFF_A + 512 + h * 64;
    for (int m = 0; m < 128; ++m) {
        asm volatile("" ::: "memory");
        const bf16* kp = kb + (size_t)m * NPROJ; const bf16* vp = kp + 512;
        float sc = 0.f;
#pragma unroll
        for (int i = 0; i < 64; ++i) sc += bf2f(qp[i]) * bf2f(kp[i]);
        sc *= m <= n ? expf(lgf * (float)(n - m)) : expf(lgb * (float)(m - n));
#pragma unroll
        for (int i = 0; i < 64; ++i) o[i] += sc * bf2f(vp[i]);
    }
    const float qdf = expf(lgf * (float)(n + 1)), qdb = expf(lgb * (float)(128 - n));
    const float* Sf = c.rsp + ((size_t)((b * 8 + h) * 2 + 0) * NC + ch) * 4096; const float* Sb = c.rsp + ((size_t)((b * 8 + h) * 2 + 1) * NC + ch) * 4096;
    for (int d = 0; d < 64; ++d) { asm volatile("" ::: "memory"); const float qd = bf2f(qp[d]); const float a = qd * qdf, bb = qd * qdb;
#pragma unroll
        for (int i = 0; i < 64; ++i) o[i] += a * Sf[d * 64 + i] + bb * Sb[d * 64 + i]; }
    float mu = 0.f;
#pragma unroll
    for (int i = 0; i < 64; ++i) mu += o[i];
    mu *= (1.f / 64.f); float var = 0.f;
#pragma unroll
    for (int i = 0; i < 64; ++i) { const float d = o[i] - mu; var += d * d; }
    const float rstd = 1.f / sqrtf(var * (1.f / 64.f) + GN_EPS);
    const bf16* gp = c.proj + (size_t)t * NPROJ + OFF_A + 1536 + h * 64; bf16* y = c.ycat + (size_t)t * 2048 + h * 64;
    for (int i = 0; i < 64; i += 8) { asm volatile("" ::: "memory");
#pragma unroll
        for (int j = 0; j < 8; ++j) y[i + j] = f2bf(siluf_(bf2f(gp[i + j])) * ((o[i + j] - mu) * rstd * c.ret_g[h * 64 + i + j])); }
}
HD void el_rwkv_fin(const Ctx& c, long idx) {
    const int h = (int)(idx & 7); const long t = idx >> 3; const size_t o = (size_t)t * 512 + h * 64;
    float mu = 0.f, bonus = 0.f;
    for (int i = 0; i < 64; ++i) { mu += bf2f(c.yf[o + i]) + bf2f(c.yb[o + i]); bonus += bf2f(c.rs[o + i]) * bf2f(c.ks[o + i]) * c.r_k[h * 64 + i]; }
    mu *= (1.f / 64.f); float var = 0.f;
    for (int i = 0; i < 64; ++i) { const float d = bf2f(c.yf[o + i]) + bf2f(c.yb[o + i]) - mu; var += d * d; }
    const float rstd = 1.f / sqrtf(var * (1.f / 64.f) + GN_EPS);
    bf16* out = c.ycat + (size_t)t * 2048 + 512 + h * 64;
    for (int i = 0; i < 64; ++i) { const float y = bf2f(c.yf[o + i]) + bf2f(c.yb[o + i]);
        out[i] = f2bf(((y - mu) * rstd * c.ln_g[h * 64 + i] + bonus * bf2f(c.vs[o + i])) * bf2f(c.gg[o + i])); }
}
HD void route_select(const float (&lg)[4], const float (&le)[32], const float* bg, const float* be, int& e1, int& e2, float& g1, float& g2) {
    float l[4]; float mx = -1e30f; int gi = 0;
#pragma unroll
    for (int i = 0; i < 4; ++i) { l[i] = lg[i] + bg[i]; if (l[i] > mx) { mx = l[i]; gi = i; } }
    float den = 0.f;
#pragma unroll
    for (int i = 0; i < 4; ++i) den += expf(l[i] - mx);
    const float gtop = 1.f / den;
    float el[8];
#pragma unroll
    for (int i = 0; i < 8; ++i) { float v = 0.f;
#pragma unroll
        for (int g = 0; g < 4; ++g) v = (g == gi) ? le[g * 8 + i] + be[g * 8 + i] : v;
        el[i] = v; }
    float m1 = -1e30f, m2 = -1e30f; int i1 = 0, i2 = 0;
#pragma unroll
    for (int i = 0; i < 8; ++i) { if (el[i] > m1) { m2 = m1; i2 = i1; m1 = el[i]; i1 = i; } else if (el[i] > m2) { m2 = el[i]; i2 = i; } }
    const float p2 = expf(m2 - m1);
    g1 = gtop / (1.f + p2); g2 = gtop * p2 / (1.f + p2); e1 = gi * 8 + i1; e2 = gi * 8 + i2;
}

#ifndef KB_HOST_ONLY
namespace pg8 {
#define PG8_LAS __attribute__((address_space(3)))
typedef unsigned short bf16_t;
typedef short bf16x8 __attribute__((ext_vector_type(8)));
typedef float f32x4 __attribute__((ext_vector_type(4)));
typedef unsigned u32x4 __attribute__((ext_vector_type(4)));
constexpr int BM = 256, BK = 64, HALF = 128, HTB = HALF * BK * 2, STAGE_BYTES = 8 * HTB, NXCD = 8, WGM = 8;
__host__ __device__ __forceinline__ int lds_byte(int r, int c) { const int st = (r >> 4) * 2 + (c >> 5), rr = r & 15, cc = c & 31, ob = rr * 64 + cc * 2; return st * 1024 + (ob ^ (((ob >> 9) & 1) << 5)); }
__host__ __device__ __forceinline__ void stage_rc(int b, int& R, int& C) { const int st = b / 1024, sb = b % 1024, swz = sb ^ (((sb >> 9) & 1) << 5); R = (st >> 1) * 16 + swz / 64; C = (st & 1) * 32 + (swz % 64) / 2; }
__host__ __device__ __forceinline__ int perm32(int rho) { const int n = rho >> 4, i = rho & 15; return 8 * (i >> 2) + 4 * n + (i & 3); }
struct Unit { int pm, pn, pe; };
struct Gemm { const bf16_t* A; const bf16_t* Bt; int M, N, K; size_t bstride; };
template <int M, int N> struct StaticOrder {
    static constexpr int nM = M / BM, nN = N / BM, nwg = nM * nN;
    int G, c;
    __host__ __device__ void init(int G_, int c_) { G = G_; c = c_; }
    __host__ __device__ __forceinline__ bool next(int i, Unit& u) const {
        const int L = i * G + c; if (L >= nwg) return false;
        int wgid = L; { constexpr int q = nwg / NXCD, r = nwg % NXCD; const int xcd = wgid % NXCD, off = wgid / NXCD; wgid = (xcd < r ? xcd * (q + 1) : r * (q + 1) + (xcd - r) * q) + off; }
        constexpr int nig = WGM * nN; const int gid = wgid / nig, fm = gid * WGM, gsz = (nM - fm) < WGM ? (nM - fm) : WGM;
        u.pm = fm + ((wgid % nig) % gsz); u.pn = (wgid % nig) / gsz; u.pe = 0; return true;
    }
    __device__ __forceinline__ void a_ready(const Unit&) const {}
    __device__ __forceinline__ void done(const Unit&) const {}
};
template <int NN> struct MoeOrder {
    int G, c, ntiles; const PG8_LAS int* tile_exp;
    __device__ __forceinline__ bool next(int i, Unit& u) const {
        const int L = i * G + c; if (L >= ntiles * NN) return false;
        u.pm = L / NN; u.pn = L % NN; u.pe = __builtin_amdgcn_readfirstlane(tile_exp[u.pm]); return true;
    }
    __device__ __forceinline__ void a_ready(const Unit&) const {}
    __device__ __forceinline__ void done(const Unit&) const {}
};
__device__ __forceinline__ unsigned cvt_pk_bf16(float lo, float hi) { unsigned r; asm volatile("v_cvt_pk_bf16_f32 %0, %1, %2" : "=v"(r) : "v"(lo), "v"(hi)); return r; }
struct EpiBf16 {
    static constexpr bool PERM = true, AFTER_DRAIN = false;
    bf16_t* O; int ldc;
    __device__ __forceinline__ void operator()(const f32x4 (&acc)[2][2][4][2], const Unit& u, int wr, int wc, int fr, int fq) const {
        const int row0 = u.pm * BM + wr * 64 + fr, col0 = u.pn * BM + wc * 32 + 8 * fq;
#pragma unroll
        for (int ai = 0; ai < 2; ++ai)
#pragma unroll
            for (int m = 0; m < 4; ++m) { bf16_t* rowp = O + (size_t)(row0 + ai * HALF + m * 16) * ldc + col0;
#pragma unroll
                for (int bj = 0; bj < 2; ++bj) { const f32x4 v0 = acc[ai][bj][m][0], v1 = acc[ai][bj][m][1];
                    u32x4 w; w.x = cvt_pk_bf16(v0[0], v0[1]); w.y = cvt_pk_bf16(v0[2], v0[3]); w.z = cvt_pk_bf16(v1[0], v1[1]); w.w = cvt_pk_bf16(v1[2], v1[3]);
                    *(u32x4*)(rowp + bj * HALF) = w; } }
    }
};
struct EpiResF32 {
    static constexpr bool PERM = false, AFTER_DRAIN = false;
    const float* base; float* out; int ldc;
    __device__ __forceinline__ void operator()(const f32x4 (&acc)[2][2][4][2], const Unit& u, int wr, int wc, int fr, int fq) const {
        const int row0 = u.pm * BM + wr * 64 + fr, col0 = u.pn * BM + wc * 32 + 4 * fq;
#pragma unroll
        for (int ai = 0; ai < 2; ++ai)
#pragma unroll
            for (int m = 0; m < 4; ++m) { const size_t off = (size_t)(row0 + ai * HALF + m * 16) * ldc + col0;
#pragma unroll
                for (int bj = 0; bj < 2; ++bj)
#pragma unroll
                    for (int n = 0; n < 2; ++n) { const f32x4 bs = *(const f32x4*)(base + off + bj * HALF + n * 16); *(f32x4*)(out + off + bj * HALF + n * 16) = bs + acc[ai][bj][m][n]; } }
    }
};
struct EpiSwiGLU {
    static constexpr bool PERM = true, AFTER_DRAIN = false;
    bf16_t* O; int ldc;
    __device__ __forceinline__ void operator()(const f32x4 (&acc)[2][2][4][2], const Unit& u, int wr, int wc, int fr, int fq) const {
        const int row0 = u.pm * BM + wr * 64 + fr, col0 = u.pn * HALF + wc * 32 + 8 * fq;
#pragma unroll
        for (int ai = 0; ai < 2; ++ai)
#pragma unroll
            for (int m = 0; m < 4; ++m) { bf16_t* rowp = O + (size_t)(row0 + ai * HALF + m * 16) * ldc + col0;
                float h[8];
#pragma unroll
                for (int n = 0; n < 2; ++n)
#pragma unroll
                    for (int j = 0; j < 4; ++j) { const float g = acc[ai][0][m][n][j], up = acc[ai][1][m][n][j]; h[n * 4 + j] = g * __builtin_amdgcn_rcpf(1.f + __expf(-g)) * up; }
                u32x4 w; w.x = cvt_pk_bf16(h[0], h[1]); w.y = cvt_pk_bf16(h[2], h[3]); w.z = cvt_pk_bf16(h[4], h[5]); w.w = cvt_pk_bf16(h[6], h[7]);
                *(u32x4*)rowp = w; }
    }
};

template <int KK, class Epi, class Sched, bool ALIGN_EPI = false, bool SP2 = false>
__device__ __forceinline__ void gemm_phase(PG8_LAS unsigned char* lds, const Gemm g, const Sched& S, const Epi& E, const int tid) {
    const int wid = __builtin_amdgcn_readfirstlane(tid >> 6), lane = tid & 63, wr = wid >> 2, wc = wid & 3, fr = lane & 15, fq = lane >> 4;
    constexpr int K = KK, nt = K / BK;
    unsigned voffA[2], voffB[2];
#pragma unroll
    for (int i = 0; i < 2; ++i) { int R, C; stage_rc(tid * 16 + i * 8192, R, C); const int Rb = Epi::PERM ? ((R & ~31) + perm32(R & 31)) : R;
        voffA[i] = (unsigned)(R * K + C) * 2u; voffB[i] = (unsigned)(Rb * K + C) * 2u; }
    constexpr size_t kstep = (size_t)(BK * 2);
    constexpr size_t hstep = (size_t)HALF * K * 2;
    constexpr size_t tstep = 2 * hstep;
    const unsigned ldsw = (unsigned)wid * 1024u;
    const int aoff = lds_byte(wr * 64 + fr, fq * 8), boff = lds_byte(wc * 32 + fr, fq * 8);
#define PG8_SA(b, h) (((b) * 2 + (h)) * HTB)
#define PG8_SB(b, h) ((4 + (b) * 2 + (h)) * HTB)
#define PG8_STAGE(bufoff, gbase, voff) do { _Pragma("unroll") for (int _i = 0; _i < 2; ++_i) \
        __builtin_amdgcn_global_load_lds((const unsigned*)((const char*)(gbase) + (voff)[_i]), (PG8_LAS unsigned*)(lds + (bufoff) + ldsw + _i * 8192), 16, 0, 0); } while (0)
#define PG8_LDA(dst, b, h) do { _Pragma("unroll") for (int m = 0; m < 4; ++m) _Pragma("unroll") for (int k = 0; k < 2; ++k) dst[m][k] = *(const PG8_LAS bf16x8*)(lds + PG8_SA(b, h) + aoff + m * 2048 + k * 1024); } while (0)
#define PG8_LDB(dst, b, h) do { _Pragma("unroll") for (int n = 0; n < 2; ++n) _Pragma("unroll") for (int k = 0; k < 2; ++k) dst[n][k] = *(const PG8_LAS bf16x8*)(lds + PG8_SB(b, h) + boff + n * 2048 + k * 1024); } while (0)
#define PG8_MMA(ai, bj, At, Bt) do { __builtin_amdgcn_s_setprio(1); _Pragma("unroll") for (int m = 0; m < 4; ++m) _Pragma("unroll") for (int n = 0; n < 2; ++n) _Pragma("unroll") for (int k = 0; k < 2; ++k) \
        acc[ai][bj][m][n] = __builtin_amdgcn_mfma_f32_16x16x32_bf16(Bt[n][k], At[m][k], acc[ai][bj][m][n], 0, 0, 0); __builtin_amdgcn_s_setprio(0); } while (0)
#define PG8_WAIT_V(n) asm volatile("s_waitcnt vmcnt(" #n ")" ::: "memory")
#define PG8_WAIT_L(n) asm volatile("s_waitcnt lgkmcnt(" #n ")" ::: "memory")
#define PG8_BAR __builtin_amdgcn_s_barrier()
#define PG8_SCHED __builtin_amdgcn_sched_barrier(0)
    Unit cur, nxt; int ui = 0;
    if (!S.next(0, cur)) return;
    f32x4 acc[2][2][4][2];
#pragma unroll
    for (int a = 0; a < 2; ++a)
#pragma unroll
        for (int b = 0; b < 2; ++b)
#pragma unroll
            for (int m = 0; m < 4; ++m)
#pragma unroll
                for (int n = 0; n < 2; ++n) acc[a][b][m][n] = (f32x4){0.f, 0.f, 0.f, 0.f};
    bf16x8 At[4][2], B0[2][2], B1[2][2];
    const char* cA = (const char*)g.A + (size_t)cur.pm * tstep; const char* cB = (const char*)g.Bt + (size_t)cur.pe * g.bstride + (size_t)cur.pn * tstep;
    S.a_ready(cur);
    if constexpr (SP2) {
        PG8_STAGE(PG8_SB(0, 0), cB, voffB); PG8_STAGE(PG8_SB(0, 1), cB + hstep, voffB); PG8_STAGE(PG8_SA(0, 0), cA, voffA); PG8_STAGE(PG8_SA(0, 1), cA + hstep, voffA);
        if (wr == 1) PG8_BAR;
        PG8_WAIT_V(2); PG8_BAR;
        PG8_STAGE(PG8_SB(1, 0), cB + kstep, voffB); PG8_STAGE(PG8_SA(1, 0), cA + kstep, voffA); PG8_STAGE(PG8_SB(1, 1), cB + hstep + kstep, voffB);
        PG8_WAIT_V(6); PG8_BAR;
    } else {
        PG8_STAGE(PG8_SB(0, 0), cB, voffB); PG8_STAGE(PG8_SA(0, 0), cA, voffA); PG8_STAGE(PG8_SB(0, 1), cB + hstep, voffB); PG8_STAGE(PG8_SA(0, 1), cA + hstep, voffA);
        if (wr == 1) PG8_BAR;
        PG8_WAIT_V(4); PG8_BAR;
        PG8_STAGE(PG8_SB(1, 0), cB + kstep, voffB); PG8_STAGE(PG8_SA(1, 0), cA + kstep, voffA); PG8_STAGE(PG8_SB(1, 1), cB + hstep + kstep, voffB);
        PG8_WAIT_V(6); PG8_BAR;
    }
    for (;;) {
        const bool has_next = S.next(ui + 1, nxt);
        const char* nA = has_next ? (const char*)g.A + (size_t)nxt.pm * tstep : cA; const char* nB = has_next ? (const char*)g.Bt + (size_t)nxt.pe * g.bstride + (size_t)nxt.pn * tstep : cB;
        for (int t = 0; t < nt; t += 2) {
            const bool last = (t == nt - 2);
            const char* a1 = cA + (size_t)(t + 1) * kstep;
            const char* a2 = last ? nA : cA + (size_t)(t + 2) * kstep; const char* b2 = last ? nB : cB + (size_t)(t + 2) * kstep;
            const char* a3 = a2 + kstep; const char* b3 = b2 + kstep;
            if (last && has_next) S.a_ready(nxt);
            if constexpr (SP2) {
            PG8_LDB(B0, 0, 0); PG8_LDB(B1, 0, 1); PG8_SCHED; PG8_LDA(At, 0, 0); PG8_STAGE(PG8_SA(1, 1), a1 + hstep, voffA);
            PG8_WAIT_V(8); PG8_WAIT_L(0); PG8_BAR; PG8_MMA(0, 0, At, B0); PG8_MMA(0, 1, At, B1); PG8_BAR; PG8_SCHED;
            PG8_LDA(At, 0, 1); PG8_STAGE(PG8_SB(0, 0), b2, voffB); PG8_STAGE(PG8_SB(0, 1), b2 + hstep, voffB); PG8_STAGE(PG8_SA(0, 0), a2, voffA);
            PG8_WAIT_V(8); PG8_WAIT_L(0); PG8_BAR; PG8_MMA(1, 0, At, B0); PG8_MMA(1, 1, At, B1); PG8_BAR; PG8_SCHED;
            PG8_LDB(B0, 1, 0); PG8_LDB(B1, 1, 1); PG8_SCHED; PG8_LDA(At, 1, 0); PG8_STAGE(PG8_SA(0, 1), a2 + hstep, voffA);
            PG8_WAIT_V(8); PG8_WAIT_L(0); PG8_BAR; PG8_MMA(0, 0, At, B0); PG8_MMA(0, 1, At, B1); PG8_BAR; PG8_SCHED;
            PG8_LDA(At, 1, 1); PG8_STAGE(PG8_SB(1, 0), b3, voffB); PG8_STAGE(PG8_SB(1, 1), b3 + hstep, voffB); PG8_STAGE(PG8_SA(1, 0), a3, voffA);
            PG8_WAIT_V(8); PG8_WAIT_L(0); PG8_BAR; PG8_MMA(1, 0, At, B0); PG8_MMA(1, 1, At, B1); PG8_BAR; PG8_SCHED;
            } else {
            PG8_LDB(B0, 0, 0); PG8_SCHED; PG8_LDA(At, 0, 0); PG8_STAGE(PG8_SA(1, 1), a1 + hstep, voffA);
            PG8_WAIT_L(8); PG8_BAR; PG8_WAIT_L(0); PG8_MMA(0, 0, At, B0); PG8_BAR; PG8_SCHED;
            PG8_LDB(B1, 0, 1); PG8_STAGE(PG8_SB(0, 0), b2, voffB);
            PG8_BAR; PG8_WAIT_L(0); PG8_MMA(0, 1, At, B1); PG8_BAR;
            PG8_LDA(At, 0, 1); PG8_STAGE(PG8_SA(0, 0), a2, voffA);
            PG8_BAR; PG8_WAIT_L(0); PG8_MMA(1, 0, At, B0); PG8_BAR; PG8_SCHED;
            PG8_STAGE(PG8_SB(0, 1), b2 + hstep, voffB);
            PG8_WAIT_V(6); PG8_BAR; PG8_MMA(1, 1, At, B1); PG8_BAR;
            PG8_LDB(B0, 1, 0); PG8_SCHED; PG8_LDA(At, 1, 0); PG8_STAGE(PG8_SA(0, 1), a2 + hstep, voffA);
            PG8_WAIT_L(8); PG8_BAR; PG8_WAIT_L(0); PG8_MMA(0, 0, At, B0); PG8_BAR; PG8_SCHED;
            PG8_LDB(B1, 1, 1); PG8_STAGE(PG8_SB(1, 0), b3, voffB);
            PG8_BAR; PG8_WAIT_L(0); PG8_MMA(0, 1, At, B1); PG8_BAR;
            PG8_LDA(At, 1, 1); PG8_STAGE(PG8_SA(1, 0), a3, voffA);
            PG8_BAR; PG8_WAIT_L(0); PG8_MMA(1, 0, At, B0); PG8_BAR; PG8_SCHED;
            PG8_STAGE(PG8_SB(1, 1), b3 + hstep, voffB);
            PG8_WAIT_V(6); PG8_BAR; PG8_MMA(1, 1, At, B1); PG8_BAR;
            }
        }
        if constexpr (ALIGN_EPI) { if (wr == 0) PG8_BAR; }
        E(acc, cur, wr, wc, fr, fq); S.done(cur);
        if (!has_next) break;
#pragma unroll
        for (int a = 0; a < 2; ++a)
#pragma unroll
            for (int b = 0; b < 2; ++b)
#pragma unroll
                for (int m = 0; m < 4; ++m)
#pragma unroll
                    for (int n = 0; n < 2; ++n) acc[a][b][m][n] = (f32x4){0.f, 0.f, 0.f, 0.f};
        cur = nxt; cA = nA; cB = nB; ++ui;
        if constexpr (ALIGN_EPI) { if (wr == 1) PG8_BAR; }
    }
    PG8_WAIT_V(0);
    if constexpr (!ALIGN_EPI) { if (wr == 0) PG8_BAR; }
    PG8_BAR;
#undef PG8_SA
#undef PG8_SB
#undef PG8_STAGE
#undef PG8_LDA
#undef PG8_LDB
#undef PG8_MMA
#undef PG8_WAIT_V
#undef PG8_WAIT_L
#undef PG8_BAR
#undef PG8_SCHED
}
}

#define GAS __attribute__((address_space(1)))
#define LAS __attribute__((address_space(3)))
typedef unsigned v4u __attribute__((ext_vector_type(4)));
typedef unsigned v2u __attribute__((ext_vector_type(2)));
typedef float f32x4 __attribute__((ext_vector_type(4)));
#define LDS_WAIT() asm volatile("s_waitcnt lgkmcnt(0)" ::: "memory")
__device__ __forceinline__ unsigned pk2(float lo, float hi) { return (unsigned)f2bf(lo) | ((unsigned)f2bf(hi) << 16); }

#define XB_TMO      128
#define XB_XCNT(j)  (256  + 64 * (j))
#define XB_XSUB(j)  (1280 + 64 * (j))
#define XB_XGEN(j)  (2304 + 64 * (j))
#define XB_TOP      3328
#define XB_TOPGEN   3392
#define XCD_BAR_WORDS 3456
#define XB_SPIN_CAP (1u << 18)
__device__ __forceinline__ unsigned xb_ld(unsigned* p)              { return __hip_atomic_load(p, __ATOMIC_RELAXED, __HIP_MEMORY_SCOPE_AGENT); }
__device__ __forceinline__ unsigned xb_add(unsigned* p, unsigned v) { return __hip_atomic_fetch_add(p, v, __ATOMIC_RELAXED, __HIP_MEMORY_SCOPE_AGENT); }
__device__ __forceinline__ unsigned xb_xcc_id() { return (unsigned)__builtin_amdgcn_s_getreg((3 << 11) | 20) & 0xFu; }
#define XB_SPIN(cond, bar) do { unsigned _sp = 0; while (cond) { __builtin_amdgcn_s_sleep(1); \
    if ((++_sp & 255u) == 0u) { if (xb_ld(&(bar)[XB_TMO])) break; if (_sp > XB_SPIN_CAP) { atomicAdd(&(bar)[XB_TMO], 1u); break; } } } } while (0)
struct XcdBarrier { unsigned* bar; unsigned x; volatile LAS unsigned* st; };
__device__ __forceinline__ XcdBarrier xcd_barrier_post(unsigned* bar, volatile LAS unsigned* st) {
    XcdBarrier b; b.bar = bar; b.x = xb_xcc_id(); b.st = st;
    if (threadIdx.x == 0) (void)xb_add(&bar[XB_XCNT(b.x)], 1u);
    return b;
}
__device__ __forceinline__ void xcd_barrier_complete(unsigned* bar, unsigned x, unsigned& nloc, unsigned& nx) {
    const unsigned G = gridDim.x * gridDim.y * gridDim.z;
    unsigned sum, cnt, mine, sp = 0u;
    for (;;) {
        sum = 0u; cnt = 0u; mine = 0u;
#pragma unroll
        for (unsigned j = 0; j < 16; ++j) { const unsigned c = xb_ld(&bar[XB_XCNT(j)]); sum += c; cnt += (c > 0u) ? 1u : 0u; mine = (j == x) ? c : mine; }
        if (sum == G) break;
        __builtin_amdgcn_s_sleep(1);
        if ((++sp & 255u) == 0u) { if (xb_ld(&bar[XB_TMO])) break; if (sp > XB_SPIN_CAP) { atomicAdd(&bar[XB_TMO], 1u); break; } }
    }
    nloc = mine > 0u ? mine : 1u; nx = cnt > 0u ? cnt : 1u;
}
__device__ __forceinline__ void xcd_barrier(const XcdBarrier& b) {
    asm volatile("s_waitcnt vmcnt(0)" ::: "memory");
    __syncthreads();
    if (threadIdx.x == 0) {
        unsigned* bar = b.bar;
        __builtin_amdgcn_s_waitcnt(0);
        unsigned nloc = b.st[0], nx = b.st[1];
        if (nloc == 0u) { xcd_barrier_complete(bar, b.x, nloc, nx); b.st[0] = nloc; b.st[1] = nx; }
        const unsigned old = xb_add(&bar[XB_XSUB(b.x)], 1u);
        const unsigned gen = old / nloc;
        if (old + 1u == (gen + 1u) * nloc) {
            __builtin_amdgcn_fence(__ATOMIC_RELEASE, "agent");
            asm volatile("s_waitcnt vmcnt(0)" ::: "memory");
            const unsigned og = xb_add(&bar[XB_TOP], 1u);
            const unsigned tg = og / nx;
            if (og + 1u == (tg + 1u) * nx) xb_add(&bar[XB_TOPGEN], 1u);
            else XB_SPIN(xb_ld(&bar[XB_TOPGEN]) == tg, bar);
            __builtin_amdgcn_fence(__ATOMIC_ACQUIRE, "agent");
            xb_add(&bar[XB_XGEN(b.x)], 1u);
            asm volatile("s_waitcnt vmcnt(0)" ::: "memory");
        } else {
            XB_SPIN(xb_ld(&bar[XB_XGEN(b.x)]) == gen, bar);
            __builtin_amdgcn_fence(__ATOMIC_ACQUIRE, "agent");
            asm volatile("s_waitcnt vmcnt(0)" ::: "memory");
        }
    }
    __syncthreads();
}

constexpr int RING_BYTES = 131072;
constexpr int TAB_OFF = RING_BYTES;
constexpr int TAB_CNT = TAB_OFF, TAB_ROWBASE = TAB_OFF + 128, TAB_NT = TAB_OFF + 256, TAB_TEXP = TAB_OFF + 272;
constexpr int MISC_OFF = TAB_OFF + 4096;
constexpr int PTAB_OFF = MISC_OFF + 16;
constexpr int LDS_BYTES = 147456;
static_assert(TAB_TEXP + MOE_MAXTILES * 4 <= MISC_OFF && PTAB_OFF + 32 * 8 <= LDS_BYTES, "LDS map");

__device__ __forceinline__ float wave_sum(float v, int lane) {
#pragma unroll
    for (int o = 1; o < 64; o <<= 1) v += __builtin_bit_cast(float, __builtin_amdgcn_ds_bpermute((lane ^ o) << 2, __builtin_bit_cast(int, v)));
    return v;
}
__device__ __forceinline__ void transpose_item(const float* W, int K, int N, bf16* WT, int k0, int n0, int drow0, LAS float* scr, int lane) {
#pragma unroll 8
    for (int i = 0; i < 32; ++i) { const int kk = 2 * i + (lane >> 5); scr[kk * 33 + (lane & 31)] = W[(size_t)(k0 + kk) * N + n0 + (lane & 31)]; }
    LDS_WAIT(); asm volatile("" ::: "memory");
    const int c = lane & 7;
#pragma unroll
    for (int j = 0; j < 4; ++j) { const int n = (lane >> 3) + 8 * j; const LAS float* s = scr + (8 * c) * 33 + n;
        v4u o; o.x = pk2(s[0 * 33], s[1 * 33]); o.y = pk2(s[2 * 33], s[3 * 33]); o.z = pk2(s[4 * 33], s[5 * 33]); o.w = pk2(s[6 * 33], s[7 * 33]);
        *(GAS v4u*)(WT + (size_t)(drow0 + n) * K + k0 + 8 * c) = o; }
    LDS_WAIT(); asm volatile("" ::: "memory");
}


__device__ __forceinline__ void build_moe_tables(LAS unsigned char* lds, const unsigned* cnt_words, const int tid) {
    LAS int* tcnt = (LAS int*)(lds + TAB_CNT); LAS int* trb = (LAS int*)(lds + TAB_ROWBASE); LAS int* tnt = (LAS int*)(lds + TAB_NT); LAS int* texp = (LAS int*)(lds + TAB_TEXP);
    __syncthreads();
    if (tid < NEXP) tcnt[tid] = (int)__hip_atomic_load(cnt_words + 64 * tid, __ATOMIC_RELAXED, __HIP_MEMORY_SCOPE_AGENT);
    __syncthreads();
    if (tid == 0) { int tile = 0;
#pragma unroll 1
        for (int e = 0; e < NEXP; ++e) { int c = tcnt[e]; if (c > 2 * T) c = 2 * T; int nt = (c + 255) >> 8; if (tile + nt > MOE_MAXTILES) nt = MOE_MAXTILES - tile; trb[e] = tile * 256;
#pragma unroll 1
            for (int i = 0; i < nt; ++i) texp[tile + i] = e;
            tile += nt; }
        tnt[0] = tile; }
    __syncthreads();
}

struct Args { const void* in[30]; float* out; unsigned char* ws; int layer, pad; };
__device__ __forceinline__ Ctx make_ctx(const Args& args, unsigned char* ws, int l) {
    Ctx c;
    c.pos = (const int*)args.in[1];
    c.gam = (const float*)args.in[5] + l * 16; c.ret_g = (const float*)args.in[6] + l * 512; c.mu = (const float*)args.in[7] + l * 2 * B_COLS;
    c.w0 = (const float*)args.in[8] + l * 1024; c.w2 = (const float*)args.in[9] + l * 96 * 512; c.a0 = (const float*)args.in[10] + l * 1024; c.a2 = (const float*)args.in[11] + l * 96 * 512;
    c.g2 = (const float*)args.in[12] + l * 256 * 512; c.k_k = (const float*)args.in[13] + l * 512; c.k_a = (const float*)args.in[14] + l * 512; c.r_k = (const float*)args.in[15] + l * 512;
    c.ln_g = (const float*)args.in[16] + l * 512; c.sgu_g = (const float*)args.in[17] + l * 512; c.sgu_b = (const float*)args.in[18] + l * 512;
    c.sgu_w = (const float*)args.in[19] + (size_t)l * 8 * 128 * 128; c.sgu_bias = (const float*)args.in[20] + l * 1024;
    c.proj = (bf16*)(ws + WS_PROJ); c.ycat = (bf16*)(ws + WS_ACT);
    c.rs = (bf16*)(ws + WS_RS); c.ks = (bf16*)(ws + WS_KS); c.vs = (bf16*)(ws + WS_VS); c.kk = (bf16*)(ws + WS_KK); c.gg = (bf16*)(ws + WS_GG);
    c.kdf = (bf16*)(ws + WS_KDF); c.kdb = (bf16*)(ws + WS_KDB); c.akf = (bf16*)(ws + WS_AKF); c.akb = (bf16*)(ws + WS_AKB); c.yf = (bf16*)(ws + WS_YF); c.yb = (bf16*)(ws + WS_YB);
    c.lin = (bf16*)(ws + WS_LIN); c.wf = (float*)(ws + WS_WF); c.wb = (float*)(ws + WS_WB); c.rkv = (float*)(ws + WS_RKV); c.rsp = (float*)(ws + WS_RSP);
    return c;
}


#define ROW_LOAD(v, ptr) _Pragma("unroll") for (int j = 0; j < 8; ++j) v[j] = ((const GAS f32x4*)(ptr))[lane + 64 * j]
__device__ __forceinline__ void row_add_moe(f32x4 (&v)[8], const bf16* yp, size_t R1, size_t R2, float g1, float g2, int lane) {
#pragma unroll
    for (int j = 0; j < 8; ++j) { const v2u a = ((const GAS v2u*)(yp + R1 * DM))[lane + 64 * j], b = ((const GAS v2u*)(yp + R2 * DM))[lane + 64 * j];
        v[j].x += g1 * bf2f((bf16)(a.x & 0xffff)) + g2 * bf2f((bf16)(b.x & 0xffff)); v[j].y += g1 * bf2f((bf16)(a.x >> 16)) + g2 * bf2f((bf16)(b.x >> 16));
        v[j].z += g1 * bf2f((bf16)(a.y & 0xffff)) + g2 * bf2f((bf16)(b.y & 0xffff)); v[j].w += g1 * bf2f((bf16)(a.y >> 16)) + g2 * bf2f((bf16)(b.y >> 16)); }
}
__device__ __forceinline__ float row_rstd(const f32x4 (&v)[8], int lane) {
    float ss = 0.f;
#pragma unroll
    for (int j = 0; j < 8; ++j) ss += (v[j].x * v[j].x + v[j].y * v[j].y) + (v[j].z * v[j].z + v[j].w * v[j].w);
    return 1.f / sqrtf(wave_sum(ss, lane) * (1.f / DM) + NORM_EPS);
}
#define SEAM(k) do { if constexpr (KSEL < 0) { XcdBarrier b_ = bar; unsigned blo_ = __builtin_amdgcn_readfirstlane((unsigned)(unsigned long long)b_.bar), bhi_ = __builtin_amdgcn_readfirstlane((unsigned)((unsigned long long)b_.bar >> 32)); \
    asm volatile("" : "+s"(blo_), "+s"(bhi_)); b_.bar = (unsigned*)(((unsigned long long)bhi_ << 32) | blo_); xcd_barrier(b_); } } while (0)
#define PH_ON(k) if constexpr ((KSEL < 0 && KB_EN(k)) || KSEL == (k))
#define PHASE_LOCALS() unsigned char* ws = args.ws; int ll = KSEL < 0 ? l : __builtin_amdgcn_readfirstlane(l); int tid = threadIdx.x; asm volatile("" : "+s"(ws), "+s"(ll), "+v"(tid)); \
    const int lane = tid & 63, wave = __builtin_amdgcn_readfirstlane(tid >> 6); \
    const int G = gridDim.x, bid = blockIdx.x; const long gtid = (long)bid * 512 + tid, gstride = (long)G * 512; const int gw = bid * 8 + wave, NGW = G * 8; \
    (void)gtid; (void)gstride; (void)gw; (void)NGW; (void)ll; (void)lane


typedef short bf16x8 __attribute__((ext_vector_type(8)));
typedef short s16x4 __attribute__((ext_vector_type(4)));
typedef short v4i16_t __attribute__((ext_vector_type(4)));
#ifndef KB_EMU
#define MMA16(a, b, c) __builtin_amdgcn_mfma_f32_16x16x32_bf16((a), (b), (c), 0, 0, 0)
#define TR16(p) __builtin_amdgcn_ds_read_tr16_b64_v4i16((LAS v4i16_t*)(p))
#define BPERM(addr, v) __builtin_amdgcn_ds_bpermute((addr), (v))
#define RFL(x) __builtin_amdgcn_readfirstlane(x)
#define FEXP(x) __expf(x)
#define BSYNC() __syncthreads()
#endif
__device__ __forceinline__ bf16x8 frag_row(const LAS bf16* X, int ld, int r0, int c0, int fr, int fq) { return *(const LAS bf16x8*)(X + (r0 + fr) * ld + c0 + 8 * fq); }
__device__ __forceinline__ s16x4 tr4(const LAS bf16* X, int ld, int r0, int c0, int fr) { return __builtin_bit_cast(s16x4, TR16(X + (r0 + (fr >> 2)) * ld + c0 + 4 * (fr & 3))); }
__device__ __forceinline__ bf16x8 frag_col(const LAS bf16* X, int ld, int k0, int c0, int fr, int fq) {
    const s16x4 a = tr4(X, ld, k0 + 8 * fq, c0, fr), b = tr4(X, ld, k0 + 8 * fq + 4, c0, fr);
    return (bf16x8){a[0], a[1], a[2], a[3], b[0], b[1], b[2], b[3]}; }
#ifndef KB_EMU
typedef float cvt_f2 __attribute__((ext_vector_type(2)));
typedef __bf16 cvt_b2 __attribute__((ext_vector_type(2)));
__device__ __forceinline__ unsigned cvtpk(float lo, float hi) { return __builtin_bit_cast(unsigned, __builtin_convertvector(((cvt_f2){lo, hi}), cvt_b2)); }
#else
inline unsigned cvtpk(float lo, float hi) { return (unsigned)f2bf(lo) | ((unsigned)f2bf(hi) << 16); }
#endif
__device__ __forceinline__ float xlane_max4(float v, int lane) {
    v = fmaxf(v, __builtin_bit_cast(float, BPERM((lane ^ 16) << 2, __builtin_bit_cast(int, v))));
    v = fmaxf(v, __builtin_bit_cast(float, BPERM((lane ^ 32) << 2, __builtin_bit_cast(int, v)))); return v; }
__device__ __forceinline__ float xlane_sum4(float v, int lane) {
    v += __builtin_bit_cast(float, BPERM((lane ^ 16) << 2, __builtin_bit_cast(int, v)));
    v += __builtin_bit_cast(float, BPERM((lane ^ 32) << 2, __builtin_bit_cast(int, v))); return v; }

constexpr int DIL_LD = 72, DIL_TEAM_BYTES = (64 + 192 + 192) * DIL_LD * 2;
static_assert(2 * DIL_TEAM_BYTES <= RING_BYTES, "dilated attention LDS");
__device__ __forceinline__ void dil_attn_phase(LAS unsigned char* lds, const bf16* proj, bf16* dpo, float* dml, const int tid, const int bid, const int G) {
    const int lane = tid & 63, wave = RFL(tid >> 6), team = wave >> 2, w = wave & 3, tt = tid & 255, fr = lane & 15, fq = lane >> 4;
    LAS bf16* Qs = (LAS bf16*)(lds + team * DIL_TEAM_BYTES); LAS bf16* Ks = Qs + 64 * DIL_LD; LAS bf16* Vs = Ks + 192 * DIL_LD;
    constexpr int NITEMS = BATCH * 8 * 3 * 64;
    for (int it0 = bid * 2; it0 < NITEMS; it0 += G * 2) {
        const int it = it0 + team;
        const int blk = it & 63; int r = it >> 6; const int br = r % 3; r /= 3; const int h = r & 7, b = r >> 3;
        const int dil = br == 0 ? 1 : (br == 1 ? 4 : 16), L = SEQ / dil, nb = L / 64, g = blk / nb, n = blk % nb;
        const bf16* base = proj + (size_t)b * SEQ * NPROJ + OFF_D + h * 64;
        BSYNC();
#pragma unroll
        for (int c = tt; c < 512; c += 256) { const int i = c >> 3, ch = c & 7; const int pos = (64 * n + i) * dil + g;
            *(LAS v4u*)(Qs + i * DIL_LD + ch * 8) = *(const GAS v4u*)(base + (size_t)pos * NPROJ + ch * 8); }
#pragma unroll
        for (int c = tt; c < 1536; c += 256) { const int kr = c >> 3, ch = c & 7; const int kidx = 64 * (n - 1) + kr; const bool ok = kidx >= 0 && kidx < L; const int pos = (ok ? kidx : 0) * dil + g;
            v4u kv = (v4u){0u, 0u, 0u, 0u}, vv = kv;
            if (ok) { kv = *(const GAS v4u*)(base + (size_t)pos * NPROJ + 512 + ch * 8); vv = *(const GAS v4u*)(base + (size_t)pos * NPROJ + 1024 + ch * 8); }
            *(LAS v4u*)(Ks + kr * DIL_LD + ch * 8) = kv; *(LAS v4u*)(Vs + kr * DIL_LD + ch * 8) = vv; }
        BSYNC();
        bf16x8 qf[2];
#pragma unroll
        for (int ks = 0; ks < 2; ++ks) qf[ks] = frag_row(Qs, DIL_LD, 16 * w, 32 * ks, fr, fq);
        f32x4 sc[12];
#pragma unroll
        for (int kt = 0; kt < 12; ++kt) { sc[kt] = (f32x4){0.f, 0.f, 0.f, 0.f};
#pragma unroll
            for (int ks = 0; ks < 2; ++ks) sc[kt] = MMA16(frag_row(Ks, DIL_LD, 16 * kt, 32 * ks, fr, fq), qf[ks], sc[kt]); }
        const int qi = 64 * n + 16 * w + fr; float mx = -1e30f;
#pragma unroll
        for (int kt = 0; kt < 12; ++kt)
#pragma unroll
            for (int j = 0; j < 4; ++j) { const int ki = 64 * (n - 1) + 16 * kt + 4 * fq + j; const int dd = ki - qi; const bool ok = dd >= -64 && dd <= 64 && ki >= 0 && ki < L;
                sc[kt][j] = ok ? sc[kt][j] : -1e30f; mx = fmaxf(mx, sc[kt][j]); }
        mx = xlane_max4(mx, lane);
        float den = 0.f;
#pragma unroll
        for (int kt = 0; kt < 12; ++kt)
#pragma unroll
            for (int j = 0; j < 4; ++j) { const float p = sc[kt][j] > -1e29f ? FEXP(sc[kt][j] - mx) : 0.f; sc[kt][j] = p; den += p; }
        den = xlane_sum4(den, lane);
        f32x4 o[4];
#pragma unroll
        for (int et = 0; et < 4; ++et) o[et] = (f32x4){0.f, 0.f, 0.f, 0.f};
#pragma unroll
        for (int u = 0; u < 6; ++u) {
            const unsigned p0 = cvtpk(sc[2 * u][0], sc[2 * u][1]), p1 = cvtpk(sc[2 * u][2], sc[2 * u][3]), p2 = cvtpk(sc[2 * u + 1][0], sc[2 * u + 1][1]), p3 = cvtpk(sc[2 * u + 1][2], sc[2 * u + 1][3]);
            const bf16x8 pf = __builtin_bit_cast(bf16x8, (v4u){p0, p1, p2, p3});
#pragma unroll
            for (int et = 0; et < 4; ++et) { const s16x4 a = tr4(Vs, DIL_LD, 32 * u + 4 * fq, 16 * et, fr), bq = tr4(Vs, DIL_LD, 32 * u + 16 + 4 * fq, 16 * et, fr);
                o[et] = MMA16(((bf16x8){a[0], a[1], a[2], a[3], bq[0], bq[1], bq[2], bq[3]}), pf, o[et]); }
        }
        const float inv = 1.f / den; const size_t t = (size_t)b * SEQ + (size_t)qi * dil + g;
        bf16* op = dpo + ((size_t)br * T + t) * 512 + h * 64 + 4 * fq;
#pragma unroll
        for (int et = 0; et < 4; ++et) { v2u pk; pk.x = cvtpk(o[et][0] * inv, o[et][1] * inv); pk.y = cvtpk(o[et][2] * inv, o[et][3] * inv); *(GAS v2u*)(op + 16 * et) = pk; }
        if (fq == 0) { float* mp = dml + (((size_t)br * T + t) * 8 + h) * 2; mp[0] = mx; mp[1] = den; }
    }
}

constexpr int RET_LD = 72, RET1_TEAM_BYTES = 3 * 128 * RET_LD * 2;
static_assert(2 * RET1_TEAM_BYTES <= RING_BYTES && (3 * 128 + 2 * 64) * RET_LD * 2 <= RING_BYTES, "retention LDS");
__device__ __forceinline__ void unpack8(const v4u x, float (&f)[8]) {
    f[0] = __builtin_bit_cast(float, x.x << 16); f[1] = __builtin_bit_cast(float, x.x & 0xffff0000u); f[2] = __builtin_bit_cast(float, x.y << 16); f[3] = __builtin_bit_cast(float, x.y & 0xffff0000u);
    f[4] = __builtin_bit_cast(float, x.z << 16); f[5] = __builtin_bit_cast(float, x.z & 0xffff0000u); f[6] = __builtin_bit_cast(float, x.w << 16); f[7] = __builtin_bit_cast(float, x.w & 0xffff0000u); }
__device__ __forceinline__ void ret_kv_phase(LAS unsigned char* lds, const bf16* proj, const float* gam, float* rkv, const int tid, const int bid, const int G) {
    const int lane = tid & 63, wave = RFL(tid >> 6), team = wave >> 2, w = wave & 3, tt = tid & 255, fr = lane & 15, fq = lane >> 4;
    LAS bf16* Kf = (LAS bf16*)(lds + team * RET1_TEAM_BYTES); LAS bf16* Kb = Kf + 128 * RET_LD; LAS bf16* Vs = Kb + 128 * RET_LD;
    constexpr int NITEMS = BATCH * 8 * NC;
    for (int it0 = bid * 2; it0 < NITEMS; it0 += G * 2) {
        const int it = it0 + team; const int ch = it % NC, h = (it / NC) & 7, b = it / (NC * 8);
        const float lgf = logsigmoidf_(gam[h]), lgb = logsigmoidf_(gam[8 + h]);
        const bf16* base = proj + ((size_t)b * SEQ + (size_t)ch * 128) * NPROJ + OFF_A + h * 64;
        BSYNC();
#pragma unroll
        for (int c = tt; c < 1024; c += 256) { const int m = c >> 3, cc = c & 7;
            const v4u kv = *(const GAS v4u*)(base + (size_t)m * NPROJ + 512 + cc * 8), vv = *(const GAS v4u*)(base + (size_t)m * NPROJ + 1024 + cc * 8);
            float f[8]; unpack8(kv, f); const float df = FEXP(lgf * (float)(127 - m)), db = FEXP(lgb * (float)m);
            *(LAS v4u*)(Kf + m * RET_LD + cc * 8) = (v4u){cvtpk(f[0] * df, f[1] * df), cvtpk(f[2] * df, f[3] * df), cvtpk(f[4] * df, f[5] * df), cvtpk(f[6] * df, f[7] * df)};
            *(LAS v4u*)(Kb + m * RET_LD + cc * 8) = (v4u){cvtpk(f[0] * db, f[1] * db), cvtpk(f[2] * db, f[3] * db), cvtpk(f[4] * db, f[5] * db), cvtpk(f[6] * db, f[7] * db)};
            *(LAS v4u*)(Vs + m * RET_LD + cc * 8) = vv; }
        BSYNC();
        f32x4 aF[4], aB[4];
#pragma unroll
        for (int dt = 0; dt < 4; ++dt) { aF[dt] = (f32x4){0.f, 0.f, 0.f, 0.f}; aB[dt] = aF[dt]; }
#pragma unroll
        for (int ks = 0; ks < 4; ++ks) { const bf16x8 a = frag_col(Vs, RET_LD, 32 * ks, 16 * w, fr, fq);
#pragma unroll
            for (int dt = 0; dt < 4; ++dt) { aF[dt] = MMA16(a, frag_col(Kf, RET_LD, 32 * ks, 16 * dt, fr, fq), aF[dt]); aB[dt] = MMA16(a, frag_col(Kb, RET_LD, 32 * ks, 16 * dt, fr, fq), aB[dt]); } }
        float* oF = rkv + ((size_t)((b * 8 + h) * 2 + 0) * NC + ch) * 4096; float* oB = rkv + ((size_t)((b * 8 + h) * 2 + 1) * NC + ch) * 4096;
#pragma unroll
        for (int dt = 0; dt < 4; ++dt)
#pragma unroll
            for (int j = 0; j < 4; ++j) { const int e = 16 * w + 4 * fq + j, d = 16 * dt + fr; oF[e * 64 + d] = aF[dt][j]; oB[e * 64 + d] = aB[dt][j]; }
    }
}
__device__ __forceinline__ void ret_out_phase(LAS unsigned char* lds, const bf16* proj, const float* gam, const float* ret_g, const float* rsp, bf16* ycat, const int tid, const int bid, const int G) {
    const int lane = tid & 63, w = RFL(tid >> 6), fr = lane & 15, fq = lane >> 4;
    LAS bf16* Qs = (LAS bf16*)lds; LAS bf16* Ks = Qs + 128 * RET_LD; LAS bf16* Vs = Ks + 128 * RET_LD; LAS bf16* Sf = Vs + 128 * RET_LD; LAS bf16* Sb = Sf + 64 * RET_LD;
    constexpr int NITEMS = BATCH * 8 * NC;
    for (int it = bid; it < NITEMS; it += G) {
        const int ch = it % NC, h = (it / NC) & 7, b = it / (NC * 8);
        const float lgf = logsigmoidf_(gam[h]), lgb = logsigmoidf_(gam[8 + h]);
        const size_t t0 = (size_t)b * SEQ + (size_t)ch * 128;
        const bf16* base = proj + t0 * NPROJ + OFF_A + h * 64;
        const float* gSf = rsp + ((size_t)((b * 8 + h) * 2 + 0) * NC + ch) * 4096; const float* gSb = rsp + ((size_t)((b * 8 + h) * 2 + 1) * NC + ch) * 4096;
        BSYNC();
#pragma unroll
        for (int c = tid; c < 1024; c += 512) { const int m = c >> 3, cc = c & 7; const bf16* rp = base + (size_t)m * NPROJ + cc * 8;
            *(LAS v4u*)(Qs + m * RET_LD + cc * 8) = *(const GAS v4u*)(rp); *(LAS v4u*)(Ks + m * RET_LD + cc * 8) = *(const GAS v4u*)(rp + 512); *(LAS v4u*)(Vs + m * RET_LD + cc * 8) = *(const GAS v4u*)(rp + 1024); }
#pragma unroll
        for (int c = tid; c < 1024; c += 512) { const int e = c >> 4, d4 = (c & 15) * 4; const f32x4 a = *(const GAS f32x4*)(gSf + e * 64 + d4), bb = *(const GAS f32x4*)(gSb + e * 64 + d4);
            *(LAS v2u*)(Sf + e * RET_LD + d4) = (v2u){cvtpk(a.x, a.y), cvtpk(a.z, a.w)}; *(LAS v2u*)(Sb + e * RET_LD + d4) = (v2u){cvtpk(bb.x, bb.y), cvtpk(bb.z, bb.w)}; }
        BSYNC();
        bf16x8 qf[2];
#pragma unroll
        for (int ks = 0; ks < 2; ++ks) qf[ks] = frag_row(Qs, RET_LD, 16 * w, 32 * ks, fr, fq);
        f32x4 sc[8];
#pragma unroll
        for (int kt = 0; kt < 8; ++kt) { sc[kt] = (f32x4){0.f, 0.f, 0.f, 0.f};
#pragma unroll
            for (int ks = 0; ks < 2; ++ks) sc[kt] = MMA16(frag_row(Ks, RET_LD, 16 * kt, 32 * ks, fr, fq), qf[ks], sc[kt]); }
        const int n = 16 * w + fr;
#pragma unroll
        for (int kt = 0; kt < 8; ++kt)
#pragma unroll
            for (int j = 0; j < 4; ++j) { const int m = 16 * kt + 4 * fq + j; sc[kt][j] *= m <= n ? FEXP(lgf * (float)(n - m)) : FEXP(lgb * (float)(m - n)); }
        f32x4 o[4], aF[4], aB[4];
#pragma unroll
        for (int et = 0; et < 4; ++et) { o[et] = (f32x4){0.f, 0.f, 0.f, 0.f}; aF[et] = o[et]; aB[et] = o[et]; }
#pragma unroll
        for (int u = 0; u < 4; ++u) {
            const bf16x8 pf = __builtin_bit_cast(bf16x8, (v4u){cvtpk(sc[2 * u][0], sc[2 * u][1]), cvtpk(sc[2 * u][2], sc[2 * u][3]), cvtpk(sc[2 * u + 1][0], sc[2 * u + 1][1]), cvtpk(sc[2 * u + 1][2], sc[2 * u + 1][3])});
#pragma unroll
            for (int et = 0; et < 4; ++et) { const s16x4 a = tr4(Vs, RET_LD, 32 * u + 4 * fq, 16 * et, fr), bq = tr4(Vs, RET_LD, 32 * u + 16 + 4 * fq, 16 * et, fr);
                o[et] = MMA16(((bf16x8){a[0], a[1], a[2], a[3], bq[0], bq[1], bq[2], bq[3]}), pf, o[et]); }
        }
#pragma unroll
        for (int et = 0; et < 4; ++et)
#pragma unroll
            for (int ks = 0; ks < 2; ++ks) { aF[et] = MMA16(frag_row(Sf, RET_LD, 16 * et, 32 * ks, fr, fq), qf[ks], aF[et]); aB[et] = MMA16(frag_row(Sb, RET_LD, 16 * et, 32 * ks, fr, fq), qf[ks], aB[et]); }
        const float qdf = FEXP(lgf * (float)(n + 1)), qdb = FEXP(lgb * (float)(128 - n));
        float mu = 0.f;
#pragma unroll
        for (int et = 0; et < 4; ++et)
#pragma unroll
            for (int j = 0; j < 4; ++j) { o[et][j] += qdf * aF[et][j] + qdb * aB[et][j]; mu += o[et][j]; }
        mu = xlane_sum4(mu, lane) * (1.f / 64.f);
        float var = 0.f;
#pragma unroll
        for (int et = 0; et < 4; ++et)
#pragma unroll
            for (int j = 0; j < 4; ++j) { const float dlt = o[et][j] - mu; var += dlt * dlt; }
        const float rstd = 1.f / sqrtf(xlane_sum4(var, lane) * (1.f / 64.f) + GN_EPS);
        const bf16* gp = proj + (t0 + n) * NPROJ + OFF_A + 1536 + h * 64 + 4 * fq; bf16* yp = ycat + (t0 + n) * 2048 + h * 64 + 4 * fq; const float* gg = ret_g + h * 64 + 4 * fq;
#pragma unroll
        for (int et = 0; et < 4; ++et) { const v2u gv = *(const GAS v2u*)(gp + 16 * et); const f32x4 gn = *(const GAS f32x4*)(gg + 16 * et);
            const float g0 = __builtin_bit_cast(float, gv.x << 16), g1 = __builtin_bit_cast(float, gv.x & 0xffff0000u), g2 = __builtin_bit_cast(float, gv.y << 16), g3 = __builtin_bit_cast(float, gv.y & 0xffff0000u);
            const float y0 = siluf_(g0) * ((o[et][0] - mu) * rstd * gn.x), y1 = siluf_(g1) * ((o[et][1] - mu) * rstd * gn.y), y2 = siluf_(g2) * ((o[et][2] - mu) * rstd * gn.z), y3 = siluf_(g3) * ((o[et][3] - mu) * rstd * gn.w);
            *(GAS v2u*)(yp + 16 * et) = (v2u){cvtpk(y0, y1), cvtpk(y2, y3)}; }
    }
}
constexpr int SGU_LDV = 72, SGU_LDW = 136, SGU_TEAM_BYTES = (128 * SGU_LDV + 128 * SGU_LDW) * 2;
static_assert(2 * SGU_TEAM_BYTES <= RING_BYTES, "SGU LDS");
__device__ __forceinline__ void sgu_phase(LAS unsigned char* lds, const bf16* proj, const float* sgu_w, const float* sgu_bias, bf16* ycat, const int tid, const int bid, const int G) {
    const int lane = tid & 63, wave = RFL(tid >> 6), team = wave >> 2, w = wave & 3, tt = tid & 255, fr = lane & 15, fq = lane >> 4;
    LAS bf16* Vn = (LAS bf16*)(lds + team * SGU_TEAM_BYTES); LAS bf16* Ws = Vn + 128 * SGU_LDV;
    constexpr int NITEMS = BATCH * NC * 8;
    for (int it0 = bid * 2; it0 < NITEMS; it0 += G * 2) {
        const int it = it0 + team; const int bc = it % (BATCH * NC), g = it / (BATCH * NC);
        const size_t t0 = (size_t)bc * 128;
        const bf16* vb = proj + t0 * NPROJ + OFF_C + 512 + g * 64; const float* wsrc = sgu_w + (size_t)g * 128 * 128;
        BSYNC();
#pragma unroll
        for (int c = tt; c < 1024; c += 256) { const int q = c >> 3, cc = c & 7; *(LAS v4u*)(Vn + q * SGU_LDV + cc * 8) = *(const GAS v4u*)(vb + (size_t)q * NPROJ + cc * 8); }
#pragma unroll
        for (int c = tt; c < 4096; c += 256) { const int p = c >> 5, q4 = (c & 31) * 4; const f32x4 a = *(const GAS f32x4*)(wsrc + p * 128 + q4); *(LAS v2u*)(Ws + p * SGU_LDW + q4) = (v2u){cvtpk(a.x, a.y), cvtpk(a.z, a.w)}; }
        BSYNC();
        f32x4 acc[2][4];
#pragma unroll
        for (int i = 0; i < 2; ++i)
#pragma unroll
            for (int dt = 0; dt < 4; ++dt) acc[i][dt] = (f32x4){0.f, 0.f, 0.f, 0.f};
#pragma unroll
        for (int ks = 0; ks < 4; ++ks) { bf16x8 a[4];
#pragma unroll
            for (int dt = 0; dt < 4; ++dt) a[dt] = frag_col(Vn, SGU_LDV, 32 * ks, 16 * dt, fr, fq);
#pragma unroll
            for (int i = 0; i < 2; ++i) { const bf16x8 bfr = frag_row(Ws, SGU_LDW, 16 * (2 * w + i), 32 * ks, fr, fq);
#pragma unroll
                for (int dt = 0; dt < 4; ++dt) acc[i][dt] = MMA16(a[dt], bfr, acc[i][dt]); } }
#pragma unroll
        for (int i = 0; i < 2; ++i) { const int p = 16 * (2 * w + i) + fr; const float bias = sgu_bias[g * 128 + p];
            const bf16* up = proj + (t0 + p) * NPROJ + OFF_C + g * 64 + 4 * fq; bf16* yp = ycat + (t0 + p) * 2048 + 1024 + g * 64 + 4 * fq;
#pragma unroll
            for (int dt = 0; dt < 4; ++dt) { const v2u uv = *(const GAS v2u*)(up + 16 * dt);
                const float u0 = __builtin_bit_cast(float, uv.x << 16), u1 = __builtin_bit_cast(float, uv.x & 0xffff0000u), u2 = __builtin_bit_cast(float, uv.y << 16), u3 = __builtin_bit_cast(float, uv.y & 0xffff0000u);
                *(GAS v2u*)(yp + 16 * dt) = (v2u){cvtpk(geluf_(u0) * (acc[i][dt][0] + bias), geluf_(u1) * (acc[i][dt][1] + bias)), cvtpk(geluf_(u2) * (acc[i][dt][2] + bias), geluf_(u3) * (acc[i][dt][3] + bias))}; } }
    }
}

constexpr int RWC = 32, RW_NCH = SEQ / RWC, RW_LD = 72, RW_LS = 40, RW_IN_B = 32 * RW_LD * 2, RW_SM_B = 32 * RW_LS * 2;
constexpr int RW_AH = 0, RW_BC = RW_IN_B, RW_KC = 2 * RW_IN_B, RW_RH = 3 * RW_IN_B, RW_BT = 4 * RW_IN_B, RW_KT = 5 * RW_IN_B, RW_VV = 6 * RW_IN_B, RW_M1 = 7 * RW_IN_B, RW_WW = 8 * RW_IN_B, RW_UL = 9 * RW_IN_B,
              RW_XA = 10 * RW_IN_B, RW_XB = RW_XA + RW_SM_B, RW_T0 = RW_XB + RW_SM_B, RW_T1 = RW_T0 + RW_SM_B, RW_AAK = RW_T1 + RW_SM_B, RW_ARB = RW_AAK + RW_SM_B, RW_ARK = RW_ARB + RW_SM_B, RW_SEG = RW_ARK + RW_SM_B,
              RW_TEAM_BYTES = RW_SEG + 4 * 64 * 4;
static_assert(2 * RW_TEAM_BYTES <= RING_BYTES, "RWKV chunk LDS");
__device__ __forceinline__ void st_tile_bf16(LAS bf16* X, int ld, int r0, int c0, const f32x4 v, int fr, int fq) {
#pragma unroll
    for (int j = 0; j < 4; ++j) X[(r0 + 4 * fq + j) * ld + c0 + fr] = f2bf(v[j]); }
__device__ __forceinline__ void rwkv_chunk_phase(LAS unsigned char* lds, const Ctx& c, unsigned char* ws, const int tid, const int bid, const int G) {
    const int lane = tid & 63, wave = RFL(tid >> 6), team = wave >> 2, w = wave & 3, tt = tid & 255, fr = lane & 15, fq = lane >> 4;
    LAS unsigned char* L = lds + team * RW_TEAM_BYTES;
    LAS bf16* AH = (LAS bf16*)(L + RW_AH); LAS bf16* BC = (LAS bf16*)(L + RW_BC); LAS bf16* KC = (LAS bf16*)(L + RW_KC); LAS bf16* RH = (LAS bf16*)(L + RW_RH); LAS bf16* BT = (LAS bf16*)(L + RW_BT);
    LAS bf16* KT = (LAS bf16*)(L + RW_KT); LAS bf16* VV = (LAS bf16*)(L + RW_VV); LAS bf16* M1 = (LAS bf16*)(L + RW_M1); LAS bf16* WW = (LAS bf16*)(L + RW_WW); LAS bf16* UL = (LAS bf16*)(L + RW_UL);
    LAS bf16* XA = (LAS bf16*)(L + RW_XA); LAS bf16* XB = (LAS bf16*)(L + RW_XB); LAS bf16* T0 = (LAS bf16*)(L + RW_T0); LAS bf16* T1 = (LAS bf16*)(L + RW_T1);
    LAS bf16* AAK = (LAS bf16*)(L + RW_AAK); LAS bf16* ARB = (LAS bf16*)(L + RW_ARB); LAS bf16* ARK = (LAS bf16*)(L + RW_ARK); LAS float* SEG = (LAS float*)(L + RW_SEG);
    bf16* gRB = (bf16*)(ws + WS_RB); bf16* gPT = (bf16*)(ws + WS_PT); bf16* gQF = (bf16*)(ws + WS_QF); bf16* gYL = (bf16*)(ws + WS_YL); float* gDC = (float*)(ws + WS_DC);
#ifdef RW_EMU_LIMIT
    constexpr int NITEMS = RW_EMU_LIMIT;
#else
    constexpr int NITEMS = BATCH * 16 * RW_NCH;
#endif
    const int it_ = w >> 1, jt_ = w & 1;
    for (int it0 = bid * 2; it0 < NITEMS; it0 += G * 2) {
        const int item = it0 + team; const int cc = item % RW_NCH, unit = item / RW_NCH, dir = unit & 1, h = (unit >> 1) & 7, b = unit >> 4;
        const size_t tb = (size_t)b * SEQ + (size_t)cc * RWC;
        const float* LW = dir ? c.wb : c.wf; const bf16* KD = dir ? c.kdb : c.kdf; const bf16* AK = dir ? c.akb : c.akf;
        BSYNC();
        {
            const int ch = tt & 63, seg = tt >> 6; float lwv[8], g[8]; float run = 0.f;
#pragma unroll
            for (int r = 0; r < 8; ++r) { const int i = 8 * seg + r; const size_t tok = dir ? tb + 31 - i : tb + i; lwv[r] = LW[tok * 512 + h * 64 + ch]; run += lwv[r]; g[r] = run; }
            SEG[seg * 64 + ch] = run;
            BSYNC();
            float off = 0.f, GC = 0.f;
#pragma unroll
            for (int s2 = 0; s2 < 4; ++s2) { const float v = SEG[s2 * 64 + ch]; off += s2 < seg ? v : 0.f; GC += v; }
            if (seg == 0) gDC[(size_t)item * 64 + ch] = FEXP(GC);
#pragma unroll
            for (int r = 0; r < 8; ++r) { const int i = 8 * seg + r; const size_t o = (dir ? tb + 31 - i : tb + i) * 512 + h * 64 + ch;
                const float Gi = off + g[r], Gm = Gi - lwv[r];
                const float kk = bf2f(c.kk[o]), be = bf2f(AK[o]), kt = bf2f(KD[o]), rr = bf2f(c.rs[o]);
                const float eG = FEXP(Gi), eI = FEXP(-Gi), eM = FEXP(Gm), eC = FEXP(GC - Gi);
                AH[i * RW_LD + ch] = f2bf(-kk * eM); BC[i * RW_LD + ch] = f2bf(be * eI); KC[i * RW_LD + ch] = f2bf(kt * eI); RH[i * RW_LD + ch] = f2bf(rr * eG);
                BT[i * RW_LD + ch] = f2bf(be * eC); KT[i * RW_LD + ch] = f2bf(kt * eC); VV[i * RW_LD + ch] = c.vs[o]; }
        }
        BSYNC();
        {
            const LAS bf16* As = w < 2 ? AH : RH; const LAS bf16* Bs = (w & 1) ? KC : BC; LAS bf16* D = w == 0 ? XA : (w == 1 ? AAK : (w == 2 ? ARB : ARK));
#pragma unroll
            for (int it = 0; it < 2; ++it)
#pragma unroll
                for (int jt = 0; jt < 2; ++jt) { f32x4 a = (f32x4){0.f, 0.f, 0.f, 0.f};
#pragma unroll
                    for (int ks = 0; ks < 2; ++ks) a = MMA16(frag_row(As, RW_LD, 16 * it, 32 * ks, fr, fq), frag_row(Bs, RW_LD, 16 * jt, 32 * ks, fr, fq), a);
#pragma unroll
                    for (int j = 0; j < 4; ++j) { const int i = 16 * it + 4 * fq + j, jj = 16 * jt + fr; const bool keep = w < 2 ? jj < i : jj <= i; a[j] = keep ? a[j] : 0.f; }
                    st_tile_bf16(D, RW_LS, 16 * it, 16 * jt, a, fr, fq); }
        }
        BSYNC();
        f32x4 Tacc;
        {
            const f32x4 x2 = MMA16(frag_row(XA, RW_LS, 16 * it_, 0, fr, fq), frag_col(XA, RW_LS, 0, 16 * jt_, fr, fq), ((f32x4){0.f, 0.f, 0.f, 0.f}));
            st_tile_bf16(XB, RW_LS, 16 * it_, 16 * jt_, x2, fr, fq);
#pragma unroll
            for (int j = 0; j < 4; ++j) { const int i = 16 * it_ + 4 * fq + j, jj = 16 * jt_ + fr; Tacc[j] = bf2f(XA[i * RW_LS + jj]) + (i == jj ? 1.f : 0.f); }
            st_tile_bf16(T0, RW_LS, 16 * it_, 16 * jt_, Tacc, fr, fq);
#pragma unroll
            for (int q = 0; q < 2; ++q) { const int et = 2 * jt_ + q; const f32x4 m1 = MMA16(frag_row(AAK, RW_LS, 16 * it_, 0, fr, fq), frag_col(VV, RW_LD, 0, 16 * et, fr, fq), ((f32x4){0.f, 0.f, 0.f, 0.f}));
                st_tile_bf16(M1, RW_LD, 16 * it_, 16 * et, m1, fr, fq); }
        }
        BSYNC();
#define RW_CHAIN(TR, TW, XR, XW, SQUARE) { Tacc = MMA16(frag_row(TR, RW_LS, 16 * it_, 0, fr, fq), frag_col(XR, RW_LS, 0, 16 * jt_, fr, fq), Tacc); st_tile_bf16(TW, RW_LS, 16 * it_, 16 * jt_, Tacc, fr, fq); \
        if (SQUARE) { const f32x4 xx = MMA16(frag_row(XR, RW_LS, 16 * it_, 0, fr, fq), frag_col(XR, RW_LS, 0, 16 * jt_, fr, fq), ((f32x4){0.f, 0.f, 0.f, 0.f})); st_tile_bf16(XW, RW_LS, 16 * it_, 16 * jt_, xx, fr, fq); } \
        BSYNC(); }
        RW_CHAIN(T0, T1, XB, XA, true)
        RW_CHAIN(T1, T0, XA, XB, true)
        RW_CHAIN(T0, T1, XB, XA, true)
        RW_CHAIN(T1, T0, XA, XB, false)
#undef RW_CHAIN
        {
            const bf16x8 tf = frag_row(T0, RW_LS, 16 * it_, 0, fr, fq);
#pragma unroll
            for (int q = 0; q < 2; ++q) { const int ct = 2 * jt_ + q;
                st_tile_bf16(WW, RW_LD, 16 * it_, 16 * ct, MMA16(tf, frag_col(AH, RW_LD, 0, 16 * ct, fr, fq), ((f32x4){0.f, 0.f, 0.f, 0.f})), fr, fq);
                st_tile_bf16(UL, RW_LD, 16 * it_, 16 * ct, MMA16(tf, frag_col(M1, RW_LD, 0, 16 * ct, fr, fq), ((f32x4){0.f, 0.f, 0.f, 0.f})), fr, fq); }
        }
        BSYNC();
        {
            const bf16x8 wcol = frag_col(WW, RW_LD, 0, 16 * w, fr, fq), ulc = frag_col(UL, RW_LD, 0, 16 * w, fr, fq), vvc = frag_col(VV, RW_LD, 0, 16 * w, fr, fq);
            bf16* pt = gPT + (size_t)item * 4096; bf16* qf = gQF + (size_t)item * 4096; bf16* rb = gRB + (size_t)item * 2048; bf16* yl = gYL + (size_t)item * 2048;
#pragma unroll
            for (int kq = 0; kq < 4; ++kq) { const bf16x8 btc = frag_col(BT, RW_LD, 0, 16 * kq, fr, fq), ktc = frag_col(KT, RW_LD, 0, 16 * kq, fr, fq);
                const f32x4 p = MMA16(wcol, btc, ((f32x4){0.f, 0.f, 0.f, 0.f}));
                *(GAS v2u*)(pt + (16 * kq + fr) * 64 + 16 * w + 4 * fq) = (v2u){cvtpk(p[0], p[1]), cvtpk(p[2], p[3])};
                f32x4 q = MMA16(btc, ulc, ((f32x4){0.f, 0.f, 0.f, 0.f})); q = MMA16(ktc, vvc, q);
                *(GAS v2u*)(qf + ((w * 4 + kq) * 64 + lane) * 4) = (v2u){cvtpk(q[0], q[1]), cvtpk(q[2], q[3])}; }
#pragma unroll
            for (int it = 0; it < 2; ++it) { const bf16x8 arb = frag_row(ARB, RW_LS, 16 * it, 0, fr, fq), ark = frag_row(ARK, RW_LS, 16 * it, 0, fr, fq);
                const f32x4 r = MMA16(wcol, arb, ((f32x4){0.f, 0.f, 0.f, 0.f}));
                const v2u rh = *(const LAS v2u*)(RH + (16 * it + fr) * RW_LD + 16 * w + 4 * fq);
                const float r0 = r[0] + __builtin_bit_cast(float, rh.x << 16), r1 = r[1] + __builtin_bit_cast(float, rh.x & 0xffff0000u), r2 = r[2] + __builtin_bit_cast(float, rh.y << 16), r3 = r[3] + __builtin_bit_cast(float, rh.y & 0xffff0000u);
                *(GAS v2u*)(rb + (16 * it + fr) * 64 + 16 * w + 4 * fq) = (v2u){cvtpk(r0, r1), cvtpk(r2, r3)};
                f32x4 y = MMA16(arb, ulc, ((f32x4){0.f, 0.f, 0.f, 0.f})); y = MMA16(ark, vvc, y);
                *(GAS v2u*)(yl + ((it * 4 + w) * 64 + lane) * 4) = (v2u){cvtpk(y[0], y[1]), cvtpk(y[2], y[3])}; }
        }
    }
}
struct RwStep { v2u pt[4][2][2]; v2u rb[2][2][2]; v2u q[4]; v2u yl[2]; f32x4 dc[4]; };
__device__ __forceinline__ void rw_load(RwStep& s, const unsigned char* ws, int item, int vb, int lane, int fr, int fq) {
    const bf16* pt = (const bf16*)(ws + WS_PT) + (size_t)item * 4096; const bf16* rb = (const bf16*)(ws + WS_RB) + (size_t)item * 2048;
    const bf16* qf = (const bf16*)(ws + WS_QF) + (size_t)item * 4096; const bf16* yl = (const bf16*)(ws + WS_YL) + (size_t)item * 2048; const float* dc = (const float*)(ws + WS_DC) + (size_t)item * 64;
#pragma unroll
    for (int kq = 0; kq < 4; ++kq) {
#pragma unroll
        for (int ks = 0; ks < 2; ++ks) { s.pt[kq][ks][0] = *(const GAS v2u*)(pt + (16 * kq + fr) * 64 + 32 * ks + 4 * fq); s.pt[kq][ks][1] = *(const GAS v2u*)(pt + (16 * kq + fr) * 64 + 32 * ks + 16 + 4 * fq); }
        s.q[kq] = *(const GAS v2u*)(qf + ((vb * 4 + kq) * 64 + lane) * 4); s.dc[kq] = *(const GAS f32x4*)(dc + 16 * kq + 4 * fq); }
#pragma unroll
    for (int it = 0; it < 2; ++it) {
#pragma unroll
        for (int ks = 0; ks < 2; ++ks) { s.rb[it][ks][0] = *(const GAS v2u*)(rb + (16 * it + fr) * 64 + 32 * ks + 4 * fq); s.rb[it][ks][1] = *(const GAS v2u*)(rb + (16 * it + fr) * 64 + 32 * ks + 16 + 4 * fq); }
        s.yl[it] = *(const GAS v2u*)(yl + ((it * 4 + vb) * 64 + lane) * 4); }
}
__device__ __forceinline__ void rw_step(const RwStep& s, f32x4 (&S)[4], bf16* Y, size_t tb, int dir, int h, int vb, int fr, int fq) {
    bf16x8 sf[2];
#pragma unroll
    for (int ks = 0; ks < 2; ++ks) sf[ks] = __builtin_bit_cast(bf16x8, (v4u){cvtpk(S[2 * ks][0], S[2 * ks][1]), cvtpk(S[2 * ks][2], S[2 * ks][3]), cvtpk(S[2 * ks + 1][0], S[2 * ks + 1][1]), cvtpk(S[2 * ks + 1][2], S[2 * ks + 1][3])});
#pragma unroll
    for (int it = 0; it < 2; ++it) { f32x4 y = (f32x4){__builtin_bit_cast(float, s.yl[it].x << 16), __builtin_bit_cast(float, s.yl[it].x & 0xffff0000u), __builtin_bit_cast(float, s.yl[it].y << 16), __builtin_bit_cast(float, s.yl[it].y & 0xffff0000u)};
#pragma unroll
        for (int ks = 0; ks < 2; ++ks) y = MMA16(__builtin_bit_cast(bf16x8, (v4u){s.rb[it][ks][0].x, s.rb[it][ks][0].y, s.rb[it][ks][1].x, s.rb[it][ks][1].y}), sf[ks], y);
#pragma unroll
        for (int j = 0; j < 4; ++j) { const int i = 16 * it + 4 * fq + j; const size_t tok = dir ? tb + 31 - i : tb + i; Y[tok * 512 + h * 64 + 16 * vb + fr] = f2bf(y[j]); } }
#pragma unroll
    for (int kq = 0; kq < 4; ++kq) { f32x4 a;
        a[0] = S[kq][0] * s.dc[kq][0] + __builtin_bit_cast(float, s.q[kq].x << 16); a[1] = S[kq][1] * s.dc[kq][1] + __builtin_bit_cast(float, s.q[kq].x & 0xffff0000u);
        a[2] = S[kq][2] * s.dc[kq][2] + __builtin_bit_cast(float, s.q[kq].y << 16); a[3] = S[kq][3] * s.dc[kq][3] + __builtin_bit_cast(float, s.q[kq].y & 0xffff0000u);
#pragma unroll
        for (int ks = 0; ks < 2; ++ks) a = MMA16(__builtin_bit_cast(bf16x8, (v4u){s.pt[kq][ks][0].x, s.pt[kq][ks][0].y, s.pt[kq][ks][1].x, s.pt[kq][ks][1].y}), sf[ks], a);
        S[kq] = a; }
}
__device__ __forceinline__ void rwkv_scan_phase(const Ctx& c, const unsigned char* ws, const int tid, const int bid, const int G) {
    const int lane = tid & 63, wave = RFL(tid >> 6), fr = lane & 15, fq = lane >> 4;
    for (int job = bid + G * wave; job < BATCH * 16 * 4; job += G * 8) {
        const int vb = job & 3, unit = job >> 2, dir = unit & 1, h = (unit >> 1) & 7, b = unit >> 4;
        bf16* Y = dir ? c.yb : c.yf;
        f32x4 S[4];
#pragma unroll
        for (int kq = 0; kq < 4; ++kq) S[kq] = (f32x4){0.f, 0.f, 0.f, 0.f};
        RwStep sa, sb;
        rw_load(sa, ws, unit * RW_NCH + (dir ? RW_NCH - 1 : 0), vb, lane, fr, fq);
        for (int st = 0; st < RW_NCH; st += 2) {
            const int c0 = dir ? RW_NCH - 1 - st : st, c1 = dir ? c0 - 1 : c0 + 1, c2 = dir ? c0 - 2 : c0 + 2;
            rw_load(sb, ws, unit * RW_NCH + c1, vb, lane, fr, fq);
            rw_step(sa, S, Y, (size_t)b * SEQ + (size_t)c0 * RWC, dir, h, vb, fr, fq);
            if (st + 2 < RW_NCH) rw_load(sa, ws, unit * RW_NCH + c2, vb, lane, fr, fq);
            rw_step(sb, S, Y, (size_t)b * SEQ + (size_t)c1 * RWC, dir, h, vb, fr, fq);
        }
    }
}

__device__ __forceinline__ float quad_sum(float v) {
    v += __builtin_bit_cast(float, __builtin_amdgcn_update_dpp(0, __builtin_bit_cast(int, v), 0xB1, 0xF, 0xF, true));
    v += __builtin_bit_cast(float, __builtin_amdgcn_update_dpp(0, __builtin_bit_cast(int, v), 0x4E, 0xF, 0xF, true));
    return v;
}
__device__ __forceinline__ void rwkv_scan_quad(const Ctx& c, int unit, int w4, int lane) {
    const int dir = unit & 1, h = (unit >> 1) & 7, b = unit >> 4; const int row = w4 * 16 + (lane >> 2), q = lane & 3;
    const float* W = dir ? c.wb : c.wf; const bf16* KD = dir ? c.kdb : c.kdf; const bf16* AK = dir ? c.akb : c.akf; bf16* Y = dir ? c.yb : c.yf;
    float S[16];
#pragma unroll
    for (int i = 0; i < 16; ++i) S[i] = 0.f;
    for (int k = 0; k < SEQ; ++k) {
        const int s = dir ? SEQ - 1 - k : k; const size_t o = ((size_t)b * SEQ + s) * 512 + h * 64 + q * 16;
        float kkv[16], akv[16], kdv[16], rv[16], wv[16];
        { const v4u a = *(const GAS v4u*)(c.kk + o), bq = *(const GAS v4u*)(c.kk + o + 8);
          const unsigned t[8] = {a.x, a.y, a.z, a.w, bq.x, bq.y, bq.z, bq.w};
#pragma unroll
          for (int i = 0; i < 8; ++i) { kkv[2 * i] = __builtin_bit_cast(float, t[i] << 16); kkv[2 * i + 1] = __builtin_bit_cast(float, t[i] & 0xffff0000u); } }
        { const v4u a = *(const GAS v4u*)(AK + o), bq = *(const GAS v4u*)(AK + o + 8);
          const unsigned t[8] = {a.x, a.y, a.z, a.w, bq.x, bq.y, bq.z, bq.w};
#pragma unroll
          for (int i = 0; i < 8; ++i) { akv[2 * i] = __builtin_bit_cast(float, t[i] << 16); akv[2 * i + 1] = __builtin_bit_cast(float, t[i] & 0xffff0000u); } }
        { const v4u a = *(const GAS v4u*)(KD + o), bq = *(const GAS v4u*)(KD + o + 8);
          const unsigned t[8] = {a.x, a.y, a.z, a.w, bq.x, bq.y, bq.z, bq.w};
#pragma unroll
          for (int i = 0; i < 8; ++i) { kdv[2 * i] = __builtin_bit_cast(float, t[i] << 16); kdv[2 * i + 1] = __builtin_bit_cast(float, t[i] & 0xffff0000u); } }
        { const v4u a = *(const GAS v4u*)(c.rs + o), bq = *(const GAS v4u*)(c.rs + o + 8);
          const unsigned t[8] = {a.x, a.y, a.z, a.w, bq.x, bq.y, bq.z, bq.w};
#pragma unroll
          for (int i = 0; i < 8; ++i) { rv[2 * i] = __builtin_bit_cast(float, t[i] << 16); rv[2 * i + 1] = __builtin_bit_cast(float, t[i] & 0xffff0000u); } }
#pragma unroll
        for (int i = 0; i < 4; ++i) { const f32x4 w4v = *(const GAS f32x4*)(W + o + 4 * i); wv[4 * i] = w4v.x; wv[4 * i + 1] = w4v.y; wv[4 * i + 2] = w4v.z; wv[4 * i + 3] = w4v.w; }
        const float v = bf2f(c.vs[o - q * 16 + row]);
        float sk = 0.f;
#pragma unroll
        for (int i = 0; i < 16; ++i) sk += S[i] * kkv[i];
        sk = quad_sum(sk);
        float y = 0.f;
#pragma unroll
        for (int i = 0; i < 16; ++i) { S[i] = S[i] * wv[i] - sk * akv[i] + v * kdv[i]; y += S[i] * rv[i]; }
        y = quad_sum(y);
        if (q == 0) Y[o + row] = f2bf(y);
    }
}
template <int KSEL>
__device__ __forceinline__ void layer_program(const Args& args, LAS unsigned char* lds, const XcdBarrier& bar, const int l) {
        PH_ON(0) {
            PHASE_LOCALS();
            bf16* WinT = (bf16*)(ws + WS_WIN); bf16* WoutT = (bf16*)(ws + WS_WOUT);
            LAS float* scr = (LAS float*)(lds + wave * 16384);
            const float* w_in = (const float*)args.in[3] + (size_t)ll * DM * D_IN; const float* w_out = (const float*)args.in[4] + (size_t)ll * DM * DM;
            constexpr int I_IN = (DM / 64) * (D_IN / 32), I_OUT = (DM / 64) * (DM / 32);
            constexpr int NITEMS = I_IN + I_OUT;
            for (int it = gw; it < NITEMS; it += NGW) {
                int r = it;
                if (r < I_IN) { const int nblk = D_IN / 32, kb = r / nblk, nb = r % nblk; transpose_item(w_in, DM, D_IN, WinT, 64 * kb, 32 * nb, 32 * nb, scr, lane); continue; } r -= I_IN;
                { const int nblk = DM / 32, kb = r / nblk, nb = r % nblk; transpose_item(w_out, DM, DM, WoutT, 64 * kb, 32 * nb, 32 * nb, scr, lane); }
            }
            for (long i = gtid; i < (long)(NPROJ - D_IN) * DM / 8; i += gstride) ((GAS v4u*)(WinT + (size_t)D_IN * DM))[i] = (v4u){0u, 0u, 0u, 0u};
            if (ll > 0) build_moe_tables(lds, (const unsigned*)(ws + WS_CTL) + CW_CNT + (ll - 1) * 2048, tid);
            const LAS int* trb = (const LAS int*)(lds + TAB_ROWBASE);
            const float* x_in = (const float*)args.in[0]; float* xbuf = (float*)(ws + WS_X); bf16* act = (bf16*)(ws + WS_ACT); const bf16* yp = (const bf16*)(ws + WS_YP);
            const unsigned* slot_tok = (const unsigned*)(ws + WS_SLOT); const float* gate_tok = (const float*)(ws + WS_GATE);
            const float* norm1_g = (const float*)args.in[2] + ll * DM;
            for (int m = gw; m < T; m += NGW) {
                f32x4 v[8];
                ROW_LOAD(v, (ll == 0 ? x_in : xbuf) + (size_t)m * DM);
                if (ll > 0) {
                    const unsigned s1 = slot_tok[2 * m], s2 = slot_tok[2 * m + 1]; const float g1 = gate_tok[2 * m], g2 = gate_tok[2 * m + 1];
                    row_add_moe(v, yp, (size_t)(trb[s1 >> 20] + (int)(s1 & 0xfffffu)), (size_t)(trb[s2 >> 20] + (int)(s2 & 0xfffffu)), g1, g2, lane);
#pragma unroll
                    for (int j = 0; j < 8; ++j) ((GAS f32x4*)(xbuf + (size_t)m * DM))[lane + 64 * j] = v[j];
                }
                const float rstd = row_rstd(v, lane);
#pragma unroll
                for (int j = 0; j < 8; ++j) { const f32x4 g = ((const GAS f32x4*)norm1_g)[lane + 64 * j];
                    v2u o; o.x = pk2(v[j].x * rstd * g.x, v[j].y * rstd * g.y); o.y = pk2(v[j].z * rstd * g.z, v[j].w * rstd * g.w);
                    ((GAS v2u*)(act + (size_t)m * DM))[lane + 64 * j] = o; }
            }
        }
        SEAM(0);
        PH_ON(1) {
            PHASE_LOCALS();
            pg8::Gemm g{(const bf16*)(ws + WS_ACT), (const bf16*)(ws + WS_WIN), T, NPROJ, DM, 0}; pg8::StaticOrder<T, NPROJ> S; S.init(G, bid);
            pg8::EpiBf16 E{(bf16*)(ws + WS_PROJ), NPROJ};
            pg8::gemm_phase<DM, pg8::EpiBf16, pg8::StaticOrder<T, NPROJ>, true, true>(lds, g, S, E, tid);
        }
        SEAM(1);
        PH_ON(2) { PHASE_LOCALS(); const Ctx c = make_ctx(args, ws, ll);
            for (long i = gtid; i < (long)T * 256; i += gstride) el_rot_ret(c, i);
            for (long i = gtid; i < (long)T * 256; i += gstride) el_rot_dil(c, i);
            for (long i = gtid; i < (long)T * B_COLS; i += gstride) el_rwkv_shift(c, i);
            for (long i = gtid; i < (long)T; i += gstride) el_sgu_prep(c, i); }
        SEAM(2);
        PH_ON(3) { PHASE_LOCALS(); const Ctx c = make_ctx(args, ws, ll);
            for (long i = gtid; i < (long)T * 512; i += gstride) el_rwkv_lora(c, i);
            ret_kv_phase(lds, c.proj, c.gam, c.rkv, tid, bid, G);
            sgu_phase(lds, c.proj, c.sgu_w, c.sgu_bias, c.ycat, tid, bid, G);
            dil_attn_phase(lds, c.proj, (bf16*)(ws + WS_DPO), (float*)(ws + WS_DML), tid, bid, G); }
        SEAM(3);
        PH_ON(4) { PHASE_LOCALS(); const Ctx c = make_ctx(args, ws, ll);
            for (long i = gtid; i < (long)T * 8; i += gstride) el_rwkv_kk(c, i);
            for (long i = gtid; i < (long)BATCH * 8 * 2 * 4096; i += gstride) el_ret_scan(c, i); }
        SEAM(4);
        PH_ON(5) { PHASE_LOCALS(); const Ctx c = make_ctx(args, ws, ll);
            rwkv_chunk_phase(lds, c, ws, tid, bid, G); }
        SEAM(5);
        PH_ON(13) { PHASE_LOCALS(); const Ctx c = make_ctx(args, ws, ll);
            rwkv_scan_phase(c, ws, tid, bid, G); }
        SEAM(13);
        PH_ON(6) { PHASE_LOCALS(); const Ctx c = make_ctx(args, ws, ll);
            for (long i = gtid; i < (long)T * 8; i += gstride) el_dil_combine((const bf16*)(ws + WS_DPO), (const float*)(ws + WS_DML), c.ycat, i);
            ret_out_phase(lds, c.proj, c.gam, c.ret_g, c.rsp, c.ycat, tid, bid, G);
            for (long i = gtid; i < (long)T * 8; i += gstride) el_rwkv_fin(c, i); }
        SEAM(6);
        PH_ON(7) {
            PHASE_LOCALS();
            pg8::Gemm g{(const bf16*)(ws + WS_ACT), (const bf16*)(ws + WS_WOUT), T, DM, DM, 0}; pg8::StaticOrder<T, DM> S; S.init(G, bid);
            pg8::EpiResF32 E{ll == 0 ? (const float*)args.in[0] : (const float*)(ws + WS_X), (float*)(ws + WS_X), DM};
            pg8::gemm_phase<DM, pg8::EpiResF32, pg8::StaticOrder<T, DM>, true, true>(lds, g, S, E, tid);
        }
        SEAM(7);
        PH_ON(8) {
            PHASE_LOCALS();
            const float* wg = (const float*)args.in[22] + (size_t)ll * DM * 4; const float* bg = (const float*)args.in[23] + ll * 4;
            const float* we = (const float*)args.in[24] + (size_t)ll * DM * 32; const float* be = (const float*)args.in[25] + ll * 32;
            const float* norm2_g = (const float*)args.in[21] + ll * DM;
            const float* xbuf = (const float*)(ws + WS_X); bf16* act = (bf16*)(ws + WS_ACT);
            unsigned* cnt_cur = (unsigned*)(ws + WS_CTL) + CW_CNT + ll * 2048;
            int* tok_of = (int*)(ws + WS_TOK); unsigned* slot_tok = (unsigned*)(ws + WS_SLOT); float* gate_tok = (float*)(ws + WS_GATE);
            for (int m = gw; m < T; m += NGW) {
                f32x4 v[8];
                ROW_LOAD(v, xbuf + (size_t)m * DM);
                const float rstd = row_rstd(v, lane);
#pragma unroll
                for (int j = 0; j < 8; ++j) { const f32x4 g = ((const GAS f32x4*)norm2_g)[lane + 64 * j];
                    v[j] = (f32x4){v[j].x * rstd * g.x, v[j].y * rstd * g.y, v[j].z * rstd * g.z, v[j].w * rstd * g.w};
                    v2u o; o.x = pk2(v[j].x, v[j].y); o.y = pk2(v[j].z, v[j].w);
                    ((GAS v2u*)(act + (size_t)m * DM))[lane + 64 * j] = o; }
                LAS f32x4* hrow = (LAS f32x4*)(lds + wave * 16384);
#pragma unroll
                for (int j = 0; j < 8; ++j) hrow[lane + 64 * j] = v[j];
                LDS_WAIT(); asm volatile("" ::: "memory");
                float lg[4], le[32];
#pragma unroll
                for (int i = 0; i < 4; ++i) lg[i] = 0.f;
#pragma unroll
                for (int i = 0; i < 32; ++i) le[i] = 0.f;
#pragma unroll 1
                for (int kk = 0; kk < 32; ++kk) { const int k = kk * 64 + lane; const float hv = ((const LAS float*)hrow)[k];
                    const f32x4 wgr = *(const GAS f32x4*)(wg + (size_t)k * 4);
                    lg[0] += hv * wgr.x; lg[1] += hv * wgr.y; lg[2] += hv * wgr.z; lg[3] += hv * wgr.w;
#pragma unroll
                    for (int q = 0; q < 8; ++q) { const f32x4 wr = *(const GAS f32x4*)(we + (size_t)k * 32 + 4 * q);
                        le[4 * q] += hv * wr.x; le[4 * q + 1] += hv * wr.y; le[4 * q + 2] += hv * wr.z; le[4 * q + 3] += hv * wr.w; } }
#pragma unroll
                for (int i = 0; i < 4; ++i) lg[i] = wave_sum(lg[i], lane);
#pragma unroll
                for (int i = 0; i < 32; ++i) le[i] = wave_sum(le[i], lane);
                LDS_WAIT(); asm volatile("" ::: "memory");
                int e1, e2; float g1, g2; route_select(lg, le, bg, be, e1, e2, g1, g2);
                if (lane == 0) {
                    const unsigned r1 = __hip_atomic_fetch_add(cnt_cur + 64 * e1, 1u, __ATOMIC_RELAXED, __HIP_MEMORY_SCOPE_AGENT);
                    const unsigned r2 = __hip_atomic_fetch_add(cnt_cur + 64 * e2, 1u, __ATOMIC_RELAXED, __HIP_MEMORY_SCOPE_AGENT);
                    tok_of[(size_t)e1 * T + r1] = m; tok_of[(size_t)e2 * T + r2] = m;
                    slot_tok[2 * m] = ((unsigned)e1 << 20) | r1; slot_tok[2 * m + 1] = ((unsigned)e2 << 20) | r2; gate_tok[2 * m] = g1; gate_tok[2 * m + 1] = g2;
                }
            }
        }
        SEAM(8);
        PH_ON(9) {
            PHASE_LOCALS();
            {
                bf16* Wgu = (bf16*)(ws + WS_WGU); bf16* WdT = (bf16*)(ws + WS_WD); LAS float* scr = (LAS float*)(lds + wave * 16384);
                const float* wg_ = (const float*)args.in[26] + (size_t)ll * NEXP * DM * DE; const float* wu_ = (const float*)args.in[27] + (size_t)ll * NEXP * DM * DE; const float* wd_ = (const float*)args.in[28] + (size_t)ll * NEXP * DE * DM;
                constexpr int I_GU = (DM / 64) * (DE / 32), I_D = (DE / 64) * (DM / 32);
                for (int it = gw; it < NEXP * (2 * I_GU + I_D); it += NGW) {
                    const int e = it / (2 * I_GU + I_D); int r = it - e * (2 * I_GU + I_D);
                    if (r < 2 * I_GU) { const int up = r >= I_GU ? 1 : 0; r -= up * I_GU; const int nblk = DE / 32, kb = r / nblk, nb = r % nblk, n0 = 32 * nb;
                        transpose_item((up ? wu_ : wg_) + (size_t)e * DM * DE, DM, DE, Wgu + (size_t)e * 1024 * DM, 64 * kb, n0, (n0 >> 7) * 256 + (n0 & 127) + up * 128, scr, lane); continue; }
                    r -= 2 * I_GU;
                    { const int nblk = DM / 32, kb = r / nblk, nb = r % nblk; transpose_item(wd_ + (size_t)e * DE * DM, DE, DM, WdT + (size_t)e * DM * DE, 64 * kb, 32 * nb, 32 * nb, scr, lane); }
                }
            }
            build_moe_tables(lds, (const unsigned*)(ws + WS_CTL) + CW_CNT + ll * 2048, tid);
            const LAS int* tcnt = (const LAS int*)(lds + TAB_CNT); const LAS int* trb = (const LAS int*)(lds + TAB_ROWBASE); const LAS int* texp = (const LAS int*)(lds + TAB_TEXP);
            const int nrows = ((const LAS int*)(lds + TAB_NT))[0] * 256;
            const int* tok_of = (const int*)(ws + WS_TOK); const bf16* act = (const bf16*)(ws + WS_ACT); bf16* aperm = (bf16*)(ws + WS_APERM);
            for (int R = gw; R < nrows; R += NGW) {
                const int e = texp[R >> 8], r = R - trb[e];
                GAS v4u* dst = (GAS v4u*)(aperm + (size_t)R * DM);
                if (r < tcnt[e]) { const int tok = tok_of[(size_t)e * T + r]; const GAS v4u* src = (const GAS v4u*)(act + (size_t)tok * DM);
#pragma unroll
                    for (int j = 0; j < 4; ++j) dst[lane + 64 * j] = src[lane + 64 * j]; }
                else {
#pragma unroll
                    for (int j = 0; j < 4; ++j) dst[lane + 64 * j] = (v4u){0u, 0u, 0u, 0u}; }
            }
        }
        SEAM(9);
        PH_ON(10) {
            PHASE_LOCALS();
            build_moe_tables(lds, (const unsigned*)(ws + WS_CTL) + CW_CNT + ll * 2048, tid);
            const int ntiles = __builtin_amdgcn_readfirstlane(((const LAS int*)(lds + TAB_NT))[0]);
            pg8::Gemm g{(const bf16*)(ws + WS_APERM), (const bf16*)(ws + WS_WGU), MOE_MAXTILES * 256, 1024, DM, (size_t)1024 * DM * 2};
            pg8::MoeOrder<4> S{G, bid, ntiles, (const LAS int*)(lds + TAB_TEXP)};
            pg8::EpiSwiGLU E{(bf16*)(ws + WS_HID), DE};
            pg8::gemm_phase<DM, pg8::EpiSwiGLU, pg8::MoeOrder<4>, true, true>(lds, g, S, E, tid);
        }
        SEAM(10);
        PH_ON(11) {
            PHASE_LOCALS();
            build_moe_tables(lds, (const unsigned*)(ws + WS_CTL) + CW_CNT + ll * 2048, tid);
            const int ntiles = __builtin_amdgcn_readfirstlane(((const LAS int*)(lds + TAB_NT))[0]);
            pg8::Gemm g{(const bf16*)(ws + WS_HID), (const bf16*)(ws + WS_WD), MOE_MAXTILES * 256, DM, DE, (size_t)DM * DE * 2};
            pg8::MoeOrder<8> S{G, bid, ntiles, (const LAS int*)(lds + TAB_TEXP)};
            pg8::EpiBf16 E{(bf16*)(ws + WS_YP), DM};
            pg8::gemm_phase<DE, pg8::EpiBf16, pg8::MoeOrder<8>, true, true>(lds, g, S, E, tid);
        }
        SEAM(11);
    }

template <int KSEL>
__global__ void __launch_bounds__(512, 2) fwd_kernel(Args args) {
    extern __shared__ __attribute__((aligned(16))) unsigned char lds_raw[];
    LAS unsigned char* lds = (LAS unsigned char*)lds_raw;
    if (threadIdx.x < 4) ((LAS unsigned*)(lds + MISC_OFF))[threadIdx.x] = 0u;
    __syncthreads();
    XcdBarrier bar; bar.bar = (unsigned*)(args.ws + WS_CTL) + CW_BAR; bar.x = 0; bar.st = nullptr;
    if constexpr (KSEL < 0) bar = xcd_barrier_post((unsigned*)(args.ws + WS_CTL) + CW_BAR, (volatile LAS unsigned*)(lds + MISC_OFF));
    if constexpr (KSEL < 0) { layer_program<KSEL>(args, lds, bar, 0); layer_program<KSEL>(args, lds, bar, 1); }
    else if constexpr (KSEL != 12) layer_program<KSEL>(args, lds, bar, args.layer);
    PH_ON(12) {
        const int l = DEPTH - 1;
        PHASE_LOCALS();
        build_moe_tables(lds, (const unsigned*)(ws + WS_CTL) + CW_CNT + ll * 2048, tid);
        const LAS int* trb = (const LAS int*)(lds + TAB_ROWBASE);
        const float* gfin = (const float*)args.in[29]; const float* xbuf = (const float*)(ws + WS_X); const bf16* yp = (const bf16*)(ws + WS_YP);
        const unsigned* slot_tok = (const unsigned*)(ws + WS_SLOT); const float* gate_tok = (const float*)(ws + WS_GATE);
        for (int m = gw; m < T; m += NGW) {
            f32x4 v[8];
            ROW_LOAD(v, xbuf + (size_t)m * DM);
            const unsigned s1 = slot_tok[2 * m], s2 = slot_tok[2 * m + 1]; const float g1 = gate_tok[2 * m], g2 = gate_tok[2 * m + 1];
            row_add_moe(v, yp, (size_t)(trb[s1 >> 20] + (int)(s1 & 0xfffffu)), (size_t)(trb[s2 >> 20] + (int)(s2 & 0xfffffu)), g1, g2, lane);
            const float rstd = row_rstd(v, lane);
#pragma unroll
            for (int j = 0; j < 8; ++j) { const f32x4 g = ((const GAS f32x4*)gfin)[lane + 64 * j];
                ((GAS f32x4*)(args.out + (size_t)m * DM))[lane + 64 * j] = (f32x4){v[j].x * rstd * g.x, v[j].y * rstd * g.y, v[j].z * rstd * g.z, v[j].w * rstd * g.w}; }
        }
    }
#undef SEAM
#undef PH_ON
}

extern "C" void kernel_launch(void* const* d_in, const int* in_sizes, int n_in, void* d_out, int out_size, void* d_ws, size_t ws_size, hipStream_t stream) {
    static int grid = 0;
    if (grid == 0) {
        if (n_in != 30 || in_sizes[0] != T * DM || out_size != T * DM || ws_size < WS_END) { fprintf(stderr, "kernel_launch: unexpected shapes (n_in %d, in0 %d, out %d, ws %zu < %zu)\n", n_in, n_in > 0 ? in_sizes[0] : -1, out_size, ws_size, (size_t)WS_END); grid = -1; return; }
        int dev = 0, cus = 0, per_cu = 0; (void)per_cu;
        if (hipGetDevice(&dev) != hipSuccess || hipDeviceGetAttribute(&cus, hipDeviceAttributeMultiprocessorCount, dev) != hipSuccess) { grid = -1; return; }
#if KB_SPLIT
#define SET_ATTR(k) if (hipFuncSetAttribute((const void*)fwd_kernel<k>, hipFuncAttributeMaxDynamicSharedMemorySize, LDS_BYTES) != hipSuccess) { fprintf(stderr, "kernel_launch: hipFuncSetAttribute failed (%d)\n", k); grid = -1; return; }
        SET_ATTR(0) SET_ATTR(1) SET_ATTR(2) SET_ATTR(3) SET_ATTR(4) SET_ATTR(5) SET_ATTR(6) SET_ATTR(7) SET_ATTR(8) SET_ATTR(9) SET_ATTR(10) SET_ATTR(11) SET_ATTR(12) SET_ATTR(13)
#else
        if (hipFuncSetAttribute((const void*)fwd_kernel<-1>, hipFuncAttributeMaxDynamicSharedMemorySize, LDS_BYTES) != hipSuccess) { fprintf(stderr, "kernel_launch: hipFuncSetAttribute failed\n"); grid = -1; return; }
        if (hipOccupancyMaxActiveBlocksPerMultiprocessor(&per_cu, (const void*)fwd_kernel<-1>, 512, LDS_BYTES) != hipSuccess || per_cu < 1) fprintf(stderr, "kernel_launch: occupancy query says %d\n", per_cu);
#endif
        (void)hipGetLastError();
        grid = cus;
    }
    if (grid < 0) return;
    if (hipMemsetAsync((char*)d_ws + WS_CTL, 0, CTL_ZERO_BYTES, stream) != hipSuccess) return;
    Args a{};
    for (int i = 0; i < 30; ++i) a.in[i] = d_in[i];
    a.out = (float*)d_out; a.ws = (unsigned char*)d_ws; a.layer = 0; a.pad = 0;
#if KB_SPLIT
#define LAUNCH_PH(k) hipLaunchKernelGGL(fwd_kernel<k>, dim3(grid), dim3(512), LDS_BYTES, stream, a)
    for (int l = 0; l < DEPTH; ++l) { a.layer = l;
        LAUNCH_PH(0); LAUNCH_PH(1); LAUNCH_PH(2); LAUNCH_PH(3); LAUNCH_PH(4); LAUNCH_PH(5); LAUNCH_PH(13); LAUNCH_PH(6); LAUNCH_PH(7); LAUNCH_PH(8); LAUNCH_PH(9); LAUNCH_PH(10); LAUNCH_PH(11); }
    a.layer = DEPTH - 1; LAUNCH_PH(12);
#else
    hipLaunchKernelGGL(fwd_kernel<-1>, dim3(grid), dim3(512), LDS_BYTES, stream, a);
#endif
}
#endif
```

```cpp
#ifndef KB_EMU
#include <hip/hip_runtime.h>
#endif
#include <cstdio>
#include <cstdint>
#include <cmath>

#ifndef KB_BATCH
#define KB_BATCH 4
#define KB_SEQ 4096
#endif
#ifndef KB_SPLIT
#define KB_SPLIT 0
#endif

#ifndef KB_PHMASK
#define KB_PHMASK 0xffff
#endif
#define KB_EN(k) (((KB_PHMASK) >> (k)) & 1)
#ifndef KB_TPROBE
#define KB_TPROBE -1
#endif
#ifndef KB_TPROBE_END
#define KB_TPROBE_END (KB_TPROBE + 1)
#endif
#define HD __host__ __device__ __forceinline__
typedef unsigned short bf16;

constexpr int BATCH = KB_BATCH, SEQ = KB_SEQ, T = BATCH * SEQ;
constexpr int DM = 2048, DG = 512, NH = 8, HDIM = 64;
constexpr int A_COLS = 2048, B_COLS = 1984, C_COLS = 1024, D_COLS = 1536, D_IN = 6592, NPROJ = 6656;
constexpr int OFF_A = 0, OFF_B = 2048, OFF_C = 4032, OFF_D_SRC = 5056  , OFF_D = 5120  ;
static_assert(OFF_D % 256 == 0 && OFF_D + D_COLS == NPROJ && OFF_D - OFF_D_SRC == NPROJ - D_IN, "proj layout");
constexpr int NC = SEQ / 128;
constexpr int NEXP = 32, DE = 512;
constexpr int NLORA = 448;
constexpr float NORM_EPS = 1e-6f, GN_EPS = 64e-5f;
constexpr int MOE_MAXTILES = (2 * T + NEXP * 255 + 255) / 256;
constexpr int DEPTH = 2;

constexpr size_t MiB = 1u << 20;
constexpr size_t WS_CTL = 0, CTL_ZERO_BYTES = 1 * MiB;
constexpr size_t WS_WIN = 2 * MiB, WS_WOUT = 28 * MiB;
constexpr size_t WS_WD = 292 * MiB;
__host__ __device__ constexpr size_t wgu_off(int e) { return e < 16 ? (804 + 4 * (size_t)e) * MiB : e < 22 ? (780 + 4 * (size_t)(e - 16)) * MiB : e < 25 ? (868 + 4 * (size_t)(e - 22)) * MiB : (914 + 4 * (size_t)(e - 25)) * MiB; }
constexpr int GEMM1_G = 238;
constexpr size_t WS_X = 228 * MiB;
constexpr size_t WS_ACT = 356 * MiB;
constexpr size_t WS_PROJ = 420 * MiB;
constexpr size_t WS_RKV = 628 * MiB, WS_RSP = 660 * MiB;
constexpr size_t WS_RS = 692 * MiB, WS_KS = 708 * MiB, WS_VS = 724 * MiB, WS_KK = 740 * MiB, WS_GG = 756 * MiB, WS_KDF = 772 * MiB, WS_KDB = 788 * MiB,
                 WS_AKF = 804 * MiB, WS_AKB = 820 * MiB, WS_YF = 836 * MiB, WS_YB = 852 * MiB, WS_LIN = 868 * MiB  , WS_WF = 882 * MiB, WS_WB = 914 * MiB;
constexpr size_t WS_TOK = 946 * MiB  , WS_SLOT = 948 * MiB, WS_GATE = 949 * MiB;
constexpr size_t WS_RB = 36 * MiB  , WS_PT = 68 * MiB  , WS_QF = 132 * MiB  , WS_YL = 196 * MiB  , WS_DC = 1002 * MiB  ;
constexpr size_t WS_DPO = 950 * MiB  , WS_DML = 998 * MiB  , WS_ROT = 1004 * MiB  , WS_ST = 882 * MiB  , WS_RWT = 1010 * MiB  , WS_END = 1011 * MiB;
constexpr size_t WS_APERM = 420 * MiB, WS_HID = 580 * MiB, WS_YP = 620 * MiB;
static_assert((size_t)MOE_MAXTILES * 256 * 2048 * 2 <= 160 * MiB && (size_t)T * NPROJ * 2 <= 208 * MiB, "ws map");
constexpr int CW_BAR = 4096;
constexpr int CW_CNT = 16384;

HD float bf2f(bf16 v) { return __builtin_bit_cast(float, (unsigned)v << 16); }
HD bf16 f2bf(float f) { unsigned u = __builtin_bit_cast(unsigned, f); return (bf16)((u + 0x7fffu + ((u >> 16) & 1u)) >> 16); }
HD float sigmoidf_(float x) { return 1.f / (1.f + expf(-x)); }
HD float siluf_(float x) { return x / (1.f + expf(-x)); }
HD float geluf_(float x) { return 0.5f * x * (1.f + tanhf(0.7978845608028654f * (x + 0.044715f * x * x * x))); }
HD float logsigmoidf_(float x) { return x < 0.f ? x - log1pf(expf(x)) : -log1pf(expf(-x)); }

struct Ctx {
    const int* pos;
    const float *gam, *ret_g, *mu, *w0, *w2, *a0, *a2, *g2, *k_k, *k_a, *r_k, *ln_g, *sgu_g, *sgu_b, *sgu_w, *sgu_bias;
    bf16 *proj, *ycat, *rs, *ks, *vs, *kk, *gg, *kdf, *kdb, *akf, *akb, *yf, *yb, *lin;
    float *wf, *wb, *rkv, *rsp;
};

HD void el_rot_ret(const Ctx& c, long idx) {
    const int i = (int)(idx & 31), h = (int)((idx >> 5) & 7); const long t = idx >> 8;
    const float inv = expf(-(float)i * (1.f / 32.f) * 9.210340371976184f);
    const float ang = (float)c.pos[t] * inv; float sn, cs; sincosf(ang, &sn, &cs);
    bf16* q = c.proj + (size_t)t * NPROJ + OFF_A + h * 64; bf16* k = q + 512;
    const float q1 = bf2f(q[i]), q2 = bf2f(q[i + 32]), k1 = bf2f(k[i]), k2 = bf2f(k[i + 32]);
    q[i] = f2bf(q1 * cs - q2 * sn); q[i + 32] = f2bf(q2 * cs + q1 * sn);
    k[i] = f2bf((k1 * cs - k2 * sn) * 0.125f); k[i + 32] = f2bf((k2 * cs + k1 * sn) * 0.125f);
}
HD void el_rot_dil(const Ctx& c, long idx) {
    const int j = (int)(idx & 31), h = (int)((idx >> 5) & 7); const long t = idx >> 8;
    bf16* q = c.proj + (size_t)t * NPROJ + OFF_D + h * 64; bf16* k = q + 512;
    if (j < 8) {
        const float inv = expf(-(float)j * (1.f / 8.f) * 13.122363377404328f);
        const float ang = (float)c.pos[t] * inv; float sn, cs; sincosf(ang, &sn, &cs);
        const float q1 = bf2f(q[j]), q2 = bf2f(q[j + 8]), k1 = bf2f(k[j]), k2 = bf2f(k[j + 8]);
        q[j] = f2bf((q1 * cs - q2 * sn) * 0.125f); q[j + 8] = f2bf((q2 * cs + q1 * sn) * 0.125f);
        k[j] = f2bf(k1 * cs - k2 * sn); k[j + 8] = f2bf(k2 * cs + k1 * sn);
    } else {
        const int d = 16 + 2 * (j - 8);
        q[d] = f2bf(bf2f(q[d]) * 0.125f); q[d + 1] = f2bf(bf2f(q[d + 1]) * 0.125f);
    }
}
HD void el_rwkv_shift(const Ctx& c, long idx) {
    const int j = (int)(idx % B_COLS); const long t = idx / B_COLS; const int s = (int)(t % SEQ);
    const bf16* p = c.proj + (size_t)t * NPROJ + OFF_B + j;
    const float x = bf2f(p[0]), xp = s > 0 ? bf2f(p[-(long)NPROJ]) : 0.f, xn = s < SEQ - 1 ? bf2f(p[NPROJ]) : 0.f;
    const float xs = x + c.mu[j] * (xp - x) + c.mu[B_COLS + j] * (xn - x);
    if (j < 512) c.rs[t * 512 + j] = f2bf(xs);
    else if (j < 1024) c.ks[t * 512 + j - 512] = f2bf(xs);
    else if (j < 1536) c.vs[t * 512 + j - 1024] = f2bf(xs);
    else if (j < 1632) c.lin[t * NLORA + (j - 1536)] = f2bf(tanhf(xs));
    else if (j < 1728) c.lin[t * NLORA + (j - 1536)] = f2bf(xs);
    else c.lin[t * NLORA + (j - 1536)] = f2bf(sigmoidf_(xs));
}
HD void el_rwkv_lora(const Ctx& c, long idx) {
    const int ch = (int)(idx & 511); const long t = idx >> 9;
    const bf16* li = c.lin + t * NLORA;
    float wl = 0.f, al = 0.f, g = 0.f;
    for (int i = 0; i < 96; ++i) { wl += bf2f(li[i]) * c.w2[i * 512 + ch]; al += bf2f(li[96 + i]) * c.a2[i * 512 + ch]; }
    for (int i = 0; i < 256; ++i) g += bf2f(li[192 + i]) * c.g2[i * 512 + ch];
    c.gg[t * 512 + ch] = f2bf(g);
    const float k = bf2f(c.ks[t * 512 + ch]), ka = c.k_a[ch];
    c.kk[t * 512 + ch] = f2bf(k * c.k_k[ch]);
    {   const float dec = -0.6065306597126334f * sigmoidf_(c.w0[ch] + wl); const float a = sigmoidf_(c.a0[ch] + al);
        c.wf[t * 512 + ch] = dec; c.kdf[t * 512 + ch] = f2bf(k * (1.f + (a - 1.f) * ka)); c.akf[t * 512 + ch] = f2bf(a); }
    {   const float dec = -0.6065306597126334f * sigmoidf_(c.w0[512 + ch] + wl); const float a = sigmoidf_(c.a0[512 + ch] + al);
        c.wb[t * 512 + ch] = dec; c.kdb[t * 512 + ch] = f2bf(k * (1.f + (a - 1.f) * ka)); c.akb[t * 512 + ch] = f2bf(a); }
}
HD void el_rwkv_kk(const Ctx& c, long idx) {
    const int h = (int)(idx & 7); const long t = idx >> 3; const size_t o = (size_t)t * 512 + h * 64;
    float ss = 0.f;
    for (int d = 0; d < 64; ++d) { const float v = bf2f(c.kk[o + d]); ss += v * v; }
    const float n = 1.f / sqrtf(ss + 1e-12f);
    for (int d = 0; d < 64; ++d) { const float v = bf2f(c.kk[o + d]) * n; c.kk[o + d] = f2bf(v);
        c.akf[o + d] = f2bf(bf2f(c.akf[o + d]) * v); c.akb[o + d] = f2bf(bf2f(c.akb[o + d]) * v); }
}
HD void el_sgu_prep(const Ctx& c, long t) {
    bf16* v = c.proj + (size_t)t * NPROJ + OFF_C + 512;
    float s = 0.f;
    for (int j = 0; j < 512; ++j) s += geluf_(bf2f(v[j]));
    const float mean = s * (1.f / 512.f); float q = 0.f;
    for (int j = 0; j < 512; ++j) { const float d = geluf_(bf2f(v[j])) - mean; q += d * d; }
    const float rstd = 1.f / sqrtf(q * (1.f / 512.f) + NORM_EPS);
    for (int j = 0; j < 512; ++j) v[j] = f2bf((geluf_(bf2f(v[j])) - mean) * rstd * c.sgu_g[j] + c.sgu_b[j]);
}

HD void el_ret_kv(const Ctx& c, long idx) {
    const int e = (int)(idx & 63), d = (int)((idx >> 6) & 63); long r = idx >> 12;
    const int ch = (int)(r % NC); r /= NC; const int dir = (int)(r & 1); r >>= 1; const int h = (int)(r & 7); const int b = (int)(r >> 3);
    const float lg = logsigmoidf_(c.gam[dir * 8 + h]);
    const bf16* base = c.proj + ((size_t)b * SEQ + (size_t)ch * 128) * NPROJ + OFF_A + h * 64;
    float kv = 0.f;
    for (int m = 0; m < 128; ++m) { const float dec = expf(lg * (float)(dir == 0 ? 127 - m : m));
        kv += dec * bf2f(base[(size_t)m * NPROJ + 512 + d]) * bf2f(base[(size_t)m * NPROJ + 1024 + e]); }
    c.rkv[idx] = kv;
}
HD void el_dil_attn(const Ctx& c, long idx) {
    const int h = (int)(idx & 7); const long t = idx >> 3; const int s = (int)(t % SEQ); const long tb = t - s;
    const bf16* qp = c.proj + (size_t)t * NPROJ + OFF_D + h * 64;
    float o[64];
#pragma unroll
    for (int i = 0; i < 64; ++i) o[i] = 0.f;
    float m = -1e30f, l = 0.f;
    for (int br = 0; br < 3; ++br) {
        const int dil = br == 0 ? 1 : (br == 1 ? 4 : 16);
        for (int j = -64; j <= 64; ++j) {
            const int sp = s + dil * j; if (sp < 0 || sp >= SEQ) continue;
            asm volatile("" ::: "memory");
            const bf16* kp = c.proj + (size_t)(tb + sp) * NPROJ + OFF_D + 512 + h * 64; const bf16* vp = kp + 512;
            float sc = 0.f;
#pragma unroll
            for (int i = 0; i < 64; ++i) sc += bf2f(qp[i]) * bf2f(kp[i]);
            const float mn = sc > m ? sc : m, scale = expf(m - mn), p = expf(sc - mn);
            l = l * scale + p; m = mn;
#pragma unroll
            for (int i = 0; i < 64; ++i) o[i] = o[i] * scale + p * bf2f(vp[i]);
        }
    }
    const float il = 1.f / l; bf16* y = c.ycat + (size_t)t * 2048 + 1536 + h * 64;
#pragma unroll
    for (int i = 0; i < 64; ++i) y[i] = f2bf(o[i] * il);
}
HD void el_dil_combine(const bf16* dpo, const float* dml, bf16* ycat, long idx) {
    const int h = (int)(idx & 7); const long t = idx >> 3;
    float m[3], l[3];
#pragma unroll
    for (int br = 0; br < 3; ++br) { const float* mp = dml + (((size_t)br * T + t) * 8 + h) * 2; m[br] = mp[0]; l[br] = mp[1]; }
    const float M = fmaxf(m[0], fmaxf(m[1], m[2]));
    float wgt[3], den = 0.f;
#pragma unroll
    for (int br = 0; br < 3; ++br) { wgt[br] = expf(m[br] - M) * l[br]; den += wgt[br]; }
    const float inv = 1.f / den;
    bf16* y = ycat + (size_t)t * 2048 + 1536 + h * 64;
    for (int i = 0; i < 64; ++i) { float a = 0.f;
#pragma unroll
        for (int br = 0; br < 3; ++br) a += wgt[br] * bf2f(dpo[((size_t)br * T + t) * 512 + h * 64 + i]);
        y[i] = f2bf(a * inv); }
}
HD void el_sgu_main(const Ctx& c, long idx) {
    const int j = (int)(idx & 511); const long t = idx >> 9; const int s = (int)(t % SEQ), p = s & 127, g = j >> 6; const long t0 = t - p;
    const float* w = c.sgu_w + ((size_t)g * 128 + p) * 128;
    const bf16* v = c.proj + (size_t)t0 * NPROJ + OFF_C + 512 + j;
    float acc = 0.f;
    for (int q = 0; q < 128; ++q) acc += w[q] * bf2f(v[(size_t)q * NPROJ]);
    const float u = geluf_(bf2f(c.proj[(size_t)t * NPROJ + OFF_C + j]));
    c.ycat[(size_t)t * 2048 + 1024 + j] = f2bf(u * (acc + c.sgu_bias[g * 128 + p]));
}
HD void el_ret_scan(const Ctx& c, long idx) {
    const int de = (int)(idx & 4095); const long r = idx >> 12; const int dir = (int)(r & 1), h = (int)((r >> 1) & 7);
    const float cd = expf(128.f * logsigmoidf_(c.gam[dir * 8 + h]));
    float kv[NC];
#pragma unroll
    for (int k = 0; k < NC; ++k) { const int ch = dir == 0 ? k : NC - 1 - k; kv[k] = c.rkv[((size_t)r * NC + ch) * 4096 + de]; }
    float S = 0.f;
#pragma unroll
    for (int k = 0; k < NC; ++k) { const int ch = dir == 0 ? k : NC - 1 - k; c.rsp[((size_t)r * NC + ch) * 4096 + de] = S; S = S * cd + kv[k]; }
}
HD void el_rwkv_scan(const Ctx& c, long idx) {
    const int row = (int)(idx & 63); const long r = idx >> 6; const int dir = (int)(r & 1), h = (int)((r >> 1) & 7), b = (int)(r >> 4);
    const float* W = dir ? c.wb : c.wf; const bf16* KD = dir ? c.kdb : c.kdf; const bf16* AK = dir ? c.akb : c.akf; bf16* Y = dir ? c.yb : c.yf;
    float S[64];
#pragma unroll
    for (int i = 0; i < 64; ++i) S[i] = 0.f;
    for (int k = 0; k < SEQ; ++k) {
        asm volatile("" ::: "memory");
        const int s = dir ? SEQ - 1 - k : k; const size_t o = ((size_t)b * SEQ + s) * 512 + h * 64;
        float sk = 0.f;
#pragma unroll
        for (int q = 0; q < 4; ++q) { asm volatile("" ::: "memory");
#pragma unroll
            for (int i = 16 * q; i < 16 * q + 16; ++i) sk += S[i] * bf2f(c.kk[o + i]); }
        const float v = bf2f(c.vs[o + row]); float y = 0.f;
#pragma unroll
        for (int q = 0; q < 4; ++q) { asm volatile("" ::: "memory");
#pragma unroll
            for (int i = 16 * q; i < 16 * q + 16; ++i) { S[i] = S[i] * expf(W[o + i]) - sk * bf2f(AK[o + i]) + v * bf2f(KD[o + i]); y += S[i] * bf2f(c.rs[o + i]); } }
        Y[o + row] = f2bf(y);
    }
}
HD void el_ret_out(const Ctx& c, long idx) {
    const int h = (int)(idx & 7); const long t = idx >> 3; const int s = (int)(t % SEQ), n = s & 127, ch = s >> 7; const int b = (int)(t / SEQ);
    const float lgf = logsigmoidf_(c.gam[h]), lgb = logsigmoidf_(c.gam[8 + h]);
    const bf16* qp = c.proj + (size_t)t * NPROJ + OFF_A + h * 64;
    float o[64];
#pragma unroll
    for (int i = 0; i < 64; ++i) o[i] = 0.f;
    const bf16* kb = c.proj + (size_t)(t - n) * NPROJ + OFF_A + 512 + h * 64;
    for (int m = 0; m < 128; ++m) {
        asm volatile("" ::: "memory");
        const bf16* kp = kb + (size_t)m * NPROJ; const bf16* vp = kp + 512;
        float sc = 0.f;
#pragma unroll
        for (int i = 0; i < 64; ++i) sc += bf2f(qp[i]) * bf2f(kp[i]);
        sc *= m <= n ? expf(lgf * (float)(n - m)) : expf(lgb * (float)(m - n));
#pragma unroll
        for (int i = 0; i < 64; ++i) o[i] += sc * bf2f(vp[i]);
    }
    const float qdf = expf(lgf * (float)(n + 1)), qdb = expf(lgb * (float)(128 - n));
    const float* Sf = c.rsp + ((size_t)((b * 8 + h) * 2 + 0) * NC + ch) * 4096; const float* Sb = c.rsp + ((size_t)((b * 8 + h) * 2 + 1) * NC + ch) * 4096;
    for (int d = 0; d < 64; ++d) { asm volatile("" ::: "memory"); const float qd = bf2f(qp[d]); const float a = qd * qdf, bb = qd * qdb;
#pragma unroll
        for (int i = 0; i < 64; ++i) o[i] += a * Sf[d * 64 + i] + bb * Sb[d * 64 + i]; }
    float mu = 0.f;
#pragma unroll
    for (int i = 0; i < 64; ++i) mu += o[i];
    mu *= (1.f / 64.f); float var = 0.f;
#pragma unroll
    for (int i = 0; i < 64; ++i) { const float d = o[i] - mu; var += d * d; }
    const float rstd = 1.f / sqrtf(var * (1.f / 64.f) + GN_EPS);
    const bf16* gp = c.proj + (size_t)t * NPROJ + OFF_A + 1536 + h * 64; bf16* y = c.ycat + (size_t)t * 2048 + h * 64;
    for (int i = 0; i < 64; i += 8) { asm volatile("" ::: "memory");
#pragma unroll
        for (int j = 0; j < 8; ++j) y[i + j] = f2bf(siluf_(bf2f(gp[i + j])) * ((o[i + j] - mu) * rstd * c.ret_g[h * 64 + i + j])); }
}
HD void el_rwkv_fin(const Ctx& c, long idx) {
    const int h = (int)(idx & 7); const long t = idx >> 3; const size_t o = (size_t)t * 512 + h * 64;
    float mu = 0.f, bonus = 0.f;
    for (int i = 0; i < 64; ++i) { mu += bf2f(c.yf[o + i]) + bf2f(c.yb[o + i]); bonus += bf2f(c.rs[o + i]) * bf2f(c.ks[o + i]) * c.r_k[h * 64 + i]; }
    mu *= (1.f / 64.f); float var = 0.f;
    for (int i = 0; i < 64; ++i) { const float d = bf2f(c.yf[o + i]) + bf2f(c.yb[o + i]) - mu; var += d * d; }
    const float rstd = 1.f / sqrtf(var * (1.f / 64.f) + GN_EPS);
    bf16* out = c.ycat + (size_t)t * 2048 + 512 + h * 64;
    for (int i = 0; i < 64; ++i) { const float y = bf2f(c.yf[o + i]) + bf2f(c.yb[o + i]);
        out[i] = f2bf(((y - mu) * rstd * c.ln_g[h * 64 + i] + bonus * bf2f(c.vs[o + i])) * bf2f(c.gg[o + i])); }
}
HD void route_select(const float (&lg)[4], const float (&le)[32], const float* bg, const float* be, int& e1, int& e2, float& g1, float& g2) {
    float l[4]; float mx = -1e30f; int gi = 0;
#pragma unroll
    for (int i = 0; i < 4; ++i) { l[i] = lg[i] + bg[i]; if (l[i] > mx) { mx = l[i]; gi = i; } }
    float den = 0.f;
#pragma unroll
    for (int i = 0; i < 4; ++i) den += expf(l[i] - mx);
    const float gtop = 1.f / den;
    float el[8];
#pragma unroll
    for (int i = 0; i < 8; ++i) { float v = 0.f;
#pragma unroll
        for (int g = 0; g < 4; ++g) v = (g == gi) ? le[g * 8 + i] + be[g * 8 + i] : v;
        el[i] = v; }
    float m1 = -1e30f, m2 = -1e30f; int i1 = 0, i2 = 0;
#pragma unroll
    for (int i = 0; i < 8; ++i) { if (el[i] > m1) { m2 = m1; i2 = i1; m1 = el[i]; i1 = i; } else if (el[i] > m2) { m2 = el[i]; i2 = i; } }
    const float p2 = expf(m2 - m1);
    g1 = gtop / (1.f + p2); g2 = gtop * p2 / (1.f + p2); e1 = gi * 8 + i1; e2 = gi * 8 + i2;
}

#ifndef KB_HOST_ONLY
namespace pg8 {
#define PG8_LAS __attribute__((address_space(3)))
typedef unsigned short bf16_t;
typedef short bf16x8 __attribute__((ext_vector_type(8)));
typedef float f32x4 __attribute__((ext_vector_type(4)));
typedef unsigned u32x4 __attribute__((ext_vector_type(4)));
constexpr int BM = 256, BK = 64, HALF = 128, HTB = HALF * BK * 2, STAGE_BYTES = 8 * HTB, NXCD = 8, WGM = 8;
__host__ __device__ __forceinline__ int lds_byte(int r, int c) { const int st = (r >> 4) * 2 + (c >> 5), rr = r & 15, cc = c & 31, ob = rr * 64 + cc * 2; return st * 1024 + (ob ^ (((ob >> 9) & 1) << 5)); }
__host__ __device__ __forceinline__ void stage_rc(int b, int& R, int& C) { const int st = b / 1024, sb = b % 1024, swz = sb ^ (((sb >> 9) & 1) << 5); R = (st >> 1) * 16 + swz / 64; C = (st & 1) * 32 + (swz % 64) / 2; }
__host__ __device__ __forceinline__ int perm32(int rho) { const int n = rho >> 4, i = rho & 15; return 8 * (i >> 2) + 4 * n + (i & 3); }
struct Unit { int pm, pn, pe; };
struct Gemm { const bf16_t* A; const bf16_t* Bt; int M, N, K; size_t bstride; int bmap; };
template <int M, int N> struct StaticOrder {
    static constexpr int nM = M / BM, nN = N / BM, nwg = nM * nN;
    int G, c;
    __host__ __device__ void init(int G_, int c_) { G = G_; c = c_; }
    __host__ __device__ __forceinline__ bool next(int i, Unit& u) const {
        const int L = i * G + c; if (L >= nwg) return false;
        int wgid = L; { constexpr int q = nwg / NXCD, r = nwg % NXCD; const int xcd = wgid % NXCD, off = wgid / NXCD; wgid = (xcd < r ? xcd * (q + 1) : r * (q + 1) + (xcd - r) * q) + off; }
        constexpr int nig = WGM * nN; const int gid = wgid / nig, fm = gid * WGM, gsz = (nM - fm) < WGM ? (nM - fm) : WGM;
        u.pm = fm + ((wgid % nig) % gsz); u.pn = (wgid % nig) / gsz; u.pe = 0; return true;
    }
    __device__ __forceinline__ void a_ready(const Unit&) const {}
    __device__ __forceinline__ void done(const Unit&) const {}
};
template <int NN> struct MoeOrder {
    int G, c, ntiles; const PG8_LAS int* tile_exp;
    __device__ __forceinline__ bool next(int i, Unit& u) const {
        const int L = i * G + c; if (L >= ntiles * NN) return false;
        u.pm = L / NN; u.pn = L % NN; u.pe = __builtin_amdgcn_readfirstlane(tile_exp[u.pm]); return true;
    }
    __device__ __forceinline__ void a_ready(const Unit&) const {}
    __device__ __forceinline__ void done(const Unit&) const {}
};
__device__ __forceinline__ unsigned cvt_pk_bf16(float lo, float hi) { unsigned r; asm volatile("v_cvt_pk_bf16_f32 %0, %1, %2" : "=v"(r) : "v"(lo), "v"(hi)); return r; }
struct EpiBf16 {
    static constexpr bool PERM = true, AFTER_DRAIN = false;
    bf16_t* O; int ldc;
    __device__ __forceinline__ void operator()(const f32x4 (&acc)[2][2][4][2], const Unit& u, int wr, int wc, int fr, int fq) const {
        const int row0 = u.pm * BM + wr * 64 + fr, col0 = u.pn * BM + wc * 32 + 8 * fq;
#pragma unroll
        for (int ai = 0; ai < 2; ++ai)
#pragma unroll
            for (int m = 0; m < 4; ++m) { bf16_t* rowp = O + (size_t)(row0 + ai * HALF + m * 16) * ldc + col0;
#pragma unroll
                for (int bj = 0; bj < 2; ++bj) { const f32x4 v0 = acc[ai][bj][m][0], v1 = acc[ai][bj][m][1];
                    u32x4 w; w.x = cvt_pk_bf16(v0[0], v0[1]); w.y = cvt_pk_bf16(v0[2], v0[3]); w.z = cvt_pk_bf16(v1[0], v1[1]); w.w = cvt_pk_bf16(v1[2], v1[3]);
                    *(u32x4*)(rowp + bj * HALF) = w; } }
    }
};
struct EpiBf16Rot {
    static constexpr bool PERM = true, AFTER_DRAIN = false;
    bf16_t* O; int ldc; const float* rot;
    __device__ __forceinline__ void operator()(const f32x4 (&acc)[2][2][4][2], const Unit& u, int wr, int wc, int fr, int fq) const {
        const int row0 = u.pm * BM + wr * 64 + fr, col0 = u.pn * BM + wc * 32 + 8 * fq;
        const bool retT = u.pn < (OFF_A + 1024) / BM, dilT = u.pn >= OFF_D / BM && u.pn < (OFF_D + 1024) / BM;
        const int p = col0 & 63; const bool on = retT || (dilT && p < 16); const int f0 = (retT ? 0 : 32) + (p >> 1);
#pragma unroll
        for (int ai = 0; ai < 2; ++ai)
#pragma unroll
            for (int m = 0; m < 4; ++m) { const int row = row0 + ai * HALF + m * 16; bf16_t* rowp = O + (size_t)row * ldc + col0;
                f32x4 c0 = (f32x4){1.f, 0.f, 1.f, 0.f}, c1 = c0;
                if (on) { const float* rp = rot + ((size_t)row * 40 + f0) * 2; c0 = *(const f32x4*)rp; c1 = *(const f32x4*)(rp + 4); }
#pragma unroll
                for (int bj = 0; bj < 2; ++bj) { const f32x4 v0 = acc[ai][bj][m][0], v1 = acc[ai][bj][m][1];
                    u32x4 w; w.x = cvt_pk_bf16(v0[0] * c0[0] - v0[1] * c0[1], v0[1] * c0[0] + v0[0] * c0[1]); w.y = cvt_pk_bf16(v0[2] * c0[2] - v0[3] * c0[3], v0[3] * c0[2] + v0[2] * c0[3]);
                    w.z = cvt_pk_bf16(v1[0] * c1[0] - v1[1] * c1[1], v1[1] * c1[0] + v1[0] * c1[1]); w.w = cvt_pk_bf16(v1[2] * c1[2] - v1[3] * c1[3], v1[3] * c1[2] + v1[2] * c1[3]);
                    *(u32x4*)(rowp + bj * HALF) = w; } }
    }
};
struct EpiResB {
    static constexpr bool PERM = true, AFTER_DRAIN = false;
    const float* base32; const bf16_t* base16; bf16_t* out; int ldc;
    __device__ __forceinline__ void operator()(const f32x4 (&acc)[2][2][4][2], const Unit& u, int wr, int wc, int fr, int fq) const {
        const int row0 = u.pm * BM + wr * 64 + fr, col0 = u.pn * BM + wc * 32 + 8 * fq;
#pragma unroll
        for (int ai = 0; ai < 2; ++ai)
#pragma unroll
            for (int m = 0; m < 4; ++m) { const size_t off = (size_t)(row0 + ai * HALF + m * 16) * ldc + col0;
#pragma unroll
                for (int bj = 0; bj < 2; ++bj) { f32x4 v0 = acc[ai][bj][m][0], v1 = acc[ai][bj][m][1];
                    if (base32) { v0 += *(const f32x4*)(base32 + off + bj * HALF); v1 += *(const f32x4*)(base32 + off + bj * HALF + 4); }
                    else { const u32x4 b = *(const u32x4*)(base16 + off + bj * HALF);
                        v0[0] += __builtin_bit_cast(float, b.x << 16); v0[1] += __builtin_bit_cast(float, b.x & 0xffff0000u); v0[2] += __builtin_bit_cast(float, b.y << 16); v0[3] += __builtin_bit_cast(float, b.y & 0xffff0000u);
                        v1[0] += __builtin_bit_cast(float, b.z << 16); v1[1] += __builtin_bit_cast(float, b.z & 0xffff0000u); v1[2] += __builtin_bit_cast(float, b.w << 16); v1[3] += __builtin_bit_cast(float, b.w & 0xffff0000u); }
                    u32x4 w; w.x = cvt_pk_bf16(v0[0], v0[1]); w.y = cvt_pk_bf16(v0[2], v0[3]); w.z = cvt_pk_bf16(v1[0], v1[1]); w.w = cvt_pk_bf16(v1[2], v1[3]);
                    *(u32x4*)(out + off + bj * HALF) = w; } }
    }
};
struct EpiSwiGLU {
    static constexpr bool PERM = true, AFTER_DRAIN = false;
    bf16_t* O; int ldc;
    __device__ __forceinline__ void operator()(const f32x4 (&acc)[2][2][4][2], const Unit& u, int wr, int wc, int fr, int fq) const {
        const int row0 = u.pm * BM + wr * 64 + fr, col0 = u.pn * HALF + wc * 32 + 8 * fq;
#pragma unroll
        for (int ai = 0; ai < 2; ++ai)
#pragma unroll
            for (int m = 0; m < 4; ++m) { bf16_t* rowp = O + (size_t)(row0 + ai * HALF + m * 16) * ldc + col0;
                float h[8];
#pragma unroll
                for (int n = 0; n < 2; ++n)
#pragma unroll
                    for (int j = 0; j < 4; ++j) { const float g = acc[ai][0][m][n][j], up = acc[ai][1][m][n][j]; h[n * 4 + j] = g * __builtin_amdgcn_rcpf(1.f + __expf(-g)) * up; }
                u32x4 w; w.x = cvt_pk_bf16(h[0], h[1]); w.y = cvt_pk_bf16(h[2], h[3]); w.z = cvt_pk_bf16(h[4], h[5]); w.w = cvt_pk_bf16(h[6], h[7]);
                *(u32x4*)rowp = w; }
    }
};

template <int KK, class Epi, class Sched, bool ALIGN_EPI = false, bool SP2 = false>
__device__ __forceinline__ void gemm_phase(PG8_LAS unsigned char* lds, const Gemm g, const Sched& S, const Epi& E, const int tid) {
    const int wid = __builtin_amdgcn_readfirstlane(tid >> 6), lane = tid & 63, wr = wid >> 2, wc = wid & 3, fr = lane & 15, fq = lane >> 4;
    constexpr int K = KK, nt = K / BK;
    unsigned voffA[2], voffB[2];
#pragma unroll
    for (int i = 0; i < 2; ++i) { int R, C; stage_rc(tid * 16 + i * 8192, R, C); const int Rb = Epi::PERM ? ((R & ~31) + perm32(R & 31)) : R;
        voffA[i] = (unsigned)(R * K + C) * 2u; voffB[i] = (unsigned)(Rb * K + C) * 2u; }
    constexpr size_t kstep = (size_t)(BK * 2);
    constexpr size_t hstep = (size_t)HALF * K * 2;
    constexpr size_t tstep = 2 * hstep;
    const unsigned ldsw = (unsigned)wid * 1024u;
    const int aoff = lds_byte(wr * 64 + fr, fq * 8), boff = lds_byte(wc * 32 + fr, fq * 8);
#define PG8_SA(b, h) (((b) * 2 + (h)) * HTB)
#define PG8_SB(b, h) ((4 + (b) * 2 + (h)) * HTB)
#define PG8_STAGE(bufoff, gbase, voff) do { _Pragma("unroll") for (int _i = 0; _i < 2; ++_i) \
        __builtin_amdgcn_global_load_lds((const unsigned*)((const char*)(gbase) + (voff)[_i]), (PG8_LAS unsigned*)(lds + (bufoff) + ldsw + _i * 8192), 16, 0, 0); } while (0)
#define PG8_LDA(dst, b, h) do { _Pragma("unroll") for (int m = 0; m < 4; ++m) _Pragma("unroll") for (int k = 0; k < 2; ++k) dst[m][k] = *(const PG8_LAS bf16x8*)(lds + PG8_SA(b, h) + aoff + m * 2048 + k * 1024); } while (0)
#define PG8_LDB(dst, b, h) do { _Pragma("unroll") for (int n = 0; n < 2; ++n) _Pragma("unroll") for (int k = 0; k < 2; ++k) dst[n][k] = *(const PG8_LAS bf16x8*)(lds + PG8_SB(b, h) + boff + n * 2048 + k * 1024); } while (0)
#define PG8_MMA(ai, bj, At, Bt) do { __builtin_amdgcn_s_setprio(1); _Pragma("unroll") for (int m = 0; m < 4; ++m) _Pragma("unroll") for (int n = 0; n < 2; ++n) _Pragma("unroll") for (int k = 0; k < 2; ++k) \
        acc[ai][bj][m][n] = __builtin_amdgcn_mfma_f32_16x16x32_bf16(Bt[n][k], At[m][k], acc[ai][bj][m][n], 0, 0, 0); __builtin_amdgcn_s_setprio(0); } while (0)
#define PG8_WAIT_V(n) asm volatile("s_waitcnt vmcnt(" #n ")" ::: "memory")
#define PG8_WAIT_L(n) asm volatile("s_waitcnt lgkmcnt(" #n ")" ::: "memory")
#define PG8_BAR __builtin_amdgcn_s_barrier()
#define PG8_SCHED __builtin_amdgcn_sched_barrier(0)
    Unit cur, nxt; int ui = 0;
    if (!S.next(0, cur)) return;
    f32x4 acc[2][2][4][2];
#pragma unroll
    for (int a = 0; a < 2; ++a)
#pragma unroll
        for (int b = 0; b < 2; ++b)
#pragma unroll
            for (int m = 0; m < 4; ++m)
#pragma unroll
                for (int n = 0; n < 2; ++n) acc[a][b][m][n] = (f32x4){0.f, 0.f, 0.f, 0.f};
    bf16x8 At[4][2], B0[2][2], B1[2][2];
    const char* cA = (const char*)g.A + (size_t)cur.pm * tstep; const char* cB = (const char*)g.Bt + (g.bmap ? wgu_off(cur.pe) : (size_t)cur.pe * g.bstride) + (size_t)cur.pn * tstep;
    S.a_ready(cur);
    if constexpr (SP2) {
        PG8_STAGE(PG8_SB(0, 0), cB, voffB); PG8_STAGE(PG8_SB(0, 1), cB + hstep, voffB); PG8_STAGE(PG8_SA(0, 0), cA, voffA); PG8_STAGE(PG8_SA(0, 1), cA + hstep, voffA);
        if (wr == 1) PG8_BAR;
        PG8_WAIT_V(2); PG8_BAR;
        PG8_STAGE(PG8_SB(1, 0), cB + kstep, voffB); PG8_STAGE(PG8_SA(1, 0), cA + kstep, voffA); PG8_STAGE(PG8_SB(1, 1), cB + hstep + kstep, voffB);
        PG8_WAIT_V(6); PG8_BAR;
    } else {
        PG8_STAGE(PG8_SB(0, 0), cB, voffB); PG8_STAGE(PG8_SA(0, 0), cA, voffA); PG8_STAGE(PG8_SB(0, 1), cB + hstep, voffB); PG8_STAGE(PG8_SA(0, 1), cA + hstep, voffA);
        if (wr == 1) PG8_BAR;
        PG8_WAIT_V(4); PG8_BAR;
        PG8_STAGE(PG8_SB(1, 0), cB + kstep, voffB); PG8_STAGE(PG8_SA(1, 0), cA + kstep, voffA); PG8_STAGE(PG8_SB(1, 1), cB + hstep + kstep, voffB);
        PG8_WAIT_V(6); PG8_BAR;
    }
    for (;;) {
        const bool has_next = S.next(ui + 1, nxt);
        const char* nA = has_next ? (const char*)g.A + (size_t)nxt.pm * tstep : cA; const char* nB = has_next ? (const char*)g.Bt + (g.bmap ? wgu_off(nxt.pe) : (size_t)nxt.pe * g.bstride) + (size_t)nxt.pn * tstep : cB;
        for (int t = 0; t < nt; t += 2) {
            const bool last = (t == nt - 2);
            const char* a1 = cA + (size_t)(t + 1) * kstep;
            const char* a2 = last ? nA : cA + (size_t)(t + 2) * kstep; const char* b2 = last ? nB : cB + (size_t)(t + 2) * kstep;
            const char* a3 = a2 + kstep; const char* b3 = b2 + kstep;
            if (last && has_next) S.a_ready(nxt);
            if constexpr (SP2) {
            PG8_LDB(B0, 0, 0); PG8_LDB(B1, 0, 1); PG8_SCHED; PG8_LDA(At, 0, 0); PG8_STAGE(PG8_SA(1, 1), a1 + hstep, voffA);
            PG8_WAIT_V(8); PG8_WAIT_L(0); PG8_BAR; PG8_MMA(0, 0, At, B0); PG8_MMA(0, 1, At, B1); PG8_BAR; PG8_SCHED;
            PG8_LDA(At, 0, 1); PG8_STAGE(PG8_SB(0, 0), b2, voffB); PG8_STAGE(PG8_SB(0, 1), b2 + hstep, voffB); PG8_STAGE(PG8_SA(0, 0), a2, voffA);
            PG8_WAIT_V(8); PG8_WAIT_L(0); PG8_BAR; PG8_MMA(1, 0, At, B0); PG8_MMA(1, 1, At, B1); PG8_BAR; PG8_SCHED;
            PG8_LDB(B0, 1, 0); PG8_LDB(B1, 1, 1); PG8_SCHED; PG8_LDA(At, 1, 0); PG8_STAGE(PG8_SA(0, 1), a2 + hstep, voffA);
            PG8_WAIT_V(8); PG8_WAIT_L(0); PG8_BAR; PG8_MMA(0, 0, At, B0); PG8_MMA(0, 1, At, B1); PG8_BAR; PG8_SCHED;
            PG8_LDA(At, 1, 1); PG8_STAGE(PG8_SB(1, 0), b3, voffB); PG8_STAGE(PG8_SB(1, 1), b3 + hstep, voffB); PG8_STAGE(PG8_SA(1, 0), a3, voffA);
            PG8_WAIT_V(8); PG8_WAIT_L(0); PG8_BAR; PG8_MMA(1, 0, At, B0); PG8_MMA(1, 1, At, B1); PG8_BAR; PG8_SCHED;
            } else {
            PG8_LDB(B0, 0, 0); PG8_SCHED; PG8_LDA(At, 0, 0); PG8_STAGE(PG8_SA(1, 1), a1 + hstep, voffA);
            PG8_WAIT_L(8); PG8_BAR; PG8_WAIT_L(0); PG8_MMA(0, 0, At, B0); PG8_BAR; PG8_SCHED;
            PG8_LDB(B1, 0, 1); PG8_STAGE(PG8_SB(0, 0), b2, voffB);
            PG8_BAR; PG8_WAIT_L(0); PG8_MMA(0, 1, At, B1); PG8_BAR;
            PG8_LDA(At, 0, 1); PG8_STAGE(PG8_SA(0, 0), a2, voffA);
            PG8_BAR; PG8_WAIT_L(0); PG8_MMA(1, 0, At, B0); PG8_BAR; PG8_SCHED;
            PG8_STAGE(PG8_SB(0, 1), b2 + hstep, voffB);
            PG8_WAIT_V(6); PG8_BAR; PG8_MMA(1, 1, At, B1); PG8_BAR;
            PG8_LDB(B0, 1, 0); PG8_SCHED; PG8_LDA(At, 1, 0); PG8_STAGE(PG8_SA(0, 1), a2 + hstep, voffA);
            PG8_WAIT_L(8); PG8_BAR; PG8_WAIT_L(0); PG8_MMA(0, 0, At, B0); PG8_BAR; PG8_SCHED;
            PG8_LDB(B1, 1, 1); PG8_STAGE(PG8_SB(1, 0), b3, voffB);
            PG8_BAR; PG8_WAIT_L(0); PG8_MMA(0, 1, At, B1); PG8_BAR;
            PG8_LDA(At, 1, 1); PG8_STAGE(PG8_SA(1, 0), a3, voffA);
            PG8_BAR; PG8_WAIT_L(0); PG8_MMA(1, 0, At, B0); PG8_BAR; PG8_SCHED;
            PG8_STAGE(PG8_SB(1, 1), b3 + hstep, voffB);
            PG8_WAIT_V(6); PG8_BAR; PG8_MMA(1, 1, At, B1); PG8_BAR;
            }
        }
        if constexpr (ALIGN_EPI) { if (wr == 0) PG8_BAR; }
        E(acc, cur, wr, wc, fr, fq); S.done(cur);
        if (!has_next) break;
#pragma unroll
        for (int a = 0; a < 2; ++a)
#pragma unroll
            for (int b = 0; b < 2; ++b)
#pragma unroll
                for (int m = 0; m < 4; ++m)
#pragma unroll
                    for (int n = 0; n < 2; ++n) acc[a][b][m][n] = (f32x4){0.f, 0.f, 0.f, 0.f};
        cur = nxt; cA = nA; cB = nB; ++ui;
        if constexpr (ALIGN_EPI) { if (wr == 1) PG8_BAR; }
    }
    PG8_WAIT_V(0);
    if constexpr (!ALIGN_EPI) { if (wr == 0) PG8_BAR; }
    PG8_BAR;
#undef PG8_SA
#undef PG8_SB
#undef PG8_STAGE
#undef PG8_LDA
#undef PG8_LDB
#undef PG8_MMA
#undef PG8_WAIT_V
#undef PG8_WAIT_L
#undef PG8_BAR
#undef PG8_SCHED
}
}

#define GAS __attribute__((address_space(1)))
#define LAS __attribute__((address_space(3)))
typedef unsigned v4u __attribute__((ext_vector_type(4)));
typedef unsigned v2u __attribute__((ext_vector_type(2)));
typedef float f32x4 __attribute__((ext_vector_type(4)));
#define LDS_WAIT() asm volatile("s_waitcnt lgkmcnt(0)" ::: "memory")
__device__ __forceinline__ unsigned pk2(float lo, float hi) { return (unsigned)f2bf(lo) | ((unsigned)f2bf(hi) << 16); }

#define XB_TMO      128
#define XB_XCNT(j)  (256  + 64 * (j))
#define XB_XSUB(j)  (1280 + 64 * (j))
#define XB_XGEN(j)  (2304 + 64 * (j))
#define XB_TOP      3328
#define XB_TOPGEN   3392
#define XCD_BAR_WORDS 3456
#define XB_SPIN_CAP (1u << 18)
__device__ __forceinline__ unsigned xb_ld(unsigned* p)              { return __hip_atomic_load(p, __ATOMIC_RELAXED, __HIP_MEMORY_SCOPE_AGENT); }
__device__ __forceinline__ unsigned xb_add(unsigned* p, unsigned v) { return __hip_atomic_fetch_add(p, v, __ATOMIC_RELAXED, __HIP_MEMORY_SCOPE_AGENT); }
__device__ __forceinline__ unsigned xb_xcc_id() { return (unsigned)__builtin_amdgcn_s_getreg((3 << 11) | 20) & 0xFu; }
#define XB_SPIN(cond, bar) do { unsigned _sp = 0; while (cond) { __builtin_amdgcn_s_sleep(1); \
    if ((++_sp & 255u) == 0u) { if (xb_ld(&(bar)[XB_TMO])) break; if (_sp > XB_SPIN_CAP) { atomicAdd(&(bar)[XB_TMO], 1u); break; } } } } while (0)
struct XcdBarrier { unsigned* bar; unsigned x; volatile LAS unsigned* st; };
__device__ __forceinline__ XcdBarrier xcd_barrier_post(unsigned* bar, volatile LAS unsigned* st) {
    XcdBarrier b; b.bar = bar; b.x = xb_xcc_id(); b.st = st;
    if (threadIdx.x == 0) (void)xb_add(&bar[XB_XCNT(b.x)], 1u);
    return b;
}
__device__ __forceinline__ void xcd_barrier_complete(unsigned* bar, unsigned x, unsigned& nloc, unsigned& nx) {
    const unsigned G = gridDim.x * gridDim.y * gridDim.z;
    unsigned sum, cnt, mine, sp = 0u;
    for (;;) {
        sum = 0u; cnt = 0u; mine = 0u;
#pragma unroll
        for (unsigned j = 0; j < 16; ++j) { const unsigned c = xb_ld(&bar[XB_XCNT(j)]); sum += c; cnt += (c > 0u) ? 1u : 0u; mine = (j == x) ? c : mine; }
        if (sum == G) break;
        __builtin_amdgcn_s_sleep(1);
        if ((++sp & 255u) == 0u) { if (xb_ld(&bar[XB_TMO])) break; if (sp > XB_SPIN_CAP) { atomicAdd(&bar[XB_TMO], 1u); break; } }
    }
    nloc = mine > 0u ? mine : 1u; nx = cnt > 0u ? cnt : 1u;
}
__device__ __forceinline__ void xcd_barrier(const XcdBarrier& b) {
    asm volatile("s_waitcnt vmcnt(0)" ::: "memory");
    __syncthreads();
    if (threadIdx.x == 0) {
        unsigned* bar = b.bar;
        __builtin_amdgcn_s_waitcnt(0);
        unsigned nloc = b.st[0], nx = b.st[1];
        if (nloc == 0u) { xcd_barrier_complete(bar, b.x, nloc, nx); b.st[0] = nloc; b.st[1] = nx; }
        const unsigned old = xb_add(&bar[XB_XSUB(b.x)], 1u);
        const unsigned gen = old / nloc;
        if (old + 1u == (gen + 1u) * nloc) {
            __builtin_amdgcn_fence(__ATOMIC_RELEASE, "agent");
            asm volatile("s_waitcnt vmcnt(0)" ::: "memory");
            const unsigned og = xb_add(&bar[XB_TOP], 1u);
            const unsigned tg = og / nx;
            if (og + 1u == (tg + 1u) * nx) xb_add(&bar[XB_TOPGEN], 1u);
            else XB_SPIN(xb_ld(&bar[XB_TOPGEN]) == tg, bar);
            __builtin_amdgcn_fence(__ATOMIC_ACQUIRE, "agent");
            xb_add(&bar[XB_XGEN(b.x)], 1u);
            asm volatile("s_waitcnt vmcnt(0)" ::: "memory");
        } else {
            XB_SPIN(xb_ld(&bar[XB_XGEN(b.x)]) == gen, bar);
            __builtin_amdgcn_fence(__ATOMIC_ACQUIRE, "agent");
            asm volatile("s_waitcnt vmcnt(0)" ::: "memory");
        }
    }
    __syncthreads();
}

constexpr int RING_BYTES = 131072;
constexpr int TAB_OFF = RING_BYTES;
constexpr int TAB_CNT = TAB_OFF, TAB_ROWBASE = TAB_OFF + 128, TAB_NT = TAB_OFF + 256, TAB_TEXP = TAB_OFF + 272;
constexpr int MISC_OFF = TAB_OFF + 4096;
constexpr int PTAB_OFF = MISC_OFF + 16;
constexpr int LDS_BYTES = 147456;
static_assert(TAB_TEXP + MOE_MAXTILES * 4 <= MISC_OFF && PTAB_OFF + 32 * 8 <= LDS_BYTES, "LDS map");

__device__ __forceinline__ float wave_sum(float v, int lane) {
#pragma unroll
    for (int o = 1; o < 64; o <<= 1) v += __builtin_bit_cast(float, __builtin_amdgcn_ds_bpermute((lane ^ o) << 2, __builtin_bit_cast(int, v)));
    return v;
}
__device__ __forceinline__ void transpose_item(const float* W, int K, int N, bf16* WT, int k0, int n0, int drow0, LAS float* scr, int lane, const float sc = 1.f, const int rmode = 0) {
#pragma unroll 8
    for (int i = 0; i < 32; ++i) { const int kk = 2 * i + (lane >> 5); scr[kk * 33 + (lane & 31)] = W[(size_t)(k0 + kk) * N + n0 + (lane & 31)]; }
    LDS_WAIT(); asm volatile("" ::: "memory");
    const int c = lane & 7;
#pragma unroll
    for (int j = 0; j < 4; ++j) { const int n = (lane >> 3) + 8 * j; const LAS float* s = scr + (8 * c) * 33 + n;
        v4u o; o.x = pk2(s[0 * 33] * sc, s[1 * 33] * sc); o.y = pk2(s[2 * 33] * sc, s[3 * 33] * sc); o.z = pk2(s[4 * 33] * sc, s[5 * 33] * sc); o.w = pk2(s[6 * 33] * sc, s[7 * 33] * sc);
        const int dn = rmode == 0 ? n : (rmode == 1 ? 2 * n : (n < 8 ? 2 * n : (n < 16 ? 2 * (n - 8) + 1 : n)));
        *(GAS v4u*)(WT + (size_t)(drow0 + dn) * K + k0 + 8 * c) = o; }
    LDS_WAIT(); asm volatile("" ::: "memory");
}


__device__ __forceinline__ void build_moe_tables(LAS unsigned char* lds, const unsigned* cnt_words, const int tid) {
    LAS int* tcnt = (LAS int*)(lds + TAB_CNT); LAS int* trb = (LAS int*)(lds + TAB_ROWBASE); LAS int* tnt = (LAS int*)(lds + TAB_NT); LAS int* texp = (LAS int*)(lds + TAB_TEXP);
    __syncthreads();
    if (cnt_words) { if (tid < NEXP) tcnt[tid] = (int)__hip_atomic_load(cnt_words + 64 * tid, __ATOMIC_RELAXED, __HIP_MEMORY_SCOPE_AGENT); }
    __syncthreads();
    if (tid == 0) { int tile = 0;
#pragma unroll 1
        for (int e = 0; e < NEXP; ++e) { int c = tcnt[e]; if (c > 2 * T) c = 2 * T; int nt = (c + 255) >> 8; if (tile + nt > MOE_MAXTILES) nt = MOE_MAXTILES - tile; trb[e] = tile * 256;
#pragma unroll 1
            for (int i = 0; i < nt; ++i) texp[tile + i] = e;
            tile += nt; }
        tnt[0] = tile; }
    __syncthreads();
}

__device__ __forceinline__ void transpose_item64(const float* W, int K, int N, bf16* WT, int k0, int n0, int drow0, LAS float* scr, int lane, const float sc = 1.f) {
    const int r = lane >> 4, c4 = lane & 15;
#pragma unroll 4
    for (int i = 0; i < 16; ++i) { const int k = 4 * i + r; const f32x4 v = *(const GAS f32x4*)(W + (size_t)(k0 + k) * N + n0 + 4 * c4);
        scr[k * 64 + ((4 * c4 + 0) ^ k)] = v.x; scr[k * 64 + ((4 * c4 + 1) ^ k)] = v.y; scr[k * 64 + ((4 * c4 + 2) ^ k)] = v.z; scr[k * 64 + ((4 * c4 + 3) ^ k)] = v.w; }
    LDS_WAIT(); asm volatile("" ::: "memory");
    const int c = lane & 7;
#pragma unroll
    for (int j = 0; j < 8; ++j) { const int n = (lane >> 3) + 8 * j; float f[8];
#pragma unroll
        for (int e = 0; e < 8; ++e) { const int k = 8 * c + e; f[e] = scr[k * 64 + (n ^ k)] * sc; }
        *(GAS v4u*)(WT + (size_t)(drow0 + n) * K + k0 + 8 * c) = (v4u){pk2(f[0], f[1]), pk2(f[2], f[3]), pk2(f[4], f[5]), pk2(f[6], f[7])}; }
    LDS_WAIT(); asm volatile("" ::: "memory");
}

struct TrItem { const float* src; bf16* dst; int K, N, k0, n0, drow0; };
__device__ __forceinline__ void tr64_load(f32x4 (&v)[16], const TrItem& p, int lane) { const int r = lane >> 4, c4 = lane & 15;
#pragma unroll
    for (int i = 0; i < 16; ++i) v[i] = *(const GAS f32x4*)(p.src + (size_t)(p.k0 + 4 * i + r) * p.N + p.n0 + 4 * c4); }
__device__ __forceinline__ void tr64_put(const f32x4 (&v)[16], LAS float* scr, int lane) { const int r = lane >> 4, c4 = lane & 15;
#pragma unroll
    for (int i = 0; i < 16; ++i) { const int k = 4 * i + r; scr[k * 64 + ((4 * c4 + 0) ^ k)] = v[i].x; scr[k * 64 + ((4 * c4 + 1) ^ k)] = v[i].y; scr[k * 64 + ((4 * c4 + 2) ^ k)] = v[i].z; scr[k * 64 + ((4 * c4 + 3) ^ k)] = v[i].w; }
    LDS_WAIT(); asm volatile("" ::: "memory"); }
__device__ __forceinline__ void tr64_get(const TrItem& p, LAS float* scr, int lane) { const int c = lane & 7;
#pragma unroll
    for (int j = 0; j < 8; ++j) { const int n = (lane >> 3) + 8 * j; float f[8];
#pragma unroll
        for (int e = 0; e < 8; ++e) { const int k = 8 * c + e; f[e] = scr[k * 64 + (n ^ k)]; }
        *(GAS v4u*)(p.dst + (size_t)(p.drow0 + n) * p.K + p.k0 + 8 * c) = (v4u){pk2(f[0], f[1]), pk2(f[2], f[3]), pk2(f[4], f[5]), pk2(f[6], f[7])}; }
    LDS_WAIT(); asm volatile("" ::: "memory"); }

struct Args { const void* in[30]; float* out; unsigned char* ws; int layer, pad; };
__device__ __forceinline__ Ctx make_ctx(const Args& args, unsigned char* ws, int l) {
    Ctx c;
    c.pos = (const int*)args.in[1];
    c.gam = (const float*)args.in[5] + l * 16; c.ret_g = (const float*)args.in[6] + l * 512; c.mu = (const float*)args.in[7] + l * 2 * B_COLS;
    c.w0 = (const float*)args.in[8] + l * 1024; c.w2 = (const float*)args.in[9] + l * 96 * 512; c.a0 = (const float*)args.in[10] + l * 1024; c.a2 = (const float*)args.in[11] + l * 96 * 512;
    c.g2 = (const float*)args.in[12] + l * 256 * 512; c.k_k = (const float*)args.in[13] + l * 512; c.k_a = (const float*)args.in[14] + l * 512; c.r_k = (const float*)args.in[15] + l * 512;
    c.ln_g = (const float*)args.in[16] + l * 512; c.sgu_g = (const float*)args.in[17] + l * 512; c.sgu_b = (const float*)args.in[18] + l * 512;
    c.sgu_w = (const float*)args.in[19] + (size_t)l * 8 * 128 * 128; c.sgu_bias = (const float*)args.in[20] + l * 1024;
    c.proj = (bf16*)(ws + WS_PROJ); c.ycat = (bf16*)(ws + WS_ACT);
    c.rs = (bf16*)(ws + WS_RS); c.ks = (bf16*)(ws + WS_KS); c.vs = (bf16*)(ws + WS_VS); c.kk = (bf16*)(ws + WS_KK); c.gg = (bf16*)(ws + WS_GG);
    c.kdf = (bf16*)(ws + WS_KDF); c.kdb = (bf16*)(ws + WS_KDB); c.akf = (bf16*)(ws + WS_AKF); c.akb = (bf16*)(ws + WS_AKB); c.yf = (bf16*)(ws + WS_YF); c.yb = (bf16*)(ws + WS_YB);
    c.lin = (bf16*)(ws + WS_LIN); c.wf = (float*)(ws + WS_WF); c.wb = (float*)(ws + WS_WB); c.rkv = (float*)(ws + WS_RKV); c.rsp = (float*)(ws + WS_RSP);
    return c;
}


#define ROW_LOAD(v, ptr) _Pragma("unroll") for (int j = 0; j < 8; ++j) v[j] = ((const GAS f32x4*)(ptr))[lane + 64 * j]
#define ROW_LOAD_BF(v, ptr) _Pragma("unroll") for (int j = 0; j < 8; ++j) { const v2u w_ = ((const GAS v2u*)(ptr))[lane + 64 * j]; \
    v[j] = (f32x4){__builtin_bit_cast(float, w_.x << 16), __builtin_bit_cast(float, w_.x & 0xffff0000u), __builtin_bit_cast(float, w_.y << 16), __builtin_bit_cast(float, w_.y & 0xffff0000u)}; }
__device__ __forceinline__ void row_add_moe(f32x4 (&v)[8], const bf16* yp, size_t R1, size_t R2, float g1, float g2, int lane) {
#pragma unroll
    for (int j = 0; j < 8; ++j) { const v2u a = ((const GAS v2u*)(yp + R1 * DM))[lane + 64 * j], b = ((const GAS v2u*)(yp + R2 * DM))[lane + 64 * j];
        v[j].x += g1 * bf2f((bf16)(a.x & 0xffff)) + g2 * bf2f((bf16)(b.x & 0xffff)); v[j].y += g1 * bf2f((bf16)(a.x >> 16)) + g2 * bf2f((bf16)(b.x >> 16));
        v[j].z += g1 * bf2f((bf16)(a.y & 0xffff)) + g2 * bf2f((bf16)(b.y & 0xffff)); v[j].w += g1 * bf2f((bf16)(a.y >> 16)) + g2 * bf2f((bf16)(b.y >> 16)); }
}
__device__ __forceinline__ float row_rstd(const f32x4 (&v)[8], int lane) {
    float ss = 0.f;
#pragma unroll
    for (int j = 0; j < 8; ++j) ss += (v[j].x * v[j].x + v[j].y * v[j].y) + (v[j].z * v[j].z + v[j].w * v[j].w);
    return 1.f / sqrtf(wave_sum(ss, lane) * (1.f / DM) + NORM_EPS);
}
__device__ __forceinline__ f32x4 up2(v2u w) { return (f32x4){__builtin_bit_cast(float, w.x << 16), __builtin_bit_cast(float, w.x & 0xffff0000u), __builtin_bit_cast(float, w.y << 16), __builtin_bit_cast(float, w.y & 0xffff0000u)}; }
template <int NB> __device__ __forceinline__ void wave_sum_n(float (&v)[NB], int lane) {
#pragma unroll
    for (int o = 1; o < 64; o <<= 1) { float t_[NB];
#pragma unroll
        for (int u = 0; u < NB; ++u) t_[u] = __builtin_bit_cast(float, __builtin_amdgcn_ds_bpermute((lane ^ o) << 2, __builtin_bit_cast(int, v[u])));
#pragma unroll
        for (int u = 0; u < NB; ++u) v[u] += t_[u]; } }
template <int NB>
__device__ __forceinline__ void rows_norm_f32(const float* x_in, const float* gain, bf16* act, int m0, int mstride, int lane) {
    f32x4 v[NB][8]; float ss[NB];
#pragma unroll
    for (int u = 0; u < NB; ++u) { const int m = m0 + u * mstride;
#pragma unroll
        for (int j = 0; j < 8; ++j) v[u][j] = m < T ? ((const GAS f32x4*)(x_in + (size_t)m * DM))[lane + 64 * j] : (f32x4){0.f, 0.f, 0.f, 0.f}; }
#pragma unroll
    for (int u = 0; u < NB; ++u) { ss[u] = 0.f;
#pragma unroll
        for (int j = 0; j < 8; ++j) ss[u] += (v[u][j].x * v[u][j].x + v[u][j].y * v[u][j].y) + (v[u][j].z * v[u][j].z + v[u][j].w * v[u][j].w); }
    wave_sum_n<NB>(ss, lane);
#pragma unroll
    for (int u = 0; u < NB; ++u) { const int m = m0 + u * mstride; const float rstd = 1.f / sqrtf(ss[u] * (1.f / DM) + NORM_EPS);
        if (m < T) {
#pragma unroll
            for (int j = 0; j < 8; ++j) { const f32x4 g = ((const GAS f32x4*)gain)[lane + 64 * j];
                v2u o; o.x = pk2(v[u][j].x * rstd * g.x, v[u][j].y * rstd * g.y); o.y = pk2(v[u][j].z * rstd * g.z, v[u][j].w * rstd * g.w);
                ((GAS v2u*)(act + (size_t)m * DM))[lane + 64 * j] = o; } } }
}
template <int NB, bool FINAL>
__device__ __forceinline__ void rows_moe(bf16* xbuf, const bf16* yp, const unsigned* slot_tok, const float* gate_tok, const LAS int* trb, const float* gain, bf16* act, float* out, float pscale, int m0, int mstride, int lane) {
    v2u xr[NB][8], ya[NB][8], yb[NB][8]; float g1[NB], g2[NB], ss[NB]; size_t R1[NB], R2[NB];
#pragma unroll
    for (int u = 0; u < NB; ++u) { const int m = m0 + u * mstride < T ? m0 + u * mstride : m0;
        const unsigned s1 = slot_tok[2 * m], s2 = slot_tok[2 * m + 1]; g1[u] = gate_tok[2 * m]; g2[u] = gate_tok[2 * m + 1];
        R1[u] = (size_t)(trb[s1 >> 20] + (int)(s1 & 0xfffffu)); R2[u] = (size_t)(trb[s2 >> 20] + (int)(s2 & 0xfffffu)); }
#pragma unroll
    for (int u = 0; u < NB; ++u) { const int m = m0 + u * mstride < T ? m0 + u * mstride : m0;
#pragma unroll
        for (int j = 0; j < 8; ++j) { xr[u][j] = ((const GAS v2u*)(xbuf + (size_t)m * DM))[lane + 64 * j]; ya[u][j] = ((const GAS v2u*)(yp + R1[u] * DM))[lane + 64 * j]; yb[u][j] = ((const GAS v2u*)(yp + R2[u] * DM))[lane + 64 * j]; } }
#pragma unroll
    for (int u = 0; u < NB; ++u) { const int m = m0 + u * mstride; ss[u] = 0.f;
#pragma unroll
        for (int j = 0; j < 8; ++j) { f32x4 t = up2(xr[u][j]) + g1[u] * up2(ya[u][j]) + g2[u] * up2(yb[u][j]);
            if constexpr (!FINAL) { v2u o; o.x = pk2(t.x, t.y); o.y = pk2(t.z, t.w); if (m < T) ((GAS v2u*)(xbuf + (size_t)m * DM))[lane + 64 * j] = o; t = up2(o); xr[u][j] = o; }
            else { ya[u][j] = (v2u){__builtin_bit_cast(unsigned, t.x), __builtin_bit_cast(unsigned, t.y)}; yb[u][j] = (v2u){__builtin_bit_cast(unsigned, t.z), __builtin_bit_cast(unsigned, t.w)}; }
            ss[u] += (t.x * t.x + t.y * t.y) + (t.z * t.z + t.w * t.w); } }
    wave_sum_n<NB>(ss, lane);
#pragma unroll
    for (int u = 0; u < NB; ++u) { const int m = m0 + u * mstride; const float rstd = 1.f / sqrtf(ss[u] * (1.f / DM) + NORM_EPS);
        if (m < T) {
#pragma unroll
            for (int j = 0; j < 8; ++j) { const f32x4 g = ((const GAS f32x4*)gain)[lane + 64 * j];
                if constexpr (!FINAL) { const f32x4 t = up2(xr[u][j]); v2u o; o.x = pk2(t.x * rstd * g.x, t.y * rstd * g.y); o.y = pk2(t.z * rstd * g.z, t.w * rstd * g.w); ((GAS v2u*)(act + (size_t)m * DM))[lane + 64 * j] = o; }
                else { const f32x4 t = (f32x4){__builtin_bit_cast(float, ya[u][j].x), __builtin_bit_cast(float, ya[u][j].y), __builtin_bit_cast(float, yb[u][j].x), __builtin_bit_cast(float, yb[u][j].y)};
                    ((GAS f32x4*)(out + (size_t)m * DM))[lane + 64 * j] = (f32x4){t.x * rstd * g.x * pscale, t.y * rstd * g.y * pscale, t.z * rstd * g.z * pscale, t.w * rstd * g.w * pscale}; } } } }
}
#define SEAM(k) do { if constexpr (KSEL < 0) { XcdBarrier b_ = bar; unsigned blo_ = __builtin_amdgcn_readfirstlane((unsigned)(unsigned long long)b_.bar), bhi_ = __builtin_amdgcn_readfirstlane((unsigned)((unsigned long long)b_.bar >> 32)); \
    asm volatile("" : "+s"(blo_), "+s"(bhi_)); b_.bar = (unsigned*)(((unsigned long long)bhi_ << 32) | blo_); xcd_barrier(b_); } } while (0)
#define PORD(k) ((k) == 13 ? 6 : ((k) >= 6 ? (k) + 1 : (k)))
#define TSTAMP_AFTER(k) do { if (KB_TPROBE >= 0 && KSEL < 0 && blockIdx.x == 0 && threadIdx.x == 0) ((unsigned long long*)(args.ws + WS_CTL))[32768 + 1 + l * 13 + PORD(k)] = wall_clock64(); } while (0)
#define PH_ON(k) if constexpr ((KSEL < 0 && KB_EN(k)) || KSEL == (k))
#define PHASE_LOCALS() GAS unsigned char* wsg_ = (GAS unsigned char*)args.ws; int ll = KSEL < 0 ? l : __builtin_amdgcn_readfirstlane(l); int tid = threadIdx.x; asm volatile("" : "+s"(wsg_), "+s"(ll), "+v"(tid)); \
    unsigned char* ws = (unsigned char*)wsg_;         \
    const int lane = tid & 63, wave = __builtin_amdgcn_readfirstlane(tid >> 6); \
    const int G = gridDim.x, bid = blockIdx.x; const long gtid = (long)bid * 512 + tid, gstride = (long)G * 512; const int gw = bid * 8 + wave, NGW = G * 8; \
    (void)gtid; (void)gstride; (void)gw; (void)NGW; (void)ll; (void)lane


typedef short bf16x8 __attribute__((ext_vector_type(8)));
typedef short s16x4 __attribute__((ext_vector_type(4)));
typedef short v4i16_t __attribute__((ext_vector_type(4)));
#ifndef KB_EMU
#define MMA16(a, b, c) __builtin_amdgcn_mfma_f32_16x16x32_bf16((a), (b), (c), 0, 0, 0)
#define TR16(p) __builtin_amdgcn_ds_read_tr16_b64_v4i16((LAS v4i16_t*)(p))
#define BPERM(addr, v) __builtin_amdgcn_ds_bpermute((addr), (v))
#define RFL(x) __builtin_amdgcn_readfirstlane(x)
#define FEXP(x) __expf(x)
#define BSYNC() __syncthreads()
#define LBAR() do { asm volatile("s_waitcnt lgkmcnt(0)" ::: "memory"); __builtin_amdgcn_s_barrier(); asm volatile("" ::: "memory"); } while (0)
#define LDS_WAIT_() do { asm volatile("s_waitcnt lgkmcnt(0)" ::: "memory"); } while (0)
#endif
__device__ __forceinline__ bf16x8 frag_row(const LAS bf16* X, int ld, int r0, int c0, int fr, int fq) { return *(const LAS bf16x8*)(X + (r0 + fr) * ld + c0 + 8 * fq); }
__device__ __forceinline__ s16x4 tr4(const LAS bf16* X, int ld, int r0, int c0, int fr) { return __builtin_bit_cast(s16x4, TR16(X + (r0 + (fr >> 2)) * ld + c0 + 4 * (fr & 3))); }
__device__ __forceinline__ bf16x8 frag_col(const LAS bf16* X, int ld, int k0, int c0, int fr, int fq) {
    const s16x4 a = tr4(X, ld, k0 + 8 * fq, c0, fr), b = tr4(X, ld, k0 + 8 * fq + 4, c0, fr);
    return (bf16x8){a[0], a[1], a[2], a[3], b[0], b[1], b[2], b[3]}; }
#ifndef KB_EMU
typedef float cvt_f2 __attribute__((ext_vector_type(2)));
typedef __bf16 cvt_b2 __attribute__((ext_vector_type(2)));
__device__ __forceinline__ unsigned cvtpk(float lo, float hi) { return __builtin_bit_cast(unsigned, __builtin_convertvector(((cvt_f2){lo, hi}), cvt_b2)); }
#else
inline unsigned cvtpk(float lo, float hi) { return (unsigned)f2bf(lo) | ((unsigned)f2bf(hi) << 16); }
#endif
__device__ __forceinline__ float xlane_max4(float v, int lane) {
    v = fmaxf(v, __builtin_bit_cast(float, BPERM((lane ^ 16) << 2, __builtin_bit_cast(int, v))));
    v = fmaxf(v, __builtin_bit_cast(float, BPERM((lane ^ 32) << 2, __builtin_bit_cast(int, v)))); return v; }
__device__ __forceinline__ float xlane_sum4(float v, int lane) {
    v += __builtin_bit_cast(float, BPERM((lane ^ 16) << 2, __builtin_bit_cast(int, v)));
    v += __builtin_bit_cast(float, BPERM((lane ^ 32) << 2, __builtin_bit_cast(int, v))); return v; }

__device__ __forceinline__ void unpack8(const v4u x, float (&f)[8]) {
    f[0] = __builtin_bit_cast(float, x.x << 16); f[1] = __builtin_bit_cast(float, x.x & 0xffff0000u); f[2] = __builtin_bit_cast(float, x.y << 16); f[3] = __builtin_bit_cast(float, x.y & 0xffff0000u);
    f[4] = __builtin_bit_cast(float, x.z << 16); f[5] = __builtin_bit_cast(float, x.z & 0xffff0000u); f[6] = __builtin_bit_cast(float, x.w << 16); f[7] = __builtin_bit_cast(float, x.w & 0xffff0000u); }
__device__ __forceinline__ void st8(bf16* p, const float (&f)[8]) { *(GAS v4u*)p = (v4u){cvtpk(f[0], f[1]), cvtpk(f[2], f[3]), cvtpk(f[4], f[5]), cvtpk(f[6], f[7])}; }
__device__ __forceinline__ float red8(float v, int lane) {
    v += __builtin_bit_cast(float, BPERM((lane ^ 1) << 2, __builtin_bit_cast(int, v))); v += __builtin_bit_cast(float, BPERM((lane ^ 2) << 2, __builtin_bit_cast(int, v)));
    v += __builtin_bit_cast(float, BPERM((lane ^ 4) << 2, __builtin_bit_cast(int, v))); return v; }
__device__ __forceinline__ void v_rot_table(const int* pos, float* rot, long idx) {
    const int j = (int)(idx % 40); const long t = idx / 40;
    const float inv = j < 32 ? expf(-(float)j * (1.f / 32.f) * 9.210340371976184f) : expf(-(float)(j - 32) * (1.f / 8.f) * 13.122363377404328f);
    float sn, cs; sincosf((float)pos[t] * inv, &sn, &cs); rot[idx * 2] = cs; rot[idx * 2 + 1] = sn; }
__device__ __forceinline__ void v_rot_ret(bf16* proj, const float* rot, long idx) {
    const int j8 = (int)(idx & 3), h = (int)((idx >> 2) & 7); const long t = idx >> 5;
    bf16* q = proj + (size_t)t * NPROJ + OFF_A + h * 64 + 8 * j8; bf16* k = q + 512; const float* cs = rot + ((size_t)t * 40 + 8 * j8) * 2;
    float q1[8], q2[8], k1[8], k2[8], c[8], s_[8];
    unpack8(*(const GAS v4u*)q, q1); unpack8(*(const GAS v4u*)(q + 32), q2); unpack8(*(const GAS v4u*)k, k1); unpack8(*(const GAS v4u*)(k + 32), k2);
#pragma unroll
    for (int i = 0; i < 4; ++i) { const f32x4 v = *(const GAS f32x4*)(cs + 4 * i); c[2 * i] = v.x; s_[2 * i] = v.y; c[2 * i + 1] = v.z; s_[2 * i + 1] = v.w; }
    float o1[8], o2[8], p1[8], p2[8];
#pragma unroll
    for (int i = 0; i < 8; ++i) { o1[i] = q1[i] * c[i] - q2[i] * s_[i]; o2[i] = q2[i] * c[i] + q1[i] * s_[i]; p1[i] = k1[i] * c[i] - k2[i] * s_[i]; p2[i] = k2[i] * c[i] + k1[i] * s_[i]; }
    st8(q, o1); st8(q + 32, o2); st8(k, p1); st8(k + 32, p2); }
__device__ __forceinline__ void v_rot_dil(bf16* proj, const float* rot, long idx) {
    const int h = (int)(idx & 7); const long t = idx >> 3;
    bf16* q = proj + (size_t)t * NPROJ + OFF_D + h * 64; bf16* k = q + 512; const float* cs = rot + ((size_t)t * 40 + 32) * 2;
    float q1[8], q2[8], k1[8], k2[8], c[8], s_[8];
    unpack8(*(const GAS v4u*)q, q1); unpack8(*(const GAS v4u*)(q + 8), q2); unpack8(*(const GAS v4u*)k, k1); unpack8(*(const GAS v4u*)(k + 8), k2);
#pragma unroll
    for (int i = 0; i < 4; ++i) { const f32x4 v = *(const GAS f32x4*)(cs + 4 * i); c[2 * i] = v.x; s_[2 * i] = v.y; c[2 * i + 1] = v.z; s_[2 * i + 1] = v.w; }
    float o1[8], o2[8], p1[8], p2[8];
#pragma unroll
    for (int i = 0; i < 8; ++i) { o1[i] = q1[i] * c[i] - q2[i] * s_[i]; o2[i] = q2[i] * c[i] + q1[i] * s_[i]; p1[i] = k1[i] * c[i] - k2[i] * s_[i]; p2[i] = k2[i] * c[i] + k1[i] * s_[i]; }
    st8(q, o1); st8(q + 8, o2); st8(k, p1); st8(k + 8, p2); }
__device__ __forceinline__ void v_rwkv_shift(const Ctx& c, long idx) {
    const int g8 = (int)(idx % 248), j0 = 8 * g8; const long t = idx / 248; const int s = (int)(t % SEQ);
    const bf16* p = c.proj + (size_t)t * NPROJ + OFF_B + j0;
    float x[8], xp[8], xn[8], o[8];
    unpack8(*(const GAS v4u*)p, x);
    if (s > 0) unpack8(*(const GAS v4u*)(p - NPROJ), xp); else { for (int i = 0; i < 8; ++i) xp[i] = 0.f; }
    if (s < SEQ - 1) unpack8(*(const GAS v4u*)(p + NPROJ), xn); else { for (int i = 0; i < 8; ++i) xn[i] = 0.f; }
#pragma unroll
    for (int i = 0; i < 8; ++i) o[i] = x[i] + c.mu[j0 + i] * (xp[i] - x[i]) + c.mu[B_COLS + j0 + i] * (xn[i] - x[i]);
    if (j0 < 512) st8(c.rs + t * 512 + j0, o);
    else if (j0 < 1024) st8(c.ks + t * 512 + j0 - 512, o);
    else if (j0 < 1536) st8(c.vs + t * 512 + j0 - 1024, o);
    else { if (j0 < 1632) { for (int i = 0; i < 8; ++i) o[i] = tanhf(o[i]); } else if (j0 >= 1728) { for (int i = 0; i < 8; ++i) o[i] = sigmoidf_(o[i]); }
        st8(c.lin + t * NLORA + (j0 - 1536), o); } }
struct ShiftIn { v4u x, xp, xn; };
__device__ __forceinline__ void shift_load(const Ctx& c, unsigned idx, ShiftIn& in) {
    const unsigned t = idx / 248u, j0 = 8u * (idx - t * 248u), s = t % (unsigned)SEQ;
    const bf16* p = c.proj + (size_t)t * NPROJ + OFF_B + j0; const v4u z = (v4u){0u, 0u, 0u, 0u};
    in.x = *(const GAS v4u*)p; in.xp = z; in.xn = z;
    if (s > 0) in.xp = *(const GAS v4u*)(p - NPROJ);
    if (s < (unsigned)SEQ - 1) in.xn = *(const GAS v4u*)(p + NPROJ); }
__device__ __forceinline__ void shift_finish(const Ctx& c, unsigned idx, const ShiftIn& in) {
    const unsigned t = idx / 248u, j0 = 8u * (idx - t * 248u);
    float x[8], xp[8], xn[8], o[8], mp[8], mn[8];
    unpack8(in.x, x); unpack8(in.xp, xp); unpack8(in.xn, xn);
    { const f32x4 a = *(const GAS f32x4*)(c.mu + j0), b = *(const GAS f32x4*)(c.mu + j0 + 4), d = *(const GAS f32x4*)(c.mu + B_COLS + j0), e = *(const GAS f32x4*)(c.mu + B_COLS + j0 + 4);
      mp[0] = a.x; mp[1] = a.y; mp[2] = a.z; mp[3] = a.w; mp[4] = b.x; mp[5] = b.y; mp[6] = b.z; mp[7] = b.w; mn[0] = d.x; mn[1] = d.y; mn[2] = d.z; mn[3] = d.w; mn[4] = e.x; mn[5] = e.y; mn[6] = e.z; mn[7] = e.w; }
#pragma unroll
    for (int i = 0; i < 8; ++i) o[i] = x[i] + mp[i] * (xp[i] - x[i]) + mn[i] * (xn[i] - x[i]);
    if (j0 < 512) st8(c.rs + (size_t)t * 512 + j0, o);
    else if (j0 < 1024) st8(c.ks + (size_t)t * 512 + j0 - 512, o);
    else if (j0 < 1536) st8(c.vs + (size_t)t * 512 + j0 - 1024, o);
    else { if (j0 < 1632) { for (int i = 0; i < 8; ++i) o[i] = tanhf(o[i]); } else if (j0 >= 1728) { for (int i = 0; i < 8; ++i) o[i] = sigmoidf_(o[i]); }
        st8(c.lin + (size_t)t * NLORA + (j0 - 1536), o); } }
__device__ __forceinline__ void w_sgu_prep(const Ctx& c, long t, int lane) {
    bf16* v = c.proj + (size_t)t * NPROJ + OFF_C + 512 + 8 * lane; float f[8]; unpack8(*(const GAS v4u*)v, f); float s = 0.f;
#pragma unroll
    for (int i = 0; i < 8; ++i) { f[i] = geluf_(f[i]); s += f[i]; }
    const float mean = wave_sum(s, lane) * (1.f / 512.f); float q = 0.f;
#pragma unroll
    for (int i = 0; i < 8; ++i) { f[i] -= mean; q += f[i] * f[i]; }
    const float rstd = 1.f / sqrtf(wave_sum(q, lane) * (1.f / 512.f) + NORM_EPS);
#pragma unroll
    for (int i = 0; i < 8; ++i) f[i] = f[i] * rstd * c.sgu_g[8 * lane + i] + c.sgu_b[8 * lane + i];
    st8(v, f); }
template <int NB>
__device__ __forceinline__ void w_sgu_prep_batch(const Ctx& c, int m0, int mstride, int lane) {
    float f[NB][8], s[NB], q[NB]; v4u raw[NB];
#pragma unroll
    for (int u = 0; u < NB; ++u) { const int t = m0 + u * mstride; raw[u] = (v4u){0u, 0u, 0u, 0u}; if (t < T) raw[u] = *(const GAS v4u*)(c.proj + (size_t)t * NPROJ + OFF_C + 512 + 8 * lane); }
#pragma unroll
    for (int u = 0; u < NB; ++u) { unpack8(raw[u], f[u]); s[u] = 0.f;
#pragma unroll
        for (int i = 0; i < 8; ++i) { f[u][i] = geluf_(f[u][i]); s[u] += f[u][i]; } }
#pragma unroll
    for (int o = 1; o < 64; o <<= 1) { float t_[NB];
#pragma unroll
        for (int u = 0; u < NB; ++u) t_[u] = __builtin_bit_cast(float, __builtin_amdgcn_ds_bpermute((lane ^ o) << 2, __builtin_bit_cast(int, s[u])));
#pragma unroll
        for (int u = 0; u < NB; ++u) s[u] += t_[u]; }
#pragma unroll
    for (int u = 0; u < NB; ++u) { const float mean = s[u] * (1.f / 512.f); q[u] = 0.f;
#pragma unroll
        for (int i = 0; i < 8; ++i) { f[u][i] -= mean; q[u] += f[u][i] * f[u][i]; } }
#pragma unroll
    for (int o = 1; o < 64; o <<= 1) { float t_[NB];
#pragma unroll
        for (int u = 0; u < NB; ++u) t_[u] = __builtin_bit_cast(float, __builtin_amdgcn_ds_bpermute((lane ^ o) << 2, __builtin_bit_cast(int, q[u])));
#pragma unroll
        for (int u = 0; u < NB; ++u) q[u] += t_[u]; }
    float gg_[8], bb_[8];
    { const f32x4 a = *(const GAS f32x4*)(c.sgu_g + 8 * lane), b = *(const GAS f32x4*)(c.sgu_g + 8 * lane + 4), d = *(const GAS f32x4*)(c.sgu_b + 8 * lane), e = *(const GAS f32x4*)(c.sgu_b + 8 * lane + 4);
      gg_[0] = a.x; gg_[1] = a.y; gg_[2] = a.z; gg_[3] = a.w; gg_[4] = b.x; gg_[5] = b.y; gg_[6] = b.z; gg_[7] = b.w; bb_[0] = d.x; bb_[1] = d.y; bb_[2] = d.z; bb_[3] = d.w; bb_[4] = e.x; bb_[5] = e.y; bb_[6] = e.z; bb_[7] = e.w; }
#pragma unroll
    for (int u = 0; u < NB; ++u) { const int t = m0 + u * mstride; const float rstd = 1.f / sqrtf(q[u] * (1.f / 512.f) + NORM_EPS);
#pragma unroll
        for (int i = 0; i < 8; ++i) f[u][i] = f[u][i] * rstd * gg_[i] + bb_[i];
        if (t < T) st8(c.proj + (size_t)t * NPROJ + OFF_C + 512 + 8 * lane, f[u]); } }
__device__ __forceinline__ void v_rwkv_kk(const Ctx& c, long idx, int lane) {
    const size_t o = (size_t)idx * 8; float k[8], af[8], ab[8]; unpack8(*(const GAS v4u*)(c.kk + o), k); unpack8(*(const GAS v4u*)(c.akf + o), af); unpack8(*(const GAS v4u*)(c.akb + o), ab);
    float ss = 0.f;
#pragma unroll
    for (int i = 0; i < 8; ++i) ss += k[i] * k[i];
    const float n = 1.f / sqrtf(red8(ss, lane) + 1e-12f);
#pragma unroll
    for (int i = 0; i < 8; ++i) { k[i] *= n; af[i] *= k[i]; ab[i] *= k[i]; }
    st8(c.kk + o, k); st8(c.akf + o, af); st8(c.akb + o, ab); }
__device__ __forceinline__ void v_dil_combine(const bf16* dpo, const float* dml, bf16* ycat, long idx) {
    const int cg = (int)(idx & 63), h = cg >> 3; const long t = idx >> 6; float m[3], l[3];
#pragma unroll
    for (int br = 0; br < 3; ++br) { const float* mp = dml + (((size_t)br * T + t) * 8 + h) * 2; m[br] = mp[0]; l[br] = mp[1]; }
    const float M = fmaxf(m[0], fmaxf(m[1], m[2])); float wgt[3], den = 0.f;
#pragma unroll
    for (int br = 0; br < 3; ++br) { wgt[br] = FEXP(m[br] - M) * l[br]; den += wgt[br]; }
    const float inv = 1.f / den; float y[8];
#pragma unroll
    for (int i = 0; i < 8; ++i) y[i] = 0.f;
#pragma unroll
    for (int br = 0; br < 3; ++br) { float f[8]; unpack8(*(const GAS v4u*)(dpo + ((size_t)br * T + t) * 512 + cg * 8), f); const float wv = wgt[br] * inv;
#pragma unroll
        for (int i = 0; i < 8; ++i) y[i] += wv * f[i]; }
    st8(ycat + (size_t)t * 2048 + 1536 + cg * 8, y); }
template <int NB>
__device__ __forceinline__ void v_dil_combine_batch(const bf16* dpo, const float* dml, bf16* ycat, long idx0, long istride, long iend) {
    cvt_f2 ml[NB][3]; v4u raw[NB][3];
#pragma unroll
    for (int u = 0; u < NB; ++u) { const long idx = idx0 + u * istride < iend ? idx0 + u * istride : idx0; const int cg = (int)(idx & 63), h = cg >> 3; const long t = idx >> 6;
#pragma unroll
        for (int br = 0; br < 3; ++br) { ml[u][br] = *(const GAS cvt_f2*)(dml + (((size_t)br * T + t) * 8 + h) * 2); raw[u][br] = *(const GAS v4u*)(dpo + ((size_t)br * T + t) * 512 + cg * 8); } }
#pragma unroll
    for (int u = 0; u < NB; ++u) { const long idx = idx0 + u * istride; const int cg = (int)(idx & 63); const long t = idx >> 6;
        const float M = fmaxf(ml[u][0].x, fmaxf(ml[u][1].x, ml[u][2].x)); float wgt[3], den = 0.f;
#pragma unroll
        for (int br = 0; br < 3; ++br) { wgt[br] = FEXP(ml[u][br].x - M) * ml[u][br].y; den += wgt[br]; }
        const float inv = 1.f / den; float y[8];
#pragma unroll
        for (int i = 0; i < 8; ++i) y[i] = 0.f;
#pragma unroll
        for (int br = 0; br < 3; ++br) { float f[8]; unpack8(raw[u][br], f); const float wv = wgt[br] * inv;
#pragma unroll
            for (int i = 0; i < 8; ++i) y[i] += wv * f[i]; }
        if (idx < iend) st8(ycat + (size_t)t * 2048 + 1536 + cg * 8, y); } }
__device__ __forceinline__ void v_rwkv_fin(const Ctx& c, long idx, int lane) {
    const int cg = (int)(idx & 63); const long t = idx >> 6; const size_t o = (size_t)idx * 8;
    float yf[8], yb[8], r[8], k[8], v[8], g[8]; unpack8(*(const GAS v4u*)(c.yf + o), yf); unpack8(*(const GAS v4u*)(c.yb + o), yb); unpack8(*(const GAS v4u*)(c.rs + o), r); unpack8(*(const GAS v4u*)(c.ks + o), k);
    unpack8(*(const GAS v4u*)(c.vs + o), v); unpack8(*(const GAS v4u*)(c.gg + o), g);
    float s = 0.f, bon = 0.f;
#pragma unroll
    for (int i = 0; i < 8; ++i) { yf[i] += yb[i]; s += yf[i]; bon += r[i] * k[i] * c.r_k[cg * 8 + i]; }
    const float mu = red8(s, lane) * (1.f / 64.f); bon = red8(bon, lane); float q = 0.f;
#pragma unroll
    for (int i = 0; i < 8; ++i) { yf[i] -= mu; q += yf[i] * yf[i]; }
    const float rstd = 1.f / sqrtf(red8(q, lane) * (1.f / 64.f) + GN_EPS); float out[8];
#pragma unroll
    for (int i = 0; i < 8; ++i) out[i] = (yf[i] * rstd * c.ln_g[cg * 8 + i] + bon * v[i]) * g[i];
    st8(c.ycat + (size_t)t * 2048 + 512 + cg * 8, out); }

constexpr int DIL_LD = 72, DIL_TEAM_BYTES = (64 + 192 + 192) * DIL_LD * 2;
static_assert(2 * DIL_TEAM_BYTES <= RING_BYTES, "dilated attention LDS");
__device__ __forceinline__ void dil_attn_phase(LAS unsigned char* lds, const bf16* proj, bf16* dpo, float* dml, const int tid, const int bid, const int G) {
    const int lane = tid & 63, wave = RFL(tid >> 6), team = wave >> 2, w = wave & 3, tt = tid & 255, fr = lane & 15, fq = lane >> 4;
    LAS bf16* Qs = (LAS bf16*)(lds + team * DIL_TEAM_BYTES); LAS bf16* Ks = Qs + 64 * DIL_LD; LAS bf16* Vs = Ks + 192 * DIL_LD;
    constexpr int NITEMS = BATCH * 8 * 3 * 64;
    v4u pq[2], pk[6], pv[6];
#define DIL_DECODE(it_) const int blk = (it_) & 63; int r_ = (it_) >> 6; const int br = r_ % 3; r_ /= 3; const int h = r_ & 7, b = r_ >> 3; \
        const int dil = br == 0 ? 1 : (br == 1 ? 4 : 16), L = SEQ / dil, nb = L / 64, g = blk / nb, n = blk % nb; const bf16* base = proj + (size_t)b * SEQ * NPROJ + OFF_D + h * 64
#define DIL_LOAD(it_) do { DIL_DECODE(it_); \
        _Pragma("unroll") for (int u = 0; u < 2; ++u) { const int c_ = tt + 256 * u, i_ = c_ >> 3, ch_ = c_ & 7; const int pos_ = (64 * n + i_) * dil + g; pq[u] = *(const GAS v4u*)(base + (size_t)pos_ * NPROJ + ch_ * 8); } \
        _Pragma("unroll") for (int u = 0; u < 6; ++u) { const int c_ = tt + 256 * u, kr_ = c_ >> 3, ch_ = c_ & 7; const int kidx_ = 64 * (n - 1) + kr_; const bool ok_ = kidx_ >= 0 && kidx_ < L; const int pos_ = (ok_ ? kidx_ : 0) * dil + g; \
            pk[u] = (v4u){0u, 0u, 0u, 0u}; pv[u] = pk[u]; if (ok_) { pk[u] = *(const GAS v4u*)(base + (size_t)pos_ * NPROJ + 512 + ch_ * 8); pv[u] = *(const GAS v4u*)(base + (size_t)pos_ * NPROJ + 1024 + ch_ * 8); } } } while (0)
    if (bid * 2 < NITEMS) DIL_LOAD(bid * 2 + team);
    for (int it0 = bid * 2; it0 < NITEMS; it0 += G * 2) {
        const int it = it0 + team;
        DIL_DECODE(it);
        LBAR();
#pragma unroll
        for (int u = 0; u < 2; ++u) { const int c_ = tt + 256 * u; *(LAS v4u*)(Qs + (c_ >> 3) * DIL_LD + (c_ & 7) * 8) = pq[u]; }
#pragma unroll
        for (int u = 0; u < 6; ++u) { const int c_ = tt + 256 * u; *(LAS v4u*)(Ks + (c_ >> 3) * DIL_LD + (c_ & 7) * 8) = pk[u]; *(LAS v4u*)(Vs + (c_ >> 3) * DIL_LD + (c_ & 7) * 8) = pv[u]; }
        LBAR();
        if (it0 + G * 2 < NITEMS) DIL_LOAD(it0 + G * 2 + team);
        bf16x8 qf[2];
#pragma unroll
        for (int ks = 0; ks < 2; ++ks) qf[ks] = frag_row(Qs, DIL_LD, 16 * w, 32 * ks, fr, fq);
        f32x4 sc[9];
#pragma unroll
        for (int kp = 0; kp < 9; ++kp) { sc[kp] = (f32x4){0.f, 0.f, 0.f, 0.f}; const LAS bf16* Kt = Ks + 16 * (w + kp) * DIL_LD;
#pragma unroll
            for (int ks = 0; ks < 2; ++ks) sc[kp] = MMA16(frag_row(Kt, DIL_LD, 0, 32 * ks, fr, fq), qf[ks], sc[kp]); }
        const int qi = 64 * n + 16 * w + fr; float mx = -1e30f;
#pragma unroll
        for (int kp = 0; kp < 9; ++kp) { const int kt = w + kp; const bool tile_ok = (n > 0 || kt >= 4) && (n < nb - 1 || kt < 8);
#pragma unroll
            for (int j = 0; j < 4; ++j) { const int e = 4 * fq + j - fr; const bool ok = tile_ok && (kp == 0 ? e >= 0 : (kp == 8 ? e <= 0 : true));
                sc[kp][j] = ok ? sc[kp][j] : -1e30f; mx = fmaxf(mx, sc[kp][j]); } }
        mx = xlane_max4(mx, lane);
        float den = 0.f;
#pragma unroll
        for (int kp = 0; kp < 9; ++kp)
#pragma unroll
            for (int j = 0; j < 4; ++j) { const float p = sc[kp][j] > -1e29f ? FEXP(sc[kp][j] - mx) : 0.f; sc[kp][j] = p; den += p; }
        den = xlane_sum4(den, lane);
        f32x4 o[4];
#pragma unroll
        for (int et = 0; et < 4; ++et) o[et] = (f32x4){0.f, 0.f, 0.f, 0.f};
#pragma unroll
        for (int u = 0; u < 5; ++u) {
            const unsigned p0 = cvtpk(sc[2 * u][0], sc[2 * u][1]), p1 = cvtpk(sc[2 * u][2], sc[2 * u][3]);
            const unsigned p2 = u < 4 ? cvtpk(sc[u < 4 ? 2 * u + 1 : 8][0], sc[u < 4 ? 2 * u + 1 : 8][1]) : 0u, p3 = u < 4 ? cvtpk(sc[u < 4 ? 2 * u + 1 : 8][2], sc[u < 4 ? 2 * u + 1 : 8][3]) : 0u;
            const bf16x8 pf = __builtin_bit_cast(bf16x8, (v4u){p0, p1, p2, p3});
            const int r0 = 16 * (w + 2 * u), r1 = 16 * (w + (u < 4 ? 2 * u + 1 : 2 * u));
#pragma unroll
            for (int et = 0; et < 4; ++et) { const s16x4 a = tr4(Vs, DIL_LD, r0 + 4 * fq, 16 * et, fr), bq = tr4(Vs, DIL_LD, r1 + 4 * fq, 16 * et, fr);
                o[et] = MMA16(((bf16x8){a[0], a[1], a[2], a[3], bq[0], bq[1], bq[2], bq[3]}), pf, o[et]); }
        }
        const float inv = 1.f / den; const size_t t = (size_t)b * SEQ + (size_t)qi * dil + g;
        bf16* op = dpo + ((size_t)br * T + t) * 512 + h * 64 + 4 * fq;
#pragma unroll
        for (int et = 0; et < 4; ++et) { v2u pk; pk.x = cvtpk(o[et][0] * inv, o[et][1] * inv); pk.y = cvtpk(o[et][2] * inv, o[et][3] * inv); *(GAS v2u*)(op + 16 * et) = pk; }
        if (fq == 0) { float* mp = dml + (((size_t)br * T + t) * 8 + h) * 2; mp[0] = mx; mp[1] = den; }
    }
}

constexpr int RET_LD = 72, RET1_TEAM_BYTES = 3 * 128 * RET_LD * 2;
static_assert(2 * RET1_TEAM_BYTES <= RING_BYTES && (3 * 128 + 2 * 64) * RET_LD * 2 <= RING_BYTES, "retention LDS");
__device__ __forceinline__ void ret_kv_phase(LAS unsigned char* lds, const bf16* proj, const float* gam, float* rkv, const int tid, const int bid, const int G) {
    const int lane = tid & 63, wave = RFL(tid >> 6), team = wave >> 2, w = wave & 3, tt = tid & 255, fr = lane & 15, fq = lane >> 4;
    LAS bf16* Kf = (LAS bf16*)(lds + team * RET1_TEAM_BYTES); LAS bf16* Kb = Kf + 128 * RET_LD; LAS bf16* Vs = Kb + 128 * RET_LD;
    constexpr int NITEMS = BATCH * 8 * NC;
    for (int it0 = bid * 2; it0 < NITEMS; it0 += G * 2) {
        const int it = it0 + team; const int ch = it % NC, h = (it / NC) & 7, b = it / (NC * 8);
        const float lgf = logsigmoidf_(gam[h]), lgb = logsigmoidf_(gam[8 + h]);
        const bf16* base = proj + ((size_t)b * SEQ + (size_t)ch * 128) * NPROJ + OFF_A + h * 64;
        LBAR();
#pragma unroll
        for (int c = tt; c < 1024; c += 256) { const int m = c >> 3, cc = c & 7;
            const v4u kv = *(const GAS v4u*)(base + (size_t)m * NPROJ + 512 + cc * 8), vv = *(const GAS v4u*)(base + (size_t)m * NPROJ + 1024 + cc * 8);
            float f[8]; unpack8(kv, f); const float df = FEXP(lgf * (float)(127 - m)), db = FEXP(lgb * (float)m);
            *(LAS v4u*)(Kf + m * RET_LD + cc * 8) = (v4u){cvtpk(f[0] * df, f[1] * df), cvtpk(f[2] * df, f[3] * df), cvtpk(f[4] * df, f[5] * df), cvtpk(f[6] * df, f[7] * df)};
            *(LAS v4u*)(Kb + m * RET_LD + cc * 8) = (v4u){cvtpk(f[0] * db, f[1] * db), cvtpk(f[2] * db, f[3] * db), cvtpk(f[4] * db, f[5] * db), cvtpk(f[6] * db, f[7] * db)};
            *(LAS v4u*)(Vs + m * RET_LD + cc * 8) = vv; }
        LBAR();
        f32x4 aF[4], aB[4];
#pragma unroll
        for (int dt = 0; dt < 4; ++dt) { aF[dt] = (f32x4){0.f, 0.f, 0.f, 0.f}; aB[dt] = aF[dt]; }
#pragma unroll
        for (int ks = 0; ks < 4; ++ks) { const bf16x8 a = frag_col(Vs, RET_LD, 32 * ks, 16 * w, fr, fq);
#pragma unroll
            for (int dt = 0; dt < 4; ++dt) { aF[dt] = MMA16(a, frag_col(Kf, RET_LD, 32 * ks, 16 * dt, fr, fq), aF[dt]); aB[dt] = MMA16(a, frag_col(Kb, RET_LD, 32 * ks, 16 * dt, fr, fq), aB[dt]); } }
        float* oF = rkv + ((size_t)((b * 8 + h) * 2 + 0) * NC + ch) * 4096; float* oB = rkv + ((size_t)((b * 8 + h) * 2 + 1) * NC + ch) * 4096;
#pragma unroll
        for (int dt = 0; dt < 4; ++dt)
#pragma unroll
            for (int j = 0; j < 4; ++j) { const int e = 16 * w + 4 * fq + j, d = 16 * dt + fr; oF[e * 64 + d] = aF[dt][j]; oB[e * 64 + d] = aB[dt][j]; }
    }
}
__device__ __forceinline__ void ret_out_phase(LAS unsigned char* lds, const bf16* proj, const float* gam, const float* ret_g, const float* rsp, bf16* ycat, const int tid, const int bid, const int G) {
    const int lane = tid & 63, w = RFL(tid >> 6), fr = lane & 15, fq = lane >> 4;
    LAS bf16* Qs = (LAS bf16*)lds; LAS bf16* Ks = Qs + 128 * RET_LD; LAS bf16* Vs = Ks + 128 * RET_LD; LAS bf16* Sf = Vs + 128 * RET_LD; LAS bf16* Sb = Sf + 64 * RET_LD;
    constexpr int NITEMS = BATCH * 8 * NC;
    for (int it = bid; it < NITEMS; it += G) {
        const int ch = it % NC, h = (it / NC) & 7, b = it / (NC * 8);
        const float lgf = logsigmoidf_(gam[h]), lgb = logsigmoidf_(gam[8 + h]);
        const size_t t0 = (size_t)b * SEQ + (size_t)ch * 128;
        const bf16* base = proj + t0 * NPROJ + OFF_A + h * 64;
        const float* gSf = rsp + ((size_t)((b * 8 + h) * 2 + 0) * NC + ch) * 4096; const float* gSb = rsp + ((size_t)((b * 8 + h) * 2 + 1) * NC + ch) * 4096;
        LBAR();
#pragma unroll
        for (int c = tid; c < 1024; c += 512) { const int m = c >> 3, cc = c & 7; const bf16* rp = base + (size_t)m * NPROJ + cc * 8;
            *(LAS v4u*)(Qs + m * RET_LD + cc * 8) = *(const GAS v4u*)(rp); *(LAS v4u*)(Ks + m * RET_LD + cc * 8) = *(const GAS v4u*)(rp + 512); *(LAS v4u*)(Vs + m * RET_LD + cc * 8) = *(const GAS v4u*)(rp + 1024); }
#pragma unroll
        for (int c = tid; c < 1024; c += 512) { const int e = c >> 4, d4 = (c & 15) * 4; const f32x4 a = *(const GAS f32x4*)(gSf + e * 64 + d4), bb = *(const GAS f32x4*)(gSb + e * 64 + d4);
            *(LAS v2u*)(Sf + e * RET_LD + d4) = (v2u){cvtpk(a.x, a.y), cvtpk(a.z, a.w)}; *(LAS v2u*)(Sb + e * RET_LD + d4) = (v2u){cvtpk(bb.x, bb.y), cvtpk(bb.z, bb.w)}; }
        LBAR();
        bf16x8 qf[2];
#pragma unroll
        for (int ks = 0; ks < 2; ++ks) qf[ks] = frag_row(Qs, RET_LD, 16 * w, 32 * ks, fr, fq);
        f32x4 sc[8];
#pragma unroll
        for (int kt = 0; kt < 8; ++kt) { sc[kt] = (f32x4){0.f, 0.f, 0.f, 0.f};
#pragma unroll
            for (int ks = 0; ks < 2; ++ks) sc[kt] = MMA16(frag_row(Ks, RET_LD, 16 * kt, 32 * ks, fr, fq), qf[ks], sc[kt]); }
        const int n = 16 * w + fr;
#pragma unroll
        for (int kt = 0; kt < 8; ++kt)
#pragma unroll
            for (int j = 0; j < 4; ++j) { const int m = 16 * kt + 4 * fq + j; sc[kt][j] *= m <= n ? FEXP(lgf * (float)(n - m)) : FEXP(lgb * (float)(m - n)); }
        f32x4 o[4], aF[4], aB[4];
#pragma unroll
        for (int et = 0; et < 4; ++et) { o[et] = (f32x4){0.f, 0.f, 0.f, 0.f}; aF[et] = o[et]; aB[et] = o[et]; }
#pragma unroll
        for (int u = 0; u < 4; ++u) {
            const bf16x8 pf = __builtin_bit_cast(bf16x8, (v4u){cvtpk(sc[2 * u][0], sc[2 * u][1]), cvtpk(sc[2 * u][2], sc[2 * u][3]), cvtpk(sc[2 * u + 1][0], sc[2 * u + 1][1]), cvtpk(sc[2 * u + 1][2], sc[2 * u + 1][3])});
#pragma unroll
            for (int et = 0; et < 4; ++et) { const s16x4 a = tr4(Vs, RET_LD, 32 * u + 4 * fq, 16 * et, fr), bq = tr4(Vs, RET_LD, 32 * u + 16 + 4 * fq, 16 * et, fr);
                o[et] = MMA16(((bf16x8){a[0], a[1], a[2], a[3], bq[0], bq[1], bq[2], bq[3]}), pf, o[et]); }
        }
#pragma unroll
        for (int et = 0; et < 4; ++et)
#pragma unroll
            for (int ks = 0; ks < 2; ++ks) { aF[et] = MMA16(frag_row(Sf, RET_LD, 16 * et, 32 * ks, fr, fq), qf[ks], aF[et]); aB[et] = MMA16(frag_row(Sb, RET_LD, 16 * et, 32 * ks, fr, fq), qf[ks], aB[et]); }
        const float qdf = FEXP(lgf * (float)(n + 1)), qdb = FEXP(lgb * (float)(128 - n));
        float mu = 0.f;
#pragma unroll
        for (int et = 0; et < 4; ++et)
#pragma unroll
            for (int j = 0; j < 4; ++j) { o[et][j] += qdf * aF[et][j] + qdb * aB[et][j]; mu += o[et][j]; }
        mu = xlane_sum4(mu, lane) * (1.f / 64.f);
        float var = 0.f;
#pragma unroll
        for (int et = 0; et < 4; ++et)
#pragma unroll
            for (int j = 0; j < 4; ++j) { const float dlt = o[et][j] - mu; var += dlt * dlt; }
        const float rstd = 1.f / sqrtf(xlane_sum4(var, lane) * (1.f / 64.f) + GN_EPS);
        const bf16* gp = proj + (t0 + n) * NPROJ + OFF_A + 1536 + h * 64 + 4 * fq; bf16* yp = ycat + (t0 + n) * 2048 + h * 64 + 4 * fq; const float* gg = ret_g + h * 64 + 4 * fq;
#pragma unroll
        for (int et = 0; et < 4; ++et) { const v2u gv = *(const GAS v2u*)(gp + 16 * et); const f32x4 gn = *(const GAS f32x4*)(gg + 16 * et);
            const float g0 = __builtin_bit_cast(float, gv.x << 16), g1 = __builtin_bit_cast(float, gv.x & 0xffff0000u), g2 = __builtin_bit_cast(float, gv.y << 16), g3 = __builtin_bit_cast(float, gv.y & 0xffff0000u);
            const float y0 = siluf_(g0) * ((o[et][0] - mu) * rstd * gn.x), y1 = siluf_(g1) * ((o[et][1] - mu) * rstd * gn.y), y2 = siluf_(g2) * ((o[et][2] - mu) * rstd * gn.z), y3 = siluf_(g3) * ((o[et][3] - mu) * rstd * gn.w);
            *(GAS v2u*)(yp + 16 * et) = (v2u){cvtpk(y0, y1), cvtpk(y2, y3)}; }
    }
}
constexpr int SGU_LDV = 72, SGU_LDW = 136, SGU_TEAM_BYTES = (128 * SGU_LDV + 128 * SGU_LDW) * 2;
static_assert(2 * SGU_TEAM_BYTES <= RING_BYTES, "SGU LDS");
__device__ __forceinline__ void sgu_phase(LAS unsigned char* lds, const bf16* proj, const float* sgu_w, const float* sgu_bias, bf16* ycat, const int tid, const int bid, const int G) {
    const int lane = tid & 63, wave = RFL(tid >> 6), team = wave >> 2, w = wave & 3, tt = tid & 255, fr = lane & 15, fq = lane >> 4;
    LAS bf16* Vn = (LAS bf16*)(lds + team * SGU_TEAM_BYTES); LAS bf16* Ws = Vn + 128 * SGU_LDV;
    constexpr int NITEMS = BATCH * NC * 8;
    for (int it0 = bid * 2; it0 < NITEMS; it0 += G * 2) {
        const int it = it0 + team; const int bc = it % (BATCH * NC), g = it / (BATCH * NC);
        const size_t t0 = (size_t)bc * 128;
        const bf16* vb = proj + t0 * NPROJ + OFF_C + 512 + g * 64; const float* wsrc = sgu_w + (size_t)g * 128 * 128;
        LBAR();
#pragma unroll
        for (int c = tt; c < 1024; c += 256) { const int q = c >> 3, cc = c & 7; *(LAS v4u*)(Vn + q * SGU_LDV + cc * 8) = *(const GAS v4u*)(vb + (size_t)q * NPROJ + cc * 8); }
#pragma unroll
        for (int c = tt; c < 4096; c += 256) { const int p = c >> 5, q4 = (c & 31) * 4; const f32x4 a = *(const GAS f32x4*)(wsrc + p * 128 + q4); *(LAS v2u*)(Ws + p * SGU_LDW + q4) = (v2u){cvtpk(a.x, a.y), cvtpk(a.z, a.w)}; }
        LBAR();
        f32x4 acc[2][4];
#pragma unroll
        for (int i = 0; i < 2; ++i)
#pragma unroll
            for (int dt = 0; dt < 4; ++dt) acc[i][dt] = (f32x4){0.f, 0.f, 0.f, 0.f};
#pragma unroll
        for (int ks = 0; ks < 4; ++ks) { bf16x8 a[4];
#pragma unroll
            for (int dt = 0; dt < 4; ++dt) a[dt] = frag_col(Vn, SGU_LDV, 32 * ks, 16 * dt, fr, fq);
#pragma unroll
            for (int i = 0; i < 2; ++i) { const bf16x8 bfr = frag_row(Ws, SGU_LDW, 16 * (2 * w + i), 32 * ks, fr, fq);
#pragma unroll
                for (int dt = 0; dt < 4; ++dt) acc[i][dt] = MMA16(a[dt], bfr, acc[i][dt]); } }
#pragma unroll
        for (int i = 0; i < 2; ++i) { const int p = 16 * (2 * w + i) + fr; const float bias = sgu_bias[g * 128 + p];
            const bf16* up = proj + (t0 + p) * NPROJ + OFF_C + g * 64 + 4 * fq; bf16* yp = ycat + (t0 + p) * 2048 + 1024 + g * 64 + 4 * fq;
#pragma unroll
            for (int dt = 0; dt < 4; ++dt) { const v2u uv = *(const GAS v2u*)(up + 16 * dt);
                const float u0 = __builtin_bit_cast(float, uv.x << 16), u1 = __builtin_bit_cast(float, uv.x & 0xffff0000u), u2 = __builtin_bit_cast(float, uv.y << 16), u3 = __builtin_bit_cast(float, uv.y & 0xffff0000u);
                *(GAS v2u*)(yp + 16 * dt) = (v2u){cvtpk(geluf_(u0) * (acc[i][dt][0] + bias), geluf_(u1) * (acc[i][dt][1] + bias)), cvtpk(geluf_(u2) * (acc[i][dt][2] + bias), geluf_(u3) * (acc[i][dt][3] + bias))}; } }
    }
}

constexpr int LO_LDL = 456, LO_LDW = 72, LO_LIN_B = 64 * LO_LDL * 2, LO_W2_B = 96 * LO_LDW * 2, LO_G2_B = 256 * LO_LDW * 2;
static_assert(LO_LIN_B + 2 * LO_W2_B + LO_G2_B <= RING_BYTES, "LoRA LDS");
__device__ __forceinline__ void rwkv_lora_phase(LAS unsigned char* lds, const Ctx& c, const int tid, const int bid, const int G) {
    const int lane = tid & 63, wave = RFL(tid >> 6), tt = wave & 3, chh = wave >> 2, fr = lane & 15, fq = lane >> 4;
    LAS bf16* LIN = (LAS bf16*)lds; LAS bf16* W2s = (LAS bf16*)(lds + LO_LIN_B); LAS bf16* A2s = (LAS bf16*)(lds + LO_LIN_B + LO_W2_B); LAS bf16* G2s = (LAS bf16*)(lds + LO_LIN_B + 2 * LO_W2_B);
    for (int blk = bid; blk < T / 64; blk += G) {
        const size_t t0 = (size_t)blk * 64;
        LBAR();
        for (int q = tid; q < 64 * 56; q += 512) { const int r = q / 56, cc = q % 56; *(LAS v4u*)(LIN + r * LO_LDL + cc * 8) = *(const GAS v4u*)(c.lin + (t0 + r) * NLORA + cc * 8); }
        f32x4 pw2[3], pa2[3], pg2[8];
#define LO_LOADW(h_) do { _Pragma("unroll") for (int u = 0; u < 3; ++u) { const int q_ = tid + 512 * u, i_ = q_ >> 4, c4_ = (q_ & 15) * 4; pw2[u] = *(const GAS f32x4*)(c.w2 + (size_t)i_ * 512 + (h_) * 64 + c4_); pa2[u] = *(const GAS f32x4*)(c.a2 + (size_t)i_ * 512 + (h_) * 64 + c4_); } \
        _Pragma("unroll") for (int u = 0; u < 8; ++u) { const int q_ = tid + 512 * u, i_ = q_ >> 4, c4_ = (q_ & 15) * 4; pg2[u] = *(const GAS f32x4*)(c.g2 + (size_t)i_ * 512 + (h_) * 64 + c4_); } } while (0)
        LO_LOADW(0);
        for (int h = 0; h < 8; ++h) {
            if (h > 0) LBAR();
#pragma unroll
            for (int u = 0; u < 3; ++u) { const int q = tid + 512 * u, i = q >> 4, c4 = (q & 15) * 4;
                *(LAS v2u*)(W2s + i * LO_LDW + c4) = (v2u){cvtpk(pw2[u].x, pw2[u].y), cvtpk(pw2[u].z, pw2[u].w)}; *(LAS v2u*)(A2s + i * LO_LDW + c4) = (v2u){cvtpk(pa2[u].x, pa2[u].y), cvtpk(pa2[u].z, pa2[u].w)}; }
#pragma unroll
            for (int u = 0; u < 8; ++u) { const int q = tid + 512 * u, i = q >> 4, c4 = (q & 15) * 4; *(LAS v2u*)(G2s + i * LO_LDW + c4) = (v2u){cvtpk(pg2[u].x, pg2[u].y), cvtpk(pg2[u].z, pg2[u].w)}; }
            LBAR();
            if (h < 7) LO_LOADW(h + 1);
            f32x4 aw[2], aa[2], ag[2];
#pragma unroll
            for (int ct = 0; ct < 2; ++ct) { aw[ct] = (f32x4){0.f, 0.f, 0.f, 0.f}; aa[ct] = aw[ct]; ag[ct] = aw[ct]; }
#pragma unroll
            for (int ks = 0; ks < 3; ++ks) { const bf16x8 fw = frag_row(LIN, LO_LDL, 16 * tt, 32 * ks, fr, fq), fa = frag_row(LIN, LO_LDL, 16 * tt, 96 + 32 * ks, fr, fq);
#pragma unroll
                for (int ct = 0; ct < 2; ++ct) { aw[ct] = MMA16(frag_col(W2s, LO_LDW, 32 * ks, 32 * chh + 16 * ct, fr, fq), fw, aw[ct]); aa[ct] = MMA16(frag_col(A2s, LO_LDW, 32 * ks, 32 * chh + 16 * ct, fr, fq), fa, aa[ct]); } }
#pragma unroll
            for (int ks = 0; ks < 8; ++ks) { const bf16x8 fg = frag_row(LIN, LO_LDL, 16 * tt, 192 + 32 * ks, fr, fq);
#pragma unroll
                for (int ct = 0; ct < 2; ++ct) ag[ct] = MMA16(frag_col(G2s, LO_LDW, 32 * ks, 32 * chh + 16 * ct, fr, fq), fg, ag[ct]); }
#pragma unroll
            for (int ct = 0; ct < 2; ++ct) { const int ch0 = h * 64 + 32 * chh + 16 * ct + 4 * fq; const size_t o = (t0 + 16 * tt + fr) * 512 + ch0;
                *(GAS v2u*)(c.gg + o) = (v2u){cvtpk(ag[ct][0], ag[ct][1]), cvtpk(ag[ct][2], ag[ct][3])};
                *(GAS v2u*)(c.kdf + o) = (v2u){cvtpk(aw[ct][0], aw[ct][1]), cvtpk(aw[ct][2], aw[ct][3])};
                *(GAS v2u*)(c.kdb + o) = (v2u){cvtpk(aa[ct][0], aa[ct][1]), cvtpk(aa[ct][2], aa[ct][3])}; }
        }
    }
}

constexpr int RWC = 32, RW_NCH = SEQ / RWC, RW_LD = 72, RW_LS = 40, RW_IN_B = 32 * RW_LD * 2, RW_SM_B = 32 * RW_LS * 2;
constexpr int RW_AH = 0, RW_BC = RW_IN_B, RW_KC = 2 * RW_IN_B, RW_RH = 3 * RW_IN_B, RW_BT = 4 * RW_IN_B, RW_KT = 5 * RW_IN_B, RW_VV = 6 * RW_IN_B, RW_M1 = 7 * RW_IN_B, RW_WW = 8 * RW_IN_B, RW_UL = 9 * RW_IN_B,
              RW_XA = 10 * RW_IN_B, RW_XB = RW_XA + RW_SM_B, RW_T0 = RW_XB + RW_SM_B, RW_T1 = RW_T0 + RW_SM_B, RW_AAK = RW_T1 + RW_SM_B, RW_ARB = RW_AAK + RW_SM_B, RW_ARK = RW_ARB + RW_SM_B, RW_SEG = RW_ARK + RW_SM_B,
              RW_TEAM_BYTES = RW_SEG + 4 * 64 * 4;
static_assert(2 * RW_TEAM_BYTES <= RING_BYTES, "RWKV chunk LDS");
__device__ __forceinline__ void st_tile_bf16(LAS bf16* X, int ld, int r0, int c0, const f32x4 v, int fr, int fq) {
#pragma unroll
    for (int j = 0; j < 4; j += 2) { const unsigned p = cvtpk(v[j], v[j + 1]); X[(r0 + 4 * fq + j) * ld + c0 + fr] = (bf16)p; X[(r0 + 4 * fq + j + 1) * ld + c0 + fr] = (bf16)(p >> 16); } }
__device__ __forceinline__ void rwkv_chunk_phase(LAS unsigned char* lds, const Ctx& c, unsigned char* ws, const int tid, const int bid, const int G) {
    const int lane = tid & 63, wave = RFL(tid >> 6), team = wave >> 2, w = wave & 3, tt = tid & 255, fr = lane & 15, fq = lane >> 4;
    LAS unsigned char* L = lds + team * RW_TEAM_BYTES;
    LAS bf16* AH = (LAS bf16*)(L + RW_AH); LAS bf16* BC = (LAS bf16*)(L + RW_BC); LAS bf16* KC = (LAS bf16*)(L + RW_KC); LAS bf16* RH = (LAS bf16*)(L + RW_RH); LAS bf16* BT = (LAS bf16*)(L + RW_BT);
    LAS bf16* KT = (LAS bf16*)(L + RW_KT); LAS bf16* VV = (LAS bf16*)(L + RW_VV); LAS bf16* M1 = (LAS bf16*)(L + RW_M1); LAS bf16* WW = (LAS bf16*)(L + RW_WW); LAS bf16* UL = (LAS bf16*)(L + RW_UL);
    LAS bf16* XA = (LAS bf16*)(L + RW_XA); LAS bf16* XB = (LAS bf16*)(L + RW_XB); LAS bf16* T0 = (LAS bf16*)(L + RW_T0); LAS bf16* T1 = (LAS bf16*)(L + RW_T1);
    LAS bf16* AAK = (LAS bf16*)(L + RW_AAK); LAS bf16* ARB = (LAS bf16*)(L + RW_ARB); LAS bf16* ARK = (LAS bf16*)(L + RW_ARK); LAS float* SEG = (LAS float*)(L + RW_SEG);
    bf16* gRB = (bf16*)(ws + WS_RB); bf16* gPT = (bf16*)(ws + WS_PT); bf16* gQF = (bf16*)(ws + WS_QF); bf16* gYL = (bf16*)(ws + WS_YL); float* gDC = (float*)(ws + WS_DC);
#ifdef RW_EMU_LIMIT
    constexpr int NITEMS = RW_EMU_LIMIT;
#else
    constexpr int NITEMS = BATCH * 16 * RW_NCH;
#endif
    const int it_ = w >> 1, jt_ = w & 1;
    const int ch = tt & 63, seg = tt >> 6;
    float lwv[8]; unsigned ksr[8], wlr[8], alr[8], rsr[8], vsr[8]; float cw0 = 0.f, ca0 = 0.f, cka = 0.f, ckk = 0.f;
#define RW_LOAD_RAW(item_) do { const int cc_ = (item_) % RW_NCH, unit_ = (item_) / RW_NCH, dir_ = unit_ & 1, h_ = (unit_ >> 1) & 7, b_ = unit_ >> 4; const size_t tb_ = (size_t)b_ * SEQ + (size_t)cc_ * RWC; \
        cw0 = c.w0[dir_ * 512 + h_ * 64 + ch]; ca0 = c.a0[dir_ * 512 + h_ * 64 + ch]; cka = c.k_a[h_ * 64 + ch]; ckk = c.k_k[h_ * 64 + ch]; \
        _Pragma("unroll") for (int r = 0; r < 8; ++r) { const int i_ = 8 * seg + r; const unsigned o_ = ((unsigned)tb_ + (unsigned)(dir_ ? 31 - i_ : i_)) * 512u + (unsigned)(h_ * 64 + ch); \
            ksr[r] = ((const GAS bf16*)c.ks)[o_]; wlr[r] = ((const GAS bf16*)c.kdf)[o_]; alr[r] = ((const GAS bf16*)c.kdb)[o_]; rsr[r] = ((const GAS bf16*)c.rs)[o_]; vsr[r] = ((const GAS bf16*)c.vs)[o_]; } } while (0)
    if (bid * 2 < NITEMS) RW_LOAD_RAW(bid * 2 + team);
    for (int it0 = bid * 2; it0 < NITEMS; it0 += G * 2) {
        const int item = it0 + team;
        LBAR();
        {
            float g[8], kv[8], av[8], kraw[8], ksq[8]; float run = 0.f;
#pragma unroll
            for (int r = 0; r < 8; ++r) { lwv[r] = -0.6065306597126334f * __builtin_amdgcn_rcpf(1.f + FEXP(-(cw0 + __builtin_bit_cast(float, wlr[r] << 16)))); run += lwv[r]; g[r] = run; }
            SEG[seg * 64 + ch] = run;
#pragma unroll
            for (int r = 0; r < 8; ++r) { kv[r] = __builtin_bit_cast(float, ksr[r] << 16); av[r] = __builtin_amdgcn_rcpf(1.f + FEXP(-(ca0 + __builtin_bit_cast(float, alr[r] << 16)))); kraw[r] = kv[r] * ckk; ksq[r] = kraw[r] * kraw[r]; }
#pragma unroll
            for (int o = 1; o < 64; o <<= 1) { float t_[8];
#pragma unroll
                for (int r = 0; r < 8; ++r) t_[r] = __builtin_bit_cast(float, __builtin_amdgcn_ds_bpermute((lane ^ o) << 2, __builtin_bit_cast(int, ksq[r])));
#pragma unroll
                for (int r = 0; r < 8; ++r) ksq[r] += t_[r]; }
            LBAR();
            float off = 0.f, GC = 0.f;
#pragma unroll
            for (int s2 = 0; s2 < 4; ++s2) { const float v = SEG[s2 * 64 + ch]; off += s2 < seg ? v : 0.f; GC += v; }
            const float eGC = FEXP(GC);
            if (seg == 0) gDC[(size_t)item * 64 + ch] = eGC;
            float ePrev = FEXP(off);
#pragma unroll
            for (int r = 0; r < 8; r += 2) { float oa[2], ob[2], ok[2], orr[2], obt[2], okt[2];
#pragma unroll
                for (int u = 0; u < 2; ++u) { const int q = r + u;
                    const float eG = FEXP(off + g[q]), eI = __builtin_amdgcn_rcpf(eG), eM = ePrev, eC = eGC * eI; ePrev = eG;
                    const float kk = kraw[q] * __builtin_amdgcn_rsqf(ksq[q] + 1e-12f);
                    const float be = av[q] * kk, kt = kv[q] * (1.f + (av[q] - 1.f) * cka), rr = __builtin_bit_cast(float, rsr[q] << 16);
                    oa[u] = -kk * eM; ob[u] = be * eI; ok[u] = kt * eI; orr[u] = rr * eG; obt[u] = be * eC; okt[u] = kt * eC; }
                const int i = 8 * seg + r; const unsigned pa = cvtpk(oa[0], oa[1]), pb = cvtpk(ob[0], ob[1]), pk = cvtpk(ok[0], ok[1]), pr = cvtpk(orr[0], orr[1]), pbt = cvtpk(obt[0], obt[1]), pkt = cvtpk(okt[0], okt[1]);
                AH[i * RW_LD + ch] = (bf16)pa; AH[(i + 1) * RW_LD + ch] = (bf16)(pa >> 16); BC[i * RW_LD + ch] = (bf16)pb; BC[(i + 1) * RW_LD + ch] = (bf16)(pb >> 16);
                KC[i * RW_LD + ch] = (bf16)pk; KC[(i + 1) * RW_LD + ch] = (bf16)(pk >> 16); RH[i * RW_LD + ch] = (bf16)pr; RH[(i + 1) * RW_LD + ch] = (bf16)(pr >> 16);
                BT[i * RW_LD + ch] = (bf16)pbt; BT[(i + 1) * RW_LD + ch] = (bf16)(pbt >> 16); KT[i * RW_LD + ch] = (bf16)pkt; KT[(i + 1) * RW_LD + ch] = (bf16)(pkt >> 16);
                VV[i * RW_LD + ch] = (bf16)vsr[r]; VV[(i + 1) * RW_LD + ch] = (bf16)vsr[r + 1]; }
        }
        if (it0 + G * 2 < NITEMS) RW_LOAD_RAW(it0 + G * 2 + team);
        LBAR();
        {
            const LAS bf16* As = w < 2 ? AH : RH; const LAS bf16* Bs = (w & 1) ? KC : BC; LAS bf16* D = w == 0 ? XA : (w == 1 ? AAK : (w == 2 ? ARB : ARK));
#pragma unroll
            for (int it = 0; it < 2; ++it)
#pragma unroll
                for (int jt = 0; jt < 2; ++jt) { f32x4 a = (f32x4){0.f, 0.f, 0.f, 0.f};
#pragma unroll
                    for (int ks = 0; ks < 2; ++ks) a = MMA16(frag_row(As, RW_LD, 16 * it, 32 * ks, fr, fq), frag_row(Bs, RW_LD, 16 * jt, 32 * ks, fr, fq), a);
#pragma unroll
                    for (int j = 0; j < 4; ++j) { const int i = 16 * it + 4 * fq + j, jj = 16 * jt + fr; const bool keep = w < 2 ? jj < i : jj <= i; a[j] = keep ? a[j] : 0.f; }
                    st_tile_bf16(D, RW_LS, 16 * it, 16 * jt, a, fr, fq); }
        }
        LBAR();
        f32x4 Tacc;
        {
            const f32x4 x2 = MMA16(frag_row(XA, RW_LS, 16 * it_, 0, fr, fq), frag_col(XA, RW_LS, 0, 16 * jt_, fr, fq), ((f32x4){0.f, 0.f, 0.f, 0.f}));
            st_tile_bf16(XB, RW_LS, 16 * it_, 16 * jt_, x2, fr, fq);
#pragma unroll
            for (int j = 0; j < 4; ++j) { const int i = 16 * it_ + 4 * fq + j, jj = 16 * jt_ + fr; Tacc[j] = bf2f(XA[i * RW_LS + jj]) + (i == jj ? 1.f : 0.f); }
            st_tile_bf16(T0, RW_LS, 16 * it_, 16 * jt_, Tacc, fr, fq);
#pragma unroll
            for (int q = 0; q < 2; ++q) { const int et = 2 * jt_ + q; const f32x4 m1 = MMA16(frag_row(AAK, RW_LS, 16 * it_, 0, fr, fq), frag_col(VV, RW_LD, 0, 16 * et, fr, fq), ((f32x4){0.f, 0.f, 0.f, 0.f}));
                st_tile_bf16(M1, RW_LD, 16 * it_, 16 * et, m1, fr, fq); }
        }
        LBAR();
#define RW_CHAIN(TR, TW, XR, XW, SQUARE) { Tacc = MMA16(frag_row(TR, RW_LS, 16 * it_, 0, fr, fq), frag_col(XR, RW_LS, 0, 16 * jt_, fr, fq), Tacc); st_tile_bf16(TW, RW_LS, 16 * it_, 16 * jt_, Tacc, fr, fq); \
        if (SQUARE) { const f32x4 xx = MMA16(frag_row(XR, RW_LS, 16 * it_, 0, fr, fq), frag_col(XR, RW_LS, 0, 16 * jt_, fr, fq), ((f32x4){0.f, 0.f, 0.f, 0.f})); st_tile_bf16(XW, RW_LS, 16 * it_, 16 * jt_, xx, fr, fq); } \
        LBAR(); }
        RW_CHAIN(T0, T1, XB, XA, true)
        RW_CHAIN(T1, T0, XA, XB, true)
        RW_CHAIN(T0, T1, XB, XA, true)
        RW_CHAIN(T1, T0, XA, XB, false)
#undef RW_CHAIN
        {
            const bf16x8 tf = frag_row(T0, RW_LS, 16 * it_, 0, fr, fq);
#pragma unroll
            for (int q = 0; q < 2; ++q) { const int ct = 2 * jt_ + q;
                st_tile_bf16(WW, RW_LD, 16 * it_, 16 * ct, MMA16(tf, frag_col(AH, RW_LD, 0, 16 * ct, fr, fq), ((f32x4){0.f, 0.f, 0.f, 0.f})), fr, fq);
                st_tile_bf16(UL, RW_LD, 16 * it_, 16 * ct, MMA16(tf, frag_col(M1, RW_LD, 0, 16 * ct, fr, fq), ((f32x4){0.f, 0.f, 0.f, 0.f})), fr, fq); }
        }
        LBAR();
        {
            const bf16x8 wcol = frag_col(WW, RW_LD, 0, 16 * w, fr, fq), ulc = frag_col(UL, RW_LD, 0, 16 * w, fr, fq), vvc = frag_col(VV, RW_LD, 0, 16 * w, fr, fq);
            bf16* pt = gPT + (size_t)item * 4096; bf16* qf = gQF + (size_t)item * 4096; bf16* rb = gRB + (size_t)item * 2048; bf16* yl = gYL + (size_t)item * 2048;
#pragma unroll
            for (int kq = 0; kq < 4; ++kq) { const bf16x8 btc = frag_col(BT, RW_LD, 0, 16 * kq, fr, fq), ktc = frag_col(KT, RW_LD, 0, 16 * kq, fr, fq);
                const f32x4 p = MMA16(wcol, btc, ((f32x4){0.f, 0.f, 0.f, 0.f}));
                *(GAS v2u*)(pt + ((kq * 2 + (w >> 1)) * 64 + lane) * 8 + (w & 1) * 4) = (v2u){cvtpk(p[0], p[1]), cvtpk(p[2], p[3])};
                f32x4 q = MMA16(btc, ulc, ((f32x4){0.f, 0.f, 0.f, 0.f})); q = MMA16(ktc, vvc, q);
                *(GAS v2u*)(qf + ((w * 4 + kq) * 64 + lane) * 4) = (v2u){cvtpk(q[0], q[1]), cvtpk(q[2], q[3])}; }
#pragma unroll
            for (int it = 0; it < 2; ++it) { const bf16x8 arb = frag_row(ARB, RW_LS, 16 * it, 0, fr, fq), ark = frag_row(ARK, RW_LS, 16 * it, 0, fr, fq);
                const f32x4 r = MMA16(wcol, arb, ((f32x4){0.f, 0.f, 0.f, 0.f}));
                const v2u rh = *(const LAS v2u*)(RH + (16 * it + fr) * RW_LD + 16 * w + 4 * fq);
                const float r0 = r[0] + __builtin_bit_cast(float, rh.x << 16), r1 = r[1] + __builtin_bit_cast(float, rh.x & 0xffff0000u), r2 = r[2] + __builtin_bit_cast(float, rh.y << 16), r3 = r[3] + __builtin_bit_cast(float, rh.y & 0xffff0000u);
                *(GAS v2u*)(rb + ((it * 2 + (w >> 1)) * 64 + lane) * 8 + (w & 1) * 4) = (v2u){cvtpk(r0, r1), cvtpk(r2, r3)};
                f32x4 y = MMA16(arb, ulc, ((f32x4){0.f, 0.f, 0.f, 0.f})); y = MMA16(ark, vvc, y);
                *(GAS v2u*)(yl + ((it * 4 + w) * 64 + lane) * 4) = (v2u){cvtpk(y[0], y[1]), cvtpk(y[2], y[3])}; }
        }
    }
}
struct RwS { v4u pt[4][2]; v2u q[4]; f32x4 dc[4]; };
__device__ __forceinline__ void rws_load(RwS& s, const unsigned char* ws, int item, int vb, int lane, int fr, int fq) {
    const bf16* pt = (const bf16*)(ws + WS_PT) + (size_t)item * 4096; const bf16* qf = (const bf16*)(ws + WS_QF) + (size_t)item * 4096; const float* dc = (const float*)(ws + WS_DC) + (size_t)item * 64;
#pragma unroll
    for (int kq = 0; kq < 4; ++kq) {
#pragma unroll
        for (int ks = 0; ks < 2; ++ks) s.pt[kq][ks] = *(const GAS v4u*)(pt + ((kq * 2 + ks) * 64 + lane) * 8);
        s.q[kq] = *(const GAS v2u*)(qf + ((vb * 4 + kq) * 64 + lane) * 4); s.dc[kq] = *(const GAS f32x4*)(dc + 16 * kq + 4 * fq); }
}
constexpr int RWS_RING = 8, RWS_SLOT_B = 4 * 64 * 8, RWS_RING_B = RWS_RING * RWS_SLOT_B;
__device__ __forceinline__ unsigned lds_ld(const LAS unsigned* p) { return __hip_atomic_load(p, __ATOMIC_RELAXED, __HIP_MEMORY_SCOPE_WORKGROUP); }
__device__ __forceinline__ void lds_st(LAS unsigned* p, unsigned v) { __hip_atomic_store(p, v, __ATOMIC_RELAXED, __HIP_MEMORY_SCOPE_WORKGROUP); }
__device__ __forceinline__ void rws_step(const RwS& s, f32x4 (&S)[4], LAS unsigned char* ring, LAS unsigned* prog, const LAS unsigned* done, int step, int lane) {
    v2u sp[4];
    if (step >= RWS_RING) { while (lds_ld(done) + RWS_RING <= (unsigned)step) __builtin_amdgcn_s_sleep(1); }
#pragma unroll
    for (int kq = 0; kq < 4; ++kq) { sp[kq] = (v2u){cvtpk(S[kq][0], S[kq][1]), cvtpk(S[kq][2], S[kq][3])}; *(LAS v2u*)(ring + (step % RWS_RING) * RWS_SLOT_B + (kq * 64 + lane) * 8) = sp[kq]; }
    LDS_WAIT_();
    if (lane == 0) lds_st(prog, (unsigned)step + 1u);
#pragma unroll
    for (int kq = 0; kq < 4; ++kq) { f32x4 a;
        a[0] = S[kq][0] * s.dc[kq][0] + __builtin_bit_cast(float, s.q[kq].x << 16); a[1] = S[kq][1] * s.dc[kq][1] + __builtin_bit_cast(float, s.q[kq].x & 0xffff0000u);
        a[2] = S[kq][2] * s.dc[kq][2] + __builtin_bit_cast(float, s.q[kq].y << 16); a[3] = S[kq][3] * s.dc[kq][3] + __builtin_bit_cast(float, s.q[kq].y & 0xffff0000u);
#pragma unroll
        for (int ks = 0; ks < 2; ++ks) a = MMA16(__builtin_bit_cast(bf16x8, s.pt[kq][ks]), __builtin_bit_cast(bf16x8, (v4u){sp[2 * ks].x, sp[2 * ks].y, sp[2 * ks + 1].x, sp[2 * ks + 1].y}), a);
        S[kq] = a; }
}
__device__ __forceinline__ void rwkv_sscan_phase(LAS unsigned char* lds, unsigned char* ws, const int unit, const int wave, const int lane) {
    const int vb = wave & 3, fr = lane & 15, fq = lane >> 4, dir = unit & 1;
    LAS unsigned char* ring = lds + vb * RWS_RING_B; LAS unsigned* prog = (LAS unsigned*)(lds + 4 * RWS_RING_B) + vb * 16; LAS unsigned* done = prog + 8;
#define RW_CL(st) ((st) < RW_NCH ? (st) : RW_NCH - 1)
#define RW_ITEM(st) (unit * RW_NCH + (dir ? RW_NCH - 1 - RW_CL(st) : RW_CL(st)))
    if (wave >= 4) {
        for (int st = 0; st < RW_NCH; ++st) {
            while (lds_ld(prog) <= (unsigned)st) __builtin_amdgcn_s_sleep(1);
            bf16* dst = (bf16*)(ws + WS_ST) + (size_t)RW_ITEM(st) * 4096;
#pragma unroll
            for (int kq = 0; kq < 4; ++kq) *(GAS v2u*)(dst + ((vb * 4 + kq) * 64 + lane) * 4) = *(const LAS v2u*)(ring + (st % RWS_RING) * RWS_SLOT_B + (kq * 64 + lane) * 8);
            LDS_WAIT_();
            if (lane == 0) lds_st(done, (unsigned)st + 1u);
        }
        return;
    }
    f32x4 S[4];
#pragma unroll
    for (int kq = 0; kq < 4; ++kq) S[kq] = (f32x4){0.f, 0.f, 0.f, 0.f};
    RwS A, B, C;
    rws_load(A, ws, RW_ITEM(0), vb, lane, fr, fq); rws_load(B, ws, RW_ITEM(1), vb, lane, fr, fq);
#define RW_STEP3(st) do { rws_load(C, ws, RW_ITEM((st) + 2), vb, lane, fr, fq); rws_step(A, S, ring, prog, done, (st), lane); \
        rws_load(A, ws, RW_ITEM((st) + 3), vb, lane, fr, fq); rws_step(B, S, ring, prog, done, (st) + 1, lane); \
        rws_load(B, ws, RW_ITEM((st) + 4), vb, lane, fr, fq); rws_step(C, S, ring, prog, done, (st) + 2, lane); } while (0)
    constexpr int RW_MAIN = RW_NCH / 6 * 6, RW_MAIN3 = RW_NCH / 3 * 3;
#pragma unroll 1
    for (int st = 0; st < RW_MAIN; st += 6) { RW_STEP3(st); RW_STEP3(st + 3); }
#pragma unroll 1
    for (int st = RW_MAIN; st < RW_MAIN3; st += 3) RW_STEP3(st);
#undef RW_STEP3
    if (RW_NCH - RW_MAIN3 >= 1) rws_step(A, S, ring, prog, done, RW_MAIN3, lane);
    if (RW_NCH - RW_MAIN3 >= 2) rws_step(B, S, ring, prog, done, RW_MAIN3 + 1, lane);
#undef RW_ITEM
#undef RW_CL
}
__device__ __forceinline__ void rwkv_yfin_phase(LAS unsigned char* lds, const Ctx& c, const unsigned char* ws, const int tid, const int bid, const int G) {
    const int lane = tid & 63, wave = RFL(tid >> 6), fr = lane & 15, fq = lane >> 4; const int gw = bid * 8 + wave, NGW = G * 8;
    LAS float* Yt = (LAS float*)(lds + wave * 16384);
    for (int job = gw; job < BATCH * 8 * RW_NCH; job += NGW) {
        const int cc = job % RW_NCH, bh = job / RW_NCH, h = bh & 7, b = bh >> 3; const size_t tb = (size_t)b * SEQ + (size_t)cc * RWC;
        f32x4 y[2][4];
#pragma unroll
        for (int dir = 0; dir < 2; ++dir) { const int item = (bh * 2 + dir) * RW_NCH + cc;
            const bf16* rb = (const bf16*)(ws + WS_RB) + (size_t)item * 2048; const bf16* yl = (const bf16*)(ws + WS_YL) + (size_t)item * 2048; const bf16* st = (const bf16*)(ws + WS_ST) + (size_t)item * 4096;
#pragma unroll
            for (int it = 0; it < 2; ++it) {
                const int rt = dir ? 1 - it : it, rl = dir ? (15 - fr) + 16 * fq : lane;
                bf16x8 af[2];
#pragma unroll
                for (int ks = 0; ks < 2; ++ks) af[ks] = __builtin_bit_cast(bf16x8, *(const GAS v4u*)(rb + ((rt * 2 + ks) * 64 + rl) * 8));
#pragma unroll
                for (int vb = 0; vb < 4; ++vb) {
                    f32x4 a;
                    if (dir == 0) { const v2u w = *(const GAS v2u*)(yl + ((it * 4 + vb) * 64 + lane) * 4);
                        a = (f32x4){__builtin_bit_cast(float, w.x << 16), __builtin_bit_cast(float, w.x & 0xffff0000u), __builtin_bit_cast(float, w.y << 16), __builtin_bit_cast(float, w.y & 0xffff0000u)}; }
                    else { const v2u w = *(const GAS v2u*)(yl + (((1 - it) * 4 + vb) * 64 + fr + 16 * (3 - fq)) * 4);
                        a = y[it][vb]; a[0] += __builtin_bit_cast(float, w.y & 0xffff0000u); a[1] += __builtin_bit_cast(float, w.y << 16); a[2] += __builtin_bit_cast(float, w.x & 0xffff0000u); a[3] += __builtin_bit_cast(float, w.x << 16); }
#pragma unroll
                    for (int ks = 0; ks < 2; ++ks) { const v2u s0 = *(const GAS v2u*)(st + ((vb * 4 + 2 * ks) * 64 + lane) * 4), s1 = *(const GAS v2u*)(st + ((vb * 4 + 2 * ks + 1) * 64 + lane) * 4);
                        a = MMA16(af[ks], __builtin_bit_cast(bf16x8, (v4u){s0.x, s0.y, s1.x, s1.y}), a); }
                    y[it][vb] = a; } } }
#pragma unroll
        for (int it = 0; it < 2; ++it)
#pragma unroll
            for (int vb = 0; vb < 4; ++vb)
#pragma unroll
                for (int j = 0; j < 4; ++j) Yt[(16 * it + 4 * fq + j) * 68 + 16 * vb + fr] = y[it][vb][j];
        LDS_WAIT_();
#pragma unroll
        for (int q = 0; q < 4; ++q) { const int e = lane + 64 * q, r = e >> 3, cg8 = e & 7; const size_t o = (tb + r) * 512 + h * 64 + cg8 * 8;
            const f32x4 y0 = *(const LAS f32x4*)(Yt + r * 68 + cg8 * 8), y1 = *(const LAS f32x4*)(Yt + r * 68 + cg8 * 8 + 4); float yv[8] = {y0.x, y0.y, y0.z, y0.w, y1.x, y1.y, y1.z, y1.w};
            float rr[8], k[8], v[8], g[8]; unpack8(*(const GAS v4u*)(c.rs + o), rr); unpack8(*(const GAS v4u*)(c.ks + o), k); unpack8(*(const GAS v4u*)(c.vs + o), v); unpack8(*(const GAS v4u*)(c.gg + o), g);
            float s = 0.f, bon = 0.f;
#pragma unroll
            for (int i = 0; i < 8; ++i) { s += yv[i]; bon += rr[i] * k[i] * c.r_k[h * 64 + cg8 * 8 + i]; }
            const float mu = red8(s, lane) * (1.f / 64.f); bon = red8(bon, lane); float qv = 0.f;
#pragma unroll
            for (int i = 0; i < 8; ++i) { yv[i] -= mu; qv += yv[i] * yv[i]; }
            const float rstd = 1.f / sqrtf(red8(qv, lane) * (1.f / 64.f) + GN_EPS); float out[8];
#pragma unroll
            for (int i = 0; i < 8; ++i) out[i] = (yv[i] * rstd * c.ln_g[h * 64 + cg8 * 8 + i] + bon * v[i]) * g[i];
            st8(c.ycat + (tb + r) * 2048 + 512 + h * 64 + cg8 * 8, out); }
        LDS_WAIT_();
    }
}

__device__ __forceinline__ float quad_sum(float v) {
    v += __builtin_bit_cast(float, __builtin_amdgcn_update_dpp(0, __builtin_bit_cast(int, v), 0xB1, 0xF, 0xF, true));
    v += __builtin_bit_cast(float, __builtin_amdgcn_update_dpp(0, __builtin_bit_cast(int, v), 0x4E, 0xF, 0xF, true));
    return v;
}
__device__ __forceinline__ void rwkv_scan_quad(const Ctx& c, int unit, int w4, int lane) {
    const int dir = unit & 1, h = (unit >> 1) & 7, b = unit >> 4; const int row = w4 * 16 + (lane >> 2), q = lane & 3;
    const float* W = dir ? c.wb : c.wf; const bf16* KD = dir ? c.kdb : c.kdf; const bf16* AK = dir ? c.akb : c.akf; bf16* Y = dir ? c.yb : c.yf;
    float S[16];
#pragma unroll
    for (int i = 0; i < 16; ++i) S[i] = 0.f;
    for (int k = 0; k < SEQ; ++k) {
        const int s = dir ? SEQ - 1 - k : k; const size_t o = ((size_t)b * SEQ + s) * 512 + h * 64 + q * 16;
        float kkv[16], akv[16], kdv[16], rv[16], wv[16];
        { const v4u a = *(const GAS v4u*)(c.kk + o), bq = *(const GAS v4u*)(c.kk + o + 8);
          const unsigned t[8] = {a.x, a.y, a.z, a.w, bq.x, bq.y, bq.z, bq.w};
#pragma unroll
          for (int i = 0; i < 8; ++i) { kkv[2 * i] = __builtin_bit_cast(float, t[i] << 16); kkv[2 * i + 1] = __builtin_bit_cast(float, t[i] & 0xffff0000u); } }
        { const v4u a = *(const GAS v4u*)(AK + o), bq = *(const GAS v4u*)(AK + o + 8);
          const unsigned t[8] = {a.x, a.y, a.z, a.w, bq.x, bq.y, bq.z, bq.w};
#pragma unroll
          for (int i = 0; i < 8; ++i) { akv[2 * i] = __builtin_bit_cast(float, t[i] << 16); akv[2 * i + 1] = __builtin_bit_cast(float, t[i] & 0xffff0000u); } }
        { const v4u a = *(const GAS v4u*)(KD + o), bq = *(const GAS v4u*)(KD + o + 8);
          const unsigned t[8] = {a.x, a.y, a.z, a.w, bq.x, bq.y, bq.z, bq.w};
#pragma unroll
          for (int i = 0; i < 8; ++i) { kdv[2 * i] = __builtin_bit_cast(float, t[i] << 16); kdv[2 * i + 1] = __builtin_bit_cast(float, t[i] & 0xffff0000u); } }
        { const v4u a = *(const GAS v4u*)(c.rs + o), bq = *(const GAS v4u*)(c.rs + o + 8);
          const unsigned t[8] = {a.x, a.y, a.z, a.w, bq.x, bq.y, bq.z, bq.w};
#pragma unroll
          for (int i = 0; i < 8; ++i) { rv[2 * i] = __builtin_bit_cast(float, t[i] << 16); rv[2 * i + 1] = __builtin_bit_cast(float, t[i] & 0xffff0000u); } }
#pragma unroll
        for (int i = 0; i < 4; ++i) { const f32x4 w4v = *(const GAS f32x4*)(W + o + 4 * i); wv[4 * i] = w4v.x; wv[4 * i + 1] = w4v.y; wv[4 * i + 2] = w4v.z; wv[4 * i + 3] = w4v.w; }
        const float v = bf2f(c.vs[o - q * 16 + row]);
        float sk = 0.f;
#pragma unroll
        for (int i = 0; i < 16; ++i) sk += S[i] * kkv[i];
        sk = quad_sum(sk);
        float y = 0.f;
#pragma unroll
        for (int i = 0; i < 16; ++i) { S[i] = S[i] * wv[i] - sk * akv[i] + v * kdv[i]; y += S[i] * rv[i]; }
        y = quad_sum(y);
        if (q == 0) Y[o + row] = f2bf(y);
    }
}
constexpr int MOE_ITEMS_PER_E = 2 * (DM / 64) * (DE / 64) + (DE / 64) * (DM / 64);
template <int E_LO, int E_HI, bool WITH_D>
__device__ __forceinline__ void moe_convert(const Args& args, unsigned char* ws, int ll, LAS unsigned char* lds, int wave, int lane, int it0, int stride) {
    constexpr int I_GU = (DM / 64) * (DE / 64), I_D = (DE / 64) * (DM / 64), N_GU = (E_HI - E_LO) * 2 * I_GU, it_end = N_GU + (WITH_D ? NEXP * I_D : 0);
    bf16* WdT = (bf16*)(ws + WS_WD); LAS float* scr = (LAS float*)(lds + wave * 16384);
    const float* wg_ = (const float*)args.in[26] + (size_t)ll * NEXP * DM * DE; const float* wu_ = (const float*)args.in[27] + (size_t)ll * NEXP * DM * DE; const float* wd_ = (const float*)args.in[28] + (size_t)ll * NEXP * DE * DM;
#define MOE_ITEM(p, it_) do { \
        if ((it_) < N_GU) { const int e_ = E_LO + (it_) / (2 * I_GU); int r_ = (it_) % (2 * I_GU); const int up_ = r_ >= I_GU ? 1 : 0; r_ -= up_ * I_GU; const int kb_ = r_ % (DM / 64), n0_ = 64 * (r_ / (DM / 64));       \
            (p) = TrItem{(up_ ? wu_ : wg_) + (size_t)e_ * DM * DE, (bf16*)(ws + wgu_off(e_)), DM, DE, 64 * kb_, n0_, (n0_ >> 7) * 256 + (n0_ & 127) + up_ * 128}; } \
        else { const int jj_ = (it_) - N_GU, e_ = jj_ / I_D, r_ = jj_ % I_D; const int kb_ = r_ % (DE / 64), n0_ = 64 * (r_ / (DE / 64)); (p) = TrItem{wd_ + (size_t)e_ * DE * DM, WdT + (size_t)e_ * DM * DE, DE, DM, 64 * kb_, n0_, n0_}; } } while (0)
    f32x4 va[16]; TrItem pa, pb;
    int it = it0;
    if (it < it_end) { MOE_ITEM(pa, it); tr64_load(va, pa, lane); }
#pragma unroll 1
    while (it < it_end) {
        tr64_put(va, scr, lane);
        const int i1 = it + stride;
        if (i1 < it_end) { MOE_ITEM(pb, i1); tr64_load(va, pb, lane); }
        tr64_get(pa, scr, lane);
        pa = pb; it = i1;
    }
#undef MOE_ITEM
}
template <int KSEL>
__device__ __forceinline__ void layer_program(const Args& args, LAS unsigned char* lds, const XcdBarrier& bar, const int l) {
        PH_ON(0) {
            PHASE_LOCALS();
            bf16* WinT = (bf16*)(ws + WS_WIN); bf16* WoutT = (bf16*)(ws + WS_WOUT);
            LAS float* scr = (LAS float*)(lds + wave * 16384);
            const float* w_in = (const float*)args.in[3] + (size_t)ll * DM * D_IN; const float* w_out = (const float*)args.in[4] + (size_t)ll * DM * DM;
            constexpr int I_IN = (DM / 64) * (D_IN / 32), I_OUT = (DM / 64) * (DM / 32);
            constexpr int NITEMS = I_IN + I_OUT;
            for (int it = gw; it < NITEMS; it += NGW) {
                int r = it;
                if (r < I_IN) { const int nblk = D_IN / 32, kb = r / nblk, nb = r % nblk, n0 = 32 * nb;
                    const float sc = ((n0 >= OFF_A + 512 && n0 < OFF_A + 1024) || (n0 >= OFF_D_SRC && n0 < OFF_D_SRC + 512)) ? 0.125f : 1.f;
                    int drow0 = n0 + (n0 >= OFF_D_SRC ? OFF_D - OFF_D_SRC : 0), rmode = 0;
                    if (n0 < OFF_A + 1024) { drow0 = (n0 & ~63) + ((n0 >> 5) & 1); rmode = 1; }
                    else if (n0 >= OFF_D_SRC && n0 < OFF_D_SRC + 1024 && (((n0 - OFF_D_SRC) >> 5) & 1) == 0) rmode = 2;
                    transpose_item(w_in, DM, D_IN, WinT, 64 * kb, n0, drow0, scr, lane, sc, rmode); continue; } r -= I_IN;
                { const int nblk = DM / 32, kb = r / nblk, nb = r % nblk; transpose_item(w_out, DM, DM, WoutT, 64 * kb, 32 * nb, 32 * nb, scr, lane); }
            }
            for (long i = gtid; i < (long)(NPROJ - D_IN) * DM / 8; i += gstride) ((GAS v4u*)(WinT + (size_t)OFF_D_SRC * DM))[i] = (v4u){0u, 0u, 0u, 0u};
            if (ll == 0) { for (long i = gtid; i < (long)T * 40; i += gstride) v_rot_table((const int*)args.in[1], (float*)(ws + WS_ROT), i); }
            {   const float* wg = (const float*)args.in[22] + (size_t)ll * DM * 4; const float* we = (const float*)args.in[24] + (size_t)ll * DM * 32; float* rwt = (float*)(ws + WS_RWT);
                const float* n2g = (const float*)args.in[21] + ll * DM;
                for (long i = gtid; i < 48L * DM; i += gstride) { const int j = (int)(i & 3), ln = (int)((i >> 2) & 63), hh = (int)((i >> 8) & 1), r_ = (int)(i >> 9), tl = r_ % 3, S = r_ / 3;
                    const int k = 32 * S + 8 * (ln >> 4) + 4 * hh + j, col = 16 * tl + (ln & 15);
                    rwt[i] = (col < 32 ? we[(size_t)k * 32 + col] : (col < 36 ? wg[(size_t)k * 4 + col - 32] : 0.f)) * n2g[k]; } }
            if (ll > 0) build_moe_tables(lds, (const unsigned*)(ws + WS_CTL) + CW_CNT + (ll - 1) * 2048, tid);
            const LAS int* trb = (const LAS int*)(lds + TAB_ROWBASE);
            const float* x_in = (const float*)args.in[0]; bf16* xbuf = (bf16*)(ws + WS_X); bf16* act = (bf16*)(ws + WS_ACT); const bf16* yp = (const bf16*)(ws + WS_YP);
            const unsigned* slot_tok = (const unsigned*)(ws + WS_SLOT); const float* gate_tok = (const float*)(ws + WS_GATE);
            const float* norm1_g = (const float*)args.in[2] + ll * DM;
            if (ll == 0) {
#pragma unroll 1
                for (int m0 = gw; m0 < T; m0 += 4 * NGW) rows_norm_f32<4>(x_in, norm1_g, act, m0, NGW, lane);
            } else {
#pragma unroll 1
                for (int m0 = gw; m0 < T; m0 += 2 * NGW) rows_moe<2, false>(xbuf, yp, slot_tok, gate_tok, trb, norm1_g, act, nullptr, 1.f, m0, NGW, lane);
            }
        }
        SEAM(0); TSTAMP_AFTER(0);
        PH_ON(1) {
            PHASE_LOCALS();
            const int G1 = G >= 256 ? GEMM1_G : G;
            if (bid < G1) {
                pg8::Gemm g{(const bf16*)(ws + WS_ACT), (const bf16*)(ws + WS_WIN), T, NPROJ, DM, 0, 0}; pg8::StaticOrder<T, NPROJ> S; S.init(G1, bid);
                pg8::EpiBf16Rot E{(bf16*)(ws + WS_PROJ), NPROJ, (const float*)(ws + WS_ROT)};
                pg8::gemm_phase<DM, pg8::EpiBf16Rot, pg8::StaticOrder<T, NPROJ>, true, true>(lds, g, S, E, tid);
            }
            if (G1 == G) { __syncthreads(); moe_convert<0, 16, false>(args, ws, ll, lds, wave, lane, gw, NGW); }
            else if (bid >= G1) moe_convert<0, 16, false>(args, ws, ll, lds, wave, lane, (bid - G1) * 8 + wave, (G - G1) * 8);
        }
        SEAM(1); TSTAMP_AFTER(1);
        PH_ON(2) { PHASE_LOCALS(); const Ctx c = make_ctx(args, ws, ll);
            {   constexpr unsigned NSH = (unsigned)T * 248u; const unsigned gs = (unsigned)gstride;
#pragma unroll 1
                for (unsigned base = (unsigned)gtid; base < NSH; base += 8u * gs) { ShiftIn in[8];
#pragma unroll
                    for (int u = 0; u < 8; ++u) { const unsigned idx = base + (unsigned)u * gs; if (idx < NSH) shift_load(c, idx, in[u]); }
#pragma unroll
                    for (int u = 0; u < 8; ++u) { const unsigned idx = base + (unsigned)u * gs; if (idx < NSH) shift_finish(c, idx, in[u]); } } }
#pragma unroll 1
            for (int m = gw; m < T; m += 4 * NGW) w_sgu_prep_batch<4>(c, m, NGW, lane); }
        SEAM(2); TSTAMP_AFTER(2);
        PH_ON(3) { PHASE_LOCALS(); const Ctx c = make_ctx(args, ws, ll);
            rwkv_lora_phase(lds, c, tid, bid, G);
            ret_kv_phase(lds, c.proj, c.gam, c.rkv, tid, bid, G);
            sgu_phase(lds, c.proj, c.sgu_w, c.sgu_bias, c.ycat, tid, bid, G);
            dil_attn_phase(lds, c.proj, (bf16*)(ws + WS_DPO), (float*)(ws + WS_DML), tid, bid, G); }
        SEAM(3); TSTAMP_AFTER(3);
        PH_ON(5) { PHASE_LOCALS(); const Ctx c = make_ctx(args, ws, ll);
            for (long i = gtid; i < (long)BATCH * 8 * 2 * 4096; i += gstride) el_ret_scan(c, i);
            rwkv_chunk_phase(lds, c, ws, tid, bid, G); }
        SEAM(5); TSTAMP_AFTER(5);
        PH_ON(13) { PHASE_LOCALS(); const Ctx c = make_ctx(args, ws, ll);
            constexpr int NU = BATCH * 16;
            if (bid < NU) { if (tid < 64) ((LAS unsigned*)(lds + 4 * RWS_RING_B))[tid] = 0u; __syncthreads(); rwkv_sscan_phase(lds, ws, bid, wave, lane); }
            else { ret_out_phase(lds, c.proj, c.gam, c.ret_g, c.rsp, c.ycat, tid, bid - NU, G - NU);
#pragma unroll 1
                for (long i = (long)(bid - NU) * 512 + tid; i < (long)T * 64; i += 4 * (long)(G - NU) * 512) v_dil_combine_batch<4>((const bf16*)(ws + WS_DPO), (const float*)(ws + WS_DML), c.ycat, i, (long)(G - NU) * 512, (long)T * 64);
                __syncthreads();
                moe_convert<16, 25, false>(args, ws, ll, lds, wave, lane, (bid - NU) * 8 + wave, (G - NU) * 8); } }
        SEAM(13); TSTAMP_AFTER(13);
        PH_ON(6) { PHASE_LOCALS(); const Ctx c = make_ctx(args, ws, ll);
            rwkv_yfin_phase(lds, c, ws, tid, bid, G); }
        SEAM(6); TSTAMP_AFTER(6);
        PH_ON(7) {
            PHASE_LOCALS();
            pg8::Gemm g{(const bf16*)(ws + WS_ACT), (const bf16*)(ws + WS_WOUT), T, DM, DM, 0, 0}; pg8::StaticOrder<T, DM> S; S.init(G, bid);
            pg8::EpiResB E{ll == 0 ? (const float*)args.in[0] : nullptr, (const bf16*)(ws + WS_X), (bf16*)(ws + WS_X), DM};
            pg8::gemm_phase<DM, pg8::EpiResB, pg8::StaticOrder<T, DM>, true, true>(lds, g, S, E, tid);
        }
        SEAM(7); TSTAMP_AFTER(7);
        PH_ON(8) {
            PHASE_LOCALS();
            const float* wg = (const float*)args.in[22] + (size_t)ll * DM * 4; const float* bg = (const float*)args.in[23] + ll * 4;
            const float* we = (const float*)args.in[24] + (size_t)ll * DM * 32; const float* be = (const float*)args.in[25] + ll * 32;
            const float* norm2_g = (const float*)args.in[21] + ll * DM;
            const bf16* xbuf = (const bf16*)(ws + WS_X);
            unsigned* cnt_tab = (unsigned*)(ws + WS_TOK); unsigned* slot_tok = (unsigned*)(ws + WS_SLOT); float* gate_tok = (float*)(ws + WS_GATE); float* rstd_tok = (float*)(ws + WS_TOK + 256 * 1024);
            const float* rwt = (const float*)(ws + WS_RWT); const int fr = lane & 15, fq = lane >> 4;
            LAS float* lg_s = (LAS float*)(lds + wave * 16384);
            LAS unsigned* lcnt = (LAS unsigned*)(lds + 65536); LAS unsigned* lbase = lcnt + 32;
            static_assert(T / 16 % 4 == 0, "router tiles");
            for (int tile0 = bid; tile0 < T / 64; tile0 += G) { const int tile = tile0 + (T / 64) * (wave & 3); const bool wact = wave < 4;
                if (tid < 32) lcnt[tid] = 0u;
                __syncthreads();
              int e1 = 0, e2 = 0; float g1 = 0.f, g2 = 0.f; unsigned r1 = 0u, r2 = 0u; float rstd = 0.f; const size_t m0 = (size_t)tile * 16; const bf16* xr = xbuf + (m0 + fr) * DM;
              f32x4 acc[3]; float ss = 0.f;
              {
#pragma unroll
                for (int tl = 0; tl < 3; ++tl) acc[tl] = (f32x4){0.f, 0.f, 0.f, 0.f};
                const int sb = (DM / 64) * (wave >> 2);
                struct RtOp { f32x4 x[2], b[3][2]; };
#define RT_LOAD(o, S_) do { const int sc_ = (S_) < DM / 32 ? (S_) : DM / 32 - 1, k0_ = 32 * sc_ + 8 * fq; \
        { const v4u xw_ = *(const GAS v4u*)(xr + k0_); (o).x[0] = (f32x4){__builtin_bit_cast(float, xw_.x << 16), __builtin_bit_cast(float, xw_.x & 0xffff0000u), __builtin_bit_cast(float, xw_.y << 16), __builtin_bit_cast(float, xw_.y & 0xffff0000u)}; \
          (o).x[1] = (f32x4){__builtin_bit_cast(float, xw_.z << 16), __builtin_bit_cast(float, xw_.z & 0xffff0000u), __builtin_bit_cast(float, xw_.w << 16), __builtin_bit_cast(float, xw_.w & 0xffff0000u)}; } \
        _Pragma("unroll") for (int hh = 0; hh < 2; ++hh) \
            _Pragma("unroll") for (int tl = 0; tl < 3; ++tl) (o).b[tl][hh] = *(const GAS f32x4*)(rwt + ((size_t)((sc_ * 3 + tl) * 2 + hh) * 64 + lane) * 4); } while (0)
#define RT_MMA(o) do { _Pragma("unroll") for (int hh = 0; hh < 2; ++hh) { ss += ((o).x[hh].x * (o).x[hh].x + (o).x[hh].y * (o).x[hh].y) + ((o).x[hh].z * (o).x[hh].z + (o).x[hh].w * (o).x[hh].w); const f32x4 av_ = (o).x[hh]; \
        _Pragma("unroll") for (int tl = 0; tl < 3; ++tl) _Pragma("unroll") for (int j = 0; j < 4; ++j) acc[tl] = __builtin_amdgcn_mfma_f32_16x16x4f32(av_[j], (o).b[tl][hh][j], acc[tl], 0, 0, 0); } } while (0)
                RtOp oa, ob, oc;
                RT_LOAD(oa, sb); RT_LOAD(ob, sb + 1);
#pragma unroll 1
                for (int S = sb; S < sb + DM / 64 - 2; S += 6) {
                    RT_LOAD(oc, S + 2); RT_MMA(oa); RT_LOAD(oa, S + 3); RT_MMA(ob); RT_LOAD(ob, S + 4); RT_MMA(oc);
                    RT_LOAD(oc, S + 5); RT_MMA(oa); RT_LOAD(oa, S + 6); RT_MMA(ob); RT_LOAD(ob, S + 7); RT_MMA(oc); }
                RT_MMA(oa); RT_MMA(ob);
                static_assert((DM / 64 - 2) % 6 == 0, "router pipeline");
#undef RT_LOAD
#undef RT_MMA
              }
              {   LAS float* part = (LAS float*)(lds + (4 + (wave & 3)) * 16384 + 1024);
                if (!wact) {
#pragma unroll
                    for (int tl = 0; tl < 3; ++tl)
#pragma unroll
                        for (int j = 0; j < 4; ++j) part[(tl * 4 + j) * 64 + lane] = acc[tl][j];
                    part[12 * 64 + lane] = ss; }
                __syncthreads();
                if (wact) {
#pragma unroll
                    for (int tl = 0; tl < 3; ++tl)
#pragma unroll
                        for (int j = 0; j < 4; ++j) acc[tl][j] += part[(tl * 4 + j) * 64 + lane];
                    ss += part[12 * 64 + lane]; } }
              if (wact) {
                ss = xlane_sum4(ss, lane);
                rstd = 1.f / sqrtf(ss * (1.f / DM) + NORM_EPS);
#pragma unroll
                for (int tl = 0; tl < 3; ++tl)
#pragma unroll
                    for (int j = 0; j < 4; ++j) lg_s[(4 * fq + j) * 48 + 16 * tl + fr] = acc[tl][j];
                if (fq == 0) lg_s[768 + fr] = rstd;
                LDS_WAIT(); asm volatile("" ::: "memory");
                if (lane < 16) { const float rs_ = lg_s[768 + lane]; float lg[4], le[32];
#pragma unroll
                    for (int i = 0; i < 32; ++i) le[i] = lg_s[lane * 48 + i] * rs_;
#pragma unroll
                    for (int i = 0; i < 4; ++i) lg[i] = lg_s[lane * 48 + 32 + i] * rs_;
                    route_select(lg, le, bg, be, e1, e2, g1, g2);
                    r1 = __hip_atomic_fetch_add(lcnt + e1, 1u, __ATOMIC_RELAXED, __HIP_MEMORY_SCOPE_WORKGROUP); r2 = __hip_atomic_fetch_add(lcnt + e2, 1u, __ATOMIC_RELAXED, __HIP_MEMORY_SCOPE_WORKGROUP); }
              }
                __syncthreads();
                if (tid < 32) cnt_tab[tile0 * 32 + tid] = lcnt[tid];
              if (wact) {
                if (lane < 16) { const int m = (int)m0 + lane;
                    slot_tok[2 * m] = ((unsigned)e1 << 20) | r1; slot_tok[2 * m + 1] = ((unsigned)e2 << 20) | r2; gate_tok[2 * m] = g1; gate_tok[2 * m + 1] = g2; }
                if (fq == 0) rstd_tok[m0 + fr] = rstd;
              }
                __syncthreads();
            }
        }
        SEAM(8); TSTAMP_AFTER(8);
        PH_ON(9) {
            PHASE_LOCALS();
            moe_convert<25, 32, false>(args, ws, ll, lds, wave, lane, gw, NGW);
            {
                const unsigned* cnt_tab = (const unsigned*)(ws + WS_TOK); unsigned* slot_tok = (unsigned*)(ws + WS_SLOT); unsigned* cnt_cur = (unsigned*)(ws + WS_CTL) + CW_CNT + ll * 2048;
                const bf16* xbuf = (const bf16*)(ws + WS_X); const float* norm2_g = (const float*)args.in[21] + ll * DM; const float* rstd_tok = (const float*)(ws + WS_TOK + 256 * 1024); bf16* aperm = (bf16*)(ws + WS_APERM);
                LAS int* tcnt = (LAS int*)(lds + TAB_CNT); const LAS int* trb = (const LAS int*)(lds + TAB_ROWBASE);
                LAS int* gbase = (LAS int*)(lds + 8192); LAS int* clist = (LAS int*)(lds + 8192 + 256);
                static_assert((T / 64) % 16 == 0, "prefix parts");
                constexpr int GPP = T / 64 / 16;
                LAS int* psum = (LAS int*)(lds + 16384);
                __syncthreads();
                {   const int e = tid & 31, p = tid >> 5; int sacc = 0;
#pragma unroll
                    for (int u = 0; u < GPP; ++u) sacc += (int)cnt_tab[(p * GPP + u) * 32 + e];
                    psum[p * 32 + e] = sacc; }
                __syncthreads();
                if (tid < 32) { int run = 0;
#pragma unroll
                    for (int p = 0; p < 16; ++p) run += psum[p * 32 + tid];
                    tcnt[tid] = run; if (bid == 0) cnt_cur[64 * tid] = (unsigned)run; }
                build_moe_tables(lds, nullptr, tid);
                for (int rg = bid; rg < T / 64; rg += G) {
                    __syncthreads();
                    if (tid < 32) { const int p0 = rg / GPP; int base = 0;
                        for (int p = 0; p < p0; ++p) base += psum[p * 32 + tid];
#pragma unroll
                        for (int u = 0; u < GPP; ++u) base += (p0 * GPP + u < rg) ? (int)cnt_tab[(p0 * GPP + u) * 32 + tid] : 0;
                        gbase[tid] = base; }
                    __syncthreads();
                    if (wave < 4 && lane < 16) { const int m = 16 * (rg + (T / 64) * wave) + lane; clist[(wave * 16 + lane) * 4] = m;
#pragma unroll
                        for (int k = 0; k < 2; ++k) { const unsigned sv = slot_tok[2 * m + k]; const int e = (int)(sv >> 20); const int r = gbase[e] + (int)(sv & 0xfffffu);
                            slot_tok[2 * m + k] = ((unsigned)e << 20) | (unsigned)r; clist[(wave * 16 + lane) * 4 + 1 + k] = trb[e] + r; } }
                    __syncthreads();
                    for (int i = wave; i < 64; i += 8) {
                        const int m = clist[4 * i]; const size_t R1 = (size_t)clist[4 * i + 1], R2 = (size_t)clist[4 * i + 2]; const float rs_ = rstd_tok[m];
                        f32x4 v[8]; ROW_LOAD_BF(v, xbuf + (size_t)m * DM);
#pragma unroll
                        for (int j = 0; j < 8; ++j) { const f32x4 g = ((const GAS f32x4*)norm2_g)[lane + 64 * j];
                            v2u o; o.x = cvtpk(v[j].x * g.x * rs_, v[j].y * g.y * rs_); o.y = cvtpk(v[j].z * g.z * rs_, v[j].w * g.w * rs_);
                            ((GAS v2u*)(aperm + R1 * DM))[lane + 64 * j] = o; ((GAS v2u*)(aperm + R2 * DM))[lane + 64 * j] = o; } }
                }
                for (int e = 0; e < NEXP; ++e) { const int c0 = tcnt[e], rend = ((c0 + 255) >> 8) * 256;
                    for (int r = c0 + gw; r < rend; r += NGW) { GAS v4u* dst = (GAS v4u*)(aperm + (size_t)(trb[e] + r) * DM);
#pragma unroll
                        for (int j = 0; j < 4; ++j) dst[lane + 64 * j] = (v4u){0u, 0u, 0u, 0u}; } }
            }
        }
        SEAM(9); TSTAMP_AFTER(9);
        PH_ON(10) {
            PHASE_LOCALS();
            build_moe_tables(lds, (const unsigned*)(ws + WS_CTL) + CW_CNT + ll * 2048, tid);
            const int ntiles = __builtin_amdgcn_readfirstlane(((const LAS int*)(lds + TAB_NT))[0]);
            pg8::Gemm g{(const bf16*)(ws + WS_APERM), (const bf16*)ws, MOE_MAXTILES * 256, 1024, DM, 0, 1};
            const int units = ntiles * 4, rounds = (units + G - 1) / G, G3r = rounds > 0 ? (units + rounds - 1) / rounds : G, G3 = (G - G3r >= 16) ? G3r : G;
            if (bid < G3) {
                pg8::MoeOrder<4> S{G3, bid, ntiles, (const LAS int*)(lds + TAB_TEXP)};
                pg8::EpiSwiGLU E{(bf16*)(ws + WS_HID), DE};
                pg8::gemm_phase<DM, pg8::EpiSwiGLU, pg8::MoeOrder<4>, true, true>(lds, g, S, E, tid);
            }
            if (G3 == G) { __syncthreads(); moe_convert<0, 0, true>(args, ws, ll, lds, wave, lane, gw, NGW); }
            else if (bid >= G3) moe_convert<0, 0, true>(args, ws, ll, lds, wave, lane, (bid - G3) * 8 + wave, (G - G3) * 8);
        }
        SEAM(10); TSTAMP_AFTER(10);
        PH_ON(11) {
            PHASE_LOCALS();
            build_moe_tables(lds, (const unsigned*)(ws + WS_CTL) + CW_CNT + ll * 2048, tid);
            const int ntiles = __builtin_amdgcn_readfirstlane(((const LAS int*)(lds + TAB_NT))[0]);
            pg8::Gemm g{(const bf16*)(ws + WS_HID), (const bf16*)(ws + WS_WD), MOE_MAXTILES * 256, DM, DE, (size_t)DM * DE * 2, 0};
            pg8::MoeOrder<8> S{G, bid, ntiles, (const LAS int*)(lds + TAB_TEXP)};
            pg8::EpiBf16 E{(bf16*)(ws + WS_YP), DM};
            pg8::gemm_phase<DE, pg8::EpiBf16, pg8::MoeOrder<8>, true, true>(lds, g, S, E, tid);
        }
        SEAM(11); TSTAMP_AFTER(11);
    }

template <int KSEL>
__global__ void __launch_bounds__(512, 2) fwd_kernel(Args args) {
    extern __shared__ __attribute__((aligned(16))) unsigned char lds_raw[];
    LAS unsigned char* lds = (LAS unsigned char*)lds_raw;
    if (threadIdx.x < 4) ((LAS unsigned*)(lds + MISC_OFF))[threadIdx.x] = 0u;
    __syncthreads();
    XcdBarrier bar; bar.bar = (unsigned*)(args.ws + WS_CTL) + CW_BAR; bar.x = 0; bar.st = nullptr;
    if constexpr (KSEL < 0) bar = xcd_barrier_post((unsigned*)(args.ws + WS_CTL) + CW_BAR, (volatile LAS unsigned*)(lds + MISC_OFF));
    if (KB_TPROBE >= 0 && KSEL < 0 && blockIdx.x == 0 && threadIdx.x == 0) ((unsigned long long*)(args.ws + WS_CTL))[32768] = wall_clock64();
    if constexpr (KSEL < 0) { layer_program<KSEL>(args, lds, bar, 0); layer_program<KSEL>(args, lds, bar, 1); }
    else if constexpr (KSEL != 12) layer_program<KSEL>(args, lds, bar, args.layer);
    PH_ON(12) {
        const int l = DEPTH - 1;
        PHASE_LOCALS();
        build_moe_tables(lds, (const unsigned*)(ws + WS_CTL) + CW_CNT + ll * 2048, tid);
        const LAS int* trb = (const LAS int*)(lds + TAB_ROWBASE);
        float pscale = 1.f;
        if (KB_TPROBE >= 0) { const unsigned long long* ts = (const unsigned long long*)(ws + WS_CTL) + 32768; const int p = KB_TPROBE;
            const float tot = (float)(ts[13] - ts[0]); const int pe = KB_TPROBE_END; const float d = (float)(ts[pe] - ts[p]);
            pscale = 1.f + 0.01f * (float)(int)(d / tot * 40.f + 0.5f); }
        const float* gfin = (const float*)args.in[29]; const bf16* xbuf = (const bf16*)(ws + WS_X); const bf16* yp = (const bf16*)(ws + WS_YP);
        const unsigned* slot_tok = (const unsigned*)(ws + WS_SLOT); const float* gate_tok = (const float*)(ws + WS_GATE);
        for (int m = gw; m < T; m += NGW) {
            f32x4 v[8];
            ROW_LOAD_BF(v, xbuf + (size_t)m * DM);
            const unsigned s1 = slot_tok[2 * m], s2 = slot_tok[2 * m + 1]; const float g1 = gate_tok[2 * m], g2 = gate_tok[2 * m + 1];
            row_add_moe(v, yp, (size_t)(trb[s1 >> 20] + (int)(s1 & 0xfffffu)), (size_t)(trb[s2 >> 20] + (int)(s2 & 0xfffffu)), g1, g2, lane);
            const float rstd = row_rstd(v, lane);
#pragma unroll
            for (int j = 0; j < 8; ++j) { const f32x4 g = ((const GAS f32x4*)gfin)[lane + 64 * j];
                ((GAS f32x4*)(args.out + (size_t)m * DM))[lane + 64 * j] = (f32x4){v[j].x * rstd * g.x * pscale, v[j].y * rstd * g.y * pscale, v[j].z * rstd * g.z * pscale, v[j].w * rstd * g.w * pscale}; }
        }
    }
#undef SEAM
#undef PH_ON
}

extern "C" void kernel_launch(void* const* d_in, const int* in_sizes, int n_in, void* d_out, int out_size, void* d_ws, size_t ws_size, hipStream_t stream) {
    static int grid = 0;
    if (grid == 0) {
        if (n_in != 30 || in_sizes[0] != T * DM || out_size != T * DM || ws_size < WS_END) { fprintf(stderr, "kernel_launch: unexpected shapes (n_in %d, in0 %d, out %d, ws %zu < %zu)\n", n_in, n_in > 0 ? in_sizes[0] : -1, out_size, ws_size, (size_t)WS_END); grid = -1; return; }
        int dev = 0, cus = 0, per_cu = 0; (void)per_cu;
        if (hipGetDevice(&dev) != hipSuccess || hipDeviceGetAttribute(&cus, hipDeviceAttributeMultiprocessorCount, dev) != hipSuccess) { grid = -1; return; }
#if KB_SPLIT
#define SET_ATTR(k) if (hipFuncSetAttribute((const void*)fwd_kernel<k>, hipFuncAttributeMaxDynamicSharedMemorySize, LDS_BYTES) != hipSuccess) { fprintf(stderr, "kernel_launch: hipFuncSetAttribute failed (%d)\n", k); grid = -1; return; }
        SET_ATTR(0) SET_ATTR(1) SET_ATTR(2) SET_ATTR(3) SET_ATTR(4) SET_ATTR(5) SET_ATTR(6) SET_ATTR(7) SET_ATTR(8) SET_ATTR(9) SET_ATTR(10) SET_ATTR(11) SET_ATTR(12) SET_ATTR(13)
#else
        if (hipFuncSetAttribute((const void*)fwd_kernel<-1>, hipFuncAttributeMaxDynamicSharedMemorySize, LDS_BYTES) != hipSuccess) { fprintf(stderr, "kernel_launch: hipFuncSetAttribute failed\n"); grid = -1; return; }
        if (hipOccupancyMaxActiveBlocksPerMultiprocessor(&per_cu, (const void*)fwd_kernel<-1>, 512, LDS_BYTES) != hipSuccess || per_cu < 1) fprintf(stderr, "kernel_launch: occupancy query says %d\n", per_cu);
#endif
        (void)hipGetLastError();
        grid = cus;
    }
    if (grid < 0) return;
    if (hipMemsetAsync((char*)d_ws + WS_CTL, 0, CTL_ZERO_BYTES, stream) != hipSuccess) return;
    Args a{};
    for (int i = 0; i < 30; ++i) a.in[i] = d_in[i];
    a.out = (float*)d_out; a.ws = (unsigned char*)d_ws; a.layer = 0; a.pad = 0;
#if KB_SPLIT
#define LAUNCH_PH(k) hipLaunchKernelGGL(fwd_kernel<k>, dim3(grid), dim3(512), LDS_BYTES, stream, a)
    for (int l = 0; l < DEPTH; ++l) { a.layer = l;
        LAUNCH_PH(0); LAUNCH_PH(1); LAUNCH_PH(2); LAUNCH_PH(3); LAUNCH_PH(4); LAUNCH_PH(5); LAUNCH_PH(13); LAUNCH_PH(6); LAUNCH_PH(7); LAUNCH_PH(8); LAUNCH_PH(9); LAUNCH_PH(10); LAUNCH_PH(11); }
    a.layer = DEPTH - 1; LAUNCH_PH(12);
#else
    hipLaunchKernelGGL(fwd_kernel<-1>, dim3(grid), dim3(512), LDS_BYTES, stream, a);
#endif
}
#endif
```

```cpp
#ifndef KB_EMU
#include <hip/hip_runtime.h>
#endif
#include <cstdio>
#include <cstdint>
#include <cmath>

#ifndef KB_BATCH
#define KB_BATCH 4
#define KB_SEQ 4096
#endif
#ifndef KB_SPLIT
#define KB_SPLIT 0
#endif

#ifndef KB_PHMASK
#define KB_PHMASK 0xffff
#endif
#define KB_EN(k) (((KB_PHMASK) >> (k)) & 1)
#ifndef KB_TPROBE
#define KB_TPROBE -1
#endif
#ifndef KB_TPROBE_END
#define KB_TPROBE_END (KB_TPROBE + 1)
#endif
#define HD __host__ __device__ __forceinline__
typedef unsigned short bf16;

constexpr int BATCH = KB_BATCH, SEQ = KB_SEQ, T = BATCH * SEQ;
constexpr int DM = 2048, DG = 512, NH = 8, HDIM = 64;
constexpr int A_COLS = 2048, B_COLS = 1984, C_COLS = 1024, D_COLS = 1536, D_IN = 6592, NPROJ = 6656;
constexpr int OFF_A = 0, OFF_B = 2048, OFF_C = 4032, OFF_D_SRC = 5056  , OFF_D = 5120  ;
static_assert(OFF_D % 256 == 0 && OFF_D + D_COLS == NPROJ && OFF_D - OFF_D_SRC == NPROJ - D_IN, "proj layout");
constexpr int NC = SEQ / 128;
constexpr int NEXP = 32, DE = 512;
constexpr int NLORA = 448;
constexpr float NORM_EPS = 1e-6f, GN_EPS = 64e-5f;
constexpr int MOE_MAXTILES = (2 * T + NEXP * 255 + 255) / 256;
constexpr int DEPTH = 2;

constexpr size_t MiB = 1u << 20;
constexpr size_t WS_CTL = 0, CTL_ZERO_BYTES = 1 * MiB;
constexpr size_t WS_WIN = 2 * MiB, WS_WOUT = 28 * MiB;
constexpr size_t WS_WD = 292 * MiB;
__host__ __device__ constexpr size_t wgu_off(int e) { return e < 16 ? (804 + 4 * (size_t)e) * MiB : e < 22 ? (780 + 4 * (size_t)(e - 16)) * MiB : e < 25 ? (868 + 4 * (size_t)(e - 22)) * MiB : (914 + 4 * (size_t)(e - 25)) * MiB; }
constexpr int GEMM1_G = 238;
constexpr size_t WS_X = 228 * MiB;
constexpr size_t WS_ACT = 356 * MiB;
constexpr size_t WS_PROJ = 420 * MiB;
constexpr size_t WS_RKV = 628 * MiB, WS_RSP = 660 * MiB;
constexpr size_t WS_RS = 692 * MiB, WS_KS = 708 * MiB, WS_VS = 724 * MiB, WS_KK = 740 * MiB, WS_GG = 756 * MiB, WS_KDF = 772 * MiB, WS_KDB = 788 * MiB,
                 WS_AKF = 804 * MiB, WS_AKB = 820 * MiB, WS_YF = 836 * MiB, WS_YB = 852 * MiB, WS_LIN = 868 * MiB  , WS_WF = 882 * MiB, WS_WB = 914 * MiB;
constexpr size_t WS_TOK = 946 * MiB  , WS_SLOT = 948 * MiB, WS_GATE = 949 * MiB;
constexpr size_t WS_RB = 36 * MiB  , WS_PT = 68 * MiB  , WS_QF = 132 * MiB  , WS_YL = 196 * MiB  , WS_DC = 1002 * MiB  ;
constexpr size_t WS_DPO = 950 * MiB  , WS_DML = 998 * MiB  , WS_ROT = 1004 * MiB  , WS_ST = 882 * MiB  , WS_RWT = 1010 * MiB  , WS_END = 1011 * MiB;
constexpr size_t WS_APERM = 420 * MiB, WS_HID = 580 * MiB, WS_YP = 620 * MiB;
static_assert((size_t)MOE_MAXTILES * 256 * 2048 * 2 <= 160 * MiB && (size_t)T * NPROJ * 2 <= 208 * MiB, "ws map");
constexpr int CW_BAR = 4096;
constexpr int CW_CNT = 16384;

HD float bf2f(bf16 v) { return __builtin_bit_cast(float, (unsigned)v << 16); }
HD bf16 f2bf(float f) { unsigned u = __builtin_bit_cast(unsigned, f); return (bf16)((u + 0x7fffu + ((u >> 16) & 1u)) >> 16); }
HD float sigmoidf_(float x) { return 1.f / (1.f + expf(-x)); }
HD float siluf_(float x) { return x / (1.f + expf(-x)); }
HD float geluf_(float x) { return 0.5f * x * (1.f + tanhf(0.7978845608028654f * (x + 0.044715f * x * x * x))); }
HD float logsigmoidf_(float x) { return x < 0.f ? x - log1pf(expf(x)) : -log1pf(expf(-x)); }

struct Ctx {
    const int* pos;
    const float *gam, *ret_g, *mu, *w0, *w2, *a0, *a2, *g2, *k_k, *k_a, *r_k, *ln_g, *sgu_g, *sgu_b, *sgu_w, *sgu_bias;
    bf16 *proj, *ycat, *rs, *ks, *vs, *kk, *gg, *kdf, *kdb, *akf, *akb, *yf, *yb, *lin;
    float *wf, *wb, *rkv, *rsp;
};

HD void el_rot_ret(const Ctx& c, long idx) {
    const int i = (int)(idx & 31), h = (int)((idx >> 5) & 7); const long t = idx >> 8;
    const float inv = expf(-(float)i * (1.f / 32.f) * 9.210340371976184f);
    const float ang = (float)c.pos[t] * inv; float sn, cs; sincosf(ang, &sn, &cs);
    bf16* q = c.proj + (size_t)t * NPROJ + OFF_A + h * 64; bf16* k = q + 512;
    const float q1 = bf2f(q[i]), q2 = bf2f(q[i + 32]), k1 = bf2f(k[i]), k2 = bf2f(k[i + 32]);
    q[i] = f2bf(q1 * cs - q2 * sn); q[i + 32] = f2bf(q2 * cs + q1 * sn);
    k[i] = f2bf((k1 * cs - k2 * sn) * 0.125f); k[i + 32] = f2bf((k2 * cs + k1 * sn) * 0.125f);
}
HD void el_rot_dil(const Ctx& c, long idx) {
    const int j = (int)(idx & 31), h = (int)((idx >> 5) & 7); const long t = idx >> 8;
    bf16* q = c.proj + (size_t)t * NPROJ + OFF_D + h * 64; bf16* k = q + 512;
    if (j < 8) {
        const float inv = expf(-(float)j * (1.f / 8.f) * 13.122363377404328f);
        const float ang = (float)c.pos[t] * inv; float sn, cs; sincosf(ang, &sn, &cs);
        const float q1 = bf2f(q[j]), q2 = bf2f(q[j + 8]), k1 = bf2f(k[j]), k2 = bf2f(k[j + 8]);
        q[j] = f2bf((q1 * cs - q2 * sn) * 0.125f); q[j + 8] = f2bf((q2 * cs + q1 * sn) * 0.125f);
        k[j] = f2bf(k1 * cs - k2 * sn); k[j + 8] = f2bf(k2 * cs + k1 * sn);
    } else {
        const int d = 16 + 2 * (j - 8);
        q[d] = f2bf(bf2f(q[d]) * 0.125f); q[d + 1] = f2bf(bf2f(q[d + 1]) * 0.125f);
    }
}
HD void el_rwkv_shift(const Ctx& c, long idx) {
    const int j = (int)(idx % B_COLS); const long t = idx / B_COLS; const int s = (int)(t % SEQ);
    const bf16* p = c.proj + (size_t)t * NPROJ + OFF_B + j;
    const float x = bf2f(p[0]), xp = s > 0 ? bf2f(p[-(long)NPROJ]) : 0.f, xn = s < SEQ - 1 ? bf2f(p[NPROJ]) : 0.f;
    const float xs = x + c.mu[j] * (xp - x) + c.mu[B_COLS + j] * (xn - x);
    if (j < 512) c.rs[t * 512 + j] = f2bf(xs);
    else if (j < 1024) c.ks[t * 512 + j - 512] = f2bf(xs);
    else if (j < 1536) c.vs[t * 512 + j - 1024] = f2bf(xs);
    else if (j < 1632) c.lin[t * NLORA + (j - 1536)] = f2bf(tanhf(xs));
    else if (j < 1728) c.lin[t * NLORA + (j - 1536)] = f2bf(xs);
    else c.lin[t * NLORA + (j - 1536)] = f2bf(sigmoidf_(xs));
}
HD void el_rwkv_lora(const Ctx& c, long idx) {
    const int ch = (int)(idx & 511); const long t = idx >> 9;
    const bf16* li = c.lin + t * NLORA;
    float wl = 0.f, al = 0.f, g = 0.f;
    for (int i = 0; i < 96; ++i) { wl += bf2f(li[i]) * c.w2[i * 512 + ch]; al += bf2f(li[96 + i]) * c.a2[i * 512 + ch]; }
    for (int i = 0; i < 256; ++i) g += bf2f(li[192 + i]) * c.g2[i * 512 + ch];
    c.gg[t * 512 + ch] = f2bf(g);
    const float k = bf2f(c.ks[t * 512 + ch]), ka = c.k_a[ch];
    c.kk[t * 512 + ch] = f2bf(k * c.k_k[ch]);
    {   const float dec = -0.6065306597126334f * sigmoidf_(c.w0[ch] + wl); const float a = sigmoidf_(c.a0[ch] + al);
        c.wf[t * 512 + ch] = dec; c.kdf[t * 512 + ch] = f2bf(k * (1.f + (a - 1.f) * ka)); c.akf[t * 512 + ch] = f2bf(a); }
    {   const float dec = -0.6065306597126334f * sigmoidf_(c.w0[512 + ch] + wl); const float a = sigmoidf_(c.a0[512 + ch] + al);
        c.wb[t * 512 + ch] = dec; c.kdb[t * 512 + ch] = f2bf(k * (1.f + (a - 1.f) * ka)); c.akb[t * 512 + ch] = f2bf(a); }
}
HD void el_rwkv_kk(const Ctx& c, long idx) {
    const int h = (int)(idx & 7); const long t = idx >> 3; const size_t o = (size_t)t * 512 + h * 64;
    float ss = 0.f;
    for (int d = 0; d < 64; ++d) { const float v = bf2f(c.kk[o + d]); ss += v * v; }
    const float n = 1.f / sqrtf(ss + 1e-12f);
    for (int d = 0; d < 64; ++d) { const float v = bf2f(c.kk[o + d]) * n; c.kk[o + d] = f2bf(v);
        c.akf[o + d] = f2bf(bf2f(c.akf[o + d]) * v); c.akb[o + d] = f2bf(bf2f(c.akb[o + d]) * v); }
}
HD void el_sgu_prep(const Ctx& c, long t) {
    bf16* v = c.proj + (size_t)t * NPROJ + OFF_C + 512;
    float s = 0.f;
    for (int j = 0; j < 512; ++j) s += geluf_(bf2f(v[j]));
    const float mean = s * (1.f / 512.f); float q = 0.f;
    for (int j = 0; j < 512; ++j) { const float d = geluf_(bf2f(v[j])) - mean; q += d * d; }
    const float rstd = 1.f / sqrtf(q * (1.f / 512.f) + NORM_EPS);
    for (int j = 0; j < 512; ++j) v[j] = f2bf((geluf_(bf2f(v[j])) - mean) * rstd * c.sgu_g[j] + c.sgu_b[j]);
}

HD void el_ret_kv(const Ctx& c, long idx) {
    const int e = (int)(idx & 63), d = (int)((idx >> 6) & 63); long r = idx >> 12;
    const int ch = (int)(r % NC); r /= NC; const int dir = (int)(r & 1); r >>= 1; const int h = (int)(r & 7); const int b = (int)(r >> 3);
    const float lg = logsigmoidf_(c.gam[dir * 8 + h]);
    const bf16* base = c.proj + ((size_t)b * SEQ + (size_t)ch * 128) * NPROJ + OFF_A + h * 64;
    float kv = 0.f;
    for (int m = 0; m < 128; ++m) { const float dec = expf(lg * (float)(dir == 0 ? 127 - m : m));
        kv += dec * bf2f(base[(size_t)m * NPROJ + 512 + d]) * bf2f(base[(size_t)m * NPROJ + 1024 + e]); }
    c.rkv[idx] = kv;
}
HD void el_dil_attn(const Ctx& c, long idx) {
    const int h = (int)(idx & 7); const long t = idx >> 3; const int s = (int)(t % SEQ); const long tb = t - s;
    const bf16* qp = c.proj + (size_t)t * NPROJ + OFF_D + h * 64;
    float o[64];
#pragma unroll
    for (int i = 0; i < 64; ++i) o[i] = 0.f;
    float m = -1e30f, l = 0.f;
    for (int br = 0; br < 3; ++br) {
        const int dil = br == 0 ? 1 : (br == 1 ? 4 : 16);
        for (int j = -64; j <= 64; ++j) {
            const int sp = s + dil * j; if (sp < 0 || sp >= SEQ) continue;
            asm volatile("" ::: "memory");
            const bf16* kp = c.proj + (size_t)(tb + sp) * NPROJ + OFF_D + 512 + h * 64; const bf16* vp = kp + 512;
            float sc = 0.f;
#pragma unroll
            for (int i = 0; i < 64; ++i) sc += bf2f(qp[i]) * bf2f(kp[i]);
            const float mn = sc > m ? sc : m, scale = expf(m - mn), p = expf(sc - mn);
            l = l * scale + p; m = mn;
#pragma unroll
            for (int i = 0; i < 64; ++i) o[i] = o[i] * scale + p * bf2f(vp[i]);
        }
    }
    const float il = 1.f / l; bf16* y = c.ycat + (size_t)t * 2048 + 1536 + h * 64;
#pragma unroll
    for (int i = 0; i < 64; ++i) y[i] = f2bf(o[i] * il);
}
HD void el_dil_combine(const bf16* dpo, const float* dml, bf16* ycat, long idx) {
    const int h = (int)(idx & 7); const long t = idx >> 3;
    float m[3], l[3];
#pragma unroll
    for (int br = 0; br < 3; ++br) { const float* mp = dml + (((size_t)br * T + t) * 8 + h) * 2; m[br] = mp[0]; l[br] = mp[1]; }
    const float M = fmaxf(m[0], fmaxf(m[1], m[2]));
    float wgt[3], den = 0.f;
#pragma unroll
    for (int br = 0; br < 3; ++br) { wgt[br] = expf(m[br] - M) * l[br]; den += wgt[br]; }
    const float inv = 1.f / den;
    bf16* y = ycat + (size_t)t * 2048 + 1536 + h * 64;
    for (int i = 0; i < 64; ++i) { float a = 0.f;
#pragma unroll
        for (int br = 0; br < 3; ++br) a += wgt[br] * bf2f(dpo[((size_t)br * T + t) * 512 + h * 64 + i]);
        y[i] = f2bf(a * inv); }
}
HD void el_sgu_main(const Ctx& c, long idx) {
    const int j = (int)(idx & 511); const long t = idx >> 9; const int s = (int)(t % SEQ), p = s & 127, g = j >> 6; const long t0 = t - p;
    const float* w = c.sgu_w + ((size_t)g * 128 + p) * 128;
    const bf16* v = c.proj + (size_t)t0 * NPROJ + OFF_C + 512 + j;
    float acc = 0.f;
    for (int q = 0; q < 128; ++q) acc += w[q] * bf2f(v[(size_t)q * NPROJ]);
    const float u = geluf_(bf2f(c.proj[(size_t)t * NPROJ + OFF_C + j]));
    c.ycat[(size_t)t * 2048 + 1024 + j] = f2bf(u * (acc + c.sgu_bias[g * 128 + p]));
}
HD void el_ret_scan(const Ctx& c, long idx) {
    const int de = (int)(idx & 4095); const long r = idx >> 12; const int dir = (int)(r & 1), h = (int)((r >> 1) & 7);
    const float cd = expf(128.f * logsigmoidf_(c.gam[dir * 8 + h]));
    float kv[NC];
#pragma unroll
    for (int k = 0; k < NC; ++k) { const int ch = dir == 0 ? k : NC - 1 - k; kv[k] = c.rkv[((size_t)r * NC + ch) * 4096 + de]; }
    float S = 0.f;
#pragma unroll
    for (int k = 0; k < NC; ++k) { const int ch = dir == 0 ? k : NC - 1 - k; c.rsp[((size_t)r * NC + ch) * 4096 + de] = S; S = S * cd + kv[k]; }
}
HD void el_rwkv_scan(const Ctx& c, long idx) {
    const int row = (int)(idx & 63); const long r = idx >> 6; const int dir = (int)(r & 1), h = (int)((r >> 1) & 7), b = (int)(r >> 4);
    const float* W = dir ? c.wb : c.wf; const bf16* KD = dir ? c.kdb : c.kdf; const bf16* AK = dir ? c.akb : c.akf; bf16* Y = dir ? c.yb : c.yf;
    float S[64];
#pragma unroll
    for (int i = 0; i < 64; ++i) S[i] = 0.f;
    for (int k = 0; k < SEQ; ++k) {
        asm volatile("" ::: "memory");
        const int s = dir ? SEQ - 1 - k : k; const size_t o = ((size_t)b * SEQ + s) * 512 + h * 64;
        float sk = 0.f;
#pragma unroll
        for (int q = 0; q < 4; ++q) { asm volatile("" ::: "memory");
#pragma unroll
            for (int i = 16 * q; i < 16 * q + 16; ++i) sk += S[i] * bf2f(c.kk[o + i]); }
        const float v = bf2f(c.vs[o + row]); float y = 0.f;
#pragma unroll
        for (int q = 0; q < 4; ++q) { asm volatile("" ::: "memory");
#pragma unroll
            for (int i = 16 * q; i < 16 * q + 16; ++i) { S[i] = S[i] * expf(W[o + i]) - sk * bf2f(AK[o + i]) + v * bf2f(KD[o + i]); y += S[i] * bf2f(c.rs[o + i]); } }
        Y[o + row] = f2bf(y);
    }
}
HD void el_ret_out(const Ctx& c, long idx) {
    const int h = (int)(idx & 7); const long t = idx >> 3; const int s = (int)(t % SEQ), n = s & 127, ch = s >> 7; const int b = (int)(t / SEQ);
    const float lgf = logsigmoidf_(c.gam[h]), lgb = logsigmoidf_(c.gam[8 + h]);
    const bf16* qp = c.proj + (size_t)t * NPROJ + OFF_A + h * 64;
    float o[64];
#pragma unroll
    for (int i = 0; i < 64; ++i) o[i] = 0.f;
    const bf16* kb = c.proj + (size_t)(t - n) * NPROJ + OFF_A + 512 + h * 64;
    for (int m = 0; m < 128; ++m) {
        asm volatile("" ::: "memory");
        const bf16* kp = kb + (size_t)m * NPROJ; const bf16* vp = kp + 512;
        float sc = 0.f;
#pragma unroll
        for (int i = 0; i < 64; ++i) sc += bf2f(qp[i]) * bf2f(kp[i]);
        sc *= m <= n ? expf(lgf * (float)(n - m)) : expf(lgb * (float)(m - n));
#pragma unroll
        for (int i = 0; i < 64; ++i) o[i] += sc * bf2f(vp[i]);
    }
    const float qdf = expf(lgf * (float)(n + 1)), qdb = expf(lgb * (float)(128 - n));
    const float* Sf = c.rsp + ((size_t)((b * 8 + h) * 2 + 0) * NC + ch) * 4096; const float* Sb = c.rsp + ((size_t)((b * 8 + h) * 2 + 1) * NC + ch) * 4096;
    for (int d = 0; d < 64; ++d) { asm volatile("" ::: "memory"); const float qd = bf2f(qp[d]); const float a = qd * qdf, bb = qd * qdb;
#pragma unroll
        for (int i = 0; i < 64; ++i) o[i] += a * Sf[d * 64 + i] + bb * Sb[d * 64 + i]; }
    float mu = 0.f;
#pragma unroll
    for (int i = 0; i < 64; ++i) mu += o[i];
    mu *= (1.f / 64.f); float var = 0.f;
#pragma unroll
    for (int i = 0; i < 64; ++i) { const float d = o[i] - mu; var += d * d; }
    const float rstd = 1.f / sqrtf(var * (1.f / 64.f) + GN_EPS);
    const bf16* gp = c.proj + (size_t)t * NPROJ + OFF_A + 1536 + h * 64; bf16* y = c.ycat + (size_t)t * 2048 + h * 64;
    for (int i = 0; i < 64; i += 8) { asm volatile("" ::: "memory");
#pragma unroll
        for (int j = 0; j < 8; ++j) y[i + j] = f2bf(siluf_(bf2f(gp[i + j])) * ((o[i + j] - mu) * rstd * c.ret_g[h * 64 + i + j])); }
}
HD void el_rwkv_fin(const Ctx& c, long idx) {
    const int h = (int)(idx & 7); const long t = idx >> 3; const size_t o = (size_t)t * 512 + h * 64;
    float mu = 0.f, bonus = 0.f;
    for (int i = 0; i < 64; ++i) { mu += bf2f(c.yf[o + i]) + bf2f(c.yb[o + i]); bonus += bf2f(c.rs[o + i]) * bf2f(c.ks[o + i]) * c.r_k[h * 64 + i]; }
    mu *= (1.f / 64.f); float var = 0.f;
    for (int i = 0; i < 64; ++i) { const float d = bf2f(c.yf[o + i]) + bf2f(c.yb[o + i]) - mu; var += d * d; }
    const float rstd = 1.f / sqrtf(var * (1.f / 64.f) + GN_EPS);
    bf16* out = c.ycat + (size_t)t * 2048 + 512 + h * 64;
    for (int i = 0; i < 64; ++i) { const float y = bf2f(c.yf[o + i]) + bf2f(c.yb[o + i]);
        out[i] = f2bf(((y - mu) * rstd * c.ln_g[h * 64 + i] + bonus * bf2f(c.vs[o + i])) * bf2f(c.gg[o + i])); }
}
HD void route_select(const float (&lg)[4], const float (&le)[32], const float* bg, const float* be, int& e1, int& e2, float& g1, float& g2) {
    float l[4]; float mx = -1e30f; int gi = 0;
#pragma unroll
    for (int i = 0; i < 4; ++i) { l[i] = lg[i] + bg[i]; if (l[i] > mx) { mx = l[i]; gi = i; } }
    float den = 0.f;
#pragma unroll
    for (int i = 0; i < 4; ++i) den += expf(l[i] - mx);
    const float gtop = 1.f / den;
    float el[8];
#pragma unroll
    for (int i = 0; i < 8; ++i) { float v = 0.f;
#pragma unroll
        for (int g = 0; g < 4; ++g) v = (g == gi) ? le[g * 8 + i] + be[g * 8 + i] : v;
        el[i] = v; }
    float m1 = -1e30f, m2 = -1e30f; int i1 = 0, i2 = 0;
#pragma unroll
    for (int i = 0; i < 8; ++i) { if (el[i] > m1) { m2 = m1; i2 = i1; m1 = el[i]; i1 = i; } else if (el[i] > m2) { m2 = el[i]; i2 = i; } }
    const float p2 = expf(m2 - m1);
    g1 = gtop / (1.f + p2); g2 = gtop * p2 / (1.f + p2); e1 = gi * 8 + i1; e2 = gi * 8 + i2;
}

#ifndef KB_HOST_ONLY
namespace pg8 {
#define PG8_LAS __attribute__((address_space(3)))
typedef unsigned short bf16_t;
typedef short bf16x8 __attribute__((ext_vector_type(8)));
typedef float f32x4 __attribute__((ext_vector_type(4)));
typedef unsigned u32x4 __attribute__((ext_vector_type(4)));
constexpr int BM = 256, BK = 64, HALF = 128, HTB = HALF * BK * 2, STAGE_BYTES = 8 * HTB, NXCD = 8, WGM = 8;
__host__ __device__ __forceinline__ int lds_byte(int r, int c) { const int st = (r >> 4) * 2 + (c >> 5), rr = r & 15, cc = c & 31, ob = rr * 64 + cc * 2; return st * 1024 + (ob ^ (((ob >> 9) & 1) << 5)); }
__host__ __device__ __forceinline__ void stage_rc(int b, int& R, int& C) { const int st = b / 1024, sb = b % 1024, swz = sb ^ (((sb >> 9) & 1) << 5); R = (st >> 1) * 16 + swz / 64; C = (st & 1) * 32 + (swz % 64) / 2; }
__host__ __device__ __forceinline__ int perm32(int rho) { const int n = rho >> 4, i = rho & 15; return 8 * (i >> 2) + 4 * n + (i & 3); }
struct Unit { int pm, pn, pe; };
struct Gemm { const bf16_t* A; const bf16_t* Bt; int M, N, K; size_t bstride; int bmap; };
template <int M, int N> struct StaticOrder {
    static constexpr int nM = M / BM, nN = N / BM, nwg = nM * nN;
    int G, c;
    __host__ __device__ void init(int G_, int c_) { G = G_; c = c_; }
    __host__ __device__ __forceinline__ bool next(int i, Unit& u) const {
        const int L = i * G + c; if (L >= nwg) return false;
        int wgid = L; { constexpr int q = nwg / NXCD, r = nwg % NXCD; const int xcd = wgid % NXCD, off = wgid / NXCD; wgid = (xcd < r ? xcd * (q + 1) : r * (q + 1) + (xcd - r) * q) + off; }
        constexpr int nig = WGM * nN; const int gid = wgid / nig, fm = gid * WGM, gsz = (nM - fm) < WGM ? (nM - fm) : WGM;
        u.pm = fm + ((wgid % nig) % gsz); u.pn = (wgid % nig) / gsz; u.pe = 0; return true;
    }
    __device__ __forceinline__ void a_ready(const Unit&) const {}
    __device__ __forceinline__ void done(const Unit&) const {}
};
template <int NN> struct MoeOrder {
    int G, c, ntiles; const PG8_LAS int* tile_exp;
    __device__ __forceinline__ bool next(int i, Unit& u) const {
        const int L = i * G + c; if (L >= ntiles * NN) return false;
        u.pm = L / NN; u.pn = L % NN; u.pe = __builtin_amdgcn_readfirstlane(tile_exp[u.pm]); return true;
    }
    __device__ __forceinline__ void a_ready(const Unit&) const {}
    __device__ __forceinline__ void done(const Unit&) const {}
};
__device__ __forceinline__ unsigned cvt_pk_bf16(float lo, float hi) { unsigned r; asm volatile("v_cvt_pk_bf16_f32 %0, %1, %2" : "=v"(r) : "v"(lo), "v"(hi)); return r; }
struct EpiBf16 {
    static constexpr bool PERM = true, AFTER_DRAIN = false;
    bf16_t* O; int ldc;
    __device__ __forceinline__ void operator()(const f32x4 (&acc)[2][2][4][2], const Unit& u, int wr, int wc, int fr, int fq) const {
        const int row0 = u.pm * BM + wr * 64 + fr, col0 = u.pn * BM + wc * 32 + 8 * fq;
#pragma unroll
        for (int ai = 0; ai < 2; ++ai)
#pragma unroll
            for (int m = 0; m < 4; ++m) { bf16_t* rowp = O + (size_t)(row0 + ai * HALF + m * 16) * ldc + col0;
#pragma unroll
                for (int bj = 0; bj < 2; ++bj) { const f32x4 v0 = acc[ai][bj][m][0], v1 = acc[ai][bj][m][1];
                    u32x4 w; w.x = cvt_pk_bf16(v0[0], v0[1]); w.y = cvt_pk_bf16(v0[2], v0[3]); w.z = cvt_pk_bf16(v1[0], v1[1]); w.w = cvt_pk_bf16(v1[2], v1[3]);
                    *(u32x4*)(rowp + bj * HALF) = w; } }
    }
};
struct EpiBf16Rot {
    static constexpr bool PERM = true, AFTER_DRAIN = false;
    bf16_t* O; int ldc; const float* rot;
    __device__ __forceinline__ void operator()(const f32x4 (&acc)[2][2][4][2], const Unit& u, int wr, int wc, int fr, int fq) const {
        const int row0 = u.pm * BM + wr * 64 + fr, col0 = u.pn * BM + wc * 32 + 8 * fq;
        const bool retT = u.pn < (OFF_A + 1024) / BM, dilT = u.pn >= OFF_D / BM && u.pn < (OFF_D + 1024) / BM;
        const int p = col0 & 63; const bool on = retT || (dilT && p < 16); const int f0 = (retT ? 0 : 32) + (p >> 1);
#pragma unroll
        for (int ai = 0; ai < 2; ++ai)
#pragma unroll
            for (int m = 0; m < 4; ++m) { const int row = row0 + ai * HALF + m * 16; bf16_t* rowp = O + (size_t)row * ldc + col0;
                f32x4 c0 = (f32x4){1.f, 0.f, 1.f, 0.f}, c1 = c0;
                if (on) { const float* rp = rot + ((size_t)row * 40 + f0) * 2; c0 = *(const f32x4*)rp; c1 = *(const f32x4*)(rp + 4); }
#pragma unroll
                for (int bj = 0; bj < 2; ++bj) { const f32x4 v0 = acc[ai][bj][m][0], v1 = acc[ai][bj][m][1];
                    u32x4 w; w.x = cvt_pk_bf16(v0[0] * c0[0] - v0[1] * c0[1], v0[1] * c0[0] + v0[0] * c0[1]); w.y = cvt_pk_bf16(v0[2] * c0[2] - v0[3] * c0[3], v0[3] * c0[2] + v0[2] * c0[3]);
                    w.z = cvt_pk_bf16(v1[0] * c1[0] - v1[1] * c1[1], v1[1] * c1[0] + v1[0] * c1[1]); w.w = cvt_pk_bf16(v1[2] * c1[2] - v1[3] * c1[3], v1[3] * c1[2] + v1[2] * c1[3]);
                    *(u32x4*)(rowp + bj * HALF) = w; } }
    }
};
struct EpiResB {
    static constexpr bool PERM = true, AFTER_DRAIN = false;
    const float* base32; const bf16_t* base16; bf16_t* out; int ldc;
    __device__ __forceinline__ void operator()(const f32x4 (&acc)[2][2][4][2], const Unit& u, int wr, int wc, int fr, int fq) const {
        const int row0 = u.pm * BM + wr * 64 + fr, col0 = u.pn * BM + wc * 32 + 8 * fq;
#pragma unroll
        for (int ai = 0; ai < 2; ++ai)
#pragma unroll
            for (int m = 0; m < 4; ++m) { const size_t off = (size_t)(row0 + ai * HALF + m * 16) * ldc + col0;
#pragma unroll
                for (int bj = 0; bj < 2; ++bj) { f32x4 v0 = acc[ai][bj][m][0], v1 = acc[ai][bj][m][1];
                    if (base32) { v0 += *(const f32x4*)(base32 + off + bj * HALF); v1 += *(const f32x4*)(base32 + off + bj * HALF + 4); }
                    else { const u32x4 b = *(const u32x4*)(base16 + off + bj * HALF);
                        v0[0] += __builtin_bit_cast(float, b.x << 16); v0[1] += __builtin_bit_cast(float, b.x & 0xffff0000u); v0[2] += __builtin_bit_cast(float, b.y << 16); v0[3] += __builtin_bit_cast(float, b.y & 0xffff0000u);
                        v1[0] += __builtin_bit_cast(float, b.z << 16); v1[1] += __builtin_bit_cast(float, b.z & 0xffff0000u); v1[2] += __builtin_bit_cast(float, b.w << 16); v1[3] += __builtin_bit_cast(float, b.w & 0xffff0000u); }
                    u32x4 w; w.x = cvt_pk_bf16(v0[0], v0[1]); w.y = cvt_pk_bf16(v0[2], v0[3]); w.z = cvt_pk_bf16(v1[0], v1[1]); w.w = cvt_pk_bf16(v1[2], v1[3]);
                    *(u32x4*)(out + off + bj * HALF) = w; } }
    }
};
struct EpiSwiGLU {
    static constexpr bool PERM = true, AFTER_DRAIN = false;
    bf16_t* O; int ldc;
    __device__ __forceinline__ void operator()(const f32x4 (&acc)[2][2][4][2], const Unit& u, int wr, int wc, int fr, int fq) const {
        const int row0 = u.pm * BM + wr * 64 + fr, col0 = u.pn * HALF + wc * 32 + 8 * fq;
#pragma unroll
        for (int ai = 0; ai < 2; ++ai)
#pragma unroll
            for (int m = 0; m < 4; ++m) { bf16_t* rowp = O + (size_t)(row0 + ai * HALF + m * 16) * ldc + col0;
                float h[8];
#pragma unroll
                for (int n = 0; n < 2; ++n)
#pragma unroll
                    for (int j = 0; j < 4; ++j) { const float g = acc[ai][0][m][n][j], up = acc[ai][1][m][n][j]; h[n * 4 + j] = g * __builtin_amdgcn_rcpf(1.f + __expf(-g)) * up; }
                u32x4 w; w.x = cvt_pk_bf16(h[0], h[1]); w.y = cvt_pk_bf16(h[2], h[3]); w.z = cvt_pk_bf16(h[4], h[5]); w.w = cvt_pk_bf16(h[6], h[7]);
                *(u32x4*)rowp = w; }
    }
};

template <int KK, class Epi, class Sched, bool ALIGN_EPI = false, bool SP2 = false>
__device__ __forceinline__ void gemm_phase(PG8_LAS unsigned char* lds, const Gemm g, const Sched& S, const Epi& E, const int tid) {
    const int wid = __builtin_amdgcn_readfirstlane(tid >> 6), lane = tid & 63, wr = wid >> 2, wc = wid & 3, fr = lane & 15, fq = lane >> 4;
    constexpr int K = KK, nt = K / BK;
    unsigned voffA[2], voffB[2];
#pragma unroll
    for (int i = 0; i < 2; ++i) { int R, C; stage_rc(tid * 16 + i * 8192, R, C); const int Rb = Epi::PERM ? ((R & ~31) + perm32(R & 31)) : R;
        voffA[i] = (unsigned)(R * K + C) * 2u; voffB[i] = (unsigned)(Rb * K + C) * 2u; }
    constexpr size_t kstep = (size_t)(BK * 2);
    constexpr size_t hstep = (size_t)HALF * K * 2;
    constexpr size_t tstep = 2 * hstep;
    const unsigned ldsw = (unsigned)wid * 1024u;
    const int aoff = lds_byte(wr * 64 + fr, fq * 8), boff = lds_byte(wc * 32 + fr, fq * 8);
#define PG8_SA(b, h) (((b) * 2 + (h)) * HTB)
#define PG8_SB(b, h) ((4 + (b) * 2 + (h)) * HTB)
#define PG8_STAGE(bufoff, gbase, voff) do { _Pragma("unroll") for (int _i = 0; _i < 2; ++_i) \
        __builtin_amdgcn_global_load_lds((const unsigned*)((const char*)(gbase) + (voff)[_i]), (PG8_LAS unsigned*)(lds + (bufoff) + ldsw + _i * 8192), 16, 0, 0); } while (0)
#define PG8_LDA(dst, b, h) do { _Pragma("unroll") for (int m = 0; m < 4; ++m) _Pragma("unroll") for (int k = 0; k < 2; ++k) dst[m][k] = *(const PG8_LAS bf16x8*)(lds + PG8_SA(b, h) + aoff + m * 2048 + k * 1024); } while (0)
#define PG8_LDB(dst, b, h) do { _Pragma("unroll") for (int n = 0; n < 2; ++n) _Pragma("unroll") for (int k = 0; k < 2; ++k) dst[n][k] = *(const PG8_LAS bf16x8*)(lds + PG8_SB(b, h) + boff + n * 2048 + k * 1024); } while (0)
#define PG8_MMA(ai, bj, At, Bt) do { __builtin_amdgcn_s_setprio(1); _Pragma("unroll") for (int m = 0; m < 4; ++m) _Pragma("unroll") for (int n = 0; n < 2; ++n) _Pragma("unroll") for (int k = 0; k < 2; ++k) \
        acc[ai][bj][m][n] = __builtin_amdgcn_mfma_f32_16x16x32_bf16(Bt[n][k], At[m][k], acc[ai][bj][m][n], 0, 0, 0); __builtin_amdgcn_s_setprio(0); } while (0)
#define PG8_WAIT_V(n) asm volatile("s_waitcnt vmcnt(" #n ")" ::: "memory")
#define PG8_WAIT_L(n) asm volatile("s_waitcnt lgkmcnt(" #n ")" ::: "memory")
#define PG8_BAR __builtin_amdgcn_s_barrier()
#define PG8_SCHED __builtin_amdgcn_sched_barrier(0)
    Unit cur, nxt; int ui = 0;
    if (!S.next(0, cur)) return;
    f32x4 acc[2][2][4][2];
#pragma unroll
    for (int a = 0; a < 2; ++a)
#pragma unroll
        for (int b = 0; b < 2; ++b)
#pragma unroll
            for (int m = 0; m < 4; ++m)
#pragma unroll
                for (int n = 0; n < 2; ++n) acc[a][b][m][n] = (f32x4){0.f, 0.f, 0.f, 0.f};
    bf16x8 At[4][2], B0[2][2], B1[2][2];
    const char* cA = (const char*)g.A + (size_t)cur.pm * tstep; const char* cB = (const char*)g.Bt + (g.bmap ? wgu_off(cur.pe) : (size_t)cur.pe * g.bstride) + (size_t)cur.pn * tstep;
    S.a_ready(cur);
    if constexpr (SP2) {
        PG8_STAGE(PG8_SB(0, 0), cB, voffB); PG8_STAGE(PG8_SB(0, 1), cB + hstep, voffB); PG8_STAGE(PG8_SA(0, 0), cA, voffA); PG8_STAGE(PG8_SA(0, 1), cA + hstep, voffA);
        if (wr == 1) PG8_BAR;
        PG8_WAIT_V(2); PG8_BAR;
        PG8_STAGE(PG8_SB(1, 0), cB + kstep, voffB); PG8_STAGE(PG8_SA(1, 0), cA + kstep, voffA); PG8_STAGE(PG8_SB(1, 1), cB + hstep + kstep, voffB);
        PG8_WAIT_V(6); PG8_BAR;
    } else {
        PG8_STAGE(PG8_SB(0, 0), cB, voffB); PG8_STAGE(PG8_SA(0, 0), cA, voffA); PG8_STAGE(PG8_SB(0, 1), cB + hstep, voffB); PG8_STAGE(PG8_SA(0, 1), cA + hstep, voffA);
        if (wr == 1) PG8_BAR;
        PG8_WAIT_V(4); PG8_BAR;
        PG8_STAGE(PG8_SB(1, 0), cB + kstep, voffB); PG8_STAGE(PG8_SA(1, 0), cA + kstep, voffA); PG8_STAGE(PG8_SB(1, 1), cB + hstep + kstep, voffB);
        PG8_WAIT_V(6); PG8_BAR;
    }
    for (;;) {
        const bool has_next = S.next(ui + 1, nxt);
        const char* nA = has_next ? (const char*)g.A + (size_t)nxt.pm * tstep : cA; const char* nB = has_next ? (const char*)g.Bt + (g.bmap ? wgu_off(nxt.pe) : (size_t)nxt.pe * g.bstride) + (size_t)nxt.pn * tstep : cB;
        for (int t = 0; t < nt; t += 2) {
            const bool last = (t == nt - 2);
            const char* a1 = cA + (size_t)(t + 1) * kstep;
            const char* a2 = last ? nA : cA + (size_t)(t + 2) * kstep; const char* b2 = last ? nB : cB + (size_t)(t + 2) * kstep;
            const char* a3 = a2 + kstep; const char* b3 = b2 + kstep;
            if (last && has_next) S.a_ready(nxt);
            if constexpr (SP2) {
            PG8_LDB(B0, 0, 0); PG8_LDB(B1, 0, 1); PG8_SCHED; PG8_LDA(At, 0, 0); PG8_STAGE(PG8_SA(1, 1), a1 + hstep, voffA);
            PG8_WAIT_V(8); PG8_WAIT_L(0); PG8_BAR; PG8_MMA(0, 0, At, B0); PG8_MMA(0, 1, At, B1); PG8_BAR; PG8_SCHED;
            PG8_LDA(At, 0, 1); PG8_STAGE(PG8_SB(0, 0), b2, voffB); PG8_STAGE(PG8_SB(0, 1), b2 + hstep, voffB); PG8_STAGE(PG8_SA(0, 0), a2, voffA);
            PG8_WAIT_V(8); PG8_WAIT_L(0); PG8_BAR; PG8_MMA(1, 0, At, B0); PG8_MMA(1, 1, At, B1); PG8_BAR; PG8_SCHED;
            PG8_LDB(B0, 1, 0); PG8_LDB(B1, 1, 1); PG8_SCHED; PG8_LDA(At, 1, 0); PG8_STAGE(PG8_SA(0, 1), a2 + hstep, voffA);
            PG8_WAIT_V(8); PG8_WAIT_L(0); PG8_BAR; PG8_MMA(0, 0, At, B0); PG8_MMA(0, 1, At, B1); PG8_BAR; PG8_SCHED;
            PG8_LDA(At, 1, 1); PG8_STAGE(PG8_SB(1, 0), b3, voffB); PG8_STAGE(PG8_SB(1, 1), b3 + hstep, voffB); PG8_STAGE(PG8_SA(1, 0), a3, voffA);
            PG8_WAIT_V(8); PG8_WAIT_L(0); PG8_BAR; PG8_MMA(1, 0, At, B0); PG8_MMA(1, 1, At, B1); PG8_BAR; PG8_SCHED;
            } else {
            PG8_LDB(B0, 0, 0); PG8_SCHED; PG8_LDA(At, 0, 0); PG8_STAGE(PG8_SA(1, 1), a1 + hstep, voffA);
            PG8_WAIT_L(8); PG8_BAR; PG8_WAIT_L(0); PG8_MMA(0, 0, At, B0); PG8_BAR; PG8_SCHED;
            PG8_LDB(B1, 0, 1); PG8_STAGE(PG8_SB(0, 0), b2, voffB);
            PG8_BAR; PG8_WAIT_L(0); PG8_MMA(0, 1, At, B1); PG8_BAR;
            PG8_LDA(At, 0, 1); PG8_STAGE(PG8_SA(0, 0), a2, voffA);
            PG8_BAR; PG8_WAIT_L(0); PG8_MMA(1, 0, At, B0); PG8_BAR; PG8_SCHED;
            PG8_STAGE(PG8_SB(0, 1), b2 + hstep, voffB);
            PG8_WAIT_V(6); PG8_BAR; PG8_MMA(1, 1, At, B1); PG8_BAR;
            PG8_LDB(B0, 1, 0); PG8_SCHED; PG8_LDA(At, 1, 0); PG8_STAGE(PG8_SA(0, 1), a2 + hstep, voffA);
            PG8_WAIT_L(8); PG8_BAR; PG8_WAIT_L(0); PG8_MMA(0, 0, At, B0); PG8_BAR; PG8_SCHED;
            PG8_LDB(B1, 1, 1); PG8_STAGE(PG8_SB(1, 0), b3, voffB);
            PG8_BAR; PG8_WAIT_L(0); PG8_MMA(0, 1, At, B1); PG8_BAR;
            PG8_LDA(At, 1, 1); PG8_STAGE(PG8_SA(1, 0), a3, voffA);
            PG8_BAR; PG8_WAIT_L(0); PG8_MMA(1, 0, At, B0); PG8_BAR; PG8_SCHED;
            PG8_STAGE(PG8_SB(1, 1), b3 + hstep, voffB);
            PG8_WAIT_V(6); PG8_BAR; PG8_MMA(1, 1, At, B1); PG8_BAR;
            }
        }
        if constexpr (ALIGN_EPI) { if (wr == 0) PG8_BAR; }
        E(acc, cur, wr, wc, fr, fq); S.done(cur);
        if (!has_next) break;
#pragma unroll
        for (int a = 0; a < 2; ++a)
#pragma unroll
            for (int b = 0; b < 2; ++b)
#pragma unroll
                for (int m = 0; m < 4; ++m)
#pragma unroll
                    for (int n = 0; n < 2; ++n) acc[a][b][m][n] = (f32x4){0.f, 0.f, 0.f, 0.f};
        cur = nxt; cA = nA; cB = nB; ++ui;
        if constexpr (ALIGN_EPI) { if (wr == 1) PG8_BAR; }
    }
    PG8_WAIT_V(0);
    if constexpr (!ALIGN_EPI) { if (wr == 0) PG8_BAR; }
    PG8_BAR;
#undef PG8_SA
#undef PG8_SB
#undef PG8_STAGE
#undef PG8_LDA
#undef PG8_LDB
#undef PG8_MMA
#undef PG8_WAIT_V
#undef PG8_WAIT_L
#undef PG8_BAR
#undef PG8_SCHED
}
}

#define GAS __attribute__((address_space(1)))
#define LAS __attribute__((address_space(3)))
typedef unsigned v4u __attribute__((ext_vector_type(4)));
typedef unsigned v2u __attribute__((ext_vector_type(2)));
typedef float f32x4 __attribute__((ext_vector_type(4)));
#define LDS_WAIT() asm volatile("s_waitcnt lgkmcnt(0)" ::: "memory")
__device__ __forceinline__ unsigned pk2(float lo, float hi) { return (unsigned)f2bf(lo) | ((unsigned)f2bf(hi) << 16); }

#define XB_TMO      128
#define XB_XCNT(j)  (256  + 64 * (j))
#define XB_XSUB(j)  (1280 + 64 * (j))
#define XB_XGEN(j)  (2304 + 64 * (j))
#define XB_TOP      3328
#define XB_TOPGEN   3392
#define XCD_BAR_WORDS 3456
#define XB_SPIN_CAP (1u << 18)
__device__ __forceinline__ unsigned xb_ld(unsigned* p)              { return __hip_atomic_load(p, __ATOMIC_RELAXED, __HIP_MEMORY_SCOPE_AGENT); }
__device__ __forceinline__ unsigned xb_add(unsigned* p, unsigned v) { return __hip_atomic_fetch_add(p, v, __ATOMIC_RELAXED, __HIP_MEMORY_SCOPE_AGENT); }
__device__ __forceinline__ unsigned xb_xcc_id() { return (unsigned)__builtin_amdgcn_s_getreg((3 << 11) | 20) & 0xFu; }
#define XB_SPIN(cond, bar) do { unsigned _sp = 0; while (cond) { __builtin_amdgcn_s_sleep(1); \
    if ((++_sp & 255u) == 0u) { if (xb_ld(&(bar)[XB_TMO])) break; if (_sp > XB_SPIN_CAP) { atomicAdd(&(bar)[XB_TMO], 1u); break; } } } } while (0)
struct XcdBarrier { unsigned* bar; unsigned x; volatile LAS unsigned* st; };
__device__ __forceinline__ XcdBarrier xcd_barrier_post(unsigned* bar, volatile LAS unsigned* st) {
    XcdBarrier b; b.bar = bar; b.x = xb_xcc_id(); b.st = st;
    if (threadIdx.x == 0) (void)xb_add(&bar[XB_XCNT(b.x)], 1u);
    return b;
}
__device__ __forceinline__ void xcd_barrier_complete(unsigned* bar, unsigned x, unsigned& nloc, unsigned& nx) {
    const unsigned G = gridDim.x * gridDim.y * gridDim.z;
    unsigned sum, cnt, mine, sp = 0u;
    for (;;) {
        sum = 0u; cnt = 0u; mine = 0u;
#pragma unroll
        for (unsigned j = 0; j < 16; ++j) { const unsigned c = xb_ld(&bar[XB_XCNT(j)]); sum += c; cnt += (c > 0u) ? 1u : 0u; mine = (j == x) ? c : mine; }
        if (sum == G) break;
        __builtin_amdgcn_s_sleep(1);
        if ((++sp & 255u) == 0u) { if (xb_ld(&bar[XB_TMO])) break; if (sp > XB_SPIN_CAP) { atomicAdd(&bar[XB_TMO], 1u); break; } }
    }
    nloc = mine > 0u ? mine : 1u; nx = cnt > 0u ? cnt : 1u;
}
__device__ __forceinline__ void xcd_barrier(const XcdBarrier& b) {
    asm volatile("s_waitcnt vmcnt(0)" ::: "memory");
    __syncthreads();
    if (threadIdx.x == 0) {
        unsigned* bar = b.bar;
        __builtin_amdgcn_s_waitcnt(0);
        unsigned nloc = b.st[0], nx = b.st[1];
        if (nloc == 0u) { xcd_barrier_complete(bar, b.x, nloc, nx); b.st[0] = nloc; b.st[1] = nx; }
        const unsigned old = xb_add(&bar[XB_XSUB(b.x)], 1u);
        const unsigned gen = old / nloc;
        if (old + 1u == (gen + 1u) * nloc) {
            __builtin_amdgcn_fence(__ATOMIC_RELEASE, "agent");
            asm volatile("s_waitcnt vmcnt(0)" ::: "memory");
            const unsigned og = xb_add(&bar[XB_TOP], 1u);
            const unsigned tg = og / nx;
            if (og + 1u == (tg + 1u) * nx) xb_add(&bar[XB_TOPGEN], 1u);
            else XB_SPIN(xb_ld(&bar[XB_TOPGEN]) == tg, bar);
            __builtin_amdgcn_fence(__ATOMIC_ACQUIRE, "agent");
            xb_add(&bar[XB_XGEN(b.x)], 1u);
            asm volatile("s_waitcnt vmcnt(0)" ::: "memory");
        } else {
            XB_SPIN(xb_ld(&bar[XB_XGEN(b.x)]) == gen, bar);
            __builtin_amdgcn_fence(__ATOMIC_ACQUIRE, "agent");
            asm volatile("s_waitcnt vmcnt(0)" ::: "memory");
        }
    }
    __syncthreads();
}

constexpr int RING_BYTES = 131072;
constexpr int TAB_OFF = RING_BYTES;
constexpr int TAB_CNT = TAB_OFF, TAB_ROWBASE = TAB_OFF + 128, TAB_NT = TAB_OFF + 256, TAB_TEXP = TAB_OFF + 272;
constexpr int MISC_OFF = TAB_OFF + 4096;
constexpr int PTAB_OFF = MISC_OFF + 16;
constexpr int LDS_BYTES = 147456;
static_assert(TAB_TEXP + MOE_MAXTILES * 4 <= MISC_OFF && PTAB_OFF + 32 * 8 <= LDS_BYTES, "LDS map");

__device__ __forceinline__ float wave_sum(float v, int lane) {
#pragma unroll
    for (int o = 1; o < 64; o <<= 1) v += __builtin_bit_cast(float, __builtin_amdgcn_ds_bpermute((lane ^ o) << 2, __builtin_bit_cast(int, v)));
    return v;
}
__device__ __forceinline__ void transpose_item(const float* W, int K, int N, bf16* WT, int k0, int n0, int drow0, LAS float* scr, int lane, const float sc = 1.f, const int rmode = 0) {
#pragma unroll 8
    for (int i = 0; i < 32; ++i) { const int kk = 2 * i + (lane >> 5); scr[kk * 33 + (lane & 31)] = W[(size_t)(k0 + kk) * N + n0 + (lane & 31)]; }
    LDS_WAIT(); asm volatile("" ::: "memory");
    const int c = lane & 7;
#pragma unroll
    for (int j = 0; j < 4; ++j) { const int n = (lane >> 3) + 8 * j; const LAS float* s = scr + (8 * c) * 33 + n;
        v4u o; o.x = pk2(s[0 * 33] * sc, s[1 * 33] * sc); o.y = pk2(s[2 * 33] * sc, s[3 * 33] * sc); o.z = pk2(s[4 * 33] * sc, s[5 * 33] * sc); o.w = pk2(s[6 * 33] * sc, s[7 * 33] * sc);
        const int dn = rmode == 0 ? n : (rmode == 1 ? 2 * n : (n < 8 ? 2 * n : (n < 16 ? 2 * (n - 8) + 1 : n)));
        *(GAS v4u*)(WT + (size_t)(drow0 + dn) * K + k0 + 8 * c) = o; }
    LDS_WAIT(); asm volatile("" ::: "memory");
}


__device__ __forceinline__ void build_moe_tables(LAS unsigned char* lds, const unsigned* cnt_words, const int tid) {
    LAS int* tcnt = (LAS int*)(lds + TAB_CNT); LAS int* trb = (LAS int*)(lds + TAB_ROWBASE); LAS int* tnt = (LAS int*)(lds + TAB_NT); LAS int* texp = (LAS int*)(lds + TAB_TEXP);
    __syncthreads();
    if (cnt_words) { if (tid < NEXP) tcnt[tid] = (int)__hip_atomic_load(cnt_words + 64 * tid, __ATOMIC_RELAXED, __HIP_MEMORY_SCOPE_AGENT); }
    __syncthreads();
    if (tid == 0) { int tile = 0;
#pragma unroll 1
        for (int e = 0; e < NEXP; ++e) { int c = tcnt[e]; if (c > 2 * T) c = 2 * T; int nt = (c + 255) >> 8; if (tile + nt > MOE_MAXTILES) nt = MOE_MAXTILES - tile; trb[e] = tile * 256;
#pragma unroll 1
            for (int i = 0; i < nt; ++i) texp[tile + i] = e;
            tile += nt; }
        tnt[0] = tile; }
    __syncthreads();
}

__device__ __forceinline__ void transpose_item64(const float* W, int K, int N, bf16* WT, int k0, int n0, int drow0, LAS float* scr, int lane, const float sc = 1.f) {
    const int r = lane >> 4, c4 = lane & 15;
#pragma unroll 4
    for (int i = 0; i < 16; ++i) { const int k = 4 * i + r; const f32x4 v = *(const GAS f32x4*)(W + (size_t)(k0 + k) * N + n0 + 4 * c4);
        scr[k * 64 + ((4 * c4 + 0) ^ k)] = v.x; scr[k * 64 + ((4 * c4 + 1) ^ k)] = v.y; scr[k * 64 + ((4 * c4 + 2) ^ k)] = v.z; scr[k * 64 + ((4 * c4 + 3) ^ k)] = v.w; }
    LDS_WAIT(); asm volatile("" ::: "memory");
    const int c = lane & 7;
#pragma unroll
    for (int j = 0; j < 8; ++j) { const int n = (lane >> 3) + 8 * j; float f[8];
#pragma unroll
        for (int e = 0; e < 8; ++e) { const int k = 8 * c + e; f[e] = scr[k * 64 + (n ^ k)] * sc; }
        *(GAS v4u*)(WT + (size_t)(drow0 + n) * K + k0 + 8 * c) = (v4u){pk2(f[0], f[1]), pk2(f[2], f[3]), pk2(f[4], f[5]), pk2(f[6], f[7])}; }
    LDS_WAIT(); asm volatile("" ::: "memory");
}

struct TrItem { const float* src; bf16* dst; int K, N, k0, n0, drow0; };
__device__ __forceinline__ void tr64_load(f32x4 (&v)[16], const TrItem& p, int lane) { const int r = lane >> 4, c4 = lane & 15;
#pragma unroll
    for (int i = 0; i < 16; ++i) v[i] = *(const GAS f32x4*)(p.src + (size_t)(p.k0 + 4 * i + r) * p.N + p.n0 + 4 * c4); }
__device__ __forceinline__ void tr64_put(const f32x4 (&v)[16], LAS float* scr, int lane) { const int r = lane >> 4, c4 = lane & 15;
#pragma unroll
    for (int i = 0; i < 16; ++i) { const int k = 4 * i + r; scr[k * 64 + ((4 * c4 + 0) ^ k)] = v[i].x; scr[k * 64 + ((4 * c4 + 1) ^ k)] = v[i].y; scr[k * 64 + ((4 * c4 + 2) ^ k)] = v[i].z; scr[k * 64 + ((4 * c4 + 3) ^ k)] = v[i].w; }
    LDS_WAIT(); asm volatile("" ::: "memory"); }
__device__ __forceinline__ void tr64_get(const TrItem& p, LAS float* scr, int lane) { const int c = lane & 7;
#pragma unroll
    for (int j = 0; j < 8; ++j) { const int n = (lane >> 3) + 8 * j; float f[8];
#pragma unroll
        for (int e = 0; e < 8; ++e) { const int k = 8 * c + e; f[e] = scr[k * 64 + (n ^ k)]; }
        *(GAS v4u*)(p.dst + (size_t)(p.drow0 + n) * p.K + p.k0 + 8 * c) = (v4u){pk2(f[0], f[1]), pk2(f[2], f[3]), pk2(f[4], f[5]), pk2(f[6], f[7])}; }
    LDS_WAIT(); asm volatile("" ::: "memory"); }

struct Args { const void* in[30]; float* out; unsigned char* ws; int layer, pad; };
__device__ __forceinline__ Ctx make_ctx(const Args& args, unsigned char* ws, int l) {
    Ctx c;
    c.pos = (const int*)args.in[1];
    c.gam = (const float*)args.in[5] + l * 16; c.ret_g = (const float*)args.in[6] + l * 512; c.mu = (const float*)args.in[7] + l * 2 * B_COLS;
    c.w0 = (const float*)args.in[8] + l * 1024; c.w2 = (const float*)args.in[9] + l * 96 * 512; c.a0 = (const float*)args.in[10] + l * 1024; c.a2 = (const float*)args.in[11] + l * 96 * 512;
    c.g2 = (const float*)args.in[12] + l * 256 * 512; c.k_k = (const float*)args.in[13] + l * 512; c.k_a = (const float*)args.in[14] + l * 512; c.r_k = (const float*)args.in[15] + l * 512;
    c.ln_g = (const float*)args.in[16] + l * 512; c.sgu_g = (const float*)args.in[17] + l * 512; c.sgu_b = (const float*)args.in[18] + l * 512;
    c.sgu_w = (const float*)args.in[19] + (size_t)l * 8 * 128 * 128; c.sgu_bias = (const float*)args.in[20] + l * 1024;
    c.proj = (bf16*)(ws + WS_PROJ); c.ycat = (bf16*)(ws + WS_ACT);
    c.rs = (bf16*)(ws + WS_RS); c.ks = (bf16*)(ws + WS_KS); c.vs = (bf16*)(ws + WS_VS); c.kk = (bf16*)(ws + WS_KK); c.gg = (bf16*)(ws + WS_GG);
    c.kdf = (bf16*)(ws + WS_KDF); c.kdb = (bf16*)(ws + WS_KDB); c.akf = (bf16*)(ws + WS_AKF); c.akb = (bf16*)(ws + WS_AKB); c.yf = (bf16*)(ws + WS_YF); c.yb = (bf16*)(ws + WS_YB);
    c.lin = (bf16*)(ws + WS_LIN); c.wf = (float*)(ws + WS_WF); c.wb = (float*)(ws + WS_WB); c.rkv = (float*)(ws + WS_RKV); c.rsp = (float*)(ws + WS_RSP);
    return c;
}


#define ROW_LOAD(v, ptr) _Pragma("unroll") for (int j = 0; j < 8; ++j) v[j] = ((const GAS f32x4*)(ptr))[lane + 64 * j]
#define ROW_LOAD_BF(v, ptr) _Pragma("unroll") for (int j = 0; j < 8; ++j) { const v2u w_ = ((const GAS v2u*)(ptr))[lane + 64 * j]; \
    v[j] = (f32x4){__builtin_bit_cast(float, w_.x << 16), __builtin_bit_cast(float, w_.x & 0xffff0000u), __builtin_bit_cast(float, w_.y << 16), __builtin_bit_cast(float, w_.y & 0xffff0000u)}; }
__device__ __forceinline__ void row_add_moe(f32x4 (&v)[8], const bf16* yp, size_t R1, size_t R2, float g1, float g2, int lane) {
#pragma unroll
    for (int j = 0; j < 8; ++j) { const v2u a = ((const GAS v2u*)(yp + R1 * DM))[lane + 64 * j], b = ((const GAS v2u*)(yp + R2 * DM))[lane + 64 * j];
        v[j].x += g1 * bf2f((bf16)(a.x & 0xffff)) + g2 * bf2f((bf16)(b.x & 0xffff)); v[j].y += g1 * bf2f((bf16)(a.x >> 16)) + g2 * bf2f((bf16)(b.x >> 16));
        v[j].z += g1 * bf2f((bf16)(a.y & 0xffff)) + g2 * bf2f((bf16)(b.y & 0xffff)); v[j].w += g1 * bf2f((bf16)(a.y >> 16)) + g2 * bf2f((bf16)(b.y >> 16)); }
}
__device__ __forceinline__ float row_rstd(const f32x4 (&v)[8], int lane) {
    float ss = 0.f;
#pragma unroll
    for (int j = 0; j < 8; ++j) ss += (v[j].x * v[j].x + v[j].y * v[j].y) + (v[j].z * v[j].z + v[j].w * v[j].w);
    return 1.f / sqrtf(wave_sum(ss, lane) * (1.f / DM) + NORM_EPS);
}
__device__ __forceinline__ f32x4 up2(v2u w) { return (f32x4){__builtin_bit_cast(float, w.x << 16), __builtin_bit_cast(float, w.x & 0xffff0000u), __builtin_bit_cast(float, w.y << 16), __builtin_bit_cast(float, w.y & 0xffff0000u)}; }
template <int NB> __device__ __forceinline__ void wave_sum_n(float (&v)[NB], int lane) {
#pragma unroll
    for (int o = 1; o < 64; o <<= 1) { float t_[NB];
#pragma unroll
        for (int u = 0; u < NB; ++u) t_[u] = __builtin_bit_cast(float, __builtin_amdgcn_ds_bpermute((lane ^ o) << 2, __builtin_bit_cast(int, v[u])));
#pragma unroll
        for (int u = 0; u < NB; ++u) v[u] += t_[u]; } }
template <int NB>
__device__ __forceinline__ void rows_norm_f32(const float* x_in, const float* gain, bf16* act, int m0, int mstride, int lane) {
    f32x4 v[NB][8]; float ss[NB];
#pragma unroll
    for (int u = 0; u < NB; ++u) { const int m = m0 + u * mstride;
#pragma unroll
        for (int j = 0; j < 8; ++j) v[u][j] = m < T ? ((const GAS f32x4*)(x_in + (size_t)m * DM))[lane + 64 * j] : (f32x4){0.f, 0.f, 0.f, 0.f}; }
#pragma unroll
    for (int u = 0; u < NB; ++u) { ss[u] = 0.f;
#pragma unroll
        for (int j = 0; j < 8; ++j) ss[u] += (v[u][j].x * v[u][j].x + v[u][j].y * v[u][j].y) + (v[u][j].z * v[u][j].z + v[u][j].w * v[u][j].w); }
    wave_sum_n<NB>(ss, lane);
#pragma unroll
    for (int u = 0; u < NB; ++u) { const int m = m0 + u * mstride; const float rstd = 1.f / sqrtf(ss[u] * (1.f / DM) + NORM_EPS);
        if (m < T) {
#pragma unroll
            for (int j = 0; j < 8; ++j) { const f32x4 g = ((const GAS f32x4*)gain)[lane + 64 * j];
                v2u o; o.x = pk2(v[u][j].x * rstd * g.x, v[u][j].y * rstd * g.y); o.y = pk2(v[u][j].z * rstd * g.z, v[u][j].w * rstd * g.w);
                ((GAS v2u*)(act + (size_t)m * DM))[lane + 64 * j] = o; } } }
}
template <int NB, bool FINAL>
__device__ __forceinline__ void rows_moe(bf16* xbuf, const bf16* yp, const unsigned* slot_tok, const float* gate_tok, const LAS int* trb, const float* gain, bf16* act, float* out, float pscale, int m0, int mstride, int lane) {
    v2u xr[NB][8], ya[NB][8], yb[NB][8]; float g1[NB], g2[NB], ss[NB]; size_t R1[NB], R2[NB];
#pragma unroll
    for (int u = 0; u < NB; ++u) { const int m = m0 + u * mstride < T ? m0 + u * mstride : m0;
        const unsigned s1 = slot_tok[2 * m], s2 = slot_tok[2 * m + 1]; g1[u] = gate_tok[2 * m]; g2[u] = gate_tok[2 * m + 1];
        R1[u] = (size_t)(trb[s1 >> 20] + (int)(s1 & 0xfffffu)); R2[u] = (size_t)(trb[s2 >> 20] + (int)(s2 & 0xfffffu)); }
#pragma unroll
    for (int u = 0; u < NB; ++u) { const int m = m0 + u * mstride < T ? m0 + u * mstride : m0;
#pragma unroll
        for (int j = 0; j < 8; ++j) { xr[u][j] = ((const GAS v2u*)(xbuf + (size_t)m * DM))[lane + 64 * j]; ya[u][j] = ((const GAS v2u*)(yp + R1[u] * DM))[lane + 64 * j]; yb[u][j] = ((const GAS v2u*)(yp + R2[u] * DM))[lane + 64 * j]; } }
#pragma unroll
    for (int u = 0; u < NB; ++u) { const int m = m0 + u * mstride; ss[u] = 0.f;
#pragma unroll
        for (int j = 0; j < 8; ++j) { f32x4 t = up2(xr[u][j]) + g1[u] * up2(ya[u][j]) + g2[u] * up2(yb[u][j]);
            if constexpr (!FINAL) { v2u o; o.x = pk2(t.x, t.y); o.y = pk2(t.z, t.w); if (m < T) ((GAS v2u*)(xbuf + (size_t)m * DM))[lane + 64 * j] = o; t = up2(o); xr[u][j] = o; }
            else { ya[u][j] = (v2u){__builtin_bit_cast(unsigned, t.x), __builtin_bit_cast(unsigned, t.y)}; yb[u][j] = (v2u){__builtin_bit_cast(unsigned, t.z), __builtin_bit_cast(unsigned, t.w)}; }
            ss[u] += (t.x * t.x + t.y * t.y) + (t.z * t.z + t.w * t.w); } }
    wave_sum_n<NB>(ss, lane);
#pragma unroll
    for (int u = 0; u < NB; ++u) { const int m = m0 + u * mstride; const float rstd = 1.f / sqrtf(ss[u] * (1.f / DM) + NORM_EPS);
        if (m < T) {
#pragma unroll
            for (int j = 0; j < 8; ++j) { const f32x4 g = ((const GAS f32x4*)gain)[lane + 64 * j];
                if constexpr (!FINAL) { const f32x4 t = up2(xr[u][j]); v2u o; o.x = pk2(t.x * rstd * g.x, t.y * rstd * g.y); o.y = pk2(t.z * rstd * g.z, t.w * rstd * g.w); ((GAS v2u*)(act + (size_t)m * DM))[lane + 64 * j] = o; }
                else { const f32x4 t = (f32x4){__builtin_bit_cast(float, ya[u][j].x), __builtin_bit_cast(float, ya[u][j].y), __builtin_bit_cast(float, yb[u][j].x), __builtin_bit_cast(float, yb[u][j].y)};
                    ((GAS f32x4*)(out + (size_t)m * DM))[lane + 64 * j] = (f32x4){t.x * rstd * g.x * pscale, t.y * rstd * g.y * pscale, t.z * rstd * g.z * pscale, t.w * rstd * g.w * pscale}; } } } }
}
#define SEAM(k) do { if constexpr (KSEL < 0) { XcdBarrier b_ = bar; unsigned blo_ = __builtin_amdgcn_readfirstlane((unsigned)(unsigned long long)b_.bar), bhi_ = __builtin_amdgcn_readfirstlane((unsigned)((unsigned long long)b_.bar >> 32)); \
    asm volatile("" : "+s"(blo_), "+s"(bhi_)); b_.bar = (unsigned*)(((unsigned long long)bhi_ << 32) | blo_); xcd_barrier(b_); } } while (0)
#define PORD(k) ((k) == 13 ? 6 : ((k) >= 6 ? (k) + 1 : (k)))
#define TSTAMP_AFTER(k) do { if (KB_TPROBE >= 0 && KSEL < 0 && blockIdx.x == 0 && threadIdx.x == 0) ((unsigned long long*)(args.ws + WS_CTL))[32768 + 1 + l * 13 + PORD(k)] = wall_clock64(); } while (0)
#define PH_ON(k) if constexpr ((KSEL < 0 && KB_EN(k)) || KSEL == (k))
#define PHASE_LOCALS() GAS unsigned char* wsg_ = (GAS unsigned char*)args.ws; int ll = KSEL < 0 ? l : __builtin_amdgcn_readfirstlane(l); int tid = threadIdx.x; asm volatile("" : "+s"(wsg_), "+s"(ll), "+v"(tid)); \
    unsigned char* ws = (unsigned char*)wsg_;         \
    const int lane = tid & 63, wave = __builtin_amdgcn_readfirstlane(tid >> 6); \
    const int G = gridDim.x, bid = blockIdx.x; const long gtid = (long)bid * 512 + tid, gstride = (long)G * 512; const int gw = bid * 8 + wave, NGW = G * 8; \
    (void)gtid; (void)gstride; (void)gw; (void)NGW; (void)ll; (void)lane


typedef short bf16x8 __attribute__((ext_vector_type(8)));
typedef short s16x4 __attribute__((ext_vector_type(4)));
typedef short v4i16_t __attribute__((ext_vector_type(4)));
#ifndef KB_EMU
#define MMA16(a, b, c) __builtin_amdgcn_mfma_f32_16x16x32_bf16((a), (b), (c), 0, 0, 0)
#define TR16(p) __builtin_amdgcn_ds_read_tr16_b64_v4i16((LAS v4i16_t*)(p))
#define BPERM(addr, v) __builtin_amdgcn_ds_bpermute((addr), (v))
#define RFL(x) __builtin_amdgcn_readfirstlane(x)
#define FEXP(x) __expf(x)
#define BSYNC() __syncthreads()
#define LBAR() do { asm volatile("s_waitcnt lgkmcnt(0)" ::: "memory"); __builtin_amdgcn_s_barrier(); asm volatile("" ::: "memory"); } while (0)
#define LDS_WAIT_() do { asm volatile("s_waitcnt lgkmcnt(0)" ::: "memory"); } while (0)
#endif
__device__ __forceinline__ bf16x8 frag_row(const LAS bf16* X, int ld, int r0, int c0, int fr, int fq) { return *(const LAS bf16x8*)(X + (r0 + fr) * ld + c0 + 8 * fq); }
__device__ __forceinline__ s16x4 tr4(const LAS bf16* X, int ld, int r0, int c0, int fr) { return __builtin_bit_cast(s16x4, TR16(X + (r0 + (fr >> 2)) * ld + c0 + 4 * (fr & 3))); }
__device__ __forceinline__ bf16x8 frag_col(const LAS bf16* X, int ld, int k0, int c0, int fr, int fq) {
    const s16x4 a = tr4(X, ld, k0 + 8 * fq, c0, fr), b = tr4(X, ld, k0 + 8 * fq + 4, c0, fr);
    return (bf16x8){a[0], a[1], a[2], a[3], b[0], b[1], b[2], b[3]}; }
#ifndef KB_EMU
typedef float cvt_f2 __attribute__((ext_vector_type(2)));
typedef __bf16 cvt_b2 __attribute__((ext_vector_type(2)));
__device__ __forceinline__ unsigned cvtpk(float lo, float hi) { return __builtin_bit_cast(unsigned, __builtin_convertvector(((cvt_f2){lo, hi}), cvt_b2)); }
#else
inline unsigned cvtpk(float lo, float hi) { return (unsigned)f2bf(lo) | ((unsigned)f2bf(hi) << 16); }
#endif
__device__ __forceinline__ float xlane_max4(float v, int lane) {
    v = fmaxf(v, __builtin_bit_cast(float, BPERM((lane ^ 16) << 2, __builtin_bit_cast(int, v))));
    v = fmaxf(v, __builtin_bit_cast(float, BPERM((lane ^ 32) << 2, __builtin_bit_cast(int, v)))); return v; }
__device__ __forceinline__ float xlane_sum4(float v, int lane) {
    v += __builtin_bit_cast(float, BPERM((lane ^ 16) << 2, __builtin_bit_cast(int, v)));
    v += __builtin_bit_cast(float, BPERM((lane ^ 32) << 2, __builtin_bit_cast(int, v))); return v; }

__device__ __forceinline__ void unpack8(const v4u x, float (&f)[8]) {
    f[0] = __builtin_bit_cast(float, x.x << 16); f[1] = __builtin_bit_cast(float, x.x & 0xffff0000u); f[2] = __builtin_bit_cast(float, x.y << 16); f[3] = __builtin_bit_cast(float, x.y & 0xffff0000u);
    f[4] = __builtin_bit_cast(float, x.z << 16); f[5] = __builtin_bit_cast(float, x.z & 0xffff0000u); f[6] = __builtin_bit_cast(float, x.w << 16); f[7] = __builtin_bit_cast(float, x.w & 0xffff0000u); }
__device__ __forceinline__ void st8(bf16* p, const float (&f)[8]) { *(GAS v4u*)p = (v4u){cvtpk(f[0], f[1]), cvtpk(f[2], f[3]), cvtpk(f[4], f[5]), cvtpk(f[6], f[7])}; }
__device__ __forceinline__ float red8(float v, int lane) {
    v += __builtin_bit_cast(float, BPERM((lane ^ 1) << 2, __builtin_bit_cast(int, v))); v += __builtin_bit_cast(float, BPERM((lane ^ 2) << 2, __builtin_bit_cast(int, v)));
    v += __builtin_bit_cast(float, BPERM((lane ^ 4) << 2, __builtin_bit_cast(int, v))); return v; }
__device__ __forceinline__ void v_rot_table(const int* pos, float* rot, long idx) {
    const int j = (int)(idx % 40); const long t = idx / 40;
    const float inv = j < 32 ? expf(-(float)j * (1.f / 32.f) * 9.210340371976184f) : expf(-(float)(j - 32) * (1.f / 8.f) * 13.122363377404328f);
    float sn, cs; sincosf((float)pos[t] * inv, &sn, &cs); rot[idx * 2] = cs; rot[idx * 2 + 1] = sn; }
__device__ __forceinline__ void v_rot_ret(bf16* proj, const float* rot, long idx) {
    const int j8 = (int)(idx & 3), h = (int)((idx >> 2) & 7); const long t = idx >> 5;
    bf16* q = proj + (size_t)t * NPROJ + OFF_A + h * 64 + 8 * j8; bf16* k = q + 512; const float* cs = rot + ((size_t)t * 40 + 8 * j8) * 2;
    float q1[8], q2[8], k1[8], k2[8], c[8], s_[8];
    unpack8(*(const GAS v4u*)q, q1); unpack8(*(const GAS v4u*)(q + 32), q2); unpack8(*(const GAS v4u*)k, k1); unpack8(*(const GAS v4u*)(k + 32), k2);
#pragma unroll
    for (int i = 0; i < 4; ++i) { const f32x4 v = *(const GAS f32x4*)(cs + 4 * i); c[2 * i] = v.x; s_[2 * i] = v.y; c[2 * i + 1] = v.z; s_[2 * i + 1] = v.w; }
    float o1[8], o2[8], p1[8], p2[8];
#pragma unroll
    for (int i = 0; i < 8; ++i) { o1[i] = q1[i] * c[i] - q2[i] * s_[i]; o2[i] = q2[i] * c[i] + q1[i] * s_[i]; p1[i] = k1[i] * c[i] - k2[i] * s_[i]; p2[i] = k2[i] * c[i] + k1[i] * s_[i]; }
    st8(q, o1); st8(q + 32, o2); st8(k, p1); st8(k + 32, p2); }
__device__ __forceinline__ void v_rot_dil(bf16* proj, const float* rot, long idx) {
    const int h = (int)(idx & 7); const long t = idx >> 3;
    bf16* q = proj + (size_t)t * NPROJ + OFF_D + h * 64; bf16* k = q + 512; const float* cs = rot + ((size_t)t * 40 + 32) * 2;
    float q1[8], q2[8], k1[8], k2[8], c[8], s_[8];
    unpack8(*(const GAS v4u*)q, q1); unpack8(*(const GAS v4u*)(q + 8), q2); unpack8(*(const GAS v4u*)k, k1); unpack8(*(const GAS v4u*)(k + 8), k2);
#pragma unroll
    for (int i = 0; i < 4; ++i) { const f32x4 v = *(const GAS f32x4*)(cs + 4 * i); c[2 * i] = v.x; s_[2 * i] = v.y; c[2 * i + 1] = v.z; s_[2 * i + 1] = v.w; }
    float o1[8], o2[8], p1[8], p2[8];
#pragma unroll
    for (int i = 0; i < 8; ++i) { o1[i] = q1[i] * c[i] - q2[i] * s_[i]; o2[i] = q2[i] * c[i] + q1[i] * s_[i]; p1[i] = k1[i] * c[i] - k2[i] * s_[i]; p2[i] = k2[i] * c[i] + k1[i] * s_[i]; }
    st8(q, o1); st8(q + 8, o2); st8(k, p1); st8(k + 8, p2); }
__device__ __forceinline__ void v_rwkv_shift(const Ctx& c, long idx) {
    const int g8 = (int)(idx % 248), j0 = 8 * g8; const long t = idx / 248; const int s = (int)(t % SEQ);
    const bf16* p = c.proj + (size_t)t * NPROJ + OFF_B + j0;
    float x[8], xp[8], xn[8], o[8];
    unpack8(*(const GAS v4u*)p, x);
    if (s > 0) unpack8(*(const GAS v4u*)(p - NPROJ), xp); else { for (int i = 0; i < 8; ++i) xp[i] = 0.f; }
    if (s < SEQ - 1) unpack8(*(const GAS v4u*)(p + NPROJ), xn); else { for (int i = 0; i < 8; ++i) xn[i] = 0.f; }
#pragma unroll
    for (int i = 0; i < 8; ++i) o[i] = x[i] + c.mu[j0 + i] * (xp[i] - x[i]) + c.mu[B_COLS + j0 + i] * (xn[i] - x[i]);
    if (j0 < 512) st8(c.rs + t * 512 + j0, o);
    else if (j0 < 1024) st8(c.ks + t * 512 + j0 - 512, o);
    else if (j0 < 1536) st8(c.vs + t * 512 + j0 - 1024, o);
    else { if (j0 < 1632) { for (int i = 0; i < 8; ++i) o[i] = tanhf(o[i]); } else if (j0 >= 1728) { for (int i = 0; i < 8; ++i) o[i] = sigmoidf_(o[i]); }
        st8(c.lin + t * NLORA + (j0 - 1536), o); } }
struct ShiftIn { v4u x, xp, xn; };
__device__ __forceinline__ void shift_load(const Ctx& c, unsigned idx, ShiftIn& in) {
    const unsigned t = idx / 248u, j0 = 8u * (idx - t * 248u), s = t % (unsigned)SEQ;
    const bf16* p = c.proj + (size_t)t * NPROJ + OFF_B + j0; const v4u z = (v4u){0u, 0u, 0u, 0u};
    in.x = *(const GAS v4u*)p; in.xp = z; in.xn = z;
    if (s > 0) in.xp = *(const GAS v4u*)(p - NPROJ);
    if (s < (unsigned)SEQ - 1) in.xn = *(const GAS v4u*)(p + NPROJ); }
__device__ __forceinline__ void shift_finish(const Ctx& c, unsigned idx, const ShiftIn& in) {
    const unsigned t = idx / 248u, j0 = 8u * (idx - t * 248u);
    float x[8], xp[8], xn[8], o[8], mp[8], mn[8];
    unpack8(in.x, x); unpack8(in.xp, xp); unpack8(in.xn, xn);
    { const f32x4 a = *(const GAS f32x4*)(c.mu + j0), b = *(const GAS f32x4*)(c.mu + j0 + 4), d = *(const GAS f32x4*)(c.mu + B_COLS + j0), e = *(const GAS f32x4*)(c.mu + B_COLS + j0 + 4);
      mp[0] = a.x; mp[1] = a.y; mp[2] = a.z; mp[3] = a.w; mp[4] = b.x; mp[5] = b.y; mp[6] = b.z; mp[7] = b.w; mn[0] = d.x; mn[1] = d.y; mn[2] = d.z; mn[3] = d.w; mn[4] = e.x; mn[5] = e.y; mn[6] = e.z; mn[7] = e.w; }
#pragma unroll
    for (int i = 0; i < 8; ++i) o[i] = x[i] + mp[i] * (xp[i] - x[i]) + mn[i] * (xn[i] - x[i]);
    if (j0 < 512) st8(c.rs + (size_t)t * 512 + j0, o);
    else if (j0 < 1024) st8(c.ks + (size_t)t * 512 + j0 - 512, o);
    else if (j0 < 1536) st8(c.vs + (size_t)t * 512 + j0 - 1024, o);
    else { if (j0 < 1632) { for (int i = 0; i < 8; ++i) o[i] = tanhf(o[i]); } else if (j0 >= 1728) { for (int i = 0; i < 8; ++i) o[i] = sigmoidf_(o[i]); }
        st8(c.lin + (size_t)t * NLORA + (j0 - 1536), o); } }
__device__ __forceinline__ void w_sgu_prep(const Ctx& c, long t, int lane) {
    bf16* v = c.proj + (size_t)t * NPROJ + OFF_C + 512 + 8 * lane; float f[8]; unpack8(*(const GAS v4u*)v, f); float s = 0.f;
#pragma unroll
    for (int i = 0; i < 8; ++i) { f[i] = geluf_(f[i]); s += f[i]; }
    const float mean = wave_sum(s, lane) * (1.f / 512.f); float q = 0.f;
#pragma unroll
    for (int i = 0; i < 8; ++i) { f[i] -= mean; q += f[i] * f[i]; }
    const float rstd = 1.f / sqrtf(wave_sum(q, lane) * (1.f / 512.f) + NORM_EPS);
#pragma unroll
    for (int i = 0; i < 8; ++i) f[i] = f[i] * rstd * c.sgu_g[8 * lane + i] + c.sgu_b[8 * lane + i];
    st8(v, f); }
template <int NB>
__device__ __forceinline__ void w_sgu_prep_batch(const Ctx& c, int m0, int mstride, int lane) {
    float f[NB][8], s[NB], q[NB]; v4u raw[NB];
#pragma unroll
    for (int u = 0; u < NB; ++u) { const int t = m0 + u * mstride; raw[u] = (v4u){0u, 0u, 0u, 0u}; if (t < T) raw[u] = *(const GAS v4u*)(c.proj + (size_t)t * NPROJ + OFF_C + 512 + 8 * lane); }
#pragma unroll
    for (int u = 0; u < NB; ++u) { unpack8(raw[u], f[u]); s[u] = 0.f;
#pragma unroll
        for (int i = 0; i < 8; ++i) { f[u][i] = geluf_(f[u][i]); s[u] += f[u][i]; } }
#pragma unroll
    for (int o = 1; o < 64; o <<= 1) { float t_[NB];
#pragma unroll
        for (int u = 0; u < NB; ++u) t_[u] = __builtin_bit_cast(float, __builtin_amdgcn_ds_bpermute((lane ^ o) << 2, __builtin_bit_cast(int, s[u])));
#pragma unroll
        for (int u = 0; u < NB; ++u) s[u] += t_[u]; }
#pragma unroll
    for (int u = 0; u < NB; ++u) { const float mean = s[u] * (1.f / 512.f); q[u] = 0.f;
#pragma unroll
        for (int i = 0; i < 8; ++i) { f[u][i] -= mean; q[u] += f[u][i] * f[u][i]; } }
#pragma unroll
    for (int o = 1; o < 64; o <<= 1) { float t_[NB];
#pragma unroll
        for (int u = 0; u < NB; ++u) t_[u] = __builtin_bit_cast(float, __builtin_amdgcn_ds_bpermute((lane ^ o) << 2, __builtin_bit_cast(int, q[u])));
#pragma unroll
        for (int u = 0; u < NB; ++u) q[u] += t_[u]; }
    float gg_[8], bb_[8];
    { const f32x4 a = *(const GAS f32x4*)(c.sgu_g + 8 * lane), b = *(const GAS f32x4*)(c.sgu_g + 8 * lane + 4), d = *(const GAS f32x4*)(c.sgu_b + 8 * lane), e = *(const GAS f32x4*)(c.sgu_b + 8 * lane + 4);
      gg_[0] = a.x; gg_[1] = a.y; gg_[2] = a.z; gg_[3] = a.w; gg_[4] = b.x; gg_[5] = b.y; gg_[6] = b.z; gg_[7] = b.w; bb_[0] = d.x; bb_[1] = d.y; bb_[2] = d.z; bb_[3] = d.w; bb_[4] = e.x; bb_[5] = e.y; bb_[6] = e.z; bb_[7] = e.w; }
#pragma unroll
    for (int u = 0; u < NB; ++u) { const int t = m0 + u * mstride; const float rstd = 1.f / sqrtf(q[u] * (1.f / 512.f) + NORM_EPS);
#pragma unroll
        for (int i = 0; i < 8; ++i) f[u][i] = f[u][i] * rstd * gg_[i] + bb_[i];
        if (t < T) st8(c.proj + (size_t)t * NPROJ + OFF_C + 512 + 8 * lane, f[u]); } }
__device__ __forceinline__ void v_rwkv_kk(const Ctx& c, long idx, int lane) {
    const size_t o = (size_t)idx * 8; float k[8], af[8], ab[8]; unpack8(*(const GAS v4u*)(c.kk + o), k); unpack8(*(const GAS v4u*)(c.akf + o), af); unpack8(*(const GAS v4u*)(c.akb + o), ab);
    float ss = 0.f;
#pragma unroll
    for (int i = 0; i < 8; ++i) ss += k[i] * k[i];
    const float n = 1.f / sqrtf(red8(ss, lane) + 1e-12f);
#pragma unroll
    for (int i = 0; i < 8; ++i) { k[i] *= n; af[i] *= k[i]; ab[i] *= k[i]; }
    st8(c.kk + o, k); st8(c.akf + o, af); st8(c.akb + o, ab); }
__device__ __forceinline__ void v_dil_combine(const bf16* dpo, const float* dml, bf16* ycat, long idx) {
    const int cg = (int)(idx & 63), h = cg >> 3; const long t = idx >> 6; float m[3], l[3];
#pragma unroll
    for (int br = 0; br < 3; ++br) { const float* mp = dml + (((size_t)br * T + t) * 8 + h) * 2; m[br] = mp[0]; l[br] = mp[1]; }
    const float M = fmaxf(m[0], fmaxf(m[1], m[2])); float wgt[3], den = 0.f;
#pragma unroll
    for (int br = 0; br < 3; ++br) { wgt[br] = FEXP(m[br] - M) * l[br]; den += wgt[br]; }
    const float inv = 1.f / den; float y[8];
#pragma unroll
    for (int i = 0; i < 8; ++i) y[i] = 0.f;
#pragma unroll
    for (int br = 0; br < 3; ++br) { float f[8]; unpack8(*(const GAS v4u*)(dpo + ((size_t)br * T + t) * 512 + cg * 8), f); const float wv = wgt[br] * inv;
#pragma unroll
        for (int i = 0; i < 8; ++i) y[i] += wv * f[i]; }
    st8(ycat + (size_t)t * 2048 + 1536 + cg * 8, y); }
template <int NB>
__device__ __forceinline__ void v_dil_combine_batch(const bf16* dpo, const float* dml, bf16* ycat, long idx0, long istride, long iend) {
    cvt_f2 ml[NB][3]; v4u raw[NB][3];
#pragma unroll
    for (int u = 0; u < NB; ++u) { const long idx = idx0 + u * istride < iend ? idx0 + u * istride : idx0; const int cg = (int)(idx & 63), h = cg >> 3; const long t = idx >> 6;
#pragma unroll
        for (int br = 0; br < 3; ++br) { ml[u][br] = *(const GAS cvt_f2*)(dml + (((size_t)br * T + t) * 8 + h) * 2); raw[u][br] = *(const GAS v4u*)(dpo + ((size_t)br * T + t) * 512 + cg * 8); } }
#pragma unroll
    for (int u = 0; u < NB; ++u) { const long idx = idx0 + u * istride; const int cg = (int)(idx & 63); const long t = idx >> 6;
        const float M = fmaxf(ml[u][0].x, fmaxf(ml[u][1].x, ml[u][2].x)); float wgt[3], den = 0.f;
#pragma unroll
        for (int br = 0; br < 3; ++br) { wgt[br] = FEXP(ml[u][br].x - M) * ml[u][br].y; den += wgt[br]; }
        const float inv = 1.f / den; float y[8];
#pragma unroll
        for (int i = 0; i < 8; ++i) y[i] = 0.f;
#pragma unroll
        for (int br = 0; br < 3; ++br) { float f[8]; unpack8(raw[u][br], f); const float wv = wgt[br] * inv;
#pragma unroll
            for (int i = 0; i < 8; ++i) y[i] += wv * f[i]; }
        if (idx < iend) st8(ycat + (size_t)t * 2048 + 1536 + cg * 8, y); } }
__device__ __forceinline__ void v_rwkv_fin(const Ctx& c, long idx, int lane) {
    const int cg = (int)(idx & 63); const long t = idx >> 6; const size_t o = (size_t)idx * 8;
    float yf[8], yb[8], r[8], k[8], v[8], g[8]; unpack8(*(const GAS v4u*)(c.yf + o), yf); unpack8(*(const GAS v4u*)(c.yb + o), yb); unpack8(*(const GAS v4u*)(c.rs + o), r); unpack8(*(const GAS v4u*)(c.ks + o), k);
    unpack8(*(const GAS v4u*)(c.vs + o), v); unpack8(*(const GAS v4u*)(c.gg + o), g);
    float s = 0.f, bon = 0.f;
#pragma unroll
    for (int i = 0; i < 8; ++i) { yf[i] += yb[i]; s += yf[i]; bon += r[i] * k[i] * c.r_k[cg * 8 + i]; }
    const float mu = red8(s, lane) * (1.f / 64.f); bon = red8(bon, lane); float q = 0.f;
#pragma unroll
    for (int i = 0; i < 8; ++i) { yf[i] -= mu; q += yf[i] * yf[i]; }
    const float rstd = 1.f / sqrtf(red8(q, lane) * (1.f / 64.f) + GN_EPS); float out[8];
#pragma unroll
    for (int i = 0; i < 8; ++i) out[i] = (yf[i] * rstd * c.ln_g[cg * 8 + i] + bon * v[i]) * g[i];
    st8(c.ycat + (size_t)t * 2048 + 512 + cg * 8, out); }

constexpr int DIL_LD = 72, DIL_TEAM_BYTES = (64 + 192 + 192) * DIL_LD * 2;
static_assert(2 * DIL_TEAM_BYTES <= RING_BYTES, "dilated attention LDS");
__device__ __forceinline__ void dil_attn_phase(LAS unsigned char* lds, const bf16* proj, bf16* dpo, float* dml, const int tid, const int bid, const int G) {
    const int lane = tid & 63, wave = RFL(tid >> 6), team = wave >> 2, w = wave & 3, tt = tid & 255, fr = lane & 15, fq = lane >> 4;
    LAS bf16* Qs = (LAS bf16*)(lds + team * DIL_TEAM_BYTES); LAS bf16* Ks = Qs + 64 * DIL_LD; LAS bf16* Vs = Ks + 192 * DIL_LD;
    constexpr int NITEMS = BATCH * 8 * 3 * 64;
    v4u pq[2], pk[6], pv[6];
#define DIL_DECODE(it_) const int blk = (it_) & 63; int r_ = (it_) >> 6; const int br = r_ % 3; r_ /= 3; const int h = r_ & 7, b = r_ >> 3; \
        const int dil = br == 0 ? 1 : (br == 1 ? 4 : 16), L = SEQ / dil, nb = L / 64, g = blk / nb, n = blk % nb; const bf16* base = proj + (size_t)b * SEQ * NPROJ + OFF_D + h * 64
#define DIL_LOAD(it_) do { DIL_DECODE(it_); \
        _Pragma("unroll") for (int u = 0; u < 2; ++u) { const int c_ = tt + 256 * u, i_ = c_ >> 3, ch_ = c_ & 7; const int pos_ = (64 * n + i_) * dil + g; pq[u] = *(const GAS v4u*)(base + (size_t)pos_ * NPROJ + ch_ * 8); } \
        _Pragma("unroll") for (int u = 0; u < 6; ++u) { const int c_ = tt + 256 * u, kr_ = c_ >> 3, ch_ = c_ & 7; const int kidx_ = 64 * (n - 1) + kr_; const bool ok_ = kidx_ >= 0 && kidx_ < L; const int pos_ = (ok_ ? kidx_ : 0) * dil + g; \
            pk[u] = (v4u){0u, 0u, 0u, 0u}; pv[u] = pk[u]; if (ok_) { pk[u] = *(const GAS v4u*)(base + (size_t)pos_ * NPROJ + 512 + ch_ * 8); pv[u] = *(const GAS v4u*)(base + (size_t)pos_ * NPROJ + 1024 + ch_ * 8); } } } while (0)
    if (bid * 2 < NITEMS) DIL_LOAD(bid * 2 + team);
    for (int it0 = bid * 2; it0 < NITEMS; it0 += G * 2) {
        const int it = it0 + team;
        DIL_DECODE(it);
        LBAR();
#pragma unroll
        for (int u = 0; u < 2; ++u) { const int c_ = tt + 256 * u; *(LAS v4u*)(Qs + (c_ >> 3) * DIL_LD + (c_ & 7) * 8) = pq[u]; }
#pragma unroll
        for (int u = 0; u < 6; ++u) { const int c_ = tt + 256 * u; *(LAS v4u*)(Ks + (c_ >> 3) * DIL_LD + (c_ & 7) * 8) = pk[u]; *(LAS v4u*)(Vs + (c_ >> 3) * DIL_LD + (c_ & 7) * 8) = pv[u]; }
        LBAR();
        if (it0 + G * 2 < NITEMS) DIL_LOAD(it0 + G * 2 + team);
        bf16x8 qf[2];
#pragma unroll
        for (int ks = 0; ks < 2; ++ks) qf[ks] = frag_row(Qs, DIL_LD, 16 * w, 32 * ks, fr, fq);
        f32x4 sc[9];
#pragma unroll
        for (int kp = 0; kp < 9; ++kp) { sc[kp] = (f32x4){0.f, 0.f, 0.f, 0.f}; const LAS bf16* Kt = Ks + 16 * (w + kp) * DIL_LD;
#pragma unroll
            for (int ks = 0; ks < 2; ++ks) sc[kp] = MMA16(frag_row(Kt, DIL_LD, 0, 32 * ks, fr, fq), qf[ks], sc[kp]); }
        const int qi = 64 * n + 16 * w + fr; float mx = -1e30f;
#pragma unroll
        for (int kp = 0; kp < 9; ++kp) { const int kt = w + kp; const bool tile_ok = (n > 0 || kt >= 4) && (n < nb - 1 || kt < 8);
#pragma unroll
            for (int j = 0; j < 4; ++j) { const int e = 4 * fq + j - fr; const bool ok = tile_ok && (kp == 0 ? e >= 0 : (kp == 8 ? e <= 0 : true));
                sc[kp][j] = ok ? sc[kp][j] : -1e30f; mx = fmaxf(mx, sc[kp][j]); } }
        mx = xlane_max4(mx, lane);
        float den = 0.f;
#pragma unroll
        for (int kp = 0; kp < 9; ++kp)
#pragma unroll
            for (int j = 0; j < 4; ++j) { const float p = sc[kp][j] > -1e29f ? FEXP(sc[kp][j] - mx) : 0.f; sc[kp][j] = p; den += p; }
        den = xlane_sum4(den, lane);
        f32x4 o[4];
#pragma unroll
        for (int et = 0; et < 4; ++et) o[et] = (f32x4){0.f, 0.f, 0.f, 0.f};
#pragma unroll
        for (int u = 0; u < 5; ++u) {
            const unsigned p0 = cvtpk(sc[2 * u][0], sc[2 * u][1]), p1 = cvtpk(sc[2 * u][2], sc[2 * u][3]);
            const unsigned p2 = u < 4 ? cvtpk(sc[u < 4 ? 2 * u + 1 : 8][0], sc[u < 4 ? 2 * u + 1 : 8][1]) : 0u, p3 = u < 4 ? cvtpk(sc[u < 4 ? 2 * u + 1 : 8][2], sc[u < 4 ? 2 * u + 1 : 8][3]) : 0u;
            const bf16x8 pf = __builtin_bit_cast(bf16x8, (v4u){p0, p1, p2, p3});
            const int r0 = 16 * (w + 2 * u), r1 = 16 * (w + (u < 4 ? 2 * u + 1 : 2 * u));
#pragma unroll
            for (int et = 0; et < 4; ++et) { const s16x4 a = tr4(Vs, DIL_LD, r0 + 4 * fq, 16 * et, fr), bq = tr4(Vs, DIL_LD, r1 + 4 * fq, 16 * et, fr);
                o[et] = MMA16(((bf16x8){a[0], a[1], a[2], a[3], bq[0], bq[1], bq[2], bq[3]}), pf, o[et]); }
        }
        const float inv = 1.f / den; const size_t t = (size_t)b * SEQ + (size_t)qi * dil + g;
        bf16* op = dpo + ((size_t)br * T + t) * 512 + h * 64 + 4 * fq;
#pragma unroll
        for (int et = 0; et < 4; ++et) { v2u pk; pk.x = cvtpk(o[et][0] * inv, o[et][1] * inv); pk.y = cvtpk(o[et][2] * inv, o[et][3] * inv); *(GAS v2u*)(op + 16 * et) = pk; }
        if (fq == 0) { float* mp = dml + (((size_t)br * T + t) * 8 + h) * 2; mp[0] = mx; mp[1] = den; }
    }
}

constexpr int RET_LD = 72, RET1_TEAM_BYTES = 3 * 128 * RET_LD * 2;
static_assert(2 * RET1_TEAM_BYTES <= RING_BYTES && (3 * 128 + 2 * 64) * RET_LD * 2 <= RING_BYTES, "retention LDS");
__device__ __forceinline__ void ret_kv_phase(LAS unsigned char* lds, const bf16* proj, const float* gam, float* rkv, const int tid, const int bid, const int G) {
    const int lane = tid & 63, wave = RFL(tid >> 6), team = wave >> 2, w = wave & 3, tt = tid & 255, fr = lane & 15, fq = lane >> 4;
    LAS bf16* Kf = (LAS bf16*)(lds + team * RET1_TEAM_BYTES); LAS bf16* Kb = Kf + 128 * RET_LD; LAS bf16* Vs = Kb + 128 * RET_LD;
    constexpr int NITEMS = BATCH * 8 * NC;
    for (int it0 = bid * 2; it0 < NITEMS; it0 += G * 2) {
        const int it = it0 + team; const int ch = it % NC, h = (it / NC) & 7, b = it / (NC * 8);
        const float lgf = logsigmoidf_(gam[h]), lgb = logsigmoidf_(gam[8 + h]);
        const bf16* base = proj + ((size_t)b * SEQ + (size_t)ch * 128) * NPROJ + OFF_A + h * 64;
        LBAR();
#pragma unroll
        for (int c = tt; c < 1024; c += 256) { const int m = c >> 3, cc = c & 7;
            const v4u kv = *(const GAS v4u*)(base + (size_t)m * NPROJ + 512 + cc * 8), vv = *(const GAS v4u*)(base + (size_t)m * NPROJ + 1024 + cc * 8);
            float f[8]; unpack8(kv, f); const float df = FEXP(lgf * (float)(127 - m)), db = FEXP(lgb * (float)m);
            *(LAS v4u*)(Kf + m * RET_LD + cc * 8) = (v4u){cvtpk(f[0] * df, f[1] * df), cvtpk(f[2] * df, f[3] * df), cvtpk(f[4] * df, f[5] * df), cvtpk(f[6] * df, f[7] * df)};
            *(LAS v4u*)(Kb + m * RET_LD + cc * 8) = (v4u){cvtpk(f[0] * db, f[1] * db), cvtpk(f[2] * db, f[3] * db), cvtpk(f[4] * db, f[5] * db), cvtpk(f[6] * db, f[7] * db)};
            *(LAS v4u*)(Vs + m * RET_LD + cc * 8) = vv; }
        LBAR();
        f32x4 aF[4], aB[4];
#pragma unroll
        for (int dt = 0; dt < 4; ++dt) { aF[dt] = (f32x4){0.f, 0.f, 0.f, 0.f}; aB[dt] = aF[dt]; }
#pragma unroll
        for (int ks = 0; ks < 4; ++ks) { const bf16x8 a = frag_col(Vs, RET_LD, 32 * ks, 16 * w, fr, fq);
#pragma unroll
            for (int dt = 0; dt < 4; ++dt) { aF[dt] = MMA16(a, frag_col(Kf, RET_LD, 32 * ks, 16 * dt, fr, fq), aF[dt]); aB[dt] = MMA16(a, frag_col(Kb, RET_LD, 32 * ks, 16 * dt, fr, fq), aB[dt]); } }
        float* oF = rkv + ((size_t)((b * 8 + h) * 2 + 0) * NC + ch) * 4096; float* oB = rkv + ((size_t)((b * 8 + h) * 2 + 1) * NC + ch) * 4096;
#pragma unroll
        for (int dt = 0; dt < 4; ++dt)
#pragma unroll
            for (int j = 0; j < 4; ++j) { const int e = 16 * w + 4 * fq + j, d = 16 * dt + fr; oF[e * 64 + d] = aF[dt][j]; oB[e * 64 + d] = aB[dt][j]; }
    }
}
__device__ __forceinline__ void ret_out_phase(LAS unsigned char* lds, const bf16* proj, const float* gam, const float* ret_g, const float* rsp, bf16* ycat, const int tid, const int bid, const int G) {
    const int lane = tid & 63, w = RFL(tid >> 6), fr = lane & 15, fq = lane >> 4;
    LAS bf16* Qs = (LAS bf16*)lds; LAS bf16* Ks = Qs + 128 * RET_LD; LAS bf16* Vs = Ks + 128 * RET_LD; LAS bf16* Sf = Vs + 128 * RET_LD; LAS bf16* Sb = Sf + 64 * RET_LD;
    constexpr int NITEMS = BATCH * 8 * NC;
    for (int it = bid; it < NITEMS; it += G) {
        const int ch = it % NC, h = (it / NC) & 7, b = it / (NC * 8);
        const float lgf = logsigmoidf_(gam[h]), lgb = logsigmoidf_(gam[8 + h]);
        const size_t t0 = (size_t)b * SEQ + (size_t)ch * 128;
        const bf16* base = proj + t0 * NPROJ + OFF_A + h * 64;
        const float* gSf = rsp + ((size_t)((b * 8 + h) * 2 + 0) * NC + ch) * 4096; const float* gSb = rsp + ((size_t)((b * 8 + h) * 2 + 1) * NC + ch) * 4096;
        LBAR();
#pragma unroll
        for (int c = tid; c < 1024; c += 512) { const int m = c >> 3, cc = c & 7; const bf16* rp = base + (size_t)m * NPROJ + cc * 8;
            *(LAS v4u*)(Qs + m * RET_LD + cc * 8) = *(const GAS v4u*)(rp); *(LAS v4u*)(Ks + m * RET_LD + cc * 8) = *(const GAS v4u*)(rp + 512); *(LAS v4u*)(Vs + m * RET_LD + cc * 8) = *(const GAS v4u*)(rp + 1024); }
#pragma unroll
        for (int c = tid; c < 1024; c += 512) { const int e = c >> 4, d4 = (c & 15) * 4; const f32x4 a = *(const GAS f32x4*)(gSf + e * 64 + d4), bb = *(const GAS f32x4*)(gSb + e * 64 + d4);
            *(LAS v2u*)(Sf + e * RET_LD + d4) = (v2u){cvtpk(a.x, a.y), cvtpk(a.z, a.w)}; *(LAS v2u*)(Sb + e * RET_LD + d4) = (v2u){cvtpk(bb.x, bb.y), cvtpk(bb.z, bb.w)}; }
        LBAR();
        bf16x8 qf[2];
#pragma unroll
        for (int ks = 0; ks < 2; ++ks) qf[ks] = frag_row(Qs, RET_LD, 16 * w, 32 * ks, fr, fq);
        f32x4 sc[8];
#pragma unroll
        for (int kt = 0; kt < 8; ++kt) { sc[kt] = (f32x4){0.f, 0.f, 0.f, 0.f};
#pragma unroll
            for (int ks = 0; ks < 2; ++ks) sc[kt] = MMA16(frag_row(Ks, RET_LD, 16 * kt, 32 * ks, fr, fq), qf[ks], sc[kt]); }
        const int n = 16 * w + fr;
#pragma unroll
        for (int kt = 0; kt < 8; ++kt)
#pragma unroll
            for (int j = 0; j < 4; ++j) { const int m = 16 * kt + 4 * fq + j; sc[kt][j] *= m <= n ? FEXP(lgf * (float)(n - m)) : FEXP(lgb * (float)(m - n)); }
        f32x4 o[4], aF[4], aB[4];
#pragma unroll
        for (int et = 0; et < 4; ++et) { o[et] = (f32x4){0.f, 0.f, 0.f, 0.f}; aF[et] = o[et]; aB[et] = o[et]; }
#pragma unroll
        for (int u = 0; u < 4; ++u) {
            const bf16x8 pf = __builtin_bit_cast(bf16x8, (v4u){cvtpk(sc[2 * u][0], sc[2 * u][1]), cvtpk(sc[2 * u][2], sc[2 * u][3]), cvtpk(sc[2 * u + 1][0], sc[2 * u + 1][1]), cvtpk(sc[2 * u + 1][2], sc[2 * u + 1][3])});
#pragma unroll
            for (int et = 0; et < 4; ++et) { const s16x4 a = tr4(Vs, RET_LD, 32 * u + 4 * fq, 16 * et, fr), bq = tr4(Vs, RET_LD, 32 * u + 16 + 4 * fq, 16 * et, fr);
                o[et] = MMA16(((bf16x8){a[0], a[1], a[2], a[3], bq[0], bq[1], bq[2], bq[3]}), pf, o[et]); }
        }
#pragma unroll
        for (int et = 0; et < 4; ++et)
#pragma unroll
            for (int ks = 0; ks < 2; ++ks) { aF[et] = MMA16(frag_row(Sf, RET_LD, 16 * et, 32 * ks, fr, fq), qf[ks], aF[et]); aB[et] = MMA16(frag_row(Sb, RET_LD, 16 * et, 32 * ks, fr, fq), qf[ks], aB[et]); }
        const float qdf = FEXP(lgf * (float)(n + 1)), qdb = FEXP(lgb * (float)(128 - n));
        float mu = 0.f;
#pragma unroll
        for (int et = 0; et < 4; ++et)
#pragma unroll
            for (int j = 0; j < 4; ++j) { o[et][j] += qdf * aF[et][j] + qdb * aB[et][j]; mu += o[et][j]; }
        mu = xlane_sum4(mu, lane) * (1.f / 64.f);
        float var = 0.f;
#pragma unroll
        for (int et = 0; et < 4; ++et)
#pragma unroll
            for (int j = 0; j < 4; ++j) { const float dlt = o[et][j] - mu; var += dlt * dlt; }
        const float rstd = 1.f / sqrtf(xlane_sum4(var, lane) * (1.f / 64.f) + GN_EPS);
        const bf16* gp = proj + (t0 + n) * NPROJ + OFF_A + 1536 + h * 64 + 4 * fq; bf16* yp = ycat + (t0 + n) * 2048 + h * 64 + 4 * fq; const float* gg = ret_g + h * 64 + 4 * fq;
#pragma unroll
        for (int et = 0; et < 4; ++et) { const v2u gv = *(const GAS v2u*)(gp + 16 * et); const f32x4 gn = *(const GAS f32x4*)(gg + 16 * et);
            const float g0 = __builtin_bit_cast(float, gv.x << 16), g1 = __builtin_bit_cast(float, gv.x & 0xffff0000u), g2 = __builtin_bit_cast(float, gv.y << 16), g3 = __builtin_bit_cast(float, gv.y & 0xffff0000u);
            const float y0 = siluf_(g0) * ((o[et][0] - mu) * rstd * gn.x), y1 = siluf_(g1) * ((o[et][1] - mu) * rstd * gn.y), y2 = siluf_(g2) * ((o[et][2] - mu) * rstd * gn.z), y3 = siluf_(g3) * ((o[et][3] - mu) * rstd * gn.w);
            *(GAS v2u*)(yp + 16 * et) = (v2u){cvtpk(y0, y1), cvtpk(y2, y3)}; }
    }
}
constexpr int SGU_LDV = 72, SGU_LDW = 136, SGU_TEAM_BYTES = (128 * SGU_LDV + 128 * SGU_LDW) * 2;
static_assert(2 * SGU_TEAM_BYTES <= RING_BYTES, "SGU LDS");
__device__ __forceinline__ void sgu_phase(LAS unsigned char* lds, const bf16* proj, const float* sgu_w, const float* sgu_bias, bf16* ycat, const int tid, const int bid, const int G) {
    const int lane = tid & 63, wave = RFL(tid >> 6), team = wave >> 2, w = wave & 3, tt = tid & 255, fr = lane & 15, fq = lane >> 4;
    LAS bf16* Vn = (LAS bf16*)(lds + team * SGU_TEAM_BYTES); LAS bf16* Ws = Vn + 128 * SGU_LDV;
    constexpr int NITEMS = BATCH * NC * 8;
    for (int it0 = bid * 2; it0 < NITEMS; it0 += G * 2) {
        const int it = it0 + team; const int bc = it % (BATCH * NC), g = it / (BATCH * NC);
        const size_t t0 = (size_t)bc * 128;
        const bf16* vb = proj + t0 * NPROJ + OFF_C + 512 + g * 64; const float* wsrc = sgu_w + (size_t)g * 128 * 128;
        LBAR();
#pragma unroll
        for (int c = tt; c < 1024; c += 256) { const int q = c >> 3, cc = c & 7; *(LAS v4u*)(Vn + q * SGU_LDV + cc * 8) = *(const GAS v4u*)(vb + (size_t)q * NPROJ + cc * 8); }
#pragma unroll
        for (int c = tt; c < 4096; c += 256) { const int p = c >> 5, q4 = (c & 31) * 4; const f32x4 a = *(const GAS f32x4*)(wsrc + p * 128 + q4); *(LAS v2u*)(Ws + p * SGU_LDW + q4) = (v2u){cvtpk(a.x, a.y), cvtpk(a.z, a.w)}; }
        LBAR();
        f32x4 acc[2][4];
#pragma unroll
        for (int i = 0; i < 2; ++i)
#pragma unroll
            for (int dt = 0; dt < 4; ++dt) acc[i][dt] = (f32x4){0.f, 0.f, 0.f, 0.f};
#pragma unroll
        for (int ks = 0; ks < 4; ++ks) { bf16x8 a[4];
#pragma unroll
            for (int dt = 0; dt < 4; ++dt) a[dt] = frag_col(Vn, SGU_LDV, 32 * ks, 16 * dt, fr, fq);
#pragma unroll
            for (int i = 0; i < 2; ++i) { const bf16x8 bfr = frag_row(Ws, SGU_LDW, 16 * (2 * w + i), 32 * ks, fr, fq);
#pragma unroll
                for (int dt = 0; dt < 4; ++dt) acc[i][dt] = MMA16(a[dt], bfr, acc[i][dt]); } }
#pragma unroll
        for (int i = 0; i < 2; ++i) { const int p = 16 * (2 * w + i) + fr; const float bias = sgu_bias[g * 128 + p];
            const bf16* up = proj + (t0 + p) * NPROJ + OFF_C + g * 64 + 4 * fq; bf16* yp = ycat + (t0 + p) * 2048 + 1024 + g * 64 + 4 * fq;
#pragma unroll
            for (int dt = 0; dt < 4; ++dt) { const v2u uv = *(const GAS v2u*)(up + 16 * dt);
                const float u0 = __builtin_bit_cast(float, uv.x << 16), u1 = __builtin_bit_cast(float, uv.x & 0xffff0000u), u2 = __builtin_bit_cast(float, uv.y << 16), u3 = __builtin_bit_cast(float, uv.y & 0xffff0000u);
                *(GAS v2u*)(yp + 16 * dt) = (v2u){cvtpk(geluf_(u0) * (acc[i][dt][0] + bias), geluf_(u1) * (acc[i][dt][1] + bias)), cvtpk(geluf_(u2) * (acc[i][dt][2] + bias), geluf_(u3) * (acc[i][dt][3] + bias))}; } }
    }
}

constexpr int LO_LDL = 456, LO_LDW = 72, LO_LIN_B = 64 * LO_LDL * 2, LO_W2_B = 96 * LO_LDW * 2, LO_G2_B = 256 * LO_LDW * 2;
static_assert(LO_LIN_B + 2 * LO_W2_B + LO_G2_B <= RING_BYTES, "LoRA LDS");
__device__ __forceinline__ void rwkv_lora_phase(LAS unsigned char* lds, const Ctx& c, const int tid, const int bid, const int G) {
    const int lane = tid & 63, wave = RFL(tid >> 6), tt = wave & 3, chh = wave >> 2, fr = lane & 15, fq = lane >> 4;
    LAS bf16* LIN = (LAS bf16*)lds; LAS bf16* W2s = (LAS bf16*)(lds + LO_LIN_B); LAS bf16* A2s = (LAS bf16*)(lds + LO_LIN_B + LO_W2_B); LAS bf16* G2s = (LAS bf16*)(lds + LO_LIN_B + 2 * LO_W2_B);
    for (int blk = bid; blk < T / 64; blk += G) {
        const size_t t0 = (size_t)blk * 64;
        LBAR();
        for (int q = tid; q < 64 * 56; q += 512) { const int r = q / 56, cc = q % 56; *(LAS v4u*)(LIN + r * LO_LDL + cc * 8) = *(const GAS v4u*)(c.lin + (t0 + r) * NLORA + cc * 8); }
        f32x4 pw2[3], pa2[3], pg2[8];
#define LO_LOADW(h_) do { _Pragma("unroll") for (int u = 0; u < 3; ++u) { const int q_ = tid + 512 * u, i_ = q_ >> 4, c4_ = (q_ & 15) * 4; pw2[u] = *(const GAS f32x4*)(c.w2 + (size_t)i_ * 512 + (h_) * 64 + c4_); pa2[u] = *(const GAS f32x4*)(c.a2 + (size_t)i_ * 512 + (h_) * 64 + c4_); } \
        _Pragma("unroll") for (int u = 0; u < 8; ++u) { const int q_ = tid + 512 * u, i_ = q_ >> 4, c4_ = (q_ & 15) * 4; pg2[u] = *(const GAS f32x4*)(c.g2 + (size_t)i_ * 512 + (h_) * 64 + c4_); } } while (0)
        LO_LOADW(0);
        for (int h = 0; h < 8; ++h) {
            if (h > 0) LBAR();
#pragma unroll
            for (int u = 0; u < 3; ++u) { const int q = tid + 512 * u, i = q >> 4, c4 = (q & 15) * 4;
                *(LAS v2u*)(W2s + i * LO_LDW + c4) = (v2u){cvtpk(pw2[u].x, pw2[u].y), cvtpk(pw2[u].z, pw2[u].w)}; *(LAS v2u*)(A2s + i * LO_LDW + c4) = (v2u){cvtpk(pa2[u].x, pa2[u].y), cvtpk(pa2[u].z, pa2[u].w)}; }
#pragma unroll
            for (int u = 0; u < 8; ++u) { const int q = tid + 512 * u, i = q >> 4, c4 = (q & 15) * 4; *(LAS v2u*)(G2s + i * LO_LDW + c4) = (v2u){cvtpk(pg2[u].x, pg2[u].y), cvtpk(pg2[u].z, pg2[u].w)}; }
            LBAR();
            if (h < 7) LO_LOADW(h + 1);
            f32x4 aw[2], aa[2], ag[2];
#pragma unroll
            for (int ct = 0; ct < 2; ++ct) { aw[ct] = (f32x4){0.f, 0.f, 0.f, 0.f}; aa[ct] = aw[ct]; ag[ct] = aw[ct]; }
#pragma unroll
            for (int ks = 0; ks < 3; ++ks) { const bf16x8 fw = frag_row(LIN, LO_LDL, 16 * tt, 32 * ks, fr, fq), fa = frag_row(LIN, LO_LDL, 16 * tt, 96 + 32 * ks, fr, fq);
#pragma unroll
                for (int ct = 0; ct < 2; ++ct) { aw[ct] = MMA16(frag_col(W2s, LO_LDW, 32 * ks, 32 * chh + 16 * ct, fr, fq), fw, aw[ct]); aa[ct] = MMA16(frag_col(A2s, LO_LDW, 32 * ks, 32 * chh + 16 * ct, fr, fq), fa, aa[ct]); } }
#pragma unroll
            for (int ks = 0; ks < 8; ++ks) { const bf16x8 fg = frag_row(LIN, LO_LDL, 16 * tt, 192 + 32 * ks, fr, fq);
#pragma unroll
                for (int ct = 0; ct < 2; ++ct) ag[ct] = MMA16(frag_col(G2s, LO_LDW, 32 * ks, 32 * chh + 16 * ct, fr, fq), fg, ag[ct]); }
#pragma unroll
            for (int ct = 0; ct < 2; ++ct) { const int ch0 = h * 64 + 32 * chh + 16 * ct + 4 * fq; const size_t o = (t0 + 16 * tt + fr) * 512 + ch0;
                *(GAS v2u*)(c.gg + o) = (v2u){cvtpk(ag[ct][0], ag[ct][1]), cvtpk(ag[ct][2], ag[ct][3])};
                *(GAS v2u*)(c.kdf + o) = (v2u){cvtpk(aw[ct][0], aw[ct][1]), cvtpk(aw[ct][2], aw[ct][3])};
                *(GAS v2u*)(c.kdb + o) = (v2u){cvtpk(aa[ct][0], aa[ct][1]), cvtpk(aa[ct][2], aa[ct][3])}; }
        }
    }
}

constexpr int RWC = 32, RW_NCH = SEQ / RWC, RW_LD = 72, RW_LS = 40, RW_IN_B = 32 * RW_LD * 2, RW_SM_B = 32 * RW_LS * 2;
constexpr int RW_AH = 0, RW_BC = RW_IN_B, RW_KC = 2 * RW_IN_B, RW_RH = 3 * RW_IN_B, RW_BT = 4 * RW_IN_B, RW_KT = 5 * RW_IN_B, RW_VV = 6 * RW_IN_B, RW_M1 = 7 * RW_IN_B, RW_WW = 8 * RW_IN_B, RW_UL = 9 * RW_IN_B,
              RW_XA = 10 * RW_IN_B, RW_XB = RW_XA + RW_SM_B, RW_T0 = RW_XB + RW_SM_B, RW_T1 = RW_T0 + RW_SM_B, RW_AAK = RW_T1 + RW_SM_B, RW_ARB = RW_AAK + RW_SM_B, RW_ARK = RW_ARB + RW_SM_B, RW_SEG = RW_ARK + RW_SM_B,
              RW_TEAM_BYTES = RW_SEG + 4 * 64 * 4;
static_assert(2 * RW_TEAM_BYTES <= RING_BYTES, "RWKV chunk LDS");
__device__ __forceinline__ void st_tile_bf16(LAS bf16* X, int ld, int r0, int c0, const f32x4 v, int fr, int fq) {
#pragma unroll
    for (int j = 0; j < 4; j += 2) { const unsigned p = cvtpk(v[j], v[j + 1]); X[(r0 + 4 * fq + j) * ld + c0 + fr] = (bf16)p; X[(r0 + 4 * fq + j + 1) * ld + c0 + fr] = (bf16)(p >> 16); } }
__device__ __forceinline__ void rwkv_chunk_phase(LAS unsigned char* lds, const Ctx& c, unsigned char* ws, const int tid, const int bid, const int G) {
    const int lane = tid & 63, wave = RFL(tid >> 6), team = wave >> 2, w = wave & 3, tt = tid & 255, fr = lane & 15, fq = lane >> 4;
    LAS unsigned char* L = lds + team * RW_TEAM_BYTES;
    LAS bf16* AH = (LAS bf16*)(L + RW_AH); LAS bf16* BC = (LAS bf16*)(L + RW_BC); LAS bf16* KC = (LAS bf16*)(L + RW_KC); LAS bf16* RH = (LAS bf16*)(L + RW_RH); LAS bf16* BT = (LAS bf16*)(L + RW_BT);
    LAS bf16* KT = (LAS bf16*)(L + RW_KT); LAS bf16* VV = (LAS bf16*)(L + RW_VV); LAS bf16* M1 = (LAS bf16*)(L + RW_M1); LAS bf16* WW = (LAS bf16*)(L + RW_WW); LAS bf16* UL = (LAS bf16*)(L + RW_UL);
    LAS bf16* XA = (LAS bf16*)(L + RW_XA); LAS bf16* XB = (LAS bf16*)(L + RW_XB); LAS bf16* T0 = (LAS bf16*)(L + RW_T0); LAS bf16* T1 = (LAS bf16*)(L + RW_T1);
    LAS bf16* AAK = (LAS bf16*)(L + RW_AAK); LAS bf16* ARB = (LAS bf16*)(L + RW_ARB); LAS bf16* ARK = (LAS bf16*)(L + RW_ARK); LAS float* SEG = (LAS float*)(L + RW_SEG);
    bf16* gRB = (bf16*)(ws + WS_RB); bf16* gPT = (bf16*)(ws + WS_PT); bf16* gQF = (bf16*)(ws + WS_QF); bf16* gYL = (bf16*)(ws + WS_YL); float* gDC = (float*)(ws + WS_DC);
#ifdef RW_EMU_LIMIT
    constexpr int NITEMS = RW_EMU_LIMIT;
#else
    constexpr int NITEMS = BATCH * 16 * RW_NCH;
#endif
    const int it_ = w >> 1, jt_ = w & 1;
    const int ch = tt & 63, seg = tt >> 6;
    float lwv[8]; unsigned ksr[8], wlr[8], alr[8], rsr[8], vsr[8]; float cw0 = 0.f, ca0 = 0.f, cka = 0.f, ckk = 0.f;
#define RW_LOAD_RAW(item_) do { const int cc_ = (item_) % RW_NCH, unit_ = (item_) / RW_NCH, dir_ = unit_ & 1, h_ = (unit_ >> 1) & 7, b_ = unit_ >> 4; const size_t tb_ = (size_t)b_ * SEQ + (size_t)cc_ * RWC; \
        cw0 = c.w0[dir_ * 512 + h_ * 64 + ch]; ca0 = c.a0[dir_ * 512 + h_ * 64 + ch]; cka = c.k_a[h_ * 64 + ch]; ckk = c.k_k[h_ * 64 + ch]; \
        _Pragma("unroll") for (int r = 0; r < 8; ++r) { const int i_ = 8 * seg + r; const unsigned o_ = ((unsigned)tb_ + (unsigned)(dir_ ? 31 - i_ : i_)) * 512u + (unsigned)(h_ * 64 + ch); \
            ksr[r] = ((const GAS bf16*)c.ks)[o_]; wlr[r] = ((const GAS bf16*)c.kdf)[o_]; alr[r] = ((const GAS bf16*)c.kdb)[o_]; rsr[r] = ((const GAS bf16*)c.rs)[o_]; vsr[r] = ((const GAS bf16*)c.vs)[o_]; } } while (0)
    if (bid * 2 < NITEMS) RW_LOAD_RAW(bid * 2 + team);
    for (int it0 = bid * 2; it0 < NITEMS; it0 += G * 2) {
        const int item = it0 + team;
        LBAR();
        {
            float g[8], kv[8], av[8], kraw[8], ksq[8]; float run = 0.f;
#pragma unroll
            for (int r = 0; r < 8; ++r) { lwv[r] = -0.6065306597126334f * __builtin_amdgcn_rcpf(1.f + FEXP(-(cw0 + __builtin_bit_cast(float, wlr[r] << 16)))); run += lwv[r]; g[r] = run; }
            SEG[seg * 64 + ch] = run;
#pragma unroll
            for (int r = 0; r < 8; ++r) { kv[r] = __builtin_bit_cast(float, ksr[r] << 16); av[r] = __builtin_amdgcn_rcpf(1.f + FEXP(-(ca0 + __builtin_bit_cast(float, alr[r] << 16)))); kraw[r] = kv[r] * ckk; ksq[r] = kraw[r] * kraw[r]; }
#pragma unroll
            for (int o = 1; o < 64; o <<= 1) { float t_[8];
#pragma unroll
                for (int r = 0; r < 8; ++r) t_[r] = __builtin_bit_cast(float, __builtin_amdgcn_ds_bpermute((lane ^ o) << 2, __builtin_bit_cast(int, ksq[r])));
#pragma unroll
                for (int r = 0; r < 8; ++r) ksq[r] += t_[r]; }
            LBAR();
            float off = 0.f, GC = 0.f;
#pragma unroll
            for (int s2 = 0; s2 < 4; ++s2) { const float v = SEG[s2 * 64 + ch]; off += s2 < seg ? v : 0.f; GC += v; }
            const float eGC = FEXP(GC);
            if (seg == 0) gDC[(size_t)item * 64 + ch] = eGC;
            float ePrev = FEXP(off);
#pragma unroll
            for (int r = 0; r < 8; r += 2) { float oa[2], ob[2], ok[2], orr[2], obt[2], okt[2];
#pragma unroll
                for (int u = 0; u < 2; ++u) { const int q = r + u;
                    const float eG = FEXP(off + g[q]), eI = __builtin_amdgcn_rcpf(eG), eM = ePrev, eC = eGC * eI; ePrev = eG;
                    const float kk = kraw[q] * __builtin_amdgcn_rsqf(ksq[q] + 1e-12f);
                    const float be = av[q] * kk, kt = kv[q] * (1.f + (av[q] - 1.f) * cka), rr = __builtin_bit_cast(float, rsr[q] << 16);
                    oa[u] = -kk * eM; ob[u] = be * eI; ok[u] = kt * eI; orr[u] = rr * eG; obt[u] = be * eC; okt[u] = kt * eC; }
                const int i = 8 * seg + r; const unsigned pa = cvtpk(oa[0], oa[1]), pb = cvtpk(ob[0], ob[1]), pk = cvtpk(ok[0], ok[1]), pr = cvtpk(orr[0], orr[1]), pbt = cvtpk(obt[0], obt[1]), pkt = cvtpk(okt[0], okt[1]);
                AH[i * RW_LD + ch] = (bf16)pa; AH[(i + 1) * RW_LD + ch] = (bf16)(pa >> 16); BC[i * RW_LD + ch] = (bf16)pb; BC[(i + 1) * RW_LD + ch] = (bf16)(pb >> 16);
                KC[i * RW_LD + ch] = (bf16)pk; KC[(i + 1) * RW_LD + ch] = (bf16)(pk >> 16); RH[i * RW_LD + ch] = (bf16)pr; RH[(i + 1) * RW_LD + ch] = (bf16)(pr >> 16);
                BT[i * RW_LD + ch] = (bf16)pbt; BT[(i + 1) * RW_LD + ch] = (bf16)(pbt >> 16); KT[i * RW_LD + ch] = (bf16)pkt; KT[(i + 1) * RW_LD + ch] = (bf16)(pkt >> 16);
                VV[i * RW_LD + ch] = (bf16)vsr[r]; VV[(i + 1) * RW_LD + ch] = (bf16)vsr[r + 1]; }
        }
        if (it0 + G * 2 < NITEMS) RW_LOAD_RAW(it0 + G * 2 + team);
        LBAR();
        {
            const LAS bf16* As = w < 2 ? AH : RH; const LAS bf16* Bs = (w & 1) ? KC : BC; LAS bf16* D = w == 0 ? XA : (w == 1 ? AAK : (w == 2 ? ARB : ARK));
#pragma unroll
            for (int it = 0; it < 2; ++it)
#pragma unroll
                for (int jt = 0; jt < 2; ++jt) { f32x4 a = (f32x4){0.f, 0.f, 0.f, 0.f};
#pragma unroll
                    for (int ks = 0; ks < 2; ++ks) a = MMA16(frag_row(As, RW_LD, 16 * it, 32 * ks, fr, fq), frag_row(Bs, RW_LD, 16 * jt, 32 * ks, fr, fq), a);
#pragma unroll
                    for (int j = 0; j < 4; ++j) { const int i = 16 * it + 4 * fq + j, jj = 16 * jt + fr; const bool keep = w < 2 ? jj < i : jj <= i; a[j] = keep ? a[j] : 0.f; }
                    st_tile_bf16(D, RW_LS, 16 * it, 16 * jt, a, fr, fq); }
        }
        LBAR();
        f32x4 Tacc;
        {
            const f32x4 x2 = MMA16(frag_row(XA, RW_LS, 16 * it_, 0, fr, fq), frag_col(XA, RW_LS, 0, 16 * jt_, fr, fq), ((f32x4){0.f, 0.f, 0.f, 0.f}));
            st_tile_bf16(XB, RW_LS, 16 * it_, 16 * jt_, x2, fr, fq);
#pragma unroll
            for (int j = 0; j < 4; ++j) { const int i = 16 * it_ + 4 * fq + j, jj = 16 * jt_ + fr; Tacc[j] = bf2f(XA[i * RW_LS + jj]) + (i == jj ? 1.f : 0.f); }
            st_tile_bf16(T0, RW_LS, 16 * it_, 16 * jt_, Tacc, fr, fq);
#pragma unroll
            for (int q = 0; q < 2; ++q) { const int et = 2 * jt_ + q; const f32x4 m1 = MMA16(frag_row(AAK, RW_LS, 16 * it_, 0, fr, fq), frag_col(VV, RW_LD, 0, 16 * et, fr, fq), ((f32x4){0.f, 0.f, 0.f, 0.f}));
                st_tile_bf16(M1, RW_LD, 16 * it_, 16 * et, m1, fr, fq); }
        }
        LBAR();
#define RW_CHAIN(TR, TW, XR, XW, SQUARE) { Tacc = MMA16(frag_row(TR, RW_LS, 16 * it_, 0, fr, fq), frag_col(XR, RW_LS, 0, 16 * jt_, fr, fq), Tacc); st_tile_bf16(TW, RW_LS, 16 * it_, 16 * jt_, Tacc, fr, fq); \
        if (SQUARE) { const f32x4 xx = MMA16(frag_row(XR, RW_LS, 16 * it_, 0, fr, fq), frag_col(XR, RW_LS, 0, 16 * jt_, fr, fq), ((f32x4){0.f, 0.f, 0.f, 0.f})); st_tile_bf16(XW, RW_LS, 16 * it_, 16 * jt_, xx, fr, fq); } \
        LBAR(); }
        RW_CHAIN(T0, T1, XB, XA, true)
        RW_CHAIN(T1, T0, XA, XB, true)
        RW_CHAIN(T0, T1, XB, XA, true)
        RW_CHAIN(T1, T0, XA, XB, false)
#undef RW_CHAIN
        {
            const bf16x8 tf = frag_row(T0, RW_LS, 16 * it_, 0, fr, fq);
#pragma unroll
            for (int q = 0; q < 2; ++q) { const int ct = 2 * jt_ + q;
                st_tile_bf16(WW, RW_LD, 16 * it_, 16 * ct, MMA16(tf, frag_col(AH, RW_LD, 0, 16 * ct, fr, fq), ((f32x4){0.f, 0.f, 0.f, 0.f})), fr, fq);
                st_tile_bf16(UL, RW_LD, 16 * it_, 16 * ct, MMA16(tf, frag_col(M1, RW_LD, 0, 16 * ct, fr, fq), ((f32x4){0.f, 0.f, 0.f, 0.f})), fr, fq); }
        }
        LBAR();
        {
            const bf16x8 wcol = frag_col(WW, RW_LD, 0, 16 * w, fr, fq), ulc = frag_col(UL, RW_LD, 0, 16 * w, fr, fq), vvc = frag_col(VV, RW_LD, 0, 16 * w, fr, fq);
            bf16* pt = gPT + (size_t)item * 4096; bf16* qf = gQF + (size_t)item * 4096; bf16* rb = gRB + (size_t)item * 2048; bf16* yl = gYL + (size_t)item * 2048;
#pragma unroll
            for (int kq = 0; kq < 4; ++kq) { const bf16x8 btc = frag_col(BT, RW_LD, 0, 16 * kq, fr, fq), ktc = frag_col(KT, RW_LD, 0, 16 * kq, fr, fq);
                const f32x4 p = MMA16(wcol, btc, ((f32x4){0.f, 0.f, 0.f, 0.f}));
                *(GAS v2u*)(pt + ((kq * 2 + (w >> 1)) * 64 + lane) * 8 + (w & 1) * 4) = (v2u){cvtpk(p[0], p[1]), cvtpk(p[2], p[3])};
                f32x4 q = MMA16(btc, ulc, ((f32x4){0.f, 0.f, 0.f, 0.f})); q = MMA16(ktc, vvc, q);
                *(GAS v2u*)(qf + ((w * 4 + kq) * 64 + lane) * 4) = (v2u){cvtpk(q[0], q[1]), cvtpk(q[2], q[3])}; }
#pragma unroll
            for (int it = 0; it < 2; ++it) { const bf16x8 arb = frag_row(ARB, RW_LS, 16 * it, 0, fr, fq), ark = frag_row(ARK, RW_LS, 16 * it, 0, fr, fq);
                const f32x4 r = MMA16(wcol, arb, ((f32x4){0.f, 0.f, 0.f, 0.f}));
                const v2u rh = *(const LAS v2u*)(RH + (16 * it + fr) * RW_LD + 16 * w + 4 * fq);
                const float r0 = r[0] + __builtin_bit_cast(float, rh.x << 16), r1 = r[1] + __builtin_bit_cast(float, rh.x & 0xffff0000u), r2 = r[2] + __builtin_bit_cast(float, rh.y << 16), r3 = r[3] + __builtin_bit_cast(float, rh.y & 0xffff0000u);
                *(GAS v2u*)(rb + ((it * 2 + (w >> 1)) * 64 + lane) * 8 + (w & 1) * 4) = (v2u){cvtpk(r0, r1), cvtpk(r2, r3)};
                f32x4 y = MMA16(arb, ulc, ((f32x4){0.f, 0.f, 0.f, 0.f})); y = MMA16(ark, vvc, y);
                *(GAS v2u*)(yl + ((it * 4 + w) * 64 + lane) * 4) = (v2u){cvtpk(y[0], y[1]), cvtpk(y[2], y[3])}; }
        }
    }
}
struct RwS { v4u pt[4][2]; v2u q[4]; f32x4 dc[4]; };
__device__ __forceinline__ void rws_load(RwS& s, const unsigned char* ws, int item, int vb, int lane, int fr, int fq) {
    const bf16* pt = (const bf16*)(ws + WS_PT) + (size_t)item * 4096; const bf16* qf = (const bf16*)(ws + WS_QF) + (size_t)item * 4096; const float* dc = (const float*)(ws + WS_DC) + (size_t)item * 64;
#pragma unroll
    for (int kq = 0; kq < 4; ++kq) {
#pragma unroll
        for (int ks = 0; ks < 2; ++ks) s.pt[kq][ks] = *(const GAS v4u*)(pt + ((kq * 2 + ks) * 64 + lane) * 8);
        s.q[kq] = *(const GAS v2u*)(qf + ((vb * 4 + kq) * 64 + lane) * 4); s.dc[kq] = *(const GAS f32x4*)(dc + 16 * kq + 4 * fq); }
}
constexpr int RWS_RING = 8, RWS_SLOT_B = 4 * 64 * 8, RWS_RING_B = RWS_RING * RWS_SLOT_B;
__device__ __forceinline__ unsigned lds_ld(const LAS unsigned* p) { return __hip_atomic_load(p, __ATOMIC_RELAXED, __HIP_MEMORY_SCOPE_WORKGROUP); }
__device__ __forceinline__ void lds_st(LAS unsigned* p, unsigned v) { __hip_atomic_store(p, v, __ATOMIC_RELAXED, __HIP_MEMORY_SCOPE_WORKGROUP); }
__device__ __forceinline__ void rws_step(const RwS& s, f32x4 (&S)[4], LAS unsigned char* ring, LAS unsigned* prog, const LAS unsigned* done, int step, int lane) {
    v2u sp[4];
    if (step >= RWS_RING) { while (lds_ld(done) + RWS_RING <= (unsigned)step) __builtin_amdgcn_s_sleep(1); }
#pragma unroll
    for (int kq = 0; kq < 4; ++kq) { sp[kq] = (v2u){cvtpk(S[kq][0], S[kq][1]), cvtpk(S[kq][2], S[kq][3])}; *(LAS v2u*)(ring + (step % RWS_RING) * RWS_SLOT_B + (kq * 64 + lane) * 8) = sp[kq]; }
    LDS_WAIT_();
    if (lane == 0) lds_st(prog, (unsigned)step + 1u);
#pragma unroll
    for (int kq = 0; kq < 4; ++kq) { f32x4 a;
        a[0] = S[kq][0] * s.dc[kq][0] + __builtin_bit_cast(float, s.q[kq].x << 16); a[1] = S[kq][1] * s.dc[kq][1] + __builtin_bit_cast(float, s.q[kq].x & 0xffff0000u);
        a[2] = S[kq][2] * s.dc[kq][2] + __builtin_bit_cast(float, s.q[kq].y << 16); a[3] = S[kq][3] * s.dc[kq][3] + __builtin_bit_cast(float, s.q[kq].y & 0xffff0000u);
#pragma unroll
        for (int ks = 0; ks < 2; ++ks) a = MMA16(__builtin_bit_cast(bf16x8, s.pt[kq][ks]), __builtin_bit_cast(bf16x8, (v4u){sp[2 * ks].x, sp[2 * ks].y, sp[2 * ks + 1].x, sp[2 * ks + 1].y}), a);
        S[kq] = a; }
}
__device__ __forceinline__ void rwkv_sscan_phase(LAS unsigned char* lds, unsigned char* ws, const int unit, const int vbase, const int wave, const int lane) {
    const int li = wave & 3; if (li >= 2) return;
    const int vb = vbase + li, fr = lane & 15, fq = lane >> 4, dir = unit & 1;
    LAS unsigned char* ring = lds + li * RWS_RING_B; LAS unsigned* prog = (LAS unsigned*)(lds + 4 * RWS_RING_B) + li * 16; LAS unsigned* done = prog + 8;
#define RW_CL(st) ((st) < RW_NCH ? (st) : RW_NCH - 1)
#define RW_ITEM(st) (unit * RW_NCH + (dir ? RW_NCH - 1 - RW_CL(st) : RW_CL(st)))
    if (wave >= 4) {
        for (int st = 0; st < RW_NCH; ++st) {
            while (lds_ld(prog) <= (unsigned)st) __builtin_amdgcn_s_sleep(1);
            bf16* dst = (bf16*)(ws + WS_ST) + (size_t)RW_ITEM(st) * 4096;
#pragma unroll
            for (int kq = 0; kq < 4; ++kq) *(GAS v2u*)(dst + ((vb * 4 + kq) * 64 + lane) * 4) = *(const LAS v2u*)(ring + (st % RWS_RING) * RWS_SLOT_B + (kq * 64 + lane) * 8);
            LDS_WAIT_();
            if (lane == 0) lds_st(done, (unsigned)st + 1u);
        }
        return;
    }
    f32x4 S[4];
#pragma unroll
    for (int kq = 0; kq < 4; ++kq) S[kq] = (f32x4){0.f, 0.f, 0.f, 0.f};
    RwS A, B, C;
    rws_load(A, ws, RW_ITEM(0), vb, lane, fr, fq); rws_load(B, ws, RW_ITEM(1), vb, lane, fr, fq);
#define RW_STEP3(st) do { rws_load(C, ws, RW_ITEM((st) + 2), vb, lane, fr, fq); rws_step(A, S, ring, prog, done, (st), lane); \
        rws_load(A, ws, RW_ITEM((st) + 3), vb, lane, fr, fq); rws_step(B, S, ring, prog, done, (st) + 1, lane); \
        rws_load(B, ws, RW_ITEM((st) + 4), vb, lane, fr, fq); rws_step(C, S, ring, prog, done, (st) + 2, lane); } while (0)
    constexpr int RW_MAIN = RW_NCH / 6 * 6, RW_MAIN3 = RW_NCH / 3 * 3;
#pragma unroll 1
    for (int st = 0; st < RW_MAIN; st += 6) { RW_STEP3(st); RW_STEP3(st + 3); }
#pragma unroll 1
    for (int st = RW_MAIN; st < RW_MAIN3; st += 3) RW_STEP3(st);
#undef RW_STEP3
    if (RW_NCH - RW_MAIN3 >= 1) rws_step(A, S, ring, prog, done, RW_MAIN3, lane);
    if (RW_NCH - RW_MAIN3 >= 2) rws_step(B, S, ring, prog, done, RW_MAIN3 + 1, lane);
#undef RW_ITEM
#undef RW_CL
}
__device__ __forceinline__ void rwkv_yfin_phase(LAS unsigned char* lds, const Ctx& c, const unsigned char* ws, const int tid, const int bid, const int G) {
    const int lane = tid & 63, wave = RFL(tid >> 6), fr = lane & 15, fq = lane >> 4; const int gw = bid * 8 + wave, NGW = G * 8;
    LAS float* Yt = (LAS float*)(lds + wave * 16384);
    for (int job = gw; job < BATCH * 8 * RW_NCH; job += NGW) {
        const int cc = job % RW_NCH, bh = job / RW_NCH, h = bh & 7, b = bh >> 3; const size_t tb = (size_t)b * SEQ + (size_t)cc * RWC;
        f32x4 y[2][4];
#pragma unroll
        for (int dir = 0; dir < 2; ++dir) { const int item = (bh * 2 + dir) * RW_NCH + cc;
            const bf16* rb = (const bf16*)(ws + WS_RB) + (size_t)item * 2048; const bf16* yl = (const bf16*)(ws + WS_YL) + (size_t)item * 2048; const bf16* st = (const bf16*)(ws + WS_ST) + (size_t)item * 4096;
#pragma unroll
            for (int it = 0; it < 2; ++it) {
                const int rt = dir ? 1 - it : it, rl = dir ? (15 - fr) + 16 * fq : lane;
                bf16x8 af[2];
#pragma unroll
                for (int ks = 0; ks < 2; ++ks) af[ks] = __builtin_bit_cast(bf16x8, *(const GAS v4u*)(rb + ((rt * 2 + ks) * 64 + rl) * 8));
#pragma unroll
                for (int vb = 0; vb < 4; ++vb) {
                    f32x4 a;
                    if (dir == 0) { const v2u w = *(const GAS v2u*)(yl + ((it * 4 + vb) * 64 + lane) * 4);
                        a = (f32x4){__builtin_bit_cast(float, w.x << 16), __builtin_bit_cast(float, w.x & 0xffff0000u), __builtin_bit_cast(float, w.y << 16), __builtin_bit_cast(float, w.y & 0xffff0000u)}; }
                    else { const v2u w = *(const GAS v2u*)(yl + (((1 - it) * 4 + vb) * 64 + fr + 16 * (3 - fq)) * 4);
                        a = y[it][vb]; a[0] += __builtin_bit_cast(float, w.y & 0xffff0000u); a[1] += __builtin_bit_cast(float, w.y << 16); a[2] += __builtin_bit_cast(float, w.x & 0xffff0000u); a[3] += __builtin_bit_cast(float, w.x << 16); }
#pragma unroll
                    for (int ks = 0; ks < 2; ++ks) { const v2u s0 = *(const GAS v2u*)(st + ((vb * 4 + 2 * ks) * 64 + lane) * 4), s1 = *(const GAS v2u*)(st + ((vb * 4 + 2 * ks + 1) * 64 + lane) * 4);
                        a = MMA16(af[ks], __builtin_bit_cast(bf16x8, (v4u){s0.x, s0.y, s1.x, s1.y}), a); }
                    y[it][vb] = a; } } }
#pragma unroll
        for (int it = 0; it < 2; ++it)
#pragma unroll
            for (int vb = 0; vb < 4; ++vb)
#pragma unroll
                for (int j = 0; j < 4; ++j) Yt[(16 * it + 4 * fq + j) * 68 + 16 * vb + fr] = y[it][vb][j];
        LDS_WAIT_();
#pragma unroll
        for (int q = 0; q < 4; ++q) { const int e = lane + 64 * q, r = e >> 3, cg8 = e & 7; const size_t o = (tb + r) * 512 + h * 64 + cg8 * 8;
            const f32x4 y0 = *(const LAS f32x4*)(Yt + r * 68 + cg8 * 8), y1 = *(const LAS f32x4*)(Yt + r * 68 + cg8 * 8 + 4); float yv[8] = {y0.x, y0.y, y0.z, y0.w, y1.x, y1.y, y1.z, y1.w};
            float rr[8], k[8], v[8], g[8]; unpack8(*(const GAS v4u*)(c.rs + o), rr); unpack8(*(const GAS v4u*)(c.ks + o), k); unpack8(*(const GAS v4u*)(c.vs + o), v); unpack8(*(const GAS v4u*)(c.gg + o), g);
            float s = 0.f, bon = 0.f;
#pragma unroll
            for (int i = 0; i < 8; ++i) { s += yv[i]; bon += rr[i] * k[i] * c.r_k[h * 64 + cg8 * 8 + i]; }
            const float mu = red8(s, lane) * (1.f / 64.f); bon = red8(bon, lane); float qv = 0.f;
#pragma unroll
            for (int i = 0; i < 8; ++i) { yv[i] -= mu; qv += yv[i] * yv[i]; }
            const float rstd = 1.f / sqrtf(red8(qv, lane) * (1.f / 64.f) + GN_EPS); float out[8];
#pragma unroll
            for (int i = 0; i < 8; ++i) out[i] = (yv[i] * rstd * c.ln_g[h * 64 + cg8 * 8 + i] + bon * v[i]) * g[i];
            st8(c.ycat + (tb + r) * 2048 + 512 + h * 64 + cg8 * 8, out); }
        LDS_WAIT_();
    }
}

__device__ __forceinline__ float quad_sum(float v) {
    v += __builtin_bit_cast(float, __builtin_amdgcn_update_dpp(0, __builtin_bit_cast(int, v), 0xB1, 0xF, 0xF, true));
    v += __builtin_bit_cast(float, __builtin_amdgcn_update_dpp(0, __builtin_bit_cast(int, v), 0x4E, 0xF, 0xF, true));
    return v;
}
__device__ __forceinline__ void rwkv_scan_quad(const Ctx& c, int unit, int w4, int lane) {
    const int dir = unit & 1, h = (unit >> 1) & 7, b = unit >> 4; const int row = w4 * 16 + (lane >> 2), q = lane & 3;
    const float* W = dir ? c.wb : c.wf; const bf16* KD = dir ? c.kdb : c.kdf; const bf16* AK = dir ? c.akb : c.akf; bf16* Y = dir ? c.yb : c.yf;
    float S[16];
#pragma unroll
    for (int i = 0; i < 16; ++i) S[i] = 0.f;
    for (int k = 0; k < SEQ; ++k) {
        const int s = dir ? SEQ - 1 - k : k; const size_t o = ((size_t)b * SEQ + s) * 512 + h * 64 + q * 16;
        float kkv[16], akv[16], kdv[16], rv[16], wv[16];
        { const v4u a = *(const GAS v4u*)(c.kk + o), bq = *(const GAS v4u*)(c.kk + o + 8);
          const unsigned t[8] = {a.x, a.y, a.z, a.w, bq.x, bq.y, bq.z, bq.w};
#pragma unroll
          for (int i = 0; i < 8; ++i) { kkv[2 * i] = __builtin_bit_cast(float, t[i] << 16); kkv[2 * i + 1] = __builtin_bit_cast(float, t[i] & 0xffff0000u); } }
        { const v4u a = *(const GAS v4u*)(AK + o), bq = *(const GAS v4u*)(AK + o + 8);
          const unsigned t[8] = {a.x, a.y, a.z, a.w, bq.x, bq.y, bq.z, bq.w};
#pragma unroll
          for (int i = 0; i < 8; ++i) { akv[2 * i] = __builtin_bit_cast(float, t[i] << 16); akv[2 * i + 1] = __builtin_bit_cast(float, t[i] & 0xffff0000u); } }
        { const v4u a = *(const GAS v4u*)(KD + o), bq = *(const GAS v4u*)(KD + o + 8);
          const unsigned t[8] = {a.x, a.y, a.z, a.w, bq.x, bq.y, bq.z, bq.w};
#pragma unroll
          for (int i = 0; i < 8; ++i) { kdv[2 * i] = __builtin_bit_cast(float, t[i] << 16); kdv[2 * i + 1] = __builtin_bit_cast(float, t[i] & 0xffff0000u); } }
        { const v4u a = *(const GAS v4u*)(c.rs + o), bq = *(const GAS v4u*)(c.rs + o + 8);
          const unsigned t[8] = {a.x, a.y, a.z, a.w, bq.x, bq.y, bq.z, bq.w};
#pragma unroll
          for (int i = 0; i < 8; ++i) { rv[2 * i] = __builtin_bit_cast(float, t[i] << 16); rv[2 * i + 1] = __builtin_bit_cast(float, t[i] & 0xffff0000u); } }
#pragma unroll
        for (int i = 0; i < 4; ++i) { const f32x4 w4v = *(const GAS f32x4*)(W + o + 4 * i); wv[4 * i] = w4v.x; wv[4 * i + 1] = w4v.y; wv[4 * i + 2] = w4v.z; wv[4 * i + 3] = w4v.w; }
        const float v = bf2f(c.vs[o - q * 16 + row]);
        float sk = 0.f;
#pragma unroll
        for (int i = 0; i < 16; ++i) sk += S[i] * kkv[i];
        sk = quad_sum(sk);
        float y = 0.f;
#pragma unroll
        for (int i = 0; i < 16; ++i) { S[i] = S[i] * wv[i] - sk * akv[i] + v * kdv[i]; y += S[i] * rv[i]; }
        y = quad_sum(y);
        if (q == 0) Y[o + row] = f2bf(y);
    }
}
constexpr int MOE_ITEMS_PER_E = 2 * (DM / 64) * (DE / 64) + (DE / 64) * (DM / 64);
template <int E_LO, int E_HI, bool WITH_D>
__device__ __forceinline__ void moe_convert(const Args& args, unsigned char* ws, int ll, LAS unsigned char* lds, int wave, int lane, int it0, int stride) {
    constexpr int I_GU = (DM / 64) * (DE / 64), I_D = (DE / 64) * (DM / 64), N_GU = (E_HI - E_LO) * 2 * I_GU, it_end = N_GU + (WITH_D ? NEXP * I_D : 0);
    bf16* WdT = (bf16*)(ws + WS_WD); LAS float* scr = (LAS float*)(lds + wave * 16384);
    const float* wg_ = (const float*)args.in[26] + (size_t)ll * NEXP * DM * DE; const float* wu_ = (const float*)args.in[27] + (size_t)ll * NEXP * DM * DE; const float* wd_ = (const float*)args.in[28] + (size_t)ll * NEXP * DE * DM;
#define MOE_ITEM(p, it_) do { \
        if ((it_) < N_GU) { const int e_ = E_LO + (it_) / (2 * I_GU); int r_ = (it_) % (2 * I_GU); const int up_ = r_ >= I_GU ? 1 : 0; r_ -= up_ * I_GU; const int kb_ = r_ % (DM / 64), n0_ = 64 * (r_ / (DM / 64));       \
            (p) = TrItem{(up_ ? wu_ : wg_) + (size_t)e_ * DM * DE, (bf16*)(ws + wgu_off(e_)), DM, DE, 64 * kb_, n0_, (n0_ >> 7) * 256 + (n0_ & 127) + up_ * 128}; } \
        else { const int jj_ = (it_) - N_GU, e_ = jj_ / I_D, r_ = jj_ % I_D; const int kb_ = r_ % (DE / 64), n0_ = 64 * (r_ / (DE / 64)); (p) = TrItem{wd_ + (size_t)e_ * DE * DM, WdT + (size_t)e_ * DM * DE, DE, DM, 64 * kb_, n0_, n0_}; } } while (0)
    f32x4 va[16]; TrItem pa, pb;
    int it = it0;
    if (it < it_end) { MOE_ITEM(pa, it); tr64_load(va, pa, lane); }
#pragma unroll 1
    while (it < it_end) {
        tr64_put(va, scr, lane);
        const int i1 = it + stride;
        if (i1 < it_end) { MOE_ITEM(pb, i1); tr64_load(va, pb, lane); }
        tr64_get(pa, scr, lane);
        pa = pb; it = i1;
    }
#undef MOE_ITEM
}
template <int KSEL>
__device__ __forceinline__ void layer_program(const Args& args, LAS unsigned char* lds, const XcdBarrier& bar, const int l) {
        PH_ON(0) {
            PHASE_LOCALS();
            bf16* WinT = (bf16*)(ws + WS_WIN); bf16* WoutT = (bf16*)(ws + WS_WOUT);
            LAS float* scr = (LAS float*)(lds + wave * 16384);
            const float* w_in = (const float*)args.in[3] + (size_t)ll * DM * D_IN; const float* w_out = (const float*)args.in[4] + (size_t)ll * DM * DM;
            constexpr int I_IN = (DM / 64) * (D_IN / 32), I_OUT = (DM / 64) * (DM / 32);
            constexpr int NITEMS = I_IN + I_OUT;
            for (int it = gw; it < NITEMS; it += NGW) {
                int r = it;
                if (r < I_IN) { const int nblk = D_IN / 32, kb = r / nblk, nb = r % nblk, n0 = 32 * nb;
                    const float sc = ((n0 >= OFF_A + 512 && n0 < OFF_A + 1024) || (n0 >= OFF_D_SRC && n0 < OFF_D_SRC + 512)) ? 0.125f : 1.f;
                    int drow0 = n0 + (n0 >= OFF_D_SRC ? OFF_D - OFF_D_SRC : 0), rmode = 0;
                    if (n0 < OFF_A + 1024) { drow0 = (n0 & ~63) + ((n0 >> 5) & 1); rmode = 1; }
                    else if (n0 >= OFF_D_SRC && n0 < OFF_D_SRC + 1024 && (((n0 - OFF_D_SRC) >> 5) & 1) == 0) rmode = 2;
                    transpose_item(w_in, DM, D_IN, WinT, 64 * kb, n0, drow0, scr, lane, sc, rmode); continue; } r -= I_IN;
                { const int nblk = DM / 32, kb = r / nblk, nb = r % nblk; transpose_item(w_out, DM, DM, WoutT, 64 * kb, 32 * nb, 32 * nb, scr, lane); }
            }
            for (long i = gtid; i < (long)(NPROJ - D_IN) * DM / 8; i += gstride) ((GAS v4u*)(WinT + (size_t)OFF_D_SRC * DM))[i] = (v4u){0u, 0u, 0u, 0u};
            if (ll == 0) { for (long i = gtid; i < (long)T * 40; i += gstride) v_rot_table((const int*)args.in[1], (float*)(ws + WS_ROT), i); }
            {   const float* wg = (const float*)args.in[22] + (size_t)ll * DM * 4; const float* we = (const float*)args.in[24] + (size_t)ll * DM * 32; float* rwt = (float*)(ws + WS_RWT);
                const float* n2g = (const float*)args.in[21] + ll * DM;
                for (long i = gtid; i < 48L * DM; i += gstride) { const int j = (int)(i & 3), ln = (int)((i >> 2) & 63), hh = (int)((i >> 8) & 1), r_ = (int)(i >> 9), tl = r_ % 3, S = r_ / 3;
                    const int k = 32 * S + 8 * (ln >> 4) + 4 * hh + j, col = 16 * tl + (ln & 15);
                    rwt[i] = (col < 32 ? we[(size_t)k * 32 + col] : (col < 36 ? wg[(size_t)k * 4 + col - 32] : 0.f)) * n2g[k]; } }
            if (ll > 0) build_moe_tables(lds, (const unsigned*)(ws + WS_CTL) + CW_CNT + (ll - 1) * 2048, tid);
            const LAS int* trb = (const LAS int*)(lds + TAB_ROWBASE);
            const float* x_in = (const float*)args.in[0]; bf16* xbuf = (bf16*)(ws + WS_X); bf16* act = (bf16*)(ws + WS_ACT); const bf16* yp = (const bf16*)(ws + WS_YP);
            const unsigned* slot_tok = (const unsigned*)(ws + WS_SLOT); const float* gate_tok = (const float*)(ws + WS_GATE);
            const float* norm1_g = (const float*)args.in[2] + ll * DM;
            if (ll == 0) {
#pragma unroll 1
                for (int m0 = gw; m0 < T; m0 += 4 * NGW) rows_norm_f32<4>(x_in, norm1_g, act, m0, NGW, lane);
            } else {
#pragma unroll 1
                for (int m0 = gw; m0 < T; m0 += 2 * NGW) rows_moe<2, false>(xbuf, yp, slot_tok, gate_tok, trb, norm1_g, act, nullptr, 1.f, m0, NGW, lane);
            }
        }
        SEAM(0); TSTAMP_AFTER(0);
        PH_ON(1) {
            PHASE_LOCALS();
            const int G1 = G >= 256 ? GEMM1_G : G;
            if (bid < G1) {
                pg8::Gemm g{(const bf16*)(ws + WS_ACT), (const bf16*)(ws + WS_WIN), T, NPROJ, DM, 0, 0}; pg8::StaticOrder<T, NPROJ> S; S.init(G1, bid);
                pg8::EpiBf16Rot E{(bf16*)(ws + WS_PROJ), NPROJ, (const float*)(ws + WS_ROT)};
                pg8::gemm_phase<DM, pg8::EpiBf16Rot, pg8::StaticOrder<T, NPROJ>, true, true>(lds, g, S, E, tid);
            }
            if (G1 == G) { __syncthreads(); moe_convert<0, 16, false>(args, ws, ll, lds, wave, lane, gw, NGW); }
            else if (bid >= G1) moe_convert<0, 16, false>(args, ws, ll, lds, wave, lane, (bid - G1) * 8 + wave, (G - G1) * 8);
        }
        SEAM(1); TSTAMP_AFTER(1);
        PH_ON(2) { PHASE_LOCALS(); const Ctx c = make_ctx(args, ws, ll);
            {   constexpr unsigned NSH = (unsigned)T * 248u; const unsigned gs = (unsigned)gstride;
#pragma unroll 1
                for (unsigned base = (unsigned)gtid; base < NSH; base += 8u * gs) { ShiftIn in[8];
#pragma unroll
                    for (int u = 0; u < 8; ++u) { const unsigned idx = base + (unsigned)u * gs; if (idx < NSH) shift_load(c, idx, in[u]); }
#pragma unroll
                    for (int u = 0; u < 8; ++u) { const unsigned idx = base + (unsigned)u * gs; if (idx < NSH) shift_finish(c, idx, in[u]); } } }
#pragma unroll 1
            for (int m = gw; m < T; m += 4 * NGW) w_sgu_prep_batch<4>(c, m, NGW, lane); }
        SEAM(2); TSTAMP_AFTER(2);
        PH_ON(3) { PHASE_LOCALS(); const Ctx c = make_ctx(args, ws, ll);
            rwkv_lora_phase(lds, c, tid, bid, G);
            ret_kv_phase(lds, c.proj, c.gam, c.rkv, tid, bid, G);
            sgu_phase(lds, c.proj, c.sgu_w, c.sgu_bias, c.ycat, tid, bid, G);
            dil_attn_phase(lds, c.proj, (bf16*)(ws + WS_DPO), (float*)(ws + WS_DML), tid, bid, G); }
        SEAM(3); TSTAMP_AFTER(3);
        PH_ON(5) { PHASE_LOCALS(); const Ctx c = make_ctx(args, ws, ll);
            for (long i = gtid; i < (long)BATCH * 8 * 2 * 4096; i += gstride) el_ret_scan(c, i);
            rwkv_chunk_phase(lds, c, ws, tid, bid, G); }
        SEAM(5); TSTAMP_AFTER(5);
        PH_ON(13) { PHASE_LOCALS(); const Ctx c = make_ctx(args, ws, ll);
            constexpr int NU = BATCH * 16 * 2;
            if (bid < NU) { if (tid < 64) ((LAS unsigned*)(lds + 4 * RWS_RING_B))[tid] = 0u; __syncthreads(); rwkv_sscan_phase(lds, ws, bid >> 1, 2 * (bid & 1), wave, lane);
                __syncthreads(); moe_convert<16, 25, false>(args, ws, ll, lds, wave, lane, bid * 8 + wave, NU * 8); }
            else { ret_out_phase(lds, c.proj, c.gam, c.ret_g, c.rsp, c.ycat, tid, bid - NU, G - NU);
#pragma unroll 1
                for (long i = (long)(bid - NU) * 512 + tid; i < (long)T * 64; i += 4 * (long)(G - NU) * 512) v_dil_combine_batch<4>((const bf16*)(ws + WS_DPO), (const float*)(ws + WS_DML), c.ycat, i, (long)(G - NU) * 512, (long)T * 64);
 } }
        SEAM(13); TSTAMP_AFTER(13);
        PH_ON(6) { PHASE_LOCALS(); const Ctx c = make_ctx(args, ws, ll);
            rwkv_yfin_phase(lds, c, ws, tid, bid, G); }
        SEAM(6); TSTAMP_AFTER(6);
        PH_ON(7) {
            PHASE_LOCALS();
            pg8::Gemm g{(const bf16*)(ws + WS_ACT), (const bf16*)(ws + WS_WOUT), T, DM, DM, 0, 0}; pg8::StaticOrder<T, DM> S; S.init(G, bid);
            pg8::EpiResB E{ll == 0 ? (const float*)args.in[0] : nullptr, (const bf16*)(ws + WS_X), (bf16*)(ws + WS_X), DM};
            pg8::gemm_phase<DM, pg8::EpiResB, pg8::StaticOrder<T, DM>, true, true>(lds, g, S, E, tid);
        }
        SEAM(7); TSTAMP_AFTER(7);
        PH_ON(8) {
            PHASE_LOCALS();
            const float* wg = (const float*)args.in[22] + (size_t)ll * DM * 4; const float* bg = (const float*)args.in[23] + ll * 4;
            const float* we = (const float*)args.in[24] + (size_t)ll * DM * 32; const float* be = (const float*)args.in[25] + ll * 32;
            const float* norm2_g = (const float*)args.in[21] + ll * DM;
            const bf16* xbuf = (const bf16*)(ws + WS_X);
            unsigned* cnt_tab = (unsigned*)(ws + WS_TOK); unsigned* slot_tok = (unsigned*)(ws + WS_SLOT); float* gate_tok = (float*)(ws + WS_GATE); float* rstd_tok = (float*)(ws + WS_TOK + 256 * 1024);
            const float* rwt = (const float*)(ws + WS_RWT); const int fr = lane & 15, fq = lane >> 4;
            LAS float* lg_s = (LAS float*)(lds + wave * 16384);
            LAS unsigned* lcnt = (LAS unsigned*)(lds + 65536); LAS unsigned* lbase = lcnt + 32;
            static_assert(T / 16 % 4 == 0, "router tiles");
            for (int tile0 = bid; tile0 < T / 64; tile0 += G) { const int tile = tile0 + (T / 64) * (wave & 3); const bool wact = wave < 4;
                if (tid < 32) lcnt[tid] = 0u;
                __syncthreads();
              int e1 = 0, e2 = 0; float g1 = 0.f, g2 = 0.f; unsigned r1 = 0u, r2 = 0u; float rstd = 0.f; const size_t m0 = (size_t)tile * 16; const bf16* xr = xbuf + (m0 + fr) * DM;
              f32x4 acc[3]; float ss = 0.f;
              {
#pragma unroll
                for (int tl = 0; tl < 3; ++tl) acc[tl] = (f32x4){0.f, 0.f, 0.f, 0.f};
                const int sb = (DM / 64) * (wave >> 2);
                struct RtOp { f32x4 x[2], b[3][2]; };
#define RT_LOAD(o, S_) do { const int sc_ = (S_) < DM / 32 ? (S_) : DM / 32 - 1, k0_ = 32 * sc_ + 8 * fq; \
        { const v4u xw_ = *(const GAS v4u*)(xr + k0_); (o).x[0] = (f32x4){__builtin_bit_cast(float, xw_.x << 16), __builtin_bit_cast(float, xw_.x & 0xffff0000u), __builtin_bit_cast(float, xw_.y << 16), __builtin_bit_cast(float, xw_.y & 0xffff0000u)}; \
          (o).x[1] = (f32x4){__builtin_bit_cast(float, xw_.z << 16), __builtin_bit_cast(float, xw_.z & 0xffff0000u), __builtin_bit_cast(float, xw_.w << 16), __builtin_bit_cast(float, xw_.w & 0xffff0000u)}; } \
        _Pragma("unroll") for (int hh = 0; hh < 2; ++hh) \
            _Pragma("unroll") for (int tl = 0; tl < 3; ++tl) (o).b[tl][hh] = *(const GAS f32x4*)(rwt + ((size_t)((sc_ * 3 + tl) * 2 + hh) * 64 + lane) * 4); } while (0)
#define RT_MMA(o) do { _Pragma("unroll") for (int hh = 0; hh < 2; ++hh) { ss += ((o).x[hh].x * (o).x[hh].x + (o).x[hh].y * (o).x[hh].y) + ((o).x[hh].z * (o).x[hh].z + (o).x[hh].w * (o).x[hh].w); const f32x4 av_ = (o).x[hh]; \
        _Pragma("unroll") for (int tl = 0; tl < 3; ++tl) _Pragma("unroll") for (int j = 0; j < 4; ++j) acc[tl] = __builtin_amdgcn_mfma_f32_16x16x4f32(av_[j], (o).b[tl][hh][j], acc[tl], 0, 0, 0); } } while (0)
                RtOp oa, ob, oc;
                RT_LOAD(oa, sb); RT_LOAD(ob, sb + 1);
#pragma unroll 1
                for (int S = sb; S < sb + DM / 64 - 2; S += 6) {
                    RT_LOAD(oc, S + 2); RT_MMA(oa); RT_LOAD(oa, S + 3); RT_MMA(ob); RT_LOAD(ob, S + 4); RT_MMA(oc);
                    RT_LOAD(oc, S + 5); RT_MMA(oa); RT_LOAD(oa, S + 6); RT_MMA(ob); RT_LOAD(ob, S + 7); RT_MMA(oc); }
                RT_MMA(oa); RT_MMA(ob);
                static_assert((DM / 64 - 2) % 6 == 0, "router pipeline");
#undef RT_LOAD
#undef RT_MMA
              }
              {   LAS float* part = (LAS float*)(lds + (4 + (wave & 3)) * 16384 + 1024);
                if (!wact) {
#pragma unroll
                    for (int tl = 0; tl < 3; ++tl)
#pragma unroll
                        for (int j = 0; j < 4; ++j) part[(tl * 4 + j) * 64 + lane] = acc[tl][j];
                    part[12 * 64 + lane] = ss; }
                __syncthreads();
                if (wact) {
#pragma unroll
                    for (int tl = 0; tl < 3; ++tl)
#pragma unroll
                        for (int j = 0; j < 4; ++j) acc[tl][j] += part[(tl * 4 + j) * 64 + lane];
                    ss += part[12 * 64 + lane]; } }
              if (wact) {
                ss = xlane_sum4(ss, lane);
                rstd = 1.f / sqrtf(ss * (1.f / DM) + NORM_EPS);
#pragma unroll
                for (int tl = 0; tl < 3; ++tl)
#pragma unroll
                    for (int j = 0; j < 4; ++j) lg_s[(4 * fq + j) * 48 + 16 * tl + fr] = acc[tl][j];
                if (fq == 0) lg_s[768 + fr] = rstd;
                LDS_WAIT(); asm volatile("" ::: "memory");
                if (lane < 16) { const float rs_ = lg_s[768 + lane]; float lg[4], le[32];
#pragma unroll
                    for (int i = 0; i < 32; ++i) le[i] = lg_s[lane * 48 + i] * rs_;
#pragma unroll
                    for (int i = 0; i < 4; ++i) lg[i] = lg_s[lane * 48 + 32 + i] * rs_;
                    route_select(lg, le, bg, be, e1, e2, g1, g2);
                    r1 = __hip_atomic_fetch_add(lcnt + e1, 1u, __ATOMIC_RELAXED, __HIP_MEMORY_SCOPE_WORKGROUP); r2 = __hip_atomic_fetch_add(lcnt + e2, 1u, __ATOMIC_RELAXED, __HIP_MEMORY_SCOPE_WORKGROUP); }
              }
                __syncthreads();
                if (tid < 32) cnt_tab[tile0 * 32 + tid] = lcnt[tid];
              if (wact) {
                if (lane < 16) { const int m = (int)m0 + lane;
                    slot_tok[2 * m] = ((unsigned)e1 << 20) | r1; slot_tok[2 * m + 1] = ((unsigned)e2 << 20) | r2; gate_tok[2 * m] = g1; gate_tok[2 * m + 1] = g2; }
                if (fq == 0) rstd_tok[m0 + fr] = rstd;
              }
                __syncthreads();
            }
        }
        SEAM(8); TSTAMP_AFTER(8);
        PH_ON(9) {
            PHASE_LOCALS();
            moe_convert<25, 32, false>(args, ws, ll, lds, wave, lane, gw, NGW);
            {
                const unsigned* cnt_tab = (const unsigned*)(ws + WS_TOK); unsigned* slot_tok = (unsigned*)(ws + WS_SLOT); unsigned* cnt_cur = (unsigned*)(ws + WS_CTL) + CW_CNT + ll * 2048;
                const bf16* xbuf = (const bf16*)(ws + WS_X); const float* norm2_g = (const float*)args.in[21] + ll * DM; const float* rstd_tok = (const float*)(ws + WS_TOK + 256 * 1024); bf16* aperm = (bf16*)(ws + WS_APERM);
                LAS int* tcnt = (LAS int*)(lds + TAB_CNT); const LAS int* trb = (const LAS int*)(lds + TAB_ROWBASE);
                LAS int* gbase = (LAS int*)(lds + 8192); LAS int* clist = (LAS int*)(lds + 8192 + 256);
                static_assert((T / 64) % 16 == 0, "prefix parts");
                constexpr int GPP = T / 64 / 16;
                LAS int* psum = (LAS int*)(lds + 16384);
                __syncthreads();
                {   const int e = tid & 31, p = tid >> 5; int sacc = 0;
#pragma unroll
                    for (int u = 0; u < GPP; ++u) sacc += (int)cnt_tab[(p * GPP + u) * 32 + e];
                    psum[p * 32 + e] = sacc; }
                __syncthreads();
                if (tid < 32) { int run = 0;
#pragma unroll
                    for (int p = 0; p < 16; ++p) run += psum[p * 32 + tid];
                    tcnt[tid] = run; if (bid == 0) cnt_cur[64 * tid] = (unsigned)run; }
                build_moe_tables(lds, nullptr, tid);
                for (int rg = bid; rg < T / 64; rg += G) {
                    __syncthreads();
                    if (tid < 32) { const int p0 = rg / GPP; int base = 0;
                        for (int p = 0; p < p0; ++p) base += psum[p * 32 + tid];
#pragma unroll
                        for (int u = 0; u < GPP; ++u) base += (p0 * GPP + u < rg) ? (int)cnt_tab[(p0 * GPP + u) * 32 + tid] : 0;
                        gbase[tid] = base; }
                    __syncthreads();
                    if (wave < 4 && lane < 16) { const int m = 16 * (rg + (T / 64) * wave) + lane; clist[(wave * 16 + lane) * 4] = m;
#pragma unroll
                        for (int k = 0; k < 2; ++k) { const unsigned sv = slot_tok[2 * m + k]; const int e = (int)(sv >> 20); const int r = gbase[e] + (int)(sv & 0xfffffu);
                            slot_tok[2 * m + k] = ((unsigned)e << 20) | (unsigned)r; clist[(wave * 16 + lane) * 4 + 1 + k] = trb[e] + r; } }
                    __syncthreads();
                    for (int i = wave; i < 64; i += 8) {
                        const int m = clist[4 * i]; const size_t R1 = (size_t)clist[4 * i + 1], R2 = (size_t)clist[4 * i + 2]; const float rs_ = rstd_tok[m];
                        f32x4 v[8]; ROW_LOAD_BF(v, xbuf + (size_t)m * DM);
#pragma unroll
                        for (int j = 0; j < 8; ++j) { const f32x4 g = ((const GAS f32x4*)norm2_g)[lane + 64 * j];
                            v2u o; o.x = cvtpk(v[j].x * g.x * rs_, v[j].y * g.y * rs_); o.y = cvtpk(v[j].z * g.z * rs_, v[j].w * g.w * rs_);
                            ((GAS v2u*)(aperm + R1 * DM))[lane + 64 * j] = o; ((GAS v2u*)(aperm + R2 * DM))[lane + 64 * j] = o; } }
                }
                for (int e = 0; e < NEXP; ++e) { const int c0 = tcnt[e], rend = ((c0 + 255) >> 8) * 256;
                    for (int r = c0 + gw; r < rend; r += NGW) { GAS v4u* dst = (GAS v4u*)(aperm + (size_t)(trb[e] + r) * DM);
#pragma unroll
                        for (int j = 0; j < 4; ++j) dst[lane + 64 * j] = (v4u){0u, 0u, 0u, 0u}; } }
            }
        }
        SEAM(9); TSTAMP_AFTER(9);
        PH_ON(10) {
            PHASE_LOCALS();
            build_moe_tables(lds, (const unsigned*)(ws + WS_CTL) + CW_CNT + ll * 2048, tid);
            const int ntiles = __builtin_amdgcn_readfirstlane(((const LAS int*)(lds + TAB_NT))[0]);
            pg8::Gemm g{(const bf16*)(ws + WS_APERM), (const bf16*)ws, MOE_MAXTILES * 256, 1024, DM, 0, 1};
            const int units = ntiles * 4, rounds = (units + G - 1) / G, G3r = rounds > 0 ? (units + rounds - 1) / rounds : G, G3 = (G - G3r >= 16) ? G3r : G;
            if (bid < G3) {
                pg8::MoeOrder<4> S{G3, bid, ntiles, (const LAS int*)(lds + TAB_TEXP)};
                pg8::EpiSwiGLU E{(bf16*)(ws + WS_HID), DE};
                pg8::gemm_phase<DM, pg8::EpiSwiGLU, pg8::MoeOrder<4>, true, true>(lds, g, S, E, tid);
            }
            if (G3 == G) { __syncthreads(); moe_convert<0, 0, true>(args, ws, ll, lds, wave, lane, gw, NGW); }
            else if (bid >= G3) moe_convert<0, 0, true>(args, ws, ll, lds, wave, lane, (bid - G3) * 8 + wave, (G - G3) * 8);
        }
        SEAM(10); TSTAMP_AFTER(10);
        PH_ON(11) {
            PHASE_LOCALS();
            build_moe_tables(lds, (const unsigned*)(ws + WS_CTL) + CW_CNT + ll * 2048, tid);
            const int ntiles = __builtin_amdgcn_readfirstlane(((const LAS int*)(lds + TAB_NT))[0]);
            pg8::Gemm g{(const bf16*)(ws + WS_HID), (const bf16*)(ws + WS_WD), MOE_MAXTILES * 256, DM, DE, (size_t)DM * DE * 2, 0};
            pg8::MoeOrder<8> S{G, bid, ntiles, (const LAS int*)(lds + TAB_TEXP)};
            pg8::EpiBf16 E{(bf16*)(ws + WS_YP), DM};
            pg8::gemm_phase<DE, pg8::EpiBf16, pg8::MoeOrder<8>, true, true>(lds, g, S, E, tid);
        }
        SEAM(11); TSTAMP_AFTER(11);
    }

template <int KSEL>
__global__ void __launch_bounds__(512, 2) fwd_kernel(Args args) {
    extern __shared__ __attribute__((aligned(16))) unsigned char lds_raw[];
    LAS unsigned char* lds = (LAS unsigned char*)lds_raw;
    if (threadIdx.x < 4) ((LAS unsigned*)(lds + MISC_OFF))[threadIdx.x] = 0u;
    __syncthreads();
    XcdBarrier bar; bar.bar = (unsigned*)(args.ws + WS_CTL) + CW_BAR; bar.x = 0; bar.st = nullptr;
    if constexpr (KSEL < 0) bar = xcd_barrier_post((unsigned*)(args.ws + WS_CTL) + CW_BAR, (volatile LAS unsigned*)(lds + MISC_OFF));
    if (KB_TPROBE >= 0 && KSEL < 0 && blockIdx.x == 0 && threadIdx.x == 0) ((unsigned long long*)(args.ws + WS_CTL))[32768] = wall_clock64();
    if constexpr (KSEL < 0) { layer_program<KSEL>(args, lds, bar, 0); layer_program<KSEL>(args, lds, bar, 1); }
    else if constexpr (KSEL != 12) layer_program<KSEL>(args, lds, bar, args.layer);
    PH_ON(12) {
        const int l = DEPTH - 1;
        PHASE_LOCALS();
        build_moe_tables(lds, (const unsigned*)(ws + WS_CTL) + CW_CNT + ll * 2048, tid);
        const LAS int* trb = (const LAS int*)(lds + TAB_ROWBASE);
        float pscale = 1.f;
        if (KB_TPROBE >= 0) { const unsigned long long* ts = (const unsigned long long*)(ws + WS_CTL) + 32768; const int p = KB_TPROBE;
            const float tot = (float)(ts[13] - ts[0]); const int pe = KB_TPROBE_END; const float d = (float)(ts[pe] - ts[p]);
            pscale = 1.f + 0.01f * (float)(int)(d / tot * 40.f + 0.5f); }
        const float* gfin = (const float*)args.in[29]; const bf16* xbuf = (const bf16*)(ws + WS_X); const bf16* yp = (const bf16*)(ws + WS_YP);
        const unsigned* slot_tok = (const unsigned*)(ws + WS_SLOT); const float* gate_tok = (const float*)(ws + WS_GATE);
        for (int m = gw; m < T; m += NGW) {
            f32x4 v[8];
            ROW_LOAD_BF(v, xbuf + (size_t)m * DM);
            const unsigned s1 = slot_tok[2 * m], s2 = slot_tok[2 * m + 1]; const float g1 = gate_tok[2 * m], g2 = gate_tok[2 * m + 1];
            row_add_moe(v, yp, (size_t)(trb[s1 >> 20] + (int)(s1 & 0xfffffu)), (size_t)(trb[s2 >> 20] + (int)(s2 & 0xfffffu)), g1, g2, lane);
            const float rstd = row_rstd(v, lane);
#pragma unroll
            for (int j = 0; j < 8; ++j) { const f32x4 g = ((const GAS f32x4*)gfin)[lane + 64 * j];
                ((GAS f32x4*)(args.out + (size_t)m * DM))[lane + 64 * j] = (f32x4){v[j].x * rstd * g.x * pscale, v[j].y * rstd * g.y * pscale, v[j].z * rstd * g.z * pscale, v[j].w * rstd * g.w * pscale}; }
        }
    }
#undef SEAM
#undef PH_ON
}

extern "C" void kernel_launch(void* const* d_in, const int* in_sizes, int n_in, void* d_out, int out_size, void* d_ws, size_t ws_size, hipStream_t stream) {
    static int grid = 0;
    if (grid == 0) {
        if (n_in != 30 || in_sizes[0] != T * DM || out_size != T * DM || ws_size < WS_END) { fprintf(stderr, "kernel_launch: unexpected shapes (n_in %d, in0 %d, out %d, ws %zu < %zu)\n", n_in, n_in > 0 ? in_sizes[0] : -1, out_size, ws_size, (size_t)WS_END); grid = -1; return; }
        int dev = 0, cus = 0, per_cu = 0; (void)per_cu;
        if (hipGetDevice(&dev) != hipSuccess || hipDeviceGetAttribute(&cus, hipDeviceAttributeMultiprocessorCount, dev) != hipSuccess) { grid = -1; return; }
#if KB_SPLIT
#define SET_ATTR(k) if (hipFuncSetAttribute((const void*)fwd_kernel<k>, hipFuncAttributeMaxDynamicSharedMemorySize, LDS_BYTES) != hipSuccess) { fprintf(stderr, "kernel_launch: hipFuncSetAttribute failed (%d)\n", k); grid = -1; return; }
        SET_ATTR(0) SET_ATTR(1) SET_ATTR(2) SET_ATTR(3) SET_ATTR(4) SET_ATTR(5) SET_ATTR(6) SET_ATTR(7) SET_ATTR(8) SET_ATTR(9) SET_ATTR(10) SET_ATTR(11) SET_ATTR(12) SET_ATTR(13)
#else
        if (hipFuncSetAttribute((const void*)fwd_kernel<-1>, hipFuncAttributeMaxDynamicSharedMemorySize, LDS_BYTES) != hipSuccess) { fprintf(stderr, "kernel_launch: hipFuncSetAttribute failed\n"); grid = -1; return; }
        if (hipOccupancyMaxActiveBlocksPerMultiprocessor(&per_cu, (const void*)fwd_kernel<-1>, 512, LDS_BYTES) != hipSuccess || per_cu < 1) fprintf(stderr, "kernel_launch: occupancy query says %d\n", per_cu);
#endif
        (void)hipGetLastError();
        grid = cus;
    }
    if (grid < 0) return;
    if (hipMemsetAsync((char*)d_ws + WS_CTL, 0, CTL_ZERO_BYTES, stream) != hipSuccess) return;
    Args a{};
    for (int i = 0; i < 30; ++i) a.in[i] = d_in[i];
    a.out = (float*)d_out; a.ws = (unsigned char*)d_ws; a.layer = 0; a.pad = 0;
#if KB_SPLIT
#define LAUNCH_PH(k) hipLaunchKernelGGL(fwd_kernel<k>, dim3(grid), dim3(512), LDS_BYTES, stream, a)
    for (int l = 0; l < DEPTH; ++l) { a.layer = l;
        LAUNCH_PH(0); LAUNCH_PH(1); LAUNCH_PH(2); LAUNCH_PH(3); LAUNCH_PH(4); LAUNCH_PH(5); LAUNCH_PH(13); LAUNCH_PH(6); LAUNCH_PH(7); LAUNCH_PH(8); LAUNCH_PH(9); LAUNCH_PH(10); LAUNCH_PH(11); }
    a.layer = DEPTH - 1; LAUNCH_PH(12);
#else
    hipLaunchKernelGGL(fwd_kernel<-1>, dim3(grid), dim3(512), LDS_BYTES, stream, a);
#endif
}
#endif
```

```cpp
#ifndef KB_EMU
#include <hip/hip_runtime.h>
#endif
#include <cstdio>
#include <cstdint>
#include <cmath>

#ifndef KB_BATCH
#define KB_BATCH 4
#define KB_SEQ 4096
#endif
#ifndef KB_SPLIT
#define KB_SPLIT 0
#endif

#ifndef KB_PHMASK
#define KB_PHMASK 0xffff
#endif
#define KB_EN(k) (((KB_PHMASK) >> (k)) & 1)
#ifndef KB_TPROBE
#define KB_TPROBE -1
#endif
#ifndef KB_TPROBE_END
#define KB_TPROBE_END (KB_TPROBE + 1)
#endif
#define HD __host__ __device__ __forceinline__
typedef unsigned short bf16;

constexpr int BATCH = KB_BATCH, SEQ = KB_SEQ, T = BATCH * SEQ;
constexpr int DM = 2048, DG = 512, NH = 8, HDIM = 64;
constexpr int A_COLS = 2048, B_COLS = 1984, C_COLS = 1024, D_COLS = 1536, D_IN = 6592, NPROJ = 6656;
constexpr int OFF_A = 0, OFF_B = 2048, OFF_C = 4032, OFF_D_SRC = 5056  , OFF_D = 5120  ;
static_assert(OFF_D % 256 == 0 && OFF_D + D_COLS == NPROJ && OFF_D - OFF_D_SRC == NPROJ - D_IN, "proj layout");
constexpr int NC = SEQ / 128;
constexpr int NEXP = 32, DE = 512;
constexpr int NLORA = 448;
constexpr float NORM_EPS = 1e-6f, GN_EPS = 64e-5f;
constexpr int MOE_MAXTILES = (2 * T + NEXP * 255 + 255) / 256;
constexpr int DEPTH = 2;

constexpr size_t MiB = 1u << 20;
constexpr size_t WS_CTL = 0, CTL_ZERO_BYTES = 1 * MiB;
constexpr size_t WS_WIN = 2 * MiB, WS_WOUT = 28 * MiB;
constexpr size_t WS_WD = 292 * MiB;
__host__ __device__ constexpr size_t wgu_off(int e) { return e < 16 ? (804 + 4 * (size_t)e) * MiB : e < 22 ? (780 + 4 * (size_t)(e - 16)) * MiB : e < 25 ? (868 + 4 * (size_t)(e - 22)) * MiB : (914 + 4 * (size_t)(e - 25)) * MiB; }
constexpr int GEMM1_G = 238;
constexpr size_t WS_X = 228 * MiB;
constexpr size_t WS_ACT = 356 * MiB;
constexpr size_t WS_PROJ = 420 * MiB;
constexpr size_t WS_RKV = 628 * MiB, WS_RSP = 660 * MiB;
constexpr size_t WS_RS = 692 * MiB, WS_KS = 708 * MiB, WS_VS = 724 * MiB, WS_KK = 740 * MiB, WS_GG = 756 * MiB, WS_KDF = 772 * MiB, WS_KDB = 788 * MiB,
                 WS_AKF = 804 * MiB, WS_AKB = 820 * MiB, WS_YF = 836 * MiB, WS_YB = 852 * MiB, WS_LIN = 868 * MiB  , WS_WF = 882 * MiB, WS_WB = 914 * MiB;
constexpr size_t WS_TOK = 946 * MiB  , WS_SLOT = 948 * MiB, WS_GATE = 949 * MiB;
constexpr size_t WS_RB = 36 * MiB  , WS_PT = 68 * MiB  , WS_QF = 132 * MiB  , WS_YL = 196 * MiB  , WS_DC = 1002 * MiB  ;
constexpr size_t WS_DPO = 950 * MiB  , WS_DML = 998 * MiB  , WS_ROT = 1004 * MiB  , WS_ST = 882 * MiB  , WS_RWT = 1010 * MiB  , WS_LORAW = 1011 * MiB  , WS_END = 1012 * MiB;
constexpr size_t WS_APERM = 420 * MiB, WS_HID = 580 * MiB, WS_YP = 620 * MiB;
static_assert((size_t)MOE_MAXTILES * 256 * 2048 * 2 <= 160 * MiB && (size_t)T * NPROJ * 2 <= 208 * MiB, "ws map");
constexpr int CW_BAR = 4096;
constexpr int CW_CNT = 16384;

HD float bf2f(bf16 v) { return __builtin_bit_cast(float, (unsigned)v << 16); }
HD bf16 f2bf(float f) { unsigned u = __builtin_bit_cast(unsigned, f); return (bf16)((u + 0x7fffu + ((u >> 16) & 1u)) >> 16); }
HD float sigmoidf_(float x) { return 1.f / (1.f + expf(-x)); }
HD float siluf_(float x) { return x / (1.f + expf(-x)); }
HD float geluf_(float x) { return 0.5f * x * (1.f + tanhf(0.7978845608028654f * (x + 0.044715f * x * x * x))); }
HD float logsigmoidf_(float x) { return x < 0.f ? x - log1pf(expf(x)) : -log1pf(expf(-x)); }

struct Ctx {
    const int* pos;
    const float *gam, *ret_g, *mu, *w0, *w2, *a0, *a2, *g2, *k_k, *k_a, *r_k, *ln_g, *sgu_g, *sgu_b, *sgu_w, *sgu_bias;
    bf16 *proj, *ycat, *rs, *ks, *vs, *kk, *gg, *kdf, *kdb, *akf, *akb, *yf, *yb, *lin;
    const bf16* loraw;
    float *wf, *wb, *rkv, *rsp;
};

HD void el_rot_ret(const Ctx& c, long idx) {
    const int i = (int)(idx & 31), h = (int)((idx >> 5) & 7); const long t = idx >> 8;
    const float inv = expf(-(float)i * (1.f / 32.f) * 9.210340371976184f);
    const float ang = (float)c.pos[t] * inv; float sn, cs; sincosf(ang, &sn, &cs);
    bf16* q = c.proj + (size_t)t * NPROJ + OFF_A + h * 64; bf16* k = q + 512;
    const float q1 = bf2f(q[i]), q2 = bf2f(q[i + 32]), k1 = bf2f(k[i]), k2 = bf2f(k[i + 32]);
    q[i] = f2bf(q1 * cs - q2 * sn); q[i + 32] = f2bf(q2 * cs + q1 * sn);
    k[i] = f2bf((k1 * cs - k2 * sn) * 0.125f); k[i + 32] = f2bf((k2 * cs + k1 * sn) * 0.125f);
}
HD void el_rot_dil(const Ctx& c, long idx) {
    const int j = (int)(idx & 31), h = (int)((idx >> 5) & 7); const long t = idx >> 8;
    bf16* q = c.proj + (size_t)t * NPROJ + OFF_D + h * 64; bf16* k = q + 512;
    if (j < 8) {
        const float inv = expf(-(float)j * (1.f / 8.f) * 13.122363377404328f);
        const float ang = (float)c.pos[t] * inv; float sn, cs; sincosf(ang, &sn, &cs);
        const float q1 = bf2f(q[j]), q2 = bf2f(q[j + 8]), k1 = bf2f(k[j]), k2 = bf2f(k[j + 8]);
        q[j] = f2bf((q1 * cs - q2 * sn) * 0.125f); q[j + 8] = f2bf((q2 * cs + q1 * sn) * 0.125f);
        k[j] = f2bf(k1 * cs - k2 * sn); k[j + 8] = f2bf(k2 * cs + k1 * sn);
    } else {
        const int d = 16 + 2 * (j - 8);
        q[d] = f2bf(bf2f(q[d]) * 0.125f); q[d + 1] = f2bf(bf2f(q[d + 1]) * 0.125f);
    }
}
HD void el_rwkv_shift(const Ctx& c, long idx) {
    const int j = (int)(idx % B_COLS); const long t = idx / B_COLS; const int s = (int)(t % SEQ);
    const bf16* p = c.proj + (size_t)t * NPROJ + OFF_B + j;
    const float x = bf2f(p[0]), xp = s > 0 ? bf2f(p[-(long)NPROJ]) : 0.f, xn = s < SEQ - 1 ? bf2f(p[NPROJ]) : 0.f;
    const float xs = x + c.mu[j] * (xp - x) + c.mu[B_COLS + j] * (xn - x);
    if (j < 512) c.rs[t * 512 + j] = f2bf(xs);
    else if (j < 1024) c.ks[t * 512 + j - 512] = f2bf(xs);
    else if (j < 1536) c.vs[t * 512 + j - 1024] = f2bf(xs);
    else if (j < 1632) c.lin[t * NLORA + (j - 1536)] = f2bf(tanhf(xs));
    else if (j < 1728) c.lin[t * NLORA + (j - 1536)] = f2bf(xs);
    else c.lin[t * NLORA + (j - 1536)] = f2bf(sigmoidf_(xs));
}
HD void el_rwkv_lora(const Ctx& c, long idx) {
    const int ch = (int)(idx & 511); const long t = idx >> 9;
    const bf16* li = c.lin + t * NLORA;
    float wl = 0.f, al = 0.f, g = 0.f;
    for (int i = 0; i < 96; ++i) { wl += bf2f(li[i]) * c.w2[i * 512 + ch]; al += bf2f(li[96 + i]) * c.a2[i * 512 + ch]; }
    for (int i = 0; i < 256; ++i) g += bf2f(li[192 + i]) * c.g2[i * 512 + ch];
    c.gg[t * 512 + ch] = f2bf(g);
    const float k = bf2f(c.ks[t * 512 + ch]), ka = c.k_a[ch];
    c.kk[t * 512 + ch] = f2bf(k * c.k_k[ch]);
    {   const float dec = -0.6065306597126334f * sigmoidf_(c.w0[ch] + wl); const float a = sigmoidf_(c.a0[ch] + al);
        c.wf[t * 512 + ch] = dec; c.kdf[t * 512 + ch] = f2bf(k * (1.f + (a - 1.f) * ka)); c.akf[t * 512 + ch] = f2bf(a); }
    {   const float dec = -0.6065306597126334f * sigmoidf_(c.w0[512 + ch] + wl); const float a = sigmoidf_(c.a0[512 + ch] + al);
        c.wb[t * 512 + ch] = dec; c.kdb[t * 512 + ch] = f2bf(k * (1.f + (a - 1.f) * ka)); c.akb[t * 512 + ch] = f2bf(a); }
}
HD void el_rwkv_kk(const Ctx& c, long idx) {
    const int h = (int)(idx & 7); const long t = idx >> 3; const size_t o = (size_t)t * 512 + h * 64;
    float ss = 0.f;
    for (int d = 0; d < 64; ++d) { const float v = bf2f(c.kk[o + d]); ss += v * v; }
    const float n = 1.f / sqrtf(ss + 1e-12f);
    for (int d = 0; d < 64; ++d) { const float v = bf2f(c.kk[o + d]) * n; c.kk[o + d] = f2bf(v);
        c.akf[o + d] = f2bf(bf2f(c.akf[o + d]) * v); c.akb[o + d] = f2bf(bf2f(c.akb[o + d]) * v); }
}
HD void el_sgu_prep(const Ctx& c, long t) {
    bf16* v = c.proj + (size_t)t * NPROJ + OFF_C + 512;
    float s = 0.f;
    for (int j = 0; j < 512; ++j) s += geluf_(bf2f(v[j]));
    const float mean = s * (1.f / 512.f); float q = 0.f;
    for (int j = 0; j < 512; ++j) { const float d = geluf_(bf2f(v[j])) - mean; q += d * d; }
    const float rstd = 1.f / sqrtf(q * (1.f / 512.f) + NORM_EPS);
    for (int j = 0; j < 512; ++j) v[j] = f2bf((geluf_(bf2f(v[j])) - mean) * rstd * c.sgu_g[j] + c.sgu_b[j]);
}

HD void el_ret_kv(const Ctx& c, long idx) {
    const int e = (int)(idx & 63), d = (int)((idx >> 6) & 63); long r = idx >> 12;
    const int ch = (int)(r % NC); r /= NC; const int dir = (int)(r & 1); r >>= 1; const int h = (int)(r & 7); const int b = (int)(r >> 3);
    const float lg = logsigmoidf_(c.gam[dir * 8 + h]);
    const bf16* base = c.proj + ((size_t)b * SEQ + (size_t)ch * 128) * NPROJ + OFF_A + h * 64;
    float kv = 0.f;
    for (int m = 0; m < 128; ++m) { const float dec = expf(lg * (float)(dir == 0 ? 127 - m : m));
        kv += dec * bf2f(base[(size_t)m * NPROJ + 512 + d]) * bf2f(base[(size_t)m * NPROJ + 1024 + e]); }
    c.rkv[idx] = kv;
}
HD void el_dil_attn(const Ctx& c, long idx) {
    const int h = (int)(idx & 7); const long t = idx >> 3; const int s = (int)(t % SEQ); const long tb = t - s;
    const bf16* qp = c.proj + (size_t)t * NPROJ + OFF_D + h * 64;
    float o[64];
#pragma unroll
    for (int i = 0; i < 64; ++i) o[i] = 0.f;
    float m = -1e30f, l = 0.f;
    for (int br = 0; br < 3; ++br) {
        const int dil = br == 0 ? 1 : (br == 1 ? 4 : 16);
        for (int j = -64; j <= 64; ++j) {
            const int sp = s + dil * j; if (sp < 0 || sp >= SEQ) continue;
            asm volatile("" ::: "memory");
            const bf16* kp = c.proj + (size_t)(tb + sp) * NPROJ + OFF_D + 512 + h * 64; const bf16* vp = kp + 512;
            float sc = 0.f;
#pragma unroll
            for (int i = 0; i < 64; ++i) sc += bf2f(qp[i]) * bf2f(kp[i]);
            const float mn = sc > m ? sc : m, scale = expf(m - mn), p = expf(sc - mn);
            l = l * scale + p; m = mn;
#pragma unroll
            for (int i = 0; i < 64; ++i) o[i] = o[i] * scale + p * bf2f(vp[i]);
        }
    }
    const float il = 1.f / l; bf16* y = c.ycat + (size_t)t * 2048 + 1536 + h * 64;
#pragma unroll
    for (int i = 0; i < 64; ++i) y[i] = f2bf(o[i] * il);
}
HD void el_dil_combine(const bf16* dpo, const float* dml, bf16* ycat, long idx) {
    const int h = (int)(idx & 7); const long t = idx >> 3;
    float m[3], l[3];
#pragma unroll
    for (int br = 0; br < 3; ++br) { const float* mp = dml + (((size_t)br * T + t) * 8 + h) * 2; m[br] = mp[0]; l[br] = mp[1]; }
    const float M = fmaxf(m[0], fmaxf(m[1], m[2]));
    float wgt[3], den = 0.f;
#pragma unroll
    for (int br = 0; br < 3; ++br) { wgt[br] = expf(m[br] - M) * l[br]; den += wgt[br]; }
    const float inv = 1.f / den;
    bf16* y = ycat + (size_t)t * 2048 + 1536 + h * 64;
    for (int i = 0; i < 64; ++i) { float a = 0.f;
#pragma unroll
        for (int br = 0; br < 3; ++br) a += wgt[br] * bf2f(dpo[((size_t)br * T + t) * 512 + h * 64 + i]);
        y[i] = f2bf(a * inv); }
}
HD void el_sgu_main(const Ctx& c, long idx) {
    const int j = (int)(idx & 511); const long t = idx >> 9; const int s = (int)(t % SEQ), p = s & 127, g = j >> 6; const long t0 = t - p;
    const float* w = c.sgu_w + ((size_t)g * 128 + p) * 128;
    const bf16* v = c.proj + (size_t)t0 * NPROJ + OFF_C + 512 + j;
    float acc = 0.f;
    for (int q = 0; q < 128; ++q) acc += w[q] * bf2f(v[(size_t)q * NPROJ]);
    const float u = geluf_(bf2f(c.proj[(size_t)t * NPROJ + OFF_C + j]));
    c.ycat[(size_t)t * 2048 + 1024 + j] = f2bf(u * (acc + c.sgu_bias[g * 128 + p]));
}
HD void el_ret_scan(const Ctx& c, long idx) {
    const int de = (int)(idx & 4095); const long r = idx >> 12; const int dir = (int)(r & 1), h = (int)((r >> 1) & 7);
    const float cd = expf(128.f * logsigmoidf_(c.gam[dir * 8 + h]));
    float kv[NC];
#pragma unroll
    for (int k = 0; k < NC; ++k) { const int ch = dir == 0 ? k : NC - 1 - k; kv[k] = c.rkv[((size_t)r * NC + ch) * 4096 + de]; }
    float S = 0.f;
#pragma unroll
    for (int k = 0; k < NC; ++k) { const int ch = dir == 0 ? k : NC - 1 - k; c.rsp[((size_t)r * NC + ch) * 4096 + de] = S; S = S * cd + kv[k]; }
}
HD void el_rwkv_scan(const Ctx& c, long idx) {
    const int row = (int)(idx & 63); const long r = idx >> 6; const int dir = (int)(r & 1), h = (int)((r >> 1) & 7), b = (int)(r >> 4);
    const float* W = dir ? c.wb : c.wf; const bf16* KD = dir ? c.kdb : c.kdf; const bf16* AK = dir ? c.akb : c.akf; bf16* Y = dir ? c.yb : c.yf;
    float S[64];
#pragma unroll
    for (int i = 0; i < 64; ++i) S[i] = 0.f;
    for (int k = 0; k < SEQ; ++k) {
        asm volatile("" ::: "memory");
        const int s = dir ? SEQ - 1 - k : k; const size_t o = ((size_t)b * SEQ + s) * 512 + h * 64;
        float sk = 0.f;
#pragma unroll
        for (int q = 0; q < 4; ++q) { asm volatile("" ::: "memory");
#pragma unroll
            for (int i = 16 * q; i < 16 * q + 16; ++i) sk += S[i] * bf2f(c.kk[o + i]); }
        const float v = bf2f(c.vs[o + row]); float y = 0.f;
#pragma unroll
        for (int q = 0; q < 4; ++q) { asm volatile("" ::: "memory");
#pragma unroll
            for (int i = 16 * q; i < 16 * q + 16; ++i) { S[i] = S[i] * expf(W[o + i]) - sk * bf2f(AK[o + i]) + v * bf2f(KD[o + i]); y += S[i] * bf2f(c.rs[o + i]); } }
        Y[o + row] = f2bf(y);
    }
}
HD void el_ret_out(const Ctx& c, long idx) {
    const int h = (int)(idx & 7); const long t = idx >> 3; const int s = (int)(t % SEQ), n = s & 127, ch = s >> 7; const int b = (int)(t / SEQ);
    const float lgf = logsigmoidf_(c.gam[h]), lgb = logsigmoidf_(c.gam[8 + h]);
    const bf16* qp = c.proj + (size_t)t * NPROJ + OFF_A + h * 64;
    float o[64];
#pragma unroll
    for (int i = 0; i < 64; ++i) o[i] = 0.f;
    const bf16* kb = c.proj + (size_t)(t - n) * NPROJ + OFF_A + 512 + h * 64;
    for (int m = 0; m < 128; ++m) {
        asm volatile("" ::: "memory");
        const bf16* kp = kb + (size_t)m * NPROJ; const bf16* vp = kp + 512;
        float sc = 0.f;
#pragma unroll
        for (int i = 0; i < 64; ++i) sc += bf2f(qp[i]) * bf2f(kp[i]);
        sc *= m <= n ? expf(lgf * (float)(n - m)) : expf(lgb * (float)(m - n));
#pragma unroll
        for (int i = 0; i < 64; ++i) o[i] += sc * bf2f(vp[i]);
    }
    const float qdf = expf(lgf * (float)(n + 1)), qdb = expf(lgb * (float)(128 - n));
    const float* Sf = c.rsp + ((size_t)((b * 8 + h) * 2 + 0) * NC + ch) * 4096; const float* Sb = c.rsp + ((size_t)((b * 8 + h) * 2 + 1) * NC + ch) * 4096;
    for (int d = 0; d < 64; ++d) { asm volatile("" ::: "memory"); const float qd = bf2f(qp[d]); const float a = qd * qdf, bb = qd * qdb;
#pragma unroll
        for (int i = 0; i < 64; ++i) o[i] += a * Sf[d * 64 + i] + bb * Sb[d * 64 + i]; }
    float mu = 0.f;
#pragma unroll
    for (int i = 0; i < 64; ++i) mu += o[i];
    mu *= (1.f / 64.f); float var = 0.f;
#pragma unroll
    for (int i = 0; i < 64; ++i) { const float d = o[i] - mu; var += d * d; }
    const float rstd = 1.f / sqrtf(var * (1.f / 64.f) + GN_EPS);
    const bf16* gp = c.proj + (size_t)t * NPROJ + OFF_A + 1536 + h * 64; bf16* y = c.ycat + (size_t)t * 2048 + h * 64;
    for (int i = 0; i < 64; i += 8) { asm volatile("" ::: "memory");
#pragma unroll
        for (int j = 0; j < 8; ++j) y[i + j] = f2bf(siluf_(bf2f(gp[i + j])) * ((o[i + j] - mu) * rstd * c.ret_g[h * 64 + i + j])); }
}
HD void el_rwkv_fin(const Ctx& c, long idx) {
    const int h = (int)(idx & 7); const long t = idx >> 3; const size_t o = (size_t)t * 512 + h * 64;
    float mu = 0.f, bonus = 0.f;
    for (int i = 0; i < 64; ++i) { mu += bf2f(c.yf[o + i]) + bf2f(c.yb[o + i]); bonus += bf2f(c.rs[o + i]) * bf2f(c.ks[o + i]) * c.r_k[h * 64 + i]; }
    mu *= (1.f / 64.f); float var = 0.f;
    for (int i = 0; i < 64; ++i) { const float d = bf2f(c.yf[o + i]) + bf2f(c.yb[o + i]) - mu; var += d * d; }
    const float rstd = 1.f / sqrtf(var * (1.f / 64.f) + GN_EPS);
    bf16* out = c.ycat + (size_t)t * 2048 + 512 + h * 64;
    for (int i = 0; i < 64; ++i) { const float y = bf2f(c.yf[o + i]) + bf2f(c.yb[o + i]);
        out[i] = f2bf(((y - mu) * rstd * c.ln_g[h * 64 + i] + bonus * bf2f(c.vs[o + i])) * bf2f(c.gg[o + i])); }
}
HD void route_select(const float (&lg)[4], const float (&le)[32], const float* bg, const float* be, int& e1, int& e2, float& g1, float& g2) {
    float l[4]; float mx = -1e30f; int gi = 0;
#pragma unroll
    for (int i = 0; i < 4; ++i) { l[i] = lg[i] + bg[i]; if (l[i] > mx) { mx = l[i]; gi = i; } }
    float den = 0.f;
#pragma unroll
    for (int i = 0; i < 4; ++i) den += expf(l[i] - mx);
    const float gtop = 1.f / den;
    float el[8];
#pragma unroll
    for (int i = 0; i < 8; ++i) { float v = 0.f;
#pragma unroll
        for (int g = 0; g < 4; ++g) v = (g == gi) ? le[g * 8 + i] + be[g * 8 + i] : v;
        el[i] = v; }
    float m1 = -1e30f, m2 = -1e30f; int i1 = 0, i2 = 0;
#pragma unroll
    for (int i = 0; i < 8; ++i) { if (el[i] > m1) { m2 = m1; i2 = i1; m1 = el[i]; i1 = i; } else if (el[i] > m2) { m2 = el[i]; i2 = i; } }
    const float p2 = expf(m2 - m1);
    g1 = gtop / (1.f + p2); g2 = gtop * p2 / (1.f + p2); e1 = gi * 8 + i1; e2 = gi * 8 + i2;
}

#ifndef KB_HOST_ONLY
namespace pg8 {
#define PG8_LAS __attribute__((address_space(3)))
typedef unsigned short bf16_t;
typedef short bf16x8 __attribute__((ext_vector_type(8)));
typedef float f32x4 __attribute__((ext_vector_type(4)));
typedef unsigned u32x4 __attribute__((ext_vector_type(4)));
constexpr int BM = 256, BK = 64, HALF = 128, HTB = HALF * BK * 2, STAGE_BYTES = 8 * HTB, NXCD = 8, WGM = 8;
__host__ __device__ __forceinline__ int lds_byte(int r, int c) { const int st = (r >> 4) * 2 + (c >> 5), rr = r & 15, cc = c & 31, ob = rr * 64 + cc * 2; return st * 1024 + (ob ^ (((ob >> 9) & 1) << 5)); }
__host__ __device__ __forceinline__ void stage_rc(int b, int& R, int& C) { const int st = b / 1024, sb = b % 1024, swz = sb ^ (((sb >> 9) & 1) << 5); R = (st >> 1) * 16 + swz / 64; C = (st & 1) * 32 + (swz % 64) / 2; }
__host__ __device__ __forceinline__ int perm32(int rho) { const int n = rho >> 4, i = rho & 15; return 8 * (i >> 2) + 4 * n + (i & 3); }
struct Unit { int pm, pn, pe; };
struct Gemm { const bf16_t* A; const bf16_t* Bt; int M, N, K; size_t bstride; int bmap; };
template <int M, int N> struct StaticOrder {
    static constexpr int nM = M / BM, nN = N / BM, nwg = nM * nN;
    int G, c;
    __host__ __device__ void init(int G_, int c_) { G = G_; c = c_; }
    __host__ __device__ __forceinline__ bool next(int i, Unit& u) const {
        const int L = i * G + c; if (L >= nwg) return false;
        int wgid = L; { constexpr int q = nwg / NXCD, r = nwg % NXCD; const int xcd = wgid % NXCD, off = wgid / NXCD; wgid = (xcd < r ? xcd * (q + 1) : r * (q + 1) + (xcd - r) * q) + off; }
        constexpr int nig = WGM * nN; const int gid = wgid / nig, fm = gid * WGM, gsz = (nM - fm) < WGM ? (nM - fm) : WGM;
        u.pm = fm + ((wgid % nig) % gsz); u.pn = (wgid % nig) / gsz; u.pe = 0; return true;
    }
    __device__ __forceinline__ void a_ready(const Unit&) const {}
    __device__ __forceinline__ void done(const Unit&) const {}
};
template <int NN> struct MoeOrder {
    int G, c, ntiles; const PG8_LAS int* tile_exp;
    __device__ __forceinline__ bool next(int i, Unit& u) const {
        const int L = i * G + c; if (L >= ntiles * NN) return false;
        u.pm = L / NN; u.pn = L % NN; u.pe = __builtin_amdgcn_readfirstlane(tile_exp[u.pm]); return true;
    }
    __device__ __forceinline__ void a_ready(const Unit&) const {}
    __device__ __forceinline__ void done(const Unit&) const {}
};
__device__ __forceinline__ unsigned cvt_pk_bf16(float lo, float hi) { unsigned r; asm volatile("v_cvt_pk_bf16_f32 %0, %1, %2" : "=v"(r) : "v"(lo), "v"(hi)); return r; }
struct EpiBf16 {
    static constexpr bool PERM = true, AFTER_DRAIN = false;
    bf16_t* O; int ldc;
    __device__ __forceinline__ void operator()(const f32x4 (&acc)[2][2][4][2], const Unit& u, int wr, int wc, int fr, int fq) const {
        const int row0 = u.pm * BM + wr * 64 + fr, col0 = u.pn * BM + wc * 32 + 8 * fq;
#pragma unroll
        for (int ai = 0; ai < 2; ++ai)
#pragma unroll
            for (int m = 0; m < 4; ++m) { bf16_t* rowp = O + (size_t)(row0 + ai * HALF + m * 16) * ldc + col0;
#pragma unroll
                for (int bj = 0; bj < 2; ++bj) { const f32x4 v0 = acc[ai][bj][m][0], v1 = acc[ai][bj][m][1];
                    u32x4 w; w.x = cvt_pk_bf16(v0[0], v0[1]); w.y = cvt_pk_bf16(v0[2], v0[3]); w.z = cvt_pk_bf16(v1[0], v1[1]); w.w = cvt_pk_bf16(v1[2], v1[3]);
                    *(u32x4*)(rowp + bj * HALF) = w; } }
    }
};
struct EpiBf16Rot {
    static constexpr bool PERM = true, AFTER_DRAIN = false;
    bf16_t* O; int ldc; const float* rot;
    __device__ __forceinline__ void operator()(const f32x4 (&acc)[2][2][4][2], const Unit& u, int wr, int wc, int fr, int fq) const {
        const int row0 = u.pm * BM + wr * 64 + fr, col0 = u.pn * BM + wc * 32 + 8 * fq;
        const bool retT = u.pn < (OFF_A + 1024) / BM, dilT = u.pn >= OFF_D / BM && u.pn < (OFF_D + 1024) / BM;
        const int p = col0 & 63; const bool on = retT || (dilT && p < 16); const int f0 = (retT ? 0 : 32) + (p >> 1);
#pragma unroll
        for (int ai = 0; ai < 2; ++ai)
#pragma unroll
            for (int m = 0; m < 4; ++m) { const int row = row0 + ai * HALF + m * 16; bf16_t* rowp = O + (size_t)row * ldc + col0;
                f32x4 c0 = (f32x4){1.f, 0.f, 1.f, 0.f}, c1 = c0;
                if (on) { const float* rp = rot + ((size_t)row * 40 + f0) * 2; c0 = *(const f32x4*)rp; c1 = *(const f32x4*)(rp + 4); }
#pragma unroll
                for (int bj = 0; bj < 2; ++bj) { const f32x4 v0 = acc[ai][bj][m][0], v1 = acc[ai][bj][m][1];
                    u32x4 w; w.x = cvt_pk_bf16(v0[0] * c0[0] - v0[1] * c0[1], v0[1] * c0[0] + v0[0] * c0[1]); w.y = cvt_pk_bf16(v0[2] * c0[2] - v0[3] * c0[3], v0[3] * c0[2] + v0[2] * c0[3]);
                    w.z = cvt_pk_bf16(v1[0] * c1[0] - v1[1] * c1[1], v1[1] * c1[0] + v1[0] * c1[1]); w.w = cvt_pk_bf16(v1[2] * c1[2] - v1[3] * c1[3], v1[3] * c1[2] + v1[2] * c1[3]);
                    *(u32x4*)(rowp + bj * HALF) = w; } }
    }
};
struct EpiResB {
    static constexpr bool PERM = true, AFTER_DRAIN = false;
    const float* base32; const bf16_t* base16; bf16_t* out; int ldc;
    __device__ __forceinline__ void operator()(const f32x4 (&acc)[2][2][4][2], const Unit& u, int wr, int wc, int fr, int fq) const {
        const int row0 = u.pm * BM + wr * 64 + fr, col0 = u.pn * BM + wc * 32 + 8 * fq;
#pragma unroll
        for (int ai = 0; ai < 2; ++ai)
#pragma unroll
            for (int m = 0; m < 4; ++m) { const size_t off = (size_t)(row0 + ai * HALF + m * 16) * ldc + col0;
#pragma unroll
                for (int bj = 0; bj < 2; ++bj) { f32x4 v0 = acc[ai][bj][m][0], v1 = acc[ai][bj][m][1];
                    if (base32) { v0 += *(const f32x4*)(base32 + off + bj * HALF); v1 += *(const f32x4*)(base32 + off + bj * HALF + 4); }
                    else { const u32x4 b = *(const u32x4*)(base16 + off + bj * HALF);
                        v0[0] += __builtin_bit_cast(float, b.x << 16); v0[1] += __builtin_bit_cast(float, b.x & 0xffff0000u); v0[2] += __builtin_bit_cast(float, b.y << 16); v0[3] += __builtin_bit_cast(float, b.y & 0xffff0000u);
                        v1[0] += __builtin_bit_cast(float, b.z << 16); v1[1] += __builtin_bit_cast(float, b.z & 0xffff0000u); v1[2] += __builtin_bit_cast(float, b.w << 16); v1[3] += __builtin_bit_cast(float, b.w & 0xffff0000u); }
                    u32x4 w; w.x = cvt_pk_bf16(v0[0], v0[1]); w.y = cvt_pk_bf16(v0[2], v0[3]); w.z = cvt_pk_bf16(v1[0], v1[1]); w.w = cvt_pk_bf16(v1[2], v1[3]);
                    *(u32x4*)(out + off + bj * HALF) = w; } }
    }
};
struct EpiSwiGLU {
    static constexpr bool PERM = true, AFTER_DRAIN = false;
    bf16_t* O; int ldc;
    __device__ __forceinline__ void operator()(const f32x4 (&acc)[2][2][4][2], const Unit& u, int wr, int wc, int fr, int fq) const {
        const int row0 = u.pm * BM + wr * 64 + fr, col0 = u.pn * HALF + wc * 32 + 8 * fq;
#pragma unroll
        for (int ai = 0; ai < 2; ++ai)
#pragma unroll
            for (int m = 0; m < 4; ++m) { bf16_t* rowp = O + (size_t)(row0 + ai * HALF + m * 16) * ldc + col0;
                float h[8];
#pragma unroll
                for (int n = 0; n < 2; ++n)
#pragma unroll
                    for (int j = 0; j < 4; ++j) { const float g = acc[ai][0][m][n][j], up = acc[ai][1][m][n][j]; h[n * 4 + j] = g * __builtin_amdgcn_rcpf(1.f + __expf(-g)) * up; }
                u32x4 w; w.x = cvt_pk_bf16(h[0], h[1]); w.y = cvt_pk_bf16(h[2], h[3]); w.z = cvt_pk_bf16(h[4], h[5]); w.w = cvt_pk_bf16(h[6], h[7]);
                *(u32x4*)rowp = w; }
    }
};

template <int KK, class Epi, class Sched, bool ALIGN_EPI = false, bool SP2 = false>
__device__ __forceinline__ void gemm_phase(PG8_LAS unsigned char* lds, const Gemm g, const Sched& S, const Epi& E, const int tid) {
    const int wid = __builtin_amdgcn_readfirstlane(tid >> 6), lane = tid & 63, wr = wid >> 2, wc = wid & 3, fr = lane & 15, fq = lane >> 4;
    constexpr int K = KK, nt = K / BK;
    unsigned voffA[2], voffB[2];
#pragma unroll
    for (int i = 0; i < 2; ++i) { int R, C; stage_rc(tid * 16 + i * 8192, R, C); const int Rb = Epi::PERM ? ((R & ~31) + perm32(R & 31)) : R;
        voffA[i] = (unsigned)(R * K + C) * 2u; voffB[i] = (unsigned)(Rb * K + C) * 2u; }
    constexpr size_t kstep = (size_t)(BK * 2);
    constexpr size_t hstep = (size_t)HALF * K * 2;
    constexpr size_t tstep = 2 * hstep;
    const unsigned ldsw = (unsigned)wid * 1024u;
    const int aoff = lds_byte(wr * 64 + fr, fq * 8), boff = lds_byte(wc * 32 + fr, fq * 8);
#define PG8_SA(b, h) (((b) * 2 + (h)) * HTB)
#define PG8_SB(b, h) ((4 + (b) * 2 + (h)) * HTB)
#define PG8_STAGE(bufoff, gbase, voff) do { _Pragma("unroll") for (int _i = 0; _i < 2; ++_i) \
        __builtin_amdgcn_global_load_lds((const unsigned*)((const char*)(gbase) + (voff)[_i]), (PG8_LAS unsigned*)(lds + (bufoff) + ldsw + _i * 8192), 16, 0, 0); } while (0)
#define PG8_LDA(dst, b, h) do { _Pragma("unroll") for (int m = 0; m < 4; ++m) _Pragma("unroll") for (int k = 0; k < 2; ++k) dst[m][k] = *(const PG8_LAS bf16x8*)(lds + PG8_SA(b, h) + aoff + m * 2048 + k * 1024); } while (0)
#define PG8_LDB(dst, b, h) do { _Pragma("unroll") for (int n = 0; n < 2; ++n) _Pragma("unroll") for (int k = 0; k < 2; ++k) dst[n][k] = *(const PG8_LAS bf16x8*)(lds + PG8_SB(b, h) + boff + n * 2048 + k * 1024); } while (0)
#define PG8_MMA(ai, bj, At, Bt) do { __builtin_amdgcn_s_setprio(1); _Pragma("unroll") for (int m = 0; m < 4; ++m) _Pragma("unroll") for (int n = 0; n < 2; ++n) _Pragma("unroll") for (int k = 0; k < 2; ++k) \
        acc[ai][bj][m][n] = __builtin_amdgcn_mfma_f32_16x16x32_bf16(Bt[n][k], At[m][k], acc[ai][bj][m][n], 0, 0, 0); __builtin_amdgcn_s_setprio(0); } while (0)
#define PG8_WAIT_V(n) asm volatile("s_waitcnt vmcnt(" #n ")" ::: "memory")
#define PG8_WAIT_L(n) asm volatile("s_waitcnt lgkmcnt(" #n ")" ::: "memory")
#define PG8_BAR __builtin_amdgcn_s_barrier()
#define PG8_SCHED __builtin_amdgcn_sched_barrier(0)
    Unit cur, nxt; int ui = 0;
    if (!S.next(0, cur)) return;
    f32x4 acc[2][2][4][2];
#pragma unroll
    for (int a = 0; a < 2; ++a)
#pragma unroll
        for (int b = 0; b < 2; ++b)
#pragma unroll
            for (int m = 0; m < 4; ++m)
#pragma unroll
                for (int n = 0; n < 2; ++n) acc[a][b][m][n] = (f32x4){0.f, 0.f, 0.f, 0.f};
    bf16x8 At[4][2], B0[2][2], B1[2][2];
    const char* cA = (const char*)g.A + (size_t)cur.pm * tstep; const char* cB = (const char*)g.Bt + (g.bmap ? wgu_off(cur.pe) : (size_t)cur.pe * g.bstride) + (size_t)cur.pn * tstep;
    S.a_ready(cur);
    if constexpr (SP2) {
        PG8_STAGE(PG8_SB(0, 0), cB, voffB); PG8_STAGE(PG8_SB(0, 1), cB + hstep, voffB); PG8_STAGE(PG8_SA(0, 0), cA, voffA); PG8_STAGE(PG8_SA(0, 1), cA + hstep, voffA);
        if (wr == 1) PG8_BAR;
        PG8_WAIT_V(2); PG8_BAR;
        PG8_STAGE(PG8_SB(1, 0), cB + kstep, voffB); PG8_STAGE(PG8_SA(1, 0), cA + kstep, voffA); PG8_STAGE(PG8_SB(1, 1), cB + hstep + kstep, voffB);
        PG8_WAIT_V(6); PG8_BAR;
    } else {
        PG8_STAGE(PG8_SB(0, 0), cB, voffB); PG8_STAGE(PG8_SA(0, 0), cA, voffA); PG8_STAGE(PG8_SB(0, 1), cB + hstep, voffB); PG8_STAGE(PG8_SA(0, 1), cA + hstep, voffA);
        if (wr == 1) PG8_BAR;
        PG8_WAIT_V(4); PG8_BAR;
        PG8_STAGE(PG8_SB(1, 0), cB + kstep, voffB); PG8_STAGE(PG8_SA(1, 0), cA + kstep, voffA); PG8_STAGE(PG8_SB(1, 1), cB + hstep + kstep, voffB);
        PG8_WAIT_V(6); PG8_BAR;
    }
    for (;;) {
        const bool has_next = S.next(ui + 1, nxt);
        const char* nA = has_next ? (const char*)g.A + (size_t)nxt.pm * tstep : cA; const char* nB = has_next ? (const char*)g.Bt + (g.bmap ? wgu_off(nxt.pe) : (size_t)nxt.pe * g.bstride) + (size_t)nxt.pn * tstep : cB;
        for (int t = 0; t < nt; t += 2) {
            const bool last = (t == nt - 2);
            const char* a1 = cA + (size_t)(t + 1) * kstep;
            const char* a2 = last ? nA : cA + (size_t)(t + 2) * kstep; const char* b2 = last ? nB : cB + (size_t)(t + 2) * kstep;
            const char* a3 = a2 + kstep; const char* b3 = b2 + kstep;
            if (last && has_next) S.a_ready(nxt);
            if constexpr (SP2) {
            PG8_LDB(B0, 0, 0); PG8_LDB(B1, 0, 1); PG8_SCHED; PG8_LDA(At, 0, 0); PG8_STAGE(PG8_SA(1, 1), a1 + hstep, voffA);
            PG8_WAIT_V(8); PG8_WAIT_L(0); PG8_BAR; PG8_MMA(0, 0, At, B0); PG8_MMA(0, 1, At, B1); PG8_BAR; PG8_SCHED;
            PG8_LDA(At, 0, 1); PG8_STAGE(PG8_SB(0, 0), b2, voffB); PG8_STAGE(PG8_SB(0, 1), b2 + hstep, voffB); PG8_STAGE(PG8_SA(0, 0), a2, voffA);
            PG8_WAIT_V(8); PG8_WAIT_L(0); PG8_BAR; PG8_MMA(1, 0, At, B0); PG8_MMA(1, 1, At, B1); PG8_BAR; PG8_SCHED;
            PG8_LDB(B0, 1, 0); PG8_LDB(B1, 1, 1); PG8_SCHED; PG8_LDA(At, 1, 0); PG8_STAGE(PG8_SA(0, 1), a2 + hstep, voffA);
            PG8_WAIT_V(8); PG8_WAIT_L(0); PG8_BAR; PG8_MMA(0, 0, At, B0); PG8_MMA(0, 1, At, B1); PG8_BAR; PG8_SCHED;
            PG8_LDA(At, 1, 1); PG8_STAGE(PG8_SB(1, 0), b3, voffB); PG8_STAGE(PG8_SB(1, 1), b3 + hstep, voffB); PG8_STAGE(PG8_SA(1, 0), a3, voffA);
            PG8_WAIT_V(8); PG8_WAIT_L(0); PG8_BAR; PG8_MMA(1, 0, At, B0); PG8_MMA(1, 1, At, B1); PG8_BAR; PG8_SCHED;
            } else {
            PG8_LDB(B0, 0, 0); PG8_SCHED; PG8_LDA(At, 0, 0); PG8_STAGE(PG8_SA(1, 1), a1 + hstep, voffA);
            PG8_WAIT_L(8); PG8_BAR; PG8_WAIT_L(0); PG8_MMA(0, 0, At, B0); PG8_BAR; PG8_SCHED;
            PG8_LDB(B1, 0, 1); PG8_STAGE(PG8_SB(0, 0), b2, voffB);
            PG8_BAR; PG8_WAIT_L(0); PG8_MMA(0, 1, At, B1); PG8_BAR;
            PG8_LDA(At, 0, 1); PG8_STAGE(PG8_SA(0, 0), a2, voffA);
            PG8_BAR; PG8_WAIT_L(0); PG8_MMA(1, 0, At, B0); PG8_BAR; PG8_SCHED;
            PG8_STAGE(PG8_SB(0, 1), b2 + hstep, voffB);
            PG8_WAIT_V(6); PG8_BAR; PG8_MMA(1, 1, At, B1); PG8_BAR;
            PG8_LDB(B0, 1, 0); PG8_SCHED; PG8_LDA(At, 1, 0); PG8_STAGE(PG8_SA(0, 1), a2 + hstep, voffA);
            PG8_WAIT_L(8); PG8_BAR; PG8_WAIT_L(0); PG8_MMA(0, 0, At, B0); PG8_BAR; PG8_SCHED;
            PG8_LDB(B1, 1, 1); PG8_STAGE(PG8_SB(1, 0), b3, voffB);
            PG8_BAR; PG8_WAIT_L(0); PG8_MMA(0, 1, At, B1); PG8_BAR;
            PG8_LDA(At, 1, 1); PG8_STAGE(PG8_SA(1, 0), a3, voffA);
            PG8_BAR; PG8_WAIT_L(0); PG8_MMA(1, 0, At, B0); PG8_BAR; PG8_SCHED;
            PG8_STAGE(PG8_SB(1, 1), b3 + hstep, voffB);
            PG8_WAIT_V(6); PG8_BAR; PG8_MMA(1, 1, At, B1); PG8_BAR;
            }
        }
        if constexpr (ALIGN_EPI) { if (wr == 0) PG8_BAR; }
        E(acc, cur, wr, wc, fr, fq); S.done(cur);
        if (!has_next) break;
#pragma unroll
        for (int a = 0; a < 2; ++a)
#pragma unroll
            for (int b = 0; b < 2; ++b)
#pragma unroll
                for (int m = 0; m < 4; ++m)
#pragma unroll
                    for (int n = 0; n < 2; ++n) acc[a][b][m][n] = (f32x4){0.f, 0.f, 0.f, 0.f};
        cur = nxt; cA = nA; cB = nB; ++ui;
        if constexpr (ALIGN_EPI) { if (wr == 1) PG8_BAR; }
    }
    PG8_WAIT_V(0);
    if constexpr (!ALIGN_EPI) { if (wr == 0) PG8_BAR; }
    PG8_BAR;
#undef PG8_SA
#undef PG8_SB
#undef PG8_STAGE
#undef PG8_LDA
#undef PG8_LDB
#undef PG8_MMA
#undef PG8_WAIT_V
#undef PG8_WAIT_L
#undef PG8_BAR
#undef PG8_SCHED
}
}

#define GAS __attribute__((address_space(1)))
#define LAS __attribute__((address_space(3)))
typedef unsigned v4u __attribute__((ext_vector_type(4)));
typedef unsigned v2u __attribute__((ext_vector_type(2)));
typedef float f32x4 __attribute__((ext_vector_type(4)));
#define LDS_WAIT() asm volatile("s_waitcnt lgkmcnt(0)" ::: "memory")
__device__ __forceinline__ unsigned pk2(float lo, float hi) { return (unsigned)f2bf(lo) | ((unsigned)f2bf(hi) << 16); }

#define XB_TMO      128
#define XB_XCNT(j)  (256  + 64 * (j))
#define XB_XSUB(j)  (1280 + 64 * (j))
#define XB_XGEN(j)  (2304 + 64 * (j))
#define XB_TOP      3328
#define XB_TOPGEN   3392
#define XCD_BAR_WORDS 3456
#define XB_SPIN_CAP (1u << 18)
__device__ __forceinline__ unsigned xb_ld(unsigned* p)              { return __hip_atomic_load(p, __ATOMIC_RELAXED, __HIP_MEMORY_SCOPE_AGENT); }
__device__ __forceinline__ unsigned xb_add(unsigned* p, unsigned v) { return __hip_atomic_fetch_add(p, v, __ATOMIC_RELAXED, __HIP_MEMORY_SCOPE_AGENT); }
__device__ __forceinline__ unsigned xb_xcc_id() { return (unsigned)__builtin_amdgcn_s_getreg((3 << 11) | 20) & 0xFu; }
#define XB_SPIN(cond, bar) do { unsigned _sp = 0; while (cond) { __builtin_amdgcn_s_sleep(1); \
    if ((++_sp & 255u) == 0u) { if (xb_ld(&(bar)[XB_TMO])) break; if (_sp > XB_SPIN_CAP) { atomicAdd(&(bar)[XB_TMO], 1u); break; } } } } while (0)
struct XcdBarrier { unsigned* bar; unsigned x; volatile LAS unsigned* st; };
__device__ __forceinline__ XcdBarrier xcd_barrier_post(unsigned* bar, volatile LAS unsigned* st) {
    XcdBarrier b; b.bar = bar; b.x = xb_xcc_id(); b.st = st;
    if (threadIdx.x == 0) (void)xb_add(&bar[XB_XCNT(b.x)], 1u);
    return b;
}
__device__ __forceinline__ void xcd_barrier_complete(unsigned* bar, unsigned x, unsigned& nloc, unsigned& nx) {
    const unsigned G = gridDim.x * gridDim.y * gridDim.z;
    unsigned sum, cnt, mine, sp = 0u;
    for (;;) {
        sum = 0u; cnt = 0u; mine = 0u;
#pragma unroll
        for (unsigned j = 0; j < 16; ++j) { const unsigned c = xb_ld(&bar[XB_XCNT(j)]); sum += c; cnt += (c > 0u) ? 1u : 0u; mine = (j == x) ? c : mine; }
        if (sum == G) break;
        __builtin_amdgcn_s_sleep(1);
        if ((++sp & 255u) == 0u) { if (xb_ld(&bar[XB_TMO])) break; if (sp > XB_SPIN_CAP) { atomicAdd(&bar[XB_TMO], 1u); break; } }
    }
    nloc = mine > 0u ? mine : 1u; nx = cnt > 0u ? cnt : 1u;
}
__device__ __forceinline__ void xcd_barrier(const XcdBarrier& b) {
    asm volatile("s_waitcnt vmcnt(0)" ::: "memory");
    __syncthreads();
    if (threadIdx.x == 0) {
        unsigned* bar = b.bar;
        __builtin_amdgcn_s_waitcnt(0);
        unsigned nloc = b.st[0], nx = b.st[1];
        if (nloc == 0u) { xcd_barrier_complete(bar, b.x, nloc, nx); b.st[0] = nloc; b.st[1] = nx; }
        const unsigned old = xb_add(&bar[XB_XSUB(b.x)], 1u);
        const unsigned gen = old / nloc;
        if (old + 1u == (gen + 1u) * nloc) {
            __builtin_amdgcn_fence(__ATOMIC_RELEASE, "agent");
            asm volatile("s_waitcnt vmcnt(0)" ::: "memory");
            const unsigned og = xb_add(&bar[XB_TOP], 1u);
            const unsigned tg = og / nx;
            if (og + 1u == (tg + 1u) * nx) xb_add(&bar[XB_TOPGEN], 1u);
            else XB_SPIN(xb_ld(&bar[XB_TOPGEN]) == tg, bar);
            __builtin_amdgcn_fence(__ATOMIC_ACQUIRE, "agent");
            xb_add(&bar[XB_XGEN(b.x)], 1u);
            asm volatile("s_waitcnt vmcnt(0)" ::: "memory");
        } else {
            XB_SPIN(xb_ld(&bar[XB_XGEN(b.x)]) == gen, bar);
            __builtin_amdgcn_fence(__ATOMIC_ACQUIRE, "agent");
            asm volatile("s_waitcnt vmcnt(0)" ::: "memory");
        }
    }
    __syncthreads();
}

constexpr int RING_BYTES = 131072;
constexpr int TAB_OFF = RING_BYTES;
constexpr int TAB_CNT = TAB_OFF, TAB_ROWBASE = TAB_OFF + 128, TAB_NT = TAB_OFF + 256, TAB_TEXP = TAB_OFF + 272;
constexpr int MISC_OFF = TAB_OFF + 4096;
constexpr int PTAB_OFF = MISC_OFF + 16;
constexpr int LDS_BYTES = 147456;
static_assert(TAB_TEXP + MOE_MAXTILES * 4 <= MISC_OFF && PTAB_OFF + 32 * 8 <= LDS_BYTES, "LDS map");

__device__ __forceinline__ float wave_sum(float v, int lane) {
#pragma unroll
    for (int o = 1; o < 64; o <<= 1) v += __builtin_bit_cast(float, __builtin_amdgcn_ds_bpermute((lane ^ o) << 2, __builtin_bit_cast(int, v)));
    return v;
}
__device__ __forceinline__ void transpose_item(const float* W, int K, int N, bf16* WT, int k0, int n0, int drow0, LAS float* scr, int lane, const float sc = 1.f, const int rmode = 0) {
#pragma unroll 8
    for (int i = 0; i < 32; ++i) { const int kk = 2 * i + (lane >> 5); scr[kk * 33 + (lane & 31)] = W[(size_t)(k0 + kk) * N + n0 + (lane & 31)]; }
    LDS_WAIT(); asm volatile("" ::: "memory");
    const int c = lane & 7;
#pragma unroll
    for (int j = 0; j < 4; ++j) { const int n = (lane >> 3) + 8 * j; const LAS float* s = scr + (8 * c) * 33 + n;
        v4u o; o.x = pk2(s[0 * 33] * sc, s[1 * 33] * sc); o.y = pk2(s[2 * 33] * sc, s[3 * 33] * sc); o.z = pk2(s[4 * 33] * sc, s[5 * 33] * sc); o.w = pk2(s[6 * 33] * sc, s[7 * 33] * sc);
        const int dn = rmode == 0 ? n : (rmode == 1 ? 2 * n : (n < 8 ? 2 * n : (n < 16 ? 2 * (n - 8) + 1 : n)));
        *(GAS v4u*)(WT + (size_t)(drow0 + dn) * K + k0 + 8 * c) = o; }
    LDS_WAIT(); asm volatile("" ::: "memory");
}


__device__ __forceinline__ void build_moe_tables(LAS unsigned char* lds, const unsigned* cnt_words, const int tid) {
    LAS int* tcnt = (LAS int*)(lds + TAB_CNT); LAS int* trb = (LAS int*)(lds + TAB_ROWBASE); LAS int* tnt = (LAS int*)(lds + TAB_NT); LAS int* texp = (LAS int*)(lds + TAB_TEXP);
    __syncthreads();
    if (cnt_words) { if (tid < NEXP) tcnt[tid] = (int)__hip_atomic_load(cnt_words + 64 * tid, __ATOMIC_RELAXED, __HIP_MEMORY_SCOPE_AGENT); }
    __syncthreads();
    if (tid == 0) { int tile = 0;
#pragma unroll 1
        for (int e = 0; e < NEXP; ++e) { int c = tcnt[e]; if (c > 2 * T) c = 2 * T; int nt = (c + 255) >> 8; if (tile + nt > MOE_MAXTILES) nt = MOE_MAXTILES - tile; trb[e] = tile * 256;
#pragma unroll 1
            for (int i = 0; i < nt; ++i) texp[tile + i] = e;
            tile += nt; }
        tnt[0] = tile; }
    __syncthreads();
}

__device__ __forceinline__ void transpose_item64(const float* W, int K, int N, bf16* WT, int k0, int n0, int drow0, LAS float* scr, int lane, const float sc = 1.f) {
    const int r = lane >> 4, c4 = lane & 15;
#pragma unroll 4
    for (int i = 0; i < 16; ++i) { const int k = 4 * i + r; const f32x4 v = *(const GAS f32x4*)(W + (size_t)(k0 + k) * N + n0 + 4 * c4);
        scr[k * 64 + ((4 * c4 + 0) ^ k)] = v.x; scr[k * 64 + ((4 * c4 + 1) ^ k)] = v.y; scr[k * 64 + ((4 * c4 + 2) ^ k)] = v.z; scr[k * 64 + ((4 * c4 + 3) ^ k)] = v.w; }
    LDS_WAIT(); asm volatile("" ::: "memory");
    const int c = lane & 7;
#pragma unroll
    for (int j = 0; j < 8; ++j) { const int n = (lane >> 3) + 8 * j; float f[8];
#pragma unroll
        for (int e = 0; e < 8; ++e) { const int k = 8 * c + e; f[e] = scr[k * 64 + (n ^ k)] * sc; }
        *(GAS v4u*)(WT + (size_t)(drow0 + n) * K + k0 + 8 * c) = (v4u){pk2(f[0], f[1]), pk2(f[2], f[3]), pk2(f[4], f[5]), pk2(f[6], f[7])}; }
    LDS_WAIT(); asm volatile("" ::: "memory");
}

struct TrItem { const float* src; bf16* dst; int K, N, k0, n0, drow0; };
__device__ __forceinline__ void tr64_load(f32x4 (&v)[16], const TrItem& p, int lane) { const int r = lane >> 4, c4 = lane & 15;
#pragma unroll
    for (int i = 0; i < 16; ++i) v[i] = *(const GAS f32x4*)(p.src + (size_t)(p.k0 + 4 * i + r) * p.N + p.n0 + 4 * c4); }
__device__ __forceinline__ void tr64_put(const f32x4 (&v)[16], LAS float* scr, int lane) { const int r = lane >> 4, c4 = lane & 15;
#pragma unroll
    for (int i = 0; i < 16; ++i) { const int k = 4 * i + r; scr[k * 64 + ((4 * c4 + 0) ^ k)] = v[i].x; scr[k * 64 + ((4 * c4 + 1) ^ k)] = v[i].y; scr[k * 64 + ((4 * c4 + 2) ^ k)] = v[i].z; scr[k * 64 + ((4 * c4 + 3) ^ k)] = v[i].w; }
    LDS_WAIT(); asm volatile("" ::: "memory"); }
__device__ __forceinline__ void tr64_get(const TrItem& p, LAS float* scr, int lane) { const int c = lane & 7;
#pragma unroll
    for (int j = 0; j < 8; ++j) { const int n = (lane >> 3) + 8 * j; float f[8];
#pragma unroll
        for (int e = 0; e < 8; ++e) { const int k = 8 * c + e; f[e] = scr[k * 64 + (n ^ k)]; }
        *(GAS v4u*)(p.dst + (size_t)(p.drow0 + n) * p.K + p.k0 + 8 * c) = (v4u){pk2(f[0], f[1]), pk2(f[2], f[3]), pk2(f[4], f[5]), pk2(f[6], f[7])}; }
    LDS_WAIT(); asm volatile("" ::: "memory"); }

struct Args { const void* in[30]; float* out; unsigned char* ws; int layer, pad; };
__device__ __forceinline__ Ctx make_ctx(const Args& args, unsigned char* ws, int l) {
    Ctx c;
    c.pos = (const int*)args.in[1];
    c.gam = (const float*)args.in[5] + l * 16; c.ret_g = (const float*)args.in[6] + l * 512; c.mu = (const float*)args.in[7] + l * 2 * B_COLS;
    c.w0 = (const float*)args.in[8] + l * 1024; c.w2 = (const float*)args.in[9] + l * 96 * 512; c.a0 = (const float*)args.in[10] + l * 1024; c.a2 = (const float*)args.in[11] + l * 96 * 512;
    c.g2 = (const float*)args.in[12] + l * 256 * 512; c.k_k = (const float*)args.in[13] + l * 512; c.k_a = (const float*)args.in[14] + l * 512; c.r_k = (const float*)args.in[15] + l * 512;
    c.ln_g = (const float*)args.in[16] + l * 512; c.sgu_g = (const float*)args.in[17] + l * 512; c.sgu_b = (const float*)args.in[18] + l * 512;
    c.sgu_w = (const float*)args.in[19] + (size_t)l * 8 * 128 * 128; c.sgu_bias = (const float*)args.in[20] + l * 1024;
    c.proj = (bf16*)(ws + WS_PROJ); c.ycat = (bf16*)(ws + WS_ACT);
    c.rs = (bf16*)(ws + WS_RS); c.ks = (bf16*)(ws + WS_KS); c.vs = (bf16*)(ws + WS_VS); c.kk = (bf16*)(ws + WS_KK); c.gg = (bf16*)(ws + WS_GG);
    c.kdf = (bf16*)(ws + WS_KDF); c.kdb = (bf16*)(ws + WS_KDB); c.akf = (bf16*)(ws + WS_AKF); c.akb = (bf16*)(ws + WS_AKB); c.yf = (bf16*)(ws + WS_YF); c.yb = (bf16*)(ws + WS_YB);
    c.loraw = (const bf16*)(ws + WS_LORAW);
    c.lin = (bf16*)(ws + WS_LIN); c.wf = (float*)(ws + WS_WF); c.wb = (float*)(ws + WS_WB); c.rkv = (float*)(ws + WS_RKV); c.rsp = (float*)(ws + WS_RSP);
    return c;
}


#define ROW_LOAD(v, ptr) _Pragma("unroll") for (int j = 0; j < 8; ++j) v[j] = ((const GAS f32x4*)(ptr))[lane + 64 * j]
#define ROW_LOAD_BF(v, ptr) _Pragma("unroll") for (int j = 0; j < 8; ++j) { const v2u w_ = ((const GAS v2u*)(ptr))[lane + 64 * j]; \
    v[j] = (f32x4){__builtin_bit_cast(float, w_.x << 16), __builtin_bit_cast(float, w_.x & 0xffff0000u), __builtin_bit_cast(float, w_.y << 16), __builtin_bit_cast(float, w_.y & 0xffff0000u)}; }
__device__ __forceinline__ void row_add_moe(f32x4 (&v)[8], const bf16* yp, size_t R1, size_t R2, float g1, float g2, int lane) {
#pragma unroll
    for (int j = 0; j < 8; ++j) { const v2u a = ((const GAS v2u*)(yp + R1 * DM))[lane + 64 * j], b = ((const GAS v2u*)(yp + R2 * DM))[lane + 64 * j];
        v[j].x += g1 * bf2f((bf16)(a.x & 0xffff)) + g2 * bf2f((bf16)(b.x & 0xffff)); v[j].y += g1 * bf2f((bf16)(a.x >> 16)) + g2 * bf2f((bf16)(b.x >> 16));
        v[j].z += g1 * bf2f((bf16)(a.y & 0xffff)) + g2 * bf2f((bf16)(b.y & 0xffff)); v[j].w += g1 * bf2f((bf16)(a.y >> 16)) + g2 * bf2f((bf16)(b.y >> 16)); }
}
__device__ __forceinline__ float row_rstd(const f32x4 (&v)[8], int lane) {
    float ss = 0.f;
#pragma unroll
    for (int j = 0; j < 8; ++j) ss += (v[j].x * v[j].x + v[j].y * v[j].y) + (v[j].z * v[j].z + v[j].w * v[j].w);
    return 1.f / sqrtf(wave_sum(ss, lane) * (1.f / DM) + NORM_EPS);
}
__device__ __forceinline__ f32x4 up2(v2u w) { return (f32x4){__builtin_bit_cast(float, w.x << 16), __builtin_bit_cast(float, w.x & 0xffff0000u), __builtin_bit_cast(float, w.y << 16), __builtin_bit_cast(float, w.y & 0xffff0000u)}; }
template <int NB> __device__ __forceinline__ void wave_sum_n(float (&v)[NB], int lane) {
#pragma unroll
    for (int o = 1; o < 64; o <<= 1) { float t_[NB];
#pragma unroll
        for (int u = 0; u < NB; ++u) t_[u] = __builtin_bit_cast(float, __builtin_amdgcn_ds_bpermute((lane ^ o) << 2, __builtin_bit_cast(int, v[u])));
#pragma unroll
        for (int u = 0; u < NB; ++u) v[u] += t_[u]; } }
template <int NB>
__device__ __forceinline__ void rows_norm_f32(const float* x_in, const float* gain, bf16* act, int m0, int mstride, int lane) {
    f32x4 v[NB][8]; float ss[NB];
#pragma unroll
    for (int u = 0; u < NB; ++u) { const int m = m0 + u * mstride;
#pragma unroll
        for (int j = 0; j < 8; ++j) v[u][j] = m < T ? ((const GAS f32x4*)(x_in + (size_t)m * DM))[lane + 64 * j] : (f32x4){0.f, 0.f, 0.f, 0.f}; }
#pragma unroll
    for (int u = 0; u < NB; ++u) { ss[u] = 0.f;
#pragma unroll
        for (int j = 0; j < 8; ++j) ss[u] += (v[u][j].x * v[u][j].x + v[u][j].y * v[u][j].y) + (v[u][j].z * v[u][j].z + v[u][j].w * v[u][j].w); }
    wave_sum_n<NB>(ss, lane);
#pragma unroll
    for (int u = 0; u < NB; ++u) { const int m = m0 + u * mstride; const float rstd = 1.f / sqrtf(ss[u] * (1.f / DM) + NORM_EPS);
        if (m < T) {
#pragma unroll
            for (int j = 0; j < 8; ++j) { const f32x4 g = ((const GAS f32x4*)gain)[lane + 64 * j];
                v2u o; o.x = pk2(v[u][j].x * rstd * g.x, v[u][j].y * rstd * g.y); o.y = pk2(v[u][j].z * rstd * g.z, v[u][j].w * rstd * g.w);
                ((GAS v2u*)(act + (size_t)m * DM))[lane + 64 * j] = o; } } }
}
template <int NB, bool FINAL>
__device__ __forceinline__ void rows_moe(bf16* xbuf, const bf16* yp, const unsigned* slot_tok, const float* gate_tok, const LAS int* trb, const float* gain, bf16* act, float* out, float pscale, int m0, int mstride, int lane) {
    v2u xr[NB][8], ya[NB][8], yb[NB][8]; float g1[NB], g2[NB], ss[NB]; size_t R1[NB], R2[NB];
#pragma unroll
    for (int u = 0; u < NB; ++u) { const int m = m0 + u * mstride < T ? m0 + u * mstride : m0;
        const unsigned s1 = slot_tok[2 * m], s2 = slot_tok[2 * m + 1]; g1[u] = gate_tok[2 * m]; g2[u] = gate_tok[2 * m + 1];
        R1[u] = (size_t)(trb[s1 >> 20] + (int)(s1 & 0xfffffu)); R2[u] = (size_t)(trb[s2 >> 20] + (int)(s2 & 0xfffffu)); }
#pragma unroll
    for (int u = 0; u < NB; ++u) { const int m = m0 + u * mstride < T ? m0 + u * mstride : m0;
#pragma unroll
        for (int j = 0; j < 8; ++j) { xr[u][j] = ((const GAS v2u*)(xbuf + (size_t)m * DM))[lane + 64 * j]; ya[u][j] = ((const GAS v2u*)(yp + R1[u] * DM))[lane + 64 * j]; yb[u][j] = ((const GAS v2u*)(yp + R2[u] * DM))[lane + 64 * j]; } }
#pragma unroll
    for (int u = 0; u < NB; ++u) { const int m = m0 + u * mstride; ss[u] = 0.f;
#pragma unroll
        for (int j = 0; j < 8; ++j) { f32x4 t = up2(xr[u][j]) + g1[u] * up2(ya[u][j]) + g2[u] * up2(yb[u][j]);
            if constexpr (!FINAL) { v2u o; o.x = pk2(t.x, t.y); o.y = pk2(t.z, t.w); if (m < T) ((GAS v2u*)(xbuf + (size_t)m * DM))[lane + 64 * j] = o; t = up2(o); xr[u][j] = o; }
            else { ya[u][j] = (v2u){__builtin_bit_cast(unsigned, t.x), __builtin_bit_cast(unsigned, t.y)}; yb[u][j] = (v2u){__builtin_bit_cast(unsigned, t.z), __builtin_bit_cast(unsigned, t.w)}; }
            ss[u] += (t.x * t.x + t.y * t.y) + (t.z * t.z + t.w * t.w); } }
    wave_sum_n<NB>(ss, lane);
#pragma unroll
    for (int u = 0; u < NB; ++u) { const int m = m0 + u * mstride; const float rstd = 1.f / sqrtf(ss[u] * (1.f / DM) + NORM_EPS);
        if (m < T) {
#pragma unroll
            for (int j = 0; j < 8; ++j) { const f32x4 g = ((const GAS f32x4*)gain)[lane + 64 * j];
                if constexpr (!FINAL) { const f32x4 t = up2(xr[u][j]); v2u o; o.x = pk2(t.x * rstd * g.x, t.y * rstd * g.y); o.y = pk2(t.z * rstd * g.z, t.w * rstd * g.w); ((GAS v2u*)(act + (size_t)m * DM))[lane + 64 * j] = o; }
                else { const f32x4 t = (f32x4){__builtin_bit_cast(float, ya[u][j].x), __builtin_bit_cast(float, ya[u][j].y), __builtin_bit_cast(float, yb[u][j].x), __builtin_bit_cast(float, yb[u][j].y)};
                    ((GAS f32x4*)(out + (size_t)m * DM))[lane + 64 * j] = (f32x4){t.x * rstd * g.x * pscale, t.y * rstd * g.y * pscale, t.z * rstd * g.z * pscale, t.w * rstd * g.w * pscale}; } } } }
}
#define SEAM(k) do { if constexpr (KSEL < 0) { XcdBarrier b_ = bar; unsigned blo_ = __builtin_amdgcn_readfirstlane((unsigned)(unsigned long long)b_.bar), bhi_ = __builtin_amdgcn_readfirstlane((unsigned)((unsigned long long)b_.bar >> 32)); \
    asm volatile("" : "+s"(blo_), "+s"(bhi_)); b_.bar = (unsigned*)(((unsigned long long)bhi_ << 32) | blo_); xcd_barrier(b_); } } while (0)
#define PORD(k) ((k) == 13 ? 6 : ((k) >= 6 ? (k) + 1 : (k)))
#define TSTAMP_AFTER(k) do { if (KB_TPROBE >= 0 && KSEL < 0 && blockIdx.x == 0 && threadIdx.x == 0) ((unsigned long long*)(args.ws + WS_CTL))[32768 + 1 + l * 13 + PORD(k)] = wall_clock64(); } while (0)
#define PH_ON(k) if constexpr ((KSEL < 0 && KB_EN(k)) || KSEL == (k))
#define PHASE_LOCALS() GAS unsigned char* wsg_ = (GAS unsigned char*)args.ws; int ll = KSEL < 0 ? l : __builtin_amdgcn_readfirstlane(l); int tid = threadIdx.x; asm volatile("" : "+s"(wsg_), "+s"(ll), "+v"(tid)); \
    unsigned char* ws = (unsigned char*)wsg_;         \
    const int lane = tid & 63, wave = __builtin_amdgcn_readfirstlane(tid >> 6); \
    const int G = gridDim.x, bid = blockIdx.x; const long gtid = (long)bid * 512 + tid, gstride = (long)G * 512; const int gw = bid * 8 + wave, NGW = G * 8; \
    (void)gtid; (void)gstride; (void)gw; (void)NGW; (void)ll; (void)lane


typedef short bf16x8 __attribute__((ext_vector_type(8)));
typedef short s16x4 __attribute__((ext_vector_type(4)));
typedef short v4i16_t __attribute__((ext_vector_type(4)));
#ifndef KB_EMU
#define MMA16(a, b, c) __builtin_amdgcn_mfma_f32_16x16x32_bf16((a), (b), (c), 0, 0, 0)
#define TR16(p) __builtin_amdgcn_ds_read_tr16_b64_v4i16((LAS v4i16_t*)(p))
#define BPERM(addr, v) __builtin_amdgcn_ds_bpermute((addr), (v))
#define RFL(x) __builtin_amdgcn_readfirstlane(x)
#define FEXP(x) __expf(x)
#define BSYNC() __syncthreads()
#define LBAR() do { asm volatile("s_waitcnt lgkmcnt(0)" ::: "memory"); __builtin_amdgcn_s_barrier(); asm volatile("" ::: "memory"); } while (0)
#define LDS_WAIT_() do { asm volatile("s_waitcnt lgkmcnt(0)" ::: "memory"); } while (0)
#endif
__device__ __forceinline__ bf16x8 frag_row(const LAS bf16* X, int ld, int r0, int c0, int fr, int fq) { return *(const LAS bf16x8*)(X + (r0 + fr) * ld + c0 + 8 * fq); }
__device__ __forceinline__ s16x4 tr4(const LAS bf16* X, int ld, int r0, int c0, int fr) { return __builtin_bit_cast(s16x4, TR16(X + (r0 + (fr >> 2)) * ld + c0 + 4 * (fr & 3))); }
__device__ __forceinline__ bf16x8 frag_col(const LAS bf16* X, int ld, int k0, int c0, int fr, int fq) {
    const s16x4 a = tr4(X, ld, k0 + 8 * fq, c0, fr), b = tr4(X, ld, k0 + 8 * fq + 4, c0, fr);
    return (bf16x8){a[0], a[1], a[2], a[3], b[0], b[1], b[2], b[3]}; }
#ifndef KB_EMU
typedef float cvt_f2 __attribute__((ext_vector_type(2)));
typedef __bf16 cvt_b2 __attribute__((ext_vector_type(2)));
__device__ __forceinline__ unsigned cvtpk(float lo, float hi) { return __builtin_bit_cast(unsigned, __builtin_convertvector(((cvt_f2){lo, hi}), cvt_b2)); }
#else
inline unsigned cvtpk(float lo, float hi) { return (unsigned)f2bf(lo) | ((unsigned)f2bf(hi) << 16); }
#endif
__device__ __forceinline__ float xlane_max4(float v, int lane) {
    v = fmaxf(v, __builtin_bit_cast(float, BPERM((lane ^ 16) << 2, __builtin_bit_cast(int, v))));
    v = fmaxf(v, __builtin_bit_cast(float, BPERM((lane ^ 32) << 2, __builtin_bit_cast(int, v)))); return v; }
__device__ __forceinline__ float xlane_sum4(float v, int lane) {
    v += __builtin_bit_cast(float, BPERM((lane ^ 16) << 2, __builtin_bit_cast(int, v)));
    v += __builtin_bit_cast(float, BPERM((lane ^ 32) << 2, __builtin_bit_cast(int, v))); return v; }

__device__ __forceinline__ void unpack8(const v4u x, float (&f)[8]) {
    f[0] = __builtin_bit_cast(float, x.x << 16); f[1] = __builtin_bit_cast(float, x.x & 0xffff0000u); f[2] = __builtin_bit_cast(float, x.y << 16); f[3] = __builtin_bit_cast(float, x.y & 0xffff0000u);
    f[4] = __builtin_bit_cast(float, x.z << 16); f[5] = __builtin_bit_cast(float, x.z & 0xffff0000u); f[6] = __builtin_bit_cast(float, x.w << 16); f[7] = __builtin_bit_cast(float, x.w & 0xffff0000u); }
__device__ __forceinline__ void st8(bf16* p, const float (&f)[8]) { *(GAS v4u*)p = (v4u){cvtpk(f[0], f[1]), cvtpk(f[2], f[3]), cvtpk(f[4], f[5]), cvtpk(f[6], f[7])}; }
__device__ __forceinline__ float red8(float v, int lane) {
    v += __builtin_bit_cast(float, BPERM((lane ^ 1) << 2, __builtin_bit_cast(int, v))); v += __builtin_bit_cast(float, BPERM((lane ^ 2) << 2, __builtin_bit_cast(int, v)));
    v += __builtin_bit_cast(float, BPERM((lane ^ 4) << 2, __builtin_bit_cast(int, v))); return v; }
__device__ __forceinline__ void v_rot_table(const int* pos, float* rot, long idx) {
    const int j = (int)(idx % 40); const long t = idx / 40;
    const float inv = j < 32 ? expf(-(float)j * (1.f / 32.f) * 9.210340371976184f) : expf(-(float)(j - 32) * (1.f / 8.f) * 13.122363377404328f);
    float sn, cs; sincosf((float)pos[t] * inv, &sn, &cs); rot[idx * 2] = cs; rot[idx * 2 + 1] = sn; }
__device__ __forceinline__ void v_rot_ret(bf16* proj, const float* rot, long idx) {
    const int j8 = (int)(idx & 3), h = (int)((idx >> 2) & 7); const long t = idx >> 5;
    bf16* q = proj + (size_t)t * NPROJ + OFF_A + h * 64 + 8 * j8; bf16* k = q + 512; const float* cs = rot + ((size_t)t * 40 + 8 * j8) * 2;
    float q1[8], q2[8], k1[8], k2[8], c[8], s_[8];
    unpack8(*(const GAS v4u*)q, q1); unpack8(*(const GAS v4u*)(q + 32), q2); unpack8(*(const GAS v4u*)k, k1); unpack8(*(const GAS v4u*)(k + 32), k2);
#pragma unroll
    for (int i = 0; i < 4; ++i) { const f32x4 v = *(const GAS f32x4*)(cs + 4 * i); c[2 * i] = v.x; s_[2 * i] = v.y; c[2 * i + 1] = v.z; s_[2 * i + 1] = v.w; }
    float o1[8], o2[8], p1[8], p2[8];
#pragma unroll
    for (int i = 0; i < 8; ++i) { o1[i] = q1[i] * c[i] - q2[i] * s_[i]; o2[i] = q2[i] * c[i] + q1[i] * s_[i]; p1[i] = k1[i] * c[i] - k2[i] * s_[i]; p2[i] = k2[i] * c[i] + k1[i] * s_[i]; }
    st8(q, o1); st8(q + 32, o2); st8(k, p1); st8(k + 32, p2); }
__device__ __forceinline__ void v_rot_dil(bf16* proj, const float* rot, long idx) {
    const int h = (int)(idx & 7); const long t = idx >> 3;
    bf16* q = proj + (size_t)t * NPROJ + OFF_D + h * 64; bf16* k = q + 512; const float* cs = rot + ((size_t)t * 40 + 32) * 2;
    float q1[8], q2[8], k1[8], k2[8], c[8], s_[8];
    unpack8(*(const GAS v4u*)q, q1); unpack8(*(const GAS v4u*)(q + 8), q2); unpack8(*(const GAS v4u*)k, k1); unpack8(*(const GAS v4u*)(k + 8), k2);
#pragma unroll
    for (int i = 0; i < 4; ++i) { const f32x4 v = *(const GAS f32x4*)(cs + 4 * i); c[2 * i] = v.x; s_[2 * i] = v.y; c[2 * i + 1] = v.z; s_[2 * i + 1] = v.w; }
    float o1[8], o2[8], p1[8], p2[8];
#pragma unroll
    for (int i = 0; i < 8; ++i) { o1[i] = q1[i] * c[i] - q2[i] * s_[i]; o2[i] = q2[i] * c[i] + q1[i] * s_[i]; p1[i] = k1[i] * c[i] - k2[i] * s_[i]; p2[i] = k2[i] * c[i] + k1[i] * s_[i]; }
    st8(q, o1); st8(q + 8, o2); st8(k, p1); st8(k + 8, p2); }
__device__ __forceinline__ void v_rwkv_shift(const Ctx& c, long idx) {
    const int g8 = (int)(idx % 248), j0 = 8 * g8; const long t = idx / 248; const int s = (int)(t % SEQ);
    const bf16* p = c.proj + (size_t)t * NPROJ + OFF_B + j0;
    float x[8], xp[8], xn[8], o[8];
    unpack8(*(const GAS v4u*)p, x);
    if (s > 0) unpack8(*(const GAS v4u*)(p - NPROJ), xp); else { for (int i = 0; i < 8; ++i) xp[i] = 0.f; }
    if (s < SEQ - 1) unpack8(*(const GAS v4u*)(p + NPROJ), xn); else { for (int i = 0; i < 8; ++i) xn[i] = 0.f; }
#pragma unroll
    for (int i = 0; i < 8; ++i) o[i] = x[i] + c.mu[j0 + i] * (xp[i] - x[i]) + c.mu[B_COLS + j0 + i] * (xn[i] - x[i]);
    if (j0 < 512) st8(c.rs + t * 512 + j0, o);
    else if (j0 < 1024) st8(c.ks + t * 512 + j0 - 512, o);
    else if (j0 < 1536) st8(c.vs + t * 512 + j0 - 1024, o);
    else { if (j0 < 1632) { for (int i = 0; i < 8; ++i) o[i] = tanhf(o[i]); } else if (j0 >= 1728) { for (int i = 0; i < 8; ++i) o[i] = sigmoidf_(o[i]); }
        st8(c.lin + t * NLORA + (j0 - 1536), o); } }
struct ShiftIn { v4u x, xp, xn; };
__device__ __forceinline__ void shift_load(const Ctx& c, unsigned idx, ShiftIn& in) {
    const unsigned t = idx / 248u, j0 = 8u * (idx - t * 248u), s = t % (unsigned)SEQ;
    const bf16* p = c.proj + (size_t)t * NPROJ + OFF_B + j0; const v4u z = (v4u){0u, 0u, 0u, 0u};
    in.x = *(const GAS v4u*)p; in.xp = z; in.xn = z;
    if (s > 0) in.xp = *(const GAS v4u*)(p - NPROJ);
    if (s < (unsigned)SEQ - 1) in.xn = *(const GAS v4u*)(p + NPROJ); }
__device__ __forceinline__ void shift_finish(const Ctx& c, unsigned idx, const ShiftIn& in) {
    const unsigned t = idx / 248u, j0 = 8u * (idx - t * 248u);
    float x[8], xp[8], xn[8], o[8], mp[8], mn[8];
    unpack8(in.x, x); unpack8(in.xp, xp); unpack8(in.xn, xn);
    { const f32x4 a = *(const GAS f32x4*)(c.mu + j0), b = *(const GAS f32x4*)(c.mu + j0 + 4), d = *(const GAS f32x4*)(c.mu + B_COLS + j0), e = *(const GAS f32x4*)(c.mu + B_COLS + j0 + 4);
      mp[0] = a.x; mp[1] = a.y; mp[2] = a.z; mp[3] = a.w; mp[4] = b.x; mp[5] = b.y; mp[6] = b.z; mp[7] = b.w; mn[0] = d.x; mn[1] = d.y; mn[2] = d.z; mn[3] = d.w; mn[4] = e.x; mn[5] = e.y; mn[6] = e.z; mn[7] = e.w; }
#pragma unroll
    for (int i = 0; i < 8; ++i) o[i] = x[i] + mp[i] * (xp[i] - x[i]) + mn[i] * (xn[i] - x[i]);
    if (j0 < 512) st8(c.rs + (size_t)t * 512 + j0, o);
    else if (j0 < 1024) st8(c.ks + (size_t)t * 512 + j0 - 512, o);
    else if (j0 < 1536) st8(c.vs + (size_t)t * 512 + j0 - 1024, o);
    else { if (j0 < 1632) { for (int i = 0; i < 8; ++i) o[i] = tanhf(o[i]); } else if (j0 >= 1728) { for (int i = 0; i < 8; ++i) o[i] = sigmoidf_(o[i]); }
        st8(c.lin + (size_t)t * NLORA + (j0 - 1536), o); } }
__device__ __forceinline__ void w_sgu_prep(const Ctx& c, long t, int lane) {
    bf16* v = c.proj + (size_t)t * NPROJ + OFF_C + 512 + 8 * lane; float f[8]; unpack8(*(const GAS v4u*)v, f); float s = 0.f;
#pragma unroll
    for (int i = 0; i < 8; ++i) { f[i] = geluf_(f[i]); s += f[i]; }
    const float mean = wave_sum(s, lane) * (1.f / 512.f); float q = 0.f;
#pragma unroll
    for (int i = 0; i < 8; ++i) { f[i] -= mean; q += f[i] * f[i]; }
    const float rstd = 1.f / sqrtf(wave_sum(q, lane) * (1.f / 512.f) + NORM_EPS);
#pragma unroll
    for (int i = 0; i < 8; ++i) f[i] = f[i] * rstd * c.sgu_g[8 * lane + i] + c.sgu_b[8 * lane + i];
    st8(v, f); }
template <int NB>
__device__ __forceinline__ void w_sgu_prep_batch(const Ctx& c, int m0, int mstride, int lane) {
    float f[NB][8], s[NB], q[NB]; v4u raw[NB];
#pragma unroll
    for (int u = 0; u < NB; ++u) { const int t = m0 + u * mstride; raw[u] = (v4u){0u, 0u, 0u, 0u}; if (t < T) raw[u] = *(const GAS v4u*)(c.proj + (size_t)t * NPROJ + OFF_C + 512 + 8 * lane); }
#pragma unroll
    for (int u = 0; u < NB; ++u) { unpack8(raw[u], f[u]); s[u] = 0.f;
#pragma unroll
        for (int i = 0; i < 8; ++i) { f[u][i] = geluf_(f[u][i]); s[u] += f[u][i]; } }
#pragma unroll
    for (int o = 1; o < 64; o <<= 1) { float t_[NB];
#pragma unroll
        for (int u = 0; u < NB; ++u) t_[u] = __builtin_bit_cast(float, __builtin_amdgcn_ds_bpermute((lane ^ o) << 2, __builtin_bit_cast(int, s[u])));
#pragma unroll
        for (int u = 0; u < NB; ++u) s[u] += t_[u]; }
#pragma unroll
    for (int u = 0; u < NB; ++u) { const float mean = s[u] * (1.f / 512.f); q[u] = 0.f;
#pragma unroll
        for (int i = 0; i < 8; ++i) { f[u][i] -= mean; q[u] += f[u][i] * f[u][i]; } }
#pragma unroll
    for (int o = 1; o < 64; o <<= 1) { float t_[NB];
#pragma unroll
        for (int u = 0; u < NB; ++u) t_[u] = __builtin_bit_cast(float, __builtin_amdgcn_ds_bpermute((lane ^ o) << 2, __builtin_bit_cast(int, q[u])));
#pragma unroll
        for (int u = 0; u < NB; ++u) q[u] += t_[u]; }
    float gg_[8], bb_[8];
    { const f32x4 a = *(const GAS f32x4*)(c.sgu_g + 8 * lane), b = *(const GAS f32x4*)(c.sgu_g + 8 * lane + 4), d = *(const GAS f32x4*)(c.sgu_b + 8 * lane), e = *(const GAS f32x4*)(c.sgu_b + 8 * lane + 4);
      gg_[0] = a.x; gg_[1] = a.y; gg_[2] = a.z; gg_[3] = a.w; gg_[4] = b.x; gg_[5] = b.y; gg_[6] = b.z; gg_[7] = b.w; bb_[0] = d.x; bb_[1] = d.y; bb_[2] = d.z; bb_[3] = d.w; bb_[4] = e.x; bb_[5] = e.y; bb_[6] = e.z; bb_[7] = e.w; }
#pragma unroll
    for (int u = 0; u < NB; ++u) { const int t = m0 + u * mstride; const float rstd = 1.f / sqrtf(q[u] * (1.f / 512.f) + NORM_EPS);
#pragma unroll
        for (int i = 0; i < 8; ++i) f[u][i] = f[u][i] * rstd * gg_[i] + bb_[i];
        if (t < T) st8(c.proj + (size_t)t * NPROJ + OFF_C + 512 + 8 * lane, f[u]); } }
__device__ __forceinline__ void v_rwkv_kk(const Ctx& c, long idx, int lane) {
    const size_t o = (size_t)idx * 8; float k[8], af[8], ab[8]; unpack8(*(const GAS v4u*)(c.kk + o), k); unpack8(*(const GAS v4u*)(c.akf + o), af); unpack8(*(const GAS v4u*)(c.akb + o), ab);
    float ss = 0.f;
#pragma unroll
    for (int i = 0; i < 8; ++i) ss += k[i] * k[i];
    const float n = 1.f / sqrtf(red8(ss, lane) + 1e-12f);
#pragma unroll
    for (int i = 0; i < 8; ++i) { k[i] *= n; af[i] *= k[i]; ab[i] *= k[i]; }
    st8(c.kk + o, k); st8(c.akf + o, af); st8(c.akb + o, ab); }
__device__ __forceinline__ void v_dil_combine(const bf16* dpo, const float* dml, bf16* ycat, long idx) {
    const int cg = (int)(idx & 63), h = cg >> 3; const long t = idx >> 6; float m[3], l[3];
#pragma unroll
    for (int br = 0; br < 3; ++br) { const float* mp = dml + (((size_t)br * T + t) * 8 + h) * 2; m[br] = mp[0]; l[br] = mp[1]; }
    const float M = fmaxf(m[0], fmaxf(m[1], m[2])); float wgt[3], den = 0.f;
#pragma unroll
    for (int br = 0; br < 3; ++br) { wgt[br] = FEXP(m[br] - M) * l[br]; den += wgt[br]; }
    const float inv = 1.f / den; float y[8];
#pragma unroll
    for (int i = 0; i < 8; ++i) y[i] = 0.f;
#pragma unroll
    for (int br = 0; br < 3; ++br) { float f[8]; unpack8(*(const GAS v4u*)(dpo + ((size_t)br * T + t) * 512 + cg * 8), f); const float wv = wgt[br] * inv;
#pragma unroll
        for (int i = 0; i < 8; ++i) y[i] += wv * f[i]; }
    st8(ycat + (size_t)t * 2048 + 1536 + cg * 8, y); }
template <int NB>
__device__ __forceinline__ void v_dil_combine_batch(const bf16* dpo, const float* dml, bf16* ycat, long idx0, long istride, long iend) {
    cvt_f2 ml[NB][3]; v4u raw[NB][3];
#pragma unroll
    for (int u = 0; u < NB; ++u) { const long idx = idx0 + u * istride < iend ? idx0 + u * istride : idx0; const int cg = (int)(idx & 63), h = cg >> 3; const long t = idx >> 6;
#pragma unroll
        for (int br = 0; br < 3; ++br) { ml[u][br] = *(const GAS cvt_f2*)(dml + (((size_t)br * T + t) * 8 + h) * 2); raw[u][br] = *(const GAS v4u*)(dpo + ((size_t)br * T + t) * 512 + cg * 8); } }
#pragma unroll
    for (int u = 0; u < NB; ++u) { const long idx = idx0 + u * istride; const int cg = (int)(idx & 63); const long t = idx >> 6;
        const float M = fmaxf(ml[u][0].x, fmaxf(ml[u][1].x, ml[u][2].x)); float wgt[3], den = 0.f;
#pragma unroll
        for (int br = 0; br < 3; ++br) { wgt[br] = FEXP(ml[u][br].x - M) * ml[u][br].y; den += wgt[br]; }
        const float inv = 1.f / den; float y[8];
#pragma unroll
        for (int i = 0; i < 8; ++i) y[i] = 0.f;
#pragma unroll
        for (int br = 0; br < 3; ++br) { float f[8]; unpack8(raw[u][br], f); const float wv = wgt[br] * inv;
#pragma unroll
            for (int i = 0; i < 8; ++i) y[i] += wv * f[i]; }
        if (idx < iend) st8(ycat + (size_t)t * 2048 + 1536 + cg * 8, y); } }
__device__ __forceinline__ void v_rwkv_fin(const Ctx& c, long idx, int lane) {
    const int cg = (int)(idx & 63); const long t = idx >> 6; const size_t o = (size_t)idx * 8;
    float yf[8], yb[8], r[8], k[8], v[8], g[8]; unpack8(*(const GAS v4u*)(c.yf + o), yf); unpack8(*(const GAS v4u*)(c.yb + o), yb); unpack8(*(const GAS v4u*)(c.rs + o), r); unpack8(*(const GAS v4u*)(c.ks + o), k);
    unpack8(*(const GAS v4u*)(c.vs + o), v); unpack8(*(const GAS v4u*)(c.gg + o), g);
    float s = 0.f, bon = 0.f;
#pragma unroll
    for (int i = 0; i < 8; ++i) { yf[i] += yb[i]; s += yf[i]; bon += r[i] * k[i] * c.r_k[cg * 8 + i]; }
    const float mu = red8(s, lane) * (1.f / 64.f); bon = red8(bon, lane); float q = 0.f;
#pragma unroll
    for (int i = 0; i < 8; ++i) { yf[i] -= mu; q += yf[i] * yf[i]; }
    const float rstd = 1.f / sqrtf(red8(q, lane) * (1.f / 64.f) + GN_EPS); float out[8];
#pragma unroll
    for (int i = 0; i < 8; ++i) out[i] = (yf[i] * rstd * c.ln_g[cg * 8 + i] + bon * v[i]) * g[i];
    st8(c.ycat + (size_t)t * 2048 + 512 + cg * 8, out); }

constexpr int DIL_LD = 72, DIL_TEAM_BYTES = (64 + 192 + 192) * DIL_LD * 2;
static_assert(2 * DIL_TEAM_BYTES <= RING_BYTES, "dilated attention LDS");
__device__ __forceinline__ void dil_attn_phase(LAS unsigned char* lds, const bf16* proj, bf16* dpo, float* dml, const int tid, const int bid, const int G) {
    const int lane = tid & 63, wave = RFL(tid >> 6), team = wave >> 2, w = wave & 3, tt = tid & 255, fr = lane & 15, fq = lane >> 4;
    LAS bf16* Qs = (LAS bf16*)(lds + team * DIL_TEAM_BYTES); LAS bf16* Ks = Qs + 64 * DIL_LD; LAS bf16* Vs = Ks + 192 * DIL_LD;
    constexpr int NITEMS = BATCH * 8 * 3 * 64;
    v4u pq[2], pk[6], pv[6];
#define DIL_DECODE(it_) const int blk = (it_) & 63; int r_ = (it_) >> 6; const int br = r_ % 3; r_ /= 3; const int h = r_ & 7, b = r_ >> 3; \
        const int dil = br == 0 ? 1 : (br == 1 ? 4 : 16), L = SEQ / dil, nb = L / 64, g = blk / nb, n = blk % nb; const bf16* base = proj + (size_t)b * SEQ * NPROJ + OFF_D + h * 64
#define DIL_LOAD(it_) do { DIL_DECODE(it_); \
        _Pragma("unroll") for (int u = 0; u < 2; ++u) { const int c_ = tt + 256 * u, i_ = c_ >> 3, ch_ = c_ & 7; const int pos_ = (64 * n + i_) * dil + g; pq[u] = *(const GAS v4u*)(base + (size_t)pos_ * NPROJ + ch_ * 8); } \
        _Pragma("unroll") for (int u = 0; u < 6; ++u) { const int c_ = tt + 256 * u, kr_ = c_ >> 3, ch_ = c_ & 7; const int kidx_ = 64 * (n - 1) + kr_; const bool ok_ = kidx_ >= 0 && kidx_ < L; const int pos_ = (ok_ ? kidx_ : 0) * dil + g; \
            pk[u] = (v4u){0u, 0u, 0u, 0u}; pv[u] = pk[u]; if (ok_) { pk[u] = *(const GAS v4u*)(base + (size_t)pos_ * NPROJ + 512 + ch_ * 8); pv[u] = *(const GAS v4u*)(base + (size_t)pos_ * NPROJ + 1024 + ch_ * 8); } } } while (0)
    if (bid * 2 < NITEMS) DIL_LOAD(bid * 2 + team);
    for (int it0 = bid * 2; it0 < NITEMS; it0 += G * 2) {
        const int it = it0 + team;
        DIL_DECODE(it);
        LBAR();
#pragma unroll
        for (int u = 0; u < 2; ++u) { const int c_ = tt + 256 * u; *(LAS v4u*)(Qs + (c_ >> 3) * DIL_LD + (c_ & 7) * 8) = pq[u]; }
#pragma unroll
        for (int u = 0; u < 6; ++u) { const int c_ = tt + 256 * u; *(LAS v4u*)(Ks + (c_ >> 3) * DIL_LD + (c_ & 7) * 8) = pk[u]; *(LAS v4u*)(Vs + (c_ >> 3) * DIL_LD + (c_ & 7) * 8) = pv[u]; }
        LBAR();
        if (it0 + G * 2 < NITEMS) DIL_LOAD(it0 + G * 2 + team);
        bf16x8 qf[2];
#pragma unroll
        for (int ks = 0; ks < 2; ++ks) qf[ks] = frag_row(Qs, DIL_LD, 16 * w, 32 * ks, fr, fq);
        f32x4 sc[9];
#pragma unroll
        for (int kp = 0; kp < 9; ++kp) { sc[kp] = (f32x4){0.f, 0.f, 0.f, 0.f}; const LAS bf16* Kt = Ks + 16 * (w + kp) * DIL_LD;
#pragma unroll
            for (int ks = 0; ks < 2; ++ks) sc[kp] = MMA16(frag_row(Kt, DIL_LD, 0, 32 * ks, fr, fq), qf[ks], sc[kp]); }
        const int qi = 64 * n + 16 * w + fr; float mx = -1e30f;
#pragma unroll
        for (int kp = 0; kp < 9; ++kp) { const int kt = w + kp; const bool tile_ok = (n > 0 || kt >= 4) && (n < nb - 1 || kt < 8);
#pragma unroll
            for (int j = 0; j < 4; ++j) { const int e = 4 * fq + j - fr; const bool ok = tile_ok && (kp == 0 ? e >= 0 : (kp == 8 ? e <= 0 : true));
                sc[kp][j] = ok ? sc[kp][j] : -1e30f; mx = fmaxf(mx, sc[kp][j]); } }
        mx = xlane_max4(mx, lane);
        float den = 0.f;
#pragma unroll
        for (int kp = 0; kp < 9; ++kp)
#pragma unroll
            for (int j = 0; j < 4; ++j) { const float p = sc[kp][j] > -1e29f ? FEXP(sc[kp][j] - mx) : 0.f; sc[kp][j] = p; den += p; }
        den = xlane_sum4(den, lane);
        f32x4 o[4];
#pragma unroll
        for (int et = 0; et < 4; ++et) o[et] = (f32x4){0.f, 0.f, 0.f, 0.f};
#pragma unroll
        for (int u = 0; u < 5; ++u) {
            const unsigned p0 = cvtpk(sc[2 * u][0], sc[2 * u][1]), p1 = cvtpk(sc[2 * u][2], sc[2 * u][3]);
            const unsigned p2 = u < 4 ? cvtpk(sc[u < 4 ? 2 * u + 1 : 8][0], sc[u < 4 ? 2 * u + 1 : 8][1]) : 0u, p3 = u < 4 ? cvtpk(sc[u < 4 ? 2 * u + 1 : 8][2], sc[u < 4 ? 2 * u + 1 : 8][3]) : 0u;
            const bf16x8 pf = __builtin_bit_cast(bf16x8, (v4u){p0, p1, p2, p3});
            const int r0 = 16 * (w + 2 * u), r1 = 16 * (w + (u < 4 ? 2 * u + 1 : 2 * u));
#pragma unroll
            for (int et = 0; et < 4; ++et) { const s16x4 a = tr4(Vs, DIL_LD, r0 + 4 * fq, 16 * et, fr), bq = tr4(Vs, DIL_LD, r1 + 4 * fq, 16 * et, fr);
                o[et] = MMA16(((bf16x8){a[0], a[1], a[2], a[3], bq[0], bq[1], bq[2], bq[3]}), pf, o[et]); }
        }
        const float inv = 1.f / den; const size_t t = (size_t)b * SEQ + (size_t)qi * dil + g;
        bf16* op = dpo + ((size_t)br * T + t) * 512 + h * 64 + 4 * fq;
#pragma unroll
        for (int et = 0; et < 4; ++et) { v2u pk; pk.x = cvtpk(o[et][0] * inv, o[et][1] * inv); pk.y = cvtpk(o[et][2] * inv, o[et][3] * inv); *(GAS v2u*)(op + 16 * et) = pk; }
        if (fq == 0) { float* mp = dml + (((size_t)br * T + t) * 8 + h) * 2; mp[0] = mx; mp[1] = den; }
    }
}

constexpr int RET_LD = 72, RET1_TEAM_BYTES = 3 * 128 * RET_LD * 2;
static_assert(2 * RET1_TEAM_BYTES <= RING_BYTES && (3 * 128 + 2 * 64) * RET_LD * 2 <= RING_BYTES, "retention LDS");
__device__ __forceinline__ void ret_kv_phase(LAS unsigned char* lds, const bf16* proj, const float* gam, float* rkv, const int tid, const int bid, const int G) {
    const int lane = tid & 63, wave = RFL(tid >> 6), team = wave >> 2, w = wave & 3, tt = tid & 255, fr = lane & 15, fq = lane >> 4;
    LAS bf16* Kf = (LAS bf16*)(lds + team * RET1_TEAM_BYTES); LAS bf16* Kb = Kf + 128 * RET_LD; LAS bf16* Vs = Kb + 128 * RET_LD;
    constexpr int NITEMS = BATCH * 8 * NC;
    for (int it0 = bid * 2; it0 < NITEMS; it0 += G * 2) {
        const int it = it0 + team; const int ch = it % NC, h = (it / NC) & 7, b = it / (NC * 8);
        const float lgf = logsigmoidf_(gam[h]), lgb = logsigmoidf_(gam[8 + h]);
        const bf16* base = proj + ((size_t)b * SEQ + (size_t)ch * 128) * NPROJ + OFF_A + h * 64;
        LBAR();
#pragma unroll
        for (int c = tt; c < 1024; c += 256) { const int m = c >> 3, cc = c & 7;
            const v4u kv = *(const GAS v4u*)(base + (size_t)m * NPROJ + 512 + cc * 8), vv = *(const GAS v4u*)(base + (size_t)m * NPROJ + 1024 + cc * 8);
            float f[8]; unpack8(kv, f); const float df = FEXP(lgf * (float)(127 - m)), db = FEXP(lgb * (float)m);
            *(LAS v4u*)(Kf + m * RET_LD + cc * 8) = (v4u){cvtpk(f[0] * df, f[1] * df), cvtpk(f[2] * df, f[3] * df), cvtpk(f[4] * df, f[5] * df), cvtpk(f[6] * df, f[7] * df)};
            *(LAS v4u*)(Kb + m * RET_LD + cc * 8) = (v4u){cvtpk(f[0] * db, f[1] * db), cvtpk(f[2] * db, f[3] * db), cvtpk(f[4] * db, f[5] * db), cvtpk(f[6] * db, f[7] * db)};
            *(LAS v4u*)(Vs + m * RET_LD + cc * 8) = vv; }
        LBAR();
        f32x4 aF[4], aB[4];
#pragma unroll
        for (int dt = 0; dt < 4; ++dt) { aF[dt] = (f32x4){0.f, 0.f, 0.f, 0.f}; aB[dt] = aF[dt]; }
#pragma unroll
        for (int ks = 0; ks < 4; ++ks) { const bf16x8 a = frag_col(Vs, RET_LD, 32 * ks, 16 * w, fr, fq);
#pragma unroll
            for (int dt = 0; dt < 4; ++dt) { aF[dt] = MMA16(a, frag_col(Kf, RET_LD, 32 * ks, 16 * dt, fr, fq), aF[dt]); aB[dt] = MMA16(a, frag_col(Kb, RET_LD, 32 * ks, 16 * dt, fr, fq), aB[dt]); } }
        float* oF = rkv + ((size_t)((b * 8 + h) * 2 + 0) * NC + ch) * 4096; float* oB = rkv + ((size_t)((b * 8 + h) * 2 + 1) * NC + ch) * 4096;
#pragma unroll
        for (int dt = 0; dt < 4; ++dt)
#pragma unroll
            for (int j = 0; j < 4; ++j) { const int e = 16 * w + 4 * fq + j, d = 16 * dt + fr; oF[e * 64 + d] = aF[dt][j]; oB[e * 64 + d] = aB[dt][j]; }
    }
}
__device__ __forceinline__ void ret_out_phase(LAS unsigned char* lds, const bf16* proj, const float* gam, const float* ret_g, const float* rsp, bf16* ycat, const int tid, const int bid, const int G) {
    const int lane = tid & 63, w = RFL(tid >> 6), fr = lane & 15, fq = lane >> 4;
    LAS bf16* Qs = (LAS bf16*)lds; LAS bf16* Ks = Qs + 128 * RET_LD; LAS bf16* Vs = Ks + 128 * RET_LD; LAS bf16* Sf = Vs + 128 * RET_LD; LAS bf16* Sb = Sf + 64 * RET_LD;
    constexpr int NITEMS = BATCH * 8 * NC;
    for (int it = bid; it < NITEMS; it += G) {
        const int ch = it % NC, h = (it / NC) & 7, b = it / (NC * 8);
        const float lgf = logsigmoidf_(gam[h]), lgb = logsigmoidf_(gam[8 + h]);
        const size_t t0 = (size_t)b * SEQ + (size_t)ch * 128;
        const bf16* base = proj + t0 * NPROJ + OFF_A + h * 64;
        const float* gSf = rsp + ((size_t)((b * 8 + h) * 2 + 0) * NC + ch) * 4096; const float* gSb = rsp + ((size_t)((b * 8 + h) * 2 + 1) * NC + ch) * 4096;
        LBAR();
#pragma unroll
        for (int c = tid; c < 1024; c += 512) { const int m = c >> 3, cc = c & 7; const bf16* rp = base + (size_t)m * NPROJ + cc * 8;
            *(LAS v4u*)(Qs + m * RET_LD + cc * 8) = *(const GAS v4u*)(rp); *(LAS v4u*)(Ks + m * RET_LD + cc * 8) = *(const GAS v4u*)(rp + 512); *(LAS v4u*)(Vs + m * RET_LD + cc * 8) = *(const GAS v4u*)(rp + 1024); }
#pragma unroll
        for (int c = tid; c < 1024; c += 512) { const int e = c >> 4, d4 = (c & 15) * 4; const f32x4 a = *(const GAS f32x4*)(gSf + e * 64 + d4), bb = *(const GAS f32x4*)(gSb + e * 64 + d4);
            *(LAS v2u*)(Sf + e * RET_LD + d4) = (v2u){cvtpk(a.x, a.y), cvtpk(a.z, a.w)}; *(LAS v2u*)(Sb + e * RET_LD + d4) = (v2u){cvtpk(bb.x, bb.y), cvtpk(bb.z, bb.w)}; }
        LBAR();
        bf16x8 qf[2];
#pragma unroll
        for (int ks = 0; ks < 2; ++ks) qf[ks] = frag_row(Qs, RET_LD, 16 * w, 32 * ks, fr, fq);
        f32x4 sc[8];
#pragma unroll
        for (int kt = 0; kt < 8; ++kt) { sc[kt] = (f32x4){0.f, 0.f, 0.f, 0.f};
#pragma unroll
            for (int ks = 0; ks < 2; ++ks) sc[kt] = MMA16(frag_row(Ks, RET_LD, 16 * kt, 32 * ks, fr, fq), qf[ks], sc[kt]); }
        const int n = 16 * w + fr;
#pragma unroll
        for (int kt = 0; kt < 8; ++kt)
#pragma unroll
            for (int j = 0; j < 4; ++j) { const int m = 16 * kt + 4 * fq + j; sc[kt][j] *= m <= n ? FEXP(lgf * (float)(n - m)) : FEXP(lgb * (float)(m - n)); }
        f32x4 o[4], aF[4], aB[4];
#pragma unroll
        for (int et = 0; et < 4; ++et) { o[et] = (f32x4){0.f, 0.f, 0.f, 0.f}; aF[et] = o[et]; aB[et] = o[et]; }
#pragma unroll
        for (int u = 0; u < 4; ++u) {
            const bf16x8 pf = __builtin_bit_cast(bf16x8, (v4u){cvtpk(sc[2 * u][0], sc[2 * u][1]), cvtpk(sc[2 * u][2], sc[2 * u][3]), cvtpk(sc[2 * u + 1][0], sc[2 * u + 1][1]), cvtpk(sc[2 * u + 1][2], sc[2 * u + 1][3])});
#pragma unroll
            for (int et = 0; et < 4; ++et) { const s16x4 a = tr4(Vs, RET_LD, 32 * u + 4 * fq, 16 * et, fr), bq = tr4(Vs, RET_LD, 32 * u + 16 + 4 * fq, 16 * et, fr);
                o[et] = MMA16(((bf16x8){a[0], a[1], a[2], a[3], bq[0], bq[1], bq[2], bq[3]}), pf, o[et]); }
        }
#pragma unroll
        for (int et = 0; et < 4; ++et)
#pragma unroll
            for (int ks = 0; ks < 2; ++ks) { aF[et] = MMA16(frag_row(Sf, RET_LD, 16 * et, 32 * ks, fr, fq), qf[ks], aF[et]); aB[et] = MMA16(frag_row(Sb, RET_LD, 16 * et, 32 * ks, fr, fq), qf[ks], aB[et]); }
        const float qdf = FEXP(lgf * (float)(n + 1)), qdb = FEXP(lgb * (float)(128 - n));
        float mu = 0.f;
#pragma unroll
        for (int et = 0; et < 4; ++et)
#pragma unroll
            for (int j = 0; j < 4; ++j) { o[et][j] += qdf * aF[et][j] + qdb * aB[et][j]; mu += o[et][j]; }
        mu = xlane_sum4(mu, lane) * (1.f / 64.f);
        float var = 0.f;
#pragma unroll
        for (int et = 0; et < 4; ++et)
#pragma unroll
            for (int j = 0; j < 4; ++j) { const float dlt = o[et][j] - mu; var += dlt * dlt; }
        const float rstd = 1.f / sqrtf(xlane_sum4(var, lane) * (1.f / 64.f) + GN_EPS);
        const bf16* gp = proj + (t0 + n) * NPROJ + OFF_A + 1536 + h * 64 + 4 * fq; bf16* yp = ycat + (t0 + n) * 2048 + h * 64 + 4 * fq; const float* gg = ret_g + h * 64 + 4 * fq;
#pragma unroll
        for (int et = 0; et < 4; ++et) { const v2u gv = *(const GAS v2u*)(gp + 16 * et); const f32x4 gn = *(const GAS f32x4*)(gg + 16 * et);
            const float g0 = __builtin_bit_cast(float, gv.x << 16), g1 = __builtin_bit_cast(float, gv.x & 0xffff0000u), g2 = __builtin_bit_cast(float, gv.y << 16), g3 = __builtin_bit_cast(float, gv.y & 0xffff0000u);
            const float y0 = siluf_(g0) * ((o[et][0] - mu) * rstd * gn.x), y1 = siluf_(g1) * ((o[et][1] - mu) * rstd * gn.y), y2 = siluf_(g2) * ((o[et][2] - mu) * rstd * gn.z), y3 = siluf_(g3) * ((o[et][3] - mu) * rstd * gn.w);
            *(GAS v2u*)(yp + 16 * et) = (v2u){cvtpk(y0, y1), cvtpk(y2, y3)}; }
    }
}
constexpr int SGU_LDV = 72, SGU_LDW = 136, SGU_TEAM_BYTES = (128 * SGU_LDV + 128 * SGU_LDW) * 2;
static_assert(2 * SGU_TEAM_BYTES <= RING_BYTES, "SGU LDS");
__device__ __forceinline__ void sgu_phase(LAS unsigned char* lds, const bf16* proj, const float* sgu_w, const float* sgu_bias, bf16* ycat, const int tid, const int bid, const int G) {
    const int lane = tid & 63, wave = RFL(tid >> 6), team = wave >> 2, w = wave & 3, tt = tid & 255, fr = lane & 15, fq = lane >> 4;
    LAS bf16* Vn = (LAS bf16*)(lds + team * SGU_TEAM_BYTES); LAS bf16* Ws = Vn + 128 * SGU_LDV;
    constexpr int NITEMS = BATCH * NC * 8;
    for (int it0 = bid * 2; it0 < NITEMS; it0 += G * 2) {
        const int it = it0 + team; const int bc = it % (BATCH * NC), g = it / (BATCH * NC);
        const size_t t0 = (size_t)bc * 128;
        const bf16* vb = proj + t0 * NPROJ + OFF_C + 512 + g * 64; const float* wsrc = sgu_w + (size_t)g * 128 * 128;
        LBAR();
#pragma unroll
        for (int c = tt; c < 1024; c += 256) { const int q = c >> 3, cc = c & 7; *(LAS v4u*)(Vn + q * SGU_LDV + cc * 8) = *(const GAS v4u*)(vb + (size_t)q * NPROJ + cc * 8); }
#pragma unroll
        for (int c = tt; c < 4096; c += 256) { const int p = c >> 5, q4 = (c & 31) * 4; const f32x4 a = *(const GAS f32x4*)(wsrc + p * 128 + q4); *(LAS v2u*)(Ws + p * SGU_LDW + q4) = (v2u){cvtpk(a.x, a.y), cvtpk(a.z, a.w)}; }
        LBAR();
        f32x4 acc[2][4];
#pragma unroll
        for (int i = 0; i < 2; ++i)
#pragma unroll
            for (int dt = 0; dt < 4; ++dt) acc[i][dt] = (f32x4){0.f, 0.f, 0.f, 0.f};
#pragma unroll
        for (int ks = 0; ks < 4; ++ks) { bf16x8 a[4];
#pragma unroll
            for (int dt = 0; dt < 4; ++dt) a[dt] = frag_col(Vn, SGU_LDV, 32 * ks, 16 * dt, fr, fq);
#pragma unroll
            for (int i = 0; i < 2; ++i) { const bf16x8 bfr = frag_row(Ws, SGU_LDW, 16 * (2 * w + i), 32 * ks, fr, fq);
#pragma unroll
                for (int dt = 0; dt < 4; ++dt) acc[i][dt] = MMA16(a[dt], bfr, acc[i][dt]); } }
#pragma unroll
        for (int i = 0; i < 2; ++i) { const int p = 16 * (2 * w + i) + fr; const float bias = sgu_bias[g * 128 + p];
            const bf16* up = proj + (t0 + p) * NPROJ + OFF_C + g * 64 + 4 * fq; bf16* yp = ycat + (t0 + p) * 2048 + 1024 + g * 64 + 4 * fq;
#pragma unroll
            for (int dt = 0; dt < 4; ++dt) { const v2u uv = *(const GAS v2u*)(up + 16 * dt);
                const float u0 = __builtin_bit_cast(float, uv.x << 16), u1 = __builtin_bit_cast(float, uv.x & 0xffff0000u), u2 = __builtin_bit_cast(float, uv.y << 16), u3 = __builtin_bit_cast(float, uv.y & 0xffff0000u);
                *(GAS v2u*)(yp + 16 * dt) = (v2u){cvtpk(geluf_(u0) * (acc[i][dt][0] + bias), geluf_(u1) * (acc[i][dt][1] + bias)), cvtpk(geluf_(u2) * (acc[i][dt][2] + bias), geluf_(u3) * (acc[i][dt][3] + bias))}; } }
    }
}

constexpr int LO_LDL = 456, LO_LDW = 72, LO_LIN_B = 64 * LO_LDL * 2, LO_W2_B = 96 * LO_LDW * 2, LO_G2_B = 256 * LO_LDW * 2;
static_assert(LO_LIN_B + 2 * LO_W2_B + LO_G2_B <= RING_BYTES, "LoRA LDS");
__device__ __forceinline__ void rwkv_lora_phase(LAS unsigned char* lds, const Ctx& c, const int tid, const int bid, const int G) {
    const int lane = tid & 63, wave = RFL(tid >> 6), tt = wave & 3, chh = wave >> 2, fr = lane & 15, fq = lane >> 4;
    LAS bf16* LIN = (LAS bf16*)lds; LAS bf16* W2s = (LAS bf16*)(lds + LO_LIN_B); LAS bf16* A2s = (LAS bf16*)(lds + LO_LIN_B + LO_W2_B); LAS bf16* G2s = (LAS bf16*)(lds + LO_LIN_B + 2 * LO_W2_B);
    for (int blk = bid; blk < T / 64; blk += G) {
        const size_t t0 = (size_t)blk * 64;
        LBAR();
        for (int q = tid; q < 64 * 56; q += 512) { const int r = q / 56, cc = q % 56; *(LAS v4u*)(LIN + r * LO_LDL + cc * 8) = *(const GAS v4u*)(c.lin + (t0 + r) * NLORA + cc * 8); }
        v2u pw2[3], pa2[3], pg2[8];
#define LO_LOADW(h_) do { _Pragma("unroll") for (int u = 0; u < 3; ++u) { const int q_ = tid + 512 * u, i_ = q_ >> 4, c4_ = (q_ & 15) * 4; pw2[u] = *(const GAS v2u*)(c.loraw + (size_t)i_ * 512 + (h_) * 64 + c4_); pa2[u] = *(const GAS v2u*)(c.loraw + (size_t)(96 + i_) * 512 + (h_) * 64 + c4_); } \
        _Pragma("unroll") for (int u = 0; u < 8; ++u) { const int q_ = tid + 512 * u, i_ = q_ >> 4, c4_ = (q_ & 15) * 4; pg2[u] = *(const GAS v2u*)(c.loraw + (size_t)(192 + i_) * 512 + (h_) * 64 + c4_); } } while (0)
        LO_LOADW(0);
        for (int h = 0; h < 8; ++h) {
            if (h > 0) LBAR();
#pragma unroll
            for (int u = 0; u < 3; ++u) { const int q = tid + 512 * u, i = q >> 4, c4 = (q & 15) * 4;
                *(LAS v2u*)(W2s + i * LO_LDW + c4) = pw2[u]; *(LAS v2u*)(A2s + i * LO_LDW + c4) = pa2[u]; }
#pragma unroll
            for (int u = 0; u < 8; ++u) { const int q = tid + 512 * u, i = q >> 4, c4 = (q & 15) * 4; *(LAS v2u*)(G2s + i * LO_LDW + c4) = pg2[u]; }
            LBAR();
            if (h < 7) LO_LOADW(h + 1);
            f32x4 aw[2], aa[2], ag[2];
#pragma unroll
            for (int ct = 0; ct < 2; ++ct) { aw[ct] = (f32x4){0.f, 0.f, 0.f, 0.f}; aa[ct] = aw[ct]; ag[ct] = aw[ct]; }
#pragma unroll
            for (int ks = 0; ks < 3; ++ks) { const bf16x8 fw = frag_row(LIN, LO_LDL, 16 * tt, 32 * ks, fr, fq), fa = frag_row(LIN, LO_LDL, 16 * tt, 96 + 32 * ks, fr, fq);
#pragma unroll
                for (int ct = 0; ct < 2; ++ct) { aw[ct] = MMA16(frag_col(W2s, LO_LDW, 32 * ks, 32 * chh + 16 * ct, fr, fq), fw, aw[ct]); aa[ct] = MMA16(frag_col(A2s, LO_LDW, 32 * ks, 32 * chh + 16 * ct, fr, fq), fa, aa[ct]); } }
#pragma unroll
            for (int ks = 0; ks < 8; ++ks) { const bf16x8 fg = frag_row(LIN, LO_LDL, 16 * tt, 192 + 32 * ks, fr, fq);
#pragma unroll
                for (int ct = 0; ct < 2; ++ct) ag[ct] = MMA16(frag_col(G2s, LO_LDW, 32 * ks, 32 * chh + 16 * ct, fr, fq), fg, ag[ct]); }
#pragma unroll
            for (int ct = 0; ct < 2; ++ct) { const int ch0 = h * 64 + 32 * chh + 16 * ct + 4 * fq; const size_t o = (t0 + 16 * tt + fr) * 512 + ch0;
                *(GAS v2u*)(c.gg + o) = (v2u){cvtpk(ag[ct][0], ag[ct][1]), cvtpk(ag[ct][2], ag[ct][3])};
                *(GAS v2u*)(c.kdf + o) = (v2u){cvtpk(aw[ct][0], aw[ct][1]), cvtpk(aw[ct][2], aw[ct][3])};
                *(GAS v2u*)(c.kdb + o) = (v2u){cvtpk(aa[ct][0], aa[ct][1]), cvtpk(aa[ct][2], aa[ct][3])}; }
        }
    }
}

constexpr int RWC = 32, RW_NCH = SEQ / RWC, RW_LD = 72, RW_LS = 40, RW_IN_B = 32 * RW_LD * 2, RW_SM_B = 32 * RW_LS * 2;
constexpr int RW_AH = 0, RW_BC = RW_IN_B, RW_KC = 2 * RW_IN_B, RW_RH = 3 * RW_IN_B, RW_BT = 4 * RW_IN_B, RW_KT = 5 * RW_IN_B, RW_VV = 6 * RW_IN_B, RW_M1 = 7 * RW_IN_B, RW_WW = 8 * RW_IN_B, RW_UL = 9 * RW_IN_B,
              RW_XA = 10 * RW_IN_B, RW_XB = RW_XA + RW_SM_B, RW_T0 = RW_XB + RW_SM_B, RW_T1 = RW_T0 + RW_SM_B, RW_AAK = RW_T1 + RW_SM_B, RW_ARB = RW_AAK + RW_SM_B, RW_ARK = RW_ARB + RW_SM_B, RW_SEG = RW_ARK + RW_SM_B,
              RW_TEAM_BYTES = RW_SEG + 4 * 64 * 4;
static_assert(2 * RW_TEAM_BYTES <= RING_BYTES, "RWKV chunk LDS");
__device__ __forceinline__ void st_tile_bf16(LAS bf16* X, int ld, int r0, int c0, const f32x4 v, int fr, int fq) {
#pragma unroll
    for (int j = 0; j < 4; j += 2) { const unsigned p = cvtpk(v[j], v[j + 1]); X[(r0 + 4 * fq + j) * ld + c0 + fr] = (bf16)p; X[(r0 + 4 * fq + j + 1) * ld + c0 + fr] = (bf16)(p >> 16); } }
__device__ __forceinline__ void rwkv_chunk_phase(LAS unsigned char* lds, const Ctx& c, unsigned char* ws, const int tid, const int bid, const int G) {
    const int lane = tid & 63, wave = RFL(tid >> 6), team = wave >> 2, w = wave & 3, tt = tid & 255, fr = lane & 15, fq = lane >> 4;
    LAS unsigned char* L = lds + team * RW_TEAM_BYTES;
    LAS bf16* AH = (LAS bf16*)(L + RW_AH); LAS bf16* BC = (LAS bf16*)(L + RW_BC); LAS bf16* KC = (LAS bf16*)(L + RW_KC); LAS bf16* RH = (LAS bf16*)(L + RW_RH); LAS bf16* BT = (LAS bf16*)(L + RW_BT);
    LAS bf16* KT = (LAS bf16*)(L + RW_KT); LAS bf16* VV = (LAS bf16*)(L + RW_VV); LAS bf16* M1 = (LAS bf16*)(L + RW_M1); LAS bf16* WW = (LAS bf16*)(L + RW_WW); LAS bf16* UL = (LAS bf16*)(L + RW_UL);
    LAS bf16* XA = (LAS bf16*)(L + RW_XA); LAS bf16* XB = (LAS bf16*)(L + RW_XB); LAS bf16* T0 = (LAS bf16*)(L + RW_T0); LAS bf16* T1 = (LAS bf16*)(L + RW_T1);
    LAS bf16* AAK = (LAS bf16*)(L + RW_AAK); LAS bf16* ARB = (LAS bf16*)(L + RW_ARB); LAS bf16* ARK = (LAS bf16*)(L + RW_ARK); LAS float* SEG = (LAS float*)(L + RW_SEG);
    bf16* gRB = (bf16*)(ws + WS_RB); bf16* gPT = (bf16*)(ws + WS_PT); bf16* gQF = (bf16*)(ws + WS_QF); bf16* gYL = (bf16*)(ws + WS_YL); float* gDC = (float*)(ws + WS_DC);
#ifdef RW_EMU_LIMIT
    constexpr int NITEMS = RW_EMU_LIMIT;
#else
    constexpr int NITEMS = BATCH * 16 * RW_NCH;
#endif
    const int it_ = w >> 1, jt_ = w & 1;
    const int ch = tt & 63, seg = tt >> 6;
    float lwv[8]; unsigned ksr[8], wlr[8], alr[8], rsr[8], vsr[8]; float cw0 = 0.f, ca0 = 0.f, cka = 0.f, ckk = 0.f;
#define RW_LOAD_RAW(item_) do { const int cc_ = (item_) % RW_NCH, unit_ = (item_) / RW_NCH, dir_ = unit_ & 1, h_ = (unit_ >> 1) & 7, b_ = unit_ >> 4; const size_t tb_ = (size_t)b_ * SEQ + (size_t)cc_ * RWC; \
        cw0 = c.w0[dir_ * 512 + h_ * 64 + ch]; ca0 = c.a0[dir_ * 512 + h_ * 64 + ch]; cka = c.k_a[h_ * 64 + ch]; ckk = c.k_k[h_ * 64 + ch]; \
        _Pragma("unroll") for (int r = 0; r < 8; ++r) { const int i_ = 8 * seg + r; const unsigned o_ = ((unsigned)tb_ + (unsigned)(dir_ ? 31 - i_ : i_)) * 512u + (unsigned)(h_ * 64 + ch); \
            ksr[r] = ((const GAS bf16*)c.ks)[o_]; wlr[r] = ((const GAS bf16*)c.kdf)[o_]; alr[r] = ((const GAS bf16*)c.kdb)[o_]; rsr[r] = ((const GAS bf16*)c.rs)[o_]; vsr[r] = ((const GAS bf16*)c.vs)[o_]; } } while (0)
    if (bid * 2 < NITEMS) RW_LOAD_RAW(bid * 2 + team);
    for (int it0 = bid * 2; it0 < NITEMS; it0 += G * 2) {
        const int item = it0 + team;
        LBAR();
        {
            float g[8], kv[8], av[8], kraw[8], ksq[8]; float run = 0.f;
#pragma unroll
            for (int r = 0; r < 8; ++r) { lwv[r] = -0.6065306597126334f * __builtin_amdgcn_rcpf(1.f + FEXP(-(cw0 + __builtin_bit_cast(float, wlr[r] << 16)))); run += lwv[r]; g[r] = run; }
            SEG[seg * 64 + ch] = run;
#pragma unroll
            for (int r = 0; r < 8; ++r) { kv[r] = __builtin_bit_cast(float, ksr[r] << 16); av[r] = __builtin_amdgcn_rcpf(1.f + FEXP(-(ca0 + __builtin_bit_cast(float, alr[r] << 16)))); kraw[r] = kv[r] * ckk; ksq[r] = kraw[r] * kraw[r]; }
#pragma unroll
            for (int o = 1; o < 64; o <<= 1) { float t_[8];
#pragma unroll
                for (int r = 0; r < 8; ++r) t_[r] = __builtin_bit_cast(float, __builtin_amdgcn_ds_bpermute((lane ^ o) << 2, __builtin_bit_cast(int, ksq[r])));
#pragma unroll
                for (int r = 0; r < 8; ++r) ksq[r] += t_[r]; }
            LBAR();
            float off = 0.f, GC = 0.f;
#pragma unroll
            for (int s2 = 0; s2 < 4; ++s2) { const float v = SEG[s2 * 64 + ch]; off += s2 < seg ? v : 0.f; GC += v; }
            const float eGC = FEXP(GC);
            if (seg == 0) gDC[(size_t)item * 64 + ch] = eGC;
            float ePrev = FEXP(off);
#pragma unroll
            for (int r = 0; r < 8; r += 2) { float oa[2], ob[2], ok[2], orr[2], obt[2], okt[2];
#pragma unroll
                for (int u = 0; u < 2; ++u) { const int q = r + u;
                    const float eG = FEXP(off + g[q]), eI = __builtin_amdgcn_rcpf(eG), eM = ePrev, eC = eGC * eI; ePrev = eG;
                    const float kk = kraw[q] * __builtin_amdgcn_rsqf(ksq[q] + 1e-12f);
                    const float be = av[q] * kk, kt = kv[q] * (1.f + (av[q] - 1.f) * cka), rr = __builtin_bit_cast(float, rsr[q] << 16);
                    oa[u] = -kk * eM; ob[u] = be * eI; ok[u] = kt * eI; orr[u] = rr * eG; obt[u] = be * eC; okt[u] = kt * eC; }
                const int i = 8 * seg + r; const unsigned pa = cvtpk(oa[0], oa[1]), pb = cvtpk(ob[0], ob[1]), pk = cvtpk(ok[0], ok[1]), pr = cvtpk(orr[0], orr[1]), pbt = cvtpk(obt[0], obt[1]), pkt = cvtpk(okt[0], okt[1]);
                AH[i * RW_LD + ch] = (bf16)pa; AH[(i + 1) * RW_LD + ch] = (bf16)(pa >> 16); BC[i * RW_LD + ch] = (bf16)pb; BC[(i + 1) * RW_LD + ch] = (bf16)(pb >> 16);
                KC[i * RW_LD + ch] = (bf16)pk; KC[(i + 1) * RW_LD + ch] = (bf16)(pk >> 16); RH[i * RW_LD + ch] = (bf16)pr; RH[(i + 1) * RW_LD + ch] = (bf16)(pr >> 16);
                BT[i * RW_LD + ch] = (bf16)pbt; BT[(i + 1) * RW_LD + ch] = (bf16)(pbt >> 16); KT[i * RW_LD + ch] = (bf16)pkt; KT[(i + 1) * RW_LD + ch] = (bf16)(pkt >> 16);
                VV[i * RW_LD + ch] = (bf16)vsr[r]; VV[(i + 1) * RW_LD + ch] = (bf16)vsr[r + 1]; }
        }
        if (it0 + G * 2 < NITEMS) RW_LOAD_RAW(it0 + G * 2 + team);
        LBAR();
        {
            const LAS bf16* As = w < 2 ? AH : RH; const LAS bf16* Bs = (w & 1) ? KC : BC; LAS bf16* D = w == 0 ? XA : (w == 1 ? AAK : (w == 2 ? ARB : ARK));
#pragma unroll
            for (int it = 0; it < 2; ++it)
#pragma unroll
                for (int jt = 0; jt < 2; ++jt) { f32x4 a = (f32x4){0.f, 0.f, 0.f, 0.f};
#pragma unroll
                    for (int ks = 0; ks < 2; ++ks) a = MMA16(frag_row(As, RW_LD, 16 * it, 32 * ks, fr, fq), frag_row(Bs, RW_LD, 16 * jt, 32 * ks, fr, fq), a);
#pragma unroll
                    for (int j = 0; j < 4; ++j) { const int i = 16 * it + 4 * fq + j, jj = 16 * jt + fr; const bool keep = w < 2 ? jj < i : jj <= i; a[j] = keep ? a[j] : 0.f; }
                    st_tile_bf16(D, RW_LS, 16 * it, 16 * jt, a, fr, fq); }
        }
        LBAR();
        f32x4 Tacc;
        {
            const f32x4 x2 = MMA16(frag_row(XA, RW_LS, 16 * it_, 0, fr, fq), frag_col(XA, RW_LS, 0, 16 * jt_, fr, fq), ((f32x4){0.f, 0.f, 0.f, 0.f}));
            st_tile_bf16(XB, RW_LS, 16 * it_, 16 * jt_, x2, fr, fq);
#pragma unroll
            for (int j = 0; j < 4; ++j) { const int i = 16 * it_ + 4 * fq + j, jj = 16 * jt_ + fr; Tacc[j] = bf2f(XA[i * RW_LS + jj]) + (i == jj ? 1.f : 0.f); }
            st_tile_bf16(T0, RW_LS, 16 * it_, 16 * jt_, Tacc, fr, fq);
#pragma unroll
            for (int q = 0; q < 2; ++q) { const int et = 2 * jt_ + q; const f32x4 m1 = MMA16(frag_row(AAK, RW_LS, 16 * it_, 0, fr, fq), frag_col(VV, RW_LD, 0, 16 * et, fr, fq), ((f32x4){0.f, 0.f, 0.f, 0.f}));
                st_tile_bf16(M1, RW_LD, 16 * it_, 16 * et, m1, fr, fq); }
        }
        LBAR();
#define RW_CHAIN(TR, TW, XR, XW, SQUARE) { Tacc = MMA16(frag_row(TR, RW_LS, 16 * it_, 0, fr, fq), frag_col(XR, RW_LS, 0, 16 * jt_, fr, fq), Tacc); st_tile_bf16(TW, RW_LS, 16 * it_, 16 * jt_, Tacc, fr, fq); \
        if (SQUARE) { const f32x4 xx = MMA16(frag_row(XR, RW_LS, 16 * it_, 0, fr, fq), frag_col(XR, RW_LS, 0, 16 * jt_, fr, fq), ((f32x4){0.f, 0.f, 0.f, 0.f})); st_tile_bf16(XW, RW_LS, 16 * it_, 16 * jt_, xx, fr, fq); } \
        LBAR(); }
        RW_CHAIN(T0, T1, XB, XA, true)
        RW_CHAIN(T1, T0, XA, XB, true)
        RW_CHAIN(T0, T1, XB, XA, true)
        RW_CHAIN(T1, T0, XA, XB, false)
#undef RW_CHAIN
        {
            const bf16x8 tf = frag_row(T0, RW_LS, 16 * it_, 0, fr, fq);
#pragma unroll
            for (int q = 0; q < 2; ++q) { const int ct = 2 * jt_ + q;
                st_tile_bf16(WW, RW_LD, 16 * it_, 16 * ct, MMA16(tf, frag_col(AH, RW_LD, 0, 16 * ct, fr, fq), ((f32x4){0.f, 0.f, 0.f, 0.f})), fr, fq);
                st_tile_bf16(UL, RW_LD, 16 * it_, 16 * ct, MMA16(tf, frag_col(M1, RW_LD, 0, 16 * ct, fr, fq), ((f32x4){0.f, 0.f, 0.f, 0.f})), fr, fq); }
        }
        LBAR();
        {
            const bf16x8 wcol = frag_col(WW, RW_LD, 0, 16 * w, fr, fq), ulc = frag_col(UL, RW_LD, 0, 16 * w, fr, fq), vvc = frag_col(VV, RW_LD, 0, 16 * w, fr, fq);
            bf16* pt = gPT + (size_t)item * 4096; bf16* qf = gQF + (size_t)item * 4096; bf16* rb = gRB + (size_t)item * 2048; bf16* yl = gYL + (size_t)item * 2048;
#pragma unroll
            for (int kq = 0; kq < 4; ++kq) { const bf16x8 btc = frag_col(BT, RW_LD, 0, 16 * kq, fr, fq), ktc = frag_col(KT, RW_LD, 0, 16 * kq, fr, fq);
                const f32x4 p = MMA16(wcol, btc, ((f32x4){0.f, 0.f, 0.f, 0.f}));
                *(GAS v2u*)(pt + ((kq * 2 + (w >> 1)) * 64 + lane) * 8 + (w & 1) * 4) = (v2u){cvtpk(p[0], p[1]), cvtpk(p[2], p[3])};
                f32x4 q = MMA16(btc, ulc, ((f32x4){0.f, 0.f, 0.f, 0.f})); q = MMA16(ktc, vvc, q);
                *(GAS v2u*)(qf + ((w * 4 + kq) * 64 + lane) * 4) = (v2u){cvtpk(q[0], q[1]), cvtpk(q[2], q[3])}; }
#pragma unroll
            for (int it = 0; it < 2; ++it) { const bf16x8 arb = frag_row(ARB, RW_LS, 16 * it, 0, fr, fq), ark = frag_row(ARK, RW_LS, 16 * it, 0, fr, fq);
                const f32x4 r = MMA16(wcol, arb, ((f32x4){0.f, 0.f, 0.f, 0.f}));
                const v2u rh = *(const LAS v2u*)(RH + (16 * it + fr) * RW_LD + 16 * w + 4 * fq);
                const float r0 = r[0] + __builtin_bit_cast(float, rh.x << 16), r1 = r[1] + __builtin_bit_cast(float, rh.x & 0xffff0000u), r2 = r[2] + __builtin_bit_cast(float, rh.y << 16), r3 = r[3] + __builtin_bit_cast(float, rh.y & 0xffff0000u);
                *(GAS v2u*)(rb + ((it * 2 + (w >> 1)) * 64 + lane) * 8 + (w & 1) * 4) = (v2u){cvtpk(r0, r1), cvtpk(r2, r3)};
                f32x4 y = MMA16(arb, ulc, ((f32x4){0.f, 0.f, 0.f, 0.f})); y = MMA16(ark, vvc, y);
                *(GAS v2u*)(yl + ((it * 4 + w) * 64 + lane) * 4) = (v2u){cvtpk(y[0], y[1]), cvtpk(y[2], y[3])}; }
        }
    }
}
struct RwS { v4u pt[4][2]; v2u q[4]; f32x4 dc[4]; };
__device__ __forceinline__ void rws_load(RwS& s, const unsigned char* ws, int item, int vb, int lane, int fr, int fq) {
    const bf16* pt = (const bf16*)(ws + WS_PT) + (size_t)item * 4096; const bf16* qf = (const bf16*)(ws + WS_QF) + (size_t)item * 4096; const float* dc = (const float*)(ws + WS_DC) + (size_t)item * 64;
#pragma unroll
    for (int kq = 0; kq < 4; ++kq) {
#pragma unroll
        for (int ks = 0; ks < 2; ++ks) s.pt[kq][ks] = *(const GAS v4u*)(pt + ((kq * 2 + ks) * 64 + lane) * 8);
        s.q[kq] = *(const GAS v2u*)(qf + ((vb * 4 + kq) * 64 + lane) * 4); s.dc[kq] = *(const GAS f32x4*)(dc + 16 * kq + 4 * fq); }
}
constexpr int RWS_RING = 8, RWS_SLOT_B = 4 * 64 * 8, RWS_RING_B = RWS_RING * RWS_SLOT_B;
__device__ __forceinline__ unsigned lds_ld(const LAS unsigned* p) { return __hip_atomic_load(p, __ATOMIC_RELAXED, __HIP_MEMORY_SCOPE_WORKGROUP); }
__device__ __forceinline__ void lds_st(LAS unsigned* p, unsigned v) { __hip_atomic_store(p, v, __ATOMIC_RELAXED, __HIP_MEMORY_SCOPE_WORKGROUP); }
__device__ __forceinline__ void rws_step(const RwS& s, f32x4 (&S)[4], LAS unsigned char* ring, LAS unsigned* prog, const LAS unsigned* done, int step, int lane) {
    v2u sp[4];
    if (step >= RWS_RING) { while (lds_ld(done) + RWS_RING <= (unsigned)step) __builtin_amdgcn_s_sleep(1); }
#pragma unroll
    for (int kq = 0; kq < 4; ++kq) { sp[kq] = (v2u){cvtpk(S[kq][0], S[kq][1]), cvtpk(S[kq][2], S[kq][3])}; *(LAS v2u*)(ring + (step % RWS_RING) * RWS_SLOT_B + (kq * 64 + lane) * 8) = sp[kq]; }
    LDS_WAIT_();
    if (lane == 0) lds_st(prog, (unsigned)step + 1u);
#pragma unroll
    for (int kq = 0; kq < 4; ++kq) { f32x4 a;
        a[0] = S[kq][0] * s.dc[kq][0] + __builtin_bit_cast(float, s.q[kq].x << 16); a[1] = S[kq][1] * s.dc[kq][1] + __builtin_bit_cast(float, s.q[kq].x & 0xffff0000u);
        a[2] = S[kq][2] * s.dc[kq][2] + __builtin_bit_cast(float, s.q[kq].y << 16); a[3] = S[kq][3] * s.dc[kq][3] + __builtin_bit_cast(float, s.q[kq].y & 0xffff0000u);
#pragma unroll
        for (int ks = 0; ks < 2; ++ks) a = MMA16(__builtin_bit_cast(bf16x8, s.pt[kq][ks]), __builtin_bit_cast(bf16x8, (v4u){sp[2 * ks].x, sp[2 * ks].y, sp[2 * ks + 1].x, sp[2 * ks + 1].y}), a);
        S[kq] = a; }
}
__device__ __forceinline__ void rwkv_sscan_phase(LAS unsigned char* lds, unsigned char* ws, const int unit, const int vbase, const int wave, const int lane) {
    const int li = wave & 3; if (li >= 2) return;
    const int vb = vbase + li, fr = lane & 15, fq = lane >> 4, dir = unit & 1;
    LAS unsigned char* ring = lds + li * RWS_RING_B; LAS unsigned* prog = (LAS unsigned*)(lds + 4 * RWS_RING_B) + li * 16; LAS unsigned* done = prog + 8;
#define RW_CL(st) ((st) < RW_NCH ? (st) : RW_NCH - 1)
#define RW_ITEM(st) (unit * RW_NCH + (dir ? RW_NCH - 1 - RW_CL(st) : RW_CL(st)))
    if (wave >= 4) {
        for (int st = 0; st < RW_NCH; ++st) {
            while (lds_ld(prog) <= (unsigned)st) __builtin_amdgcn_s_sleep(1);
            bf16* dst = (bf16*)(ws + WS_ST) + (size_t)RW_ITEM(st) * 4096;
#pragma unroll
            for (int kq = 0; kq < 4; ++kq) *(GAS v2u*)(dst + ((vb * 4 + kq) * 64 + lane) * 4) = *(const LAS v2u*)(ring + (st % RWS_RING) * RWS_SLOT_B + (kq * 64 + lane) * 8);
            LDS_WAIT_();
            if (lane == 0) lds_st(done, (unsigned)st + 1u);
        }
        return;
    }
    f32x4 S[4];
#pragma unroll
    for (int kq = 0; kq < 4; ++kq) S[kq] = (f32x4){0.f, 0.f, 0.f, 0.f};
    RwS A, B, C;
    rws_load(A, ws, RW_ITEM(0), vb, lane, fr, fq); rws_load(B, ws, RW_ITEM(1), vb, lane, fr, fq);
#define RW_STEP3(st) do { rws_load(C, ws, RW_ITEM((st) + 2), vb, lane, fr, fq); rws_step(A, S, ring, prog, done, (st), lane); \
        rws_load(A, ws, RW_ITEM((st) + 3), vb, lane, fr, fq); rws_step(B, S, ring, prog, done, (st) + 1, lane); \
        rws_load(B, ws, RW_ITEM((st) + 4), vb, lane, fr, fq); rws_step(C, S, ring, prog, done, (st) + 2, lane); } while (0)
    constexpr int RW_MAIN = RW_NCH / 6 * 6, RW_MAIN3 = RW_NCH / 3 * 3;
#pragma unroll 1
    for (int st = 0; st < RW_MAIN; st += 6) { RW_STEP3(st); RW_STEP3(st + 3); }
#pragma unroll 1
    for (int st = RW_MAIN; st < RW_MAIN3; st += 3) RW_STEP3(st);
#undef RW_STEP3
    if (RW_NCH - RW_MAIN3 >= 1) rws_step(A, S, ring, prog, done, RW_MAIN3, lane);
    if (RW_NCH - RW_MAIN3 >= 2) rws_step(B, S, ring, prog, done, RW_MAIN3 + 1, lane);
#undef RW_ITEM
#undef RW_CL
}
__device__ __forceinline__ void rwkv_yfin_phase(LAS unsigned char* lds, const Ctx& c, const unsigned char* ws, const int tid, const int bid, const int G) {
    const int lane = tid & 63, wave = RFL(tid >> 6), fr = lane & 15, fq = lane >> 4; const int gw = bid * 8 + wave, NGW = G * 8;
    LAS float* Yt = (LAS float*)(lds + wave * 16384);
    for (int job = gw; job < BATCH * 8 * RW_NCH; job += NGW) {
        const int cc = job % RW_NCH, bh = job / RW_NCH, h = bh & 7, b = bh >> 3; const size_t tb = (size_t)b * SEQ + (size_t)cc * RWC;
        f32x4 y[2][4];
#pragma unroll
        for (int dir = 0; dir < 2; ++dir) { const int item = (bh * 2 + dir) * RW_NCH + cc;
            const bf16* rb = (const bf16*)(ws + WS_RB) + (size_t)item * 2048; const bf16* yl = (const bf16*)(ws + WS_YL) + (size_t)item * 2048; const bf16* st = (const bf16*)(ws + WS_ST) + (size_t)item * 4096;
#pragma unroll
            for (int it = 0; it < 2; ++it) {
                const int rt = dir ? 1 - it : it, rl = dir ? (15 - fr) + 16 * fq : lane;
                bf16x8 af[2];
#pragma unroll
                for (int ks = 0; ks < 2; ++ks) af[ks] = __builtin_bit_cast(bf16x8, *(const GAS v4u*)(rb + ((rt * 2 + ks) * 64 + rl) * 8));
#pragma unroll
                for (int vb = 0; vb < 4; ++vb) {
                    f32x4 a;
                    if (dir == 0) { const v2u w = *(const GAS v2u*)(yl + ((it * 4 + vb) * 64 + lane) * 4);
                        a = (f32x4){__builtin_bit_cast(float, w.x << 16), __builtin_bit_cast(float, w.x & 0xffff0000u), __builtin_bit_cast(float, w.y << 16), __builtin_bit_cast(float, w.y & 0xffff0000u)}; }
                    else { const v2u w = *(const GAS v2u*)(yl + (((1 - it) * 4 + vb) * 64 + fr + 16 * (3 - fq)) * 4);
                        a = y[it][vb]; a[0] += __builtin_bit_cast(float, w.y & 0xffff0000u); a[1] += __builtin_bit_cast(float, w.y << 16); a[2] += __builtin_bit_cast(float, w.x & 0xffff0000u); a[3] += __builtin_bit_cast(float, w.x << 16); }
#pragma unroll
                    for (int ks = 0; ks < 2; ++ks) { const v2u s0 = *(const GAS v2u*)(st + ((vb * 4 + 2 * ks) * 64 + lane) * 4), s1 = *(const GAS v2u*)(st + ((vb * 4 + 2 * ks + 1) * 64 + lane) * 4);
                        a = MMA16(af[ks], __builtin_bit_cast(bf16x8, (v4u){s0.x, s0.y, s1.x, s1.y}), a); }
                    y[it][vb] = a; } } }
#pragma unroll
        for (int it = 0; it < 2; ++it)
#pragma unroll
            for (int vb = 0; vb < 4; ++vb)
#pragma unroll
                for (int j = 0; j < 4; ++j) Yt[(16 * it + 4 * fq + j) * 68 + 16 * vb + fr] = y[it][vb][j];
        LDS_WAIT_();
#pragma unroll
        for (int q = 0; q < 4; ++q) { const int e = lane + 64 * q, r = e >> 3, cg8 = e & 7; const size_t o = (tb + r) * 512 + h * 64 + cg8 * 8;
            const f32x4 y0 = *(const LAS f32x4*)(Yt + r * 68 + cg8 * 8), y1 = *(const LAS f32x4*)(Yt + r * 68 + cg8 * 8 + 4); float yv[8] = {y0.x, y0.y, y0.z, y0.w, y1.x, y1.y, y1.z, y1.w};
            float rr[8], k[8], v[8], g[8]; unpack8(*(const GAS v4u*)(c.rs + o), rr); unpack8(*(const GAS v4u*)(c.ks + o), k); unpack8(*(const GAS v4u*)(c.vs + o), v); unpack8(*(const GAS v4u*)(c.gg + o), g);
            float s = 0.f, bon = 0.f;
#pragma unroll
            for (int i = 0; i < 8; ++i) { s += yv[i]; bon += rr[i] * k[i] * c.r_k[h * 64 + cg8 * 8 + i]; }
            const float mu = red8(s, lane) * (1.f / 64.f); bon = red8(bon, lane); float qv = 0.f;
#pragma unroll
            for (int i = 0; i < 8; ++i) { yv[i] -= mu; qv += yv[i] * yv[i]; }
            const float rstd = 1.f / sqrtf(red8(qv, lane) * (1.f / 64.f) + GN_EPS); float out[8];
#pragma unroll
            for (int i = 0; i < 8; ++i) out[i] = (yv[i] * rstd * c.ln_g[h * 64 + cg8 * 8 + i] + bon * v[i]) * g[i];
            st8(c.ycat + (tb + r) * 2048 + 512 + h * 64 + cg8 * 8, out); }
        LDS_WAIT_();
    }
}

__device__ __forceinline__ float quad_sum(float v) {
    v += __builtin_bit_cast(float, __builtin_amdgcn_update_dpp(0, __builtin_bit_cast(int, v), 0xB1, 0xF, 0xF, true));
    v += __builtin_bit_cast(float, __builtin_amdgcn_update_dpp(0, __builtin_bit_cast(int, v), 0x4E, 0xF, 0xF, true));
    return v;
}
__device__ __forceinline__ void rwkv_scan_quad(const Ctx& c, int unit, int w4, int lane) {
    const int dir = unit & 1, h = (unit >> 1) & 7, b = unit >> 4; const int row = w4 * 16 + (lane >> 2), q = lane & 3;
    const float* W = dir ? c.wb : c.wf; const bf16* KD = dir ? c.kdb : c.kdf; const bf16* AK = dir ? c.akb : c.akf; bf16* Y = dir ? c.yb : c.yf;
    float S[16];
#pragma unroll
    for (int i = 0; i < 16; ++i) S[i] = 0.f;
    for (int k = 0; k < SEQ; ++k) {
        const int s = dir ? SEQ - 1 - k : k; const size_t o = ((size_t)b * SEQ + s) * 512 + h * 64 + q * 16;
        float kkv[16], akv[16], kdv[16], rv[16], wv[16];
        { const v4u a = *(const GAS v4u*)(c.kk + o), bq = *(const GAS v4u*)(c.kk + o + 8);
          const unsigned t[8] = {a.x, a.y, a.z, a.w, bq.x, bq.y, bq.z, bq.w};
#pragma unroll
          for (int i = 0; i < 8; ++i) { kkv[2 * i] = __builtin_bit_cast(float, t[i] << 16); kkv[2 * i + 1] = __builtin_bit_cast(float, t[i] & 0xffff0000u); } }
        { const v4u a = *(const GAS v4u*)(AK + o), bq = *(const GAS v4u*)(AK + o + 8);
          const unsigned t[8] = {a.x, a.y, a.z, a.w, bq.x, bq.y, bq.z, bq.w};
#pragma unroll
          for (int i = 0; i < 8; ++i) { akv[2 * i] = __builtin_bit_cast(float, t[i] << 16); akv[2 * i + 1] = __builtin_bit_cast(float, t[i] & 0xffff0000u); } }
        { const v4u a = *(const GAS v4u*)(KD + o), bq = *(const GAS v4u*)(KD + o + 8);
          const unsigned t[8] = {a.x, a.y, a.z, a.w, bq.x, bq.y, bq.z, bq.w};
#pragma unroll
          for (int i = 0; i < 8; ++i) { kdv[2 * i] = __builtin_bit_cast(float, t[i] << 16); kdv[2 * i + 1] = __builtin_bit_cast(float, t[i] & 0xffff0000u); } }
        { const v4u a = *(const GAS v4u*)(c.rs + o), bq = *(const GAS v4u*)(c.rs + o + 8);
          const unsigned t[8] = {a.x, a.y, a.z, a.w, bq.x, bq.y, bq.z, bq.w};
#pragma unroll
          for (int i = 0; i < 8; ++i) { rv[2 * i] = __builtin_bit_cast(float, t[i] << 16); rv[2 * i + 1] = __builtin_bit_cast(float, t[i] & 0xffff0000u); } }
#pragma unroll
        for (int i = 0; i < 4; ++i) { const f32x4 w4v = *(const GAS f32x4*)(W + o + 4 * i); wv[4 * i] = w4v.x; wv[4 * i + 1] = w4v.y; wv[4 * i + 2] = w4v.z; wv[4 * i + 3] = w4v.w; }
        const float v = bf2f(c.vs[o - q * 16 + row]);
        float sk = 0.f;
#pragma unroll
        for (int i = 0; i < 16; ++i) sk += S[i] * kkv[i];
        sk = quad_sum(sk);
        float y = 0.f;
#pragma unroll
        for (int i = 0; i < 16; ++i) { S[i] = S[i] * wv[i] - sk * akv[i] + v * kdv[i]; y += S[i] * rv[i]; }
        y = quad_sum(y);
        if (q == 0) Y[o + row] = f2bf(y);
    }
}
constexpr int MOE_ITEMS_PER_E = 2 * (DM / 64) * (DE / 64) + (DE / 64) * (DM / 64);
template <int E_LO, int E_HI, bool WITH_D>
__device__ __forceinline__ void moe_convert(const Args& args, unsigned char* ws, int ll, LAS unsigned char* lds, int wave, int lane, int it0, int stride) {
    constexpr int I_GU = (DM / 64) * (DE / 64), I_D = (DE / 64) * (DM / 64), N_GU = (E_HI - E_LO) * 2 * I_GU, it_end = N_GU + (WITH_D ? NEXP * I_D : 0);
    bf16* WdT = (bf16*)(ws + WS_WD); LAS float* scr = (LAS float*)(lds + wave * 16384);
    const float* wg_ = (const float*)args.in[26] + (size_t)ll * NEXP * DM * DE; const float* wu_ = (const float*)args.in[27] + (size_t)ll * NEXP * DM * DE; const float* wd_ = (const float*)args.in[28] + (size_t)ll * NEXP * DE * DM;
#define MOE_ITEM(p, it_) do { \
        if ((it_) < N_GU) { const int e_ = E_LO + (it_) / (2 * I_GU); int r_ = (it_) % (2 * I_GU); const int up_ = r_ >= I_GU ? 1 : 0; r_ -= up_ * I_GU; const int kb_ = r_ % (DM / 64), n0_ = 64 * (r_ / (DM / 64));       \
            (p) = TrItem{(up_ ? wu_ : wg_) + (size_t)e_ * DM * DE, (bf16*)(ws + wgu_off(e_)), DM, DE, 64 * kb_, n0_, (n0_ >> 7) * 256 + (n0_ & 127) + up_ * 128}; } \
        else { const int jj_ = (it_) - N_GU, e_ = jj_ / I_D, r_ = jj_ % I_D; const int kb_ = r_ % (DE / 64), n0_ = 64 * (r_ / (DE / 64)); (p) = TrItem{wd_ + (size_t)e_ * DE * DM, WdT + (size_t)e_ * DM * DE, DE, DM, 64 * kb_, n0_, n0_}; } } while (0)
    f32x4 va[16]; TrItem pa, pb;
    int it = it0;
    if (it < it_end) { MOE_ITEM(pa, it); tr64_load(va, pa, lane); }
#pragma unroll 1
    while (it < it_end) {
        tr64_put(va, scr, lane);
        const int i1 = it + stride;
        if (i1 < it_end) { MOE_ITEM(pb, i1); tr64_load(va, pb, lane); }
        tr64_get(pa, scr, lane);
        pa = pb; it = i1;
    }
#undef MOE_ITEM
}
template <int KSEL>
__device__ __forceinline__ void layer_program(const Args& args, LAS unsigned char* lds, const XcdBarrier& bar, const int l) {
        PH_ON(0) {
            PHASE_LOCALS();
            bf16* WinT = (bf16*)(ws + WS_WIN); bf16* WoutT = (bf16*)(ws + WS_WOUT);
            LAS float* scr = (LAS float*)(lds + wave * 16384);
            const float* w_in = (const float*)args.in[3] + (size_t)ll * DM * D_IN; const float* w_out = (const float*)args.in[4] + (size_t)ll * DM * DM;
            constexpr int I_IN = (DM / 64) * (D_IN / 32), I_OUT = (DM / 64) * (DM / 32);
            constexpr int NITEMS = I_IN + I_OUT;
            for (int it = gw; it < NITEMS; it += NGW) {
                int r = it;
                if (r < I_IN) { const int nblk = D_IN / 32, kb = r / nblk, nb = r % nblk, n0 = 32 * nb;
                    const float sc = ((n0 >= OFF_A + 512 && n0 < OFF_A + 1024) || (n0 >= OFF_D_SRC && n0 < OFF_D_SRC + 512)) ? 0.125f : 1.f;
                    int drow0 = n0 + (n0 >= OFF_D_SRC ? OFF_D - OFF_D_SRC : 0), rmode = 0;
                    if (n0 < OFF_A + 1024) { drow0 = (n0 & ~63) + ((n0 >> 5) & 1); rmode = 1; }
                    else if (n0 >= OFF_D_SRC && n0 < OFF_D_SRC + 1024 && (((n0 - OFF_D_SRC) >> 5) & 1) == 0) rmode = 2;
                    transpose_item(w_in, DM, D_IN, WinT, 64 * kb, n0, drow0, scr, lane, sc, rmode); continue; } r -= I_IN;
                { const int nblk = DM / 32, kb = r / nblk, nb = r % nblk; transpose_item(w_out, DM, DM, WoutT, 64 * kb, 32 * nb, 32 * nb, scr, lane); }
            }
            for (long i = gtid; i < (long)(NPROJ - D_IN) * DM / 8; i += gstride) ((GAS v4u*)(WinT + (size_t)OFF_D_SRC * DM))[i] = (v4u){0u, 0u, 0u, 0u};
            if (ll == 0) { for (long i = gtid; i < (long)T * 40; i += gstride) v_rot_table((const int*)args.in[1], (float*)(ws + WS_ROT), i); }
            {   const float* wg = (const float*)args.in[22] + (size_t)ll * DM * 4; const float* we = (const float*)args.in[24] + (size_t)ll * DM * 32; float* rwt = (float*)(ws + WS_RWT);
                const float* n2g = (const float*)args.in[21] + ll * DM;
                for (long i = gtid; i < 48L * DM; i += gstride) { const int j = (int)(i & 3), ln = (int)((i >> 2) & 63), hh = (int)((i >> 8) & 1), r_ = (int)(i >> 9), tl = r_ % 3, S = r_ / 3;
                    const int k = 32 * S + 8 * (ln >> 4) + 4 * hh + j, col = 16 * tl + (ln & 15);
                    rwt[i] = (col < 32 ? we[(size_t)k * 32 + col] : (col < 36 ? wg[(size_t)k * 4 + col - 32] : 0.f)) * n2g[k]; } }
            {
                const float* w2_ = (const float*)args.in[9] + ll * 96 * 512; const float* a2_ = (const float*)args.in[11] + ll * 96 * 512; const float* g2_ = (const float*)args.in[12] + ll * 256 * 512; bf16* lw = (bf16*)(ws + WS_LORAW);
                for (long i = gtid; i < 448L * 512 / 4; i += gstride) { const long e = 4 * i; const int r = (int)(e / 512), cc = (int)(e % 512);
                    const f32x4 v = *(const GAS f32x4*)(r < 96 ? w2_ + (size_t)r * 512 + cc : (r < 192 ? a2_ + (size_t)(r - 96) * 512 + cc : g2_ + (size_t)(r - 192) * 512 + cc));
                    *(GAS v2u*)(lw + e) = (v2u){cvtpk(v.x, v.y), cvtpk(v.z, v.w)}; } }
            if (ll > 0) build_moe_tables(lds, (const unsigned*)(ws + WS_CTL) + CW_CNT + (ll - 1) * 2048, tid);
            const LAS int* trb = (const LAS int*)(lds + TAB_ROWBASE);
            const float* x_in = (const float*)args.in[0]; bf16* xbuf = (bf16*)(ws + WS_X); bf16* act = (bf16*)(ws + WS_ACT); const bf16* yp = (const bf16*)(ws + WS_YP);
            const unsigned* slot_tok = (const unsigned*)(ws + WS_SLOT); const float* gate_tok = (const float*)(ws + WS_GATE);
            const float* norm1_g = (const float*)args.in[2] + ll * DM;
            if (ll == 0) {
#pragma unroll 1
                for (int m0 = gw; m0 < T; m0 += 4 * NGW) rows_norm_f32<4>(x_in, norm1_g, act, m0, NGW, lane);
            } else {
#pragma unroll 1
                for (int m0 = gw; m0 < T; m0 += 2 * NGW) rows_moe<2, false>(xbuf, yp, slot_tok, gate_tok, trb, norm1_g, act, nullptr, 1.f, m0, NGW, lane);
            }
        }
        SEAM(0); TSTAMP_AFTER(0);
        PH_ON(1) {
            PHASE_LOCALS();
            const int G1 = G >= 256 ? GEMM1_G : G;
            if (bid < G1) {
                pg8::Gemm g{(const bf16*)(ws + WS_ACT), (const bf16*)(ws + WS_WIN), T, NPROJ, DM, 0, 0}; pg8::StaticOrder<T, NPROJ> S; S.init(G1, bid);
                pg8::EpiBf16Rot E{(bf16*)(ws + WS_PROJ), NPROJ, (const float*)(ws + WS_ROT)};
                pg8::gemm_phase<DM, pg8::EpiBf16Rot, pg8::StaticOrder<T, NPROJ>, true, true>(lds, g, S, E, tid);
            }
            if (G1 == G) { __syncthreads(); moe_convert<0, 16, false>(args, ws, ll, lds, wave, lane, gw, NGW); }
            else if (bid >= G1) moe_convert<0, 16, false>(args, ws, ll, lds, wave, lane, (bid - G1) * 8 + wave, (G - G1) * 8);
        }
        SEAM(1); TSTAMP_AFTER(1);
        PH_ON(2) { PHASE_LOCALS(); const Ctx c = make_ctx(args, ws, ll);
            {   constexpr unsigned NSH = (unsigned)T * 248u; const unsigned gs = (unsigned)gstride;
#pragma unroll 1
                for (unsigned base = (unsigned)gtid; base < NSH; base += 8u * gs) { ShiftIn in[8];
#pragma unroll
                    for (int u = 0; u < 8; ++u) { const unsigned idx = base + (unsigned)u * gs; if (idx < NSH) shift_load(c, idx, in[u]); }
#pragma unroll
                    for (int u = 0; u < 8; ++u) { const unsigned idx = base + (unsigned)u * gs; if (idx < NSH) shift_finish(c, idx, in[u]); } } }
#pragma unroll 1
            for (int m = gw; m < T; m += 4 * NGW) w_sgu_prep_batch<4>(c, m, NGW, lane); }
        SEAM(2); TSTAMP_AFTER(2);
        PH_ON(3) { PHASE_LOCALS(); const Ctx c = make_ctx(args, ws, ll);
            rwkv_lora_phase(lds, c, tid, bid, G);
            ret_kv_phase(lds, c.proj, c.gam, c.rkv, tid, bid, G);
            sgu_phase(lds, c.proj, c.sgu_w, c.sgu_bias, c.ycat, tid, bid, G);
            dil_attn_phase(lds, c.proj, (bf16*)(ws + WS_DPO), (float*)(ws + WS_DML), tid, bid, G); }
        SEAM(3); TSTAMP_AFTER(3);
        PH_ON(5) { PHASE_LOCALS(); const Ctx c = make_ctx(args, ws, ll);
            for (long i = gtid; i < (long)BATCH * 8 * 2 * 4096; i += gstride) el_ret_scan(c, i);
            rwkv_chunk_phase(lds, c, ws, tid, bid, G); }
        SEAM(5); TSTAMP_AFTER(5);
        PH_ON(13) { PHASE_LOCALS(); const Ctx c = make_ctx(args, ws, ll);
            constexpr int NU = BATCH * 16 * 2;
            if (bid < NU) { if (tid < 64) ((LAS unsigned*)(lds + 4 * RWS_RING_B))[tid] = 0u; __syncthreads(); rwkv_sscan_phase(lds, ws, bid >> 1, 2 * (bid & 1), wave, lane);
                __syncthreads(); moe_convert<16, 25, false>(args, ws, ll, lds, wave, lane, bid * 8 + wave, NU * 8); }
            else { ret_out_phase(lds, c.proj, c.gam, c.ret_g, c.rsp, c.ycat, tid, bid - NU, G - NU);
#pragma unroll 1
                for (long i = (long)(bid - NU) * 512 + tid; i < (long)T * 64; i += 4 * (long)(G - NU) * 512) v_dil_combine_batch<4>((const bf16*)(ws + WS_DPO), (const float*)(ws + WS_DML), c.ycat, i, (long)(G - NU) * 512, (long)T * 64);
 } }
        SEAM(13); TSTAMP_AFTER(13);
        PH_ON(6) { PHASE_LOCALS(); const Ctx c = make_ctx(args, ws, ll);
            rwkv_yfin_phase(lds, c, ws, tid, bid, G); }
        SEAM(6); TSTAMP_AFTER(6);
        PH_ON(7) {
            PHASE_LOCALS();
            pg8::Gemm g{(const bf16*)(ws + WS_ACT), (const bf16*)(ws + WS_WOUT), T, DM, DM, 0, 0}; pg8::StaticOrder<T, DM> S; S.init(G, bid);
            pg8::EpiResB E{ll == 0 ? (const float*)args.in[0] : nullptr, (const bf16*)(ws + WS_X), (bf16*)(ws + WS_X), DM};
            pg8::gemm_phase<DM, pg8::EpiResB, pg8::StaticOrder<T, DM>, true, true>(lds, g, S, E, tid);
        }
        SEAM(7); TSTAMP_AFTER(7);
        PH_ON(8) {
            PHASE_LOCALS();
            const float* wg = (const float*)args.in[22] + (size_t)ll * DM * 4; const float* bg = (const float*)args.in[23] + ll * 4;
            const float* we = (const float*)args.in[24] + (size_t)ll * DM * 32; const float* be = (const float*)args.in[25] + ll * 32;
            const float* norm2_g = (const float*)args.in[21] + ll * DM;
            const bf16* xbuf = (const bf16*)(ws + WS_X);
            unsigned* cnt_tab = (unsigned*)(ws + WS_TOK); unsigned* slot_tok = (unsigned*)(ws + WS_SLOT); float* gate_tok = (float*)(ws + WS_GATE); float* rstd_tok = (float*)(ws + WS_TOK + 256 * 1024);
            const float* rwt = (const float*)(ws + WS_RWT); const int fr = lane & 15, fq = lane >> 4;
            LAS float* SB = (LAS float*)lds;
            LAS float* lg_s = (LAS float*)(lds + 98304 + (wave & 3) * 4096);
            LAS unsigned* lcnt = (LAS unsigned*)(lds + 131072); LAS unsigned* lbase = lcnt + 32;
            static_assert(T / 16 % 4 == 0, "router tiles");
            for (int tile0 = bid; tile0 < T / 64; tile0 += G) { const int tile = tile0 + (T / 64) * (wave & 3); const bool wact = wave < 4;
                if (tid < 32) lcnt[tid] = 0u;
                __syncthreads();
              int e1 = 0, e2 = 0; float g1 = 0.f, g2 = 0.f; unsigned r1 = 0u, r2 = 0u; float rstd = 0.f; const size_t m0 = (size_t)tile * 16; const bf16* xr = xbuf + (m0 + fr) * DM;
              f32x4 acc[3]; float ss = 0.f;
              {
#pragma unroll
                for (int tl = 0; tl < 3; ++tl) acc[tl] = (f32x4){0.f, 0.f, 0.f, 0.f};
                const int hk = wave >> 2; f32x4 pst[6]; v4u xc[4], xn[4];
#define RT_SLOAD(s_) do { _Pragma("unroll") for (int u = 0; u < 6; ++u) { const int q_ = tid + 512 * (u % 3); pst[u] = *(const GAS f32x4*)(rwt + (size_t)(32 * (u / 3) + 4 * (s_)) * 1536 + 4 * q_); } } while (0)
#define RT_SPUT(buf_) do { _Pragma("unroll") for (int u = 0; u < 6; ++u) { const int q_ = tid + 512 * (u % 3); *(LAS f32x4*)(SB + ((buf_) * 2 + (u / 3)) * 6144 + 4 * q_) = pst[u]; } } while (0)
#define RT_XLOAD(xv, s_) do { _Pragma("unroll") for (int j_ = 0; j_ < 4; ++j_) (xv)[j_] = *(const GAS v4u*)(xr + 32 * (32 * hk + 4 * (s_) + j_) + 8 * fq); } while (0)
                RT_SLOAD(0); RT_XLOAD(xc, 0); RT_SPUT(0); __syncthreads();
#pragma unroll 1
                for (int sg = 0; sg < 8; ++sg) {
                    if (sg < 7) { RT_SLOAD(sg + 1); RT_XLOAD(xn, sg + 1); }
                    const LAS float* bs = SB + ((sg & 1) * 2 + hk) * 6144 + lane * 4;
#pragma unroll
                    for (int j_ = 0; j_ < 4; ++j_) { f32x4 xv[2];
                        xv[0] = (f32x4){__builtin_bit_cast(float, xc[j_].x << 16), __builtin_bit_cast(float, xc[j_].x & 0xffff0000u), __builtin_bit_cast(float, xc[j_].y << 16), __builtin_bit_cast(float, xc[j_].y & 0xffff0000u)};
                        xv[1] = (f32x4){__builtin_bit_cast(float, xc[j_].z << 16), __builtin_bit_cast(float, xc[j_].z & 0xffff0000u), __builtin_bit_cast(float, xc[j_].w << 16), __builtin_bit_cast(float, xc[j_].w & 0xffff0000u)};
#pragma unroll
                        for (int hh = 0; hh < 2; ++hh) { ss += (xv[hh].x * xv[hh].x + xv[hh].y * xv[hh].y) + (xv[hh].z * xv[hh].z + xv[hh].w * xv[hh].w);
#pragma unroll
                            for (int tl = 0; tl < 3; ++tl) { const f32x4 bv = *(const LAS f32x4*)(bs + j_ * 1536 + (tl * 2 + hh) * 256);
#pragma unroll
                                for (int jj = 0; jj < 4; ++jj) acc[tl] = __builtin_amdgcn_mfma_f32_16x16x4f32(xv[hh][jj], bv[jj], acc[tl], 0, 0, 0); } } }
                    if (sg < 7) RT_SPUT((sg + 1) & 1);
                    __syncthreads();
#pragma unroll
                    for (int j_ = 0; j_ < 4; ++j_) xc[j_] = xn[j_];
                }
#undef RT_SLOAD
#undef RT_SPUT
#undef RT_XLOAD
              }
              {   LAS float* part = (LAS float*)(lds + 114688 + (wave & 3) * 4096);
                if (!wact) {
#pragma unroll
                    for (int tl = 0; tl < 3; ++tl)
#pragma unroll
                        for (int j = 0; j < 4; ++j) part[(tl * 4 + j) * 64 + lane] = acc[tl][j];
                    part[12 * 64 + lane] = ss; }
                __syncthreads();
                if (wact) {
#pragma unroll
                    for (int tl = 0; tl < 3; ++tl)
#pragma unroll
                        for (int j = 0; j < 4; ++j) acc[tl][j] += part[(tl * 4 + j) * 64 + lane];
                    ss += part[12 * 64 + lane]; } }
              if (wact) {
                ss = xlane_sum4(ss, lane);
                rstd = 1.f / sqrtf(ss * (1.f / DM) + NORM_EPS);
#pragma unroll
                for (int tl = 0; tl < 3; ++tl)
#pragma unroll
                    for (int j = 0; j < 4; ++j) lg_s[(4 * fq + j) * 48 + 16 * tl + fr] = acc[tl][j];
                if (fq == 0) lg_s[768 + fr] = rstd;
                LDS_WAIT(); asm volatile("" ::: "memory");
                if (lane < 16) { const float rs_ = lg_s[768 + lane]; float lg[4], le[32];
#pragma unroll
                    for (int i = 0; i < 32; ++i) le[i] = lg_s[lane * 48 + i] * rs_;
#pragma unroll
                    for (int i = 0; i < 4; ++i) lg[i] = lg_s[lane * 48 + 32 + i] * rs_;
                    route_select(lg, le, bg, be, e1, e2, g1, g2);
                    r1 = __hip_atomic_fetch_add(lcnt + e1, 1u, __ATOMIC_RELAXED, __HIP_MEMORY_SCOPE_WORKGROUP); r2 = __hip_atomic_fetch_add(lcnt + e2, 1u, __ATOMIC_RELAXED, __HIP_MEMORY_SCOPE_WORKGROUP); }
              }
                __syncthreads();
                if (tid < 32) cnt_tab[tile0 * 32 + tid] = lcnt[tid];
              if (wact) {
                if (lane < 16) { const int m = (int)m0 + lane;
                    slot_tok[2 * m] = ((unsigned)e1 << 20) | r1; slot_tok[2 * m + 1] = ((unsigned)e2 << 20) | r2; gate_tok[2 * m] = g1; gate_tok[2 * m + 1] = g2; }
                if (fq == 0) rstd_tok[m0 + fr] = rstd;
              }
                __syncthreads();
            }
        }
        SEAM(8); TSTAMP_AFTER(8);
        PH_ON(9) {
            PHASE_LOCALS();
            moe_convert<25, 32, false>(args, ws, ll, lds, wave, lane, gw, NGW);
            {
                const unsigned* cnt_tab = (const unsigned*)(ws + WS_TOK); unsigned* slot_tok = (unsigned*)(ws + WS_SLOT); unsigned* cnt_cur = (unsigned*)(ws + WS_CTL) + CW_CNT + ll * 2048;
                const bf16* xbuf = (const bf16*)(ws + WS_X); const float* norm2_g = (const float*)args.in[21] + ll * DM; const float* rstd_tok = (const float*)(ws + WS_TOK + 256 * 1024); bf16* aperm = (bf16*)(ws + WS_APERM);
                LAS int* tcnt = (LAS int*)(lds + TAB_CNT); const LAS int* trb = (const LAS int*)(lds + TAB_ROWBASE);
                LAS int* gbase = (LAS int*)(lds + 8192); LAS int* clist = (LAS int*)(lds + 8192 + 256);
                static_assert((T / 64) % 16 == 0, "prefix parts");
                constexpr int GPP = T / 64 / 16;
                LAS int* psum = (LAS int*)(lds + 16384);
                __syncthreads();
                {   const int e = tid & 31, p = tid >> 5; int sacc = 0;
#pragma unroll
                    for (int u = 0; u < GPP; ++u) sacc += (int)cnt_tab[(p * GPP + u) * 32 + e];
                    psum[p * 32 + e] = sacc; }
                __syncthreads();
                if (tid < 32) { int run = 0;
#pragma unroll
                    for (int p = 0; p < 16; ++p) run += psum[p * 32 + tid];
                    tcnt[tid] = run; if (bid == 0) cnt_cur[64 * tid] = (unsigned)run; }
                build_moe_tables(lds, nullptr, tid);
                for (int rg = bid; rg < T / 64; rg += G) {
                    __syncthreads();
                    if (tid < 32) { const int p0 = rg / GPP; int base = 0;
                        for (int p = 0; p < p0; ++p) base += psum[p * 32 + tid];
#pragma unroll
                        for (int u = 0; u < GPP; ++u) base += (p0 * GPP + u < rg) ? (int)cnt_tab[(p0 * GPP + u) * 32 + tid] : 0;
                        gbase[tid] = base; }
                    __syncthreads();
                    if (wave < 4 && lane < 16) { const int m = 16 * (rg + (T / 64) * wave) + lane; clist[(wave * 16 + lane) * 4] = m;
#pragma unroll
                        for (int k = 0; k < 2; ++k) { const unsigned sv = slot_tok[2 * m + k]; const int e = (int)(sv >> 20); const int r = gbase[e] + (int)(sv & 0xfffffu);
                            slot_tok[2 * m + k] = ((unsigned)e << 20) | (unsigned)r; clist[(wave * 16 + lane) * 4 + 1 + k] = trb[e] + r; } }
                    __syncthreads();
                    for (int i = wave; i < 64; i += 8) {
                        const int m = clist[4 * i]; const size_t R1 = (size_t)clist[4 * i + 1], R2 = (size_t)clist[4 * i + 2]; const float rs_ = rstd_tok[m];
                        f32x4 v[8]; ROW_LOAD_BF(v, xbuf + (size_t)m * DM);
#pragma unroll
                        for (int j = 0; j < 8; ++j) { const f32x4 g = ((const GAS f32x4*)norm2_g)[lane + 64 * j];
                            v2u o; o.x = cvtpk(v[j].x * g.x * rs_, v[j].y * g.y * rs_); o.y = cvtpk(v[j].z * g.z * rs_, v[j].w * g.w * rs_);
                            ((GAS v2u*)(aperm + R1 * DM))[lane + 64 * j] = o; ((GAS v2u*)(aperm + R2 * DM))[lane + 64 * j] = o; } }
                }
                for (int e = 0; e < NEXP; ++e) { const int c0 = tcnt[e], rend = ((c0 + 255) >> 8) * 256;
                    for (int r = c0 + gw; r < rend; r += NGW) { GAS v4u* dst = (GAS v4u*)(aperm + (size_t)(trb[e] + r) * DM);
#pragma unroll
                        for (int j = 0; j < 4; ++j) dst[lane + 64 * j] = (v4u){0u, 0u, 0u, 0u}; } }
            }
        }
        SEAM(9); TSTAMP_AFTER(9);
        PH_ON(10) {
            PHASE_LOCALS();
            build_moe_tables(lds, (const unsigned*)(ws + WS_CTL) + CW_CNT + ll * 2048, tid);
            const int ntiles = __builtin_amdgcn_readfirstlane(((const LAS int*)(lds + TAB_NT))[0]);
            pg8::Gemm g{(const bf16*)(ws + WS_APERM), (const bf16*)ws, MOE_MAXTILES * 256, 1024, DM, 0, 1};
            const int units = ntiles * 4, rounds = (units + G - 1) / G, G3r = rounds > 0 ? (units + rounds - 1) / rounds : G, G3 = (G - G3r >= 16) ? G3r : G;
            if (bid < G3) {
                pg8::MoeOrder<4> S{G3, bid, ntiles, (const LAS int*)(lds + TAB_TEXP)};
                pg8::EpiSwiGLU E{(bf16*)(ws + WS_HID), DE};
                pg8::gemm_phase<DM, pg8::EpiSwiGLU, pg8::MoeOrder<4>, true, true>(lds, g, S, E, tid);
            }
            if (G3 == G) { __syncthreads(); moe_convert<0, 0, true>(args, ws, ll, lds, wave, lane, gw, NGW); }
            else if (bid >= G3) moe_convert<0, 0, true>(args, ws, ll, lds, wave, lane, (bid - G3) * 8 + wave, (G - G3) * 8);
        }
        SEAM(10); TSTAMP_AFTER(10);
        PH_ON(11) {
            PHASE_LOCALS();
            build_moe_tables(lds, (const unsigned*)(ws + WS_CTL) + CW_CNT + ll * 2048, tid);
            const int ntiles = __builtin_amdgcn_readfirstlane(((const LAS int*)(lds + TAB_NT))[0]);
            pg8::Gemm g{(const bf16*)(ws + WS_HID), (const bf16*)(ws + WS_WD), MOE_MAXTILES * 256, DM, DE, (size_t)DM * DE * 2, 0};
            pg8::MoeOrder<8> S{G, bid, ntiles, (const LAS int*)(lds + TAB_TEXP)};
            pg8::EpiBf16 E{(bf16*)(ws + WS_YP), DM};
            pg8::gemm_phase<DE, pg8::EpiBf16, pg8::MoeOrder<8>, true, true>(lds, g, S, E, tid);
        }
        SEAM(11); TSTAMP_AFTER(11);
    }

template <int KSEL>
__global__ void __launch_bounds__(512, 2) fwd_kernel(Args args) {
    extern __shared__ __attribute__((aligned(16))) unsigned char lds_raw[];
    LAS unsigned char* lds = (LAS unsigned char*)lds_raw;
    if (threadIdx.x < 4) ((LAS unsigned*)(lds + MISC_OFF))[threadIdx.x] = 0u;
    __syncthreads();
    XcdBarrier bar; bar.bar = (unsigned*)(args.ws + WS_CTL) + CW_BAR; bar.x = 0; bar.st = nullptr;
    if constexpr (KSEL < 0) bar = xcd_barrier_post((unsigned*)(args.ws + WS_CTL) + CW_BAR, (volatile LAS unsigned*)(lds + MISC_OFF));
    if (KB_TPROBE >= 0 && KSEL < 0 && blockIdx.x == 0 && threadIdx.x == 0) ((unsigned long long*)(args.ws + WS_CTL))[32768] = wall_clock64();
    if constexpr (KSEL < 0) { layer_program<KSEL>(args, lds, bar, 0); layer_program<KSEL>(args, lds, bar, 1); }
    else if constexpr (KSEL != 12) layer_program<KSEL>(args, lds, bar, args.layer);
    PH_ON(12) {
        const int l = DEPTH - 1;
        PHASE_LOCALS();
        build_moe_tables(lds, (const unsigned*)(ws + WS_CTL) + CW_CNT + ll * 2048, tid);
        const LAS int* trb = (const LAS int*)(lds + TAB_ROWBASE);
        float pscale = 1.f;
        if (KB_TPROBE >= 0) { const unsigned long long* ts = (const unsigned long long*)(ws + WS_CTL) + 32768; const int p = KB_TPROBE;
            const float tot = (float)(ts[13] - ts[0]); const int pe = KB_TPROBE_END; const float d = (float)(ts[pe] - ts[p]);
            pscale = 1.f + 0.01f * (float)(int)(d / tot * 40.f + 0.5f); }
        const float* gfin = (const float*)args.in[29]; const bf16* xbuf = (const bf16*)(ws + WS_X); const bf16* yp = (const bf16*)(ws + WS_YP);
        const unsigned* slot_tok = (const unsigned*)(ws + WS_SLOT); const float* gate_tok = (const float*)(ws + WS_GATE);
        for (int m = gw; m < T; m += NGW) {
            f32x4 v[8];
            ROW_LOAD_BF(v, xbuf + (size_t)m * DM);
            const unsigned s1 = slot_tok[2 * m], s2 = slot_tok[2 * m + 1]; const float g1 = gate_tok[2 * m], g2 = gate_tok[2 * m + 1];
            row_add_moe(v, yp, (size_t)(trb[s1 >> 20] + (int)(s1 & 0xfffffu)), (size_t)(trb[s2 >> 20] + (int)(s2 & 0xfffffu)), g1, g2, lane);
            const float rstd = row_rstd(v, lane);
#pragma unroll
            for (int j = 0; j < 8; ++j) { const f32x4 g = ((const GAS f32x4*)gfin)[lane + 64 * j];
                ((GAS f32x4*)(args.out + (size_t)m * DM))[lane + 64 * j] = (f32x4){v[j].x * rstd * g.x * pscale, v[j].y * rstd * g.y * pscale, v[j].z * rstd * g.z * pscale, v[j].w * rstd * g.w * pscale}; }
        }
    }
#undef SEAM
#undef PH_ON
}

extern "C" void kernel_launch(void* const* d_in, const int* in_sizes, int n_in, void* d_out, int out_size, void* d_ws, size_t ws_size, hipStream_t stream) {
    static int grid = 0;
    if (grid == 0) {
        if (n_in != 30 || in_sizes[0] != T * DM || out_size != T * DM || ws_size < WS_END) { fprintf(stderr, "kernel_launch: unexpected shapes (n_in %d, in0 %d, out %d, ws %zu < %zu)\n", n_in, n_in > 0 ? in_sizes[0] : -1, out_size, ws_size, (size_t)WS_END); grid = -1; return; }
        int dev = 0, cus = 0, per_cu = 0; (void)per_cu;
        if (hipGetDevice(&dev) != hipSuccess || hipDeviceGetAttribute(&cus, hipDeviceAttributeMultiprocessorCount, dev) != hipSuccess) { grid = -1; return; }
#if KB_SPLIT
#define SET_ATTR(k) if (hipFuncSetAttribute((const void*)fwd_kernel<k>, hipFuncAttributeMaxDynamicSharedMemorySize, LDS_BYTES) != hipSuccess) { fprintf(stderr, "kernel_launch: hipFuncSetAttribute failed (%d)\n", k); grid = -1; return; }
        SET_ATTR(0) SET_ATTR(1) SET_ATTR(2) SET_ATTR(3) SET_ATTR(4) SET_ATTR(5) SET_ATTR(6) SET_ATTR(7) SET_ATTR(8) SET_ATTR(9) SET_ATTR(10) SET_ATTR(11) SET_ATTR(12) SET_ATTR(13)
#else
        if (hipFuncSetAttribute((const void*)fwd_kernel<-1>, hipFuncAttributeMaxDynamicSharedMemorySize, LDS_BYTES) != hipSuccess) { fprintf(stderr, "kernel_launch: hipFuncSetAttribute failed\n"); grid = -1; return; }
        if (hipOccupancyMaxActiveBlocksPerMultiprocessor(&per_cu, (const void*)fwd_kernel<-1>, 512, LDS_BYTES) != hipSuccess || per_cu < 1) fprintf(stderr, "kernel_launch: occupancy query says %d\n", per_cu);
#endif
        (void)hipGetLastError();
        grid = cus;
    }
    if (grid < 0) return;
    if (hipMemsetAsync((char*)d_ws + WS_CTL, 0, CTL_ZERO_BYTES, stream) != hipSuccess) return;
    Args a{};
    for (int i = 0; i < 30; ++i) a.in[i] = d_in[i];
    a.out = (float*)d_out; a.ws = (unsigned char*)d_ws; a.layer = 0; a.pad = 0;
#if KB_SPLIT
#define LAUNCH_PH(k) hipLaunchKernelGGL(fwd_kernel<k>, dim3(grid), dim3(512), LDS_BYTES, stream, a)
    for (int l = 0; l < DEPTH; ++l) { a.layer = l;
        LAUNCH_PH(0); LAUNCH_PH(1); LAUNCH_PH(2); LAUNCH_PH(3); LAUNCH_PH(4); LAUNCH_PH(5); LAUNCH_PH(13); LAUNCH_PH(6); LAUNCH_PH(7); LAUNCH_PH(8); LAUNCH_PH(9); LAUNCH_PH(10); LAUNCH_PH(11); }
    a.layer = DEPTH - 1; LAUNCH_PH(12);
#else
    hipLaunchKernelGGL(fwd_kernel<-1>, dim3(grid), dim3(512), LDS_BYTES, stream, a);
#endif
}
#endif
```

```cpp
#ifndef KB_EMU
#include <hip/hip_runtime.h>
#endif
#include <cstdio>
#include <cstdint>
#include <cmath>

#ifndef KB_BATCH
#define KB_BATCH 4
#define KB_SEQ 4096
#endif
#ifndef KB_SPLIT
#define KB_SPLIT 0
#endif

#ifndef KB_PHMASK
#define KB_PHMASK 0xffff
#endif
#define KB_EN(k) (((KB_PHMASK) >> (k)) & 1)
#ifndef KB_TPROBE
#define KB_TPROBE -1
#endif
#ifndef KB_TPROBE_END
#define KB_TPROBE_END (KB_TPROBE + 1)
#endif
#define HD __host__ __device__ __forceinline__
typedef unsigned short bf16;

constexpr int BATCH = KB_BATCH, SEQ = KB_SEQ, T = BATCH * SEQ;
constexpr int DM = 2048, DG = 512, NH = 8, HDIM = 64;
constexpr int A_COLS = 2048, B_COLS = 1984, C_COLS = 1024, D_COLS = 1536, D_IN = 6592, NPROJ = 6656;
constexpr int OFF_A = 0, OFF_B = 2048, OFF_C = 4032, OFF_D_SRC = 5056  , OFF_D = 5120  ;
static_assert(OFF_D % 256 == 0 && OFF_D + D_COLS == NPROJ && OFF_D - OFF_D_SRC == NPROJ - D_IN, "proj layout");
constexpr int NC = SEQ / 128;
constexpr int NEXP = 32, DE = 512;
constexpr int NLORA = 448;
constexpr float NORM_EPS = 1e-6f, GN_EPS = 64e-5f;
constexpr int MOE_MAXTILES = (2 * T + NEXP * 255 + 255) / 256;
constexpr int DEPTH = 2;

constexpr size_t MiB = 1u << 20;
constexpr size_t WS_CTL = 0, CTL_ZERO_BYTES = 32 * 1024;
constexpr size_t WS_WIN = 2 * MiB, WS_WOUT = 28 * MiB;
constexpr size_t WS_WD = 292 * MiB;
__host__ __device__ constexpr size_t wgu_off(int e) { return e < 16 ? (804 + 4 * (size_t)e) * MiB : e < 22 ? (780 + 4 * (size_t)(e - 16)) * MiB : e < 25 ? (868 + 4 * (size_t)(e - 22)) * MiB : (914 + 4 * (size_t)(e - 25)) * MiB; }
constexpr int GEMM1_G = 238;
constexpr size_t WS_X = 228 * MiB;
constexpr size_t WS_ACT = 356 * MiB;
constexpr size_t WS_PROJ = 420 * MiB;
constexpr size_t WS_RKV = 628 * MiB, WS_RSP = 660 * MiB;
constexpr size_t WS_RS = 692 * MiB, WS_KS = 708 * MiB, WS_VS = 724 * MiB, WS_KK = 740 * MiB, WS_GG = 756 * MiB, WS_KDF = 772 * MiB, WS_KDB = 788 * MiB,
                 WS_AKF = 804 * MiB, WS_AKB = 820 * MiB, WS_YF = 836 * MiB, WS_YB = 852 * MiB, WS_LIN = 868 * MiB  , WS_WF = 882 * MiB, WS_WB = 914 * MiB;
constexpr size_t WS_TOK = 946 * MiB  , WS_SLOT = 948 * MiB, WS_GATE = 949 * MiB;
constexpr size_t WS_RB = 36 * MiB  , WS_PT = 68 * MiB  , WS_QF = 132 * MiB  , WS_YL = 196 * MiB  , WS_DC = 1002 * MiB  ;
constexpr size_t WS_DPO = 950 * MiB  , WS_DML = 998 * MiB  , WS_ROT = 1004 * MiB  , WS_ST = 882 * MiB  , WS_RWT = 1010 * MiB  , WS_LORAW = 1011 * MiB  , WS_END = 1012 * MiB;
constexpr size_t WS_APERM = 420 * MiB, WS_HID = 580 * MiB, WS_YP = 620 * MiB;
static_assert((size_t)MOE_MAXTILES * 256 * 2048 * 2 <= 160 * MiB && (size_t)T * NPROJ * 2 <= 208 * MiB, "ws map");
constexpr int CW_BAR = 4096;
constexpr int CW_CNT = 16384;

HD float bf2f(bf16 v) { return __builtin_bit_cast(float, (unsigned)v << 16); }
HD bf16 f2bf(float f) { unsigned u = __builtin_bit_cast(unsigned, f); return (bf16)((u + 0x7fffu + ((u >> 16) & 1u)) >> 16); }
HD float sigmoidf_(float x) { return 1.f / (1.f + expf(-x)); }
HD float siluf_(float x) { return x / (1.f + expf(-x)); }
HD float geluf_(float x) { return 0.5f * x * (1.f + tanhf(0.7978845608028654f * (x + 0.044715f * x * x * x))); }
HD float logsigmoidf_(float x) { return x < 0.f ? x - log1pf(expf(x)) : -log1pf(expf(-x)); }

struct Ctx {
    const int* pos;
    const float *gam, *ret_g, *mu, *w0, *w2, *a0, *a2, *g2, *k_k, *k_a, *r_k, *ln_g, *sgu_g, *sgu_b, *sgu_w, *sgu_bias;
    bf16 *proj, *ycat, *rs, *ks, *vs, *kk, *gg, *kdf, *kdb, *akf, *akb, *yf, *yb, *lin;
    const bf16* loraw;
    float *wf, *wb, *rkv, *rsp;
};

HD void el_rot_ret(const Ctx& c, long idx) {
    const int i = (int)(idx & 31), h = (int)((idx >> 5) & 7); const long t = idx >> 8;
    const float inv = expf(-(float)i * (1.f / 32.f) * 9.210340371976184f);
    const float ang = (float)c.pos[t] * inv; float sn, cs; sincosf(ang, &sn, &cs);
    bf16* q = c.proj + (size_t)t * NPROJ + OFF_A + h * 64; bf16* k = q + 512;
    const float q1 = bf2f(q[i]), q2 = bf2f(q[i + 32]), k1 = bf2f(k[i]), k2 = bf2f(k[i + 32]);
    q[i] = f2bf(q1 * cs - q2 * sn); q[i + 32] = f2bf(q2 * cs + q1 * sn);
    k[i] = f2bf((k1 * cs - k2 * sn) * 0.125f); k[i + 32] = f2bf((k2 * cs + k1 * sn) * 0.125f);
}
HD void el_rot_dil(const Ctx& c, long idx) {
    const int j = (int)(idx & 31), h = (int)((idx >> 5) & 7); const long t = idx >> 8;
    bf16* q = c.proj + (size_t)t * NPROJ + OFF_D + h * 64; bf16* k = q + 512;
    if (j < 8) {
        const float inv = expf(-(float)j * (1.f / 8.f) * 13.122363377404328f);
        const float ang = (float)c.pos[t] * inv; float sn, cs; sincosf(ang, &sn, &cs);
        const float q1 = bf2f(q[j]), q2 = bf2f(q[j + 8]), k1 = bf2f(k[j]), k2 = bf2f(k[j + 8]);
        q[j] = f2bf((q1 * cs - q2 * sn) * 0.125f); q[j + 8] = f2bf((q2 * cs + q1 * sn) * 0.125f);
        k[j] = f2bf(k1 * cs - k2 * sn); k[j + 8] = f2bf(k2 * cs + k1 * sn);
    } else {
        const int d = 16 + 2 * (j - 8);
        q[d] = f2bf(bf2f(q[d]) * 0.125f); q[d + 1] = f2bf(bf2f(q[d + 1]) * 0.125f);
    }
}
HD void el_rwkv_shift(const Ctx& c, long idx) {
    const int j = (int)(idx % B_COLS); const long t = idx / B_COLS; const int s = (int)(t % SEQ);
    const bf16* p = c.proj + (size_t)t * NPROJ + OFF_B + j;
    const float x = bf2f(p[0]), xp = s > 0 ? bf2f(p[-(long)NPROJ]) : 0.f, xn = s < SEQ - 1 ? bf2f(p[NPROJ]) : 0.f;
    const float xs = x + c.mu[j] * (xp - x) + c.mu[B_COLS + j] * (xn - x);
    if (j < 512) c.rs[t * 512 + j] = f2bf(xs);
    else if (j < 1024) c.ks[t * 512 + j - 512] = f2bf(xs);
    else if (j < 1536) c.vs[t * 512 + j - 1024] = f2bf(xs);
    else if (j < 1632) c.lin[t * NLORA + (j - 1536)] = f2bf(tanhf(xs));
    else if (j < 1728) c.lin[t * NLORA + (j - 1536)] = f2bf(xs);
    else c.lin[t * NLORA + (j - 1536)] = f2bf(sigmoidf_(xs));
}
HD void el_rwkv_lora(const Ctx& c, long idx) {
    const int ch = (int)(idx & 511); const long t = idx >> 9;
    const bf16* li = c.lin + t * NLORA;
    float wl = 0.f, al = 0.f, g = 0.f;
    for (int i = 0; i < 96; ++i) { wl += bf2f(li[i]) * c.w2[i * 512 + ch]; al += bf2f(li[96 + i]) * c.a2[i * 512 + ch]; }
    for (int i = 0; i < 256; ++i) g += bf2f(li[192 + i]) * c.g2[i * 512 + ch];
    c.gg[t * 512 + ch] = f2bf(g);
    const float k = bf2f(c.ks[t * 512 + ch]), ka = c.k_a[ch];
    c.kk[t * 512 + ch] = f2bf(k * c.k_k[ch]);
    {   const float dec = -0.6065306597126334f * sigmoidf_(c.w0[ch] + wl); const float a = sigmoidf_(c.a0[ch] + al);
        c.wf[t * 512 + ch] = dec; c.kdf[t * 512 + ch] = f2bf(k * (1.f + (a - 1.f) * ka)); c.akf[t * 512 + ch] = f2bf(a); }
    {   const float dec = -0.6065306597126334f * sigmoidf_(c.w0[512 + ch] + wl); const float a = sigmoidf_(c.a0[512 + ch] + al);
        c.wb[t * 512 + ch] = dec; c.kdb[t * 512 + ch] = f2bf(k * (1.f + (a - 1.f) * ka)); c.akb[t * 512 + ch] = f2bf(a); }
}
HD void el_rwkv_kk(const Ctx& c, long idx) {
    const int h = (int)(idx & 7); const long t = idx >> 3; const size_t o = (size_t)t * 512 + h * 64;
    float ss = 0.f;
    for (int d = 0; d < 64; ++d) { const float v = bf2f(c.kk[o + d]); ss += v * v; }
    const float n = 1.f / sqrtf(ss + 1e-12f);
    for (int d = 0; d < 64; ++d) { const float v = bf2f(c.kk[o + d]) * n; c.kk[o + d] = f2bf(v);
        c.akf[o + d] = f2bf(bf2f(c.akf[o + d]) * v); c.akb[o + d] = f2bf(bf2f(c.akb[o + d]) * v); }
}
HD void el_sgu_prep(const Ctx& c, long t) {
    bf16* v = c.proj + (size_t)t * NPROJ + OFF_C + 512;
    float s = 0.f;
    for (int j = 0; j < 512; ++j) s += geluf_(bf2f(v[j]));
    const float mean = s * (1.f / 512.f); float q = 0.f;
    for (int j = 0; j < 512; ++j) { const float d = geluf_(bf2f(v[j])) - mean; q += d * d; }
    const float rstd = 1.f / sqrtf(q * (1.f / 512.f) + NORM_EPS);
    for (int j = 0; j < 512; ++j) v[j] = f2bf((geluf_(bf2f(v[j])) - mean) * rstd * c.sgu_g[j] + c.sgu_b[j]);
}

HD void el_ret_kv(const Ctx& c, long idx) {
    const int e = (int)(idx & 63), d = (int)((idx >> 6) & 63); long r = idx >> 12;
    const int ch = (int)(r % NC); r /= NC; const int dir = (int)(r & 1); r >>= 1; const int h = (int)(r & 7); const int b = (int)(r >> 3);
    const float lg = logsigmoidf_(c.gam[dir * 8 + h]);
    const bf16* base = c.proj + ((size_t)b * SEQ + (size_t)ch * 128) * NPROJ + OFF_A + h * 64;
    float kv = 0.f;
    for (int m = 0; m < 128; ++m) { const float dec = expf(lg * (float)(dir == 0 ? 127 - m : m));
        kv += dec * bf2f(base[(size_t)m * NPROJ + 512 + d]) * bf2f(base[(size_t)m * NPROJ + 1024 + e]); }
    c.rkv[idx] = kv;
}
HD void el_dil_attn(const Ctx& c, long idx) {
    const int h = (int)(idx & 7); const long t = idx >> 3; const int s = (int)(t % SEQ); const long tb = t - s;
    const bf16* qp = c.proj + (size_t)t * NPROJ + OFF_D + h * 64;
    float o[64];
#pragma unroll
    for (int i = 0; i < 64; ++i) o[i] = 0.f;
    float m = -1e30f, l = 0.f;
    for (int br = 0; br < 3; ++br) {
        const int dil = br == 0 ? 1 : (br == 1 ? 4 : 16);
        for (int j = -64; j <= 64; ++j) {
            const int sp = s + dil * j; if (sp < 0 || sp >= SEQ) continue;
            asm volatile("" ::: "memory");
            const bf16* kp = c.proj + (size_t)(tb + sp) * NPROJ + OFF_D + 512 + h * 64; const bf16* vp = kp + 512;
            float sc = 0.f;
#pragma unroll
            for (int i = 0; i < 64; ++i) sc += bf2f(qp[i]) * bf2f(kp[i]);
            const float mn = sc > m ? sc : m, scale = expf(m - mn), p = expf(sc - mn);
            l = l * scale + p; m = mn;
#pragma unroll
            for (int i = 0; i < 64; ++i) o[i] = o[i] * scale + p * bf2f(vp[i]);
        }
    }
    const float il = 1.f / l; bf16* y = c.ycat + (size_t)t * 2048 + 1536 + h * 64;
#pragma unroll
    for (int i = 0; i < 64; ++i) y[i] = f2bf(o[i] * il);
}
HD void el_dil_combine(const bf16* dpo, const float* dml, bf16* ycat, long idx) {
    const int h = (int)(idx & 7); const long t = idx >> 3;
    float m[3], l[3];
#pragma unroll
    for (int br = 0; br < 3; ++br) { const float* mp = dml + (((size_t)br * T + t) * 8 + h) * 2; m[br] = mp[0]; l[br] = mp[1]; }
    const float M = fmaxf(m[0], fmaxf(m[1], m[2]));
    float wgt[3], den = 0.f;
#pragma unroll
    for (int br = 0; br < 3; ++br) { wgt[br] = expf(m[br] - M) * l[br]; den += wgt[br]; }
    const float inv = 1.f / den;
    bf16* y = ycat + (size_t)t * 2048 + 1536 + h * 64;
    for (int i = 0; i < 64; ++i) { float a = 0.f;
#pragma unroll
        for (int br = 0; br < 3; ++br) a += wgt[br] * bf2f(dpo[((size_t)br * T + t) * 512 + h * 64 + i]);
        y[i] = f2bf(a * inv); }
}
HD void el_sgu_main(const Ctx& c, long idx) {
    const int j = (int)(idx & 511); const long t = idx >> 9; const int s = (int)(t % SEQ), p = s & 127, g = j >> 6; const long t0 = t - p;
    const float* w = c.sgu_w + ((size_t)g * 128 + p) * 128;
    const bf16* v = c.proj + (size_t)t0 * NPROJ + OFF_C + 512 + j;
    float acc = 0.f;
    for (int q = 0; q < 128; ++q) acc += w[q] * bf2f(v[(size_t)q * NPROJ]);
    const float u = geluf_(bf2f(c.proj[(size_t)t * NPROJ + OFF_C + j]));
    c.ycat[(size_t)t * 2048 + 1024 + j] = f2bf(u * (acc + c.sgu_bias[g * 128 + p]));
}
HD void el_ret_scan(const Ctx& c, long idx) {
    const int de = (int)(idx & 4095); const long r = idx >> 12; const int dir = (int)(r & 1), h = (int)((r >> 1) & 7);
    const float cd = expf(128.f * logsigmoidf_(c.gam[dir * 8 + h]));
    float kv[NC];
#pragma unroll
    for (int k = 0; k < NC; ++k) { const int ch = dir == 0 ? k : NC - 1 - k; kv[k] = c.rkv[((size_t)r * NC + ch) * 4096 + de]; }
    float S = 0.f;
#pragma unroll
    for (int k = 0; k < NC; ++k) { const int ch = dir == 0 ? k : NC - 1 - k; c.rsp[((size_t)r * NC + ch) * 4096 + de] = S; S = S * cd + kv[k]; }
}
HD void el_rwkv_scan(const Ctx& c, long idx) {
    const int row = (int)(idx & 63); const long r = idx >> 6; const int dir = (int)(r & 1), h = (int)((r >> 1) & 7), b = (int)(r >> 4);
    const float* W = dir ? c.wb : c.wf; const bf16* KD = dir ? c.kdb : c.kdf; const bf16* AK = dir ? c.akb : c.akf; bf16* Y = dir ? c.yb : c.yf;
    float S[64];
#pragma unroll
    for (int i = 0; i < 64; ++i) S[i] = 0.f;
    for (int k = 0; k < SEQ; ++k) {
        asm volatile("" ::: "memory");
        const int s = dir ? SEQ - 1 - k : k; const size_t o = ((size_t)b * SEQ + s) * 512 + h * 64;
        float sk = 0.f;
#pragma unroll
        for (int q = 0; q < 4; ++q) { asm volatile("" ::: "memory");
#pragma unroll
            for (int i = 16 * q; i < 16 * q + 16; ++i) sk += S[i] * bf2f(c.kk[o + i]); }
        const float v = bf2f(c.vs[o + row]); float y = 0.f;
#pragma unroll
        for (int q = 0; q < 4; ++q) { asm volatile("" ::: "memory");
#pragma unroll
            for (int i = 16 * q; i < 16 * q + 16; ++i) { S[i] = S[i] * expf(W[o + i]) - sk * bf2f(AK[o + i]) + v * bf2f(KD[o + i]); y += S[i] * bf2f(c.rs[o + i]); } }
        Y[o + row] = f2bf(y);
    }
}
HD void el_ret_out(const Ctx& c, long idx) {
    const int h = (int)(idx & 7); const long t = idx >> 3; const int s = (int)(t % SEQ), n = s & 127, ch = s >> 7; const int b = (int)(t / SEQ);
    const float lgf = logsigmoidf_(c.gam[h]), lgb = logsigmoidf_(c.gam[8 + h]);
    const bf16* qp = c.proj + (size_t)t * NPROJ + OFF_A + h * 64;
    float o[64];
#pragma unroll
    for (int i = 0; i < 64; ++i) o[i] = 0.f;
    const bf16* kb = c.proj + (size_t)(t - n) * NPROJ + OFF_A + 512 + h * 64;
    for (int m = 0; m < 128; ++m) {
        asm volatile("" ::: "memory");
        const bf16* kp = kb + (size_t)m * NPROJ; const bf16* vp = kp + 512;
        float sc = 0.f;
#pragma unroll
        for (int i = 0; i < 64; ++i) sc += bf2f(qp[i]) * bf2f(kp[i]);
        sc *= m <= n ? expf(lgf * (float)(n - m)) : expf(lgb * (float)(m - n));
#pragma unroll
        for (int i = 0; i < 64; ++i) o[i] += sc * bf2f(vp[i]);
    }
    const float qdf = expf(lgf * (float)(n + 1)), qdb = expf(lgb * (float)(128 - n));
    const float* Sf = c.rsp + ((size_t)((b * 8 + h) * 2 + 0) * NC + ch) * 4096; const float* Sb = c.rsp + ((size_t)((b * 8 + h) * 2 + 1) * NC + ch) * 4096;
    for (int d = 0; d < 64; ++d) { asm volatile("" ::: "memory"); const float qd = bf2f(qp[d]); const float a = qd * qdf, bb = qd * qdb;
#pragma unroll
        for (int i = 0; i < 64; ++i) o[i] += a * Sf[d * 64 + i] + bb * Sb[d * 64 + i]; }
    float mu = 0.f;
#pragma unroll
    for (int i = 0; i < 64; ++i) mu += o[i];
    mu *= (1.f / 64.f); float var = 0.f;
#pragma unroll
    for (int i = 0; i < 64; ++i) { const float d = o[i] - mu; var += d * d; }
    const float rstd = 1.f / sqrtf(var * (1.f / 64.f) + GN_EPS);
    const bf16* gp = c.proj + (size_t)t * NPROJ + OFF_A + 1536 + h * 64; bf16* y = c.ycat + (size_t)t * 2048 + h * 64;
    for (int i = 0; i < 64; i += 8) { asm volatile("" ::: "memory");
#pragma unroll
        for (int j = 0; j < 8; ++j) y[i + j] = f2bf(siluf_(bf2f(gp[i + j])) * ((o[i + j] - mu) * rstd * c.ret_g[h * 64 + i + j])); }
}
HD void el_rwkv_fin(const Ctx& c, long idx) {
    const int h = (int)(idx & 7); const long t = idx >> 3; const size_t o = (size_t)t * 512 + h * 64;
    float mu = 0.f, bonus = 0.f;
    for (int i = 0; i < 64; ++i) { mu += bf2f(c.yf[o + i]) + bf2f(c.yb[o + i]); bonus += bf2f(c.rs[o + i]) * bf2f(c.ks[o + i]) * c.r_k[h * 64 + i]; }
    mu *= (1.f / 64.f); float var = 0.f;
    for (int i = 0; i < 64; ++i) { const float d = bf2f(c.yf[o + i]) + bf2f(c.yb[o + i]) - mu; var += d * d; }
    const float rstd = 1.f / sqrtf(var * (1.f / 64.f) + GN_EPS);
    bf16* out = c.ycat + (size_t)t * 2048 + 512 + h * 64;
    for (int i = 0; i < 64; ++i) { const float y = bf2f(c.yf[o + i]) + bf2f(c.yb[o + i]);
        out[i] = f2bf(((y - mu) * rstd * c.ln_g[h * 64 + i] + bonus * bf2f(c.vs[o + i])) * bf2f(c.gg[o + i])); }
}
HD void route_select(const float (&lg)[4], const float (&le)[32], const float* bg, const float* be, int& e1, int& e2, float& g1, float& g2) {
    float l[4]; float mx = -1e30f; int gi = 0;
#pragma unroll
    for (int i = 0; i < 4; ++i) { l[i] = lg[i] + bg[i]; if (l[i] > mx) { mx = l[i]; gi = i; } }
    float den = 0.f;
#pragma unroll
    for (int i = 0; i < 4; ++i) den += expf(l[i] - mx);
    const float gtop = 1.f / den;
    float el[8];
#pragma unroll
    for (int i = 0; i < 8; ++i) { float v = 0.f;
#pragma unroll
        for (int g = 0; g < 4; ++g) v = (g == gi) ? le[g * 8 + i] + be[g * 8 + i] : v;
        el[i] = v; }
    float m1 = -1e30f, m2 = -1e30f; int i1 = 0, i2 = 0;
#pragma unroll
    for (int i = 0; i < 8; ++i) { if (el[i] > m1) { m2 = m1; i2 = i1; m1 = el[i]; i1 = i; } else if (el[i] > m2) { m2 = el[i]; i2 = i; } }
    const float p2 = expf(m2 - m1);
    g1 = gtop / (1.f + p2); g2 = gtop * p2 / (1.f + p2); e1 = gi * 8 + i1; e2 = gi * 8 + i2;
}

#ifndef KB_HOST_ONLY
namespace pg8 {
#define PG8_LAS __attribute__((address_space(3)))
typedef unsigned short bf16_t;
typedef short bf16x8 __attribute__((ext_vector_type(8)));
typedef float f32x4 __attribute__((ext_vector_type(4)));
typedef unsigned u32x4 __attribute__((ext_vector_type(4)));
constexpr int BM = 256, BK = 64, HALF = 128, HTB = HALF * BK * 2, STAGE_BYTES = 8 * HTB, NXCD = 8, WGM = 8;
__host__ __device__ __forceinline__ int lds_byte(int r, int c) { const int st = (r >> 4) * 2 + (c >> 5), rr = r & 15, cc = c & 31, ob = rr * 64 + cc * 2; return st * 1024 + (ob ^ (((ob >> 9) & 1) << 5)); }
__host__ __device__ __forceinline__ void stage_rc(int b, int& R, int& C) { const int st = b / 1024, sb = b % 1024, swz = sb ^ (((sb >> 9) & 1) << 5); R = (st >> 1) * 16 + swz / 64; C = (st & 1) * 32 + (swz % 64) / 2; }
__host__ __device__ __forceinline__ int perm32(int rho) { const int n = rho >> 4, i = rho & 15; return 8 * (i >> 2) + 4 * n + (i & 3); }
struct Unit { int pm, pn, pe; };
struct Gemm { const bf16_t* A; const bf16_t* Bt; int M, N, K; size_t bstride; int bmap; };
template <int M, int N> struct StaticOrder {
    static constexpr int nM = M / BM, nN = N / BM, nwg = nM * nN;
    int G, c;
    __host__ __device__ void init(int G_, int c_) { G = G_; c = c_; }
    __host__ __device__ __forceinline__ bool next(int i, Unit& u) const {
        const int L = i * G + c; if (L >= nwg) return false;
        int wgid = L; { constexpr int q = nwg / NXCD, r = nwg % NXCD; const int xcd = wgid % NXCD, off = wgid / NXCD; wgid = (xcd < r ? xcd * (q + 1) : r * (q + 1) + (xcd - r) * q) + off; }
        constexpr int nig = WGM * nN; const int gid = wgid / nig, fm = gid * WGM, gsz = (nM - fm) < WGM ? (nM - fm) : WGM;
        u.pm = fm + ((wgid % nig) % gsz); u.pn = (wgid % nig) / gsz; u.pe = 0; return true;
    }
    __device__ __forceinline__ void a_ready(const Unit&) const {}
    __device__ __forceinline__ void done(const Unit&) const {}
};
template <int NN> struct MoeOrder {
    int G, c, ntiles; const PG8_LAS int* tile_exp;
    __device__ __forceinline__ bool next(int i, Unit& u) const {
        const int U = ntiles * NN, L = i * G + c; if (L >= U) return false;
        const int q = U / NXCD, r = U % NXCD, xcd = L % NXCD, off = L / NXCD; const int w = (xcd < r ? xcd * (q + 1) : r * (q + 1) + (xcd - r) * q) + off;
        u.pm = w / NN; u.pn = w % NN; u.pe = __builtin_amdgcn_readfirstlane(tile_exp[u.pm]); return true;
    }
    __device__ __forceinline__ void a_ready(const Unit&) const {}
    __device__ __forceinline__ void done(const Unit&) const {}
};
__device__ __forceinline__ unsigned cvt_pk_bf16(float lo, float hi) { unsigned r; asm volatile("v_cvt_pk_bf16_f32 %0, %1, %2" : "=v"(r) : "v"(lo), "v"(hi)); return r; }
struct EpiBf16 {
    static constexpr bool PERM = true, AFTER_DRAIN = false;
    bf16_t* O; int ldc;
    __device__ __forceinline__ void operator()(const f32x4 (&acc)[2][2][4][2], const Unit& u, int wr, int wc, int fr, int fq) const {
        const int row0 = u.pm * BM + wr * 64 + fr, col0 = u.pn * BM + wc * 32 + 8 * fq;
#pragma unroll
        for (int ai = 0; ai < 2; ++ai)
#pragma unroll
            for (int m = 0; m < 4; ++m) { bf16_t* rowp = O + (size_t)(row0 + ai * HALF + m * 16) * ldc + col0;
#pragma unroll
                for (int bj = 0; bj < 2; ++bj) { const f32x4 v0 = acc[ai][bj][m][0], v1 = acc[ai][bj][m][1];
                    u32x4 w; w.x = cvt_pk_bf16(v0[0], v0[1]); w.y = cvt_pk_bf16(v0[2], v0[3]); w.z = cvt_pk_bf16(v1[0], v1[1]); w.w = cvt_pk_bf16(v1[2], v1[3]);
                    *(u32x4*)(rowp + bj * HALF) = w; } }
    }
};
struct EpiBf16Rot {
    static constexpr bool PERM = true, AFTER_DRAIN = false;
    bf16_t* O; int ldc; const float* rot;
    __device__ __forceinline__ void operator()(const f32x4 (&acc)[2][2][4][2], const Unit& u, int wr, int wc, int fr, int fq) const {
        const int row0 = u.pm * BM + wr * 64 + fr, col0 = u.pn * BM + wc * 32 + 8 * fq;
        const bool retT = u.pn < (OFF_A + 1024) / BM, dilT = u.pn >= OFF_D / BM && u.pn < (OFF_D + 1024) / BM;
        const int p = col0 & 63; const bool on = retT || (dilT && p < 16); const int f0 = (retT ? 0 : 32) + (p >> 1);
#pragma unroll
        for (int ai = 0; ai < 2; ++ai)
#pragma unroll
            for (int m = 0; m < 4; ++m) { const int row = row0 + ai * HALF + m * 16; bf16_t* rowp = O + (size_t)row * ldc + col0;
                f32x4 c0 = (f32x4){1.f, 0.f, 1.f, 0.f}, c1 = c0;
                if (on) { const float* rp = rot + ((size_t)row * 40 + f0) * 2; c0 = *(const f32x4*)rp; c1 = *(const f32x4*)(rp + 4); }
#pragma unroll
                for (int bj = 0; bj < 2; ++bj) { const f32x4 v0 = acc[ai][bj][m][0], v1 = acc[ai][bj][m][1];
                    u32x4 w; w.x = cvt_pk_bf16(v0[0] * c0[0] - v0[1] * c0[1], v0[1] * c0[0] + v0[0] * c0[1]); w.y = cvt_pk_bf16(v0[2] * c0[2] - v0[3] * c0[3], v0[3] * c0[2] + v0[2] * c0[3]);
                    w.z = cvt_pk_bf16(v1[0] * c1[0] - v1[1] * c1[1], v1[1] * c1[0] + v1[0] * c1[1]); w.w = cvt_pk_bf16(v1[2] * c1[2] - v1[3] * c1[3], v1[3] * c1[2] + v1[2] * c1[3]);
                    __builtin_nontemporal_store(w, (u32x4*)(rowp + bj * HALF)); } }
    }
};
struct EpiResB {
    static constexpr bool PERM = true, AFTER_DRAIN = false;
    const float* base32; const bf16_t* base16; bf16_t* out; int ldc;
    __device__ __forceinline__ void operator()(const f32x4 (&acc)[2][2][4][2], const Unit& u, int wr, int wc, int fr, int fq) const {
        const int row0 = u.pm * BM + wr * 64 + fr, col0 = u.pn * BM + wc * 32 + 8 * fq;
#pragma unroll
        for (int ai = 0; ai < 2; ++ai)
#pragma unroll
            for (int m = 0; m < 4; ++m) { const size_t off = (size_t)(row0 + ai * HALF + m * 16) * ldc + col0;
#pragma unroll
                for (int bj = 0; bj < 2; ++bj) { f32x4 v0 = acc[ai][bj][m][0], v1 = acc[ai][bj][m][1];
                    if (base32) { v0 += *(const f32x4*)(base32 + off + bj * HALF); v1 += *(const f32x4*)(base32 + off + bj * HALF + 4); }
                    else { const u32x4 b = *(const u32x4*)(base16 + off + bj * HALF);
                        v0[0] += __builtin_bit_cast(float, b.x << 16); v0[1] += __builtin_bit_cast(float, b.x & 0xffff0000u); v0[2] += __builtin_bit_cast(float, b.y << 16); v0[3] += __builtin_bit_cast(float, b.y & 0xffff0000u);
                        v1[0] += __builtin_bit_cast(float, b.z << 16); v1[1] += __builtin_bit_cast(float, b.z & 0xffff0000u); v1[2] += __builtin_bit_cast(float, b.w << 16); v1[3] += __builtin_bit_cast(float, b.w & 0xffff0000u); }
                    u32x4 w; w.x = cvt_pk_bf16(v0[0], v0[1]); w.y = cvt_pk_bf16(v0[2], v0[3]); w.z = cvt_pk_bf16(v1[0], v1[1]); w.w = cvt_pk_bf16(v1[2], v1[3]);
                    *(u32x4*)(out + off + bj * HALF) = w; } }
    }
};
struct EpiSwiGLU {
    static constexpr bool PERM = true, AFTER_DRAIN = false;
    bf16_t* O; int ldc;
    __device__ __forceinline__ void operator()(const f32x4 (&acc)[2][2][4][2], const Unit& u, int wr, int wc, int fr, int fq) const {
        const int row0 = u.pm * BM + wr * 64 + fr, col0 = u.pn * HALF + wc * 32 + 8 * fq;
#pragma unroll
        for (int ai = 0; ai < 2; ++ai)
#pragma unroll
            for (int m = 0; m < 4; ++m) { bf16_t* rowp = O + (size_t)(row0 + ai * HALF + m * 16) * ldc + col0;
                float h[8];
#pragma unroll
                for (int n = 0; n < 2; ++n)
#pragma unroll
                    for (int j = 0; j < 4; ++j) { const float g = acc[ai][0][m][n][j], up = acc[ai][1][m][n][j]; h[n * 4 + j] = g * __builtin_amdgcn_rcpf(1.f + __expf(-g)) * up; }
                u32x4 w; w.x = cvt_pk_bf16(h[0], h[1]); w.y = cvt_pk_bf16(h[2], h[3]); w.z = cvt_pk_bf16(h[4], h[5]); w.w = cvt_pk_bf16(h[6], h[7]);
                *(u32x4*)rowp = w; }
    }
};

template <int KK, class Epi, class Sched, bool ALIGN_EPI = false, bool SP2 = false>
__device__ __forceinline__ void gemm_phase(PG8_LAS unsigned char* lds, const Gemm g, const Sched& S, const Epi& E, const int tid) {
    const int wid = __builtin_amdgcn_readfirstlane(tid >> 6), lane = tid & 63, wr = wid >> 2, wc = wid & 3, fr = lane & 15, fq = lane >> 4;
    constexpr int K = KK, nt = K / BK;
    unsigned voffA[2], voffB[2];
#pragma unroll
    for (int i = 0; i < 2; ++i) { int R, C; stage_rc(tid * 16 + i * 8192, R, C); const int Rb = Epi::PERM ? ((R & ~31) + perm32(R & 31)) : R;
        voffA[i] = (unsigned)(R * K + C) * 2u; voffB[i] = (unsigned)(Rb * K + C) * 2u; }
    constexpr size_t kstep = (size_t)(BK * 2);
    constexpr size_t hstep = (size_t)HALF * K * 2;
    constexpr size_t tstep = 2 * hstep;
    const unsigned ldsw = (unsigned)wid * 1024u;
    const int aoff = lds_byte(wr * 64 + fr, fq * 8), boff = lds_byte(wc * 32 + fr, fq * 8);
#define PG8_SA(b, h) (((b) * 2 + (h)) * HTB)
#define PG8_SB(b, h) ((4 + (b) * 2 + (h)) * HTB)
#define PG8_STAGE(bufoff, gbase, voff) do { _Pragma("unroll") for (int _i = 0; _i < 2; ++_i) \
        __builtin_amdgcn_global_load_lds((const unsigned*)((const char*)(gbase) + (voff)[_i]), (PG8_LAS unsigned*)(lds + (bufoff) + ldsw + _i * 8192), 16, 0, 0); } while (0)
#define PG8_LDA(dst, b, h) do { _Pragma("unroll") for (int m = 0; m < 4; ++m) _Pragma("unroll") for (int k = 0; k < 2; ++k) dst[m][k] = *(const PG8_LAS bf16x8*)(lds + PG8_SA(b, h) + aoff + m * 2048 + k * 1024); } while (0)
#define PG8_LDB(dst, b, h) do { _Pragma("unroll") for (int n = 0; n < 2; ++n) _Pragma("unroll") for (int k = 0; k < 2; ++k) dst[n][k] = *(const PG8_LAS bf16x8*)(lds + PG8_SB(b, h) + boff + n * 2048 + k * 1024); } while (0)
#define PG8_MMA(ai, bj, At, Bt) do { __builtin_amdgcn_s_setprio(1); _Pragma("unroll") for (int m = 0; m < 4; ++m) _Pragma("unroll") for (int n = 0; n < 2; ++n) _Pragma("unroll") for (int k = 0; k < 2; ++k) \
        acc[ai][bj][m][n] = __builtin_amdgcn_mfma_f32_16x16x32_bf16(Bt[n][k], At[m][k], acc[ai][bj][m][n], 0, 0, 0); __builtin_amdgcn_s_setprio(0); } while (0)
#define PG8_WAIT_V(n) asm volatile("s_waitcnt vmcnt(" #n ")" ::: "memory")
#define PG8_WAIT_L(n) asm volatile("s_waitcnt lgkmcnt(" #n ")" ::: "memory")
#define PG8_BAR __builtin_amdgcn_s_barrier()
#define PG8_SCHED __builtin_amdgcn_sched_barrier(0)
    Unit cur, nxt; int ui = 0;
    if (!S.next(0, cur)) return;
    f32x4 acc[2][2][4][2];
#pragma unroll
    for (int a = 0; a < 2; ++a)
#pragma unroll
        for (int b = 0; b < 2; ++b)
#pragma unroll
            for (int m = 0; m < 4; ++m)
#pragma unroll
                for (int n = 0; n < 2; ++n) acc[a][b][m][n] = (f32x4){0.f, 0.f, 0.f, 0.f};
    bf16x8 At[4][2], B0[2][2], B1[2][2];
    const char* cA = (const char*)g.A + (size_t)cur.pm * tstep; const char* cB = (const char*)g.Bt + (g.bmap ? wgu_off(cur.pe) : (size_t)cur.pe * g.bstride) + (size_t)cur.pn * tstep;
    S.a_ready(cur);
    if constexpr (SP2) {
        PG8_STAGE(PG8_SB(0, 0), cB, voffB); PG8_STAGE(PG8_SB(0, 1), cB + hstep, voffB); PG8_STAGE(PG8_SA(0, 0), cA, voffA); PG8_STAGE(PG8_SA(0, 1), cA + hstep, voffA);
        if (wr == 1) PG8_BAR;
        PG8_WAIT_V(2); PG8_BAR;
        PG8_STAGE(PG8_SB(1, 0), cB + kstep, voffB); PG8_STAGE(PG8_SA(1, 0), cA + kstep, voffA); PG8_STAGE(PG8_SB(1, 1), cB + hstep + kstep, voffB);
        PG8_WAIT_V(6); PG8_BAR;
    } else {
        PG8_STAGE(PG8_SB(0, 0), cB, voffB); PG8_STAGE(PG8_SA(0, 0), cA, voffA); PG8_STAGE(PG8_SB(0, 1), cB + hstep, voffB); PG8_STAGE(PG8_SA(0, 1), cA + hstep, voffA);
        if (wr == 1) PG8_BAR;
        PG8_WAIT_V(4); PG8_BAR;
        PG8_STAGE(PG8_SB(1, 0), cB + kstep, voffB); PG8_STAGE(PG8_SA(1, 0), cA + kstep, voffA); PG8_STAGE(PG8_SB(1, 1), cB + hstep + kstep, voffB);
        PG8_WAIT_V(6); PG8_BAR;
    }
    for (;;) {
        const bool has_next = S.next(ui + 1, nxt);
        const char* nA = has_next ? (const char*)g.A + (size_t)nxt.pm * tstep : cA; const char* nB = has_next ? (const char*)g.Bt + (g.bmap ? wgu_off(nxt.pe) : (size_t)nxt.pe * g.bstride) + (size_t)nxt.pn * tstep : cB;
        for (int t = 0; t < nt; t += 2) {
            const bool last = (t == nt - 2);
            const char* a1 = cA + (size_t)(t + 1) * kstep;
            const char* a2 = last ? nA : cA + (size_t)(t + 2) * kstep; const char* b2 = last ? nB : cB + (size_t)(t + 2) * kstep;
            const char* a3 = a2 + kstep; const char* b3 = b2 + kstep;
            if (last && has_next) S.a_ready(nxt);
            if constexpr (SP2) {
            PG8_LDB(B0, 0, 0); PG8_LDB(B1, 0, 1); PG8_SCHED; PG8_LDA(At, 0, 0); PG8_STAGE(PG8_SA(1, 1), a1 + hstep, voffA);
            PG8_WAIT_V(8); PG8_WAIT_L(0); PG8_BAR; PG8_MMA(0, 0, At, B0); PG8_MMA(0, 1, At, B1); PG8_BAR; PG8_SCHED;
            PG8_LDA(At, 0, 1); PG8_STAGE(PG8_SB(0, 0), b2, voffB); PG8_STAGE(PG8_SB(0, 1), b2 + hstep, voffB); PG8_STAGE(PG8_SA(0, 0), a2, voffA);
            PG8_WAIT_V(8); PG8_WAIT_L(0); PG8_BAR; PG8_MMA(1, 0, At, B0); PG8_MMA(1, 1, At, B1); PG8_BAR; PG8_SCHED;
            PG8_LDB(B0, 1, 0); PG8_LDB(B1, 1, 1); PG8_SCHED; PG8_LDA(At, 1, 0); PG8_STAGE(PG8_SA(0, 1), a2 + hstep, voffA);
            PG8_WAIT_V(8); PG8_WAIT_L(0); PG8_BAR; PG8_MMA(0, 0, At, B0); PG8_MMA(0, 1, At, B1); PG8_BAR; PG8_SCHED;
            PG8_LDA(At, 1, 1); PG8_STAGE(PG8_SB(1, 0), b3, voffB); PG8_STAGE(PG8_SB(1, 1), b3 + hstep, voffB); PG8_STAGE(PG8_SA(1, 0), a3, voffA);
            PG8_WAIT_V(8); PG8_WAIT_L(0); PG8_BAR; PG8_MMA(1, 0, At, B0); PG8_MMA(1, 1, At, B1); PG8_BAR; PG8_SCHED;
            } else {
            PG8_LDB(B0, 0, 0); PG8_SCHED; PG8_LDA(At, 0, 0); PG8_STAGE(PG8_SA(1, 1), a1 + hstep, voffA);
            PG8_WAIT_L(8); PG8_BAR; PG8_WAIT_L(0); PG8_MMA(0, 0, At, B0); PG8_BAR; PG8_SCHED;
            PG8_LDB(B1, 0, 1); PG8_STAGE(PG8_SB(0, 0), b2, voffB);
            PG8_BAR; PG8_WAIT_L(0); PG8_MMA(0, 1, At, B1); PG8_BAR;
            PG8_LDA(At, 0, 1); PG8_STAGE(PG8_SA(0, 0), a2, voffA);
            PG8_BAR; PG8_WAIT_L(0); PG8_MMA(1, 0, At, B0); PG8_BAR; PG8_SCHED;
            PG8_STAGE(PG8_SB(0, 1), b2 + hstep, voffB);
            PG8_WAIT_V(6); PG8_BAR; PG8_MMA(1, 1, At, B1); PG8_BAR;
            PG8_LDB(B0, 1, 0); PG8_SCHED; PG8_LDA(At, 1, 0); PG8_STAGE(PG8_SA(0, 1), a2 + hstep, voffA);
            PG8_WAIT_L(8); PG8_BAR; PG8_WAIT_L(0); PG8_MMA(0, 0, At, B0); PG8_BAR; PG8_SCHED;
            PG8_LDB(B1, 1, 1); PG8_STAGE(PG8_SB(1, 0), b3, voffB);
            PG8_BAR; PG8_WAIT_L(0); PG8_MMA(0, 1, At, B1); PG8_BAR;
            PG8_LDA(At, 1, 1); PG8_STAGE(PG8_SA(1, 0), a3, voffA);
            PG8_BAR; PG8_WAIT_L(0); PG8_MMA(1, 0, At, B0); PG8_BAR; PG8_SCHED;
            PG8_STAGE(PG8_SB(1, 1), b3 + hstep, voffB);
            PG8_WAIT_V(6); PG8_BAR; PG8_MMA(1, 1, At, B1); PG8_BAR;
            }
        }
        if constexpr (ALIGN_EPI) { if (wr == 0) PG8_BAR; }
        E(acc, cur, wr, wc, fr, fq); S.done(cur);
        if (!has_next) break;
#pragma unroll
        for (int a = 0; a < 2; ++a)
#pragma unroll
            for (int b = 0; b < 2; ++b)
#pragma unroll
                for (int m = 0; m < 4; ++m)
#pragma unroll
                    for (int n = 0; n < 2; ++n) acc[a][b][m][n] = (f32x4){0.f, 0.f, 0.f, 0.f};
        cur = nxt; cA = nA; cB = nB; ++ui;
        if constexpr (ALIGN_EPI) { if (wr == 1) PG8_BAR; }
    }
    PG8_WAIT_V(0);
    if constexpr (!ALIGN_EPI) { if (wr == 0) PG8_BAR; }
    PG8_BAR;
#undef PG8_SA
#undef PG8_SB
#undef PG8_STAGE
#undef PG8_LDA
#undef PG8_LDB
#undef PG8_MMA
#undef PG8_WAIT_V
#undef PG8_WAIT_L
#undef PG8_BAR
#undef PG8_SCHED
}
}

#define GAS __attribute__((address_space(1)))
#define LAS __attribute__((address_space(3)))
typedef unsigned v4u __attribute__((ext_vector_type(4)));
typedef unsigned v2u __attribute__((ext_vector_type(2)));
typedef float f32x4 __attribute__((ext_vector_type(4)));
#define LDS_WAIT() asm volatile("s_waitcnt lgkmcnt(0)" ::: "memory")
__device__ __forceinline__ unsigned pk2(float lo, float hi) { return (unsigned)f2bf(lo) | ((unsigned)f2bf(hi) << 16); }

#define XB_TMO      128
#define XB_XCNT(j)  (256  + 64 * (j))
#define XB_XSUB(j)  (1280 + 64 * (j))
#define XB_XGEN(j)  (2304 + 64 * (j))
#define XB_TOP      3328
#define XB_TOPGEN   3392
#define XCD_BAR_WORDS 3456
#define XB_SPIN_CAP (1u << 18)
__device__ __forceinline__ unsigned xb_ld(unsigned* p)              { return __hip_atomic_load(p, __ATOMIC_RELAXED, __HIP_MEMORY_SCOPE_AGENT); }
__device__ __forceinline__ unsigned xb_add(unsigned* p, unsigned v) { return __hip_atomic_fetch_add(p, v, __ATOMIC_RELAXED, __HIP_MEMORY_SCOPE_AGENT); }
__device__ __forceinline__ unsigned xb_xcc_id() { return (unsigned)__builtin_amdgcn_s_getreg((3 << 11) | 20) & 0xFu; }
#define XB_SPIN(cond, bar) do { unsigned _sp = 0; while (cond) { __builtin_amdgcn_s_sleep(1); \
    if ((++_sp & 255u) == 0u) { if (xb_ld(&(bar)[XB_TMO])) break; if (_sp > XB_SPIN_CAP) { atomicAdd(&(bar)[XB_TMO], 1u); break; } } } } while (0)
struct XcdBarrier { unsigned* bar; unsigned x; volatile LAS unsigned* st; };
__device__ __forceinline__ XcdBarrier xcd_barrier_post(unsigned* bar, volatile LAS unsigned* st) {
    XcdBarrier b; b.bar = bar; b.x = xb_xcc_id(); b.st = st;
    if (threadIdx.x == 0) (void)xb_add(&bar[XB_XCNT(b.x)], 1u);
    return b;
}
__device__ __forceinline__ void xcd_barrier_complete(unsigned* bar, unsigned x, unsigned& nloc, unsigned& nx) {
    const unsigned G = gridDim.x * gridDim.y * gridDim.z;
    unsigned sum, cnt, mine, sp = 0u;
    for (;;) {
        sum = 0u; cnt = 0u; mine = 0u;
#pragma unroll
        for (unsigned j = 0; j < 16; ++j) { const unsigned c = xb_ld(&bar[XB_XCNT(j)]); sum += c; cnt += (c > 0u) ? 1u : 0u; mine = (j == x) ? c : mine; }
        if (sum == G) break;
        __builtin_amdgcn_s_sleep(1);
        if ((++sp & 255u) == 0u) { if (xb_ld(&bar[XB_TMO])) break; if (sp > XB_SPIN_CAP) { atomicAdd(&bar[XB_TMO], 1u); break; } }
    }
    nloc = mine > 0u ? mine : 1u; nx = cnt > 0u ? cnt : 1u;
}
__device__ __forceinline__ void xcd_barrier(const XcdBarrier& b) {
    asm volatile("s_waitcnt vmcnt(0)" ::: "memory");
    __syncthreads();
    if (threadIdx.x == 0) {
        unsigned* bar = b.bar;
        __builtin_amdgcn_s_waitcnt(0);
        unsigned nloc = b.st[0], nx = b.st[1];
        if (nloc == 0u) { xcd_barrier_complete(bar, b.x, nloc, nx); b.st[0] = nloc; b.st[1] = nx; }
        const unsigned old = xb_add(&bar[XB_XSUB(b.x)], 1u);
        const unsigned gen = old / nloc;
        if (old + 1u == (gen + 1u) * nloc) {
            __builtin_amdgcn_fence(__ATOMIC_RELEASE, "agent");
            asm volatile("s_waitcnt vmcnt(0)" ::: "memory");
            const unsigned og = xb_add(&bar[XB_TOP], 1u);
            const unsigned tg = og / nx;
            if (og + 1u == (tg + 1u) * nx) xb_add(&bar[XB_TOPGEN], 1u);
            else XB_SPIN(xb_ld(&bar[XB_TOPGEN]) == tg, bar);
            __builtin_amdgcn_fence(__ATOMIC_ACQUIRE, "agent");
            xb_add(&bar[XB_XGEN(b.x)], 1u);
            asm volatile("s_waitcnt vmcnt(0)" ::: "memory");
        } else {
            XB_SPIN(xb_ld(&bar[XB_XGEN(b.x)]) == gen, bar);
            __builtin_amdgcn_fence(__ATOMIC_ACQUIRE, "agent");
            asm volatile("s_waitcnt vmcnt(0)" ::: "memory");
        }
    }
    __syncthreads();
}

constexpr int RING_BYTES = 131072;
constexpr int TAB_OFF = RING_BYTES;
constexpr int TAB_CNT = TAB_OFF, TAB_ROWBASE = TAB_OFF + 128, TAB_NT = TAB_OFF + 256, TAB_TEXP = TAB_OFF + 272;
constexpr int MISC_OFF = TAB_OFF + 4096;
constexpr int PTAB_OFF = MISC_OFF + 16;
constexpr int LDS_BYTES = 147456;
static_assert(TAB_TEXP + MOE_MAXTILES * 4 <= MISC_OFF && PTAB_OFF + 32 * 8 <= LDS_BYTES, "LDS map");

#define DPP_ADD_(v_, ctrl_) (v_) += __builtin_bit_cast(float, __builtin_amdgcn_update_dpp(0, __builtin_bit_cast(int, (v_)), (ctrl_), 0xF, 0xF, true))
__device__ __forceinline__ float row16_sum(float v) { DPP_ADD_(v, 0xB1); DPP_ADD_(v, 0x4E); DPP_ADD_(v, 0x124); DPP_ADD_(v, 0x128); return v; }
__device__ __forceinline__ float wave_sum(float v, int lane) {
    v = row16_sum(v);
#pragma unroll
    for (int o = 16; o < 64; o <<= 1) v += __builtin_bit_cast(float, __builtin_amdgcn_ds_bpermute((lane ^ o) << 2, __builtin_bit_cast(int, v)));
    return v;
}
__device__ __forceinline__ void transpose_load(float (&v)[32], const float* W, int N, int k0, int n0, int lane) {
#pragma unroll
    for (int i = 0; i < 32; ++i) { const int kk = 2 * i + (lane >> 5); v[i] = __builtin_nontemporal_load((const GAS float*)W + (size_t)(k0 + kk) * N + n0 + (lane & 31)); } }
__device__ __forceinline__ void transpose_finish(const float (&v)[32], int K, bf16* WT, int k0, int drow0, LAS float* scr, int lane, const float sc, const int rmode) {
#pragma unroll
    for (int i = 0; i < 32; ++i) { const int kk = 2 * i + (lane >> 5); scr[kk * 33 + (lane & 31)] = v[i]; }
    LDS_WAIT(); asm volatile("" ::: "memory");
    const int c = lane & 7;
#pragma unroll
    for (int j = 0; j < 4; ++j) { const int n = (lane >> 3) + 8 * j; const LAS float* s = scr + (8 * c) * 33 + n;
        v4u o; o.x = pk2(s[0 * 33] * sc, s[1 * 33] * sc); o.y = pk2(s[2 * 33] * sc, s[3 * 33] * sc); o.z = pk2(s[4 * 33] * sc, s[5 * 33] * sc); o.w = pk2(s[6 * 33] * sc, s[7 * 33] * sc);
        const int dn = rmode == 0 ? n : (rmode == 1 ? 2 * n : (n < 8 ? 2 * n : (n < 16 ? 2 * (n - 8) + 1 : n)));
        __builtin_nontemporal_store(o, (GAS v4u*)(WT + (size_t)(drow0 + dn) * K + k0 + 8 * c)); }
    LDS_WAIT(); asm volatile("" ::: "memory");
}
__device__ __forceinline__ void transpose_item(const float* W, int K, int N, bf16* WT, int k0, int n0, int drow0, LAS float* scr, int lane, const float sc = 1.f, const int rmode = 0) {
    float v[32]; transpose_load(v, W, N, k0, n0, lane); transpose_finish(v, K, WT, k0, drow0, scr, lane, sc, rmode); }
__device__ __forceinline__ void build_moe_tables(LAS unsigned char* lds, const unsigned* cnt_words, const int tid) {
    LAS int* tcnt = (LAS int*)(lds + TAB_CNT); LAS int* trb = (LAS int*)(lds + TAB_ROWBASE); LAS int* tnt = (LAS int*)(lds + TAB_NT); LAS int* texp = (LAS int*)(lds + TAB_TEXP);
    __syncthreads();
    if (cnt_words) { if (tid < NEXP) tcnt[tid] = (int)__hip_atomic_load(cnt_words + 64 * tid, __ATOMIC_RELAXED, __HIP_MEMORY_SCOPE_AGENT); }
    __syncthreads();
    if (tid == 0) { int tile = 0;
#pragma unroll 1
        for (int e = 0; e < NEXP; ++e) { int c = tcnt[e]; if (c > 2 * T) c = 2 * T; int nt = (c + 255) >> 8; if (tile + nt > MOE_MAXTILES) nt = MOE_MAXTILES - tile; trb[e] = tile * 256;
#pragma unroll 1
            for (int i = 0; i < nt; ++i) texp[tile + i] = e;
            tile += nt; }
        tnt[0] = tile; }
    __syncthreads();
}

__device__ __forceinline__ void transpose_item64(const float* W, int K, int N, bf16* WT, int k0, int n0, int drow0, LAS float* scr, int lane, const float sc = 1.f) {
    const int r = lane >> 4, c4 = lane & 15;
#pragma unroll 4
    for (int i = 0; i < 16; ++i) { const int k = 4 * i + r; const f32x4 v = *(const GAS f32x4*)(W + (size_t)(k0 + k) * N + n0 + 4 * c4);
        scr[k * 64 + ((4 * c4 + 0) ^ k)] = v.x; scr[k * 64 + ((4 * c4 + 1) ^ k)] = v.y; scr[k * 64 + ((4 * c4 + 2) ^ k)] = v.z; scr[k * 64 + ((4 * c4 + 3) ^ k)] = v.w; }
    LDS_WAIT(); asm volatile("" ::: "memory");
    const int c = lane & 7;
#pragma unroll
    for (int j = 0; j < 8; ++j) { const int n = (lane >> 3) + 8 * j; float f[8];
#pragma unroll
        for (int e = 0; e < 8; ++e) { const int k = 8 * c + e; f[e] = scr[k * 64 + (n ^ k)] * sc; }
        *(GAS v4u*)(WT + (size_t)(drow0 + n) * K + k0 + 8 * c) = (v4u){pk2(f[0], f[1]), pk2(f[2], f[3]), pk2(f[4], f[5]), pk2(f[6], f[7])}; }
    LDS_WAIT(); asm volatile("" ::: "memory");
}

struct TrItem { const float* src; bf16* dst; int K, N, k0, n0, drow0; };
__device__ __forceinline__ void tr64_load(f32x4 (&v)[16], const TrItem& p, int lane) { const int r = lane >> 4, c4 = lane & 15;
#pragma unroll
    for (int i = 0; i < 16; ++i) v[i] = __builtin_nontemporal_load((const GAS f32x4*)(p.src + (size_t)(p.k0 + 4 * i + r) * p.N + p.n0 + 4 * c4)); }
__device__ __forceinline__ void tr64_put(const f32x4 (&v)[16], LAS float* scr, int lane) { const int r = lane >> 4, c4 = lane & 15;
#pragma unroll
    for (int i = 0; i < 16; ++i) { const int k = 4 * i + r; scr[k * 64 + ((4 * c4 + 0) ^ k)] = v[i].x; scr[k * 64 + ((4 * c4 + 1) ^ k)] = v[i].y; scr[k * 64 + ((4 * c4 + 2) ^ k)] = v[i].z; scr[k * 64 + ((4 * c4 + 3) ^ k)] = v[i].w; }
    LDS_WAIT(); asm volatile("" ::: "memory"); }
__device__ __forceinline__ void tr64_get(const TrItem& p, LAS float* scr, int lane) { const int c = lane & 7;
#pragma unroll
    for (int j = 0; j < 8; ++j) { const int n = (lane >> 3) + 8 * j; float f[8];
#pragma unroll
        for (int e = 0; e < 8; ++e) { const int k = 8 * c + e; f[e] = scr[k * 64 + (n ^ k)]; }
        __builtin_nontemporal_store(((v4u){pk2(f[0], f[1]), pk2(f[2], f[3]), pk2(f[4], f[5]), pk2(f[6], f[7])}), (GAS v4u*)(p.dst + (size_t)(p.drow0 + n) * p.K + p.k0 + 8 * c)); }
    LDS_WAIT(); asm volatile("" ::: "memory"); }

struct Args { const void* in[30]; float* out; unsigned char* ws; int layer, pad; };
__device__ __forceinline__ Ctx make_ctx(const Args& args, unsigned char* ws, int l) {
    Ctx c;
    c.pos = (const int*)args.in[1];
    c.gam = (const float*)args.in[5] + l * 16; c.ret_g = (const float*)args.in[6] + l * 512; c.mu = (const float*)args.in[7] + l * 2 * B_COLS;
    c.w0 = (const float*)args.in[8] + l * 1024; c.w2 = (const float*)args.in[9] + l * 96 * 512; c.a0 = (const float*)args.in[10] + l * 1024; c.a2 = (const float*)args.in[11] + l * 96 * 512;
    c.g2 = (const float*)args.in[12] + l * 256 * 512; c.k_k = (const float*)args.in[13] + l * 512; c.k_a = (const float*)args.in[14] + l * 512; c.r_k = (const float*)args.in[15] + l * 512;
    c.ln_g = (const float*)args.in[16] + l * 512; c.sgu_g = (const float*)args.in[17] + l * 512; c.sgu_b = (const float*)args.in[18] + l * 512;
    c.sgu_w = (const float*)args.in[19] + (size_t)l * 8 * 128 * 128; c.sgu_bias = (const float*)args.in[20] + l * 1024;
    c.proj = (bf16*)(ws + WS_PROJ); c.ycat = (bf16*)(ws + WS_ACT);
    c.rs = (bf16*)(ws + WS_RS); c.ks = (bf16*)(ws + WS_KS); c.vs = (bf16*)(ws + WS_VS); c.kk = (bf16*)(ws + WS_KK); c.gg = (bf16*)(ws + WS_GG);
    c.kdf = (bf16*)(ws + WS_KDF); c.kdb = (bf16*)(ws + WS_KDB); c.akf = (bf16*)(ws + WS_AKF); c.akb = (bf16*)(ws + WS_AKB); c.yf = (bf16*)(ws + WS_YF); c.yb = (bf16*)(ws + WS_YB);
    c.loraw = (const bf16*)(ws + WS_LORAW);
    c.lin = (bf16*)(ws + WS_LIN); c.wf = (float*)(ws + WS_WF); c.wb = (float*)(ws + WS_WB); c.rkv = (float*)(ws + WS_RKV); c.rsp = (float*)(ws + WS_RSP);
    return c;
}


#define ROW_LOAD(v, ptr) _Pragma("unroll") for (int j = 0; j < 8; ++j) v[j] = ((const GAS f32x4*)(ptr))[lane + 64 * j]
#define ROW_LOAD_BF(v, ptr) _Pragma("unroll") for (int j = 0; j < 8; ++j) { const v2u w_ = ((const GAS v2u*)(ptr))[lane + 64 * j]; \
    v[j] = (f32x4){__builtin_bit_cast(float, w_.x << 16), __builtin_bit_cast(float, w_.x & 0xffff0000u), __builtin_bit_cast(float, w_.y << 16), __builtin_bit_cast(float, w_.y & 0xffff0000u)}; }
__device__ __forceinline__ void row_add_moe(f32x4 (&v)[8], const bf16* yp, size_t R1, size_t R2, float g1, float g2, int lane) {
#pragma unroll
    for (int j = 0; j < 8; ++j) { const v2u a = ((const GAS v2u*)(yp + R1 * DM))[lane + 64 * j], b = ((const GAS v2u*)(yp + R2 * DM))[lane + 64 * j];
        v[j].x += g1 * bf2f((bf16)(a.x & 0xffff)) + g2 * bf2f((bf16)(b.x & 0xffff)); v[j].y += g1 * bf2f((bf16)(a.x >> 16)) + g2 * bf2f((bf16)(b.x >> 16));
        v[j].z += g1 * bf2f((bf16)(a.y & 0xffff)) + g2 * bf2f((bf16)(b.y & 0xffff)); v[j].w += g1 * bf2f((bf16)(a.y >> 16)) + g2 * bf2f((bf16)(b.y >> 16)); }
}
__device__ __forceinline__ float row_rstd(const f32x4 (&v)[8], int lane) {
    float ss = 0.f;
#pragma unroll
    for (int j = 0; j < 8; ++j) ss += (v[j].x * v[j].x + v[j].y * v[j].y) + (v[j].z * v[j].z + v[j].w * v[j].w);
    return 1.f / sqrtf(wave_sum(ss, lane) * (1.f / DM) + NORM_EPS);
}
__device__ __forceinline__ f32x4 up2(v2u w) { return (f32x4){__builtin_bit_cast(float, w.x << 16), __builtin_bit_cast(float, w.x & 0xffff0000u), __builtin_bit_cast(float, w.y << 16), __builtin_bit_cast(float, w.y & 0xffff0000u)}; }
template <int NB> __device__ __forceinline__ void wave_sum_n(float (&v)[NB], int lane) {
#pragma unroll
    for (int u = 0; u < NB; ++u) v[u] = row16_sum(v[u]);
#pragma unroll
    for (int o = 16; o < 64; o <<= 1) { float t_[NB];
#pragma unroll
        for (int u = 0; u < NB; ++u) t_[u] = __builtin_bit_cast(float, __builtin_amdgcn_ds_bpermute((lane ^ o) << 2, __builtin_bit_cast(int, v[u])));
#pragma unroll
        for (int u = 0; u < NB; ++u) v[u] += t_[u]; } }
template <int NB>
__device__ __forceinline__ void rows_norm_f32(const float* x_in, const float* gain, bf16* act, int m0, int mstride, int lane) {
    f32x4 v[NB][8]; float ss[NB];
#pragma unroll
    for (int u = 0; u < NB; ++u) { const int m = m0 + u * mstride;
#pragma unroll
        for (int j = 0; j < 8; ++j) v[u][j] = m < T ? ((const GAS f32x4*)(x_in + (size_t)m * DM))[lane + 64 * j] : (f32x4){0.f, 0.f, 0.f, 0.f}; }
#pragma unroll
    for (int u = 0; u < NB; ++u) { ss[u] = 0.f;
#pragma unroll
        for (int j = 0; j < 8; ++j) ss[u] += (v[u][j].x * v[u][j].x + v[u][j].y * v[u][j].y) + (v[u][j].z * v[u][j].z + v[u][j].w * v[u][j].w); }
    wave_sum_n<NB>(ss, lane);
#pragma unroll
    for (int u = 0; u < NB; ++u) { const int m = m0 + u * mstride; const float rstd = 1.f / sqrtf(ss[u] * (1.f / DM) + NORM_EPS);
        if (m < T) {
#pragma unroll
            for (int j = 0; j < 8; ++j) { const f32x4 g = ((const GAS f32x4*)gain)[lane + 64 * j];
                v2u o; o.x = pk2(v[u][j].x * rstd * g.x, v[u][j].y * rstd * g.y); o.y = pk2(v[u][j].z * rstd * g.z, v[u][j].w * rstd * g.w);
                ((GAS v2u*)(act + (size_t)m * DM))[lane + 64 * j] = o; } } }
}
template <int NB, bool FINAL>
__device__ __forceinline__ void rows_moe(bf16* xbuf, const bf16* yp, const unsigned* slot_tok, const float* gate_tok, const LAS int* trb, const float* gain, bf16* act, float* out, float pscale, int m0, int mstride, int lane) {
    v2u xr[NB][8], ya[NB][8], yb[NB][8]; float g1[NB], g2[NB], ss[NB]; size_t R1[NB], R2[NB];
#pragma unroll
    for (int u = 0; u < NB; ++u) { const int m = m0 + u * mstride < T ? m0 + u * mstride : m0;
        const unsigned s1 = slot_tok[2 * m], s2 = slot_tok[2 * m + 1]; g1[u] = gate_tok[2 * m]; g2[u] = gate_tok[2 * m + 1];
        R1[u] = (size_t)(trb[s1 >> 20] + (int)(s1 & 0xfffffu)); R2[u] = (size_t)(trb[s2 >> 20] + (int)(s2 & 0xfffffu)); }
#pragma unroll
    for (int u = 0; u < NB; ++u) { const int m = m0 + u * mstride < T ? m0 + u * mstride : m0;
#pragma unroll
        for (int j = 0; j < 8; ++j) { xr[u][j] = ((const GAS v2u*)(xbuf + (size_t)m * DM))[lane + 64 * j]; ya[u][j] = ((const GAS v2u*)(yp + R1[u] * DM))[lane + 64 * j]; yb[u][j] = ((const GAS v2u*)(yp + R2[u] * DM))[lane + 64 * j]; } }
#pragma unroll
    for (int u = 0; u < NB; ++u) { const int m = m0 + u * mstride; ss[u] = 0.f;
#pragma unroll
        for (int j = 0; j < 8; ++j) { f32x4 t = up2(xr[u][j]) + g1[u] * up2(ya[u][j]) + g2[u] * up2(yb[u][j]);
            if constexpr (!FINAL) { v2u o; o.x = pk2(t.x, t.y); o.y = pk2(t.z, t.w); if (m < T) ((GAS v2u*)(xbuf + (size_t)m * DM))[lane + 64 * j] = o; t = up2(o); xr[u][j] = o; }
            else { ya[u][j] = (v2u){__builtin_bit_cast(unsigned, t.x), __builtin_bit_cast(unsigned, t.y)}; yb[u][j] = (v2u){__builtin_bit_cast(unsigned, t.z), __builtin_bit_cast(unsigned, t.w)}; }
            ss[u] += (t.x * t.x + t.y * t.y) + (t.z * t.z + t.w * t.w); } }
    wave_sum_n<NB>(ss, lane);
#pragma unroll
    for (int u = 0; u < NB; ++u) { const int m = m0 + u * mstride; const float rstd = 1.f / sqrtf(ss[u] * (1.f / DM) + NORM_EPS);
        if (m < T) {
#pragma unroll
            for (int j = 0; j < 8; ++j) { const f32x4 g = ((const GAS f32x4*)gain)[lane + 64 * j];
                if constexpr (!FINAL) { const f32x4 t = up2(xr[u][j]); v2u o; o.x = pk2(t.x * rstd * g.x, t.y * rstd * g.y); o.y = pk2(t.z * rstd * g.z, t.w * rstd * g.w); ((GAS v2u*)(act + (size_t)m * DM))[lane + 64 * j] = o; }
                else { const f32x4 t = (f32x4){__builtin_bit_cast(float, ya[u][j].x), __builtin_bit_cast(float, ya[u][j].y), __builtin_bit_cast(float, yb[u][j].x), __builtin_bit_cast(float, yb[u][j].y)};
                    ((GAS f32x4*)(out + (size_t)m * DM))[lane + 64 * j] = (f32x4){t.x * rstd * g.x * pscale, t.y * rstd * g.y * pscale, t.z * rstd * g.z * pscale, t.w * rstd * g.w * pscale}; } } } }
}
#define SEAM(k) do { if constexpr (KSEL < 0) { XcdBarrier b_ = bar; unsigned blo_ = __builtin_amdgcn_readfirstlane((unsigned)(unsigned long long)b_.bar), bhi_ = __builtin_amdgcn_readfirstlane((unsigned)((unsigned long long)b_.bar >> 32)); \
    asm volatile("" : "+s"(blo_), "+s"(bhi_)); b_.bar = (unsigned*)(((unsigned long long)bhi_ << 32) | blo_); xcd_barrier(b_); } } while (0)
#define PORD(k) ((k) == 13 ? 6 : ((k) >= 6 ? (k) + 1 : (k)))
#define TSTAMP_AFTER(k) do { if (KB_TPROBE >= 0 && KSEL < 0 && blockIdx.x == 0 && threadIdx.x == 0) ((unsigned long long*)(args.ws + WS_CTL))[32768 + 1 + l * 13 + PORD(k)] = wall_clock64(); } while (0)
#define PH_ON(k) if constexpr ((KSEL < 0 && KB_EN(k)) || KSEL == (k))
#define PHASE_LOCALS() GAS unsigned char* wsg_ = (GAS unsigned char*)args.ws; int ll = KSEL < 0 ? l : __builtin_amdgcn_readfirstlane(l); int tid = threadIdx.x; asm volatile("" : "+s"(wsg_), "+s"(ll), "+v"(tid)); \
    unsigned char* ws = (unsigned char*)wsg_;         \
    const int lane = tid & 63, wave = __builtin_amdgcn_readfirstlane(tid >> 6); \
    const int G = gridDim.x, bid = blockIdx.x; const long gtid = (long)bid * 512 + tid, gstride = (long)G * 512; const int gw = bid * 8 + wave, NGW = G * 8; \
    (void)gtid; (void)gstride; (void)gw; (void)NGW; (void)ll; (void)lane


typedef short bf16x8 __attribute__((ext_vector_type(8)));
typedef short s16x4 __attribute__((ext_vector_type(4)));
typedef short v4i16_t __attribute__((ext_vector_type(4)));
#ifndef KB_EMU
#define MMA16(a, b, c) __builtin_amdgcn_mfma_f32_16x16x32_bf16((a), (b), (c), 0, 0, 0)
#define TR16(p) __builtin_amdgcn_ds_read_tr16_b64_v4i16((LAS v4i16_t*)(p))
#define BPERM(addr, v) __builtin_amdgcn_ds_bpermute((addr), (v))
#define RFL(x) __builtin_amdgcn_readfirstlane(x)
#define FEXP(x) __expf(x)
#define BSYNC() __syncthreads()
#define LBAR() do { asm volatile("s_waitcnt lgkmcnt(0)" ::: "memory"); __builtin_amdgcn_s_barrier(); asm volatile("" ::: "memory"); } while (0)
#define LDS_WAIT_() do { asm volatile("s_waitcnt lgkmcnt(0)" ::: "memory"); } while (0)
#endif
__device__ __forceinline__ bf16x8 frag_row(const LAS bf16* X, int ld, int r0, int c0, int fr, int fq) { return *(const LAS bf16x8*)(X + (r0 + fr) * ld + c0 + 8 * fq); }
__device__ __forceinline__ s16x4 tr4(const LAS bf16* X, int ld, int r0, int c0, int fr) { return __builtin_bit_cast(s16x4, TR16(X + (r0 + (fr >> 2)) * ld + c0 + 4 * (fr & 3))); }
__device__ __forceinline__ bf16x8 frag_col(const LAS bf16* X, int ld, int k0, int c0, int fr, int fq) {
    const s16x4 a = tr4(X, ld, k0 + 8 * fq, c0, fr), b = tr4(X, ld, k0 + 8 * fq + 4, c0, fr);
    return (bf16x8){a[0], a[1], a[2], a[3], b[0], b[1], b[2], b[3]}; }
#ifndef KB_EMU
typedef float cvt_f2 __attribute__((ext_vector_type(2)));
typedef __bf16 cvt_b2 __attribute__((ext_vector_type(2)));
__device__ __forceinline__ unsigned cvtpk(float lo, float hi) { return __builtin_bit_cast(unsigned, __builtin_convertvector(((cvt_f2){lo, hi}), cvt_b2)); }
#else
inline unsigned cvtpk(float lo, float hi) { return (unsigned)f2bf(lo) | ((unsigned)f2bf(hi) << 16); }
#endif
__device__ __forceinline__ float xlane_max4(float v, int lane) {
    v = fmaxf(v, __builtin_bit_cast(float, BPERM((lane ^ 16) << 2, __builtin_bit_cast(int, v))));
    v = fmaxf(v, __builtin_bit_cast(float, BPERM((lane ^ 32) << 2, __builtin_bit_cast(int, v)))); return v; }
__device__ __forceinline__ float xlane_sum4(float v, int lane) {
    v += __builtin_bit_cast(float, BPERM((lane ^ 16) << 2, __builtin_bit_cast(int, v)));
    v += __builtin_bit_cast(float, BPERM((lane ^ 32) << 2, __builtin_bit_cast(int, v))); return v; }

__device__ __forceinline__ void unpack8(const v4u x, float (&f)[8]) {
    f[0] = __builtin_bit_cast(float, x.x << 16); f[1] = __builtin_bit_cast(float, x.x & 0xffff0000u); f[2] = __builtin_bit_cast(float, x.y << 16); f[3] = __builtin_bit_cast(float, x.y & 0xffff0000u);
    f[4] = __builtin_bit_cast(float, x.z << 16); f[5] = __builtin_bit_cast(float, x.z & 0xffff0000u); f[6] = __builtin_bit_cast(float, x.w << 16); f[7] = __builtin_bit_cast(float, x.w & 0xffff0000u); }
__device__ __forceinline__ void st8(bf16* p, const float (&f)[8]) { *(GAS v4u*)p = (v4u){cvtpk(f[0], f[1]), cvtpk(f[2], f[3]), cvtpk(f[4], f[5]), cvtpk(f[6], f[7])}; }
__device__ __forceinline__ float red8(float v, int lane) {
    v += __builtin_bit_cast(float, BPERM((lane ^ 1) << 2, __builtin_bit_cast(int, v))); v += __builtin_bit_cast(float, BPERM((lane ^ 2) << 2, __builtin_bit_cast(int, v)));
    v += __builtin_bit_cast(float, BPERM((lane ^ 4) << 2, __builtin_bit_cast(int, v))); return v; }
__device__ __forceinline__ void v_rot_table(const int* pos, float* rot, long idx) {
    const int j = (int)(idx % 40); const long t = idx / 40;
    const float inv = j < 32 ? expf(-(float)j * (1.f / 32.f) * 9.210340371976184f) : expf(-(float)(j - 32) * (1.f / 8.f) * 13.122363377404328f);
    float sn, cs; sincosf((float)pos[t] * inv, &sn, &cs); rot[idx * 2] = cs; rot[idx * 2 + 1] = sn; }
__device__ __forceinline__ void v_rot_ret(bf16* proj, const float* rot, long idx) {
    const int j8 = (int)(idx & 3), h = (int)((idx >> 2) & 7); const long t = idx >> 5;
    bf16* q = proj + (size_t)t * NPROJ + OFF_A + h * 64 + 8 * j8; bf16* k = q + 512; const float* cs = rot + ((size_t)t * 40 + 8 * j8) * 2;
    float q1[8], q2[8], k1[8], k2[8], c[8], s_[8];
    unpack8(*(const GAS v4u*)q, q1); unpack8(*(const GAS v4u*)(q + 32), q2); unpack8(*(const GAS v4u*)k, k1); unpack8(*(const GAS v4u*)(k + 32), k2);
#pragma unroll
    for (int i = 0; i < 4; ++i) { const f32x4 v = *(const GAS f32x4*)(cs + 4 * i); c[2 * i] = v.x; s_[2 * i] = v.y; c[2 * i + 1] = v.z; s_[2 * i + 1] = v.w; }
    float o1[8], o2[8], p1[8], p2[8];
#pragma unroll
    for (int i = 0; i < 8; ++i) { o1[i] = q1[i] * c[i] - q2[i] * s_[i]; o2[i] = q2[i] * c[i] + q1[i] * s_[i]; p1[i] = k1[i] * c[i] - k2[i] * s_[i]; p2[i] = k2[i] * c[i] + k1[i] * s_[i]; }
    st8(q, o1); st8(q + 32, o2); st8(k, p1); st8(k + 32, p2); }
__device__ __forceinline__ void v_rot_dil(bf16* proj, const float* rot, long idx) {
    const int h = (int)(idx & 7); const long t = idx >> 3;
    bf16* q = proj + (size_t)t * NPROJ + OFF_D + h * 64; bf16* k = q + 512; const float* cs = rot + ((size_t)t * 40 + 32) * 2;
    float q1[8], q2[8], k1[8], k2[8], c[8], s_[8];
    unpack8(*(const GAS v4u*)q, q1); unpack8(*(const GAS v4u*)(q + 8), q2); unpack8(*(const GAS v4u*)k, k1); unpack8(*(const GAS v4u*)(k + 8), k2);
#pragma unroll
    for (int i = 0; i < 4; ++i) { const f32x4 v = *(const GAS f32x4*)(cs + 4 * i); c[2 * i] = v.x; s_[2 * i] = v.y; c[2 * i + 1] = v.z; s_[2 * i + 1] = v.w; }
    float o1[8], o2[8], p1[8], p2[8];
#pragma unroll
    for (int i = 0; i < 8; ++i) { o1[i] = q1[i] * c[i] - q2[i] * s_[i]; o2[i] = q2[i] * c[i] + q1[i] * s_[i]; p1[i] = k1[i] * c[i] - k2[i] * s_[i]; p2[i] = k2[i] * c[i] + k1[i] * s_[i]; }
    st8(q, o1); st8(q + 8, o2); st8(k, p1); st8(k + 8, p2); }
__device__ __forceinline__ void v_rwkv_shift(const Ctx& c, long idx) {
    const int g8 = (int)(idx % 248), j0 = 8 * g8; const long t = idx / 248; const int s = (int)(t % SEQ);
    const bf16* p = c.proj + (size_t)t * NPROJ + OFF_B + j0;
    float x[8], xp[8], xn[8], o[8];
    unpack8(*(const GAS v4u*)p, x);
    if (s > 0) unpack8(*(const GAS v4u*)(p - NPROJ), xp); else { for (int i = 0; i < 8; ++i) xp[i] = 0.f; }
    if (s < SEQ - 1) unpack8(*(const GAS v4u*)(p + NPROJ), xn); else { for (int i = 0; i < 8; ++i) xn[i] = 0.f; }
#pragma unroll
    for (int i = 0; i < 8; ++i) o[i] = x[i] + c.mu[j0 + i] * (xp[i] - x[i]) + c.mu[B_COLS + j0 + i] * (xn[i] - x[i]);
    if (j0 < 512) st8(c.rs + t * 512 + j0, o);
    else if (j0 < 1024) st8(c.ks + t * 512 + j0 - 512, o);
    else if (j0 < 1536) st8(c.vs + t * 512 + j0 - 1024, o);
    else { if (j0 < 1632) { for (int i = 0; i < 8; ++i) o[i] = tanhf(o[i]); } else if (j0 >= 1728) { for (int i = 0; i < 8; ++i) o[i] = sigmoidf_(o[i]); }
        st8(c.lin + t * NLORA + (j0 - 1536), o); } }
struct ShiftIn { v4u x, xp, xn; };
__device__ __forceinline__ void shift_load(const Ctx& c, unsigned idx, ShiftIn& in) {
    const unsigned t = idx / 248u, j0 = 8u * (idx - t * 248u), s = t % (unsigned)SEQ;
    const bf16* p = c.proj + (size_t)t * NPROJ + OFF_B + j0; const v4u z = (v4u){0u, 0u, 0u, 0u};
    in.x = *(const GAS v4u*)p; in.xp = z; in.xn = z;
    if (s > 0) in.xp = *(const GAS v4u*)(p - NPROJ);
    if (s < (unsigned)SEQ - 1) in.xn = *(const GAS v4u*)(p + NPROJ); }
__device__ __forceinline__ void shift_finish(const Ctx& c, unsigned idx, const ShiftIn& in) {
    const unsigned t = idx / 248u, j0 = 8u * (idx - t * 248u);
    float x[8], xp[8], xn[8], o[8], mp[8], mn[8];
    unpack8(in.x, x); unpack8(in.xp, xp); unpack8(in.xn, xn);
    { const f32x4 a = *(const GAS f32x4*)(c.mu + j0), b = *(const GAS f32x4*)(c.mu + j0 + 4), d = *(const GAS f32x4*)(c.mu + B_COLS + j0), e = *(const GAS f32x4*)(c.mu + B_COLS + j0 + 4);
      mp[0] = a.x; mp[1] = a.y; mp[2] = a.z; mp[3] = a.w; mp[4] = b.x; mp[5] = b.y; mp[6] = b.z; mp[7] = b.w; mn[0] = d.x; mn[1] = d.y; mn[2] = d.z; mn[3] = d.w; mn[4] = e.x; mn[5] = e.y; mn[6] = e.z; mn[7] = e.w; }
#pragma unroll
    for (int i = 0; i < 8; ++i) o[i] = x[i] + mp[i] * (xp[i] - x[i]) + mn[i] * (xn[i] - x[i]);
    if (j0 < 512) st8(c.rs + (size_t)t * 512 + j0, o);
    else if (j0 < 1024) st8(c.ks + (size_t)t * 512 + j0 - 512, o);
    else if (j0 < 1536) st8(c.vs + (size_t)t * 512 + j0 - 1024, o);
    else { if (j0 < 1632) { for (int i = 0; i < 8; ++i) o[i] = tanhf(o[i]); } else if (j0 >= 1728) { for (int i = 0; i < 8; ++i) o[i] = sigmoidf_(o[i]); }
        st8(c.lin + (size_t)t * NLORA + (j0 - 1536), o); } }
__device__ __forceinline__ void w_sgu_prep(const Ctx& c, long t, int lane) {
    bf16* v = c.proj + (size_t)t * NPROJ + OFF_C + 512 + 8 * lane; float f[8]; unpack8(*(const GAS v4u*)v, f); float s = 0.f;
#pragma unroll
    for (int i = 0; i < 8; ++i) { f[i] = geluf_(f[i]); s += f[i]; }
    const float mean = wave_sum(s, lane) * (1.f / 512.f); float q = 0.f;
#pragma unroll
    for (int i = 0; i < 8; ++i) { f[i] -= mean; q += f[i] * f[i]; }
    const float rstd = 1.f / sqrtf(wave_sum(q, lane) * (1.f / 512.f) + NORM_EPS);
#pragma unroll
    for (int i = 0; i < 8; ++i) f[i] = f[i] * rstd * c.sgu_g[8 * lane + i] + c.sgu_b[8 * lane + i];
    st8(v, f); }
template <int NB>
__device__ __forceinline__ void w_sgu_prep_batch(const Ctx& c, int m0, int mstride, int lane) {
    float f[NB][8], s[NB], q[NB]; v4u raw[NB];
#pragma unroll
    for (int u = 0; u < NB; ++u) { const int t = m0 + u * mstride; raw[u] = (v4u){0u, 0u, 0u, 0u}; if (t < T) raw[u] = *(const GAS v4u*)(c.proj + (size_t)t * NPROJ + OFF_C + 512 + 8 * lane); }
#pragma unroll
    for (int u = 0; u < NB; ++u) { unpack8(raw[u], f[u]); s[u] = 0.f;
#pragma unroll
        for (int i = 0; i < 8; ++i) { f[u][i] = geluf_(f[u][i]); s[u] += f[u][i]; } }
#pragma unroll
    for (int u = 0; u < NB; ++u) s[u] = row16_sum(s[u]);
#pragma unroll
    for (int o = 16; o < 64; o <<= 1) { float t_[NB];
#pragma unroll
        for (int u = 0; u < NB; ++u) t_[u] = __builtin_bit_cast(float, __builtin_amdgcn_ds_bpermute((lane ^ o) << 2, __builtin_bit_cast(int, s[u])));
#pragma unroll
        for (int u = 0; u < NB; ++u) s[u] += t_[u]; }
#pragma unroll
    for (int u = 0; u < NB; ++u) { const float mean = s[u] * (1.f / 512.f); q[u] = 0.f;
#pragma unroll
        for (int i = 0; i < 8; ++i) { f[u][i] -= mean; q[u] += f[u][i] * f[u][i]; } }
#pragma unroll
    for (int u = 0; u < NB; ++u) q[u] = row16_sum(q[u]);
#pragma unroll
    for (int o = 16; o < 64; o <<= 1) { float t_[NB];
#pragma unroll
        for (int u = 0; u < NB; ++u) t_[u] = __builtin_bit_cast(float, __builtin_amdgcn_ds_bpermute((lane ^ o) << 2, __builtin_bit_cast(int, q[u])));
#pragma unroll
        for (int u = 0; u < NB; ++u) q[u] += t_[u]; }
    float gg_[8], bb_[8];
    { const f32x4 a = *(const GAS f32x4*)(c.sgu_g + 8 * lane), b = *(const GAS f32x4*)(c.sgu_g + 8 * lane + 4), d = *(const GAS f32x4*)(c.sgu_b + 8 * lane), e = *(const GAS f32x4*)(c.sgu_b + 8 * lane + 4);
      gg_[0] = a.x; gg_[1] = a.y; gg_[2] = a.z; gg_[3] = a.w; gg_[4] = b.x; gg_[5] = b.y; gg_[6] = b.z; gg_[7] = b.w; bb_[0] = d.x; bb_[1] = d.y; bb_[2] = d.z; bb_[3] = d.w; bb_[4] = e.x; bb_[5] = e.y; bb_[6] = e.z; bb_[7] = e.w; }
#pragma unroll
    for (int u = 0; u < NB; ++u) { const int t = m0 + u * mstride; const float rstd = 1.f / sqrtf(q[u] * (1.f / 512.f) + NORM_EPS);
#pragma unroll
        for (int i = 0; i < 8; ++i) f[u][i] = f[u][i] * rstd * gg_[i] + bb_[i];
        if (t < T) st8(c.proj + (size_t)t * NPROJ + OFF_C + 512 + 8 * lane, f[u]); } }
__device__ __forceinline__ void v_rwkv_kk(const Ctx& c, long idx, int lane) {
    const size_t o = (size_t)idx * 8; float k[8], af[8], ab[8]; unpack8(*(const GAS v4u*)(c.kk + o), k); unpack8(*(const GAS v4u*)(c.akf + o), af); unpack8(*(const GAS v4u*)(c.akb + o), ab);
    float ss = 0.f;
#pragma unroll
    for (int i = 0; i < 8; ++i) ss += k[i] * k[i];
    const float n = 1.f / sqrtf(red8(ss, lane) + 1e-12f);
#pragma unroll
    for (int i = 0; i < 8; ++i) { k[i] *= n; af[i] *= k[i]; ab[i] *= k[i]; }
    st8(c.kk + o, k); st8(c.akf + o, af); st8(c.akb + o, ab); }
__device__ __forceinline__ void v_dil_combine(const bf16* dpo, const float* dml, bf16* ycat, long idx) {
    const int cg = (int)(idx & 63), h = cg >> 3; const long t = idx >> 6; float m[3], l[3];
#pragma unroll
    for (int br = 0; br < 3; ++br) { const float* mp = dml + (((size_t)br * T + t) * 8 + h) * 2; m[br] = mp[0]; l[br] = mp[1]; }
    const float M = fmaxf(m[0], fmaxf(m[1], m[2])); float wgt[3], den = 0.f;
#pragma unroll
    for (int br = 0; br < 3; ++br) { wgt[br] = FEXP(m[br] - M) * l[br]; den += wgt[br]; }
    const float inv = 1.f / den; float y[8];
#pragma unroll
    for (int i = 0; i < 8; ++i) y[i] = 0.f;
#pragma unroll
    for (int br = 0; br < 3; ++br) { float f[8]; unpack8(*(const GAS v4u*)(dpo + ((size_t)br * T + t) * 512 + cg * 8), f); const float wv = wgt[br] * inv;
#pragma unroll
        for (int i = 0; i < 8; ++i) y[i] += wv * f[i]; }
    st8(ycat + (size_t)t * 2048 + 1536 + cg * 8, y); }
template <int NB>
__device__ __forceinline__ void v_dil_combine_batch(const bf16* dpo, const float* dml, bf16* ycat, long idx0, long istride, long iend) {
    cvt_f2 ml[NB][3]; v4u raw[NB][3];
#pragma unroll
    for (int u = 0; u < NB; ++u) { const long idx = idx0 + u * istride < iend ? idx0 + u * istride : idx0; const int cg = (int)(idx & 63), h = cg >> 3; const long t = idx >> 6;
#pragma unroll
        for (int br = 0; br < 3; ++br) { ml[u][br] = *(const GAS cvt_f2*)(dml + (((size_t)br * T + t) * 8 + h) * 2); raw[u][br] = *(const GAS v4u*)(dpo + ((size_t)br * T + t) * 512 + cg * 8); } }
#pragma unroll
    for (int u = 0; u < NB; ++u) { const long idx = idx0 + u * istride; const int cg = (int)(idx & 63); const long t = idx >> 6;
        const float M = fmaxf(ml[u][0].x, fmaxf(ml[u][1].x, ml[u][2].x)); float wgt[3], den = 0.f;
#pragma unroll
        for (int br = 0; br < 3; ++br) { wgt[br] = FEXP(ml[u][br].x - M) * ml[u][br].y; den += wgt[br]; }
        const float inv = 1.f / den; float y[8];
#pragma unroll
        for (int i = 0; i < 8; ++i) y[i] = 0.f;
#pragma unroll
        for (int br = 0; br < 3; ++br) { float f[8]; unpack8(raw[u][br], f); const float wv = wgt[br] * inv;
#pragma unroll
            for (int i = 0; i < 8; ++i) y[i] += wv * f[i]; }
        if (idx < iend) st8(ycat + (size_t)t * 2048 + 1536 + cg * 8, y); } }
__device__ __forceinline__ void v_ret_scan2(const Ctx& c, long idx) {
    const int de = 2 * (int)(idx & 2047); const long r = idx >> 11; const int dir = (int)(r & 1), h = (int)((r >> 1) & 7);
    const float cd = expf(128.f * logsigmoidf_(c.gam[dir * 8 + h]));
    const GAS unsigned* src = (const GAS unsigned*)((const bf16*)c.rkv + (size_t)r * NC * 4096 + de); GAS unsigned* dst = (GAS unsigned*)((bf16*)c.rsp + (size_t)r * NC * 4096 + de);
    unsigned kv[NC];
#pragma unroll
    for (int k = 0; k < NC; ++k) { const int ch = dir == 0 ? k : NC - 1 - k; kv[k] = src[ch * 2048]; }
    float S0 = 0.f, S1 = 0.f;
#pragma unroll
    for (int k = 0; k < NC; ++k) { const int ch = dir == 0 ? k : NC - 1 - k; dst[ch * 2048] = cvtpk(S0, S1); S0 = S0 * cd + __builtin_bit_cast(float, kv[k] << 16); S1 = S1 * cd + __builtin_bit_cast(float, kv[k] & 0xffff0000u); }
}
__device__ __forceinline__ void v_rwkv_fin(const Ctx& c, long idx, int lane) {
    const int cg = (int)(idx & 63); const long t = idx >> 6; const size_t o = (size_t)idx * 8;
    float yf[8], yb[8], r[8], k[8], v[8], g[8]; unpack8(*(const GAS v4u*)(c.yf + o), yf); unpack8(*(const GAS v4u*)(c.yb + o), yb); unpack8(*(const GAS v4u*)(c.rs + o), r); unpack8(*(const GAS v4u*)(c.ks + o), k);
    unpack8(*(const GAS v4u*)(c.vs + o), v); unpack8(*(const GAS v4u*)(c.gg + o), g);
    float s = 0.f, bon = 0.f;
#pragma unroll
    for (int i = 0; i < 8; ++i) { yf[i] += yb[i]; s += yf[i]; bon += r[i] * k[i] * c.r_k[cg * 8 + i]; }
    const float mu = red8(s, lane) * (1.f / 64.f); bon = red8(bon, lane); float q = 0.f;
#pragma unroll
    for (int i = 0; i < 8; ++i) { yf[i] -= mu; q += yf[i] * yf[i]; }
    const float rstd = 1.f / sqrtf(red8(q, lane) * (1.f / 64.f) + GN_EPS); float out[8];
#pragma unroll
    for (int i = 0; i < 8; ++i) out[i] = (yf[i] * rstd * c.ln_g[cg * 8 + i] + bon * v[i]) * g[i];
    st8(c.ycat + (size_t)t * 2048 + 512 + cg * 8, out); }

constexpr int DIL_LD = 72, DIL_TEAM_BYTES = (64 + 192 + 192) * DIL_LD * 2;
static_assert(2 * DIL_TEAM_BYTES <= RING_BYTES, "dilated attention LDS");
__device__ __forceinline__ void dil_attn_phase(LAS unsigned char* lds, const bf16* proj, bf16* dpo, float* dml, const int tid, const int bid, const int G) {
    const int lane = tid & 63, wave = RFL(tid >> 6), team = wave >> 2, w = wave & 3, tt = tid & 255, fr = lane & 15, fq = lane >> 4;
    LAS bf16* Qs = (LAS bf16*)(lds + team * DIL_TEAM_BYTES); LAS bf16* Ks = Qs + 64 * DIL_LD; LAS bf16* Vs = Ks + 192 * DIL_LD;
    constexpr int NITEMS = BATCH * 8 * 3 * 64;
    v4u pq[2], pk[6], pv[6];
#define DIL_DECODE(it_) const int blk = (it_) & 63; int r_ = (it_) >> 6; const int br = r_ % 3; r_ /= 3; const int h = r_ & 7, b = r_ >> 3; \
        const int dil = br == 0 ? 1 : (br == 1 ? 4 : 16), L = SEQ / dil, nb = L / 64, g = blk / nb, n = blk % nb; const bf16* base = proj + (size_t)b * SEQ * NPROJ + OFF_D + h * 64
#define DIL_LOAD(it_) do { DIL_DECODE(it_); \
        _Pragma("unroll") for (int u = 0; u < 2; ++u) { const int c_ = tt + 256 * u, i_ = c_ >> 3, ch_ = c_ & 7; const int pos_ = (64 * n + i_) * dil + g; pq[u] = *(const GAS v4u*)(base + (size_t)pos_ * NPROJ + ch_ * 8); } \
        _Pragma("unroll") for (int u = 0; u < 6; ++u) { const int c_ = tt + 256 * u, kr_ = c_ >> 3, ch_ = c_ & 7; const int kidx_ = 64 * (n - 1) + kr_; const bool ok_ = kidx_ >= 0 && kidx_ < L; const int pos_ = (ok_ ? kidx_ : 0) * dil + g; \
            pk[u] = (v4u){0u, 0u, 0u, 0u}; pv[u] = pk[u]; if (ok_) { pk[u] = *(const GAS v4u*)(base + (size_t)pos_ * NPROJ + 512 + ch_ * 8); pv[u] = *(const GAS v4u*)(base + (size_t)pos_ * NPROJ + 1024 + ch_ * 8); } } } while (0)
    if (bid * 2 < NITEMS) DIL_LOAD(bid * 2 + team);
    for (int it0 = bid * 2; it0 < NITEMS; it0 += G * 2) {
        const int it = it0 + team;
        DIL_DECODE(it);
        LBAR();
#pragma unroll
        for (int u = 0; u < 2; ++u) { const int c_ = tt + 256 * u; *(LAS v4u*)(Qs + (c_ >> 3) * DIL_LD + (c_ & 7) * 8) = pq[u]; }
#pragma unroll
        for (int u = 0; u < 6; ++u) { const int c_ = tt + 256 * u; *(LAS v4u*)(Ks + (c_ >> 3) * DIL_LD + (c_ & 7) * 8) = pk[u]; *(LAS v4u*)(Vs + (c_ >> 3) * DIL_LD + (c_ & 7) * 8) = pv[u]; }
        LBAR();
        if (it0 + G * 2 < NITEMS) DIL_LOAD(it0 + G * 2 + team);
        bf16x8 qf[2];
#pragma unroll
        for (int ks = 0; ks < 2; ++ks) qf[ks] = frag_row(Qs, DIL_LD, 16 * w, 32 * ks, fr, fq);
        f32x4 sc[9];
#pragma unroll
        for (int kp = 0; kp < 9; ++kp) { sc[kp] = (f32x4){0.f, 0.f, 0.f, 0.f}; const LAS bf16* Kt = Ks + 16 * (w + kp) * DIL_LD;
#pragma unroll
            for (int ks = 0; ks < 2; ++ks) sc[kp] = MMA16(frag_row(Kt, DIL_LD, 0, 32 * ks, fr, fq), qf[ks], sc[kp]); }
        const int qi = 64 * n + 16 * w + fr; float mx = -1e30f;
#pragma unroll
        for (int kp = 0; kp < 9; ++kp) { const int kt = w + kp; const bool tile_ok = (n > 0 || kt >= 4) && (n < nb - 1 || kt < 8);
#pragma unroll
            for (int j = 0; j < 4; ++j) { const int e = 4 * fq + j - fr; const bool ok = tile_ok && (kp == 0 ? e >= 0 : (kp == 8 ? e <= 0 : true));
                sc[kp][j] = ok ? sc[kp][j] : -1e30f; mx = fmaxf(mx, sc[kp][j]); } }
        mx = xlane_max4(mx, lane);
        float den = 0.f;
#pragma unroll
        for (int kp = 0; kp < 9; ++kp)
#pragma unroll
            for (int j = 0; j < 4; ++j) { const float p = sc[kp][j] > -1e29f ? FEXP(sc[kp][j] - mx) : 0.f; sc[kp][j] = p; den += p; }
        den = xlane_sum4(den, lane);
        f32x4 o[4];
#pragma unroll
        for (int et = 0; et < 4; ++et) o[et] = (f32x4){0.f, 0.f, 0.f, 0.f};
#pragma unroll
        for (int u = 0; u < 5; ++u) {
            const unsigned p0 = cvtpk(sc[2 * u][0], sc[2 * u][1]), p1 = cvtpk(sc[2 * u][2], sc[2 * u][3]);
            const unsigned p2 = u < 4 ? cvtpk(sc[u < 4 ? 2 * u + 1 : 8][0], sc[u < 4 ? 2 * u + 1 : 8][1]) : 0u, p3 = u < 4 ? cvtpk(sc[u < 4 ? 2 * u + 1 : 8][2], sc[u < 4 ? 2 * u + 1 : 8][3]) : 0u;
            const bf16x8 pf = __builtin_bit_cast(bf16x8, (v4u){p0, p1, p2, p3});
            const int r0 = 16 * (w + 2 * u), r1 = 16 * (w + (u < 4 ? 2 * u + 1 : 2 * u));
#pragma unroll
            for (int et = 0; et < 4; ++et) { const s16x4 a = tr4(Vs, DIL_LD, r0 + 4 * fq, 16 * et, fr), bq = tr4(Vs, DIL_LD, r1 + 4 * fq, 16 * et, fr);
                o[et] = MMA16(((bf16x8){a[0], a[1], a[2], a[3], bq[0], bq[1], bq[2], bq[3]}), pf, o[et]); }
        }
        const float inv = 1.f / den; const size_t t = (size_t)b * SEQ + (size_t)qi * dil + g;
        bf16* op = dpo + ((size_t)br * T + t) * 512 + h * 64 + 4 * fq;
#pragma unroll
        for (int et = 0; et < 4; ++et) { v2u pk; pk.x = cvtpk(o[et][0] * inv, o[et][1] * inv); pk.y = cvtpk(o[et][2] * inv, o[et][3] * inv); __builtin_nontemporal_store(pk, (GAS v2u*)(op + 16 * et)); }
        if (fq == 0) { float* mp = dml + (((size_t)br * T + t) * 8 + h) * 2; mp[0] = mx; mp[1] = den; }
    }
}

constexpr int RET_LD = 72, RET1_TEAM_BYTES = 3 * 128 * RET_LD * 2;
static_assert(2 * RET1_TEAM_BYTES <= RING_BYTES && (3 * 128 + 2 * 64) * RET_LD * 2 <= RING_BYTES, "retention LDS");
__device__ __forceinline__ void ret_kv_phase(LAS unsigned char* lds, const bf16* proj, const float* gam, float* rkv, const int tid, const int bid, const int G) {
    const int lane = tid & 63, wave = RFL(tid >> 6), team = wave >> 2, w = wave & 3, tt = tid & 255, fr = lane & 15, fq = lane >> 4;
    LAS bf16* Kf = (LAS bf16*)(lds + team * RET1_TEAM_BYTES); LAS bf16* Kb = Kf + 128 * RET_LD; LAS bf16* Vs = Kb + 128 * RET_LD;
    constexpr int NITEMS = BATCH * 8 * NC;
    v4u pkk[4], pvv[4];
#define RKV_LOAD(it_) do { const int ch_ = (it_) % NC, h_ = ((it_) / NC) & 7, b_ = (it_) / (NC * 8); const bf16* base_ = proj + ((size_t)b_ * SEQ + (size_t)ch_ * 128) * NPROJ + OFF_A + h_ * 64; \
        _Pragma("unroll") for (int u = 0; u < 4; ++u) { const int c_ = tt + 256 * u, m_ = c_ >> 3, cc_ = c_ & 7; pkk[u] = *(const GAS v4u*)(base_ + (size_t)m_ * NPROJ + 512 + cc_ * 8); pvv[u] = *(const GAS v4u*)(base_ + (size_t)m_ * NPROJ + 1024 + cc_ * 8); } } while (0)
    if (bid * 2 < NITEMS) RKV_LOAD(bid * 2 + team);
    for (int it0 = bid * 2; it0 < NITEMS; it0 += G * 2) {
        const int it = it0 + team; const int ch = it % NC, h = (it / NC) & 7, b = it / (NC * 8);
        const float lgf = logsigmoidf_(gam[h]), lgb = logsigmoidf_(gam[8 + h]);
        LBAR();
#pragma unroll
        for (int u = 0; u < 4; ++u) { const int c = tt + 256 * u; const int m = c >> 3, cc = c & 7;
            const v4u kv = pkk[u], vv = pvv[u];
            float f[8]; unpack8(kv, f); const float df = FEXP(lgf * (float)(127 - m)), db = FEXP(lgb * (float)m);
            *(LAS v4u*)(Kf + m * RET_LD + cc * 8) = (v4u){cvtpk(f[0] * df, f[1] * df), cvtpk(f[2] * df, f[3] * df), cvtpk(f[4] * df, f[5] * df), cvtpk(f[6] * df, f[7] * df)};
            *(LAS v4u*)(Kb + m * RET_LD + cc * 8) = (v4u){cvtpk(f[0] * db, f[1] * db), cvtpk(f[2] * db, f[3] * db), cvtpk(f[4] * db, f[5] * db), cvtpk(f[6] * db, f[7] * db)};
            *(LAS v4u*)(Vs + m * RET_LD + cc * 8) = vv; }
        LBAR();
        if (it0 + G * 2 < NITEMS) RKV_LOAD(it0 + G * 2 + team);
        f32x4 aF[4], aB[4];
#pragma unroll
        for (int dt = 0; dt < 4; ++dt) { aF[dt] = (f32x4){0.f, 0.f, 0.f, 0.f}; aB[dt] = aF[dt]; }
#pragma unroll
        for (int ks = 0; ks < 4; ++ks) { const bf16x8 a = frag_col(Vs, RET_LD, 32 * ks, 16 * w, fr, fq);
#pragma unroll
            for (int dt = 0; dt < 4; ++dt) { aF[dt] = MMA16(frag_col(Kf, RET_LD, 32 * ks, 16 * dt, fr, fq), a, aF[dt]); aB[dt] = MMA16(frag_col(Kb, RET_LD, 32 * ks, 16 * dt, fr, fq), a, aB[dt]); } }
        bf16* oF = (bf16*)rkv + ((size_t)((b * 8 + h) * 2 + 0) * NC + ch) * 4096; bf16* oB = (bf16*)rkv + ((size_t)((b * 8 + h) * 2 + 1) * NC + ch) * 4096;
#pragma unroll
        for (int dt = 0; dt < 4; ++dt) { const int e = 16 * w + fr, d0 = 16 * dt + 4 * fq;
            *(GAS v2u*)(oF + e * 64 + d0) = (v2u){cvtpk(aF[dt][0], aF[dt][1]), cvtpk(aF[dt][2], aF[dt][3])}; *(GAS v2u*)(oB + e * 64 + d0) = (v2u){cvtpk(aB[dt][0], aB[dt][1]), cvtpk(aB[dt][2], aB[dt][3])}; }
    }
}
__device__ __forceinline__ void ret_out_phase(LAS unsigned char* lds, const bf16* proj, const float* gam, const float* ret_g, const float* rsp, bf16* ycat, const int tid, const int bid, const int G) {
    const int lane = tid & 63, w = RFL(tid >> 6), fr = lane & 15, fq = lane >> 4;
    LAS bf16* Qs = (LAS bf16*)lds; LAS bf16* Ks = Qs + 128 * RET_LD; LAS bf16* Vs = Ks + 128 * RET_LD; LAS bf16* Sf = Vs + 128 * RET_LD; LAS bf16* Sb = Sf + 64 * RET_LD;
    constexpr int NITEMS = BATCH * 8 * NC;
    v4u pq[2], pk[2], pv[2]; v2u psf[2], psb[2];
#define RO_LOAD(it_) do { const int ch_ = (it_) % NC, h_ = ((it_) / NC) & 7, b_ = (it_) / (NC * 8); const bf16* base_ = proj + ((size_t)b_ * SEQ + (size_t)ch_ * 128) * NPROJ + OFF_A + h_ * 64; \
        const bf16* gSf_ = (const bf16*)rsp + ((size_t)((b_ * 8 + h_) * 2 + 0) * NC + ch_) * 4096; const bf16* gSb_ = (const bf16*)rsp + ((size_t)((b_ * 8 + h_) * 2 + 1) * NC + ch_) * 4096; \
        _Pragma("unroll") for (int u = 0; u < 2; ++u) { const int c_ = tid + 512 * u, m_ = c_ >> 3, cc_ = c_ & 7; const bf16* rp_ = base_ + (size_t)m_ * NPROJ + cc_ * 8; \
            pq[u] = *(const GAS v4u*)(rp_); pk[u] = *(const GAS v4u*)(rp_ + 512); pv[u] = *(const GAS v4u*)(rp_ + 1024); \
            const int e_ = c_ >> 4, d4_ = (c_ & 15) * 4; psf[u] = *(const GAS v2u*)(gSf_ + e_ * 64 + d4_); psb[u] = *(const GAS v2u*)(gSb_ + e_ * 64 + d4_); } } while (0)
    if (bid < NITEMS) RO_LOAD(bid);
    for (int it = bid; it < NITEMS; it += G) {
        const int ch = it % NC, h = (it / NC) & 7, b = it / (NC * 8);
        const float lgf = logsigmoidf_(gam[h]), lgb = logsigmoidf_(gam[8 + h]);
        const size_t t0 = (size_t)b * SEQ + (size_t)ch * 128;
        const bf16* base = proj + t0 * NPROJ + OFF_A + h * 64;
        LBAR();
#pragma unroll
        for (int u = 0; u < 2; ++u) { const int c = tid + 512 * u, m = c >> 3, cc = c & 7;
            *(LAS v4u*)(Qs + m * RET_LD + cc * 8) = pq[u]; *(LAS v4u*)(Ks + m * RET_LD + cc * 8) = pk[u]; *(LAS v4u*)(Vs + m * RET_LD + cc * 8) = pv[u];
            const int e = c >> 4, d4 = (c & 15) * 4;
            *(LAS v2u*)(Sf + e * RET_LD + d4) = psf[u]; *(LAS v2u*)(Sb + e * RET_LD + d4) = psb[u]; }
        LBAR();
        if (it + G < NITEMS) RO_LOAD(it + G);
        bf16x8 qf[2];
#pragma unroll
        for (int ks = 0; ks < 2; ++ks) qf[ks] = frag_row(Qs, RET_LD, 16 * w, 32 * ks, fr, fq);
        f32x4 sc[8];
#pragma unroll
        for (int kt = 0; kt < 8; ++kt) { sc[kt] = (f32x4){0.f, 0.f, 0.f, 0.f};
#pragma unroll
            for (int ks = 0; ks < 2; ++ks) sc[kt] = MMA16(frag_row(Ks, RET_LD, 16 * kt, 32 * ks, fr, fq), qf[ks], sc[kt]); }
        const int n = 16 * w + fr;
#pragma unroll
        for (int kt = 0; kt < 8; ++kt)
#pragma unroll
            for (int j = 0; j < 4; ++j) { const int m = 16 * kt + 4 * fq + j; sc[kt][j] *= m <= n ? FEXP(lgf * (float)(n - m)) : FEXP(lgb * (float)(m - n)); }
        f32x4 o[4], aF[4], aB[4];
#pragma unroll
        for (int et = 0; et < 4; ++et) { o[et] = (f32x4){0.f, 0.f, 0.f, 0.f}; aF[et] = o[et]; aB[et] = o[et]; }
#pragma unroll
        for (int u = 0; u < 4; ++u) {
            const bf16x8 pf = __builtin_bit_cast(bf16x8, (v4u){cvtpk(sc[2 * u][0], sc[2 * u][1]), cvtpk(sc[2 * u][2], sc[2 * u][3]), cvtpk(sc[2 * u + 1][0], sc[2 * u + 1][1]), cvtpk(sc[2 * u + 1][2], sc[2 * u + 1][3])});
#pragma unroll
            for (int et = 0; et < 4; ++et) { const s16x4 a = tr4(Vs, RET_LD, 32 * u + 4 * fq, 16 * et, fr), bq = tr4(Vs, RET_LD, 32 * u + 16 + 4 * fq, 16 * et, fr);
                o[et] = MMA16(((bf16x8){a[0], a[1], a[2], a[3], bq[0], bq[1], bq[2], bq[3]}), pf, o[et]); }
        }
#pragma unroll
        for (int et = 0; et < 4; ++et)
#pragma unroll
            for (int ks = 0; ks < 2; ++ks) { aF[et] = MMA16(frag_row(Sf, RET_LD, 16 * et, 32 * ks, fr, fq), qf[ks], aF[et]); aB[et] = MMA16(frag_row(Sb, RET_LD, 16 * et, 32 * ks, fr, fq), qf[ks], aB[et]); }
        const float qdf = FEXP(lgf * (float)(n + 1)), qdb = FEXP(lgb * (float)(128 - n));
        float mu = 0.f;
#pragma unroll
        for (int et = 0; et < 4; ++et)
#pragma unroll
            for (int j = 0; j < 4; ++j) { o[et][j] += qdf * aF[et][j] + qdb * aB[et][j]; mu += o[et][j]; }
        mu = xlane_sum4(mu, lane) * (1.f / 64.f);
        float var = 0.f;
#pragma unroll
        for (int et = 0; et < 4; ++et)
#pragma unroll
            for (int j = 0; j < 4; ++j) { const float dlt = o[et][j] - mu; var += dlt * dlt; }
        const float rstd = 1.f / sqrtf(xlane_sum4(var, lane) * (1.f / 64.f) + GN_EPS);
        const bf16* gp = proj + (t0 + n) * NPROJ + OFF_A + 1536 + h * 64 + 4 * fq; bf16* yp = ycat + (t0 + n) * 2048 + h * 64 + 4 * fq; const float* gg = ret_g + h * 64 + 4 * fq;
#pragma unroll
        for (int et = 0; et < 4; ++et) { const v2u gv = *(const GAS v2u*)(gp + 16 * et); const f32x4 gn = *(const GAS f32x4*)(gg + 16 * et);
            const float g0 = __builtin_bit_cast(float, gv.x << 16), g1 = __builtin_bit_cast(float, gv.x & 0xffff0000u), g2 = __builtin_bit_cast(float, gv.y << 16), g3 = __builtin_bit_cast(float, gv.y & 0xffff0000u);
            const float y0 = siluf_(g0) * ((o[et][0] - mu) * rstd * gn.x), y1 = siluf_(g1) * ((o[et][1] - mu) * rstd * gn.y), y2 = siluf_(g2) * ((o[et][2] - mu) * rstd * gn.z), y3 = siluf_(g3) * ((o[et][3] - mu) * rstd * gn.w);
            *(GAS v2u*)(yp + 16 * et) = (v2u){cvtpk(y0, y1), cvtpk(y2, y3)}; }
    }
}
constexpr int SGU_LDV = 72, SGU_LDW = 136, SGU_TEAM_BYTES = (128 * SGU_LDV + 128 * SGU_LDW) * 2;
static_assert(2 * SGU_TEAM_BYTES <= RING_BYTES, "SGU LDS");
__device__ __forceinline__ void sgu_phase(LAS unsigned char* lds, const bf16* proj, const float* sgu_w, const float* sgu_bias, bf16* ycat, const int tid, const int bid, const int G) {
    const int lane = tid & 63, wave = RFL(tid >> 6), team = wave >> 2, w = wave & 3, tt = tid & 255, fr = lane & 15, fq = lane >> 4;
    LAS bf16* Vn = (LAS bf16*)(lds + team * SGU_TEAM_BYTES); LAS bf16* Ws = Vn + 128 * SGU_LDV;
    constexpr int NITEMS = BATCH * NC * 8;
    v4u pvn[4]; f32x4 pws[16];
#define SGU_LOAD(it_) do { const int bc_ = (it_) % (BATCH * NC), g_ = (it_) / (BATCH * NC); const bf16* vb_ = proj + (size_t)bc_ * 128 * NPROJ + OFF_C + 512 + g_ * 64; const float* wsrc_ = sgu_w + (size_t)g_ * 128 * 128; \
        _Pragma("unroll") for (int u = 0; u < 4; ++u) { const int c_ = tt + 256 * u, q_ = c_ >> 3, cc_ = c_ & 7; pvn[u] = *(const GAS v4u*)(vb_ + (size_t)q_ * NPROJ + cc_ * 8); } \
        _Pragma("unroll") for (int u = 0; u < 16; ++u) { const int c_ = tt + 256 * u, p_ = c_ >> 5, q4_ = (c_ & 31) * 4; pws[u] = *(const GAS f32x4*)(wsrc_ + p_ * 128 + q4_); } } while (0)
    if (bid * 2 < NITEMS) SGU_LOAD(bid * 2 + team);
    for (int it0 = bid * 2; it0 < NITEMS; it0 += G * 2) {
        const int it = it0 + team; const int bc = it % (BATCH * NC), g = it / (BATCH * NC);
        const size_t t0 = (size_t)bc * 128;
        LBAR();
#pragma unroll
        for (int u = 0; u < 4; ++u) { const int c = tt + 256 * u, q = c >> 3, cc = c & 7; *(LAS v4u*)(Vn + q * SGU_LDV + cc * 8) = pvn[u]; }
#pragma unroll
        for (int u = 0; u < 16; ++u) { const int c = tt + 256 * u, p = c >> 5, q4 = (c & 31) * 4; const f32x4 a = pws[u]; *(LAS v2u*)(Ws + p * SGU_LDW + q4) = (v2u){cvtpk(a.x, a.y), cvtpk(a.z, a.w)}; }
        LBAR();
        if (it0 + G * 2 < NITEMS) SGU_LOAD(it0 + G * 2 + team);
        f32x4 acc[2][4];
#pragma unroll
        for (int i = 0; i < 2; ++i)
#pragma unroll
            for (int dt = 0; dt < 4; ++dt) acc[i][dt] = (f32x4){0.f, 0.f, 0.f, 0.f};
#pragma unroll
        for (int ks = 0; ks < 4; ++ks) { bf16x8 a[4];
#pragma unroll
            for (int dt = 0; dt < 4; ++dt) a[dt] = frag_col(Vn, SGU_LDV, 32 * ks, 16 * dt, fr, fq);
#pragma unroll
            for (int i = 0; i < 2; ++i) { const bf16x8 bfr = frag_row(Ws, SGU_LDW, 16 * (2 * w + i), 32 * ks, fr, fq);
#pragma unroll
                for (int dt = 0; dt < 4; ++dt) acc[i][dt] = MMA16(a[dt], bfr, acc[i][dt]); } }
#pragma unroll
        for (int i = 0; i < 2; ++i) { const int p = 16 * (2 * w + i) + fr; const float bias = sgu_bias[g * 128 + p];
            const bf16* up = proj + (t0 + p) * NPROJ + OFF_C + g * 64 + 4 * fq; bf16* yp = ycat + (t0 + p) * 2048 + 1024 + g * 64 + 4 * fq;
#pragma unroll
            for (int dt = 0; dt < 4; ++dt) { const v2u uv = *(const GAS v2u*)(up + 16 * dt);
                const float u0 = __builtin_bit_cast(float, uv.x << 16), u1 = __builtin_bit_cast(float, uv.x & 0xffff0000u), u2 = __builtin_bit_cast(float, uv.y << 16), u3 = __builtin_bit_cast(float, uv.y & 0xffff0000u);
                *(GAS v2u*)(yp + 16 * dt) = (v2u){cvtpk(geluf_(u0) * (acc[i][dt][0] + bias), geluf_(u1) * (acc[i][dt][1] + bias)), cvtpk(geluf_(u2) * (acc[i][dt][2] + bias), geluf_(u3) * (acc[i][dt][3] + bias))}; } }
    }
}

constexpr int LO_LDL = 456, LO_LDW = 72, LO_LIN_B = 64 * LO_LDL * 2, LO_W2_B = 96 * LO_LDW * 2, LO_G2_B = 256 * LO_LDW * 2;
static_assert(LO_LIN_B + 2 * LO_W2_B + LO_G2_B <= RING_BYTES, "LoRA LDS");
__device__ __forceinline__ void rwkv_lora_phase(LAS unsigned char* lds, const Ctx& c, const int tid, const int bid, const int G) {
    const int lane = tid & 63, wave = RFL(tid >> 6), tt = wave & 3, chh = wave >> 2, fr = lane & 15, fq = lane >> 4;
    LAS bf16* LIN = (LAS bf16*)lds; LAS bf16* W2s = (LAS bf16*)(lds + LO_LIN_B); LAS bf16* A2s = (LAS bf16*)(lds + LO_LIN_B + LO_W2_B); LAS bf16* G2s = (LAS bf16*)(lds + LO_LIN_B + 2 * LO_W2_B);
    for (int blk = bid; blk < T / 64; blk += G) {
        const size_t t0 = (size_t)blk * 64;
        LBAR();
        for (int q = tid; q < 64 * 56; q += 512) { const int r = q / 56, cc = q % 56; *(LAS v4u*)(LIN + r * LO_LDL + cc * 8) = *(const GAS v4u*)(c.lin + (t0 + r) * NLORA + cc * 8); }
        v2u pw2[3], pa2[3], pg2[8];
#define LO_LOADW(h_) do { _Pragma("unroll") for (int u = 0; u < 3; ++u) { const int q_ = tid + 512 * u, i_ = q_ >> 4, c4_ = (q_ & 15) * 4; pw2[u] = *(const GAS v2u*)(c.loraw + (size_t)i_ * 512 + (h_) * 64 + c4_); pa2[u] = *(const GAS v2u*)(c.loraw + (size_t)(96 + i_) * 512 + (h_) * 64 + c4_); } \
        _Pragma("unroll") for (int u = 0; u < 8; ++u) { const int q_ = tid + 512 * u, i_ = q_ >> 4, c4_ = (q_ & 15) * 4; pg2[u] = *(const GAS v2u*)(c.loraw + (size_t)(192 + i_) * 512 + (h_) * 64 + c4_); } } while (0)
        LO_LOADW(0);
        for (int h = 0; h < 8; ++h) {
            if (h > 0) LBAR();
#pragma unroll
            for (int u = 0; u < 3; ++u) { const int q = tid + 512 * u, i = q >> 4, c4 = (q & 15) * 4;
                *(LAS v2u*)(W2s + i * LO_LDW + c4) = pw2[u]; *(LAS v2u*)(A2s + i * LO_LDW + c4) = pa2[u]; }
#pragma unroll
            for (int u = 0; u < 8; ++u) { const int q = tid + 512 * u, i = q >> 4, c4 = (q & 15) * 4; *(LAS v2u*)(G2s + i * LO_LDW + c4) = pg2[u]; }
            LBAR();
            if (h < 7) LO_LOADW(h + 1);
            f32x4 aw[2], aa[2], ag[2];
#pragma unroll
            for (int ct = 0; ct < 2; ++ct) { aw[ct] = (f32x4){0.f, 0.f, 0.f, 0.f}; aa[ct] = aw[ct]; ag[ct] = aw[ct]; }
#pragma unroll
            for (int ks = 0; ks < 3; ++ks) { const bf16x8 fw = frag_row(LIN, LO_LDL, 16 * tt, 32 * ks, fr, fq), fa = frag_row(LIN, LO_LDL, 16 * tt, 96 + 32 * ks, fr, fq);
#pragma unroll
                for (int ct = 0; ct < 2; ++ct) { aw[ct] = MMA16(frag_col(W2s, LO_LDW, 32 * ks, 32 * chh + 16 * ct, fr, fq), fw, aw[ct]); aa[ct] = MMA16(frag_col(A2s, LO_LDW, 32 * ks, 32 * chh + 16 * ct, fr, fq), fa, aa[ct]); } }
#pragma unroll
            for (int ks = 0; ks < 8; ++ks) { const bf16x8 fg = frag_row(LIN, LO_LDL, 16 * tt, 192 + 32 * ks, fr, fq);
#pragma unroll
                for (int ct = 0; ct < 2; ++ct) ag[ct] = MMA16(frag_col(G2s, LO_LDW, 32 * ks, 32 * chh + 16 * ct, fr, fq), fg, ag[ct]); }
#pragma unroll
            for (int ct = 0; ct < 2; ++ct) { const int ch0 = h * 64 + 32 * chh + 16 * ct + 4 * fq; const size_t o = (t0 + 16 * tt + fr) * 512 + ch0;
                *(GAS v2u*)(c.gg + o) = (v2u){cvtpk(ag[ct][0], ag[ct][1]), cvtpk(ag[ct][2], ag[ct][3])};
                *(GAS v2u*)(c.kdf + o) = (v2u){cvtpk(aw[ct][0], aw[ct][1]), cvtpk(aw[ct][2], aw[ct][3])};
                *(GAS v2u*)(c.kdb + o) = (v2u){cvtpk(aa[ct][0], aa[ct][1]), cvtpk(aa[ct][2], aa[ct][3])}; }
        }
    }
}

constexpr int RWC = 32, RW_NCH = SEQ / RWC, RW_LD = 72, RW_LS = 40, RW_IN_B = 32 * RW_LD * 2, RW_SM_B = 32 * RW_LS * 2;
constexpr int RW_AH = 0, RW_BC = RW_IN_B, RW_KC = 2 * RW_IN_B, RW_RH = 3 * RW_IN_B, RW_BT = 4 * RW_IN_B, RW_KT = 5 * RW_IN_B, RW_VV = 6 * RW_IN_B, RW_M1 = 7 * RW_IN_B, RW_WW = 8 * RW_IN_B, RW_UL = 9 * RW_IN_B,
              RW_XA = 10 * RW_IN_B, RW_XB = RW_XA + RW_SM_B, RW_T0 = RW_XB + RW_SM_B, RW_T1 = RW_T0 + RW_SM_B, RW_AAK = RW_T1 + RW_SM_B, RW_ARB = RW_AAK + RW_SM_B, RW_ARK = RW_ARB + RW_SM_B, RW_SEG = RW_ARK + RW_SM_B,
              RW_TEAM_BYTES = RW_SEG + 4 * 64 * 4;
static_assert(2 * RW_TEAM_BYTES <= RING_BYTES, "RWKV chunk LDS");
__device__ __forceinline__ void st_tile_bf16(LAS bf16* X, int ld, int r0, int c0, const f32x4 v, int fr, int fq) {
#pragma unroll
    for (int j = 0; j < 4; j += 2) { const unsigned p = cvtpk(v[j], v[j + 1]); X[(r0 + 4 * fq + j) * ld + c0 + fr] = (bf16)p; X[(r0 + 4 * fq + j + 1) * ld + c0 + fr] = (bf16)(p >> 16); } }
__device__ __forceinline__ void rwkv_chunk_phase(LAS unsigned char* lds, const Ctx& c, unsigned char* ws, const int tid, const int bid, const int G) {
    const int lane = tid & 63, wave = RFL(tid >> 6), team = wave >> 2, w = wave & 3, tt = tid & 255, fr = lane & 15, fq = lane >> 4;
    LAS unsigned char* L = lds + team * RW_TEAM_BYTES;
    LAS bf16* AH = (LAS bf16*)(L + RW_AH); LAS bf16* BC = (LAS bf16*)(L + RW_BC); LAS bf16* KC = (LAS bf16*)(L + RW_KC); LAS bf16* RH = (LAS bf16*)(L + RW_RH); LAS bf16* BT = (LAS bf16*)(L + RW_BT);
    LAS bf16* KT = (LAS bf16*)(L + RW_KT); LAS bf16* VV = (LAS bf16*)(L + RW_VV); LAS bf16* M1 = (LAS bf16*)(L + RW_M1); LAS bf16* WW = (LAS bf16*)(L + RW_WW); LAS bf16* UL = (LAS bf16*)(L + RW_UL);
    LAS bf16* XA = (LAS bf16*)(L + RW_XA); LAS bf16* XB = (LAS bf16*)(L + RW_XB); LAS bf16* T0 = (LAS bf16*)(L + RW_T0); LAS bf16* T1 = (LAS bf16*)(L + RW_T1);
    LAS bf16* AAK = (LAS bf16*)(L + RW_AAK); LAS bf16* ARB = (LAS bf16*)(L + RW_ARB); LAS bf16* ARK = (LAS bf16*)(L + RW_ARK); LAS float* SEG = (LAS float*)(L + RW_SEG);
    bf16* gRB = (bf16*)(ws + WS_RB); bf16* gPT = (bf16*)(ws + WS_PT); bf16* gQF = (bf16*)(ws + WS_QF); bf16* gYL = (bf16*)(ws + WS_YL); float* gDC = (float*)(ws + WS_DC);
#ifdef RW_EMU_LIMIT
    constexpr int NITEMS = RW_EMU_LIMIT;
#else
    constexpr int NITEMS = BATCH * 16 * RW_NCH;
#endif
    const int it_ = w >> 1, jt_ = w & 1;
    const int ch = tt & 63, seg = tt >> 6;
    float lwv[8]; unsigned ksr[8], wlr[8], alr[8], rsr[8], vsr[8]; float cw0 = 0.f, ca0 = 0.f, cka = 0.f, ckk = 0.f;
#define RW_LOAD_RAW(item_) do { const int cc_ = (item_) % RW_NCH, unit_ = (item_) / RW_NCH, dir_ = unit_ & 1, h_ = (unit_ >> 1) & 7, b_ = unit_ >> 4; const size_t tb_ = (size_t)b_ * SEQ + (size_t)cc_ * RWC; \
        cw0 = c.w0[dir_ * 512 + h_ * 64 + ch]; ca0 = c.a0[dir_ * 512 + h_ * 64 + ch]; cka = c.k_a[h_ * 64 + ch]; ckk = c.k_k[h_ * 64 + ch]; \
        _Pragma("unroll") for (int r = 0; r < 8; ++r) { const int i_ = 8 * seg + r; const unsigned o_ = ((unsigned)tb_ + (unsigned)(dir_ ? 31 - i_ : i_)) * 512u + (unsigned)(h_ * 64 + ch); \
            ksr[r] = ((const GAS bf16*)c.ks)[o_]; wlr[r] = ((const GAS bf16*)c.kdf)[o_]; alr[r] = ((const GAS bf16*)c.kdb)[o_]; rsr[r] = ((const GAS bf16*)c.rs)[o_]; vsr[r] = ((const GAS bf16*)c.vs)[o_]; } } while (0)
    if (bid * 2 < NITEMS) RW_LOAD_RAW(bid * 2 + team);
    for (int it0 = bid * 2; it0 < NITEMS; it0 += G * 2) {
        const int item = it0 + team;
        LBAR();
        {
            float g[8], kv[8], av[8], kraw[8], ksq[8]; float run = 0.f;
#pragma unroll
            for (int r = 0; r < 8; ++r) { lwv[r] = -0.6065306597126334f * __builtin_amdgcn_rcpf(1.f + FEXP(-(cw0 + __builtin_bit_cast(float, wlr[r] << 16)))); run += lwv[r]; g[r] = run; }
            SEG[seg * 64 + ch] = run;
#pragma unroll
            for (int r = 0; r < 8; ++r) { kv[r] = __builtin_bit_cast(float, ksr[r] << 16); av[r] = __builtin_amdgcn_rcpf(1.f + FEXP(-(ca0 + __builtin_bit_cast(float, alr[r] << 16)))); kraw[r] = kv[r] * ckk; ksq[r] = kraw[r] * kraw[r]; }
#define DPP_ADD(v_, ctrl_) (v_) += __builtin_bit_cast(float, __builtin_amdgcn_update_dpp(0, __builtin_bit_cast(int, (v_)), (ctrl_), 0xF, 0xF, true))
#pragma unroll
            for (int r = 0; r < 8; ++r) { DPP_ADD(ksq[r], 0xB1); DPP_ADD(ksq[r], 0x4E); DPP_ADD(ksq[r], 0x124); DPP_ADD(ksq[r], 0x128); }
#undef DPP_ADD
#pragma unroll
            for (int o = 16; o < 64; o <<= 1) { float t_[8];
#pragma unroll
                for (int r = 0; r < 8; ++r) t_[r] = __builtin_bit_cast(float, __builtin_amdgcn_ds_bpermute((lane ^ o) << 2, __builtin_bit_cast(int, ksq[r])));
#pragma unroll
                for (int r = 0; r < 8; ++r) ksq[r] += t_[r]; }
            LBAR();
            float off = 0.f, GC = 0.f;
#pragma unroll
            for (int s2 = 0; s2 < 4; ++s2) { const float v = SEG[s2 * 64 + ch]; off += s2 < seg ? v : 0.f; GC += v; }
            const float eGC = FEXP(GC);
            if (seg == 0) gDC[(size_t)item * 64 + ch] = eGC;
            float ePrev = FEXP(off);
#pragma unroll
            for (int r = 0; r < 8; r += 2) { float oa[2], ob[2], ok[2], orr[2], obt[2], okt[2];
#pragma unroll
                for (int u = 0; u < 2; ++u) { const int q = r + u;
                    const float eG = FEXP(off + g[q]), eI = __builtin_amdgcn_rcpf(eG), eM = ePrev, eC = eGC * eI; ePrev = eG;
                    const float kk = kraw[q] * __builtin_amdgcn_rsqf(ksq[q] + 1e-12f);
                    const float be = av[q] * kk, kt = kv[q] * (1.f + (av[q] - 1.f) * cka), rr = __builtin_bit_cast(float, rsr[q] << 16);
                    oa[u] = -kk * eM; ob[u] = be * eI; ok[u] = kt * eI; orr[u] = rr * eG; obt[u] = be * eC; okt[u] = kt * eC; }
                const int i = 8 * seg + r; const unsigned pa = cvtpk(oa[0], oa[1]), pb = cvtpk(ob[0], ob[1]), pk = cvtpk(ok[0], ok[1]), pr = cvtpk(orr[0], orr[1]), pbt = cvtpk(obt[0], obt[1]), pkt = cvtpk(okt[0], okt[1]);
                AH[i * RW_LD + ch] = (bf16)pa; AH[(i + 1) * RW_LD + ch] = (bf16)(pa >> 16); BC[i * RW_LD + ch] = (bf16)pb; BC[(i + 1) * RW_LD + ch] = (bf16)(pb >> 16);
                KC[i * RW_LD + ch] = (bf16)pk; KC[(i + 1) * RW_LD + ch] = (bf16)(pk >> 16); RH[i * RW_LD + ch] = (bf16)pr; RH[(i + 1) * RW_LD + ch] = (bf16)(pr >> 16);
                BT[i * RW_LD + ch] = (bf16)pbt; BT[(i + 1) * RW_LD + ch] = (bf16)(pbt >> 16); KT[i * RW_LD + ch] = (bf16)pkt; KT[(i + 1) * RW_LD + ch] = (bf16)(pkt >> 16);
                VV[i * RW_LD + ch] = (bf16)vsr[r]; VV[(i + 1) * RW_LD + ch] = (bf16)vsr[r + 1]; }
        }
        if (it0 + G * 2 < NITEMS) RW_LOAD_RAW(it0 + G * 2 + team);
        LBAR();
        {
            const LAS bf16* As = w < 2 ? AH : RH; const LAS bf16* Bs = (w & 1) ? KC : BC; LAS bf16* D = w == 0 ? XA : (w == 1 ? AAK : (w == 2 ? ARB : ARK));
#pragma unroll
            for (int it = 0; it < 2; ++it)
#pragma unroll
                for (int jt = 0; jt < 2; ++jt) { f32x4 a = (f32x4){0.f, 0.f, 0.f, 0.f};
#pragma unroll
                    for (int ks = 0; ks < 2; ++ks) a = MMA16(frag_row(As, RW_LD, 16 * it, 32 * ks, fr, fq), frag_row(Bs, RW_LD, 16 * jt, 32 * ks, fr, fq), a);
#pragma unroll
                    for (int j = 0; j < 4; ++j) { const int i = 16 * it + 4 * fq + j, jj = 16 * jt + fr; const bool keep = w < 2 ? jj < i : jj <= i; a[j] = keep ? a[j] : 0.f; }
                    st_tile_bf16(D, RW_LS, 16 * it, 16 * jt, a, fr, fq); }
        }
        LBAR();
        f32x4 Tacc;
        {
            const f32x4 x2 = MMA16(frag_row(XA, RW_LS, 16 * it_, 0, fr, fq), frag_col(XA, RW_LS, 0, 16 * jt_, fr, fq), ((f32x4){0.f, 0.f, 0.f, 0.f}));
            st_tile_bf16(XB, RW_LS, 16 * it_, 16 * jt_, x2, fr, fq);
#pragma unroll
            for (int j = 0; j < 4; ++j) { const int i = 16 * it_ + 4 * fq + j, jj = 16 * jt_ + fr; Tacc[j] = bf2f(XA[i * RW_LS + jj]) + (i == jj ? 1.f : 0.f); }
            st_tile_bf16(T0, RW_LS, 16 * it_, 16 * jt_, Tacc, fr, fq);
#pragma unroll
            for (int q = 0; q < 2; ++q) { const int et = 2 * jt_ + q; const f32x4 m1 = MMA16(frag_row(AAK, RW_LS, 16 * it_, 0, fr, fq), frag_col(VV, RW_LD, 0, 16 * et, fr, fq), ((f32x4){0.f, 0.f, 0.f, 0.f}));
                st_tile_bf16(M1, RW_LD, 16 * it_, 16 * et, m1, fr, fq); }
        }
        LBAR();
#define RW_CHAIN(TR, TW, XR, XW, SQUARE) { Tacc = MMA16(frag_row(TR, RW_LS, 16 * it_, 0, fr, fq), frag_col(XR, RW_LS, 0, 16 * jt_, fr, fq), Tacc); st_tile_bf16(TW, RW_LS, 16 * it_, 16 * jt_, Tacc, fr, fq); \
        if (SQUARE) { const f32x4 xx = MMA16(frag_row(XR, RW_LS, 16 * it_, 0, fr, fq), frag_col(XR, RW_LS, 0, 16 * jt_, fr, fq), ((f32x4){0.f, 0.f, 0.f, 0.f})); st_tile_bf16(XW, RW_LS, 16 * it_, 16 * jt_, xx, fr, fq); } \
        LBAR(); }
        RW_CHAIN(T0, T1, XB, XA, true)
        RW_CHAIN(T1, T0, XA, XB, true)
        RW_CHAIN(T0, T1, XB, XA, true)
        RW_CHAIN(T1, T0, XA, XB, false)
#undef RW_CHAIN
        {
            const bf16x8 tf = frag_row(T0, RW_LS, 16 * it_, 0, fr, fq);
#pragma unroll
            for (int q = 0; q < 2; ++q) { const int ct = 2 * jt_ + q;
                st_tile_bf16(WW, RW_LD, 16 * it_, 16 * ct, MMA16(tf, frag_col(AH, RW_LD, 0, 16 * ct, fr, fq), ((f32x4){0.f, 0.f, 0.f, 0.f})), fr, fq);
                st_tile_bf16(UL, RW_LD, 16 * it_, 16 * ct, MMA16(tf, frag_col(M1, RW_LD, 0, 16 * ct, fr, fq), ((f32x4){0.f, 0.f, 0.f, 0.f})), fr, fq); }
        }
        LBAR();
        {
            const bf16x8 wcol = frag_col(WW, RW_LD, 0, 16 * w, fr, fq), ulc = frag_col(UL, RW_LD, 0, 16 * w, fr, fq), vvc = frag_col(VV, RW_LD, 0, 16 * w, fr, fq);
            bf16* pt = gPT + (size_t)item * 4096; bf16* qf = gQF + (size_t)item * 4096; bf16* rb = gRB + (size_t)item * 2048; bf16* yl = gYL + (size_t)item * 2048;
#pragma unroll
            for (int kq = 0; kq < 4; ++kq) { const bf16x8 btc = frag_col(BT, RW_LD, 0, 16 * kq, fr, fq), ktc = frag_col(KT, RW_LD, 0, 16 * kq, fr, fq);
                const f32x4 p = MMA16(wcol, btc, ((f32x4){0.f, 0.f, 0.f, 0.f}));
                __builtin_nontemporal_store(((v2u){cvtpk(p[0], p[1]), cvtpk(p[2], p[3])}), (GAS v2u*)(pt + ((kq * 2 + (w >> 1)) * 64 + lane) * 8 + (w & 1) * 4));
                f32x4 q = MMA16(btc, ulc, ((f32x4){0.f, 0.f, 0.f, 0.f})); q = MMA16(ktc, vvc, q);
                __builtin_nontemporal_store(((v2u){cvtpk(q[0], q[1]), cvtpk(q[2], q[3])}), (GAS v2u*)(qf + ((w * 4 + kq) * 64 + lane) * 4)); }
#pragma unroll
            for (int it = 0; it < 2; ++it) { const bf16x8 arb = frag_row(ARB, RW_LS, 16 * it, 0, fr, fq), ark = frag_row(ARK, RW_LS, 16 * it, 0, fr, fq);
                const f32x4 r = MMA16(wcol, arb, ((f32x4){0.f, 0.f, 0.f, 0.f}));
                const v2u rh = *(const LAS v2u*)(RH + (16 * it + fr) * RW_LD + 16 * w + 4 * fq);
                const float r0 = r[0] + __builtin_bit_cast(float, rh.x << 16), r1 = r[1] + __builtin_bit_cast(float, rh.x & 0xffff0000u), r2 = r[2] + __builtin_bit_cast(float, rh.y << 16), r3 = r[3] + __builtin_bit_cast(float, rh.y & 0xffff0000u);
                __builtin_nontemporal_store(((v2u){cvtpk(r0, r1), cvtpk(r2, r3)}), (GAS v2u*)(rb + ((it * 2 + (w >> 1)) * 64 + lane) * 8 + (w & 1) * 4));
                f32x4 y = MMA16(arb, ulc, ((f32x4){0.f, 0.f, 0.f, 0.f})); y = MMA16(ark, vvc, y);
                __builtin_nontemporal_store(((v2u){cvtpk(y[0], y[1]), cvtpk(y[2], y[3])}), (GAS v2u*)(yl + ((it * 4 + w) * 64 + lane) * 4)); }
        }
    }
}
struct RwS { v4u pt[4][2]; v2u q[4]; f32x4 dc[4]; };
__device__ __forceinline__ void rws_load(RwS& s, const unsigned char* ws, int item, int vb, int lane, int fr, int fq) {
    const bf16* pt = (const bf16*)(ws + WS_PT) + (size_t)item * 4096; const bf16* qf = (const bf16*)(ws + WS_QF) + (size_t)item * 4096; const float* dc = (const float*)(ws + WS_DC) + (size_t)item * 64;
#pragma unroll
    for (int kq = 0; kq < 4; ++kq) {
#pragma unroll
        for (int ks = 0; ks < 2; ++ks) s.pt[kq][ks] = *(const GAS v4u*)(pt + ((kq * 2 + ks) * 64 + lane) * 8);
        s.q[kq] = *(const GAS v2u*)(qf + ((vb * 4 + kq) * 64 + lane) * 4); s.dc[kq] = *(const GAS f32x4*)(dc + 16 * kq + 4 * fq); }
}
constexpr int RWS_RING = 8, RWS_SLOT_B = 4 * 64 * 8, RWS_RING_B = RWS_RING * RWS_SLOT_B;
__device__ __forceinline__ unsigned lds_ld(const LAS unsigned* p) { return __hip_atomic_load(p, __ATOMIC_RELAXED, __HIP_MEMORY_SCOPE_WORKGROUP); }
__device__ __forceinline__ void lds_st(LAS unsigned* p, unsigned v) { __hip_atomic_store(p, v, __ATOMIC_RELAXED, __HIP_MEMORY_SCOPE_WORKGROUP); }
__device__ __forceinline__ void rws_step(const RwS& s, f32x4 (&S)[4], LAS unsigned char* ring, LAS unsigned* prog, const LAS unsigned* done, int step, int lane) {
    v2u sp[4];
    if (step >= RWS_RING) { while (lds_ld(done) + RWS_RING <= (unsigned)step) __builtin_amdgcn_s_sleep(1); }
#pragma unroll
    for (int kq = 0; kq < 4; ++kq) { sp[kq] = (v2u){cvtpk(S[kq][0], S[kq][1]), cvtpk(S[kq][2], S[kq][3])}; *(LAS v2u*)(ring + (step % RWS_RING) * RWS_SLOT_B + (kq * 64 + lane) * 8) = sp[kq]; }
    LDS_WAIT_();
    if (lane == 0) lds_st(prog, (unsigned)step + 1u);
#pragma unroll
    for (int kq = 0; kq < 4; ++kq) { f32x4 a;
        a[0] = S[kq][0] * s.dc[kq][0] + __builtin_bit_cast(float, s.q[kq].x << 16); a[1] = S[kq][1] * s.dc[kq][1] + __builtin_bit_cast(float, s.q[kq].x & 0xffff0000u);
        a[2] = S[kq][2] * s.dc[kq][2] + __builtin_bit_cast(float, s.q[kq].y << 16); a[3] = S[kq][3] * s.dc[kq][3] + __builtin_bit_cast(float, s.q[kq].y & 0xffff0000u);
#pragma unroll
        for (int ks = 0; ks < 2; ++ks) a = MMA16(__builtin_bit_cast(bf16x8, s.pt[kq][ks]), __builtin_bit_cast(bf16x8, (v4u){sp[2 * ks].x, sp[2 * ks].y, sp[2 * ks + 1].x, sp[2 * ks + 1].y}), a);
        S[kq] = a; }
}
__device__ __forceinline__ void rwkv_sscan_phase(LAS unsigned char* lds, unsigned char* ws, const int unit, const int vbase, const int wave, const int lane) {
    const int li = wave & 3; if (li >= 2) return;
    const int vb = vbase + li, fr = lane & 15, fq = lane >> 4, dir = unit & 1;
    LAS unsigned char* ring = lds + li * RWS_RING_B; LAS unsigned* prog = (LAS unsigned*)(lds + 4 * RWS_RING_B) + li * 16; LAS unsigned* done = prog + 8;
#define RW_CL(st) ((st) < RW_NCH ? (st) : RW_NCH - 1)
#define RW_ITEM(st) (unit * RW_NCH + (dir ? RW_NCH - 1 - RW_CL(st) : RW_CL(st)))
    if (wave >= 4) {
        for (int st = 0; st < RW_NCH; ++st) {
            while (lds_ld(prog) <= (unsigned)st) __builtin_amdgcn_s_sleep(1);
            bf16* dst = (bf16*)(ws + WS_ST) + (size_t)RW_ITEM(st) * 4096;
#pragma unroll
            for (int kq = 0; kq < 4; ++kq) __builtin_nontemporal_store(*(const LAS v2u*)(ring + (st % RWS_RING) * RWS_SLOT_B + (kq * 64 + lane) * 8), (GAS v2u*)(dst + ((vb * 4 + kq) * 64 + lane) * 4));
            LDS_WAIT_();
            if (lane == 0) lds_st(done, (unsigned)st + 1u);
        }
        return;
    }
    f32x4 S[4];
#pragma unroll
    for (int kq = 0; kq < 4; ++kq) S[kq] = (f32x4){0.f, 0.f, 0.f, 0.f};
    RwS A, B, C;
    rws_load(A, ws, RW_ITEM(0), vb, lane, fr, fq); rws_load(B, ws, RW_ITEM(1), vb, lane, fr, fq);
#define RW_STEP3(st) do { rws_load(C, ws, RW_ITEM((st) + 2), vb, lane, fr, fq); rws_step(A, S, ring, prog, done, (st), lane); \
        rws_load(A, ws, RW_ITEM((st) + 3), vb, lane, fr, fq); rws_step(B, S, ring, prog, done, (st) + 1, lane); \
        rws_load(B, ws, RW_ITEM((st) + 4), vb, lane, fr, fq); rws_step(C, S, ring, prog, done, (st) + 2, lane); } while (0)
    constexpr int RW_MAIN = RW_NCH / 6 * 6, RW_MAIN3 = RW_NCH / 3 * 3;
#pragma unroll 1
    for (int st = 0; st < RW_MAIN; st += 6) { RW_STEP3(st); RW_STEP3(st + 3); }
#pragma unroll 1
    for (int st = RW_MAIN; st < RW_MAIN3; st += 3) RW_STEP3(st);
#undef RW_STEP3
    if (RW_NCH - RW_MAIN3 >= 1) rws_step(A, S, ring, prog, done, RW_MAIN3, lane);
    if (RW_NCH - RW_MAIN3 >= 2) rws_step(B, S, ring, prog, done, RW_MAIN3 + 1, lane);
#undef RW_ITEM
#undef RW_CL
}
__device__ __forceinline__ void rwkv_yfin_phase(LAS unsigned char* lds, const Ctx& c, const unsigned char* ws, const int tid, const int bid, const int G) {
    const int lane = tid & 63, wave = RFL(tid >> 6), fr = lane & 15, fq = lane >> 4; const int gw = bid * 8 + wave, NGW = G * 8;
    LAS float* Yt = (LAS float*)(lds + wave * 16384);
    for (int job = gw; job < BATCH * 8 * RW_NCH; job += NGW) {
        const int cc = job % RW_NCH, bh = job / RW_NCH, h = bh & 7, b = bh >> 3; const size_t tb = (size_t)b * SEQ + (size_t)cc * RWC;
        f32x4 y[2][4];
#pragma unroll
        for (int dir = 0; dir < 2; ++dir) { const int item = (bh * 2 + dir) * RW_NCH + cc;
            const bf16* rb = (const bf16*)(ws + WS_RB) + (size_t)item * 2048; const bf16* yl = (const bf16*)(ws + WS_YL) + (size_t)item * 2048; const bf16* st = (const bf16*)(ws + WS_ST) + (size_t)item * 4096;
#pragma unroll
            for (int it = 0; it < 2; ++it) {
                const int rt = dir ? 1 - it : it, rl = dir ? (15 - fr) + 16 * fq : lane;
                bf16x8 af[2];
#pragma unroll
                for (int ks = 0; ks < 2; ++ks) af[ks] = __builtin_bit_cast(bf16x8, *(const GAS v4u*)(rb + ((rt * 2 + ks) * 64 + rl) * 8));
#pragma unroll
                for (int vb = 0; vb < 4; ++vb) {
                    f32x4 a;
                    if (dir == 0) { const v2u w = *(const GAS v2u*)(yl + ((it * 4 + vb) * 64 + lane) * 4);
                        a = (f32x4){__builtin_bit_cast(float, w.x << 16), __builtin_bit_cast(float, w.x & 0xffff0000u), __builtin_bit_cast(float, w.y << 16), __builtin_bit_cast(float, w.y & 0xffff0000u)}; }
                    else { const v2u w = *(const GAS v2u*)(yl + (((1 - it) * 4 + vb) * 64 + fr + 16 * (3 - fq)) * 4);
                        a = y[it][vb]; a[0] += __builtin_bit_cast(float, w.y & 0xffff0000u); a[1] += __builtin_bit_cast(float, w.y << 16); a[2] += __builtin_bit_cast(float, w.x & 0xffff0000u); a[3] += __builtin_bit_cast(float, w.x << 16); }
#pragma unroll
                    for (int ks = 0; ks < 2; ++ks) { const v2u s0 = *(const GAS v2u*)(st + ((vb * 4 + 2 * ks) * 64 + lane) * 4), s1 = *(const GAS v2u*)(st + ((vb * 4 + 2 * ks + 1) * 64 + lane) * 4);
                        a = MMA16(af[ks], __builtin_bit_cast(bf16x8, (v4u){s0.x, s0.y, s1.x, s1.y}), a); }
                    y[it][vb] = a; } } }
#pragma unroll
        for (int it = 0; it < 2; ++it)
#pragma unroll
            for (int vb = 0; vb < 4; ++vb)
#pragma unroll
                for (int j = 0; j < 4; ++j) Yt[(16 * it + 4 * fq + j) * 68 + 16 * vb + fr] = y[it][vb][j];
        LDS_WAIT_();
#pragma unroll
        for (int q = 0; q < 4; ++q) { const int e = lane + 64 * q, r = e >> 3, cg8 = e & 7; const size_t o = (tb + r) * 512 + h * 64 + cg8 * 8;
            const f32x4 y0 = *(const LAS f32x4*)(Yt + r * 68 + cg8 * 8), y1 = *(const LAS f32x4*)(Yt + r * 68 + cg8 * 8 + 4); float yv[8] = {y0.x, y0.y, y0.z, y0.w, y1.x, y1.y, y1.z, y1.w};
            float rr[8], k[8], v[8], g[8]; unpack8(*(const GAS v4u*)(c.rs + o), rr); unpack8(*(const GAS v4u*)(c.ks + o), k); unpack8(*(const GAS v4u*)(c.vs + o), v); unpack8(*(const GAS v4u*)(c.gg + o), g);
            float s = 0.f, bon = 0.f;
#pragma unroll
            for (int i = 0; i < 8; ++i) { s += yv[i]; bon += rr[i] * k[i] * c.r_k[h * 64 + cg8 * 8 + i]; }
            const float mu = red8(s, lane) * (1.f / 64.f); bon = red8(bon, lane); float qv = 0.f;
#pragma unroll
            for (int i = 0; i < 8; ++i) { yv[i] -= mu; qv += yv[i] * yv[i]; }
            const float rstd = 1.f / sqrtf(red8(qv, lane) * (1.f / 64.f) + GN_EPS); float out[8];
#pragma unroll
            for (int i = 0; i < 8; ++i) out[i] = (yv[i] * rstd * c.ln_g[h * 64 + cg8 * 8 + i] + bon * v[i]) * g[i];
            st8(c.ycat + (tb + r) * 2048 + 512 + h * 64 + cg8 * 8, out); }
        LDS_WAIT_();
    }
}

__device__ __forceinline__ float quad_sum(float v) {
    v += __builtin_bit_cast(float, __builtin_amdgcn_update_dpp(0, __builtin_bit_cast(int, v), 0xB1, 0xF, 0xF, true));
    v += __builtin_bit_cast(float, __builtin_amdgcn_update_dpp(0, __builtin_bit_cast(int, v), 0x4E, 0xF, 0xF, true));
    return v;
}
__device__ __forceinline__ void rwkv_scan_quad(const Ctx& c, int unit, int w4, int lane) {
    const int dir = unit & 1, h = (unit >> 1) & 7, b = unit >> 4; const int row = w4 * 16 + (lane >> 2), q = lane & 3;
    const float* W = dir ? c.wb : c.wf; const bf16* KD = dir ? c.kdb : c.kdf; const bf16* AK = dir ? c.akb : c.akf; bf16* Y = dir ? c.yb : c.yf;
    float S[16];
#pragma unroll
    for (int i = 0; i < 16; ++i) S[i] = 0.f;
    for (int k = 0; k < SEQ; ++k) {
        const int s = dir ? SEQ - 1 - k : k; const size_t o = ((size_t)b * SEQ + s) * 512 + h * 64 + q * 16;
        float kkv[16], akv[16], kdv[16], rv[16], wv[16];
        { const v4u a = *(const GAS v4u*)(c.kk + o), bq = *(const GAS v4u*)(c.kk + o + 8);
          const unsigned t[8] = {a.x, a.y, a.z, a.w, bq.x, bq.y, bq.z, bq.w};
#pragma unroll
          for (int i = 0; i < 8; ++i) { kkv[2 * i] = __builtin_bit_cast(float, t[i] << 16); kkv[2 * i + 1] = __builtin_bit_cast(float, t[i] & 0xffff0000u); } }
        { const v4u a = *(const GAS v4u*)(AK + o), bq = *(const GAS v4u*)(AK + o + 8);
          const unsigned t[8] = {a.x, a.y, a.z, a.w, bq.x, bq.y, bq.z, bq.w};
#pragma unroll
          for (int i = 0; i < 8; ++i) { akv[2 * i] = __builtin_bit_cast(float, t[i] << 16); akv[2 * i + 1] = __builtin_bit_cast(float, t[i] & 0xffff0000u); } }
        { const v4u a = *(const GAS v4u*)(KD + o), bq = *(const GAS v4u*)(KD + o + 8);
          const unsigned t[8] = {a.x, a.y, a.z, a.w, bq.x, bq.y, bq.z, bq.w};
#pragma unroll
          for (int i = 0; i < 8; ++i) { kdv[2 * i] = __builtin_bit_cast(float, t[i] << 16); kdv[2 * i + 1] = __builtin_bit_cast(float, t[i] & 0xffff0000u); } }
        { const v4u a = *(const GAS v4u*)(c.rs + o), bq = *(const GAS v4u*)(c.rs + o + 8);
          const unsigned t[8] = {a.x, a.y, a.z, a.w, bq.x, bq.y, bq.z, bq.w};
#pragma unroll
          for (int i = 0; i < 8; ++i) { rv[2 * i] = __builtin_bit_cast(float, t[i] << 16); rv[2 * i + 1] = __builtin_bit_cast(float, t[i] & 0xffff0000u); } }
#pragma unroll
        for (int i = 0; i < 4; ++i) { const f32x4 w4v = *(const GAS f32x4*)(W + o + 4 * i); wv[4 * i] = w4v.x; wv[4 * i + 1] = w4v.y; wv[4 * i + 2] = w4v.z; wv[4 * i + 3] = w4v.w; }
        const float v = bf2f(c.vs[o - q * 16 + row]);
        float sk = 0.f;
#pragma unroll
        for (int i = 0; i < 16; ++i) sk += S[i] * kkv[i];
        sk = quad_sum(sk);
        float y = 0.f;
#pragma unroll
        for (int i = 0; i < 16; ++i) { S[i] = S[i] * wv[i] - sk * akv[i] + v * kdv[i]; y += S[i] * rv[i]; }
        y = quad_sum(y);
        if (q == 0) Y[o + row] = f2bf(y);
    }
}
constexpr int MOE_ITEMS_PER_E = 2 * (DM / 64) * (DE / 64) + (DE / 64) * (DM / 64);
template <int E_LO, int E_HI, bool WITH_D>
__device__ __forceinline__ void moe_convert(const Args& args, unsigned char* ws, int ll, LAS unsigned char* lds, int wave, int lane, int it0, int stride) {
    constexpr int I_GU = (DM / 64) * (DE / 64), I_D = (DE / 64) * (DM / 64), N_GU = (E_HI - E_LO) * 2 * I_GU, it_end = N_GU + (WITH_D ? NEXP * I_D : 0);
    bf16* WdT = (bf16*)(ws + WS_WD); LAS float* scr = (LAS float*)(lds + wave * 16384);
    const float* wg_ = (const float*)args.in[26] + (size_t)ll * NEXP * DM * DE; const float* wu_ = (const float*)args.in[27] + (size_t)ll * NEXP * DM * DE; const float* wd_ = (const float*)args.in[28] + (size_t)ll * NEXP * DE * DM;
#define MOE_ITEM(p, it_) do { \
        if ((it_) < N_GU) { const int e_ = E_LO + (it_) / (2 * I_GU); int r_ = (it_) % (2 * I_GU); const int up_ = r_ >= I_GU ? 1 : 0; r_ -= up_ * I_GU; const int kb_ = r_ % (DM / 64), n0_ = 64 * (r_ / (DM / 64));       \
            (p) = TrItem{(up_ ? wu_ : wg_) + (size_t)e_ * DM * DE, (bf16*)(ws + wgu_off(e_)), DM, DE, 64 * kb_, n0_, (n0_ >> 7) * 256 + (n0_ & 127) + up_ * 128}; } \
        else { const int jj_ = (it_) - N_GU, e_ = jj_ / I_D, r_ = jj_ % I_D; const int kb_ = r_ % (DE / 64), n0_ = 64 * (r_ / (DE / 64)); (p) = TrItem{wd_ + (size_t)e_ * DE * DM, WdT + (size_t)e_ * DM * DE, DE, DM, 64 * kb_, n0_, n0_}; } } while (0)
    f32x4 va[16]; TrItem pa, pb;
    int it = it0;
    if (it < it_end) { MOE_ITEM(pa, it); tr64_load(va, pa, lane); }
#pragma unroll 1
    while (it < it_end) {
        tr64_put(va, scr, lane);
        const int i1 = it + stride;
        if (i1 < it_end) { MOE_ITEM(pb, i1); tr64_load(va, pb, lane); }
        tr64_get(pa, scr, lane);
        pa = pb; it = i1;
    }
#undef MOE_ITEM
}
__device__ __forceinline__ void win_convert(const Args& args, unsigned char* ws, int lw, LAS unsigned char* lds, int wave, int lane, int w0, int nw) {
            bf16* WinT = (bf16*)(ws + WS_WIN); bf16* WoutT = (bf16*)(ws + WS_WOUT);
            LAS float* scr = (LAS float*)(lds + wave * 16384);
            const float* w_in = (const float*)args.in[3] + (size_t)lw * DM * D_IN; const float* w_out = (const float*)args.in[4] + (size_t)lw * DM * DM;
            constexpr int I_IN = (DM / 64) * (D_IN / 32), I_OUT = (DM / 64) * (DM / 32);
            constexpr int NITEMS = I_IN + I_OUT;
            struct TI { const float* W; bf16* WT; int N, k0, n0, drow0, rmode; float sc; };
#define P0_ITEM(p, it_) do { int r_ = (it_); if (r_ < I_IN) { const int nblk_ = D_IN / 32, kb_ = r_ / nblk_, n0_ = 32 * (r_ % nblk_); \
                    int drow0_ = n0_ + (n0_ >= OFF_D_SRC ? OFF_D - OFF_D_SRC : 0), rmode_ = 0; \
                    if (n0_ < OFF_A + 1024) { drow0_ = (n0_ & ~63) + ((n0_ >> 5) & 1); rmode_ = 1; } else if (n0_ >= OFF_D_SRC && n0_ < OFF_D_SRC + 1024 && (((n0_ - OFF_D_SRC) >> 5) & 1) == 0) rmode_ = 2; \
                    (p) = TI{w_in, WinT, D_IN, 64 * kb_, n0_, drow0_, rmode_, ((n0_ >= OFF_A + 512 && n0_ < OFF_A + 1024) || (n0_ >= OFF_D_SRC && n0_ < OFF_D_SRC + 512)) ? 0.125f : 1.f}; } \
                else { r_ -= I_IN; const int nblk_ = DM / 32, kb_ = r_ / nblk_, n0_ = 32 * (r_ % nblk_); (p) = TI{w_out, WoutT, DM, 64 * kb_, n0_, n0_, 0, 1.f}; } } while (0)
            {   float va[32]; TI pa, pb; int it = w0;
                if (it < NITEMS) { P0_ITEM(pa, it); transpose_load(va, pa.W, pa.N, pa.k0, pa.n0, lane); }
#pragma unroll 1
                while (it < NITEMS) { float vc[32];
#pragma unroll
                    for (int i = 0; i < 32; ++i) vc[i] = va[i];
                    const int i1 = it + nw;
                    if (i1 < NITEMS) { P0_ITEM(pb, i1); transpose_load(va, pb.W, pb.N, pb.k0, pb.n0, lane); }
                    transpose_finish(vc, DM, pa.WT, pa.k0, pa.drow0, scr, lane, pa.sc, pa.rmode);
                    pa = pb; it = i1; } }
#undef P0_ITEM
            for (long i = (long)w0 * 64 + lane; i < (long)(NPROJ - D_IN) * DM / 8; i += (long)nw * 64) ((GAS v4u*)(WinT + (size_t)OFF_D_SRC * DM))[i] = (v4u){0u, 0u, 0u, 0u};
}
template <int KSEL>
__device__ __forceinline__ void layer_program(const Args& args, LAS unsigned char* lds, const XcdBarrier& bar, const int l) {
        PH_ON(0) {
            PHASE_LOCALS();
            if (ll == 0) win_convert(args, ws, ll, lds, wave, lane, gw, NGW);
            if (ll == 0) { for (long i = gtid; i < (long)T * 40; i += gstride) v_rot_table((const int*)args.in[1], (float*)(ws + WS_ROT), i); }
            {   const float* wg = (const float*)args.in[22] + (size_t)ll * DM * 4; const float* we = (const float*)args.in[24] + (size_t)ll * DM * 32; float* rwt = (float*)(ws + WS_RWT);
                const float* n2g = (const float*)args.in[21] + ll * DM;
                for (long i = gtid; i < 48L * DM; i += gstride) { const int j = (int)(i & 3), ln = (int)((i >> 2) & 63), hh = (int)((i >> 8) & 1), r_ = (int)(i >> 9), tl = r_ % 3, S = r_ / 3;
                    const int k = 32 * S + 8 * (ln >> 4) + 4 * hh + j, col = 16 * tl + (ln & 15);
                    rwt[i] = (col < 32 ? we[(size_t)k * 32 + col] : (col < 36 ? wg[(size_t)k * 4 + col - 32] : 0.f)) * n2g[k]; } }
            {
                const float* w2_ = (const float*)args.in[9] + ll * 96 * 512; const float* a2_ = (const float*)args.in[11] + ll * 96 * 512; const float* g2_ = (const float*)args.in[12] + ll * 256 * 512; bf16* lw = (bf16*)(ws + WS_LORAW);
                for (long i = gtid; i < 448L * 512 / 4; i += gstride) { const long e = 4 * i; const int r = (int)(e / 512), cc = (int)(e % 512);
                    const f32x4 v = *(const GAS f32x4*)(r < 96 ? w2_ + (size_t)r * 512 + cc : (r < 192 ? a2_ + (size_t)(r - 96) * 512 + cc : g2_ + (size_t)(r - 192) * 512 + cc));
                    *(GAS v2u*)(lw + e) = (v2u){cvtpk(v.x, v.y), cvtpk(v.z, v.w)}; } }
            if (ll > 0) build_moe_tables(lds, (const unsigned*)(ws + WS_CTL) + CW_CNT + (ll - 1) * 2048, tid);
            const LAS int* trb = (const LAS int*)(lds + TAB_ROWBASE);
            const float* x_in = (const float*)args.in[0]; bf16* xbuf = (bf16*)(ws + WS_X); bf16* act = (bf16*)(ws + WS_ACT); const bf16* yp = (const bf16*)(ws + WS_YP);
            const unsigned* slot_tok = (const unsigned*)(ws + WS_SLOT); const float* gate_tok = (const float*)(ws + WS_GATE);
            const float* norm1_g = (const float*)args.in[2] + ll * DM;
            if (ll == 0) {
#pragma unroll 1
                for (int m0 = gw; m0 < T; m0 += 4 * NGW) rows_norm_f32<4>(x_in, norm1_g, act, m0, NGW, lane);
            } else {
#pragma unroll 1
                for (int m0 = gw; m0 < T; m0 += 2 * NGW) rows_moe<2, false>(xbuf, yp, slot_tok, gate_tok, trb, norm1_g, act, nullptr, 1.f, m0, NGW, lane);
            }
        }
        SEAM(0); TSTAMP_AFTER(0);
        PH_ON(1) {
            PHASE_LOCALS();
            const int G1 = G >= 256 ? GEMM1_G : G;
            if (bid < G1) {
                pg8::Gemm g{(const bf16*)(ws + WS_ACT), (const bf16*)(ws + WS_WIN), T, NPROJ, DM, 0, 0}; pg8::StaticOrder<T, NPROJ> S; S.init(G1, bid);
                pg8::EpiBf16Rot E{(bf16*)(ws + WS_PROJ), NPROJ, (const float*)(ws + WS_ROT)};
                pg8::gemm_phase<DM, pg8::EpiBf16Rot, pg8::StaticOrder<T, NPROJ>, true, true>(lds, g, S, E, tid);
            }
            if (G1 == G) { __syncthreads(); moe_convert<0, 16, false>(args, ws, ll, lds, wave, lane, gw, NGW); }
            else if (bid >= G1) moe_convert<0, 16, false>(args, ws, ll, lds, wave, lane, (bid - G1) * 8 + wave, (G - G1) * 8);
        }
        SEAM(1); TSTAMP_AFTER(1);
        PH_ON(2) { PHASE_LOCALS(); const Ctx c = make_ctx(args, ws, ll);
            {   constexpr unsigned NSH = (unsigned)T * 248u; const unsigned gs = (unsigned)gstride;
#pragma unroll 1
                for (unsigned base = (unsigned)gtid; base < NSH; base += 8u * gs) { ShiftIn in[8];
#pragma unroll
                    for (int u = 0; u < 8; ++u) { const unsigned idx = base + (unsigned)u * gs; if (idx < NSH) shift_load(c, idx, in[u]); }
#pragma unroll
                    for (int u = 0; u < 8; ++u) { const unsigned idx = base + (unsigned)u * gs; if (idx < NSH) shift_finish(c, idx, in[u]); } } }
#pragma unroll 1
            for (int m = gw; m < T; m += 4 * NGW) w_sgu_prep_batch<4>(c, m, NGW, lane); }
        SEAM(2); TSTAMP_AFTER(2);
        PH_ON(3) { PHASE_LOCALS(); const Ctx c = make_ctx(args, ws, ll);
            rwkv_lora_phase(lds, c, tid, bid, G);
            ret_kv_phase(lds, c.proj, c.gam, c.rkv, tid, bid, G);
            sgu_phase(lds, c.proj, c.sgu_w, c.sgu_bias, c.ycat, tid, bid, G);
            dil_attn_phase(lds, c.proj, (bf16*)(ws + WS_DPO), (float*)(ws + WS_DML), tid, bid, G); }
        SEAM(3); TSTAMP_AFTER(3);
        PH_ON(5) { PHASE_LOCALS(); const Ctx c = make_ctx(args, ws, ll);
            for (long i = gtid; i < (long)BATCH * 8 * 2 * 2048; i += gstride) v_ret_scan2(c, i);
            rwkv_chunk_phase(lds, c, ws, tid, bid, G); }
        SEAM(5); TSTAMP_AFTER(5);
        PH_ON(13) { PHASE_LOCALS(); const Ctx c = make_ctx(args, ws, ll);
            constexpr int NU = BATCH * 16 * 2;
            if (bid < NU) { if (tid < 64) ((LAS unsigned*)(lds + 4 * RWS_RING_B))[tid] = 0u; __syncthreads(); rwkv_sscan_phase(lds, ws, bid >> 1, 2 * (bid & 1), wave, lane);
                __syncthreads(); moe_convert<16, 25, false>(args, ws, ll, lds, wave, lane, bid * 8 + wave, NU * 8); }
            else { ret_out_phase(lds, c.proj, c.gam, c.ret_g, c.rsp, c.ycat, tid, bid - NU, G - NU);
#pragma unroll 1
                for (long i = (long)(bid - NU) * 512 + tid; i < (long)T * 64; i += 4 * (long)(G - NU) * 512) v_dil_combine_batch<4>((const bf16*)(ws + WS_DPO), (const float*)(ws + WS_DML), c.ycat, i, (long)(G - NU) * 512, (long)T * 64);
 } }
        SEAM(13); TSTAMP_AFTER(13);
        PH_ON(6) { PHASE_LOCALS(); const Ctx c = make_ctx(args, ws, ll);
            rwkv_yfin_phase(lds, c, ws, tid, bid, G); }
        SEAM(6); TSTAMP_AFTER(6);
        PH_ON(7) {
            PHASE_LOCALS();
            pg8::Gemm g{(const bf16*)(ws + WS_ACT), (const bf16*)(ws + WS_WOUT), T, DM, DM, 0, 0}; pg8::StaticOrder<T, DM> S; S.init(G, bid);
            pg8::EpiResB E{ll == 0 ? (const float*)args.in[0] : nullptr, (const bf16*)(ws + WS_X), (bf16*)(ws + WS_X), DM};
            pg8::gemm_phase<DM, pg8::EpiResB, pg8::StaticOrder<T, DM>, true, true>(lds, g, S, E, tid);
        }
        SEAM(7); TSTAMP_AFTER(7);
        PH_ON(8) {
            PHASE_LOCALS();
            const float* wg = (const float*)args.in[22] + (size_t)ll * DM * 4; const float* bg = (const float*)args.in[23] + ll * 4;
            const float* we = (const float*)args.in[24] + (size_t)ll * DM * 32; const float* be = (const float*)args.in[25] + ll * 32;
            const float* norm2_g = (const float*)args.in[21] + ll * DM;
            const bf16* xbuf = (const bf16*)(ws + WS_X);
            unsigned* cnt_tab = (unsigned*)(ws + WS_TOK); unsigned* slot_tok = (unsigned*)(ws + WS_SLOT); float* gate_tok = (float*)(ws + WS_GATE); float* rstd_tok = (float*)(ws + WS_TOK + 256 * 1024);
            const float* rwt = (const float*)(ws + WS_RWT); const int fr = lane & 15, fq = lane >> 4;
            LAS float* SB = (LAS float*)lds;
            LAS float* lg_s = (LAS float*)(lds + 98304 + (wave & 3) * 4096);
            LAS unsigned* lcnt = (LAS unsigned*)(lds + 131072); LAS unsigned* lbase = lcnt + 32;
            static_assert(T / 16 % 4 == 0, "router tiles");
            for (int tile0 = bid; tile0 < T / 64; tile0 += G) { const int tile = tile0 + (T / 64) * (wave & 3); const bool wact = wave < 4;
                if (tid < 32) lcnt[tid] = 0u;
                __syncthreads();
              int e1 = 0, e2 = 0; float g1 = 0.f, g2 = 0.f; unsigned r1 = 0u, r2 = 0u; float rstd = 0.f; const size_t m0 = (size_t)tile * 16; const bf16* xr = xbuf + (m0 + fr) * DM;
              f32x4 acc[3]; float ss = 0.f;
              {
#pragma unroll
                for (int tl = 0; tl < 3; ++tl) acc[tl] = (f32x4){0.f, 0.f, 0.f, 0.f};
                const int hk = wave >> 2; f32x4 pst[6]; v4u xc[4], xn[4];
#define RT_SLOAD(s_) do { _Pragma("unroll") for (int u = 0; u < 6; ++u) { const int q_ = tid + 512 * (u % 3); pst[u] = *(const GAS f32x4*)(rwt + (size_t)(32 * (u / 3) + 4 * (s_)) * 1536 + 4 * q_); } } while (0)
#define RT_SPUT(buf_) do { _Pragma("unroll") for (int u = 0; u < 6; ++u) { const int q_ = tid + 512 * (u % 3); *(LAS f32x4*)(SB + ((buf_) * 2 + (u / 3)) * 6144 + 4 * q_) = pst[u]; } } while (0)
#define RT_XLOAD(xv, s_) do { _Pragma("unroll") for (int j_ = 0; j_ < 4; ++j_) (xv)[j_] = *(const GAS v4u*)(xr + 32 * (32 * hk + 4 * (s_) + j_) + 8 * fq); } while (0)
                RT_SLOAD(0); RT_XLOAD(xc, 0); RT_SPUT(0); __syncthreads();
#pragma unroll 1
                for (int sg = 0; sg < 8; ++sg) {
                    if (sg < 7) { RT_SLOAD(sg + 1); RT_XLOAD(xn, sg + 1); }
                    const LAS float* bs = SB + ((sg & 1) * 2 + hk) * 6144 + lane * 4;
#pragma unroll
                    for (int j_ = 0; j_ < 4; ++j_) { f32x4 xv[2];
                        xv[0] = (f32x4){__builtin_bit_cast(float, xc[j_].x << 16), __builtin_bit_cast(float, xc[j_].x & 0xffff0000u), __builtin_bit_cast(float, xc[j_].y << 16), __builtin_bit_cast(float, xc[j_].y & 0xffff0000u)};
                        xv[1] = (f32x4){__builtin_bit_cast(float, xc[j_].z << 16), __builtin_bit_cast(float, xc[j_].z & 0xffff0000u), __builtin_bit_cast(float, xc[j_].w << 16), __builtin_bit_cast(float, xc[j_].w & 0xffff0000u)};
#pragma unroll
                        for (int hh = 0; hh < 2; ++hh) { ss += (xv[hh].x * xv[hh].x + xv[hh].y * xv[hh].y) + (xv[hh].z * xv[hh].z + xv[hh].w * xv[hh].w);
#pragma unroll
                            for (int tl = 0; tl < 3; ++tl) { const f32x4 bv = *(const LAS f32x4*)(bs + j_ * 1536 + (tl * 2 + hh) * 256);
#pragma unroll
                                for (int jj = 0; jj < 4; ++jj) acc[tl] = __builtin_amdgcn_mfma_f32_16x16x4f32(xv[hh][jj], bv[jj], acc[tl], 0, 0, 0); } } }
                    if (sg < 7) RT_SPUT((sg + 1) & 1);
                    __syncthreads();
#pragma unroll
                    for (int j_ = 0; j_ < 4; ++j_) xc[j_] = xn[j_];
                }
#undef RT_SLOAD
#undef RT_SPUT
#undef RT_XLOAD
              }
              {   LAS float* part = (LAS float*)(lds + 114688 + (wave & 3) * 4096);
                if (!wact) {
#pragma unroll
                    for (int tl = 0; tl < 3; ++tl)
#pragma unroll
                        for (int j = 0; j < 4; ++j) part[(tl * 4 + j) * 64 + lane] = acc[tl][j];
                    part[12 * 64 + lane] = ss; }
                __syncthreads();
                if (wact) {
#pragma unroll
                    for (int tl = 0; tl < 3; ++tl)
#pragma unroll
                        for (int j = 0; j < 4; ++j) acc[tl][j] += part[(tl * 4 + j) * 64 + lane];
                    ss += part[12 * 64 + lane]; } }
              if (wact) {
                ss = xlane_sum4(ss, lane);
                rstd = 1.f / sqrtf(ss * (1.f / DM) + NORM_EPS);
#pragma unroll
                for (int tl = 0; tl < 3; ++tl)
#pragma unroll
                    for (int j = 0; j < 4; ++j) lg_s[(4 * fq + j) * 48 + 16 * tl + fr] = acc[tl][j];
                if (fq == 0) lg_s[768 + fr] = rstd;
                LDS_WAIT(); asm volatile("" ::: "memory");
                if (lane < 16) { const float rs_ = lg_s[768 + lane]; float lg[4], le[32];
#pragma unroll
                    for (int i = 0; i < 32; ++i) le[i] = lg_s[lane * 48 + i] * rs_;
#pragma unroll
                    for (int i = 0; i < 4; ++i) lg[i] = lg_s[lane * 48 + 32 + i] * rs_;
                    route_select(lg, le, bg, be, e1, e2, g1, g2);
                    r1 = __hip_atomic_fetch_add(lcnt + e1, 1u, __ATOMIC_RELAXED, __HIP_MEMORY_SCOPE_WORKGROUP); r2 = __hip_atomic_fetch_add(lcnt + e2, 1u, __ATOMIC_RELAXED, __HIP_MEMORY_SCOPE_WORKGROUP); }
              }
                __syncthreads();
                if (tid < 32) cnt_tab[tile0 * 32 + tid] = lcnt[tid];
              if (wact) {
                if (lane < 16) { const int m = (int)m0 + lane;
                    slot_tok[2 * m] = ((unsigned)e1 << 20) | r1; slot_tok[2 * m + 1] = ((unsigned)e2 << 20) | r2; gate_tok[2 * m] = g1; gate_tok[2 * m + 1] = g2; }
                if (fq == 0) rstd_tok[m0 + fr] = rstd;
              }
                __syncthreads();
            }
        }
        SEAM(8); TSTAMP_AFTER(8);
        PH_ON(9) {
            PHASE_LOCALS();
            moe_convert<25, 32, false>(args, ws, ll, lds, wave, lane, gw, NGW);
            {
                const unsigned* cnt_tab = (const unsigned*)(ws + WS_TOK); unsigned* slot_tok = (unsigned*)(ws + WS_SLOT); unsigned* cnt_cur = (unsigned*)(ws + WS_CTL) + CW_CNT + ll * 2048;
                const bf16* xbuf = (const bf16*)(ws + WS_X); const float* norm2_g = (const float*)args.in[21] + ll * DM; const float* rstd_tok = (const float*)(ws + WS_TOK + 256 * 1024); bf16* aperm = (bf16*)(ws + WS_APERM);
                LAS int* tcnt = (LAS int*)(lds + TAB_CNT); const LAS int* trb = (const LAS int*)(lds + TAB_ROWBASE);
                LAS int* gbase = (LAS int*)(lds + 8192); LAS int* clist = (LAS int*)(lds + 8192 + 256);
                static_assert((T / 64) % 16 == 0, "prefix parts");
                constexpr int GPP = T / 64 / 16;
                LAS int* psum = (LAS int*)(lds + 16384);
                __syncthreads();
                {   const int e = tid & 31, p = tid >> 5; int sacc = 0;
#pragma unroll
                    for (int u = 0; u < GPP; ++u) sacc += (int)cnt_tab[(p * GPP + u) * 32 + e];
                    psum[p * 32 + e] = sacc; }
                __syncthreads();
                if (tid < 32) { int run = 0;
#pragma unroll
                    for (int p = 0; p < 16; ++p) run += psum[p * 32 + tid];
                    tcnt[tid] = run; if (bid == 0) cnt_cur[64 * tid] = (unsigned)run; }
                build_moe_tables(lds, nullptr, tid);
                for (int rg = bid; rg < T / 64; rg += G) {
                    __syncthreads();
                    if (tid < 32) { const int p0 = rg / GPP; int base = 0;
                        for (int p = 0; p < p0; ++p) base += psum[p * 32 + tid];
#pragma unroll
                        for (int u = 0; u < GPP; ++u) base += (p0 * GPP + u < rg) ? (int)cnt_tab[(p0 * GPP + u) * 32 + tid] : 0;
                        gbase[tid] = base; }
                    __syncthreads();
                    if (wave < 4 && lane < 16) { const int m = 16 * (rg + (T / 64) * wave) + lane; clist[(wave * 16 + lane) * 4] = m;
#pragma unroll
                        for (int k = 0; k < 2; ++k) { const unsigned sv = slot_tok[2 * m + k]; const int e = (int)(sv >> 20); const int r = gbase[e] + (int)(sv & 0xfffffu);
                            slot_tok[2 * m + k] = ((unsigned)e << 20) | (unsigned)r; clist[(wave * 16 + lane) * 4 + 1 + k] = trb[e] + r; } }
                    __syncthreads();
                    for (int i = wave; i < 64; i += 8) {
                        const int m = clist[4 * i]; const size_t R1 = (size_t)clist[4 * i + 1], R2 = (size_t)clist[4 * i + 2]; const float rs_ = rstd_tok[m];
                        f32x4 v[8]; ROW_LOAD_BF(v, xbuf + (size_t)m * DM);
#pragma unroll
                        for (int j = 0; j < 8; ++j) { const f32x4 g = ((const GAS f32x4*)norm2_g)[lane + 64 * j];
                            v2u o; o.x = cvtpk(v[j].x * g.x * rs_, v[j].y * g.y * rs_); o.y = cvtpk(v[j].z * g.z * rs_, v[j].w * g.w * rs_);
                            ((GAS v2u*)(aperm + R1 * DM))[lane + 64 * j] = o; ((GAS v2u*)(aperm + R2 * DM))[lane + 64 * j] = o; } }
                }
                for (int e = 0; e < NEXP; ++e) { const int c0 = tcnt[e], rend = ((c0 + 255) >> 8) * 256;
                    for (int r = c0 + gw; r < rend; r += NGW) { GAS v4u* dst = (GAS v4u*)(aperm + (size_t)(trb[e] + r) * DM);
#pragma unroll
                        for (int j = 0; j < 4; ++j) dst[lane + 64 * j] = (v4u){0u, 0u, 0u, 0u}; } }
            }
        }
        SEAM(9); TSTAMP_AFTER(9);
        PH_ON(10) {
            PHASE_LOCALS();
            build_moe_tables(lds, (const unsigned*)(ws + WS_CTL) + CW_CNT + ll * 2048, tid);
            const int ntiles = __builtin_amdgcn_readfirstlane(((const LAS int*)(lds + TAB_NT))[0]);
            pg8::Gemm g{(const bf16*)(ws + WS_APERM), (const bf16*)ws, MOE_MAXTILES * 256, 1024, DM, 0, 1};
            const int units = ntiles * 4, rounds = (units + G - 1) / G, G3r = rounds > 0 ? (units + rounds - 1) / rounds : G, G3 = (G - G3r >= 16) ? G3r : G;
            if (bid < G3) {
                pg8::MoeOrder<4> S{G3, bid, ntiles, (const LAS int*)(lds + TAB_TEXP)};
                pg8::EpiSwiGLU E{(bf16*)(ws + WS_HID), DE};
                pg8::gemm_phase<DM, pg8::EpiSwiGLU, pg8::MoeOrder<4>, true, true>(lds, g, S, E, tid);
            }
            if (G3 == G) { __syncthreads(); moe_convert<0, 0, true>(args, ws, ll, lds, wave, lane, gw, NGW); if (ll + 1 < DEPTH) { __syncthreads(); win_convert(args, ws, ll + 1, lds, wave, lane, gw, NGW); } }
            else if (bid >= G3) { moe_convert<0, 0, true>(args, ws, ll, lds, wave, lane, (bid - G3) * 8 + wave, (G - G3) * 8);
                if (ll + 1 < DEPTH) { __syncthreads(); win_convert(args, ws, ll + 1, lds, wave, lane, (bid - G3) * 8 + wave, (G - G3) * 8); } }
        }
        SEAM(10); TSTAMP_AFTER(10);
        PH_ON(11) {
            PHASE_LOCALS();
            build_moe_tables(lds, (const unsigned*)(ws + WS_CTL) + CW_CNT + ll * 2048, tid);
            const int ntiles = __builtin_amdgcn_readfirstlane(((const LAS int*)(lds + TAB_NT))[0]);
            pg8::Gemm g{(const bf16*)(ws + WS_HID), (const bf16*)(ws + WS_WD), MOE_MAXTILES * 256, DM, DE, (size_t)DM * DE * 2, 0};
            pg8::MoeOrder<8> S{G, bid, ntiles, (const LAS int*)(lds + TAB_TEXP)};
            pg8::EpiBf16 E{(bf16*)(ws + WS_YP), DM};
            pg8::gemm_phase<DE, pg8::EpiBf16, pg8::MoeOrder<8>, true, true>(lds, g, S, E, tid);
        }
        SEAM(11); TSTAMP_AFTER(11);
    }

template <int KSEL>
__global__ void __launch_bounds__(512, 2) fwd_kernel(Args args) {
    extern __shared__ __attribute__((aligned(16))) unsigned char lds_raw[];
    LAS unsigned char* lds = (LAS unsigned char*)lds_raw;
    if (threadIdx.x < 4) ((LAS unsigned*)(lds + MISC_OFF))[threadIdx.x] = 0u;
    __syncthreads();
    XcdBarrier bar; bar.bar = (unsigned*)(args.ws + WS_CTL) + CW_BAR; bar.x = 0; bar.st = nullptr;
    if constexpr (KSEL < 0) bar = xcd_barrier_post((unsigned*)(args.ws + WS_CTL) + CW_BAR, (volatile LAS unsigned*)(lds + MISC_OFF));
    if (KB_TPROBE >= 0 && KSEL < 0 && blockIdx.x == 0 && threadIdx.x == 0) ((unsigned long long*)(args.ws + WS_CTL))[32768] = wall_clock64();
    if constexpr (KSEL < 0) { layer_program<KSEL>(args, lds, bar, 0); layer_program<KSEL>(args, lds, bar, 1); }
    else if constexpr (KSEL != 12) layer_program<KSEL>(args, lds, bar, args.layer);
    PH_ON(12) {
        const int l = DEPTH - 1;
        PHASE_LOCALS();
        build_moe_tables(lds, (const unsigned*)(ws + WS_CTL) + CW_CNT + ll * 2048, tid);
        const LAS int* trb = (const LAS int*)(lds + TAB_ROWBASE);
        float pscale = 1.f;
        if (KB_TPROBE >= 0) { const unsigned long long* ts = (const unsigned long long*)(ws + WS_CTL) + 32768; const int p = KB_TPROBE;
            const float tot = (float)(ts[13] - ts[0]); const int pe = KB_TPROBE_END; const float d = (float)(ts[pe] - ts[p]);
            pscale = 1.f + 0.01f * (float)(int)(d / tot * 40.f + 0.5f); }
        const float* gfin = (const float*)args.in[29]; const bf16* xbuf = (const bf16*)(ws + WS_X); const bf16* yp = (const bf16*)(ws + WS_YP);
        const unsigned* slot_tok = (const unsigned*)(ws + WS_SLOT); const float* gate_tok = (const float*)(ws + WS_GATE);
        for (int m = gw; m < T; m += NGW) {
            f32x4 v[8];
            ROW_LOAD_BF(v, xbuf + (size_t)m * DM);
            const unsigned s1 = slot_tok[2 * m], s2 = slot_tok[2 * m + 1]; const float g1 = gate_tok[2 * m], g2 = gate_tok[2 * m + 1];
            row_add_moe(v, yp, (size_t)(trb[s1 >> 20] + (int)(s1 & 0xfffffu)), (size_t)(trb[s2 >> 20] + (int)(s2 & 0xfffffu)), g1, g2, lane);
            const float rstd = row_rstd(v, lane);
#pragma unroll
            for (int j = 0; j < 8; ++j) { const f32x4 g = ((const GAS f32x4*)gfin)[lane + 64 * j];
                ((GAS f32x4*)(args.out + (size_t)m * DM))[lane + 64 * j] = (f32x4){v[j].x * rstd * g.x * pscale, v[j].y * rstd * g.y * pscale, v[j].z * rstd * g.z * pscale, v[j].w * rstd * g.w * pscale}; }
        }
    }
#undef SEAM
#undef PH_ON
}

extern "C" void kernel_launch(void* const* d_in, const int* in_sizes, int n_in, void* d_out, int out_size, void* d_ws, size_t ws_size, hipStream_t stream) {
    static int grid = 0;
    if (grid == 0) {
        if (n_in != 30 || in_sizes[0] != T * DM || out_size != T * DM || ws_size < WS_END) { fprintf(stderr, "kernel_launch: unexpected shapes (n_in %d, in0 %d, out %d, ws %zu < %zu)\n", n_in, n_in > 0 ? in_sizes[0] : -1, out_size, ws_size, (size_t)WS_END); grid = -1; return; }
        int dev = 0, cus = 0, per_cu = 0; (void)per_cu;
        if (hipGetDevice(&dev) != hipSuccess || hipDeviceGetAttribute(&cus, hipDeviceAttributeMultiprocessorCount, dev) != hipSuccess) { grid = -1; return; }
#if KB_SPLIT
#define SET_ATTR(k) if (hipFuncSetAttribute((const void*)fwd_kernel<k>, hipFuncAttributeMaxDynamicSharedMemorySize, LDS_BYTES) != hipSuccess) { fprintf(stderr, "kernel_launch: hipFuncSetAttribute failed (%d)\n", k); grid = -1; return; }
        SET_ATTR(0) SET_ATTR(1) SET_ATTR(2) SET_ATTR(3) SET_ATTR(4) SET_ATTR(5) SET_ATTR(6) SET_ATTR(7) SET_ATTR(8) SET_ATTR(9) SET_ATTR(10) SET_ATTR(11) SET_ATTR(12) SET_ATTR(13)
#else
        if (hipFuncSetAttribute((const void*)fwd_kernel<-1>, hipFuncAttributeMaxDynamicSharedMemorySize, LDS_BYTES) != hipSuccess) { fprintf(stderr, "kernel_launch: hipFuncSetAttribute failed\n"); grid = -1; return; }
        if (hipOccupancyMaxActiveBlocksPerMultiprocessor(&per_cu, (const void*)fwd_kernel<-1>, 512, LDS_BYTES) != hipSuccess || per_cu < 1) fprintf(stderr, "kernel_launch: occupancy query says %d\n", per_cu);
#endif
        (void)hipGetLastError();
        grid = cus;
    }
    if (grid < 0) return;
    if (hipMemsetAsync((char*)d_ws + WS_CTL, 0, CTL_ZERO_BYTES, stream) != hipSuccess) return;
    Args a{};
    for (int i = 0; i < 30; ++i) a.in[i] = d_in[i];
    a.out = (float*)d_out; a.ws = (unsigned char*)d_ws; a.layer = 0; a.pad = 0;
#if KB_SPLIT
#define LAUNCH_PH(k) hipLaunchKernelGGL(fwd_kernel<k>, dim3(grid), dim3(512), LDS_BYTES, stream, a)
    for (int l = 0; l < DEPTH; ++l) { a.layer = l;
        LAUNCH_PH(0); LAUNCH_PH(1); LAUNCH_PH(2); LAUNCH_PH(3); LAUNCH_PH(4); LAUNCH_PH(5); LAUNCH_PH(13); LAUNCH_PH(6); LAUNCH_PH(7); LAUNCH_PH(8); LAUNCH_PH(9); LAUNCH_PH(10); LAUNCH_PH(11); }
    a.layer = DEPTH - 1; LAUNCH_PH(12);
#else
    hipLaunchKernelGGL(fwd_kernel<-1>, dim3(grid), dim3(512), LDS_BYTES, stream, a);
#endif
}
#endif
```
